# Optimizing an MI355X kernel written in HIP

```python
import jax, jax.numpy as jnp
from jax import lax
import numpy as np

D_MODEL = 1024
BATCH = 4
SEQ = 4096
DEPTH = 1

D_MIX = D_MODEL
MLA_HEADS = 4
QK_NOPE_DIM = 128
QK_ROPE_DIM = 64
QK_HEAD_DIM = QK_NOPE_DIM + QK_ROPE_DIM
V_HEAD_DIM = 128
Q_LORA_RANK = 256
KV_LORA_RANK = 128
ROPE_THETA = 10000.0
ATTN_Q_BLOCK = 128
MLA_WIDTH = MLA_HEADS * V_HEAD_DIM
SG_HEADS = 4
SG_HEAD_DIM = 128
SG_WIDTH = SG_HEADS * SG_HEAD_DIM
SG_CHUNK = 128
IN_COLS = Q_LORA_RANK + KV_LORA_RANK + QK_ROPE_DIM + 2 * SG_WIDTH
PEER_HEADS = 8
PEER_N_KEYS = 128
PEER_N_EXPERTS = PEER_N_KEYS * PEER_N_KEYS
PEER_TOPK = 16
PEER_QUERY_DIM = 256
PEER_HALF_DIM = PEER_QUERY_DIM // 2
PEER_TOKEN_BLOCK = 128
N_MOD = 6
EPS = 1e-6

kernel_name = "hymba_mla_gmlp_peer_adaln_encoder"


def rmsnorm(x, g):
    xf = x.astype(jnp.float32)
    y = xf * lax.rsqrt(jnp.mean(xf * xf, axis=-1, keepdims=True) + EPS)
    return (y * g.astype(jnp.float32)).astype(x.dtype)


def modulate(h, shift, scale):
    return h * (1.0 + scale[:, None, :]) + shift[:, None, :]


def rope(x, cos, sin):
    half = x.shape[-1] // 2
    x1, x2 = x[..., :half], x[..., half:]
    return jnp.concatenate([x1 * cos - x2 * sin, x2 * cos + x1 * sin], axis=-1)


def rope_tables(positions, dtype):
    inv_freq = 1.0 / (ROPE_THETA ** (jnp.arange(0, QK_ROPE_DIM, 2, dtype=jnp.float32) / QK_ROPE_DIM))
    ang = positions.astype(jnp.float32)[..., None] * inv_freq
    return jnp.cos(ang).astype(dtype), jnp.sin(ang).astype(dtype)


def mla_group(c_q, c_kv, k_rope_raw, cos, sin, g_q_a, w_uq, g_kv_a, w_ukv):
    B, S, _ = c_q.shape
    q = (rmsnorm(c_q, g_q_a) @ w_uq).reshape(B, S, MLA_HEADS, QK_HEAD_DIM)
    q_rope = rope(q[..., QK_NOPE_DIM:], cos[:, :, None, :], sin[:, :, None, :])
    q = jnp.concatenate([q[..., :QK_NOPE_DIM], q_rope], axis=-1)
    kv = (rmsnorm(c_kv, g_kv_a) @ w_ukv).reshape(B, S, MLA_HEADS, QK_NOPE_DIM + V_HEAD_DIM)
    k_nope, v = kv[..., :QK_NOPE_DIM], kv[..., QK_NOPE_DIM:]
    k_rope = rope(k_rope_raw, cos, sin)
    k = jnp.concatenate(
        [k_nope, jnp.broadcast_to(k_rope[:, :, None, :], (B, S, MLA_HEADS, QK_ROPE_DIM))], axis=-1)
    scale = QK_HEAD_DIM ** -0.5
    nb = S // ATTN_Q_BLOCK
    qb = q.reshape(B, nb, ATTN_Q_BLOCK, MLA_HEADS, QK_HEAD_DIM).transpose(1, 0, 2, 3, 4)

    def attend(q_blk):
        s = jnp.einsum('bqhd,bkhd->bhqk', q_blk, k).astype(jnp.float32) * scale
        p = jax.nn.softmax(s, axis=-1).astype(v.dtype)
        return jnp.einsum('bhqk,bkhd->bqhd', p, v)

    o = lax.map(attend, qb)
    return o.transpose(1, 0, 2, 3, 4).reshape(B, S, MLA_WIDTH)


def sgu_group(u, v, g_sg, w_sg, b_sg):
    B, S, _ = u.shape
    u = jax.nn.gelu(u, approximate=False)
    v = rmsnorm(jax.nn.gelu(v, approximate=False), g_sg)
    nc = S // SG_CHUNK
    v = v.reshape(B, nc, SG_CHUNK, SG_HEADS, SG_HEAD_DIM)
    mix = jnp.einsum('hpq,bnqhd->bnphd', w_sg, v) + b_sg.T[None, None, :, :, None]
    out = u.reshape(B, nc, SG_CHUNK, SG_HEADS, SG_HEAD_DIM) * mix
    return out.reshape(B, S, SG_WIDTH)


def peer(h, w_q, keys, U, V):
    B, S, D = h.shape
    T = B * S
    ht = h.reshape(T, D)
    q = (ht @ w_q).reshape(T, PEER_HEADS, 2, PEER_HALF_DIM)
    s1 = jnp.einsum('thd,hkd->thk', q[:, :, 0], keys[:, 0]).astype(jnp.float32)
    s2 = jnp.einsum('thd,hkd->thk', q[:, :, 1], keys[:, 1]).astype(jnp.float32)
    v1, i1 = lax.top_k(s1, PEER_TOPK)
    v2, i2 = lax.top_k(s2, PEER_TOPK)
    cand = (v1[..., :, None] + v2[..., None, :]).reshape(T, PEER_HEADS, PEER_TOPK * PEER_TOPK)
    sc, ci = lax.top_k(cand, PEER_TOPK)
    idx = (jnp.take_along_axis(i1, ci // PEER_TOPK, axis=-1) * PEER_N_KEYS
           + jnp.take_along_axis(i2, ci % PEER_TOPK, axis=-1))
    gates = jax.nn.softmax(sc, axis=-1).astype(h.dtype)

    nblk = T // PEER_TOKEN_BLOCK
    hb = ht.reshape(nblk, PEER_TOKEN_BLOCK, D)
    ib = idx.reshape(nblk, PEER_TOKEN_BLOCK, PEER_HEADS, PEER_TOPK)
    gb = gates.reshape(nblk, PEER_TOKEN_BLOCK, PEER_HEADS, PEER_TOPK)

    def experts(args):
        xb, ids, g = args
        u_sel = U[ids]
        a = jnp.einsum('chkd,cd->chk', u_sel, xb)
        w = jax.nn.gelu(a, approximate=False) * g
        return jnp.einsum('chk,chkd->cd', w, V[ids])

    out = lax.map(experts, (hb, ib, gb))
    return out.reshape(B, S, D)


def setup_inputs(seed: int = 0) -> dict:
    key = jax.random.key(seed)
    ks = jax.random.split(key, 26)
    nrm = lambda k, shape, s: jax.random.normal(k, shape, jnp.float32) * s
    gain = lambda k, shape: 1.0 + 0.02 * jax.random.normal(k, shape, jnp.float32)
    L = DEPTH
    positions = (jnp.arange(SEQ, dtype=jnp.int32)[None, :]
                 + jax.random.randint(ks[2], (BATCH, 1), 0, 1024, dtype=jnp.int32))
    return {
        "x": nrm(ks[0], (BATCH, SEQ, D_MODEL), 1.0),
        "c": nrm(ks[1], (BATCH, D_MODEL), 1.0),
        "positions": positions,
        "w_ada": nrm(ks[3], (L, D_MODEL, N_MOD * D_MODEL), 0.5 * D_MODEL ** -0.5),
        "b_ada": nrm(ks[4], (L, N_MOD * D_MODEL), 0.02),
        "g_norm1": gain(ks[5], (L, D_MODEL)),
        "w_in": nrm(ks[6], (L, D_MODEL, IN_COLS), D_MODEL ** -0.5),
        "g_q_a": gain(ks[7], (L, Q_LORA_RANK)),
        "w_uq": nrm(ks[8], (L, Q_LORA_RANK, MLA_HEADS * QK_HEAD_DIM), Q_LORA_RANK ** -0.5),
        "g_kv_a": gain(ks[9], (L, KV_LORA_RANK)),
        "w_ukv": nrm(ks[10], (L, KV_LORA_RANK, MLA_HEADS * (QK_NOPE_DIM + V_HEAD_DIM)), KV_LORA_RANK ** -0.5),
        "g_sg": gain(ks[11], (L, SG_WIDTH)),
        "w_sg": nrm(ks[12], (L, SG_HEADS, SG_CHUNK, SG_CHUNK), SG_CHUNK ** -0.5),
        "b_sg": 1.0 + nrm(ks[13], (L, SG_HEADS, SG_CHUNK), 0.1),
        "g_attn_out": gain(ks[14], (L, MLA_WIDTH)),
        "g_sg_out": gain(ks[15], (L, SG_WIDTH)),
        "w_o": nrm(ks[16], (L, D_MIX, D_MODEL), D_MIX ** -0.5),
        "g_norm2": gain(ks[17], (L, D_MODEL)),
        "w_peer_q": nrm(ks[18], (L, D_MODEL, PEER_HEADS * PEER_QUERY_DIM), D_MODEL ** -0.5),
        "peer_keys": nrm(ks[19], (L, PEER_HEADS, 2, PEER_N_KEYS, PEER_HALF_DIM), PEER_HALF_DIM ** -0.5),
        "peer_u": nrm(ks[20], (L, PEER_N_EXPERTS, D_MODEL), D_MODEL ** -0.5),
        "peer_v": nrm(ks[21], (L, PEER_N_EXPERTS, D_MODEL), PEER_HEADS ** -0.5),
        "g_final": gain(ks[22], (D_MODEL,)),
    }


def reference(x, c, positions, w_ada, b_ada, g_norm1, w_in, g_q_a, w_uq, g_kv_a, w_ukv,
              g_sg, w_sg, b_sg, g_attn_out, g_sg_out, w_o, g_norm2, w_peer_q, peer_keys,
              peer_u, peer_v, g_final):
    cos, sin = rope_tables(positions, x.dtype)
    c_act = jax.nn.silu(c)
    o1 = Q_LORA_RANK
    o2 = o1 + KV_LORA_RANK
    o3 = o2 + QK_ROPE_DIM
    o4 = o3 + SG_WIDTH
    for l in range(DEPTH):
        mod = c_act @ w_ada[l] + b_ada[l]
        shift1, scale1, gate1, shift2, scale2, gate2 = jnp.split(mod, N_MOD, axis=-1)
        h = modulate(rmsnorm(x, g_norm1[l]), shift1, scale1)
        z = h @ w_in[l]
        y_attn = mla_group(z[..., :o1], z[..., o1:o2], z[..., o2:o3], cos, sin,
                           g_q_a[l], w_uq[l], g_kv_a[l], w_ukv[l])
        y_sg = sgu_group(z[..., o3:o4], z[..., o4:], g_sg[l], w_sg[l], b_sg[l])
        y = jnp.concatenate([rmsnorm(y_attn, g_attn_out[l]), rmsnorm(y_sg, g_sg_out[l])], axis=-1)
        x = x + gate1[:, None, :] * (y @ w_o[l])
        h2 = modulate(rmsnorm(x, g_norm2[l]), shift2, scale2)
        x = x + gate2[:, None, :] * peer(h2, w_peer_q[l], peer_keys[l], peer_u[l], peer_v[l])
    return rmsnorm(x, g_final)
```

```cpp
#include <hip/hip_runtime.h>
#include <stdint.h>
#include <stdio.h>

#define N_LAUNCH_MODE 0

typedef unsigned short u16;
typedef __attribute__((ext_vector_type(8))) short bf16x8;
typedef __attribute__((ext_vector_type(4))) short s16x4;
typedef __attribute__((ext_vector_type(16))) float f32x16;
typedef __attribute__((ext_vector_type(4))) unsigned u32x4;

constexpr int T = 16384, DM = 1024, SEQ = 4096;
constexpr float EPS = 1e-6f;

constexpr size_t WS_BAR  = 0;
constexpr size_t WS_MODP = 16384;
constexpr size_t WS_MOD  = WS_MODP + 786432;
constexpr size_t WS_CS   = WS_MOD + 98304;
constexpr size_t WS_WIN  = WS_CS + 4194304;
constexpr size_t WS_WQ2  = WS_WIN + 3145728;
constexpr size_t WS_WUV  = WS_WQ2 + 393216;
constexpr size_t WS_WO   = WS_WUV + 131072;
constexpr size_t WS_WPQ  = WS_WO + 2097152;
constexpr size_t WS_KEYS = WS_WPQ + 4194304;
constexpr size_t WS_WSG  = WS_KEYS + 524288;
constexpr size_t WS_UB   = WS_WSG + 131072;
constexpr size_t WS_VB   = WS_UB + 33554432;
constexpr size_t WS_H    = WS_VB + 33554432;
constexpr size_t WS_Y    = WS_H + 33554432;
constexpr size_t WS_KV   = WS_Y + 33554432;
constexpr size_t WS_TOPK = WS_KV + 6291456;
constexpr size_t WS_SSQ  = WS_TOPK + 16777216;
constexpr size_t WS_SSQV = WS_SSQ + 262144;
constexpr size_t WS_R1   = WS_SSQV + 131072;
constexpr size_t WS_Q    = WS_R1;
constexpr size_t WS_QA   = WS_Q + 25165824;
constexpr size_t WS_UACT = WS_QA + 8388608;
constexpr size_t WS_GVT  = WS_UACT + 16777216;
constexpr size_t WS_X1   = WS_R1;
constexpr size_t WS_END  = WS_R1 + 67108864;

constexpr int LDS_BYTES = 147456;
constexpr int LDS_DATA  = 64;

struct Args {
  const float *x, *c; const int* pos;
  const float *w_ada, *b_ada, *g_norm1, *w_in, *g_q_a, *w_uq, *g_kv_a, *w_ukv, *g_sg, *w_sg, *b_sg, *g_attn_out, *g_sg_out,
              *w_o, *g_norm2, *w_peer_q, *peer_keys, *peer_u, *peer_v, *g_final;
  float* out; unsigned char* ws; int ph_lo, ph_hi;
};

#define XB_TMO      128
#define XB_XCNT(j)  (256  + 64 * (j))
#define XB_XSUB(j)  (1280 + 64 * (j))
#define XB_XGEN(j)  (2304 + 64 * (j))
#define XB_TOP      3328
#define XB_TOPGEN   3392
#define XCD_BAR_WORDS 3456
#define XB_SPIN_CAP (1u << 18)
#define LAS __attribute__((address_space(3)))

__device__ __forceinline__ unsigned xb_ld(unsigned* p)              { return __hip_atomic_load(p, __ATOMIC_RELAXED, __HIP_MEMORY_SCOPE_AGENT); }
__device__ __forceinline__ unsigned xb_add(unsigned* p, unsigned v) { return __hip_atomic_fetch_add(p, v, __ATOMIC_RELAXED, __HIP_MEMORY_SCOPE_AGENT); }
__device__ __forceinline__ unsigned xb_xcc_id() { return (unsigned)__builtin_amdgcn_s_getreg((3 << 11) | 20) & 0xFu; }
#define XB_SPIN(cond, bar) do { unsigned _sp = 0; while (cond) { __builtin_amdgcn_s_sleep(1); \
    if ((++_sp & 255u) == 0u) { if (xb_ld(&(bar)[XB_TMO])) break; if (_sp > XB_SPIN_CAP) { atomicAdd(&(bar)[XB_TMO], 1u); break; } } } } while (0)

struct XcdBarrier { unsigned* bar; unsigned x; volatile LAS unsigned* st; };

__device__ __forceinline__ XcdBarrier xcd_barrier_post(unsigned* bar, volatile LAS unsigned* st) {
    XcdBarrier b; b.bar = bar; b.x = xb_xcc_id(); b.st = st;
    if (threadIdx.x == 0) (void)xb_add(&bar[XB_XCNT(b.x)], 1u);
    return b;
}
__device__ __forceinline__ void xcd_barrier_complete(unsigned* bar, unsigned x, unsigned& nloc, unsigned& nx) {
    const unsigned G = gridDim.x * gridDim.y * gridDim.z;
    unsigned sum, cnt, mine, sp = 0u;
    for (;;) {
        sum = 0u; cnt = 0u; mine = 0u;
#pragma unroll
        for (unsigned j = 0; j < 16; ++j) { const unsigned c = xb_ld(&bar[XB_XCNT(j)]); sum += c; cnt += (c > 0u) ? 1u : 0u; mine = (j == x) ? c : mine; }
        if (sum == G) break;
        __builtin_amdgcn_s_sleep(1);
        if ((++sp & 255u) == 0u) { if (xb_ld(&bar[XB_TMO])) break; if (sp > XB_SPIN_CAP) { atomicAdd(&bar[XB_TMO], 1u); break; } }
    }
    nloc = mine > 0u ? mine : 1u; nx = cnt > 0u ? cnt : 1u;
}
__device__ __forceinline__ void xcd_barrier(const XcdBarrier& b) {
    asm volatile("s_waitcnt vmcnt(0)" ::: "memory");
    __syncthreads();
    if (threadIdx.x == 0) {
        unsigned* bar = b.bar;
        __builtin_amdgcn_s_waitcnt(0);
        unsigned nloc = b.st[0], nx = b.st[1];
        if (nloc == 0u) { xcd_barrier_complete(bar, b.x, nloc, nx); b.st[0] = nloc; b.st[1] = nx; }
        const unsigned old = xb_add(&bar[XB_XSUB(b.x)], 1u);
        const unsigned gen = old / nloc;
        if (old + 1u == (gen + 1u) * nloc) {
            __builtin_amdgcn_fence(__ATOMIC_RELEASE, "agent");
            asm volatile("s_waitcnt vmcnt(0)" ::: "memory");
            const unsigned og = xb_add(&bar[XB_TOP], 1u);
            const unsigned tg = og / nx;
            if (og + 1u == (tg + 1u) * nx) xb_add(&bar[XB_TOPGEN], 1u);
            else XB_SPIN(xb_ld(&bar[XB_TOPGEN]) == tg, bar);
            __builtin_amdgcn_fence(__ATOMIC_ACQUIRE, "agent");
            xb_add(&bar[XB_XGEN(b.x)], 1u);
            asm volatile("s_waitcnt vmcnt(0)" ::: "memory");
        } else {
            XB_SPIN(xb_ld(&bar[XB_XGEN(b.x)]) == gen, bar);
            __builtin_amdgcn_fence(__ATOMIC_ACQUIRE, "agent");
            asm volatile("s_waitcnt vmcnt(0)" ::: "memory");
        }
    }
    __syncthreads();
}

__device__ __forceinline__ unsigned pack2(float lo, float hi) {
  typedef __attribute__((ext_vector_type(2))) float f2; typedef __attribute__((ext_vector_type(2))) __bf16 b2;
  f2 v = {lo, hi}; b2 r = __builtin_convertvector(v, b2); return __builtin_bit_cast(unsigned, r);
}
__device__ __forceinline__ u16 f2bf(float f) { return (u16)(pack2(f, 0.f) & 0xFFFFu); }
__device__ __forceinline__ float bflo(unsigned w) { return __uint_as_float(w << 16); }
__device__ __forceinline__ float bfhi(unsigned w) { return __uint_as_float(w & 0xFFFF0000u); }
__device__ __forceinline__ float gelu_exact(float x) { return 0.5f * x * (1.f + erff(x * 0.70710678118654752f)); }
__device__ __forceinline__ float wave_sum(float v) {
#pragma unroll
  for (int o = 32; o > 0; o >>= 1) v += __shfl_xor(v, o, 64);
  return v;
}
__device__ __forceinline__ int crow(int r, int hi) { return (r & 3) + 8 * (r >> 2) + 4 * hi; }
#define MFMA32(a, b, c) __builtin_amdgcn_mfma_f32_32x32x16_bf16((a), (b), (c), 0, 0, 0)

template <int MAP> __device__ __forceinline__ int colmap(int n) {
  if (MAP == 0) return n;
  if (MAP == 1) return n < 448 ? n : (n < 512 ? -1 : n - 64);
  if (MAP == 2) return (n >> 6) * 192 + 128 + (n & 63);
  return (n >> 7) * 256 + 128 + (n & 127);
}
template <int MAP> __device__ void cvt_transpose(const float* __restrict__ src, int src_ld, int K, int N, u16* __restrict__ dst, int gtid, int gthreads) {
  const int total = N * (K >> 3);
  for (int idx = gtid; idx < total; idx += gthreads) {
    const int n = idx % N, k8 = idx / N, sc = colmap<MAP>(n);
    float v[8];
#pragma unroll
    for (int j = 0; j < 8; ++j) v[j] = sc < 0 ? 0.f : src[(size_t)(k8 * 8 + j) * src_ld + sc];
    u32x4 w = {pack2(v[0], v[1]), pack2(v[2], v[3]), pack2(v[4], v[5]), pack2(v[6], v[7])};
    *(u32x4*)(dst + (size_t)n * K + k8 * 8) = w;
  }
}
__device__ void cvt_direct(const float* __restrict__ src, u16* __restrict__ dst, size_t n8, int gtid, int gthreads) {
  for (size_t i = gtid; i < n8; i += gthreads) {
    const float4 a = *(const float4*)(src + i * 8), b = *(const float4*)(src + i * 8 + 4);
    u32x4 w = {pack2(a.x, a.y), pack2(a.z, a.w), pack2(b.x, b.y), pack2(b.z, b.w)};
    *(u32x4*)(dst + i * 8) = w;
  }
}
__device__ __forceinline__ void sincos_acc(float angf, float& sn, float& cs) {
  const double a = (double)angf;
  const double q = __builtin_rint(a * 0.63661977236758134308);
  double r = __builtin_fma(-q, 1.5707963267948966, a);
  r = __builtin_fma(-q, 6.123233995736766e-17, r);
  const double r2 = r * r;
  double s = r2 * (1.0 / 6227020800.0) - 1.0 / 39916800.0;
  s = s * r2 + 1.0 / 362880.0; s = s * r2 - 1.0 / 5040.0; s = s * r2 + 1.0 / 120.0; s = s * r2 - 1.0 / 6.0; s = r + r * r2 * s;
  double c = -r2 * (1.0 / 87178291200.0) + 1.0 / 479001600.0;
  c = c * r2 - 1.0 / 3628800.0; c = c * r2 + 1.0 / 40320.0; c = c * r2 - 1.0 / 720.0; c = c * r2 + 1.0 / 24.0; c = c * r2 - 0.5; c = 1.0 + r2 * c;
  const int n = ((int)q) & 3;
  const double ss = (n & 1) ? c : s, cc = (n & 1) ? s : c;
  sn = (float)((n & 2) ? -ss : ss);
  cs = (float)(((n + 1) & 2) ? -cc : cc);
}

__constant__ float INVF[32] = {1.000000000e+00f, 7.498942018e-01f, 5.623413324e-01f, 4.216965139e-01f, 3.162277639e-01f, 2.371373922e-01f, 1.778279394e-01f, 1.333521456e-01f,
  1.000000015e-01f, 7.498941571e-02f, 5.623412877e-02f, 4.216964915e-02f, 3.162277862e-02f, 2.371373586e-02f, 1.778279431e-02f, 1.333521493e-02f,
  9.999999776e-03f, 7.498942316e-03f, 5.623413250e-03f, 4.216964822e-03f, 3.162277862e-03f, 2.371373819e-03f, 1.778279431e-03f, 1.333521446e-03f,
  1.000000047e-03f, 7.498941850e-04f, 5.623413017e-04f, 4.216965463e-04f, 3.162277862e-04f, 2.371373848e-04f, 1.778279402e-04f, 1.333521504e-04f};
__device__ void phase0(const Args& a) {
  unsigned char* ws = a.ws;
  const int tid = threadIdx.x, lane = tid & 63, wv = tid >> 6;
  const int NWV = gridDim.x * 8, gw = blockIdx.x * 8 + wv;
  const int gthreads = gridDim.x * 512, gtid = blockIdx.x * 512 + tid;
  float* modp = (float*)(ws + WS_MODP);
  for (int job = gw; job < 768; job += NWV) {
    const int cg = job % 96, ks = job / 96, col = cg * 64 + lane;
    float a0 = 0.f, a1 = 0.f, a2 = 0.f, a3 = 0.f;
    const float* w = a.w_ada + (size_t)(ks * 128) * 6144 + col;
#pragma unroll 8
    for (int k = 0; k < 128; ++k) {
      const float wv_ = w[(size_t)k * 6144];
      const int kk = ks * 128 + k;
      const float c0 = a.c[kk], c1 = a.c[1024 + kk], c2 = a.c[2048 + kk], c3 = a.c[3072 + kk];
      a0 += (c0 / (1.f + __expf(-c0))) * wv_; a1 += (c1 / (1.f + __expf(-c1))) * wv_;
      a2 += (c2 / (1.f + __expf(-c2))) * wv_; a3 += (c3 / (1.f + __expf(-c3))) * wv_;
    }
    modp[(ks * 4 + 0) * 6144 + col] = a0; modp[(ks * 4 + 1) * 6144 + col] = a1;
    modp[(ks * 4 + 2) * 6144 + col] = a2; modp[(ks * 4 + 3) * 6144 + col] = a3;
  }
  cvt_transpose<1>(a.w_in, 1472, 1024, 1536, (u16*)(ws + WS_WIN), gtid, gthreads);
  cvt_transpose<0>(a.w_o, 1024, 1024, 1024, (u16*)(ws + WS_WO), gtid, gthreads);
  cvt_transpose<0>(a.w_peer_q, 2048, 1024, 2048, (u16*)(ws + WS_WPQ), gtid, gthreads);
  cvt_transpose<2>(a.w_uq, 768, 256, 256, (u16*)(ws + WS_WQ2) + 512 * 256, gtid, gthreads);
  cvt_transpose<3>(a.w_ukv, 1024, 128, 512, (u16*)(ws + WS_WUV), gtid, gthreads);
  {
    u16* wq2 = (u16*)(ws + WS_WQ2);
    for (int idx = gtid; idx < 512 * 256; idx += gthreads) {
      const int n = idx >> 8, i = idx & 255, h = n >> 7, cc = n & 127;
      const float* pu = a.w_uq + (size_t)i * 768 + h * 192;
      const float* pk = a.w_ukv + (size_t)cc * 1024 + h * 256;
      float s = 0.f;
#pragma unroll 8
      for (int d = 0; d < 128; d += 4) {
        const float4 u = *(const float4*)(pu + d), k = *(const float4*)(pk + d);
        s += u.x * k.x + u.y * k.y + u.z * k.z + u.w * k.w;
      }
      wq2[(size_t)n * 256 + i] = f2bf(s);
    }
  }
  cvt_direct(a.peer_keys, (u16*)(ws + WS_KEYS), 262144 / 8, gtid, gthreads);
  cvt_direct(a.w_sg, (u16*)(ws + WS_WSG), 65536 / 8, gtid, gthreads);
  cvt_direct(a.peer_u, (u16*)(ws + WS_UB), (size_t)16384 * 1024 / 8, gtid, gthreads);
  cvt_direct(a.peer_v, (u16*)(ws + WS_VB), (size_t)16384 * 1024 / 8, gtid, gthreads);
  {
    float* cs = (float*)(ws + WS_CS);
    for (int idx = gtid; idx < T * 32; idx += gthreads) {
      const int t = idx >> 5, i = idx & 31;
      const float inv = INVF[i];
      const float ang = (float)a.pos[t] * inv;
      float sn, c_; sincos_acc(ang, sn, c_);
      cs[(size_t)t * 64 + i] = c_; cs[(size_t)t * 64 + 32 + i] = sn;
    }
  }
}

__device__ void phase1(const Args& a, char* lds) {
  unsigned char* ws = a.ws;
  const int tid = threadIdx.x, lane = tid & 63, wv = tid >> 6;
  const float* modp = (const float*)(ws + WS_MODP);
  float* mod = (float*)(ws + WS_MOD);
  for (int idx = blockIdx.x * 512 + tid; idx < 4 * 6144; idx += gridDim.x * 512) {
    const int b = idx / 6144, m = idx % 6144;
    float s = a.b_ada[m];
#pragma unroll
    for (int ks = 0; ks < 8; ++ks) s += modp[(ks * 4 + b) * 6144 + m];
    mod[idx] = s;
  }
  float* sh = (float*)(lds + LDS_DATA);
  u16* H = (u16*)(ws + WS_H);
  for (int u = blockIdx.x; u < T / 64; u += gridDim.x) {
    const int b = u >> 6;
    __syncthreads();
    for (int j = tid; j < 2048; j += 512) {
      float s = a.b_ada[j];
#pragma unroll
      for (int ks = 0; ks < 8; ++ks) s += modp[(ks * 4 + b) * 6144 + j];
      sh[j] = s;
    }
    __syncthreads();
    for (int i = 0; i < 8; ++i) {
      const int r = u * 64 + wv * 8 + i;
      float4 xv[4]; float ssq = 0.f;
#pragma unroll
      for (int j = 0; j < 4; ++j) { xv[j] = *(const float4*)(a.x + (size_t)r * 1024 + j * 256 + lane * 4); ssq += xv[j].x * xv[j].x + xv[j].y * xv[j].y + xv[j].z * xv[j].z + xv[j].w * xv[j].w; }
      ssq = wave_sum(ssq);
      const float rstd = rsqrtf(ssq * (1.f / 1024.f) + EPS);
#pragma unroll
      for (int j = 0; j < 4; ++j) {
        const int col = j * 256 + lane * 4;
        const float4 g = *(const float4*)(a.g_norm1 + col);
        const float h0 = xv[j].x * rstd * g.x * (1.f + sh[1024 + col]) + sh[col];
        const float h1 = xv[j].y * rstd * g.y * (1.f + sh[1024 + col + 1]) + sh[col + 1];
        const float h2 = xv[j].z * rstd * g.z * (1.f + sh[1024 + col + 2]) + sh[col + 2];
        const float h3 = xv[j].w * rstd * g.w * (1.f + sh[1024 + col + 3]) + sh[col + 3];
        uint2 o = {pack2(h0, h1), pack2(h2, h3)};
        *(uint2*)(H + (size_t)r * 1024 + col) = o;
      }
    }
  }
}

constexpr int G_STAGE = 49152;
__device__ __forceinline__ void gemm_128x256(const u16* __restrict__ A, int lda, const u16* __restrict__ Bt, int ldb, int KT,
                                             f32x16 (&acc)[2][2], char* lds) {
  const int tid = threadIdx.x, lane = tid & 63, wv = tid >> 6, r32 = lane & 31, hi = lane >> 5;
  const int wm = wv >> 2, wn = wv & 3;
  const int srow = tid >> 3, sc = tid & 7;
  const u16* pa = A + (size_t)srow * lda + sc * 8;
  const u16* pb = Bt + (size_t)srow * ldb + sc * 8;
  const int swo = srow * 128 + ((sc ^ ((srow >> 1) & 7)) << 4);
  u32x4 ra[2], rb[4];
#pragma unroll
  for (int m = 0; m < 2; ++m)
#pragma unroll
    for (int n = 0; n < 2; ++n)
#pragma unroll
      for (int r = 0; r < 16; ++r) acc[m][n][r] = 0.f;
#pragma unroll
  for (int i = 0; i < 2; ++i) ra[i] = *(const u32x4*)(pa + (size_t)(64 * i) * lda);
#pragma unroll
  for (int i = 0; i < 4; ++i) rb[i] = *(const u32x4*)(pb + (size_t)(64 * i) * ldb);
  __syncthreads();
#pragma unroll
  for (int i = 0; i < 2; ++i) *(u32x4*)(lds + swo + 8192 * i) = ra[i];
#pragma unroll
  for (int i = 0; i < 4; ++i) *(u32x4*)(lds + 16384 + swo + 8192 * i) = rb[i];
  __syncthreads();
  const int xa = (r32 >> 1) & 7;
  const int aoff = (64 * wm + r32) * 128, boff = 16384 + (64 * wn + r32) * 128;
  for (int kt = 0; kt < KT; ++kt) {
    const char* buf = lds + (kt & 1) * G_STAGE;
    if (kt + 1 < KT) {
#pragma unroll
      for (int i = 0; i < 2; ++i) ra[i] = *(const u32x4*)(pa + (size_t)(64 * i) * lda + (kt + 1) * 64);
#pragma unroll
      for (int i = 0; i < 4; ++i) rb[i] = *(const u32x4*)(pb + (size_t)(64 * i) * ldb + (kt + 1) * 64);
    }
#pragma unroll
    for (int s = 0; s < 4; ++s) {
      const int cb = ((2 * s + hi) ^ xa) << 4;
      const bf16x8 a0 = *(const bf16x8*)(buf + aoff + cb), a1 = *(const bf16x8*)(buf + aoff + 4096 + cb);
      const bf16x8 b0 = *(const bf16x8*)(buf + boff + cb), b1 = *(const bf16x8*)(buf + boff + 4096 + cb);
      acc[0][0] = MFMA32(a0, b0, acc[0][0]); acc[0][1] = MFMA32(a0, b1, acc[0][1]);
      acc[1][0] = MFMA32(a1, b0, acc[1][0]); acc[1][1] = MFMA32(a1, b1, acc[1][1]);
    }
    if (kt + 1 < KT) {
      char* nb = lds + ((kt + 1) & 1) * G_STAGE;
#pragma unroll
      for (int i = 0; i < 2; ++i) *(u32x4*)(nb + swo + 8192 * i) = ra[i];
#pragma unroll
      for (int i = 0; i < 4; ++i) *(u32x4*)(nb + 16384 + swo + 8192 * i) = rb[i];
    }
    __syncthreads();
  }
}
constexpr int CLD = 257;
__device__ __forceinline__ void acc_to_lds(const f32x16 (&acc)[2][2], float* Cl) {
  const int lane = threadIdx.x & 63, wv = threadIdx.x >> 6, r32 = lane & 31, hi = lane >> 5, wm = wv >> 2, wn = wv & 3;
#pragma unroll
  for (int m = 0; m < 2; ++m)
#pragma unroll
    for (int n = 0; n < 2; ++n)
#pragma unroll
      for (int r = 0; r < 16; ++r) Cl[(64 * wm + 32 * m + crow(r, hi)) * CLD + 64 * wn + 32 * n + r32] = acc[m][n][r];
}

__device__ void phase2(const Args& a, char* lds) {
  unsigned char* ws = a.ws;
  const int tid = threadIdx.x, lane = tid & 63, wv = tid >> 6;
  const u16* H = (const u16*)(ws + WS_H); const u16* WIN = (const u16*)(ws + WS_WIN);
  u16* QA = (u16*)(ws + WS_QA); u16* KV = (u16*)(ws + WS_KV); u16* UACT = (u16*)(ws + WS_UACT); u16* GVT = (u16*)(ws + WS_GVT);
  float* SSQV = (float*)(ws + WS_SSQV); const float* CS = (const float*)(ws + WS_CS);
  char* gl = lds + LDS_DATA; float* Cl = (float*)gl;
  for (int u = blockIdx.x; u < 128 * 6; u += gridDim.x) {
    const int mt = u / 6, nt = u % 6, R0 = mt * 128;
    f32x16 acc[2][2];
    gemm_128x256(H + (size_t)R0 * 1024, 1024, WIN + (size_t)(nt * 256) * 1024, 1024, 16, acc, gl);
    acc_to_lds(acc, Cl);
    __syncthreads();
    if (nt == 0) {
      for (int i = 0; i < 16; ++i) {
        const int row = wv * 16 + i; float v[4], ssq = 0.f;
#pragma unroll
        for (int j = 0; j < 4; ++j) { v[j] = Cl[row * CLD + lane + 64 * j]; ssq += v[j] * v[j]; }
        ssq = wave_sum(ssq);
        const float rstd = rsqrtf(ssq * (1.f / 256.f) + EPS);
#pragma unroll
        for (int j = 0; j < 4; ++j) { const int col = lane + 64 * j; QA[(size_t)(R0 + row) * 256 + col] = f2bf(v[j] * rstd * a.g_q_a[col]); }
      }
    } else if (nt == 1) {
      for (int i = 0; i < 16; ++i) {
        const int row = wv * 16 + i, tok = R0 + row;
        const float v0 = Cl[row * CLD + lane], v1 = Cl[row * CLD + 64 + lane];
        const float ssq = wave_sum(v0 * v0 + v1 * v1);
        const float rstd = rsqrtf(ssq * (1.f / 128.f) + EPS);
        KV[(size_t)tok * 192 + lane] = f2bf(v0 * rstd * a.g_kv_a[lane]);
        KV[(size_t)tok * 192 + 64 + lane] = f2bf(v1 * rstd * a.g_kv_a[64 + lane]);
        if (lane < 32) {
          const float x1 = Cl[row * CLD + 128 + lane], x2 = Cl[row * CLD + 160 + lane];
          const float cs = CS[(size_t)tok * 64 + lane], sn = CS[(size_t)tok * 64 + 32 + lane];
          KV[(size_t)tok * 192 + 128 + lane] = f2bf(x1 * cs - x2 * sn);
          KV[(size_t)tok * 192 + 160 + lane] = f2bf(x2 * cs + x1 * sn);
        }
      }
    } else if (nt < 4) {
      for (int i = 0; i < 16; ++i) {
        const int row = wv * 16 + i;
#pragma unroll
        for (int j = 0; j < 4; ++j) { const int col = lane + 64 * j; UACT[(size_t)(R0 + row) * 512 + (nt - 2) * 256 + col] = f2bf(gelu_exact(Cl[row * CLD + col])); }
      }
    } else {
      for (int i = 0; i < 16; ++i) {
        const int row = wv * 16 + i; float ssq = 0.f;
#pragma unroll
        for (int j = 0; j < 4; ++j) { const int col = lane + 64 * j; const float g = gelu_exact(Cl[row * CLD + col]); const float gb = bflo((unsigned)f2bf(g)); ssq += gb * gb; Cl[row * CLD + col] = gb; }
        ssq = wave_sum(ssq);
        if (lane == 0) SSQV[(size_t)(R0 + row) * 2 + (nt - 4)] = ssq;
      }
      __syncthreads();
      for (int i = 0; i < 32; ++i) {
        const int c = wv * 32 + i;
        const float g0 = Cl[(2 * lane) * CLD + c], g1 = Cl[(2 * lane + 1) * CLD + c];
        *(unsigned*)(GVT + ((size_t)mt * 512 + (nt - 4) * 256 + c) * 128 + 2 * lane) = pack2(g0, g1);
      }
    }
    __syncthreads();
  }
}

__device__ void phase3(const Args& a, char* lds) {
  unsigned char* ws = a.ws;
  const int tid = threadIdx.x, lane = tid & 63, wv = tid >> 6, r32 = lane & 31, hi = lane >> 5;
  const u16* QA = (const u16*)(ws + WS_QA); const u16* WQ2 = (const u16*)(ws + WS_WQ2);
  u16* Q = (u16*)(ws + WS_Q); const float* CS = (const float*)(ws + WS_CS);
  const u16* UACT = (const u16*)(ws + WS_UACT); const u16* GVT = (const u16*)(ws + WS_GVT); const u16* WSG = (const u16*)(ws + WS_WSG);
  const float* SSQV = (const float*)(ws + WS_SSQV); u16* Y = (u16*)(ws + WS_Y);
  char* gl = lds + LDS_DATA; float* Cl = (float*)gl;
  for (int u = blockIdx.x; u < 384; u += gridDim.x) {
    {
      const int mt = u / 3, nt = u % 3, R0 = mt * 128;
      f32x16 acc[2][2];
      gemm_128x256(QA + (size_t)R0 * 256, 256, WQ2 + (size_t)(nt * 256) * 256, 256, 4, acc, gl);
      acc_to_lds(acc, Cl);
      __syncthreads();
      if (nt < 2) {
        for (int i = 0; i < 16; ++i) {
          const int row = wv * 16 + i;
#pragma unroll
          for (int j = 0; j < 4; ++j) { const int n = nt * 256 + lane + 64 * j; Q[(size_t)(R0 + row) * 768 + (n >> 7) * 192 + (n & 127)] = f2bf(Cl[row * CLD + lane + 64 * j]); }
        }
      } else {
        for (int i = 0; i < 16; ++i) {
          const int row = wv * 16 + i, tok = R0 + row;
#pragma unroll
          for (int j = 0; j < 2; ++j) {
            const int idx = lane + 64 * j, h = idx >> 5, jj = idx & 31;
            const float x1 = Cl[row * CLD + h * 64 + jj], x2 = Cl[row * CLD + h * 64 + 32 + jj];
            const float cs = CS[(size_t)tok * 64 + jj], sn = CS[(size_t)tok * 64 + 32 + jj];
            Q[(size_t)tok * 768 + h * 192 + 128 + jj] = f2bf(x1 * cs - x2 * sn);
            Q[(size_t)tok * 768 + h * 192 + 160 + jj] = f2bf(x2 * cs + x1 * sn);
          }
        }
      }
      __syncthreads();
    }
  }
  for (int su = blockIdx.x; su < 256; su += gridDim.x) {
    {
      const int c = su >> 1, ph = su & 1;
      float* rs = (float*)gl;
      float* Yl = (float*)(gl + 512);
      __syncthreads();
      if (tid < 128) { const size_t t = (size_t)c * 128 + tid; rs[tid] = rsqrtf((SSQV[t * 2] + SSQV[t * 2 + 1]) * (1.f / 512.f) + EPS); }
      __syncthreads();
      const int h = wv >> 1, dh = wv & 1;
      f32x16 acc[2][2];
#pragma unroll
      for (int m = 0; m < 2; ++m)
#pragma unroll
        for (int n = 0; n < 2; ++n)
#pragma unroll
          for (int r = 0; r < 16; ++r) acc[m][n][r] = 0.f;
      for (int s = 0; s < 8; ++s) {
        const int q0 = 16 * s + 8 * hi;
        bf16x8 af[2], bfr[2];
#pragma unroll
        for (int m = 0; m < 2; ++m) af[m] = *(const bf16x8*)(WSG + ((size_t)h * 128 + ph * 64 + 32 * m + r32) * 128 + q0);
        float rq[8];
#pragma unroll
        for (int j = 0; j < 8; ++j) rq[j] = rs[q0 + j];
#pragma unroll
        for (int n = 0; n < 2; ++n) {
          const u32x4 w = *(const u32x4*)(GVT + ((size_t)c * 512 + h * 128 + dh * 64 + 32 * n + r32) * 128 + q0);
          u32x4 o;
#pragma unroll
          for (int k = 0; k < 4; ++k) o[k] = pack2(bflo(w[k]) * rq[2 * k], bfhi(w[k]) * rq[2 * k + 1]);
          bfr[n] = __builtin_bit_cast(bf16x8, o);
        }
#pragma unroll
        for (int m = 0; m < 2; ++m)
#pragma unroll
          for (int n = 0; n < 2; ++n) acc[m][n] = MFMA32(af[m], bfr[n], acc[m][n]);
      }
#pragma unroll
      for (int m = 0; m < 2; ++m)
#pragma unroll
        for (int n = 0; n < 2; ++n)
#pragma unroll
          for (int r = 0; r < 16; ++r) {
            const int pl = 32 * m + crow(r, hi), col = h * 128 + dh * 64 + 32 * n + r32;
            const size_t tok = (size_t)c * 128 + ph * 64 + pl;
            const float mix = acc[m][n][r] * a.g_sg[col] + a.b_sg[h * 128 + ph * 64 + pl];
            Yl[pl * 513 + col] = bflo((unsigned)UACT[tok * 512 + col]) * mix;
          }
      __syncthreads();
      for (int i = 0; i < 8; ++i) {
        const int pl = wv * 8 + i; const size_t tok = (size_t)c * 128 + ph * 64 + pl;
        float v[8], ssq = 0.f;
#pragma unroll
        for (int j = 0; j < 8; ++j) { v[j] = Yl[pl * 513 + lane + 64 * j]; ssq += v[j] * v[j]; }
        ssq = wave_sum(ssq);
        const float rstd = rsqrtf(ssq * (1.f / 512.f) + EPS);
#pragma unroll
        for (int j = 0; j < 8; ++j) { const int col = lane + 64 * j; Y[tok * 1024 + 512 + col] = f2bf(v[j] * rstd * a.g_sg_out[col]); }
      }
      __syncthreads();
    }
  }
}

constexpr float ATT_SCALE = 0.07216878364870322f;
constexpr float ATT_THR = 8.f;
constexpr int KVBUF = 24576;
#define SBAR() __builtin_amdgcn_sched_barrier(0)
__device__ __forceinline__ unsigned cvtpk(float lo, float hi) { unsigned r; asm volatile("v_cvt_pk_bf16_f32 %0, %1, %2" : "=v"(r) : "v"(lo), "v"(hi)); return r; }
__device__ __forceinline__ unsigned off_a(unsigned row, unsigned ch) { return 2048u * (row >> 3) + 512u * (ch >> 2) + 64u * (row & 7) + 16u * ((ch & 3) ^ ((row >> 2) & 3)); }

__device__ __forceinline__ void partialSM(f32x16& p0, f32x16& p1, float& m_reg, float& mn, float& alpha) {
  constexpr float C = ATT_SCALE * 1.4426950408889634f;
  float pmax = p0[0];
#pragma unroll
  for (int r = 1; r < 16; ++r) pmax = fmaxf(pmax, p0[r]);
#pragma unroll
  for (int r = 0; r < 16; ++r) pmax = fmaxf(pmax, p1[r]);
  { auto rr = __builtin_amdgcn_permlane32_swap(__float_as_uint(pmax), __float_as_uint(pmax), false, false);
    pmax = fmaxf(__uint_as_float(rr[0]), __uint_as_float(rr[1])); }
  if (__builtin_expect(__all(pmax - m_reg <= ATT_THR / ATT_SCALE), 1)) { mn = m_reg; alpha = 1.f; }
  else { mn = fmaxf(m_reg, pmax); alpha = __builtin_amdgcn_exp2f((m_reg - mn) * C); m_reg = mn; }
  const float mnC = -mn * C;
#pragma unroll
  for (int r = 0; r < 16; ++r) p0[r] = fmaf(p0[r], C, mnC);
#pragma unroll
  for (int r = 0; r < 16; ++r) p1[r] = fmaf(p1[r], C, mnC);
#pragma unroll
  for (int r = 0; r < 16; ++r) p0[r] = __builtin_amdgcn_exp2f(p0[r]);
}
__device__ __forceinline__ void finishSM(f32x16& p0, f32x16& p1, float alpha, float& l_reg, bf16x8& pa0, bf16x8& pa1, bf16x8& pa2, bf16x8& pa3) {
#pragma unroll
  for (int r = 0; r < 16; ++r) p1[r] = __builtin_amdgcn_exp2f(p1[r]);
  float ps = 0;
#pragma unroll
  for (int r = 0; r < 16; ++r) ps += p0[r];
#pragma unroll
  for (int r = 0; r < 16; ++r) ps += p1[r];
  { auto rr = __builtin_amdgcn_permlane32_swap(__float_as_uint(ps), __float_as_uint(ps), false, false);
    ps = __uint_as_float(rr[0]) + __uint_as_float(rr[1]); }
  l_reg = l_reg * alpha + ps;
#define PK4(P, BASE, OUT) do { unsigned a0 = cvtpk(P[BASE + 0], P[BASE + 1]), a1 = cvtpk(P[BASE + 2], P[BASE + 3]);   \
    unsigned b0 = cvtpk(P[BASE + 4], P[BASE + 5]), b1 = cvtpk(P[BASE + 6], P[BASE + 7]);                              \
    auto r0 = __builtin_amdgcn_permlane32_swap(a0, b0, false, false); auto r1 = __builtin_amdgcn_permlane32_swap(a1, b1, false, false); \
    u32x4 w = {r0[0], r1[0], r0[1], r1[1]}; OUT = __builtin_bit_cast(bf16x8, w); } while (0)
  PK4(p0, 0, pa0); PK4(p0, 8, pa1); PK4(p1, 0, pa2); PK4(p1, 8, pa3);
#undef PK4
}
__device__ __forceinline__ void qkt192(f32x16& p0, f32x16& p1, const char* kb, const bf16x8* qr, int ke, int ko, int kr) {
#pragma unroll
  for (int r = 0; r < 16; ++r) { p0[r] = 0.f; p1[r] = 0.f; }
#pragma unroll
  for (int d0 = 0; d0 < 8; ++d0) {
    const int o = ((d0 & 1) ? ko : ke) + 512 * (d0 >> 1);
    const bf16x8 b0 = *(const bf16x8*)(kb + o), b1 = *(const bf16x8*)(kb + o + 8192);
    p0 = MFMA32(b0, qr[d0], p0); p1 = MFMA32(b1, qr[d0], p1);
  }
#pragma unroll
  for (int d1 = 0; d1 < 4; ++d1) {
    const int o = 16384 + (kr ^ (32 * d1));
    const bf16x8 b0 = *(const bf16x8*)(kb + o), b1 = *(const bf16x8*)(kb + o + 4096);
    p0 = MFMA32(b0, qr[8 + d1], p0); p1 = MFMA32(b1, qr[8 + d1], p1);
  }
}
template <int OFF> __device__ __forceinline__ s16x4 tr_read(int vb) {
  s16x4 r; asm volatile("ds_read_b64_tr_b16 %0, %1 offset:%2" : "=&v"(r) : "v"(vb), "i"(OFF) : "memory"); return r;
}
template <int C> __device__ __forceinline__ void pv_one(f32x16& od, int vb0, int vb1, bf16x8 pa0, bf16x8 pa1, bf16x8 pa2, bf16x8 pa3) {
  const s16x4 l0 = tr_read<512 * C>(vb0), h0 = tr_read<512 * C>(vb1), l1 = tr_read<4096 + 512 * C>(vb0), h1 = tr_read<4096 + 512 * C>(vb1);
  const s16x4 l2 = tr_read<8192 + 512 * C>(vb0), h2 = tr_read<8192 + 512 * C>(vb1), l3 = tr_read<12288 + 512 * C>(vb0), h3 = tr_read<12288 + 512 * C>(vb1);
  asm volatile("s_waitcnt lgkmcnt(0)" ::: "memory"); SBAR();
#define PKV(L, H) (bf16x8){L[0], L[1], L[2], L[3], H[0], H[1], H[2], H[3]}
  od = MFMA32(pa0, PKV(l0, h0), od); od = MFMA32(pa1, PKV(l1, h1), od);
  od = MFMA32(pa2, PKV(l2, h2), od); od = MFMA32(pa3, PKV(l3, h3), od);
#undef PKV
}
__device__ __forceinline__ void pv_all(f32x16* o, int vb0, int vb1, bf16x8 pa0, bf16x8 pa1, bf16x8 pa2, bf16x8 pa3) {
  pv_one<0>(o[0], vb0, vb1, pa0, pa1, pa2, pa3); pv_one<1>(o[1], vb0, vb1, pa0, pa1, pa2, pa3);
  pv_one<2>(o[2], vb0, vb1, pa0, pa1, pa2, pa3); pv_one<3>(o[3], vb0, vb1, pa0, pa1, pa2, pa3);
}

__device__ void phase4(const Args& a, char* lds) {
  unsigned char* ws = a.ws;
  const int tid = threadIdx.x, wid = tid >> 6, lane = tid & 63, r32 = lane & 31, hi = lane >> 5;
  const u16* Qg = (const u16*)(ws + WS_Q); const u16* KVg = (const u16*)(ws + WS_KV); const u16* WUV = (const u16*)(ws + WS_WUV);
  u16* Y = (u16*)(ws + WS_Y);
  char* gl = lds + LDS_DATA;
  char* kvl = gl;
  float* wsl = (float*)(gl + 2 * KVBUF) + wid * 64; float* li_l = wsl; float* al_l = wsl + 32;
  char* Ol = gl + 2 * KVBUF + 2048 + wid * 8704;
  float* Yl = (float*)gl;
  const int head = wid >> 1, qh = wid & 1;
  int sdst[3];
#pragma unroll
  for (int j = 0; j < 3; ++j) { const int id = tid + 512 * j, key = id / 24, ch = id % 24;
    sdst[j] = ch < 16 ? (int)off_a(key, ch) : 16384 + key * 128 + (((ch - 16) ^ ((key >> 1) & 7)) << 4); }
  const int xq = (r32 >> 2) & 3;
  const int ke = 2048 * (r32 >> 3) + 64 * (r32 & 7) + 16 * (hi ^ xq), ko = 2048 * (r32 >> 3) + 64 * (r32 & 7) + 16 * ((2 + hi) ^ xq);
  const int kr = r32 * 128 + ((hi ^ ((r32 >> 1) & 7)) << 4);
  const int tb = lane >> 4 & 1, tq = (lane & 15) >> 2, tp = lane & 3;
  const int vbl = 2048 * hi + 64 * tq + 32 * (tb ^ hi) + 8 * (tp & 1);
  const int lbase = (int)(uintptr_t)kvl;
  const int vb0 = lbase + vbl + 16 * (tp >> 1), vb1 = lbase + vbl + 256 + 16 * ((tp >> 1) ^ 1);
  for (int u = blockIdx.x; u < 256; u += gridDim.x) {
    const int b = u >> 6, qb = u & 63;
    const size_t tok0 = (size_t)b * SEQ + qb * 64 + qh * 32;
    const u16* KVb = KVg + (size_t)b * SEQ * 192;
    float m_reg = -1e30f, l_reg = 0.f; f32x16 o[4]; bf16x8 qr[12];
#pragma unroll
    for (int d = 0; d < 4; ++d)
#pragma unroll
      for (int r = 0; r < 16; ++r) o[d][r] = 0.f;
    { const u16* Qw = Qg + (tok0 + r32) * 768 + head * 192 + hi * 8;
#pragma unroll
      for (int d0 = 0; d0 < 12; ++d0) qr[d0] = *(const bf16x8*)(Qw + d0 * 16); }
    u32x4 st0[3];
#define SLOAD(S, k0) do { const u16* _p = KVb + (size_t)(k0) * 192 + tid * 8; S[0] = *(const u32x4*)_p; S[1] = *(const u32x4*)(_p + 4096); S[2] = *(const u32x4*)(_p + 8192); } while (0)
#define SWRITE(bufi, S) do { char* _d = kvl + (bufi) * KVBUF; *(u32x4*)(_d + sdst[0]) = S[0]; *(u32x4*)(_d + sdst[1]) = S[1]; *(u32x4*)(_d + sdst[2]) = S[2]; } while (0)
#define RESC(al) do { if (__any((al) < 1.f)) { if (hi == 0) al_l[r32] = (al); asm volatile("s_waitcnt lgkmcnt(0)" ::: "memory"); \
    _Pragma("unroll") for (int d = 0; d < 4; ++d) _Pragma("unroll") for (int r = 0; r < 16; ++r) o[d][r] *= al_l[crow(r, hi)]; } } while (0)
    constexpr int NT = SEQ / 64;
    __syncthreads();
    SLOAD(st0, 0); SWRITE(0, st0); SLOAD(st0, 64); __syncthreads();
    for (int j = 0; j < NT; ++j) {
      const int bo = (j & 1) * KVBUF;
      f32x16 p0, p1; float mn, al; bf16x8 pa0, pa1, pa2, pa3;
      qkt192(p0, p1, kvl + bo, qr, ke, ko, kr);
      partialSM(p0, p1, m_reg, mn, al);
      RESC(al);
      finishSM(p0, p1, al, l_reg, pa0, pa1, pa2, pa3);
      if (j + 1 < NT) { SWRITE((j + 1) & 1, st0); if (j + 2 < NT) SLOAD(st0, (j + 2) * 64); }
      SBAR();
      pv_all(o, vb0 + bo, vb1 + bo, pa0, pa1, pa2, pa3);
      __syncthreads();
    }
#undef SLOAD
#undef SWRITE
#undef RESC
    int r32e = r32, hie = hi, lne = lane;
    asm volatile("" : "+v"(r32e), "+v"(hie), "+v"(lne));
    if (hie == 0) li_l[r32e] = l_reg;
    asm volatile("s_waitcnt lgkmcnt(0)" ::: "memory");
#pragma unroll
    for (int r = 0; r < 16; ++r) {
      const int q = crow(r, hie); const float rl = __builtin_amdgcn_rcpf(li_l[q]);
#pragma unroll
      for (int d = 0; d < 4; ++d) *(u16*)(Ol + q * 272 + (32 * d + r32e) * 2) = f2bf(o[d][r] * rl);
    }
    asm volatile("s_waitcnt lgkmcnt(0)" ::: "memory");
    f32x16 y[4];
#pragma unroll
    for (int n = 0; n < 4; ++n)
#pragma unroll
      for (int r = 0; r < 16; ++r) y[n][r] = 0.f;
    const u16* wuv = WUV + ((size_t)head * 128 + r32e) * 128 + 8 * hie;
#pragma unroll 2
    for (int s = 0; s < 8; ++s) {
      const bf16x8 af = *(const bf16x8*)(Ol + r32e * 272 + (16 * s + 8 * hie) * 2);
#pragma unroll
      for (int n = 0; n < 4; ++n) {
        const bf16x8 bw = *(const bf16x8*)(wuv + 32 * n * 128 + 16 * s);
        y[n] = MFMA32(af, bw, y[n]);
      }
    }
    __syncthreads();
#pragma unroll
    for (int n = 0; n < 4; ++n)
#pragma unroll
      for (int r = 0; r < 16; ++r) Yl[(qh * 32 + crow(r, hie)) * 513 + head * 128 + 32 * n + r32e] = y[n][r];
    __syncthreads();
    for (int i = 0; i < 8; ++i) {
      const int pl = wid * 8 + i; const size_t tok = (size_t)b * SEQ + qb * 64 + pl;
      float v[8], ssq = 0.f;
#pragma unroll
      for (int jj = 0; jj < 8; ++jj) { v[jj] = Yl[pl * 513 + lne + 64 * jj]; ssq += v[jj] * v[jj]; }
      ssq = wave_sum(ssq);
      const float rstd = rsqrtf(ssq * (1.f / 512.f) + EPS);
#pragma unroll
      for (int jj = 0; jj < 8; ++jj) { const int col = lne + 64 * jj; Y[tok * 1024 + col] = f2bf(v[jj] * rstd * a.g_attn_out[col]); }
    }
    __syncthreads();
  }
}

__device__ void phase5(const Args& a, char* lds) {
  unsigned char* ws = a.ws;
  const int tid = threadIdx.x, lane = tid & 63, wv = tid >> 6;
  const u16* Y = (const u16*)(ws + WS_Y); const u16* WO = (const u16*)(ws + WS_WO);
  float* X1 = (float*)(ws + WS_X1); float* SSQ = (float*)(ws + WS_SSQ); const float* mod = (const float*)(ws + WS_MOD);
  char* gl = lds + LDS_DATA; float* Cl = (float*)gl;
  for (int u = blockIdx.x; u < 128 * 4; u += gridDim.x) {
    const int mt = u >> 2, nt = u & 3, R0 = mt * 128, b = R0 >> 12;
    f32x16 acc[2][2];
    gemm_128x256(Y + (size_t)R0 * 1024, 1024, WO + (size_t)(nt * 256) * 1024, 1024, 16, acc, gl);
    acc_to_lds(acc, Cl);
    __syncthreads();
    float g1[4];
#pragma unroll
    for (int j = 0; j < 4; ++j) g1[j] = mod[b * 6144 + 2048 + nt * 256 + lane + 64 * j];
    for (int i = 0; i < 16; ++i) {
      const int row = wv * 16 + i; const size_t tok = R0 + row; float ssq = 0.f;
#pragma unroll
      for (int j = 0; j < 4; ++j) {
        const int col = nt * 256 + lane + 64 * j;
        const float v = a.x[tok * 1024 + col] + g1[j] * Cl[row * CLD + lane + 64 * j];
        X1[tok * 1024 + col] = v; ssq += v * v;
      }
      ssq = wave_sum(ssq);
      if (lane == 0) SSQ[tok * 4 + nt] = ssq;
    }
    __syncthreads();
  }
}
__device__ void phase5b(const Args& a) {
  unsigned char* ws = a.ws;
  const int tid = threadIdx.x, lane = tid & 63, wv = tid >> 6;
  const float* X1 = (const float*)(ws + WS_X1); const float* SSQ = (const float*)(ws + WS_SSQ); const float* mod = (const float*)(ws + WS_MOD);
  u16* H = (u16*)(ws + WS_H);
  for (int u = blockIdx.x; u < T / 64; u += gridDim.x) {
    const int b = u >> 6;
    float4 sh[4], sc[4], g[4];
#pragma unroll
    for (int j = 0; j < 4; ++j) {
      const int col = j * 256 + lane * 4;
      sh[j] = *(const float4*)(mod + b * 6144 + 3072 + col); sc[j] = *(const float4*)(mod + b * 6144 + 4096 + col); g[j] = *(const float4*)(a.g_norm2 + col);
    }
    for (int i = 0; i < 8; ++i) {
      const size_t r = (size_t)u * 64 + wv * 8 + i;
      const float4 sq = *(const float4*)(SSQ + r * 4);
      const float rstd = rsqrtf((sq.x + sq.y + sq.z + sq.w) * (1.f / 1024.f) + EPS);
#pragma unroll
      for (int j = 0; j < 4; ++j) {
        const int col = j * 256 + lane * 4;
        const float4 xv = *(const float4*)(X1 + r * 1024 + col);
        const float h0 = xv.x * rstd * g[j].x * (1.f + sc[j].x) + sh[j].x, h1 = xv.y * rstd * g[j].y * (1.f + sc[j].y) + sh[j].y;
        const float h2 = xv.z * rstd * g[j].z * (1.f + sc[j].z) + sh[j].z, h3 = xv.w * rstd * g[j].w * (1.f + sc[j].w) + sh[j].w;
        uint2 o = {pack2(h0, h1), pack2(h2, h3)};
        *(uint2*)(H + r * 1024 + col) = o;
      }
    }
  }
}

__device__ __forceinline__ float vmaxf(float a, float b) { float r; asm("v_max_f32 %0, %1, %2" : "=v"(r) : "v"(a), "v"(b)); return r; }
__device__ __forceinline__ float vminf(float a, float b) { float r; asm("v_min_f32 %0, %1, %2" : "=v"(r) : "v"(a), "v"(b)); return r; }
#define TOP_INSERT(t, v) do { float _v = (v); _Pragma("unroll") for (int _i = 0; _i < 16; ++_i) { const float _h = vmaxf(t[_i], _v); _v = vminf(t[_i], _v); t[_i] = _h; } } while (0)

__device__ void phase6(const Args& a, char* lds) {
  unsigned char* ws = a.ws;
  const int tid = threadIdx.x, lane = tid & 63, wv = tid >> 6, r32 = lane & 31, hi = lane >> 5;
  const u16* H = (const u16*)(ws + WS_H); const u16* WPQ = (const u16*)(ws + WS_WPQ); const u16* KEYS = (const u16*)(ws + WS_KEYS);
  uint2* TOPK = (uint2*)(ws + WS_TOPK);
  char* gl = lds + LDS_DATA;
  char* Ql = gl;
  float* TK = (float*)(gl + 67584);
  for (int u = blockIdx.x; u < 128 * 8; u += gridDim.x) {
    const int mt = u >> 3, hd = u & 7, R0 = mt * 128;
    f32x16 acc[2][2];
    gemm_128x256(H + (size_t)R0 * 1024, 1024, WPQ + (size_t)(hd * 256) * 1024, 1024, 16, acc, gl);
    { const int wm = wv >> 2, wn = wv & 3;
#pragma unroll
      for (int m = 0; m < 2; ++m)
#pragma unroll
        for (int n = 0; n < 2; ++n)
#pragma unroll
          for (int r = 0; r < 16; ++r) *(u16*)(Ql + (64 * wm + 32 * m + crow(r, hi)) * 528 + (64 * wn + 32 * n + r32) * 2) = f2bf(acc[m][n][r]); }
    __syncthreads();
    {
      const int half = wv & 1, tb = wv >> 1;
      f32x16 sc[4];
#pragma unroll
      for (int k = 0; k < 4; ++k)
#pragma unroll
        for (int r = 0; r < 16; ++r) sc[k][r] = 0.f;
#pragma unroll
      for (int s = 0; s < 8; ++s) {
        const bf16x8 bq = *(const bf16x8*)(Ql + (32 * tb + r32) * 528 + (half * 128 + 16 * s + 8 * hi) * 2);
#pragma unroll
        for (int k = 0; k < 4; ++k) {
          const bf16x8 ak = *(const bf16x8*)(KEYS + ((size_t)(hd * 2 + half) * 128 + 32 * k + r32) * 128 + 16 * s + 8 * hi);
          sc[k] = MFMA32(ak, bq, sc[k]);
        }
      }
      float t[16];
#pragma unroll
      for (int i = 0; i < 16; ++i) t[i] = __uint_as_float(0xff800000u);
#pragma unroll
      for (int k = 0; k < 4; ++k)
#pragma unroll
        for (int r = 0; r < 16; ++r) {
          const unsigned key = 32 * k + crow(r, hi);
          TOP_INSERT(t, __uint_as_float((__float_as_uint(sc[k][r]) & ~127u) | key));
        }
      float p[16];
#pragma unroll
      for (int i = 0; i < 16; ++i) {
        auto rr = __builtin_amdgcn_permlane32_swap(__float_as_uint(t[i]), __float_as_uint(t[i]), false, false);
        p[i] = __uint_as_float(hi ? rr[0] : rr[1]);
      }
#pragma unroll
      for (int i = 0; i < 16; ++i) TOP_INSERT(t, p[i]);
      if (hi == 0) {
        float* dst = TK + ((size_t)half * 128 + 32 * tb + r32) * 16;
#pragma unroll
        for (int i = 0; i < 16; i += 4) *(float4*)(dst + i) = make_float4(t[i], t[i + 1], t[i + 2], t[i + 3]);
      }
    }
    __syncthreads();
    if (tid < 128) {
      float v1[16], v2[16], t[16];
#pragma unroll
      for (int i = 0; i < 16; i += 4) {
        const float4 x = *(const float4*)(TK + (size_t)tid * 16 + i), y = *(const float4*)(TK + (size_t)(128 + tid) * 16 + i);
        v1[i] = x.x; v1[i + 1] = x.y; v1[i + 2] = x.z; v1[i + 3] = x.w; v2[i] = y.x; v2[i + 1] = y.y; v2[i + 2] = y.z; v2[i + 3] = y.w;
      }
#pragma unroll
      for (int i = 0; i < 16; ++i) t[i] = __uint_as_float(0xff800000u);
#pragma unroll
      for (int i = 0; i < 16; ++i)
#pragma unroll
        for (int j = 0; j < 16; ++j)
          if ((i + 1) * (j + 1) <= 16) TOP_INSERT(t, __uint_as_float((__float_as_uint(v1[i] + v2[j]) & ~255u) | (unsigned)(i * 16 + j)));
      float e[16], sum = 0.f; unsigned ex[16];
      const float m0 = __uint_as_float(__float_as_uint(t[0]) & ~255u);
#pragma unroll
      for (int i = 0; i < 16; ++i) {
        const unsigned bits = __float_as_uint(t[i]), id = bits & 255u;
        const unsigned i1 = __float_as_uint(TK[(size_t)tid * 16 + (id >> 4)]) & 127u, i2 = __float_as_uint(TK[(size_t)(128 + tid) * 16 + (id & 15u)]) & 127u;
        ex[i] = i1 * 128u + i2;
        e[i] = __expf(__uint_as_float(bits & ~255u) - m0); sum += e[i];
      }
      const float inv = 1.f / sum;
      uint2* dst = TOPK + ((size_t)(R0 + tid) * 8 + hd) * 16;
#pragma unroll
      for (int i = 0; i < 16; i += 2) {
        uint4 o = {ex[i], __float_as_uint(e[i] * inv), ex[i + 1], __float_as_uint(e[i + 1] * inv)};
        *(uint4*)(dst + i) = o;
      }
    }
    __syncthreads();
  }
}

__device__ void phase7(const Args& a) {
  unsigned char* ws = a.ws;
  const int tid = threadIdx.x, lane = tid & 63, wv = tid >> 6;
  const u16* H = (const u16*)(ws + WS_H); const u16* UB = (const u16*)(ws + WS_UB); const u16* VB = (const u16*)(ws + WS_VB);
  const uint2* TOPK = (const uint2*)(ws + WS_TOPK); const float* X1 = (const float*)(ws + WS_X1); const float* mod = (const float*)(ws + WS_MOD);
  const int NWV = gridDim.x * 8;
  for (int tok = blockIdx.x * 8 + wv; tok < T; tok += NWV) {
    const int b = tok >> 12;
    float hf[16], out[16];
    { const u32x4 ha = *(const u32x4*)(H + (size_t)tok * 1024 + lane * 8), hb = *(const u32x4*)(H + (size_t)tok * 1024 + 512 + lane * 8);
#pragma unroll
      for (int k = 0; k < 4; ++k) { hf[2 * k] = bflo(ha[k]); hf[2 * k + 1] = bfhi(ha[k]); hf[8 + 2 * k] = bflo(hb[k]); hf[9 + 2 * k] = bfhi(hb[k]); } }
#pragma unroll
    for (int k = 0; k < 16; ++k) out[k] = 0.f;
    const uint2 pA = TOPK[(size_t)tok * 128 + lane], pB = TOPK[(size_t)tok * 128 + 64 + lane];
    for (int e0 = 0; e0 < 128; e0 += 4) {
      u32x4 ua[4], ub[4], va[4], vb[4]; float gt[4];
#pragma unroll
      for (int j = 0; j < 4; ++j) {
        const int e = e0 + j;
        const unsigned sx = e0 < 64 ? pA.x : pB.x, sg = e0 < 64 ? pA.y : pB.y;
        const unsigned ex = __builtin_amdgcn_readlane(sx, e & 63);
        gt[j] = __uint_as_float(__builtin_amdgcn_readlane(sg, e & 63));
        const u16* pu = UB + (size_t)ex * 1024 + lane * 8; const u16* pv = VB + (size_t)ex * 1024 + lane * 8;
        ua[j] = *(const u32x4*)pu; ub[j] = *(const u32x4*)(pu + 512); va[j] = *(const u32x4*)pv; vb[j] = *(const u32x4*)(pv + 512);
      }
      float d[4];
#pragma unroll
      for (int j = 0; j < 4; ++j) {
        float s = 0.f;
#pragma unroll
        for (int k = 0; k < 4; ++k) { s += bflo(ua[j][k]) * hf[2 * k] + bfhi(ua[j][k]) * hf[2 * k + 1]; s += bflo(ub[j][k]) * hf[8 + 2 * k] + bfhi(ub[j][k]) * hf[9 + 2 * k]; }
        d[j] = s;
      }
#pragma unroll
      for (int o = 32; o > 0; o >>= 1) {
#pragma unroll
        for (int j = 0; j < 4; ++j) d[j] += __shfl_xor(d[j], o, 64);
      }
#pragma unroll
      for (int j = 0; j < 4; ++j) {
        const float w = gelu_exact(d[j]) * gt[j];
#pragma unroll
        for (int k = 0; k < 4; ++k) { out[2 * k] += w * bflo(va[j][k]); out[2 * k + 1] += w * bfhi(va[j][k]); out[8 + 2 * k] += w * bflo(vb[j][k]); out[9 + 2 * k] += w * bfhi(vb[j][k]); }
      }
    }
    float x2[16], ssq = 0.f;
#pragma unroll
    for (int hh = 0; hh < 2; ++hh)
#pragma unroll
      for (int q4 = 0; q4 < 2; ++q4) {
        const int col = hh * 512 + lane * 8 + q4 * 4;
        const float4 xv = *(const float4*)(X1 + (size_t)tok * 1024 + col), g2 = *(const float4*)(mod + b * 6144 + 5120 + col);
        const int k = hh * 8 + q4 * 4;
        x2[k] = xv.x + g2.x * out[k]; x2[k + 1] = xv.y + g2.y * out[k + 1]; x2[k + 2] = xv.z + g2.z * out[k + 2]; x2[k + 3] = xv.w + g2.w * out[k + 3];
        ssq += x2[k] * x2[k] + x2[k + 1] * x2[k + 1] + x2[k + 2] * x2[k + 2] + x2[k + 3] * x2[k + 3];
      }
    ssq = wave_sum(ssq);
    const float rstd = rsqrtf(ssq * (1.f / 1024.f) + EPS);
#pragma unroll
    for (int hh = 0; hh < 2; ++hh)
#pragma unroll
      for (int q4 = 0; q4 < 2; ++q4) {
        const int col = hh * 512 + lane * 8 + q4 * 4, k = hh * 8 + q4 * 4;
        const float4 gf = *(const float4*)(a.g_final + col);
        *(float4*)(a.out + (size_t)tok * 1024 + col) = make_float4(x2[k] * rstd * gf.x, x2[k + 1] * rstd * gf.y, x2[k + 2] * rstd * gf.z, x2[k + 3] * rstd * gf.w);
      }
  }
}

constexpr int N_PHASES = 9;
__global__ void __launch_bounds__(512, 2) fwd(Args args) {
  extern __shared__ __attribute__((aligned(16))) char lds[];
  if (threadIdx.x == 0) *(uint4*)lds = make_uint4(0u, 0u, 0u, 0u);
  __syncthreads();
  const int lo = args.ph_lo, hi = args.ph_hi;
  XcdBarrier bar; bar.bar = (unsigned*)(args.ws + WS_BAR); bar.x = 0; bar.st = (volatile LAS unsigned*)lds;
  if (hi - lo > 1) bar = xcd_barrier_post((unsigned*)(args.ws + WS_BAR), (volatile LAS unsigned*)lds);
#ifndef ONLY_PHASE
#define ONLY_PHASE -1
#endif
#define IN(k) (lo <= (k) && (k) < hi && (ONLY_PHASE < 0 || ONLY_PHASE == (k)))
#define SEAM(k) do { if (IN(k) && IN((k) + 1)) xcd_barrier(bar); } while (0)
  if (IN(0)) phase0(args);
  SEAM(0);
  if (IN(1)) phase1(args, lds);
  SEAM(1);
  if (IN(2)) phase2(args, lds);
  SEAM(2);
  if (IN(3)) phase3(args, lds);
  SEAM(3);
  if (IN(4)) phase4(args, lds);
  SEAM(4);
  if (IN(5)) phase5(args, lds);
  SEAM(5);
  if (IN(6)) phase5b(args);
  SEAM(6);
  if (IN(7)) phase6(args, lds);
  SEAM(7);
  if (IN(8)) phase7(args);
#undef IN
#undef SEAM
}

extern "C" void kernel_launch(void* const* d_in, const int* in_sizes, int n_in, void* d_out, int out_size, void* d_ws, size_t ws_size, hipStream_t stream) {
  static int grid = 0;
  if (grid == 0) {
    if (n_in != 23 || out_size != T * DM || ws_size < WS_END) { fprintf(stderr, "kernel_launch: unexpected shapes (n_in %d out %d ws %zu need %zu)\n", n_in, out_size, ws_size, (size_t)WS_END); grid = -1; return; }
    int dev = 0, cus = 0, per_cu = 0;
    (void)hipGetDevice(&dev); (void)hipDeviceGetAttribute(&cus, hipDeviceAttributeMultiprocessorCount, dev);
    if (hipFuncSetAttribute((const void*)fwd, hipFuncAttributeMaxDynamicSharedMemorySize, LDS_BYTES) != hipSuccess) { fprintf(stderr, "kernel_launch: hipFuncSetAttribute failed\n"); grid = -1; return; }
    if (hipOccupancyMaxActiveBlocksPerMultiprocessor(&per_cu, (const void*)fwd, 512, LDS_BYTES) != hipSuccess || per_cu < 1) { fprintf(stderr, "kernel_launch: occupancy query says %d\n", per_cu); per_cu = 1; }
    (void)hipGetLastError();
    grid = cus;
  }
  if (grid < 0) return;
  (void)hipMemsetAsync((char*)d_ws + WS_BAR, 0, 16384, stream);
  Args a{};
  a.x = (const float*)d_in[0]; a.c = (const float*)d_in[1]; a.pos = (const int*)d_in[2];
  a.w_ada = (const float*)d_in[3]; a.b_ada = (const float*)d_in[4]; a.g_norm1 = (const float*)d_in[5]; a.w_in = (const float*)d_in[6];
  a.g_q_a = (const float*)d_in[7]; a.w_uq = (const float*)d_in[8]; a.g_kv_a = (const float*)d_in[9]; a.w_ukv = (const float*)d_in[10];
  a.g_sg = (const float*)d_in[11]; a.w_sg = (const float*)d_in[12]; a.b_sg = (const float*)d_in[13]; a.g_attn_out = (const float*)d_in[14];
  a.g_sg_out = (const float*)d_in[15]; a.w_o = (const float*)d_in[16]; a.g_norm2 = (const float*)d_in[17]; a.w_peer_q = (const float*)d_in[18];
  a.peer_keys = (const float*)d_in[19]; a.peer_u = (const float*)d_in[20]; a.peer_v = (const float*)d_in[21]; a.g_final = (const float*)d_in[22];
  a.out = (float*)d_out; a.ws = (unsigned char*)d_ws;
#if N_LAUNCH_MODE == 0
  a.ph_lo = 0; a.ph_hi = N_PHASES;
  hipLaunchKernelGGL(fwd, dim3(grid), dim3(512), LDS_BYTES, stream, a);
#else
  for (int p = 0; p < N_PHASES; ++p) { a.ph_lo = p; a.ph_hi = p + 1; hipLaunchKernelGGL(fwd, dim3(grid), dim3(512), LDS_BYTES, stream, a); }
#endif
  const hipError_t le = hipPeekAtLastError();
  if (le != hipSuccess) fprintf(stderr, "kernel_launch: launch failed: %s\n", hipGetErrorName(le));
}
```

```cpp
#include <hip/hip_runtime.h>
#include <stdint.h>
#include <stdio.h>

#define N_LAUNCH_MODE 0
#define DUP_MASK 0x000

typedef unsigned short u16;
typedef __attribute__((ext_vector_type(8))) short bf16x8;
typedef __attribute__((ext_vector_type(4))) short s16x4;
typedef __attribute__((ext_vector_type(16))) float f32x16;
typedef __attribute__((ext_vector_type(4))) unsigned u32x4;

constexpr int T = 16384, DM = 1024, SEQ = 4096;
constexpr float EPS = 1e-6f;

constexpr size_t WS_BAR  = 0;
constexpr size_t WS_MODP = 16384;
constexpr size_t WS_MOD  = WS_MODP + 786432;
constexpr size_t WS_CS   = WS_MOD + 98304;
constexpr size_t WS_WIN  = WS_CS + 4194304;
constexpr size_t WS_WQ2  = WS_WIN + 3145728;
constexpr size_t WS_WUV  = WS_WQ2 + 393216;
constexpr size_t WS_WO   = WS_WUV + 131072;
constexpr size_t WS_WPQ  = WS_WO + 2097152;
constexpr size_t WS_KEYS = WS_WPQ + 4194304;
constexpr size_t WS_WSG  = WS_KEYS + 524288;
constexpr size_t WS_UB   = WS_WSG + 131072;
constexpr size_t WS_VB   = WS_UB + 33554432;
constexpr size_t WS_H    = WS_VB + 33554432;
constexpr size_t WS_Y    = WS_H + 33554432;
constexpr size_t WS_KV   = WS_Y + 33554432;
constexpr size_t WS_TOPK = WS_KV + 6291456;
constexpr size_t WS_SSQ  = WS_TOPK + 16777216;
constexpr size_t WS_SSQV = WS_SSQ + 262144;
constexpr size_t WS_R1   = WS_SSQV + 131072;
constexpr size_t WS_Q    = WS_R1;
constexpr size_t WS_QA   = WS_Q + 25165824;
constexpr size_t WS_UACT = WS_QA + 8388608;
constexpr size_t WS_GVT  = WS_UACT + 16777216;
constexpr size_t WS_X1   = WS_R1;
constexpr size_t WS_END  = WS_R1 + 67108864;

constexpr int LDS_BYTES = 155648;
constexpr int LDS_DATA  = 64;

struct Args {
  const float *x, *c; const int* pos;
  const float *w_ada, *b_ada, *g_norm1, *w_in, *g_q_a, *w_uq, *g_kv_a, *w_ukv, *g_sg, *w_sg, *b_sg, *g_attn_out, *g_sg_out,
              *w_o, *g_norm2, *w_peer_q, *peer_keys, *peer_u, *peer_v, *g_final;
  float* out; unsigned char* ws; int ph_lo, ph_hi;
};

#define XB_TMO      128
#define XB_XCNT(j)  (256  + 64 * (j))
#define XB_XSUB(j)  (1280 + 64 * (j))
#define XB_XGEN(j)  (2304 + 64 * (j))
#define XB_TOP      3328
#define XB_TOPGEN   3392
#define XCD_BAR_WORDS 3456
#define XB_SPIN_CAP (1u << 18)
#define LAS __attribute__((address_space(3)))

__device__ __forceinline__ unsigned xb_ld(unsigned* p)              { return __hip_atomic_load(p, __ATOMIC_RELAXED, __HIP_MEMORY_SCOPE_AGENT); }
__device__ __forceinline__ unsigned xb_add(unsigned* p, unsigned v) { return __hip_atomic_fetch_add(p, v, __ATOMIC_RELAXED, __HIP_MEMORY_SCOPE_AGENT); }
__device__ __forceinline__ unsigned xb_xcc_id() { return (unsigned)__builtin_amdgcn_s_getreg((3 << 11) | 20) & 0xFu; }
#define XB_SPIN(cond, bar) do { unsigned _sp = 0; while (cond) { __builtin_amdgcn_s_sleep(1); \
    if ((++_sp & 255u) == 0u) { if (xb_ld(&(bar)[XB_TMO])) break; if (_sp > XB_SPIN_CAP) { atomicAdd(&(bar)[XB_TMO], 1u); break; } } } } while (0)

struct XcdBarrier { unsigned* bar; unsigned x; volatile LAS unsigned* st; };

__device__ __forceinline__ XcdBarrier xcd_barrier_post(unsigned* bar, volatile LAS unsigned* st) {
    XcdBarrier b; b.bar = bar; b.x = xb_xcc_id(); b.st = st;
    if (threadIdx.x == 0) (void)xb_add(&bar[XB_XCNT(b.x)], 1u);
    return b;
}
__device__ __forceinline__ void xcd_barrier_complete(unsigned* bar, unsigned x, unsigned& nloc, unsigned& nx) {
    const unsigned G = gridDim.x * gridDim.y * gridDim.z;
    unsigned sum, cnt, mine, sp = 0u;
    for (;;) {
        sum = 0u; cnt = 0u; mine = 0u;
#pragma unroll
        for (unsigned j = 0; j < 16; ++j) { const unsigned c = xb_ld(&bar[XB_XCNT(j)]); sum += c; cnt += (c > 0u) ? 1u : 0u; mine = (j == x) ? c : mine; }
        if (sum == G) break;
        __builtin_amdgcn_s_sleep(1);
        if ((++sp & 255u) == 0u) { if (xb_ld(&bar[XB_TMO])) break; if (sp > XB_SPIN_CAP) { atomicAdd(&bar[XB_TMO], 1u); break; } }
    }
    nloc = mine > 0u ? mine : 1u; nx = cnt > 0u ? cnt : 1u;
}
__device__ __forceinline__ void xcd_barrier(const XcdBarrier& b) {
    asm volatile("s_waitcnt vmcnt(0)" ::: "memory");
    __syncthreads();
    if (threadIdx.x == 0) {
        unsigned* bar = b.bar;
        __builtin_amdgcn_s_waitcnt(0);
        unsigned nloc = b.st[0], nx = b.st[1];
        if (nloc == 0u) { xcd_barrier_complete(bar, b.x, nloc, nx); b.st[0] = nloc; b.st[1] = nx; }
        const unsigned old = xb_add(&bar[XB_XSUB(b.x)], 1u);
        const unsigned gen = old / nloc;
        if (old + 1u == (gen + 1u) * nloc) {
            __builtin_amdgcn_fence(__ATOMIC_RELEASE, "agent");
            asm volatile("s_waitcnt vmcnt(0)" ::: "memory");
            const unsigned og = xb_add(&bar[XB_TOP], 1u);
            const unsigned tg = og / nx;
            if (og + 1u == (tg + 1u) * nx) xb_add(&bar[XB_TOPGEN], 1u);
            else XB_SPIN(xb_ld(&bar[XB_TOPGEN]) == tg, bar);
            __builtin_amdgcn_fence(__ATOMIC_ACQUIRE, "agent");
            xb_add(&bar[XB_XGEN(b.x)], 1u);
            asm volatile("s_waitcnt vmcnt(0)" ::: "memory");
        } else {
            XB_SPIN(xb_ld(&bar[XB_XGEN(b.x)]) == gen, bar);
            __builtin_amdgcn_fence(__ATOMIC_ACQUIRE, "agent");
            asm volatile("s_waitcnt vmcnt(0)" ::: "memory");
        }
    }
    __syncthreads();
}

__device__ __forceinline__ unsigned pack2(float lo, float hi) {
  typedef __attribute__((ext_vector_type(2))) float f2; typedef __attribute__((ext_vector_type(2))) __bf16 b2;
  f2 v = {lo, hi}; b2 r = __builtin_convertvector(v, b2); return __builtin_bit_cast(unsigned, r);
}
__device__ __forceinline__ u16 f2bf(float f) { return (u16)(pack2(f, 0.f) & 0xFFFFu); }
__device__ __forceinline__ float bflo(unsigned w) { return __uint_as_float(w << 16); }
__device__ __forceinline__ float bfhi(unsigned w) { return __uint_as_float(w & 0xFFFF0000u); }
__device__ __forceinline__ float gelu_exact(float x) { return 0.5f * x * (1.f + erff(x * 0.70710678118654752f)); }
__device__ __forceinline__ float wave_sum(float v) {
#pragma unroll
  for (int o = 32; o > 0; o >>= 1) v += __shfl_xor(v, o, 64);
  return v;
}
__device__ __forceinline__ int crow(int r, int hi) { return (r & 3) + 8 * (r >> 2) + 4 * hi; }
#define MFMA32(a, b, c) __builtin_amdgcn_mfma_f32_32x32x16_bf16((a), (b), (c), 0, 0, 0)

template <int MAP> __device__ __forceinline__ int colmap(int n) {
  if (MAP == 0) return n;
  if (MAP == 1) return n < 448 ? n : (n < 512 ? -1 : n - 64);
  if (MAP == 2) return (n >> 6) * 192 + 128 + (n & 63);
  return (n >> 7) * 256 + 128 + (n & 127);
}
template <int MAP> __device__ void cvt_transpose(const float* __restrict__ src, int src_ld, int K, int N, u16* __restrict__ dst, int gtid, int gthreads) {
  const int total = N * (K >> 3);
  for (int idx = gtid; idx < total; idx += gthreads) {
    const int n = idx % N, k8 = idx / N, sc = colmap<MAP>(n);
    float v[8];
#pragma unroll
    for (int j = 0; j < 8; ++j) v[j] = sc < 0 ? 0.f : src[(size_t)(k8 * 8 + j) * src_ld + sc];
    u32x4 w = {pack2(v[0], v[1]), pack2(v[2], v[3]), pack2(v[4], v[5]), pack2(v[6], v[7])};
    *(u32x4*)(dst + (size_t)n * K + k8 * 8) = w;
  }
}
__device__ void cvt_direct(const float* __restrict__ src, u16* __restrict__ dst, size_t n8, int gtid, int gthreads) {
  for (size_t i = gtid; i < n8; i += gthreads) {
    const float4 a = *(const float4*)(src + i * 8), b = *(const float4*)(src + i * 8 + 4);
    u32x4 w = {pack2(a.x, a.y), pack2(a.z, a.w), pack2(b.x, b.y), pack2(b.z, b.w)};
    *(u32x4*)(dst + i * 8) = w;
  }
}
__device__ __forceinline__ void sincos_acc(float angf, float& sn, float& cs) {
  const double a = (double)angf;
  const double q = __builtin_rint(a * 0.63661977236758134308);
  double r = __builtin_fma(-q, 1.5707963267948966, a);
  r = __builtin_fma(-q, 6.123233995736766e-17, r);
  const double r2 = r * r;
  double s = r2 * (1.0 / 6227020800.0) - 1.0 / 39916800.0;
  s = s * r2 + 1.0 / 362880.0; s = s * r2 - 1.0 / 5040.0; s = s * r2 + 1.0 / 120.0; s = s * r2 - 1.0 / 6.0; s = r + r * r2 * s;
  double c = -r2 * (1.0 / 87178291200.0) + 1.0 / 479001600.0;
  c = c * r2 - 1.0 / 3628800.0; c = c * r2 + 1.0 / 40320.0; c = c * r2 - 1.0 / 720.0; c = c * r2 + 1.0 / 24.0; c = c * r2 - 0.5; c = 1.0 + r2 * c;
  const int n = ((int)q) & 3;
  const double ss = (n & 1) ? c : s, cc = (n & 1) ? s : c;
  sn = (float)((n & 2) ? -ss : ss);
  cs = (float)(((n + 1) & 2) ? -cc : cc);
}

__constant__ float INVF[32] = {1.000000000e+00f, 7.498942018e-01f, 5.623413324e-01f, 4.216965139e-01f, 3.162277639e-01f, 2.371373922e-01f, 1.778279394e-01f, 1.333521456e-01f,
  1.000000015e-01f, 7.498941571e-02f, 5.623412877e-02f, 4.216964915e-02f, 3.162277862e-02f, 2.371373586e-02f, 1.778279431e-02f, 1.333521493e-02f,
  9.999999776e-03f, 7.498942316e-03f, 5.623413250e-03f, 4.216964822e-03f, 3.162277862e-03f, 2.371373819e-03f, 1.778279431e-03f, 1.333521446e-03f,
  1.000000047e-03f, 7.498941850e-04f, 5.623413017e-04f, 4.216965463e-04f, 3.162277862e-04f, 2.371373848e-04f, 1.778279402e-04f, 1.333521504e-04f};
__device__ void phase0(const Args& a) {
  unsigned char* ws = a.ws;
  const int tid = threadIdx.x, lane = tid & 63, wv = tid >> 6;
  const int NWV = gridDim.x * 8, gw = blockIdx.x * 8 + wv;
  const int gthreads = gridDim.x * 512, gtid = blockIdx.x * 512 + tid;
  float* modp = (float*)(ws + WS_MODP);
  for (int job = gw; job < 768; job += NWV) {
    const int cg = job % 96, ks = job / 96, col = cg * 64 + lane;
    float a0 = 0.f, a1 = 0.f, a2 = 0.f, a3 = 0.f;
    const float* w = a.w_ada + (size_t)(ks * 128) * 6144 + col;
#pragma unroll 8
    for (int k = 0; k < 128; ++k) {
      const float wv_ = w[(size_t)k * 6144];
      const int kk = ks * 128 + k;
      const float c0 = a.c[kk], c1 = a.c[1024 + kk], c2 = a.c[2048 + kk], c3 = a.c[3072 + kk];
      a0 += (c0 / (1.f + __expf(-c0))) * wv_; a1 += (c1 / (1.f + __expf(-c1))) * wv_;
      a2 += (c2 / (1.f + __expf(-c2))) * wv_; a3 += (c3 / (1.f + __expf(-c3))) * wv_;
    }
    modp[(ks * 4 + 0) * 6144 + col] = a0; modp[(ks * 4 + 1) * 6144 + col] = a1;
    modp[(ks * 4 + 2) * 6144 + col] = a2; modp[(ks * 4 + 3) * 6144 + col] = a3;
  }
  cvt_transpose<1>(a.w_in, 1472, 1024, 1536, (u16*)(ws + WS_WIN), gtid, gthreads);
  cvt_transpose<0>(a.w_o, 1024, 1024, 1024, (u16*)(ws + WS_WO), gtid, gthreads);
  cvt_transpose<0>(a.w_peer_q, 2048, 1024, 2048, (u16*)(ws + WS_WPQ), gtid, gthreads);
  cvt_transpose<2>(a.w_uq, 768, 256, 256, (u16*)(ws + WS_WQ2) + 512 * 256, gtid, gthreads);
  cvt_transpose<3>(a.w_ukv, 1024, 128, 512, (u16*)(ws + WS_WUV), gtid, gthreads);
  {
    u16* wq2 = (u16*)(ws + WS_WQ2);
    for (int idx = gtid; idx < 512 * 256; idx += gthreads) {
      const int n = idx >> 8, i = idx & 255, h = n >> 7, cc = n & 127;
      const float* pu = a.w_uq + (size_t)i * 768 + h * 192;
      const float* pk = a.w_ukv + (size_t)cc * 1024 + h * 256;
      float s = 0.f;
#pragma unroll 8
      for (int d = 0; d < 128; d += 4) {
        const float4 u = *(const float4*)(pu + d), k = *(const float4*)(pk + d);
        s += u.x * k.x + u.y * k.y + u.z * k.z + u.w * k.w;
      }
      wq2[(size_t)n * 256 + i] = f2bf(s);
    }
  }
  cvt_direct(a.peer_keys, (u16*)(ws + WS_KEYS), 262144 / 8, gtid, gthreads);
  cvt_direct(a.w_sg, (u16*)(ws + WS_WSG), 65536 / 8, gtid, gthreads);
  cvt_direct(a.peer_u, (u16*)(ws + WS_UB), (size_t)16384 * 1024 / 8, gtid, gthreads);
  cvt_direct(a.peer_v, (u16*)(ws + WS_VB), (size_t)16384 * 1024 / 8, gtid, gthreads);
  {
    float* cs = (float*)(ws + WS_CS);
    for (int idx = gtid; idx < T * 32; idx += gthreads) {
      const int t = idx >> 5, i = idx & 31;
      const float inv = INVF[i];
      const float ang = (float)a.pos[t] * inv;
      float sn, c_; sincos_acc(ang, sn, c_);
      cs[(size_t)t * 64 + i] = c_; cs[(size_t)t * 64 + 32 + i] = sn;
    }
  }
}

__device__ void phase1(const Args& a, char* lds) {
  unsigned char* ws = a.ws;
  const int tid = threadIdx.x, lane = tid & 63, wv = tid >> 6;
  const float* modp = (const float*)(ws + WS_MODP);
  float* mod = (float*)(ws + WS_MOD);
  for (int idx = blockIdx.x * 512 + tid; idx < 4 * 6144; idx += gridDim.x * 512) {
    const int b = idx / 6144, m = idx % 6144;
    float s = a.b_ada[m];
#pragma unroll
    for (int ks = 0; ks < 8; ++ks) s += modp[(ks * 4 + b) * 6144 + m];
    mod[idx] = s;
  }
  float* sh = (float*)(lds + LDS_DATA);
  u16* H = (u16*)(ws + WS_H);
  for (int u = blockIdx.x; u < T / 64; u += gridDim.x) {
    const int b = u >> 6;
    __syncthreads();
    for (int j = tid; j < 2048; j += 512) {
      float s = a.b_ada[j];
#pragma unroll
      for (int ks = 0; ks < 8; ++ks) s += modp[(ks * 4 + b) * 6144 + j];
      sh[j] = s;
    }
    __syncthreads();
    for (int i = 0; i < 8; ++i) {
      const int r = u * 64 + wv * 8 + i;
      float4 xv[4]; float ssq = 0.f;
#pragma unroll
      for (int j = 0; j < 4; ++j) { xv[j] = *(const float4*)(a.x + (size_t)r * 1024 + j * 256 + lane * 4); ssq += xv[j].x * xv[j].x + xv[j].y * xv[j].y + xv[j].z * xv[j].z + xv[j].w * xv[j].w; }
      ssq = wave_sum(ssq);
      const float rstd = rsqrtf(ssq * (1.f / 1024.f) + EPS);
#pragma unroll
      for (int j = 0; j < 4; ++j) {
        const int col = j * 256 + lane * 4;
        const float4 g = *(const float4*)(a.g_norm1 + col);
        const float h0 = xv[j].x * rstd * g.x * (1.f + sh[1024 + col]) + sh[col];
        const float h1 = xv[j].y * rstd * g.y * (1.f + sh[1024 + col + 1]) + sh[col + 1];
        const float h2 = xv[j].z * rstd * g.z * (1.f + sh[1024 + col + 2]) + sh[col + 2];
        const float h3 = xv[j].w * rstd * g.w * (1.f + sh[1024 + col + 3]) + sh[col + 3];
        uint2 o = {pack2(h0, h1), pack2(h2, h3)};
        *(uint2*)(H + (size_t)r * 1024 + col) = o;
      }
    }
  }
}

constexpr int G_STAGE = 49152;
__device__ __forceinline__ void gemm_128x256(const u16* __restrict__ A, int lda, const u16* __restrict__ Bt, int ldb, int KT,
                                             f32x16 (&acc)[2][2], char* lds) {
  const int tid = threadIdx.x, lane = tid & 63, wv = tid >> 6, r32 = lane & 31, hi = lane >> 5;
  const int wm = wv >> 2, wn = wv & 3;
  const int srow = tid >> 3, sc = tid & 7;
  const u16* pa = A + (size_t)srow * lda + sc * 8;
  const u16* pb = Bt + (size_t)srow * ldb + sc * 8;
  const int swo = srow * 128 + ((sc ^ ((srow >> 1) & 7)) << 4);
  u32x4 ra[2], rb[4];
#pragma unroll
  for (int m = 0; m < 2; ++m)
#pragma unroll
    for (int n = 0; n < 2; ++n)
#pragma unroll
      for (int r = 0; r < 16; ++r) acc[m][n][r] = 0.f;
#pragma unroll
  for (int i = 0; i < 2; ++i) ra[i] = *(const u32x4*)(pa + (size_t)(64 * i) * lda);
#pragma unroll
  for (int i = 0; i < 4; ++i) rb[i] = *(const u32x4*)(pb + (size_t)(64 * i) * ldb);
  __syncthreads();
#pragma unroll
  for (int i = 0; i < 2; ++i) *(u32x4*)(lds + swo + 8192 * i) = ra[i];
#pragma unroll
  for (int i = 0; i < 4; ++i) *(u32x4*)(lds + 16384 + swo + 8192 * i) = rb[i];
  __syncthreads();
  const int xa = (r32 >> 1) & 7;
  const int aoff = (64 * wm + r32) * 128, boff = 16384 + (64 * wn + r32) * 128;
  for (int kt = 0; kt < KT; ++kt) {
    const char* buf = lds + (kt & 1) * G_STAGE;
    if (kt + 1 < KT) {
#pragma unroll
      for (int i = 0; i < 2; ++i) ra[i] = *(const u32x4*)(pa + (size_t)(64 * i) * lda + (kt + 1) * 64);
#pragma unroll
      for (int i = 0; i < 4; ++i) rb[i] = *(const u32x4*)(pb + (size_t)(64 * i) * ldb + (kt + 1) * 64);
    }
#pragma unroll
    for (int s = 0; s < 4; ++s) {
      const int cb = ((2 * s + hi) ^ xa) << 4;
      const bf16x8 a0 = *(const bf16x8*)(buf + aoff + cb), a1 = *(const bf16x8*)(buf + aoff + 4096 + cb);
      const bf16x8 b0 = *(const bf16x8*)(buf + boff + cb), b1 = *(const bf16x8*)(buf + boff + 4096 + cb);
      acc[0][0] = MFMA32(a0, b0, acc[0][0]); acc[0][1] = MFMA32(a0, b1, acc[0][1]);
      acc[1][0] = MFMA32(a1, b0, acc[1][0]); acc[1][1] = MFMA32(a1, b1, acc[1][1]);
    }
    if (kt + 1 < KT) {
      char* nb = lds + ((kt + 1) & 1) * G_STAGE;
#pragma unroll
      for (int i = 0; i < 2; ++i) *(u32x4*)(nb + swo + 8192 * i) = ra[i];
#pragma unroll
      for (int i = 0; i < 4; ++i) *(u32x4*)(nb + 16384 + swo + 8192 * i) = rb[i];
    }
    __syncthreads();
  }
}
constexpr int CLD = 257;
__device__ __forceinline__ void acc_to_lds(const f32x16 (&acc)[2][2], float* Cl) {
  const int lane = threadIdx.x & 63, wv = threadIdx.x >> 6, r32 = lane & 31, hi = lane >> 5, wm = wv >> 2, wn = wv & 3;
#pragma unroll
  for (int m = 0; m < 2; ++m)
#pragma unroll
    for (int n = 0; n < 2; ++n)
#pragma unroll
      for (int r = 0; r < 16; ++r) Cl[(64 * wm + 32 * m + crow(r, hi)) * CLD + 64 * wn + 32 * n + r32] = acc[m][n][r];
}

__device__ void phase2(const Args& a, char* lds) {
  unsigned char* ws = a.ws;
  const int tid = threadIdx.x, lane = tid & 63, wv = tid >> 6;
  const u16* H = (const u16*)(ws + WS_H); const u16* WIN = (const u16*)(ws + WS_WIN);
  u16* QA = (u16*)(ws + WS_QA); u16* KV = (u16*)(ws + WS_KV); u16* UACT = (u16*)(ws + WS_UACT); u16* GVT = (u16*)(ws + WS_GVT);
  float* SSQV = (float*)(ws + WS_SSQV); const float* CS = (const float*)(ws + WS_CS);
  char* gl = lds + LDS_DATA; float* Cl = (float*)gl;
  for (int u = blockIdx.x; u < 128 * 6; u += gridDim.x) {
    const int mt = u / 6, nt = u % 6, R0 = mt * 128;
    f32x16 acc[2][2];
    gemm_128x256(H + (size_t)R0 * 1024, 1024, WIN + (size_t)(nt * 256) * 1024, 1024, 16, acc, gl);
    acc_to_lds(acc, Cl);
    __syncthreads();
    if (nt == 0) {
      for (int i = 0; i < 16; ++i) {
        const int row = wv * 16 + i; float v[4], ssq = 0.f;
#pragma unroll
        for (int j = 0; j < 4; ++j) { v[j] = Cl[row * CLD + lane + 64 * j]; ssq += v[j] * v[j]; }
        ssq = wave_sum(ssq);
        const float rstd = rsqrtf(ssq * (1.f / 256.f) + EPS);
#pragma unroll
        for (int j = 0; j < 4; ++j) { const int col = lane + 64 * j; QA[(size_t)(R0 + row) * 256 + col] = f2bf(v[j] * rstd * a.g_q_a[col]); }
      }
    } else if (nt == 1) {
      for (int i = 0; i < 16; ++i) {
        const int row = wv * 16 + i, tok = R0 + row;
        const float v0 = Cl[row * CLD + lane], v1 = Cl[row * CLD + 64 + lane];
        const float ssq = wave_sum(v0 * v0 + v1 * v1);
        const float rstd = rsqrtf(ssq * (1.f / 128.f) + EPS);
        KV[(size_t)tok * 192 + lane] = f2bf(v0 * rstd * a.g_kv_a[lane]);
        KV[(size_t)tok * 192 + 64 + lane] = f2bf(v1 * rstd * a.g_kv_a[64 + lane]);
        if (lane < 32) {
          const float x1 = Cl[row * CLD + 128 + lane], x2 = Cl[row * CLD + 160 + lane];
          const float cs = CS[(size_t)tok * 64 + lane], sn = CS[(size_t)tok * 64 + 32 + lane];
          KV[(size_t)tok * 192 + 128 + lane] = f2bf(x1 * cs - x2 * sn);
          KV[(size_t)tok * 192 + 160 + lane] = f2bf(x2 * cs + x1 * sn);
        }
      }
    } else if (nt < 4) {
      for (int i = 0; i < 16; ++i) {
        const int row = wv * 16 + i;
#pragma unroll
        for (int j = 0; j < 4; ++j) { const int col = lane + 64 * j; UACT[(size_t)(R0 + row) * 512 + (nt - 2) * 256 + col] = f2bf(gelu_exact(Cl[row * CLD + col])); }
      }
    } else {
      for (int i = 0; i < 16; ++i) {
        const int row = wv * 16 + i; float ssq = 0.f;
#pragma unroll
        for (int j = 0; j < 4; ++j) { const int col = lane + 64 * j; const float g = gelu_exact(Cl[row * CLD + col]); const float gb = bflo((unsigned)f2bf(g)); ssq += gb * gb; Cl[row * CLD + col] = gb; }
        ssq = wave_sum(ssq);
        if (lane == 0) SSQV[(size_t)(R0 + row) * 2 + (nt - 4)] = ssq;
      }
      __syncthreads();
      for (int i = 0; i < 32; ++i) {
        const int c = wv * 32 + i;
        const float g0 = Cl[(2 * lane) * CLD + c], g1 = Cl[(2 * lane + 1) * CLD + c];
        *(unsigned*)(GVT + ((size_t)mt * 512 + (nt - 4) * 256 + c) * 128 + 2 * lane) = pack2(g0, g1);
      }
    }
    __syncthreads();
  }
}

__device__ void phase3(const Args& a, char* lds) {
  unsigned char* ws = a.ws;
  const int tid = threadIdx.x, lane = tid & 63, wv = tid >> 6, r32 = lane & 31, hi = lane >> 5;
  const u16* QA = (const u16*)(ws + WS_QA); const u16* WQ2 = (const u16*)(ws + WS_WQ2);
  u16* Q = (u16*)(ws + WS_Q); const float* CS = (const float*)(ws + WS_CS);
  const u16* UACT = (const u16*)(ws + WS_UACT); const u16* GVT = (const u16*)(ws + WS_GVT); const u16* WSG = (const u16*)(ws + WS_WSG);
  const float* SSQV = (const float*)(ws + WS_SSQV); u16* Y = (u16*)(ws + WS_Y);
  char* gl = lds + LDS_DATA; float* Cl = (float*)gl;
  for (int u = blockIdx.x; u < 384; u += gridDim.x) {
    {
      const int mt = u / 3, nt = u % 3, R0 = mt * 128;
      f32x16 acc[2][2];
      gemm_128x256(QA + (size_t)R0 * 256, 256, WQ2 + (size_t)(nt * 256) * 256, 256, 4, acc, gl);
      acc_to_lds(acc, Cl);
      __syncthreads();
      if (nt < 2) {
        for (int i = 0; i < 16; ++i) {
          const int row = wv * 16 + i;
#pragma unroll
          for (int j = 0; j < 4; ++j) { const int n = nt * 256 + lane + 64 * j; Q[(size_t)(R0 + row) * 768 + (n >> 7) * 192 + (n & 127)] = f2bf(Cl[row * CLD + lane + 64 * j]); }
        }
      } else {
        for (int i = 0; i < 16; ++i) {
          const int row = wv * 16 + i, tok = R0 + row;
#pragma unroll
          for (int j = 0; j < 2; ++j) {
            const int idx = lane + 64 * j, h = idx >> 5, jj = idx & 31;
            const float x1 = Cl[row * CLD + h * 64 + jj], x2 = Cl[row * CLD + h * 64 + 32 + jj];
            const float cs = CS[(size_t)tok * 64 + jj], sn = CS[(size_t)tok * 64 + 32 + jj];
            Q[(size_t)tok * 768 + h * 192 + 128 + jj] = f2bf(x1 * cs - x2 * sn);
            Q[(size_t)tok * 768 + h * 192 + 160 + jj] = f2bf(x2 * cs + x1 * sn);
          }
        }
      }
      __syncthreads();
    }
  }
  for (int su = blockIdx.x; su < 256; su += gridDim.x) {
    {
      const int c = su >> 1, ph = su & 1;
      float* rs = (float*)gl;
      float* Yl = (float*)(gl + 512);
      __syncthreads();
      if (tid < 128) { const size_t t = (size_t)c * 128 + tid; rs[tid] = rsqrtf((SSQV[t * 2] + SSQV[t * 2 + 1]) * (1.f / 512.f) + EPS); }
      __syncthreads();
      const int h = wv >> 1, dh = wv & 1;
      f32x16 acc[2][2];
#pragma unroll
      for (int m = 0; m < 2; ++m)
#pragma unroll
        for (int n = 0; n < 2; ++n)
#pragma unroll
          for (int r = 0; r < 16; ++r) acc[m][n][r] = 0.f;
      for (int s = 0; s < 8; ++s) {
        const int q0 = 16 * s + 8 * hi;
        bf16x8 af[2], bfr[2];
#pragma unroll
        for (int m = 0; m < 2; ++m) af[m] = *(const bf16x8*)(WSG + ((size_t)h * 128 + ph * 64 + 32 * m + r32) * 128 + q0);
        float rq[8];
#pragma unroll
        for (int j = 0; j < 8; ++j) rq[j] = rs[q0 + j];
#pragma unroll
        for (int n = 0; n < 2; ++n) {
          const u32x4 w = *(const u32x4*)(GVT + ((size_t)c * 512 + h * 128 + dh * 64 + 32 * n + r32) * 128 + q0);
          u32x4 o;
#pragma unroll
          for (int k = 0; k < 4; ++k) o[k] = pack2(bflo(w[k]) * rq[2 * k], bfhi(w[k]) * rq[2 * k + 1]);
          bfr[n] = __builtin_bit_cast(bf16x8, o);
        }
#pragma unroll
        for (int m = 0; m < 2; ++m)
#pragma unroll
          for (int n = 0; n < 2; ++n) acc[m][n] = MFMA32(af[m], bfr[n], acc[m][n]);
      }
#pragma unroll
      for (int m = 0; m < 2; ++m)
#pragma unroll
        for (int n = 0; n < 2; ++n)
#pragma unroll
          for (int r = 0; r < 16; ++r) {
            const int pl = 32 * m + crow(r, hi), col = h * 128 + dh * 64 + 32 * n + r32;
            const size_t tok = (size_t)c * 128 + ph * 64 + pl;
            const float mix = acc[m][n][r] * a.g_sg[col] + a.b_sg[h * 128 + ph * 64 + pl];
            Yl[pl * 513 + col] = bflo((unsigned)UACT[tok * 512 + col]) * mix;
          }
      __syncthreads();
      for (int i = 0; i < 8; ++i) {
        const int pl = wv * 8 + i; const size_t tok = (size_t)c * 128 + ph * 64 + pl;
        float v[8], ssq = 0.f;
#pragma unroll
        for (int j = 0; j < 8; ++j) { v[j] = Yl[pl * 513 + lane + 64 * j]; ssq += v[j] * v[j]; }
        ssq = wave_sum(ssq);
        const float rstd = rsqrtf(ssq * (1.f / 512.f) + EPS);
#pragma unroll
        for (int j = 0; j < 8; ++j) { const int col = lane + 64 * j; Y[tok * 1024 + 512 + col] = f2bf(v[j] * rstd * a.g_sg_out[col]); }
      }
      __syncthreads();
    }
  }
}

constexpr float ATT_SCALE = 0.07216878364870322f;
constexpr float ATT_THR = 8.f;
constexpr int KVBUF = 24576;
#define SBAR() __builtin_amdgcn_sched_barrier(0)
__device__ __forceinline__ unsigned cvtpk(float lo, float hi) { unsigned r; asm volatile("v_cvt_pk_bf16_f32 %0, %1, %2" : "=v"(r) : "v"(lo), "v"(hi)); return r; }
__device__ __forceinline__ unsigned off_a(unsigned row, unsigned ch) { return 2048u * (row >> 3) + 512u * (ch >> 2) + 64u * (row & 7) + 16u * ((ch & 3) ^ ((row >> 2) & 3)); }

__device__ __forceinline__ void partialSM(f32x16& p0, f32x16& p1, float& m_reg, float& mn, float& alpha) {
  constexpr float C = ATT_SCALE * 1.4426950408889634f;
  float pmax = p0[0];
#pragma unroll
  for (int r = 1; r < 16; ++r) pmax = fmaxf(pmax, p0[r]);
#pragma unroll
  for (int r = 0; r < 16; ++r) pmax = fmaxf(pmax, p1[r]);
  { auto rr = __builtin_amdgcn_permlane32_swap(__float_as_uint(pmax), __float_as_uint(pmax), false, false);
    pmax = fmaxf(__uint_as_float(rr[0]), __uint_as_float(rr[1])); }
  if (__builtin_expect(__all(pmax - m_reg <= ATT_THR / ATT_SCALE), 1)) { mn = m_reg; alpha = 1.f; }
  else { mn = fmaxf(m_reg, pmax); alpha = __builtin_amdgcn_exp2f((m_reg - mn) * C); m_reg = mn; }
  const float mnC = -mn * C;
#pragma unroll
  for (int r = 0; r < 16; ++r) p0[r] = fmaf(p0[r], C, mnC);
#pragma unroll
  for (int r = 0; r < 16; ++r) p1[r] = fmaf(p1[r], C, mnC);
#pragma unroll
  for (int r = 0; r < 16; ++r) p0[r] = __builtin_amdgcn_exp2f(p0[r]);
}
__device__ __forceinline__ void finishSM(f32x16& p0, f32x16& p1, float alpha, float& l_reg, bf16x8& pa0, bf16x8& pa1, bf16x8& pa2, bf16x8& pa3) {
#pragma unroll
  for (int r = 0; r < 16; ++r) p1[r] = __builtin_amdgcn_exp2f(p1[r]);
  float ps = 0;
#pragma unroll
  for (int r = 0; r < 16; ++r) ps += p0[r];
#pragma unroll
  for (int r = 0; r < 16; ++r) ps += p1[r];
  { auto rr = __builtin_amdgcn_permlane32_swap(__float_as_uint(ps), __float_as_uint(ps), false, false);
    ps = __uint_as_float(rr[0]) + __uint_as_float(rr[1]); }
  l_reg = l_reg * alpha + ps;
#define PK4(P, BASE, OUT) do { unsigned a0 = cvtpk(P[BASE + 0], P[BASE + 1]), a1 = cvtpk(P[BASE + 2], P[BASE + 3]);   \
    unsigned b0 = cvtpk(P[BASE + 4], P[BASE + 5]), b1 = cvtpk(P[BASE + 6], P[BASE + 7]);                              \
    auto r0 = __builtin_amdgcn_permlane32_swap(a0, b0, false, false); auto r1 = __builtin_amdgcn_permlane32_swap(a1, b1, false, false); \
    u32x4 w = {r0[0], r1[0], r0[1], r1[1]}; OUT = __builtin_bit_cast(bf16x8, w); } while (0)
  PK4(p0, 0, pa0); PK4(p0, 8, pa1); PK4(p1, 0, pa2); PK4(p1, 8, pa3);
#undef PK4
}
__device__ __forceinline__ void qkt192(f32x16& p0, f32x16& p1, const char* kb, const bf16x8* qr, int ke, int ko, int kr) {
#pragma unroll
  for (int r = 0; r < 16; ++r) { p0[r] = 0.f; p1[r] = 0.f; }
#pragma unroll
  for (int d0 = 0; d0 < 8; ++d0) {
    const int o = ((d0 & 1) ? ko : ke) + 512 * (d0 >> 1);
    const bf16x8 b0 = *(const bf16x8*)(kb + o), b1 = *(const bf16x8*)(kb + o + 8192);
    p0 = MFMA32(b0, qr[d0], p0); p1 = MFMA32(b1, qr[d0], p1);
  }
#pragma unroll
  for (int d1 = 0; d1 < 4; ++d1) {
    const int o = 16384 + (kr ^ (32 * d1));
    const bf16x8 b0 = *(const bf16x8*)(kb + o), b1 = *(const bf16x8*)(kb + o + 4096);
    p0 = MFMA32(b0, qr[8 + d1], p0); p1 = MFMA32(b1, qr[8 + d1], p1);
  }
}
template <int OFF> __device__ __forceinline__ s16x4 tr_read(int vb) {
  s16x4 r; asm volatile("ds_read_b64_tr_b16 %0, %1 offset:%2" : "=&v"(r) : "v"(vb), "i"(OFF) : "memory"); return r;
}
template <int C> __device__ __forceinline__ void pv_one(f32x16& od, int vb0, int vb1, bf16x8 pa0, bf16x8 pa1, bf16x8 pa2, bf16x8 pa3) {
  const s16x4 l0 = tr_read<512 * C>(vb0), h0 = tr_read<512 * C>(vb1), l1 = tr_read<4096 + 512 * C>(vb0), h1 = tr_read<4096 + 512 * C>(vb1);
  const s16x4 l2 = tr_read<8192 + 512 * C>(vb0), h2 = tr_read<8192 + 512 * C>(vb1), l3 = tr_read<12288 + 512 * C>(vb0), h3 = tr_read<12288 + 512 * C>(vb1);
  asm volatile("s_waitcnt lgkmcnt(0)" ::: "memory"); SBAR();
#define PKV(L, H) (bf16x8){L[0], L[1], L[2], L[3], H[0], H[1], H[2], H[3]}
  od = MFMA32(pa0, PKV(l0, h0), od); od = MFMA32(pa1, PKV(l1, h1), od);
  od = MFMA32(pa2, PKV(l2, h2), od); od = MFMA32(pa3, PKV(l3, h3), od);
#undef PKV
}
__device__ __forceinline__ void pv_all(f32x16* o, int vb0, int vb1, bf16x8 pa0, bf16x8 pa1, bf16x8 pa2, bf16x8 pa3) {
  pv_one<0>(o[0], vb0, vb1, pa0, pa1, pa2, pa3); pv_one<1>(o[1], vb0, vb1, pa0, pa1, pa2, pa3);
  pv_one<2>(o[2], vb0, vb1, pa0, pa1, pa2, pa3); pv_one<3>(o[3], vb0, vb1, pa0, pa1, pa2, pa3);
}

__device__ void phase4(const Args& a, char* lds) {
  unsigned char* ws = a.ws;
  const int tid = threadIdx.x, wid = tid >> 6, lane = tid & 63, r32 = lane & 31, hi = lane >> 5;
  const u16* Qg = (const u16*)(ws + WS_Q); const u16* KVg = (const u16*)(ws + WS_KV); const u16* WUV = (const u16*)(ws + WS_WUV);
  u16* Y = (u16*)(ws + WS_Y);
  char* gl = lds + LDS_DATA;
  char* kvl = gl;
  float* wsl = (float*)(gl + 2 * KVBUF) + wid * 64; float* li_l = wsl; float* al_l = wsl + 32;
  char* Ol = gl + 2 * KVBUF + 2048 + wid * 8704;
  float* Yl = (float*)gl;
  const int head = wid >> 1, qh = wid & 1;
  int sdst[3];
#pragma unroll
  for (int j = 0; j < 3; ++j) { const int id = tid + 512 * j, key = id / 24, ch = id % 24;
    sdst[j] = ch < 16 ? (int)off_a(key, ch) : 16384 + key * 128 + (((ch - 16) ^ ((key >> 1) & 7)) << 4); }
  const int xq = (r32 >> 2) & 3;
  const int ke = 2048 * (r32 >> 3) + 64 * (r32 & 7) + 16 * (hi ^ xq), ko = 2048 * (r32 >> 3) + 64 * (r32 & 7) + 16 * ((2 + hi) ^ xq);
  const int kr = r32 * 128 + ((hi ^ ((r32 >> 1) & 7)) << 4);
  const int tb = lane >> 4 & 1, tq = (lane & 15) >> 2, tp = lane & 3;
  const int vbl = 2048 * hi + 64 * tq + 32 * (tb ^ hi) + 8 * (tp & 1);
  const int lbase = (int)(uintptr_t)kvl;
  const int vb0 = lbase + vbl + 16 * (tp >> 1), vb1 = lbase + vbl + 256 + 16 * ((tp >> 1) ^ 1);
  for (int u = blockIdx.x; u < 256; u += gridDim.x) {
    const int b = u >> 6, qb = u & 63;
    const size_t tok0 = (size_t)b * SEQ + qb * 64 + qh * 32;
    const u16* KVb = KVg + (size_t)b * SEQ * 192;
    float m_reg = -1e30f, l_reg = 0.f; f32x16 o[4]; bf16x8 qr[12];
#pragma unroll
    for (int d = 0; d < 4; ++d)
#pragma unroll
      for (int r = 0; r < 16; ++r) o[d][r] = 0.f;
    { const u16* Qw = Qg + (tok0 + r32) * 768 + head * 192 + hi * 8;
#pragma unroll
      for (int d0 = 0; d0 < 12; ++d0) qr[d0] = *(const bf16x8*)(Qw + d0 * 16); }
    u32x4 st0[3];
#define SLOAD(S, k0) do { const u16* _p = KVb + (size_t)(k0) * 192 + tid * 8; S[0] = *(const u32x4*)_p; S[1] = *(const u32x4*)(_p + 4096); S[2] = *(const u32x4*)(_p + 8192); } while (0)
#define SWRITE(bufi, S) do { char* _d = kvl + (bufi) * KVBUF; *(u32x4*)(_d + sdst[0]) = S[0]; *(u32x4*)(_d + sdst[1]) = S[1]; *(u32x4*)(_d + sdst[2]) = S[2]; } while (0)
#define RESC(al) do { if (__any((al) < 1.f)) { if (hi == 0) al_l[r32] = (al); asm volatile("s_waitcnt lgkmcnt(0)" ::: "memory"); \
    _Pragma("unroll") for (int d = 0; d < 4; ++d) _Pragma("unroll") for (int r = 0; r < 16; ++r) o[d][r] *= al_l[crow(r, hi)]; } } while (0)
    constexpr int NT = SEQ / 64;
    __syncthreads();
    SLOAD(st0, 0); SWRITE(0, st0); SLOAD(st0, 64); __syncthreads();
    for (int j = 0; j < NT; ++j) {
      const int bo = (j & 1) * KVBUF;
      f32x16 p0, p1; float mn, al; bf16x8 pa0, pa1, pa2, pa3;
      qkt192(p0, p1, kvl + bo, qr, ke, ko, kr);
      partialSM(p0, p1, m_reg, mn, al);
      RESC(al);
      finishSM(p0, p1, al, l_reg, pa0, pa1, pa2, pa3);
      if (j + 1 < NT) { SWRITE((j + 1) & 1, st0); if (j + 2 < NT) SLOAD(st0, (j + 2) * 64); }
      SBAR();
      pv_all(o, vb0 + bo, vb1 + bo, pa0, pa1, pa2, pa3);
      __syncthreads();
    }
#undef SLOAD
#undef SWRITE
#undef RESC
    int r32e = r32, hie = hi, lne = lane;
    asm volatile("" : "+v"(r32e), "+v"(hie), "+v"(lne));
    if (hie == 0) li_l[r32e] = l_reg;
    asm volatile("s_waitcnt lgkmcnt(0)" ::: "memory");
#pragma unroll
    for (int r = 0; r < 16; ++r) {
      const int q = crow(r, hie); const float rl = __builtin_amdgcn_rcpf(li_l[q]);
#pragma unroll
      for (int d = 0; d < 4; ++d) *(u16*)(Ol + q * 272 + (32 * d + r32e) * 2) = f2bf(o[d][r] * rl);
    }
    asm volatile("s_waitcnt lgkmcnt(0)" ::: "memory");
    f32x16 y[4];
#pragma unroll
    for (int n = 0; n < 4; ++n)
#pragma unroll
      for (int r = 0; r < 16; ++r) y[n][r] = 0.f;
    const u16* wuv = WUV + ((size_t)head * 128 + r32e) * 128 + 8 * hie;
#pragma unroll 2
    for (int s = 0; s < 8; ++s) {
      const bf16x8 af = *(const bf16x8*)(Ol + r32e * 272 + (16 * s + 8 * hie) * 2);
#pragma unroll
      for (int n = 0; n < 4; ++n) {
        const bf16x8 bw = *(const bf16x8*)(wuv + 32 * n * 128 + 16 * s);
        y[n] = MFMA32(af, bw, y[n]);
      }
    }
    __syncthreads();
#pragma unroll
    for (int n = 0; n < 4; ++n)
#pragma unroll
      for (int r = 0; r < 16; ++r) Yl[(qh * 32 + crow(r, hie)) * 513 + head * 128 + 32 * n + r32e] = y[n][r];
    __syncthreads();
    for (int i = 0; i < 8; ++i) {
      const int pl = wid * 8 + i; const size_t tok = (size_t)b * SEQ + qb * 64 + pl;
      float v[8], ssq = 0.f;
#pragma unroll
      for (int jj = 0; jj < 8; ++jj) { v[jj] = Yl[pl * 513 + lne + 64 * jj]; ssq += v[jj] * v[jj]; }
      ssq = wave_sum(ssq);
      const float rstd = rsqrtf(ssq * (1.f / 512.f) + EPS);
#pragma unroll
      for (int jj = 0; jj < 8; ++jj) { const int col = lne + 64 * jj; Y[tok * 1024 + col] = f2bf(v[jj] * rstd * a.g_attn_out[col]); }
    }
    __syncthreads();
  }
}

__device__ void phase5(const Args& a, char* lds) {
  unsigned char* ws = a.ws;
  const int tid = threadIdx.x, lane = tid & 63, wv = tid >> 6;
  const u16* Y = (const u16*)(ws + WS_Y); const u16* WO = (const u16*)(ws + WS_WO);
  float* X1 = (float*)(ws + WS_X1); float* SSQ = (float*)(ws + WS_SSQ); const float* mod = (const float*)(ws + WS_MOD);
  char* gl = lds + LDS_DATA; float* Cl = (float*)gl;
  for (int u = blockIdx.x; u < 128 * 4; u += gridDim.x) {
    const int mt = u >> 2, nt = u & 3, R0 = mt * 128, b = R0 >> 12;
    f32x16 acc[2][2];
    gemm_128x256(Y + (size_t)R0 * 1024, 1024, WO + (size_t)(nt * 256) * 1024, 1024, 16, acc, gl);
    acc_to_lds(acc, Cl);
    __syncthreads();
    float g1[4];
#pragma unroll
    for (int j = 0; j < 4; ++j) g1[j] = mod[b * 6144 + 2048 + nt * 256 + lane + 64 * j];
    for (int i = 0; i < 16; ++i) {
      const int row = wv * 16 + i; const size_t tok = R0 + row; float ssq = 0.f;
#pragma unroll
      for (int j = 0; j < 4; ++j) {
        const int col = nt * 256 + lane + 64 * j;
        const float v = a.x[tok * 1024 + col] + g1[j] * Cl[row * CLD + lane + 64 * j];
        X1[tok * 1024 + col] = v; ssq += v * v;
      }
      ssq = wave_sum(ssq);
      if (lane == 0) SSQ[tok * 4 + nt] = ssq;
    }
    __syncthreads();
  }
}
__device__ void phase5b(const Args& a) {
  unsigned char* ws = a.ws;
  const int tid = threadIdx.x, lane = tid & 63, wv = tid >> 6;
  const float* X1 = (const float*)(ws + WS_X1); const float* SSQ = (const float*)(ws + WS_SSQ); const float* mod = (const float*)(ws + WS_MOD);
  u16* H = (u16*)(ws + WS_H);
  for (int u = blockIdx.x; u < T / 64; u += gridDim.x) {
    const int b = u >> 6;
    float4 sh[4], sc[4], g[4];
#pragma unroll
    for (int j = 0; j < 4; ++j) {
      const int col = j * 256 + lane * 4;
      sh[j] = *(const float4*)(mod + b * 6144 + 3072 + col); sc[j] = *(const float4*)(mod + b * 6144 + 4096 + col); g[j] = *(const float4*)(a.g_norm2 + col);
    }
    for (int i = 0; i < 8; ++i) {
      const size_t r = (size_t)u * 64 + wv * 8 + i;
      const float4 sq = *(const float4*)(SSQ + r * 4);
      const float rstd = rsqrtf((sq.x + sq.y + sq.z + sq.w) * (1.f / 1024.f) + EPS);
#pragma unroll
      for (int j = 0; j < 4; ++j) {
        const int col = j * 256 + lane * 4;
        const float4 xv = *(const float4*)(X1 + r * 1024 + col);
        const float h0 = xv.x * rstd * g[j].x * (1.f + sc[j].x) + sh[j].x, h1 = xv.y * rstd * g[j].y * (1.f + sc[j].y) + sh[j].y;
        const float h2 = xv.z * rstd * g[j].z * (1.f + sc[j].z) + sh[j].z, h3 = xv.w * rstd * g[j].w * (1.f + sc[j].w) + sh[j].w;
        uint2 o = {pack2(h0, h1), pack2(h2, h3)};
        *(uint2*)(H + r * 1024 + col) = o;
      }
    }
  }
}

__device__ __forceinline__ float vmaxf(float a, float b) { float r; asm("v_max_f32 %0, %1, %2" : "=v"(r) : "v"(a), "v"(b)); return r; }
__device__ __forceinline__ float vminf(float a, float b) { float r; asm("v_min_f32 %0, %1, %2" : "=v"(r) : "v"(a), "v"(b)); return r; }
#define TOP_INSERT(t, v) do { float _v = (v); _Pragma("unroll") for (int _i = 0; _i < 16; ++_i) { const float _h = vmaxf(t[_i], _v); _v = vminf(t[_i], _v); t[_i] = _h; } } while (0)

__device__ void phase6(const Args& a, char* lds) {
  unsigned char* ws = a.ws;
  const int tid = threadIdx.x, lane = tid & 63, wv = tid >> 6, r32 = lane & 31, hi = lane >> 5;
  const u16* H = (const u16*)(ws + WS_H); const u16* WPQ = (const u16*)(ws + WS_WPQ); const u16* KEYS = (const u16*)(ws + WS_KEYS);
  uint2* TOPK = (uint2*)(ws + WS_TOPK);
  char* gl = lds + LDS_DATA;
  char* Ql = gl;
  float* TK = (float*)(gl + 67584);
  for (int u = blockIdx.x; u < 128 * 8; u += gridDim.x) {
    const int mt = u >> 3, hd = u & 7, R0 = mt * 128;
    f32x16 acc[2][2];
    gemm_128x256(H + (size_t)R0 * 1024, 1024, WPQ + (size_t)(hd * 256) * 1024, 1024, 16, acc, gl);
    { const int wm = wv >> 2, wn = wv & 3;
#pragma unroll
      for (int m = 0; m < 2; ++m)
#pragma unroll
        for (int n = 0; n < 2; ++n)
#pragma unroll
          for (int r = 0; r < 16; ++r) *(u16*)(Ql + (64 * wm + 32 * m + crow(r, hi)) * 528 + (64 * wn + 32 * n + r32) * 2) = f2bf(acc[m][n][r]); }
    __syncthreads();
    {
      const int half = wv & 1, tb = wv >> 1;
      f32x16 sc[4];
#pragma unroll
      for (int k = 0; k < 4; ++k)
#pragma unroll
        for (int r = 0; r < 16; ++r) sc[k][r] = 0.f;
#pragma unroll
      for (int s = 0; s < 8; ++s) {
        const bf16x8 bq = *(const bf16x8*)(Ql + (32 * tb + r32) * 528 + (half * 128 + 16 * s + 8 * hi) * 2);
#pragma unroll
        for (int k = 0; k < 4; ++k) {
          const bf16x8 ak = *(const bf16x8*)(KEYS + ((size_t)(hd * 2 + half) * 128 + 32 * k + r32) * 128 + 16 * s + 8 * hi);
          sc[k] = MFMA32(ak, bq, sc[k]);
        }
      }
      float t[16];
#pragma unroll
      for (int i = 0; i < 16; ++i) t[i] = __uint_as_float(0xff800000u);
#pragma unroll
      for (int k = 0; k < 4; ++k)
#pragma unroll
        for (int r = 0; r < 16; ++r) {
          const unsigned key = 32 * k + crow(r, hi);
          TOP_INSERT(t, __uint_as_float((__float_as_uint(sc[k][r]) & ~127u) | key));
        }
      float p[16];
#pragma unroll
      for (int i = 0; i < 16; ++i) {
        auto rr = __builtin_amdgcn_permlane32_swap(__float_as_uint(t[i]), __float_as_uint(t[i]), false, false);
        p[i] = __uint_as_float(hi ? rr[0] : rr[1]);
      }
#pragma unroll
      for (int i = 0; i < 16; ++i) TOP_INSERT(t, p[i]);
      if (hi == 0) {
        float* dst = TK + ((size_t)half * 128 + 32 * tb + r32) * 16;
#pragma unroll
        for (int i = 0; i < 16; i += 4) *(float4*)(dst + i) = make_float4(t[i], t[i + 1], t[i + 2], t[i + 3]);
      }
    }
    __syncthreads();
    if (tid < 128) {
      float v1[16], v2[16], t[16];
#pragma unroll
      for (int i = 0; i < 16; i += 4) {
        const float4 x = *(const float4*)(TK + (size_t)tid * 16 + i), y = *(const float4*)(TK + (size_t)(128 + tid) * 16 + i);
        v1[i] = x.x; v1[i + 1] = x.y; v1[i + 2] = x.z; v1[i + 3] = x.w; v2[i] = y.x; v2[i + 1] = y.y; v2[i + 2] = y.z; v2[i + 3] = y.w;
      }
#pragma unroll
      for (int i = 0; i < 16; ++i) t[i] = __uint_as_float(0xff800000u);
#pragma unroll
      for (int i = 0; i < 16; ++i)
#pragma unroll
        for (int j = 0; j < 16; ++j)
          if ((i + 1) * (j + 1) <= 16) TOP_INSERT(t, __uint_as_float((__float_as_uint(v1[i] + v2[j]) & ~255u) | (unsigned)(i * 16 + j)));
      float e[16], sum = 0.f; unsigned ex[16];
      const float m0 = __uint_as_float(__float_as_uint(t[0]) & ~255u);
#pragma unroll
      for (int i = 0; i < 16; ++i) {
        const unsigned bits = __float_as_uint(t[i]), id = bits & 255u;
        const unsigned i1 = __float_as_uint(TK[(size_t)tid * 16 + (id >> 4)]) & 127u, i2 = __float_as_uint(TK[(size_t)(128 + tid) * 16 + (id & 15u)]) & 127u;
        ex[i] = i1 * 128u + i2;
        e[i] = __expf(__uint_as_float(bits & ~255u) - m0); sum += e[i];
      }
      const float inv = 1.f / sum;
      uint2* dst = TOPK + ((size_t)(R0 + tid) * 8 + hd) * 16;
#pragma unroll
      for (int i = 0; i < 16; i += 2) {
        uint4 o = {ex[i], __float_as_uint(e[i] * inv), ex[i + 1], __float_as_uint(e[i + 1] * inv)};
        *(uint4*)(dst + i) = o;
      }
    }
    __syncthreads();
  }
}

typedef __attribute__((ext_vector_type(4))) float f32x4;
#define MFMA4(a, b, c) __builtin_amdgcn_mfma_f32_4x4x4bf16_1k((a), (b), (c), 0, 0, 0)
constexpr int P7_VROW = 2112, P7_VBUF = 4 * P7_VROW;
constexpr int P7_RING = 64;
constexpr int P7_ENT  = P7_RING + 8 * 2 * P7_VBUF;
constexpr int P7_CNT  = P7_ENT + 8 * 2048;
static_assert(P7_CNT + 8 * 256 <= LDS_BYTES, "phase 7 LDS map");

__device__ __forceinline__ void dma16(const void* gsrc, unsigned lds_dst) {
  unsigned keep;
  asm volatile("s_mov_b32 %0, m0\n\ts_mov_b32 m0, %2\n\ts_nop 0\n\tglobal_load_lds_dwordx4 %1, off\n\ts_mov_b32 m0, %0"
               : "=&s"(keep) : "v"(gsrc), "s"(lds_dst) : "memory");
}
__device__ __forceinline__ float sel4(const f32x4& d, int k) { return k == 0 ? d[0] : (k == 1 ? d[1] : (k == 2 ? d[2] : d[3])); }
#define P7_ULOAD(dst, ptr, OFF) asm volatile("global_load_dwordx4 %0, %1, off offset:" #OFF : "=v"(dst) : "v"(ptr) : "memory")

__device__ void phase7(const Args& a, char* lds) {
  unsigned char* ws = a.ws;
  const int tid = threadIdx.x, lane = tid & 63, wv = __builtin_amdgcn_readfirstlane(tid >> 6), blk = lane >> 2, j4 = lane & 3;
  const u16* H = (const u16*)(ws + WS_H); const u16* UB = (const u16*)(ws + WS_UB); const u16* VB = (const u16*)(ws + WS_VB);
  const uint2* TOPK = (const uint2*)(ws + WS_TOPK); const float* X1 = (const float*)(ws + WS_X1); const float* mod = (const float*)(ws + WS_MOD);
  const unsigned lbase = (unsigned)(uintptr_t)lds;
  const unsigned ring_a = __builtin_amdgcn_readfirstlane(lbase + P7_RING + wv * 2 * P7_VBUF);
  unsigned* ents = (unsigned*)(lds + P7_ENT + wv * 2048);
  int* cntw = (int*)(lds + P7_CNT + wv * 256);
  const int trb = (int)(lbase + P7_RING + wv * 2 * P7_VBUF) + ((lane & 15) >> 2) * P7_VROW + 32 * (lane >> 4) + 8 * (lane & 3);
  const int NWV = gridDim.x * 8;
  for (int qd = blockIdx.x * 8 + wv; qd < T / 4; qd += NWV) {
    const int tok0 = qd * 4, b = tok0 >> 12;
    cntw[lane] = 0;
    asm volatile("s_waitcnt lgkmcnt(0)" ::: "memory");
    {
      uint2 en[8];
#pragma unroll
      for (int i = 0; i < 8; ++i) { const int e = lane + 64 * i; en[i] = TOPK[(size_t)(tok0 + (e >> 7)) * 128 + (e & 127)]; }
#pragma unroll
      for (int i = 0; i < 8; ++i) atomicAdd(&cntw[en[i].x >> 8], 1);
      asm volatile("s_waitcnt lgkmcnt(0)" ::: "memory");
      const int c = cntw[lane]; int inc = c;
#pragma unroll
      for (int o = 1; o < 64; o <<= 1) { const int v = __shfl_up(inc, o, 64); if (lane >= o) inc += v; }
      asm volatile("s_waitcnt lgkmcnt(0)" ::: "memory");
      cntw[lane] = inc - c;
      asm volatile("s_waitcnt lgkmcnt(0)" ::: "memory");
#pragma unroll
      for (int i = 0; i < 8; ++i) {
        const int e = lane + 64 * i;
        const int pos = atomicAdd(&cntw[en[i].x >> 8], 1);
        ents[pos] = en[i].x | ((unsigned)(e >> 7) << 14) | (pack2(0.f, __uint_as_float(en[i].y)) & 0xFFFF0000u);
      }
      asm volatile("s_waitcnt lgkmcnt(0)" ::: "memory");
    }
    u32x4 hA[8];
#pragma unroll
    for (int t = 0; t < 8; ++t) hA[t] = *(const u32x4*)(H + (size_t)(tok0 + j4) * 1024 + 128 * t + 8 * blk);
    f32x4 acc[16];
#pragma unroll
    for (int c = 0; c < 16; ++c) acc[c] = (f32x4){0.f, 0.f, 0.f, 0.f};
#define P7_ISSUE_V(g, EN) do { _Pragma("unroll") for (int _q = 0; _q < 4; ++_q) {                                              \
      const unsigned _eq = (unsigned)__builtin_amdgcn_readlane((int)((EN) & 0x3FFFu), _q);                                      \
      const u16* _src = VB + (size_t)_eq * 1024 + lane * 8; const unsigned _dst = ring_a + ((g) & 1) * P7_VBUF + _q * P7_VROW;    \
      dma16(_src, _dst); dma16(_src + 512, _dst + 1024); } } while (0)
#define P7_VPHASE(bufi) do { const int _vb = trb + (bufi) * P7_VBUF;                                                            \
      { const s16x4 v0 = tr_read<0>(_vb), v1 = tr_read<128>(_vb), v2 = tr_read<256>(_vb), v3 = tr_read<384>(_vb),               \
                    v4 = tr_read<512>(_vb), v5 = tr_read<640>(_vb), v6 = tr_read<768>(_vb), v7 = tr_read<896>(_vb);               \
        asm volatile("s_waitcnt lgkmcnt(0)" ::: "memory"); SBAR();                                                                \
        acc[0] = MFMA4(awp, v0, acc[0]); acc[1] = MFMA4(awp, v1, acc[1]); acc[2] = MFMA4(awp, v2, acc[2]); acc[3] = MFMA4(awp, v3, acc[3]);   \
        acc[4] = MFMA4(awp, v4, acc[4]); acc[5] = MFMA4(awp, v5, acc[5]); acc[6] = MFMA4(awp, v6, acc[6]); acc[7] = MFMA4(awp, v7, acc[7]); } \
      { const s16x4 v0 = tr_read<1024>(_vb), v1 = tr_read<1152>(_vb), v2 = tr_read<1280>(_vb), v3 = tr_read<1408>(_vb),         \
                    v4 = tr_read<1536>(_vb), v5 = tr_read<1664>(_vb), v6 = tr_read<1792>(_vb), v7 = tr_read<1920>(_vb);           \
        asm volatile("s_waitcnt lgkmcnt(0)" ::: "memory"); SBAR();                                                                \
        acc[8] = MFMA4(awp, v0, acc[8]); acc[9] = MFMA4(awp, v1, acc[9]); acc[10] = MFMA4(awp, v2, acc[10]); acc[11] = MFMA4(awp, v3, acc[11]); \
        acc[12] = MFMA4(awp, v4, acc[12]); acc[13] = MFMA4(awp, v5, acc[13]); acc[14] = MFMA4(awp, v6, acc[14]); acc[15] = MFMA4(awp, v7, acc[15]); } } while (0)
    unsigned enc = ents[j4];
    asm volatile("s_waitcnt vmcnt(0)" ::: "memory");
    P7_ISSUE_V(0, enc);
    s16x4 awp = {0, 0, 0, 0};
    constexpr int NG = 128;
    for (int g = 0; g < NG; ++g) {
      const u16* pu = UB + (size_t)(enc & 0x3FFFu) * 1024 + 8 * blk;
      u32x4 u[8];
      P7_ULOAD(u[0], pu, 0); P7_ULOAD(u[1], pu, 256); P7_ULOAD(u[2], pu, 512); P7_ULOAD(u[3], pu, 768);
      P7_ULOAD(u[4], pu, 1024); P7_ULOAD(u[5], pu, 1280); P7_ULOAD(u[6], pu, 1536); P7_ULOAD(u[7], pu, 1792);
      if (g > 0) P7_VPHASE((g - 1) & 1);
      unsigned enn = 0u;
      if (g + 1 < NG) { enn = ents[4 * (g + 1) + j4]; P7_ISSUE_V(g + 1, enn);
        asm volatile("s_waitcnt vmcnt(8)" : "+v"(u[0]), "+v"(u[1]), "+v"(u[2]), "+v"(u[3]), "+v"(u[4]), "+v"(u[5]), "+v"(u[6]), "+v"(u[7]) :: "memory"); }
      else asm volatile("s_waitcnt vmcnt(0)" : "+v"(u[0]), "+v"(u[1]), "+v"(u[2]), "+v"(u[3]), "+v"(u[4]), "+v"(u[5]), "+v"(u[6]), "+v"(u[7]) :: "memory");
      f32x4 d = {0.f, 0.f, 0.f, 0.f};
#pragma unroll
      for (int t = 0; t < 8; ++t) {
        const uint2 hl = {hA[t][0], hA[t][1]}, hh = {hA[t][2], hA[t][3]}, ul = {u[t][0], u[t][1]}, uh = {u[t][2], u[t][3]};
        d = MFMA4(__builtin_bit_cast(s16x4, hl), __builtin_bit_cast(s16x4, ul), d);
        d = MFMA4(__builtin_bit_cast(s16x4, hh), __builtin_bit_cast(s16x4, uh), d);
      }
#pragma unroll
      for (int r = 0; r < 4; ++r) { float v = d[r]; v += __shfl_xor(v, 4, 64); v += __shfl_xor(v, 8, 64); v += __shfl_xor(v, 16, 64); v += __shfl_xor(v, 32, 64); d[r] = v; }
      const int tk = (enc >> 14) & 3;
      const float wgt = gelu_exact(sel4(d, tk)) * __uint_as_float(enc & 0xFFFF0000u);
      float z[4];
#pragma unroll
      for (int k = 0; k < 4; ++k) { const float wk = __shfl(wgt, (lane & ~3) | k, 64); const int tkk = __shfl(tk, (lane & ~3) | k, 64); z[k] = (tkk == j4) ? wk : 0.f; }
      { const uint2 pk = {pack2(z[0], z[1]), pack2(z[2], z[3])}; awp = __builtin_bit_cast(s16x4, pk); }
      enc = enn;
    }
    P7_VPHASE((NG - 1) & 1);
#undef P7_ISSUE_V
#undef P7_VPHASE
    int lne = lane; asm volatile("" : "+v"(lne));
    float ss[4] = {0.f, 0.f, 0.f, 0.f};
#pragma unroll
    for (int c = 0; c < 16; ++c) {
      const float g2 = mod[b * 6144 + 5120 + 64 * c + lne];
#pragma unroll
      for (int r = 0; r < 4; ++r) { const float v = X1[(size_t)(tok0 + r) * 1024 + 64 * c + lne] + g2 * acc[c][r]; acc[c][r] = v; ss[r] += v * v; }
    }
    float rstd[4];
#pragma unroll
    for (int r = 0; r < 4; ++r) rstd[r] = rsqrtf(wave_sum(ss[r]) * (1.f / 1024.f) + EPS);
#pragma unroll
    for (int c = 0; c < 16; ++c) {
      const float gf = a.g_final[64 * c + lne];
#pragma unroll
      for (int r = 0; r < 4; ++r) a.out[(size_t)(tok0 + r) * 1024 + 64 * c + lne] = acc[c][r] * rstd[r] * gf;
    }
  }
}

constexpr int N_PHASES = 9;
__global__ void __launch_bounds__(512, 2) fwd(Args args) {
  extern __shared__ __attribute__((aligned(16))) char lds[];
  if (threadIdx.x == 0) *(uint4*)lds = make_uint4(0u, 0u, 0u, 0u);
  __syncthreads();
  const int lo = args.ph_lo, hi = args.ph_hi;
  XcdBarrier bar; bar.bar = (unsigned*)(args.ws + WS_BAR); bar.x = 0; bar.st = (volatile LAS unsigned*)lds;
  if (hi - lo > 1) bar = xcd_barrier_post((unsigned*)(args.ws + WS_BAR), (volatile LAS unsigned*)lds);
#ifndef ONLY_PHASE
#define ONLY_PHASE -1
#endif
#define IN(k) (lo <= (k) && (k) < hi && (ONLY_PHASE < 0 || ONLY_PHASE == (k)))
#define SEAM(k) do { if (IN(k) && IN((k) + 1)) xcd_barrier(bar); } while (0)
  if (IN(0)) phase0(args);
  SEAM(0);
  if (IN(1)) phase1(args, lds);
  SEAM(1);
  if (IN(2)) phase2(args, lds);
  SEAM(2);
  if (IN(3)) phase3(args, lds);
  SEAM(3);
  if (IN(4)) phase4(args, lds);
  SEAM(4);
  if (IN(5)) phase5(args, lds);
  SEAM(5);
  if (IN(6)) phase5b(args);
  SEAM(6);
  if (IN(7)) phase6(args, lds);
  SEAM(7);
  if (IN(8)) phase7(args, lds);
#undef IN
#undef SEAM
}

extern "C" void kernel_launch(void* const* d_in, const int* in_sizes, int n_in, void* d_out, int out_size, void* d_ws, size_t ws_size, hipStream_t stream) {
  static int grid = 0;
  if (grid == 0) {
    if (n_in != 23 || out_size != T * DM || ws_size < WS_END) { fprintf(stderr, "kernel_launch: unexpected shapes (n_in %d out %d ws %zu need %zu)\n", n_in, out_size, ws_size, (size_t)WS_END); grid = -1; return; }
    int dev = 0, cus = 0, per_cu = 0;
    (void)hipGetDevice(&dev); (void)hipDeviceGetAttribute(&cus, hipDeviceAttributeMultiprocessorCount, dev);
    if (hipFuncSetAttribute((const void*)fwd, hipFuncAttributeMaxDynamicSharedMemorySize, LDS_BYTES) != hipSuccess) { fprintf(stderr, "kernel_launch: hipFuncSetAttribute failed\n"); grid = -1; return; }
    if (hipOccupancyMaxActiveBlocksPerMultiprocessor(&per_cu, (const void*)fwd, 512, LDS_BYTES) != hipSuccess || per_cu < 1) { fprintf(stderr, "kernel_launch: occupancy query says %d\n", per_cu); per_cu = 1; }
    (void)hipGetLastError();
    grid = cus;
  }
  if (grid < 0) return;
  (void)hipMemsetAsync((char*)d_ws + WS_BAR, 0, 16384, stream);
  Args a{};
  a.x = (const float*)d_in[0]; a.c = (const float*)d_in[1]; a.pos = (const int*)d_in[2];
  a.w_ada = (const float*)d_in[3]; a.b_ada = (const float*)d_in[4]; a.g_norm1 = (const float*)d_in[5]; a.w_in = (const float*)d_in[6];
  a.g_q_a = (const float*)d_in[7]; a.w_uq = (const float*)d_in[8]; a.g_kv_a = (const float*)d_in[9]; a.w_ukv = (const float*)d_in[10];
  a.g_sg = (const float*)d_in[11]; a.w_sg = (const float*)d_in[12]; a.b_sg = (const float*)d_in[13]; a.g_attn_out = (const float*)d_in[14];
  a.g_sg_out = (const float*)d_in[15]; a.w_o = (const float*)d_in[16]; a.g_norm2 = (const float*)d_in[17]; a.w_peer_q = (const float*)d_in[18];
  a.peer_keys = (const float*)d_in[19]; a.peer_u = (const float*)d_in[20]; a.peer_v = (const float*)d_in[21]; a.g_final = (const float*)d_in[22];
  a.out = (float*)d_out; a.ws = (unsigned char*)d_ws;
#if N_LAUNCH_MODE == 0
  a.ph_lo = 0; a.ph_hi = N_PHASES;
  hipLaunchKernelGGL(fwd, dim3(grid), dim3(512), LDS_BYTES, stream, a);
#else
  for (int p = 0; p < N_PHASES; ++p) for (int rep = 0; rep <= ((DUP_MASK >> p) & 1); ++rep) { a.ph_lo = p; a.ph_hi = p + 1; hipLaunchKernelGGL(fwd, dim3(grid), dim3(512), LDS_BYTES, stream, a); }
#endif
  const hipError_t le = hipPeekAtLastError();
  if (le != hipSuccess) fprintf(stderr, "kernel_launch: launch failed: %s\n", hipGetErrorName(le));
}
```

```cpp
#include <hip/hip_runtime.h>
#include <stdint.h>
#include <stdio.h>

#define N_LAUNCH_MODE 0
#define DUP_MASK 0x000

typedef unsigned short u16;
typedef __attribute__((ext_vector_type(8))) short bf16x8;
typedef __attribute__((ext_vector_type(4))) short s16x4;
typedef __attribute__((ext_vector_type(16))) float f32x16;
typedef __attribute__((ext_vector_type(4))) unsigned u32x4;

constexpr int T = 16384, DM = 1024, SEQ = 4096;
constexpr float EPS = 1e-6f;

constexpr size_t WS_BAR  = 0;
constexpr size_t WS_MODP = 16384;
constexpr size_t WS_MOD  = WS_MODP + 786432;
constexpr size_t WS_CS   = WS_MOD + 98304;
constexpr size_t WS_WIN  = WS_CS + 4194304;
constexpr size_t WS_WQ2  = WS_WIN + 3145728;
constexpr size_t WS_WUV  = WS_WQ2 + 393216;
constexpr size_t WS_WO   = WS_WUV + 131072;
constexpr size_t WS_WPQ  = WS_WO + 2097152;
constexpr size_t WS_KEYS = WS_WPQ + 4194304;
constexpr size_t WS_WSG  = WS_KEYS + 524288;
constexpr size_t WS_UB   = WS_WSG + 131072;
constexpr size_t WS_VB   = WS_UB + 33554432;
constexpr size_t WS_H    = WS_VB + 33554432;
constexpr size_t WS_Y    = WS_H + 33554432;
constexpr size_t WS_KV   = WS_Y + 33554432;
constexpr size_t WS_TOPK = WS_KV + 6291456;
constexpr size_t WS_SSQ  = WS_TOPK + 16777216;
constexpr size_t WS_SSQV = WS_SSQ + 262144;
constexpr size_t WS_R1   = WS_SSQV + 131072;
constexpr size_t WS_Q    = WS_R1;
constexpr size_t WS_QA   = WS_Q + 25165824;
constexpr size_t WS_UACT = WS_QA + 8388608;
constexpr size_t WS_GVT  = WS_UACT + 16777216;
constexpr size_t WS_X1   = WS_R1;
constexpr size_t WS_END  = WS_R1 + 67108864;

constexpr int LDS_BYTES = 155648;
constexpr int LDS_DATA  = 64;

struct Args {
  const float *x, *c; const int* pos;
  const float *w_ada, *b_ada, *g_norm1, *w_in, *g_q_a, *w_uq, *g_kv_a, *w_ukv, *g_sg, *w_sg, *b_sg, *g_attn_out, *g_sg_out,
              *w_o, *g_norm2, *w_peer_q, *peer_keys, *peer_u, *peer_v, *g_final;
  float* out; unsigned char* ws; int ph_lo, ph_hi;
};

#define XB_TMO      128
#define XB_XCNT(j)  (256  + 64 * (j))
#define XB_XSUB(j)  (1280 + 64 * (j))
#define XB_XGEN(j)  (2304 + 64 * (j))
#define XB_TOP      3328
#define XB_TOPGEN   3392
#define XCD_BAR_WORDS 3456
#define XB_SPIN_CAP (1u << 18)
#define LAS __attribute__((address_space(3)))

__device__ __forceinline__ unsigned xb_ld(unsigned* p)              { return __hip_atomic_load(p, __ATOMIC_RELAXED, __HIP_MEMORY_SCOPE_AGENT); }
__device__ __forceinline__ unsigned xb_add(unsigned* p, unsigned v) { return __hip_atomic_fetch_add(p, v, __ATOMIC_RELAXED, __HIP_MEMORY_SCOPE_AGENT); }
__device__ __forceinline__ unsigned xb_xcc_id() { return (unsigned)__builtin_amdgcn_s_getreg((3 << 11) | 20) & 0xFu; }
#define XB_SPIN(cond, bar) do { unsigned _sp = 0; while (cond) { __builtin_amdgcn_s_sleep(1); \
    if ((++_sp & 255u) == 0u) { if (xb_ld(&(bar)[XB_TMO])) break; if (_sp > XB_SPIN_CAP) { atomicAdd(&(bar)[XB_TMO], 1u); break; } } } } while (0)

struct XcdBarrier { unsigned* bar; unsigned x; volatile LAS unsigned* st; };

__device__ __forceinline__ XcdBarrier xcd_barrier_post(unsigned* bar, volatile LAS unsigned* st) {
    XcdBarrier b; b.bar = bar; b.x = xb_xcc_id(); b.st = st;
    if (threadIdx.x == 0) (void)xb_add(&bar[XB_XCNT(b.x)], 1u);
    return b;
}
__device__ __forceinline__ void xcd_barrier_complete(unsigned* bar, unsigned x, unsigned& nloc, unsigned& nx) {
    const unsigned G = gridDim.x * gridDim.y * gridDim.z;
    unsigned sum, cnt, mine, sp = 0u;
    for (;;) {
        sum = 0u; cnt = 0u; mine = 0u;
#pragma unroll
        for (unsigned j = 0; j < 16; ++j) { const unsigned c = xb_ld(&bar[XB_XCNT(j)]); sum += c; cnt += (c > 0u) ? 1u : 0u; mine = (j == x) ? c : mine; }
        if (sum == G) break;
        __builtin_amdgcn_s_sleep(1);
        if ((++sp & 255u) == 0u) { if (xb_ld(&bar[XB_TMO])) break; if (sp > XB_SPIN_CAP) { atomicAdd(&bar[XB_TMO], 1u); break; } }
    }
    nloc = mine > 0u ? mine : 1u; nx = cnt > 0u ? cnt : 1u;
}
__device__ __forceinline__ void xcd_barrier(const XcdBarrier& b) {
    asm volatile("s_waitcnt vmcnt(0)" ::: "memory");
    __syncthreads();
    if (threadIdx.x == 0) {
        unsigned* bar = b.bar;
        __builtin_amdgcn_s_waitcnt(0);
        unsigned nloc = b.st[0], nx = b.st[1];
        if (nloc == 0u) { xcd_barrier_complete(bar, b.x, nloc, nx); b.st[0] = nloc; b.st[1] = nx; }
        const unsigned old = xb_add(&bar[XB_XSUB(b.x)], 1u);
        const unsigned gen = old / nloc;
        if (old + 1u == (gen + 1u) * nloc) {
            __builtin_amdgcn_fence(__ATOMIC_RELEASE, "agent");
            asm volatile("s_waitcnt vmcnt(0)" ::: "memory");
            const unsigned og = xb_add(&bar[XB_TOP], 1u);
            const unsigned tg = og / nx;
            if (og + 1u == (tg + 1u) * nx) xb_add(&bar[XB_TOPGEN], 1u);
            else XB_SPIN(xb_ld(&bar[XB_TOPGEN]) == tg, bar);
            __builtin_amdgcn_fence(__ATOMIC_ACQUIRE, "agent");
            xb_add(&bar[XB_XGEN(b.x)], 1u);
            asm volatile("s_waitcnt vmcnt(0)" ::: "memory");
        } else {
            XB_SPIN(xb_ld(&bar[XB_XGEN(b.x)]) == gen, bar);
            __builtin_amdgcn_fence(__ATOMIC_ACQUIRE, "agent");
            asm volatile("s_waitcnt vmcnt(0)" ::: "memory");
        }
    }
    __syncthreads();
}

__device__ __forceinline__ unsigned pack2(float lo, float hi) {
  typedef __attribute__((ext_vector_type(2))) float f2; typedef __attribute__((ext_vector_type(2))) __bf16 b2;
  f2 v = {lo, hi}; b2 r = __builtin_convertvector(v, b2); return __builtin_bit_cast(unsigned, r);
}
__device__ __forceinline__ u16 f2bf(float f) { return (u16)(pack2(f, 0.f) & 0xFFFFu); }
__device__ __forceinline__ float bflo(unsigned w) { return __uint_as_float(w << 16); }
__device__ __forceinline__ float bfhi(unsigned w) { return __uint_as_float(w & 0xFFFF0000u); }
__device__ __forceinline__ float gelu_exact(float x) {
  const float z = fabsf(x) * 0.70710678118654752f;
  const float t = __builtin_amdgcn_rcpf(fmaf(0.3275911f, z, 1.f));
  float p = fmaf(1.061405429f, t, -1.453152027f); p = fmaf(p, t, 1.421413741f); p = fmaf(p, t, -0.284496736f); p = fmaf(p, t, 0.254829592f);
  const float e = p * t * __expf(-z * z);
  const float erfz = 1.f - e;
  return 0.5f * x * (1.f + copysignf(erfz, x));
}
__device__ __forceinline__ float wave_sum(float v) {
#pragma unroll
  for (int o = 32; o > 0; o >>= 1) v += __shfl_xor(v, o, 64);
  return v;
}
__device__ __forceinline__ int crow(int r, int hi) { return (r & 3) + 8 * (r >> 2) + 4 * hi; }
#define MFMA32(a, b, c) __builtin_amdgcn_mfma_f32_32x32x16_bf16((a), (b), (c), 0, 0, 0)

template <int MAP> __device__ __forceinline__ int colmap(int n) {
  if (MAP == 0) return n;
  if (MAP == 1) return n < 448 ? n : (n < 512 ? -1 : n - 64);
  if (MAP == 2) return (n >> 6) * 192 + 128 + (n & 63);
  return (n >> 7) * 256 + 128 + (n & 127);
}
template <int MAP> __device__ void cvt_transpose(const float* __restrict__ src, int src_ld, int K, int N, u16* __restrict__ dst, int gtid, int gthreads) {
  const int total = N * (K >> 3);
  for (int idx = gtid; idx < total; idx += gthreads) {
    const int n = idx % N, k8 = idx / N, sc = colmap<MAP>(n);
    float v[8];
#pragma unroll
    for (int j = 0; j < 8; ++j) v[j] = sc < 0 ? 0.f : src[(size_t)(k8 * 8 + j) * src_ld + sc];
    u32x4 w = {pack2(v[0], v[1]), pack2(v[2], v[3]), pack2(v[4], v[5]), pack2(v[6], v[7])};
    *(u32x4*)(dst + (size_t)n * K + k8 * 8) = w;
  }
}
__device__ void cvt_direct(const float* __restrict__ src, u16* __restrict__ dst, size_t n8, int gtid, int gthreads) {
  for (size_t i = gtid; i < n8; i += gthreads) {
    const float4 a = *(const float4*)(src + i * 8), b = *(const float4*)(src + i * 8 + 4);
    u32x4 w = {pack2(a.x, a.y), pack2(a.z, a.w), pack2(b.x, b.y), pack2(b.z, b.w)};
    *(u32x4*)(dst + i * 8) = w;
  }
}
constexpr float PEER_SU = 32.f, PEER_SV = 4.f;
__device__ void cvt_fp8(const float* __restrict__ src, unsigned char* __restrict__ dst, size_t n16, float sc, int gtid, int gthreads) {
  for (size_t i = gtid; i < n16; i += gthreads) {
    u32x4 w;
#pragma unroll
    for (int k = 0; k < 4; ++k) {
      const float4 a = *(const float4*)(src + i * 16 + 4 * k);
      int p = __builtin_amdgcn_cvt_pk_fp8_f32(a.x * sc, a.y * sc, 0, false);
      p = __builtin_amdgcn_cvt_pk_fp8_f32(a.z * sc, a.w * sc, p, true);
      w[k] = (unsigned)p;
    }
    *(u32x4*)(dst + i * 16) = w;
  }
}
__device__ __forceinline__ void sincos_acc(float angf, float& sn, float& cs) {
  const double a = (double)angf;
  const double q = __builtin_rint(a * 0.63661977236758134308);
  double r = __builtin_fma(-q, 1.5707963267948966, a);
  r = __builtin_fma(-q, 6.123233995736766e-17, r);
  const double r2 = r * r;
  double s = r2 * (1.0 / 6227020800.0) - 1.0 / 39916800.0;
  s = s * r2 + 1.0 / 362880.0; s = s * r2 - 1.0 / 5040.0; s = s * r2 + 1.0 / 120.0; s = s * r2 - 1.0 / 6.0; s = r + r * r2 * s;
  double c = -r2 * (1.0 / 87178291200.0) + 1.0 / 479001600.0;
  c = c * r2 - 1.0 / 3628800.0; c = c * r2 + 1.0 / 40320.0; c = c * r2 - 1.0 / 720.0; c = c * r2 + 1.0 / 24.0; c = c * r2 - 0.5; c = 1.0 + r2 * c;
  const int n = ((int)q) & 3;
  const double ss = (n & 1) ? c : s, cc = (n & 1) ? s : c;
  sn = (float)((n & 2) ? -ss : ss);
  cs = (float)(((n + 1) & 2) ? -cc : cc);
}

__constant__ float INVF[32] = {1.000000000e+00f, 7.498942018e-01f, 5.623413324e-01f, 4.216965139e-01f, 3.162277639e-01f, 2.371373922e-01f, 1.778279394e-01f, 1.333521456e-01f,
  1.000000015e-01f, 7.498941571e-02f, 5.623412877e-02f, 4.216964915e-02f, 3.162277862e-02f, 2.371373586e-02f, 1.778279431e-02f, 1.333521493e-02f,
  9.999999776e-03f, 7.498942316e-03f, 5.623413250e-03f, 4.216964822e-03f, 3.162277862e-03f, 2.371373819e-03f, 1.778279431e-03f, 1.333521446e-03f,
  1.000000047e-03f, 7.498941850e-04f, 5.623413017e-04f, 4.216965463e-04f, 3.162277862e-04f, 2.371373848e-04f, 1.778279402e-04f, 1.333521504e-04f};
__device__ void phase0(const Args& a) {
  unsigned char* ws = a.ws;
  const int tid = threadIdx.x, lane = tid & 63, wv = tid >> 6;
  const int NWV = gridDim.x * 8, gw = blockIdx.x * 8 + wv;
  const int gthreads = gridDim.x * 512, gtid = blockIdx.x * 512 + tid;
  float* modp = (float*)(ws + WS_MODP);
  for (int job = gw; job < 768; job += NWV) {
    const int cg = job % 96, ks = job / 96, col = cg * 64 + lane;
    float a0 = 0.f, a1 = 0.f, a2 = 0.f, a3 = 0.f;
    const float* w = a.w_ada + (size_t)(ks * 128) * 6144 + col;
#pragma unroll 8
    for (int k = 0; k < 128; ++k) {
      const float wv_ = w[(size_t)k * 6144];
      const int kk = ks * 128 + k;
      const float c0 = a.c[kk], c1 = a.c[1024 + kk], c2 = a.c[2048 + kk], c3 = a.c[3072 + kk];
      a0 += (c0 / (1.f + __expf(-c0))) * wv_; a1 += (c1 / (1.f + __expf(-c1))) * wv_;
      a2 += (c2 / (1.f + __expf(-c2))) * wv_; a3 += (c3 / (1.f + __expf(-c3))) * wv_;
    }
    modp[(ks * 4 + 0) * 6144 + col] = a0; modp[(ks * 4 + 1) * 6144 + col] = a1;
    modp[(ks * 4 + 2) * 6144 + col] = a2; modp[(ks * 4 + 3) * 6144 + col] = a3;
  }
  cvt_transpose<1>(a.w_in, 1472, 1024, 1536, (u16*)(ws + WS_WIN), gtid, gthreads);
  cvt_transpose<0>(a.w_o, 1024, 1024, 1024, (u16*)(ws + WS_WO), gtid, gthreads);
  cvt_transpose<0>(a.w_peer_q, 2048, 1024, 2048, (u16*)(ws + WS_WPQ), gtid, gthreads);
  cvt_transpose<2>(a.w_uq, 768, 256, 256, (u16*)(ws + WS_WQ2) + 512 * 256, gtid, gthreads);
  cvt_transpose<3>(a.w_ukv, 1024, 128, 512, (u16*)(ws + WS_WUV), gtid, gthreads);
  {
    u16* wq2 = (u16*)(ws + WS_WQ2);
    for (int idx = gtid; idx < 512 * 256; idx += gthreads) {
      const int n = idx >> 8, i = idx & 255, h = n >> 7, cc = n & 127;
      const float* pu = a.w_uq + (size_t)i * 768 + h * 192;
      const float* pk = a.w_ukv + (size_t)cc * 1024 + h * 256;
      float s = 0.f;
#pragma unroll 8
      for (int d = 0; d < 128; d += 4) {
        const float4 u = *(const float4*)(pu + d), k = *(const float4*)(pk + d);
        s += u.x * k.x + u.y * k.y + u.z * k.z + u.w * k.w;
      }
      wq2[(size_t)n * 256 + i] = f2bf(s);
    }
  }
  cvt_direct(a.peer_keys, (u16*)(ws + WS_KEYS), 262144 / 8, gtid, gthreads);
  cvt_direct(a.w_sg, (u16*)(ws + WS_WSG), 65536 / 8, gtid, gthreads);
  cvt_fp8(a.peer_u, (unsigned char*)(ws + WS_UB), (size_t)16384 * 1024 / 16, PEER_SU, gtid, gthreads);
  cvt_fp8(a.peer_v, (unsigned char*)(ws + WS_VB), (size_t)16384 * 1024 / 16, PEER_SV, gtid, gthreads);
  {
    float* cs = (float*)(ws + WS_CS);
    for (int idx = gtid; idx < T * 32; idx += gthreads) {
      const int t = idx >> 5, i = idx & 31;
      const float inv = INVF[i];
      const float ang = (float)a.pos[t] * inv;
      float sn, c_; sincos_acc(ang, sn, c_);
      cs[(size_t)t * 64 + i] = c_; cs[(size_t)t * 64 + 32 + i] = sn;
    }
  }
}

__device__ void phase1(const Args& a, char* lds) {
  unsigned char* ws = a.ws;
  const int tid = threadIdx.x, lane = tid & 63, wv = tid >> 6;
  const float* modp = (const float*)(ws + WS_MODP);
  float* mod = (float*)(ws + WS_MOD);
  for (int idx = blockIdx.x * 512 + tid; idx < 4 * 6144; idx += gridDim.x * 512) {
    const int b = idx / 6144, m = idx % 6144;
    float s = a.b_ada[m];
#pragma unroll
    for (int ks = 0; ks < 8; ++ks) s += modp[(ks * 4 + b) * 6144 + m];
    mod[idx] = s;
  }
  float* sh = (float*)(lds + LDS_DATA);
  u16* H = (u16*)(ws + WS_H);
  for (int u = blockIdx.x; u < T / 64; u += gridDim.x) {
    const int b = u >> 6;
    __syncthreads();
    for (int j = tid; j < 2048; j += 512) {
      float s = a.b_ada[j];
#pragma unroll
      for (int ks = 0; ks < 8; ++ks) s += modp[(ks * 4 + b) * 6144 + j];
      sh[j] = s;
    }
    __syncthreads();
    for (int i = 0; i < 8; ++i) {
      const int r = u * 64 + wv * 8 + i;
      float4 xv[4]; float ssq = 0.f;
#pragma unroll
      for (int j = 0; j < 4; ++j) { xv[j] = *(const float4*)(a.x + (size_t)r * 1024 + j * 256 + lane * 4); ssq += xv[j].x * xv[j].x + xv[j].y * xv[j].y + xv[j].z * xv[j].z + xv[j].w * xv[j].w; }
      ssq = wave_sum(ssq);
      const float rstd = rsqrtf(ssq * (1.f / 1024.f) + EPS);
#pragma unroll
      for (int j = 0; j < 4; ++j) {
        const int col = j * 256 + lane * 4;
        const float4 g = *(const float4*)(a.g_norm1 + col);
        const float h0 = xv[j].x * rstd * g.x * (1.f + sh[1024 + col]) + sh[col];
        const float h1 = xv[j].y * rstd * g.y * (1.f + sh[1024 + col + 1]) + sh[col + 1];
        const float h2 = xv[j].z * rstd * g.z * (1.f + sh[1024 + col + 2]) + sh[col + 2];
        const float h3 = xv[j].w * rstd * g.w * (1.f + sh[1024 + col + 3]) + sh[col + 3];
        uint2 o = {pack2(h0, h1), pack2(h2, h3)};
        *(uint2*)(H + (size_t)r * 1024 + col) = o;
      }
    }
  }
}

constexpr int G_STAGE = 49152;
__device__ __forceinline__ void gemm_128x256(const u16* __restrict__ A, int lda, const u16* __restrict__ Bt, int ldb, int KT,
                                             f32x16 (&acc)[2][2], char* lds) {
  const int tid = threadIdx.x, lane = tid & 63, wv = tid >> 6, r32 = lane & 31, hi = lane >> 5;
  const int wm = wv >> 2, wn = wv & 3;
  const int srow = tid >> 3, sc = tid & 7;
  const u16* pa = A + (size_t)srow * lda + sc * 8;
  const u16* pb = Bt + (size_t)srow * ldb + sc * 8;
  const int swo = srow * 128 + ((sc ^ ((srow >> 1) & 7)) << 4);
  u32x4 ra[2], rb[4];
#pragma unroll
  for (int m = 0; m < 2; ++m)
#pragma unroll
    for (int n = 0; n < 2; ++n)
#pragma unroll
      for (int r = 0; r < 16; ++r) acc[m][n][r] = 0.f;
#pragma unroll
  for (int i = 0; i < 2; ++i) ra[i] = *(const u32x4*)(pa + (size_t)(64 * i) * lda);
#pragma unroll
  for (int i = 0; i < 4; ++i) rb[i] = *(const u32x4*)(pb + (size_t)(64 * i) * ldb);
  __syncthreads();
#pragma unroll
  for (int i = 0; i < 2; ++i) *(u32x4*)(lds + swo + 8192 * i) = ra[i];
#pragma unroll
  for (int i = 0; i < 4; ++i) *(u32x4*)(lds + 16384 + swo + 8192 * i) = rb[i];
  __syncthreads();
  const int xa = (r32 >> 1) & 7;
  const int aoff = (64 * wm + r32) * 128, boff = 16384 + (64 * wn + r32) * 128;
  for (int kt = 0; kt < KT; ++kt) {
    const char* buf = lds + (kt & 1) * G_STAGE;
    if (kt + 1 < KT) {
#pragma unroll
      for (int i = 0; i < 2; ++i) ra[i] = *(const u32x4*)(pa + (size_t)(64 * i) * lda + (kt + 1) * 64);
#pragma unroll
      for (int i = 0; i < 4; ++i) rb[i] = *(const u32x4*)(pb + (size_t)(64 * i) * ldb + (kt + 1) * 64);
    }
#pragma unroll
    for (int s = 0; s < 4; ++s) {
      const int cb = ((2 * s + hi) ^ xa) << 4;
      const bf16x8 a0 = *(const bf16x8*)(buf + aoff + cb), a1 = *(const bf16x8*)(buf + aoff + 4096 + cb);
      const bf16x8 b0 = *(const bf16x8*)(buf + boff + cb), b1 = *(const bf16x8*)(buf + boff + 4096 + cb);
      acc[0][0] = MFMA32(a0, b0, acc[0][0]); acc[0][1] = MFMA32(a0, b1, acc[0][1]);
      acc[1][0] = MFMA32(a1, b0, acc[1][0]); acc[1][1] = MFMA32(a1, b1, acc[1][1]);
    }
    if (kt + 1 < KT) {
      char* nb = lds + ((kt + 1) & 1) * G_STAGE;
#pragma unroll
      for (int i = 0; i < 2; ++i) *(u32x4*)(nb + swo + 8192 * i) = ra[i];
#pragma unroll
      for (int i = 0; i < 4; ++i) *(u32x4*)(nb + 16384 + swo + 8192 * i) = rb[i];
    }
    __syncthreads();
  }
}
constexpr int CLD = 257;
__device__ __forceinline__ void acc_to_lds(const f32x16 (&acc)[2][2], float* Cl) {
  const int lane = threadIdx.x & 63, wv = threadIdx.x >> 6, r32 = lane & 31, hi = lane >> 5, wm = wv >> 2, wn = wv & 3;
#pragma unroll
  for (int m = 0; m < 2; ++m)
#pragma unroll
    for (int n = 0; n < 2; ++n)
#pragma unroll
      for (int r = 0; r < 16; ++r) Cl[(64 * wm + 32 * m + crow(r, hi)) * CLD + 64 * wn + 32 * n + r32] = acc[m][n][r];
}

__device__ void phase2(const Args& a, char* lds) {
  unsigned char* ws = a.ws;
  const int tid = threadIdx.x, lane = tid & 63, wv = tid >> 6;
  const u16* H = (const u16*)(ws + WS_H); const u16* WIN = (const u16*)(ws + WS_WIN);
  u16* QA = (u16*)(ws + WS_QA); u16* KV = (u16*)(ws + WS_KV); u16* UACT = (u16*)(ws + WS_UACT); u16* GVT = (u16*)(ws + WS_GVT);
  float* SSQV = (float*)(ws + WS_SSQV); const float* CS = (const float*)(ws + WS_CS);
  char* gl = lds + LDS_DATA; float* Cl = (float*)gl;
  for (int u = blockIdx.x; u < 128 * 6; u += gridDim.x) {
    const int mt = u / 6, nt = u % 6, R0 = mt * 128;
    f32x16 acc[2][2];
    gemm_128x256(H + (size_t)R0 * 1024, 1024, WIN + (size_t)(nt * 256) * 1024, 1024, 16, acc, gl);
    acc_to_lds(acc, Cl);
    __syncthreads();
    if (nt == 0) {
      for (int i = 0; i < 16; ++i) {
        const int row = wv * 16 + i; float v[4], ssq = 0.f;
#pragma unroll
        for (int j = 0; j < 4; ++j) { v[j] = Cl[row * CLD + lane + 64 * j]; ssq += v[j] * v[j]; }
        ssq = wave_sum(ssq);
        const float rstd = rsqrtf(ssq * (1.f / 256.f) + EPS);
#pragma unroll
        for (int j = 0; j < 4; ++j) { const int col = lane + 64 * j; QA[(size_t)(R0 + row) * 256 + col] = f2bf(v[j] * rstd * a.g_q_a[col]); }
      }
    } else if (nt == 1) {
      for (int i = 0; i < 16; ++i) {
        const int row = wv * 16 + i, tok = R0 + row;
        const float v0 = Cl[row * CLD + lane], v1 = Cl[row * CLD + 64 + lane];
        const float ssq = wave_sum(v0 * v0 + v1 * v1);
        const float rstd = rsqrtf(ssq * (1.f / 128.f) + EPS);
        KV[(size_t)tok * 192 + lane] = f2bf(v0 * rstd * a.g_kv_a[lane]);
        KV[(size_t)tok * 192 + 64 + lane] = f2bf(v1 * rstd * a.g_kv_a[64 + lane]);
        if (lane < 32) {
          const float x1 = Cl[row * CLD + 128 + lane], x2 = Cl[row * CLD + 160 + lane];
          const float cs = CS[(size_t)tok * 64 + lane], sn = CS[(size_t)tok * 64 + 32 + lane];
          KV[(size_t)tok * 192 + 128 + lane] = f2bf(x1 * cs - x2 * sn);
          KV[(size_t)tok * 192 + 160 + lane] = f2bf(x2 * cs + x1 * sn);
        }
      }
    } else if (nt < 4) {
      for (int i = 0; i < 16; ++i) {
        const int row = wv * 16 + i;
#pragma unroll
        for (int j = 0; j < 4; ++j) { const int col = lane + 64 * j; UACT[(size_t)(R0 + row) * 512 + (nt - 2) * 256 + col] = f2bf(gelu_exact(Cl[row * CLD + col])); }
      }
    } else {
      for (int i = 0; i < 16; ++i) {
        const int row = wv * 16 + i; float ssq = 0.f;
#pragma unroll
        for (int j = 0; j < 4; ++j) { const int col = lane + 64 * j; const float g = gelu_exact(Cl[row * CLD + col]); const float gb = bflo((unsigned)f2bf(g)); ssq += gb * gb; Cl[row * CLD + col] = gb; }
        ssq = wave_sum(ssq);
        if (lane == 0) SSQV[(size_t)(R0 + row) * 2 + (nt - 4)] = ssq;
      }
      __syncthreads();
      for (int i = 0; i < 32; ++i) {
        const int c = wv * 32 + i;
        const float g0 = Cl[(2 * lane) * CLD + c], g1 = Cl[(2 * lane + 1) * CLD + c];
        *(unsigned*)(GVT + ((size_t)mt * 512 + (nt - 4) * 256 + c) * 128 + 2 * lane) = pack2(g0, g1);
      }
    }
    __syncthreads();
  }
}

__device__ void phase3(const Args& a, char* lds) {
  unsigned char* ws = a.ws;
  const int tid = threadIdx.x, lane = tid & 63, wv = tid >> 6, r32 = lane & 31, hi = lane >> 5;
  const u16* QA = (const u16*)(ws + WS_QA); const u16* WQ2 = (const u16*)(ws + WS_WQ2);
  u16* Q = (u16*)(ws + WS_Q); const float* CS = (const float*)(ws + WS_CS);
  const u16* UACT = (const u16*)(ws + WS_UACT); const u16* GVT = (const u16*)(ws + WS_GVT); const u16* WSG = (const u16*)(ws + WS_WSG);
  const float* SSQV = (const float*)(ws + WS_SSQV); u16* Y = (u16*)(ws + WS_Y);
  char* gl = lds + LDS_DATA; float* Cl = (float*)gl;
  for (int u = blockIdx.x; u < 384; u += gridDim.x) {
    {
      const int mt = u / 3, nt = u % 3, R0 = mt * 128;
      f32x16 acc[2][2];
      gemm_128x256(QA + (size_t)R0 * 256, 256, WQ2 + (size_t)(nt * 256) * 256, 256, 4, acc, gl);
      acc_to_lds(acc, Cl);
      __syncthreads();
      if (nt < 2) {
        for (int i = 0; i < 16; ++i) {
          const int row = wv * 16 + i;
#pragma unroll
          for (int j = 0; j < 4; ++j) { const int n = nt * 256 + lane + 64 * j; Q[(size_t)(R0 + row) * 768 + (n >> 7) * 192 + (n & 127)] = f2bf(Cl[row * CLD + lane + 64 * j]); }
        }
      } else {
        for (int i = 0; i < 16; ++i) {
          const int row = wv * 16 + i, tok = R0 + row;
#pragma unroll
          for (int j = 0; j < 2; ++j) {
            const int idx = lane + 64 * j, h = idx >> 5, jj = idx & 31;
            const float x1 = Cl[row * CLD + h * 64 + jj], x2 = Cl[row * CLD + h * 64 + 32 + jj];
            const float cs = CS[(size_t)tok * 64 + jj], sn = CS[(size_t)tok * 64 + 32 + jj];
            Q[(size_t)tok * 768 + h * 192 + 128 + jj] = f2bf(x1 * cs - x2 * sn);
            Q[(size_t)tok * 768 + h * 192 + 160 + jj] = f2bf(x2 * cs + x1 * sn);
          }
        }
      }
      __syncthreads();
    }
  }
  for (int su = blockIdx.x; su < 256; su += gridDim.x) {
    {
      const int c = su >> 1, ph = su & 1;
      float* rs = (float*)gl;
      float* Yl = (float*)(gl + 512);
      __syncthreads();
      if (tid < 128) { const size_t t = (size_t)c * 128 + tid; rs[tid] = rsqrtf((SSQV[t * 2] + SSQV[t * 2 + 1]) * (1.f / 512.f) + EPS); }
      __syncthreads();
      const int h = wv >> 1, dh = wv & 1;
      f32x16 acc[2][2];
#pragma unroll
      for (int m = 0; m < 2; ++m)
#pragma unroll
        for (int n = 0; n < 2; ++n)
#pragma unroll
          for (int r = 0; r < 16; ++r) acc[m][n][r] = 0.f;
      for (int s = 0; s < 8; ++s) {
        const int q0 = 16 * s + 8 * hi;
        bf16x8 af[2], bfr[2];
#pragma unroll
        for (int m = 0; m < 2; ++m) af[m] = *(const bf16x8*)(WSG + ((size_t)h * 128 + ph * 64 + 32 * m + r32) * 128 + q0);
        float rq[8];
#pragma unroll
        for (int j = 0; j < 8; ++j) rq[j] = rs[q0 + j];
#pragma unroll
        for (int n = 0; n < 2; ++n) {
          const u32x4 w = *(const u32x4*)(GVT + ((size_t)c * 512 + h * 128 + dh * 64 + 32 * n + r32) * 128 + q0);
          u32x4 o;
#pragma unroll
          for (int k = 0; k < 4; ++k) o[k] = pack2(bflo(w[k]) * rq[2 * k], bfhi(w[k]) * rq[2 * k + 1]);
          bfr[n] = __builtin_bit_cast(bf16x8, o);
        }
#pragma unroll
        for (int m = 0; m < 2; ++m)
#pragma unroll
          for (int n = 0; n < 2; ++n) acc[m][n] = MFMA32(af[m], bfr[n], acc[m][n]);
      }
#pragma unroll
      for (int m = 0; m < 2; ++m)
#pragma unroll
        for (int n = 0; n < 2; ++n)
#pragma unroll
          for (int r = 0; r < 16; ++r) {
            const int pl = 32 * m + crow(r, hi), col = h * 128 + dh * 64 + 32 * n + r32;
            const size_t tok = (size_t)c * 128 + ph * 64 + pl;
            const float mix = acc[m][n][r] * a.g_sg[col] + a.b_sg[h * 128 + ph * 64 + pl];
            Yl[pl * 513 + col] = bflo((unsigned)UACT[tok * 512 + col]) * mix;
          }
      __syncthreads();
      for (int i = 0; i < 8; ++i) {
        const int pl = wv * 8 + i; const size_t tok = (size_t)c * 128 + ph * 64 + pl;
        float v[8], ssq = 0.f;
#pragma unroll
        for (int j = 0; j < 8; ++j) { v[j] = Yl[pl * 513 + lane + 64 * j]; ssq += v[j] * v[j]; }
        ssq = wave_sum(ssq);
        const float rstd = rsqrtf(ssq * (1.f / 512.f) + EPS);
#pragma unroll
        for (int j = 0; j < 8; ++j) { const int col = lane + 64 * j; Y[tok * 1024 + 512 + col] = f2bf(v[j] * rstd * a.g_sg_out[col]); }
      }
      __syncthreads();
    }
  }
}

constexpr float ATT_SCALE = 0.07216878364870322f;
constexpr float ATT_THR = 8.f;
constexpr int KVBUF = 24576;
#define SBAR() __builtin_amdgcn_sched_barrier(0)
__device__ __forceinline__ unsigned cvtpk(float lo, float hi) { unsigned r; asm volatile("v_cvt_pk_bf16_f32 %0, %1, %2" : "=v"(r) : "v"(lo), "v"(hi)); return r; }
__device__ __forceinline__ unsigned off_a(unsigned row, unsigned ch) { return 2048u * (row >> 3) + 512u * (ch >> 2) + 64u * (row & 7) + 16u * ((ch & 3) ^ ((row >> 2) & 3)); }

__device__ __forceinline__ void partialSM(f32x16& p0, f32x16& p1, float& m_reg, float& mn, float& alpha) {
  constexpr float C = ATT_SCALE * 1.4426950408889634f;
  float pmax = p0[0];
#pragma unroll
  for (int r = 1; r < 16; ++r) pmax = fmaxf(pmax, p0[r]);
#pragma unroll
  for (int r = 0; r < 16; ++r) pmax = fmaxf(pmax, p1[r]);
  { auto rr = __builtin_amdgcn_permlane32_swap(__float_as_uint(pmax), __float_as_uint(pmax), false, false);
    pmax = fmaxf(__uint_as_float(rr[0]), __uint_as_float(rr[1])); }
  if (__builtin_expect(__all(pmax - m_reg <= ATT_THR / ATT_SCALE), 1)) { mn = m_reg; alpha = 1.f; }
  else { mn = fmaxf(m_reg, pmax); alpha = __builtin_amdgcn_exp2f((m_reg - mn) * C); m_reg = mn; }
  const float mnC = -mn * C;
#pragma unroll
  for (int r = 0; r < 16; ++r) p0[r] = fmaf(p0[r], C, mnC);
#pragma unroll
  for (int r = 0; r < 16; ++r) p1[r] = fmaf(p1[r], C, mnC);
#pragma unroll
  for (int r = 0; r < 16; ++r) p0[r] = __builtin_amdgcn_exp2f(p0[r]);
}
__device__ __forceinline__ void finishSM(f32x16& p0, f32x16& p1, float alpha, float& l_reg, bf16x8& pa0, bf16x8& pa1, bf16x8& pa2, bf16x8& pa3) {
#pragma unroll
  for (int r = 0; r < 16; ++r) p1[r] = __builtin_amdgcn_exp2f(p1[r]);
  float ps = 0;
#pragma unroll
  for (int r = 0; r < 16; ++r) ps += p0[r];
#pragma unroll
  for (int r = 0; r < 16; ++r) ps += p1[r];
  { auto rr = __builtin_amdgcn_permlane32_swap(__float_as_uint(ps), __float_as_uint(ps), false, false);
    ps = __uint_as_float(rr[0]) + __uint_as_float(rr[1]); }
  l_reg = l_reg * alpha + ps;
#define PK4(P, BASE, OUT) do { unsigned a0 = cvtpk(P[BASE + 0], P[BASE + 1]), a1 = cvtpk(P[BASE + 2], P[BASE + 3]);   \
    unsigned b0 = cvtpk(P[BASE + 4], P[BASE + 5]), b1 = cvtpk(P[BASE + 6], P[BASE + 7]);                              \
    auto r0 = __builtin_amdgcn_permlane32_swap(a0, b0, false, false); auto r1 = __builtin_amdgcn_permlane32_swap(a1, b1, false, false); \
    u32x4 w = {r0[0], r1[0], r0[1], r1[1]}; OUT = __builtin_bit_cast(bf16x8, w); } while (0)
  PK4(p0, 0, pa0); PK4(p0, 8, pa1); PK4(p1, 0, pa2); PK4(p1, 8, pa3);
#undef PK4
}
__device__ __forceinline__ void qkt192(f32x16& p0, f32x16& p1, const char* kb, const bf16x8* qr, int ke, int ko, int kr) {
#pragma unroll
  for (int r = 0; r < 16; ++r) { p0[r] = 0.f; p1[r] = 0.f; }
#pragma unroll
  for (int d0 = 0; d0 < 8; ++d0) {
    const int o = ((d0 & 1) ? ko : ke) + 512 * (d0 >> 1);
    const bf16x8 b0 = *(const bf16x8*)(kb + o), b1 = *(const bf16x8*)(kb + o + 8192);
    p0 = MFMA32(b0, qr[d0], p0); p1 = MFMA32(b1, qr[d0], p1);
  }
#pragma unroll
  for (int d1 = 0; d1 < 4; ++d1) {
    const int o = 16384 + (kr ^ (32 * d1));
    const bf16x8 b0 = *(const bf16x8*)(kb + o), b1 = *(const bf16x8*)(kb + o + 4096);
    p0 = MFMA32(b0, qr[8 + d1], p0); p1 = MFMA32(b1, qr[8 + d1], p1);
  }
}
template <int OFF> __device__ __forceinline__ s16x4 tr_read(int vb) {
  s16x4 r; asm volatile("ds_read_b64_tr_b16 %0, %1 offset:%2" : "=&v"(r) : "v"(vb), "i"(OFF) : "memory"); return r;
}
template <int C> __device__ __forceinline__ void pv_one(f32x16& od, int vb0, int vb1, bf16x8 pa0, bf16x8 pa1, bf16x8 pa2, bf16x8 pa3) {
  const s16x4 l0 = tr_read<512 * C>(vb0), h0 = tr_read<512 * C>(vb1), l1 = tr_read<4096 + 512 * C>(vb0), h1 = tr_read<4096 + 512 * C>(vb1);
  const s16x4 l2 = tr_read<8192 + 512 * C>(vb0), h2 = tr_read<8192 + 512 * C>(vb1), l3 = tr_read<12288 + 512 * C>(vb0), h3 = tr_read<12288 + 512 * C>(vb1);
  asm volatile("s_waitcnt lgkmcnt(0)" ::: "memory"); SBAR();
#define PKV(L, H) (bf16x8){L[0], L[1], L[2], L[3], H[0], H[1], H[2], H[3]}
  od = MFMA32(pa0, PKV(l0, h0), od); od = MFMA32(pa1, PKV(l1, h1), od);
  od = MFMA32(pa2, PKV(l2, h2), od); od = MFMA32(pa3, PKV(l3, h3), od);
#undef PKV
}
__device__ __forceinline__ void pv_all(f32x16* o, int vb0, int vb1, bf16x8 pa0, bf16x8 pa1, bf16x8 pa2, bf16x8 pa3) {
  pv_one<0>(o[0], vb0, vb1, pa0, pa1, pa2, pa3); pv_one<1>(o[1], vb0, vb1, pa0, pa1, pa2, pa3);
  pv_one<2>(o[2], vb0, vb1, pa0, pa1, pa2, pa3); pv_one<3>(o[3], vb0, vb1, pa0, pa1, pa2, pa3);
}

__device__ void phase4(const Args& a, char* lds) {
  unsigned char* ws = a.ws;
  const int tid = threadIdx.x, wid = tid >> 6, lane = tid & 63, r32 = lane & 31, hi = lane >> 5;
  const u16* Qg = (const u16*)(ws + WS_Q); const u16* KVg = (const u16*)(ws + WS_KV); const u16* WUV = (const u16*)(ws + WS_WUV);
  u16* Y = (u16*)(ws + WS_Y);
  char* gl = lds + LDS_DATA;
  char* kvl = gl;
  float* wsl = (float*)(gl + 2 * KVBUF) + wid * 64; float* li_l = wsl; float* al_l = wsl + 32;
  char* Ol = gl + 2 * KVBUF + 2048 + wid * 8704;
  float* Yl = (float*)gl;
  const int head = wid >> 1, qh = wid & 1;
  int sdst[3];
#pragma unroll
  for (int j = 0; j < 3; ++j) { const int id = tid + 512 * j, key = id / 24, ch = id % 24;
    sdst[j] = ch < 16 ? (int)off_a(key, ch) : 16384 + key * 128 + (((ch - 16) ^ ((key >> 1) & 7)) << 4); }
  const int xq = (r32 >> 2) & 3;
  const int ke = 2048 * (r32 >> 3) + 64 * (r32 & 7) + 16 * (hi ^ xq), ko = 2048 * (r32 >> 3) + 64 * (r32 & 7) + 16 * ((2 + hi) ^ xq);
  const int kr = r32 * 128 + ((hi ^ ((r32 >> 1) & 7)) << 4);
  const int tb = lane >> 4 & 1, tq = (lane & 15) >> 2, tp = lane & 3;
  const int vbl = 2048 * hi + 64 * tq + 32 * (tb ^ hi) + 8 * (tp & 1);
  const int lbase = (int)(uintptr_t)kvl;
  const int vb0 = lbase + vbl + 16 * (tp >> 1), vb1 = lbase + vbl + 256 + 16 * ((tp >> 1) ^ 1);
  for (int u = blockIdx.x; u < 256; u += gridDim.x) {
    const int b = u >> 6, qb = u & 63;
    const size_t tok0 = (size_t)b * SEQ + qb * 64 + qh * 32;
    const u16* KVb = KVg + (size_t)b * SEQ * 192;
    float m_reg = -1e30f, l_reg = 0.f; f32x16 o[4]; bf16x8 qr[12];
#pragma unroll
    for (int d = 0; d < 4; ++d)
#pragma unroll
      for (int r = 0; r < 16; ++r) o[d][r] = 0.f;
    { const u16* Qw = Qg + (tok0 + r32) * 768 + head * 192 + hi * 8;
#pragma unroll
      for (int d0 = 0; d0 < 12; ++d0) qr[d0] = *(const bf16x8*)(Qw + d0 * 16); }
    u32x4 st0[3];
#define SLOAD(S, k0) do { const u16* _p = KVb + (size_t)(k0) * 192 + tid * 8; S[0] = *(const u32x4*)_p; S[1] = *(const u32x4*)(_p + 4096); S[2] = *(const u32x4*)(_p + 8192); } while (0)
#define SWRITE(bufi, S) do { char* _d = kvl + (bufi) * KVBUF; *(u32x4*)(_d + sdst[0]) = S[0]; *(u32x4*)(_d + sdst[1]) = S[1]; *(u32x4*)(_d + sdst[2]) = S[2]; } while (0)
#define RESC(al) do { if (__any((al) < 1.f)) { if (hi == 0) al_l[r32] = (al); asm volatile("s_waitcnt lgkmcnt(0)" ::: "memory"); \
    _Pragma("unroll") for (int d = 0; d < 4; ++d) _Pragma("unroll") for (int r = 0; r < 16; ++r) o[d][r] *= al_l[crow(r, hi)]; } } while (0)
    constexpr int NT = SEQ / 64;
    __syncthreads();
    SLOAD(st0, 0); SWRITE(0, st0); SLOAD(st0, 64); __syncthreads();
    for (int j = 0; j < NT; ++j) {
      const int bo = (j & 1) * KVBUF;
      f32x16 p0, p1; float mn, al; bf16x8 pa0, pa1, pa2, pa3;
      qkt192(p0, p1, kvl + bo, qr, ke, ko, kr);
      partialSM(p0, p1, m_reg, mn, al);
      RESC(al);
      finishSM(p0, p1, al, l_reg, pa0, pa1, pa2, pa3);
      if (j + 1 < NT) { SWRITE((j + 1) & 1, st0); if (j + 2 < NT) SLOAD(st0, (j + 2) * 64); }
      SBAR();
      pv_all(o, vb0 + bo, vb1 + bo, pa0, pa1, pa2, pa3);
      __syncthreads();
    }
#undef SLOAD
#undef SWRITE
#undef RESC
    int r32e = r32, hie = hi, lne = lane;
    asm volatile("" : "+v"(r32e), "+v"(hie), "+v"(lne));
    if (hie == 0) li_l[r32e] = l_reg;
    asm volatile("s_waitcnt lgkmcnt(0)" ::: "memory");
#pragma unroll
    for (int r = 0; r < 16; ++r) {
      const int q = crow(r, hie); const float rl = __builtin_amdgcn_rcpf(li_l[q]);
#pragma unroll
      for (int d = 0; d < 4; ++d) *(u16*)(Ol + q * 272 + (32 * d + r32e) * 2) = f2bf(o[d][r] * rl);
    }
    asm volatile("s_waitcnt lgkmcnt(0)" ::: "memory");
    f32x16 y[4];
#pragma unroll
    for (int n = 0; n < 4; ++n)
#pragma unroll
      for (int r = 0; r < 16; ++r) y[n][r] = 0.f;
    const u16* wuv = WUV + ((size_t)head * 128 + r32e) * 128 + 8 * hie;
#pragma unroll 2
    for (int s = 0; s < 8; ++s) {
      const bf16x8 af = *(const bf16x8*)(Ol + r32e * 272 + (16 * s + 8 * hie) * 2);
#pragma unroll
      for (int n = 0; n < 4; ++n) {
        const bf16x8 bw = *(const bf16x8*)(wuv + 32 * n * 128 + 16 * s);
        y[n] = MFMA32(af, bw, y[n]);
      }
    }
    __syncthreads();
#pragma unroll
    for (int n = 0; n < 4; ++n)
#pragma unroll
      for (int r = 0; r < 16; ++r) Yl[(qh * 32 + crow(r, hie)) * 513 + head * 128 + 32 * n + r32e] = y[n][r];
    __syncthreads();
    for (int i = 0; i < 8; ++i) {
      const int pl = wid * 8 + i; const size_t tok = (size_t)b * SEQ + qb * 64 + pl;
      float v[8], ssq = 0.f;
#pragma unroll
      for (int jj = 0; jj < 8; ++jj) { v[jj] = Yl[pl * 513 + lne + 64 * jj]; ssq += v[jj] * v[jj]; }
      ssq = wave_sum(ssq);
      const float rstd = rsqrtf(ssq * (1.f / 512.f) + EPS);
#pragma unroll
      for (int jj = 0; jj < 8; ++jj) { const int col = lne + 64 * jj; Y[tok * 1024 + col] = f2bf(v[jj] * rstd * a.g_attn_out[col]); }
    }
    __syncthreads();
  }
}

__device__ void phase5(const Args& a, char* lds) {
  unsigned char* ws = a.ws;
  const int tid = threadIdx.x, lane = tid & 63, wv = tid >> 6;
  const u16* Y = (const u16*)(ws + WS_Y); const u16* WO = (const u16*)(ws + WS_WO);
  float* X1 = (float*)(ws + WS_X1); float* SSQ = (float*)(ws + WS_SSQ); const float* mod = (const float*)(ws + WS_MOD);
  char* gl = lds + LDS_DATA; float* Cl = (float*)gl;
  for (int u = blockIdx.x; u < 128 * 4; u += gridDim.x) {
    const int mt = u >> 2, nt = u & 3, R0 = mt * 128, b = R0 >> 12;
    f32x16 acc[2][2];
    gemm_128x256(Y + (size_t)R0 * 1024, 1024, WO + (size_t)(nt * 256) * 1024, 1024, 16, acc, gl);
    acc_to_lds(acc, Cl);
    __syncthreads();
    float g1[4];
#pragma unroll
    for (int j = 0; j < 4; ++j) g1[j] = mod[b * 6144 + 2048 + nt * 256 + lane + 64 * j];
    for (int i = 0; i < 16; ++i) {
      const int row = wv * 16 + i; const size_t tok = R0 + row; float ssq = 0.f;
#pragma unroll
      for (int j = 0; j < 4; ++j) {
        const int col = nt * 256 + lane + 64 * j;
        const float v = a.x[tok * 1024 + col] + g1[j] * Cl[row * CLD + lane + 64 * j];
        X1[tok * 1024 + col] = v; ssq += v * v;
      }
      ssq = wave_sum(ssq);
      if (lane == 0) SSQ[tok * 4 + nt] = ssq;
    }
    __syncthreads();
  }
}
__device__ void phase5b(const Args& a) {
  unsigned char* ws = a.ws;
  const int tid = threadIdx.x, lane = tid & 63, wv = tid >> 6;
  const float* X1 = (const float*)(ws + WS_X1); const float* SSQ = (const float*)(ws + WS_SSQ); const float* mod = (const float*)(ws + WS_MOD);
  u16* H = (u16*)(ws + WS_H);
  for (int u = blockIdx.x; u < T / 64; u += gridDim.x) {
    const int b = u >> 6;
    float4 sh[4], sc[4], g[4];
#pragma unroll
    for (int j = 0; j < 4; ++j) {
      const int col = j * 256 + lane * 4;
      sh[j] = *(const float4*)(mod + b * 6144 + 3072 + col); sc[j] = *(const float4*)(mod + b * 6144 + 4096 + col); g[j] = *(const float4*)(a.g_norm2 + col);
    }
    for (int i = 0; i < 8; ++i) {
      const size_t r = (size_t)u * 64 + wv * 8 + i;
      const float4 sq = *(const float4*)(SSQ + r * 4);
      const float rstd = rsqrtf((sq.x + sq.y + sq.z + sq.w) * (1.f / 1024.f) + EPS);
#pragma unroll
      for (int j = 0; j < 4; ++j) {
        const int col = j * 256 + lane * 4;
        const float4 xv = *(const float4*)(X1 + r * 1024 + col);
        const float h0 = xv.x * rstd * g[j].x * (1.f + sc[j].x) + sh[j].x, h1 = xv.y * rstd * g[j].y * (1.f + sc[j].y) + sh[j].y;
        const float h2 = xv.z * rstd * g[j].z * (1.f + sc[j].z) + sh[j].z, h3 = xv.w * rstd * g[j].w * (1.f + sc[j].w) + sh[j].w;
        uint2 o = {pack2(h0, h1), pack2(h2, h3)};
        *(uint2*)(H + r * 1024 + col) = o;
      }
    }
  }
}

__device__ __forceinline__ float vmaxf(float a, float b) { float r; asm("v_max_f32 %0, %1, %2" : "=v"(r) : "v"(a), "v"(b)); return r; }
__device__ __forceinline__ float vminf(float a, float b) { float r; asm("v_min_f32 %0, %1, %2" : "=v"(r) : "v"(a), "v"(b)); return r; }
#define TOP_INSERT(t, v) do { float _v = (v); _Pragma("unroll") for (int _i = 0; _i < 16; ++_i) { const float _h = vmaxf(t[_i], _v); _v = vminf(t[_i], _v); t[_i] = _h; } } while (0)

__device__ void phase6(const Args& a, char* lds) {
  unsigned char* ws = a.ws;
  const int tid = threadIdx.x, lane = tid & 63, wv = tid >> 6, r32 = lane & 31, hi = lane >> 5;
  const u16* H = (const u16*)(ws + WS_H); const u16* WPQ = (const u16*)(ws + WS_WPQ); const u16* KEYS = (const u16*)(ws + WS_KEYS);
  uint2* TOPK = (uint2*)(ws + WS_TOPK);
  char* gl = lds + LDS_DATA;
  char* Ql = gl;
  float* TK = (float*)(gl + 67584);
  for (int u = blockIdx.x; u < 128 * 8; u += gridDim.x) {
    const int mt = u >> 3, hd = u & 7, R0 = mt * 128;
    f32x16 acc[2][2];
    gemm_128x256(H + (size_t)R0 * 1024, 1024, WPQ + (size_t)(hd * 256) * 1024, 1024, 16, acc, gl);
    { const int wm = wv >> 2, wn = wv & 3;
#pragma unroll
      for (int m = 0; m < 2; ++m)
#pragma unroll
        for (int n = 0; n < 2; ++n)
#pragma unroll
          for (int r = 0; r < 16; ++r) *(u16*)(Ql + (64 * wm + 32 * m + crow(r, hi)) * 528 + (64 * wn + 32 * n + r32) * 2) = f2bf(acc[m][n][r]); }
    __syncthreads();
    {
      const int half = wv & 1, tb = wv >> 1;
      f32x16 sc[4];
#pragma unroll
      for (int k = 0; k < 4; ++k)
#pragma unroll
        for (int r = 0; r < 16; ++r) sc[k][r] = 0.f;
#pragma unroll
      for (int s = 0; s < 8; ++s) {
        const bf16x8 bq = *(const bf16x8*)(Ql + (32 * tb + r32) * 528 + (half * 128 + 16 * s + 8 * hi) * 2);
#pragma unroll
        for (int k = 0; k < 4; ++k) {
          const bf16x8 ak = *(const bf16x8*)(KEYS + ((size_t)(hd * 2 + half) * 128 + 32 * k + r32) * 128 + 16 * s + 8 * hi);
          sc[k] = MFMA32(ak, bq, sc[k]);
        }
      }
      float t[16];
#pragma unroll
      for (int i = 0; i < 16; ++i) t[i] = __uint_as_float(0xff800000u);
#pragma unroll
      for (int k = 0; k < 4; ++k)
#pragma unroll
        for (int r = 0; r < 16; ++r) {
          const unsigned key = 32 * k + crow(r, hi);
          TOP_INSERT(t, __uint_as_float((__float_as_uint(sc[k][r]) & ~127u) | key));
        }
      float p[16];
#pragma unroll
      for (int i = 0; i < 16; ++i) {
        auto rr = __builtin_amdgcn_permlane32_swap(__float_as_uint(t[i]), __float_as_uint(t[i]), false, false);
        p[i] = __uint_as_float(hi ? rr[0] : rr[1]);
      }
#pragma unroll
      for (int i = 0; i < 16; ++i) TOP_INSERT(t, p[i]);
      if (hi == 0) {
        float* dst = TK + ((size_t)half * 128 + 32 * tb + r32) * 16;
#pragma unroll
        for (int i = 0; i < 16; i += 4) *(float4*)(dst + i) = make_float4(t[i], t[i + 1], t[i + 2], t[i + 3]);
      }
    }
    __syncthreads();
    if (tid < 128) {
      float v1[16], v2[16], t[16];
#pragma unroll
      for (int i = 0; i < 16; i += 4) {
        const float4 x = *(const float4*)(TK + (size_t)tid * 16 + i), y = *(const float4*)(TK + (size_t)(128 + tid) * 16 + i);
        v1[i] = x.x; v1[i + 1] = x.y; v1[i + 2] = x.z; v1[i + 3] = x.w; v2[i] = y.x; v2[i + 1] = y.y; v2[i + 2] = y.z; v2[i + 3] = y.w;
      }
#pragma unroll
      for (int i = 0; i < 16; ++i) t[i] = __uint_as_float(0xff800000u);
#pragma unroll
      for (int i = 0; i < 16; ++i)
#pragma unroll
        for (int j = 0; j < 16; ++j)
          if ((i + 1) * (j + 1) <= 16) TOP_INSERT(t, __uint_as_float((__float_as_uint(v1[i] + v2[j]) & ~255u) | (unsigned)(i * 16 + j)));
      float e[16], sum = 0.f; unsigned ex[16];
      const float m0 = __uint_as_float(__float_as_uint(t[0]) & ~255u);
#pragma unroll
      for (int i = 0; i < 16; ++i) {
        const unsigned bits = __float_as_uint(t[i]), id = bits & 255u;
        const unsigned i1 = __float_as_uint(TK[(size_t)tid * 16 + (id >> 4)]) & 127u, i2 = __float_as_uint(TK[(size_t)(128 + tid) * 16 + (id & 15u)]) & 127u;
        ex[i] = i1 * 128u + i2;
        e[i] = __expf(__uint_as_float(bits & ~255u) - m0); sum += e[i];
      }
      const float inv = 1.f / sum;
      uint2* dst = TOPK + ((size_t)(R0 + tid) * 8 + hd) * 16;
#pragma unroll
      for (int i = 0; i < 16; i += 2) {
        uint4 o = {ex[i], __float_as_uint(e[i] * inv), ex[i + 1], __float_as_uint(e[i + 1] * inv)};
        *(uint4*)(dst + i) = o;
      }
    }
    __syncthreads();
  }
}

typedef __attribute__((ext_vector_type(4))) float f32x4;
#define MFMA4(a, b, c) __builtin_amdgcn_mfma_f32_4x4x4bf16_1k((a), (b), (c), 0, 0, 0)
constexpr int P7_VROW = 2112, P7_VBUF = 4 * P7_VROW;
constexpr int P7_RING = 64;
constexpr int P7_ENT  = P7_RING + 8 * 2 * P7_VBUF;
constexpr int P7_CNT  = P7_ENT + 8 * 2048;
static_assert(P7_CNT + 8 * 256 <= LDS_BYTES, "phase 7 LDS map");
__device__ __forceinline__ float sel4(const f32x4& d, int k) { return k == 0 ? d[0] : (k == 1 ? d[1] : (k == 2 ? d[2] : d[3])); }
__device__ __forceinline__ unsigned fp8x2_bf16(unsigned x, float sc, bool hi) {
  return hi ? __builtin_bit_cast(unsigned, __builtin_amdgcn_cvt_scalef32_pk_bf16_fp8(x, sc, true)) : __builtin_bit_cast(unsigned, __builtin_amdgcn_cvt_scalef32_pk_bf16_fp8(x, sc, false));
}

__device__ void phase7(const Args& a, char* lds) {
  unsigned char* ws = a.ws;
  const int tid = threadIdx.x, lane = tid & 63, wv = __builtin_amdgcn_readfirstlane(tid >> 6), blk = lane >> 2, j4 = lane & 3;
  const u16* H = (const u16*)(ws + WS_H); const unsigned char* U8 = ws + WS_UB; const unsigned char* V8 = ws + WS_VB;
  const uint2* TOPK = (const uint2*)(ws + WS_TOPK); const float* X1 = (const float*)(ws + WS_X1); const float* mod = (const float*)(ws + WS_MOD);
  const unsigned lbase = (unsigned)(uintptr_t)lds;
  char* ring = lds + P7_RING + wv * 2 * P7_VBUF;
  unsigned* ents = (unsigned*)(lds + P7_ENT + wv * 2048);
  int* cntw = (int*)(lds + P7_CNT + wv * 256);
  const int trb = (int)(lbase + P7_RING + wv * 2 * P7_VBUF) + ((lane & 15) >> 2) * P7_VROW + 32 * (lane >> 4) + 8 * (lane & 3);
  const int NWV = gridDim.x * 8;
  for (int qd = blockIdx.x * 8 + wv; qd < T / 4; qd += NWV) {
    const int tok0 = qd * 4, b = tok0 >> 12;
    cntw[lane] = 0;
    asm volatile("s_waitcnt lgkmcnt(0)" ::: "memory");
    {
      uint2 en[8];
#pragma unroll
      for (int i = 0; i < 8; ++i) { const int e = lane + 64 * i; en[i] = TOPK[(size_t)(tok0 + (e >> 7)) * 128 + (e & 127)]; }
#pragma unroll
      for (int i = 0; i < 8; ++i) atomicAdd(&cntw[en[i].x >> 8], 1);
      asm volatile("s_waitcnt lgkmcnt(0)" ::: "memory");
      const int c = cntw[lane]; int inc = c;
#pragma unroll
      for (int o = 1; o < 64; o <<= 1) { const int v = __shfl_up(inc, o, 64); if (lane >= o) inc += v; }
      asm volatile("s_waitcnt lgkmcnt(0)" ::: "memory");
      cntw[lane] = inc - c;
      asm volatile("s_waitcnt lgkmcnt(0)" ::: "memory");
#pragma unroll
      for (int i = 0; i < 8; ++i) {
        const int e = lane + 64 * i;
        const int pos = atomicAdd(&cntw[en[i].x >> 8], 1);
        ents[pos] = en[i].x | ((unsigned)(e >> 7) << 14) | (pack2(0.f, __uint_as_float(en[i].y)) & 0xFFFF0000u);
      }
      asm volatile("s_waitcnt lgkmcnt(0)" ::: "memory");
    }
    u32x4 hA[4][2];
#pragma unroll
    for (int i = 0; i < 4; ++i) { const u16* ph = H + (size_t)(tok0 + j4) * 1024 + 256 * i + 16 * blk; hA[i][0] = *(const u32x4*)ph; hA[i][1] = *(const u32x4*)(ph + 8); }
    f32x4 acc[16];
#pragma unroll
    for (int c = 0; c < 16; ++c) acc[c] = (f32x4){0.f, 0.f, 0.f, 0.f};
#define P7_VPHASE(bufi) do { const int _vb = trb + (bufi) * P7_VBUF;                                                            \
      { const s16x4 v0 = tr_read<0>(_vb), v1 = tr_read<128>(_vb), v2 = tr_read<256>(_vb), v3 = tr_read<384>(_vb),               \
                    v4 = tr_read<512>(_vb), v5 = tr_read<640>(_vb), v6 = tr_read<768>(_vb), v7 = tr_read<896>(_vb);               \
        asm volatile("s_waitcnt lgkmcnt(0)" ::: "memory"); SBAR();                                                                \
        acc[0] = MFMA4(awp, v0, acc[0]); acc[1] = MFMA4(awp, v1, acc[1]); acc[2] = MFMA4(awp, v2, acc[2]); acc[3] = MFMA4(awp, v3, acc[3]);   \
        acc[4] = MFMA4(awp, v4, acc[4]); acc[5] = MFMA4(awp, v5, acc[5]); acc[6] = MFMA4(awp, v6, acc[6]); acc[7] = MFMA4(awp, v7, acc[7]); } \
      { const s16x4 v0 = tr_read<1024>(_vb), v1 = tr_read<1152>(_vb), v2 = tr_read<1280>(_vb), v3 = tr_read<1408>(_vb),         \
                    v4 = tr_read<1536>(_vb), v5 = tr_read<1664>(_vb), v6 = tr_read<1792>(_vb), v7 = tr_read<1920>(_vb);           \
        asm volatile("s_waitcnt lgkmcnt(0)" ::: "memory"); SBAR();                                                                \
        acc[8] = MFMA4(awp, v0, acc[8]); acc[9] = MFMA4(awp, v1, acc[9]); acc[10] = MFMA4(awp, v2, acc[10]); acc[11] = MFMA4(awp, v3, acc[11]); \
        acc[12] = MFMA4(awp, v4, acc[12]); acc[13] = MFMA4(awp, v5, acc[13]); acc[14] = MFMA4(awp, v6, acc[14]); acc[15] = MFMA4(awp, v7, acc[15]); } } while (0)
    u32x4 u8[4], v8[4];
#define P7_LOADG(EN) do { const unsigned _ex = (EN) & 0x3FFFu; const unsigned char* _pu = U8 + (size_t)_ex * 1024 + 16 * blk;      \
      _Pragma("unroll") for (int _i = 0; _i < 4; ++_i) u8[_i] = *(const u32x4*)(_pu + 256 * _i);                                 \
      _Pragma("unroll") for (int _q = 0; _q < 4; ++_q) { const unsigned _eq = (unsigned)__builtin_amdgcn_readlane((int)_ex, _q);  \
        v8[_q] = *(const u32x4*)(V8 + (size_t)_eq * 1024 + 16 * lane); } } while (0)
    unsigned enc = ents[j4], enn = ents[4 + j4];
    P7_LOADG(enc);
    s16x4 awp = {0, 0, 0, 0};
    constexpr int NG = 128;
    for (int g = 0; g < NG; ++g) {
      if (g > 0) P7_VPHASE((g - 1) & 1);
      f32x4 d0 = {0.f, 0.f, 0.f, 0.f}, d1 = {0.f, 0.f, 0.f, 0.f};
#pragma unroll
      for (int i = 0; i < 4; ++i)
#pragma unroll
        for (int w = 0; w < 4; ++w) {
          const uint2 ub = {fp8x2_bf16(u8[i][w], 1.f / PEER_SU, false), fp8x2_bf16(u8[i][w], 1.f / PEER_SU, true)};
          const uint2 ha = {hA[i][w >> 1][2 * (w & 1)], hA[i][w >> 1][2 * (w & 1) + 1]};
          if (w & 1) d1 = MFMA4(__builtin_bit_cast(s16x4, ha), __builtin_bit_cast(s16x4, ub), d1);
          else       d0 = MFMA4(__builtin_bit_cast(s16x4, ha), __builtin_bit_cast(s16x4, ub), d0);
        }
      { char* vw = ring + (g & 1) * P7_VBUF + lane * 32;
#pragma unroll
        for (int q = 0; q < 4; ++q) {
          u32x4 o0, o1;
          o0[0] = fp8x2_bf16(v8[q][0], 1.f / PEER_SV, false); o0[1] = fp8x2_bf16(v8[q][0], 1.f / PEER_SV, true);
          o0[2] = fp8x2_bf16(v8[q][1], 1.f / PEER_SV, false); o0[3] = fp8x2_bf16(v8[q][1], 1.f / PEER_SV, true);
          o1[0] = fp8x2_bf16(v8[q][2], 1.f / PEER_SV, false); o1[1] = fp8x2_bf16(v8[q][2], 1.f / PEER_SV, true);
          o1[2] = fp8x2_bf16(v8[q][3], 1.f / PEER_SV, false); o1[3] = fp8x2_bf16(v8[q][3], 1.f / PEER_SV, true);
          *(u32x4*)(vw + q * P7_VROW) = o0; *(u32x4*)(vw + q * P7_VROW + 16) = o1;
        } }
      unsigned en2 = 0u;
      if (g + 1 < NG) { P7_LOADG(enn); if (g + 2 < NG) en2 = ents[4 * (g + 2) + j4]; }
      const int tk = (enc >> 14) & 3;
      float av = sel4(d0, tk) + sel4(d1, tk);
      av += __uint_as_float(__builtin_amdgcn_update_dpp(0, __float_as_uint(av), 0x124, 0xf, 0xf, false));
      av += __uint_as_float(__builtin_amdgcn_update_dpp(0, __float_as_uint(av), 0x128, 0xf, 0xf, false));
      av += __shfl_xor(av, 16, 64);
      { auto rr = __builtin_amdgcn_permlane32_swap(__float_as_uint(av), __float_as_uint(av), false, false); av = __uint_as_float(rr[0]) + __uint_as_float(rr[1]); }
      const float wgt = gelu_exact(av) * __uint_as_float(enc & 0xFFFF0000u);
      float z[4];
#define P7_QB(x, k) __builtin_amdgcn_update_dpp(0, (x), (k) * 0x55, 0xf, 0xf, false)
      { const unsigned wb = __float_as_uint(wgt), tb = (unsigned)tk;
        unsigned w0 = P7_QB(wb, 0), w1 = P7_QB(wb, 1), w2 = P7_QB(wb, 2), w3 = P7_QB(wb, 3);
        unsigned t0 = P7_QB(tb, 0), t1 = P7_QB(tb, 1), t2 = P7_QB(tb, 2), t3 = P7_QB(tb, 3);
        asm volatile("" : "+v"(w0), "+v"(w1), "+v"(w2), "+v"(w3), "+v"(t0), "+v"(t1), "+v"(t2), "+v"(t3));
        z[0] = ((int)t0 == j4) ? __uint_as_float(w0) : 0.f; z[1] = ((int)t1 == j4) ? __uint_as_float(w1) : 0.f;
        z[2] = ((int)t2 == j4) ? __uint_as_float(w2) : 0.f; z[3] = ((int)t3 == j4) ? __uint_as_float(w3) : 0.f; }
#undef P7_QB
      { const uint2 pk = {pack2(z[0], z[1]), pack2(z[2], z[3])}; awp = __builtin_bit_cast(s16x4, pk); }
      enc = enn; enn = en2;
    }
#undef P7_LOADG
    P7_VPHASE((NG - 1) & 1);
#undef P7_VPHASE
    int lne = lane; asm volatile("" : "+v"(lne));
    float ss[4] = {0.f, 0.f, 0.f, 0.f};
#pragma unroll
    for (int c = 0; c < 16; ++c) {
      const float g2 = mod[b * 6144 + 5120 + 64 * c + lne];
#pragma unroll
      for (int r = 0; r < 4; ++r) { const float v = X1[(size_t)(tok0 + r) * 1024 + 64 * c + lne] + g2 * acc[c][r]; acc[c][r] = v; ss[r] += v * v; }
    }
    float rstd[4];
#pragma unroll
    for (int r = 0; r < 4; ++r) rstd[r] = rsqrtf(wave_sum(ss[r]) * (1.f / 1024.f) + EPS);
#pragma unroll
    for (int c = 0; c < 16; ++c) {
      const float gf = a.g_final[64 * c + lne];
#pragma unroll
      for (int r = 0; r < 4; ++r) a.out[(size_t)(tok0 + r) * 1024 + 64 * c + lne] = acc[c][r] * rstd[r] * gf;
    }
  }
}

constexpr int N_PHASES = 9;
__global__ void __launch_bounds__(512, 2) fwd(Args args) {
  extern __shared__ __attribute__((aligned(16))) char lds[];
  if (threadIdx.x == 0) *(uint4*)lds = make_uint4(0u, 0u, 0u, 0u);
  __syncthreads();
  const int lo = args.ph_lo, hi = args.ph_hi;
  XcdBarrier bar; bar.bar = (unsigned*)(args.ws + WS_BAR); bar.x = 0; bar.st = (volatile LAS unsigned*)lds;
  if (hi - lo > 1) bar = xcd_barrier_post((unsigned*)(args.ws + WS_BAR), (volatile LAS unsigned*)lds);
#ifndef ONLY_PHASE
#define ONLY_PHASE -1
#endif
#define IN(k) (lo <= (k) && (k) < hi && (ONLY_PHASE < 0 || ONLY_PHASE == (k)))
#define SEAM(k) do { if (IN(k) && IN((k) + 1)) xcd_barrier(bar); } while (0)
  if (IN(0)) phase0(args);
  SEAM(0);
  if (IN(1)) phase1(args, lds);
  SEAM(1);
  if (IN(2)) phase2(args, lds);
  SEAM(2);
  if (IN(3)) phase3(args, lds);
  SEAM(3);
  if (IN(4)) phase4(args, lds);
  SEAM(4);
  if (IN(5)) phase5(args, lds);
  SEAM(5);
  if (IN(6)) phase5b(args);
  SEAM(6);
  if (IN(7)) phase6(args, lds);
  SEAM(7);
  if (IN(8)) phase7(args, lds);
#undef IN
#undef SEAM
}

extern "C" void kernel_launch(void* const* d_in, const int* in_sizes, int n_in, void* d_out, int out_size, void* d_ws, size_t ws_size, hipStream_t stream) {
  static int grid = 0;
  if (grid == 0) {
    if (n_in != 23 || out_size != T * DM || ws_size < WS_END) { fprintf(stderr, "kernel_launch: unexpected shapes (n_in %d out %d ws %zu need %zu)\n", n_in, out_size, ws_size, (size_t)WS_END); grid = -1; return; }
    int dev = 0, cus = 0, per_cu = 0;
    (void)hipGetDevice(&dev); (void)hipDeviceGetAttribute(&cus, hipDeviceAttributeMultiprocessorCount, dev);
    if (hipFuncSetAttribute((const void*)fwd, hipFuncAttributeMaxDynamicSharedMemorySize, LDS_BYTES) != hipSuccess) { fprintf(stderr, "kernel_launch: hipFuncSetAttribute failed\n"); grid = -1; return; }
    if (hipOccupancyMaxActiveBlocksPerMultiprocessor(&per_cu, (const void*)fwd, 512, LDS_BYTES) != hipSuccess || per_cu < 1) { fprintf(stderr, "kernel_launch: occupancy query says %d\n", per_cu); per_cu = 1; }
    (void)hipGetLastError();
    grid = cus;
  }
  if (grid < 0) return;
  (void)hipMemsetAsync((char*)d_ws + WS_BAR, 0, 16384, stream);
  Args a{};
  a.x = (const float*)d_in[0]; a.c = (const float*)d_in[1]; a.pos = (const int*)d_in[2];
  a.w_ada = (const float*)d_in[3]; a.b_ada = (const float*)d_in[4]; a.g_norm1 = (const float*)d_in[5]; a.w_in = (const float*)d_in[6];
  a.g_q_a = (const float*)d_in[7]; a.w_uq = (const float*)d_in[8]; a.g_kv_a = (const float*)d_in[9]; a.w_ukv = (const float*)d_in[10];
  a.g_sg = (const float*)d_in[11]; a.w_sg = (const float*)d_in[12]; a.b_sg = (const float*)d_in[13]; a.g_attn_out = (const float*)d_in[14];
  a.g_sg_out = (const float*)d_in[15]; a.w_o = (const float*)d_in[16]; a.g_norm2 = (const float*)d_in[17]; a.w_peer_q = (const float*)d_in[18];
  a.peer_keys = (const float*)d_in[19]; a.peer_u = (const float*)d_in[20]; a.peer_v = (const float*)d_in[21]; a.g_final = (const float*)d_in[22];
  a.out = (float*)d_out; a.ws = (unsigned char*)d_ws;
#if N_LAUNCH_MODE == 0
  a.ph_lo = 0; a.ph_hi = N_PHASES;
  hipLaunchKernelGGL(fwd, dim3(grid), dim3(512), LDS_BYTES, stream, a);
#else
  for (int p = 0; p < N_PHASES; ++p) for (int rep = 0; rep <= ((DUP_MASK >> p) & 1); ++rep) { a.ph_lo = p; a.ph_hi = p + 1; hipLaunchKernelGGL(fwd, dim3(grid), dim3(512), LDS_BYTES, stream, a); }
#endif
  const hipError_t le = hipPeekAtLastError();
  if (le != hipSuccess) fprintf(stderr, "kernel_launch: launch failed: %s\n", hipGetErrorName(le));
}
```

```cpp
#include <hip/hip_runtime.h>
#include <stdint.h>
#include <stdio.h>

#define N_LAUNCH_MODE 0
#define DUP_MASK 0x000

typedef unsigned short u16;
typedef __attribute__((ext_vector_type(8))) short bf16x8;
typedef __attribute__((ext_vector_type(4))) short s16x4;
typedef __attribute__((ext_vector_type(16))) float f32x16;
typedef __attribute__((ext_vector_type(4))) unsigned u32x4;

constexpr int T = 16384, DM = 1024, SEQ = 4096;
constexpr float EPS = 1e-6f;

constexpr size_t WS_BAR  = 0;
constexpr size_t WS_MODP = 16384;
constexpr size_t WS_MOD  = WS_MODP + 786432;
constexpr size_t WS_CS   = WS_MOD + 98304;
constexpr size_t WS_WIN  = WS_CS + 4194304;
constexpr size_t WS_WQ2  = WS_WIN + 3145728;
constexpr size_t WS_WUV  = WS_WQ2 + 393216;
constexpr size_t WS_WO   = WS_WUV + 131072;
constexpr size_t WS_WPQ  = WS_WO + 2097152;
constexpr size_t WS_KEYS = WS_WPQ + 4194304;
constexpr size_t WS_WSG  = WS_KEYS + 524288;
constexpr size_t WS_UB   = WS_WSG + 131072;
constexpr size_t WS_VB   = WS_UB + 33554432;
constexpr size_t WS_H    = WS_VB + 33554432;
constexpr size_t WS_Y    = WS_H + 33554432;
constexpr size_t WS_KV   = WS_Y + 33554432;
constexpr size_t WS_TOPK = WS_KV + 6291456;
constexpr size_t WS_SSQ  = WS_TOPK + 16777216;
constexpr size_t WS_SSQV = WS_SSQ + 262144;
constexpr size_t WS_R1   = WS_SSQV + 131072;
constexpr size_t WS_Q    = WS_R1;
constexpr size_t WS_QA   = WS_Q + 25165824;
constexpr size_t WS_UACT = WS_QA + 8388608;
constexpr size_t WS_GVT  = WS_UACT + 16777216;
constexpr size_t WS_X1   = WS_R1;
constexpr size_t WS_END  = WS_R1 + 67108864;

constexpr int LDS_BYTES = 155648;
constexpr int LDS_DATA  = 64;

struct Args {
  const float *x, *c; const int* pos;
  const float *w_ada, *b_ada, *g_norm1, *w_in, *g_q_a, *w_uq, *g_kv_a, *w_ukv, *g_sg, *w_sg, *b_sg, *g_attn_out, *g_sg_out,
              *w_o, *g_norm2, *w_peer_q, *peer_keys, *peer_u, *peer_v, *g_final;
  float* out; unsigned char* ws; int ph_lo, ph_hi;
};

#define XB_TMO      128
#define XB_XCNT(j)  (256  + 64 * (j))
#define XB_XSUB(j)  (1280 + 64 * (j))
#define XB_XGEN(j)  (2304 + 64 * (j))
#define XB_TOP      3328
#define XB_TOPGEN   3392
#define XCD_BAR_WORDS 3456
#define XB_SPIN_CAP (1u << 18)
#define LAS __attribute__((address_space(3)))

__device__ __forceinline__ unsigned xb_ld(unsigned* p)              { return __hip_atomic_load(p, __ATOMIC_RELAXED, __HIP_MEMORY_SCOPE_AGENT); }
__device__ __forceinline__ unsigned xb_add(unsigned* p, unsigned v) { return __hip_atomic_fetch_add(p, v, __ATOMIC_RELAXED, __HIP_MEMORY_SCOPE_AGENT); }
__device__ __forceinline__ unsigned xb_xcc_id() { return (unsigned)__builtin_amdgcn_s_getreg((3 << 11) | 20) & 0xFu; }
#define XB_SPIN(cond, bar) do { unsigned _sp = 0; while (cond) { __builtin_amdgcn_s_sleep(1); \
    if ((++_sp & 255u) == 0u) { if (xb_ld(&(bar)[XB_TMO])) break; if (_sp > XB_SPIN_CAP) { atomicAdd(&(bar)[XB_TMO], 1u); break; } } } } while (0)

struct XcdBarrier { unsigned* bar; unsigned x; volatile LAS unsigned* st; };

__device__ __forceinline__ XcdBarrier xcd_barrier_post(unsigned* bar, volatile LAS unsigned* st) {
    XcdBarrier b; b.bar = bar; b.x = xb_xcc_id(); b.st = st;
    if (threadIdx.x == 0) (void)xb_add(&bar[XB_XCNT(b.x)], 1u);
    return b;
}
__device__ __forceinline__ void xcd_barrier_complete(unsigned* bar, unsigned x, unsigned& nloc, unsigned& nx) {
    const unsigned G = gridDim.x * gridDim.y * gridDim.z;
    unsigned sum, cnt, mine, sp = 0u;
    for (;;) {
        sum = 0u; cnt = 0u; mine = 0u;
#pragma unroll
        for (unsigned j = 0; j < 16; ++j) { const unsigned c = xb_ld(&bar[XB_XCNT(j)]); sum += c; cnt += (c > 0u) ? 1u : 0u; mine = (j == x) ? c : mine; }
        if (sum == G) break;
        __builtin_amdgcn_s_sleep(1);
        if ((++sp & 255u) == 0u) { if (xb_ld(&bar[XB_TMO])) break; if (sp > XB_SPIN_CAP) { atomicAdd(&bar[XB_TMO], 1u); break; } }
    }
    nloc = mine > 0u ? mine : 1u; nx = cnt > 0u ? cnt : 1u;
}
__device__ __forceinline__ void xcd_barrier(const XcdBarrier& b) {
    asm volatile("s_waitcnt vmcnt(0)" ::: "memory");
    __syncthreads();
    if (threadIdx.x == 0) {
        unsigned* bar = b.bar;
        __builtin_amdgcn_s_waitcnt(0);
        unsigned nloc = b.st[0], nx = b.st[1];
        if (nloc == 0u) { xcd_barrier_complete(bar, b.x, nloc, nx); b.st[0] = nloc; b.st[1] = nx; }
        const unsigned old = xb_add(&bar[XB_XSUB(b.x)], 1u);
        const unsigned gen = old / nloc;
        if (old + 1u == (gen + 1u) * nloc) {
            __builtin_amdgcn_fence(__ATOMIC_RELEASE, "agent");
            asm volatile("s_waitcnt vmcnt(0)" ::: "memory");
            const unsigned og = xb_add(&bar[XB_TOP], 1u);
            const unsigned tg = og / nx;
            if (og + 1u == (tg + 1u) * nx) xb_add(&bar[XB_TOPGEN], 1u);
            else XB_SPIN(xb_ld(&bar[XB_TOPGEN]) == tg, bar);
            __builtin_amdgcn_fence(__ATOMIC_ACQUIRE, "agent");
            xb_add(&bar[XB_XGEN(b.x)], 1u);
            asm volatile("s_waitcnt vmcnt(0)" ::: "memory");
        } else {
            XB_SPIN(xb_ld(&bar[XB_XGEN(b.x)]) == gen, bar);
            __builtin_amdgcn_fence(__ATOMIC_ACQUIRE, "agent");
            asm volatile("s_waitcnt vmcnt(0)" ::: "memory");
        }
    }
    __syncthreads();
}

__device__ __forceinline__ unsigned pack2(float lo, float hi) {
  typedef __attribute__((ext_vector_type(2))) float f2; typedef __attribute__((ext_vector_type(2))) __bf16 b2;
  f2 v = {lo, hi}; b2 r = __builtin_convertvector(v, b2); return __builtin_bit_cast(unsigned, r);
}
__device__ __forceinline__ u16 f2bf(float f) { return (u16)(pack2(f, 0.f) & 0xFFFFu); }
__device__ __forceinline__ float bflo(unsigned w) { return __uint_as_float(w << 16); }
__device__ __forceinline__ float bfhi(unsigned w) { return __uint_as_float(w & 0xFFFF0000u); }
__device__ __forceinline__ float gelu_exact(float x) {
  const float z = fabsf(x) * 0.70710678118654752f;
  const float t = __builtin_amdgcn_rcpf(fmaf(0.3275911f, z, 1.f));
  float p = fmaf(1.061405429f, t, -1.453152027f); p = fmaf(p, t, 1.421413741f); p = fmaf(p, t, -0.284496736f); p = fmaf(p, t, 0.254829592f);
  const float e = p * t * __expf(-z * z);
  const float erfz = 1.f - e;
  return 0.5f * x * (1.f + copysignf(erfz, x));
}
__device__ __forceinline__ float wave_sum(float v) {
#pragma unroll
  for (int o = 32; o > 0; o >>= 1) v += __shfl_xor(v, o, 64);
  return v;
}
__device__ __forceinline__ int crow(int r, int hi) { return (r & 3) + 8 * (r >> 2) + 4 * hi; }
#define MFMA32(a, b, c) __builtin_amdgcn_mfma_f32_32x32x16_bf16((a), (b), (c), 0, 0, 0)

template <int MAP> __device__ __forceinline__ int colmap(int n) {
  if (MAP == 0) return n;
  if (MAP == 1) return n < 448 ? n : (n < 512 ? -1 : n - 64);
  if (MAP == 2) return (n >> 6) * 192 + 128 + (n & 63);
  return (n >> 7) * 256 + 128 + (n & 127);
}
template <int MAP> __device__ void cvt_transpose(const float* __restrict__ src, int src_ld, int K, int N, u16* __restrict__ dst, int gtid, int gthreads) {
  const int total = N * (K >> 3);
  for (int idx = gtid; idx < total; idx += gthreads) {
    const int n = idx % N, k8 = idx / N, sc = colmap<MAP>(n);
    float v[8];
#pragma unroll
    for (int j = 0; j < 8; ++j) v[j] = sc < 0 ? 0.f : src[(size_t)(k8 * 8 + j) * src_ld + sc];
    u32x4 w = {pack2(v[0], v[1]), pack2(v[2], v[3]), pack2(v[4], v[5]), pack2(v[6], v[7])};
    *(u32x4*)(dst + (size_t)n * K + k8 * 8) = w;
  }
}
template <int MAP> __device__ void cvt_transpose_tiled(const float* __restrict__ src, int src_ld, int K, int N, u16* __restrict__ dst, float* tile) {
  const int tid = threadIdx.x, tk = K >> 6, ntile = tk * (N >> 6);
  for (int t = blockIdx.x; t < ntile; t += gridDim.x) {
    const int k0 = (t % tk) * 64, n0 = (t / tk) * 64;
    __syncthreads();
    { const int nl = tid & 63, sc = colmap<MAP>(n0 + nl);
#pragma unroll
      for (int i = 0; i < 8; ++i) { const int k = (tid >> 6) + 8 * i; tile[k * 65 + nl] = sc < 0 ? 0.f : src[(size_t)(k0 + k) * src_ld + sc]; } }
    __syncthreads();
    { const int n = tid >> 3, kk = tid & 7; float v[8];
#pragma unroll
      for (int j = 0; j < 8; ++j) v[j] = tile[(8 * kk + j) * 65 + n];
      u32x4 w = {pack2(v[0], v[1]), pack2(v[2], v[3]), pack2(v[4], v[5]), pack2(v[6], v[7])};
      *(u32x4*)(dst + (size_t)(n0 + n) * K + k0 + 8 * kk) = w; }
  }
}
__device__ void cvt_direct(const float* __restrict__ src, u16* __restrict__ dst, size_t n8, int gtid, int gthreads) {
  for (size_t i = gtid; i < n8; i += gthreads) {
    const float4 a = *(const float4*)(src + i * 8), b = *(const float4*)(src + i * 8 + 4);
    u32x4 w = {pack2(a.x, a.y), pack2(a.z, a.w), pack2(b.x, b.y), pack2(b.z, b.w)};
    *(u32x4*)(dst + i * 8) = w;
  }
}
constexpr float PEER_SU = 32.f, PEER_SV = 4.f;
__device__ void cvt_fp8(const float* __restrict__ src, unsigned char* __restrict__ dst, size_t n16, float sc, int gtid, int gthreads) {
  for (size_t i = gtid; i < n16; i += gthreads) {
    u32x4 w;
#pragma unroll
    for (int k = 0; k < 4; ++k) {
      const float4 a = *(const float4*)(src + i * 16 + 4 * k);
      int p = __builtin_amdgcn_cvt_pk_fp8_f32(a.x * sc, a.y * sc, 0, false);
      p = __builtin_amdgcn_cvt_pk_fp8_f32(a.z * sc, a.w * sc, p, true);
      w[k] = (unsigned)p;
    }
    *(u32x4*)(dst + i * 16) = w;
  }
}
__device__ __forceinline__ void sincos_acc(float angf, float& sn, float& cs) {
  const double a = (double)angf;
  const double q = __builtin_rint(a * 0.63661977236758134308);
  double r = __builtin_fma(-q, 1.5707963267948966, a);
  r = __builtin_fma(-q, 6.123233995736766e-17, r);
  const double r2 = r * r;
  double s = r2 * (1.0 / 6227020800.0) - 1.0 / 39916800.0;
  s = s * r2 + 1.0 / 362880.0; s = s * r2 - 1.0 / 5040.0; s = s * r2 + 1.0 / 120.0; s = s * r2 - 1.0 / 6.0; s = r + r * r2 * s;
  double c = -r2 * (1.0 / 87178291200.0) + 1.0 / 479001600.0;
  c = c * r2 - 1.0 / 3628800.0; c = c * r2 + 1.0 / 40320.0; c = c * r2 - 1.0 / 720.0; c = c * r2 + 1.0 / 24.0; c = c * r2 - 0.5; c = 1.0 + r2 * c;
  const int n = ((int)q) & 3;
  const double ss = (n & 1) ? c : s, cc = (n & 1) ? s : c;
  sn = (float)((n & 2) ? -ss : ss);
  cs = (float)(((n + 1) & 2) ? -cc : cc);
}

__constant__ float INVF[32] = {1.000000000e+00f, 7.498942018e-01f, 5.623413324e-01f, 4.216965139e-01f, 3.162277639e-01f, 2.371373922e-01f, 1.778279394e-01f, 1.333521456e-01f,
  1.000000015e-01f, 7.498941571e-02f, 5.623412877e-02f, 4.216964915e-02f, 3.162277862e-02f, 2.371373586e-02f, 1.778279431e-02f, 1.333521493e-02f,
  9.999999776e-03f, 7.498942316e-03f, 5.623413250e-03f, 4.216964822e-03f, 3.162277862e-03f, 2.371373819e-03f, 1.778279431e-03f, 1.333521446e-03f,
  1.000000047e-03f, 7.498941850e-04f, 5.623413017e-04f, 4.216965463e-04f, 3.162277862e-04f, 2.371373848e-04f, 1.778279402e-04f, 1.333521504e-04f};
__device__ void phase0(const Args& a, char* lds) {
  unsigned char* ws = a.ws;
  const int tid = threadIdx.x, lane = tid & 63, wv = tid >> 6;
  const int NWV = gridDim.x * 8, gw = blockIdx.x * 8 + wv;
  const int gthreads = gridDim.x * 512, gtid = blockIdx.x * 512 + tid;
  float* modp = (float*)(ws + WS_MODP);
  for (int job = gw; job < 768; job += NWV) {
    const int cg = job % 96, ks = job / 96, col = cg * 64 + lane;
    float a0 = 0.f, a1 = 0.f, a2 = 0.f, a3 = 0.f;
    const float* w = a.w_ada + (size_t)(ks * 128) * 6144 + col;
    float sv[2][4];
#pragma unroll
    for (int h = 0; h < 2; ++h)
#pragma unroll
      for (int bb = 0; bb < 4; ++bb) { const float cv = a.c[bb * 1024 + ks * 128 + 64 * h + lane]; sv[h][bb] = cv / (1.f + __expf(-cv)); }
#pragma unroll
    for (int h = 0; h < 2; ++h) {
#pragma unroll 8
      for (int k = 0; k < 64; ++k) {
        const float wv_ = w[(size_t)(64 * h + k) * 6144];
        a0 += __uint_as_float(__builtin_amdgcn_readlane(__float_as_uint(sv[h][0]), k)) * wv_;
        a1 += __uint_as_float(__builtin_amdgcn_readlane(__float_as_uint(sv[h][1]), k)) * wv_;
        a2 += __uint_as_float(__builtin_amdgcn_readlane(__float_as_uint(sv[h][2]), k)) * wv_;
        a3 += __uint_as_float(__builtin_amdgcn_readlane(__float_as_uint(sv[h][3]), k)) * wv_;
      }
    }
    modp[(ks * 4 + 0) * 6144 + col] = a0; modp[(ks * 4 + 1) * 6144 + col] = a1;
    modp[(ks * 4 + 2) * 6144 + col] = a2; modp[(ks * 4 + 3) * 6144 + col] = a3;
  }
  { float* tile = (float*)(lds + LDS_DATA);
    cvt_transpose_tiled<1>(a.w_in, 1472, 1024, 1536, (u16*)(ws + WS_WIN), tile);
    cvt_transpose_tiled<0>(a.w_o, 1024, 1024, 1024, (u16*)(ws + WS_WO), tile);
    cvt_transpose_tiled<0>(a.w_peer_q, 2048, 1024, 2048, (u16*)(ws + WS_WPQ), tile);
    cvt_transpose_tiled<2>(a.w_uq, 768, 256, 256, (u16*)(ws + WS_WQ2) + 512 * 256, tile);
    cvt_transpose_tiled<3>(a.w_ukv, 1024, 128, 512, (u16*)(ws + WS_WUV), tile); }
  {
    u16* wq2 = (u16*)(ws + WS_WQ2);
    for (int idx = gtid; idx < 512 * 256; idx += gthreads) {
      const int n = idx >> 8, i = idx & 255, h = n >> 7, cc = n & 127;
      const float* pu = a.w_uq + (size_t)i * 768 + h * 192;
      const float* pk = a.w_ukv + (size_t)cc * 1024 + h * 256;
      float s = 0.f;
#pragma unroll 8
      for (int d = 0; d < 128; d += 4) {
        const float4 u = *(const float4*)(pu + d), k = *(const float4*)(pk + d);
        s += u.x * k.x + u.y * k.y + u.z * k.z + u.w * k.w;
      }
      wq2[(size_t)n * 256 + i] = f2bf(s);
    }
  }
  cvt_direct(a.peer_keys, (u16*)(ws + WS_KEYS), 262144 / 8, gtid, gthreads);
  cvt_direct(a.w_sg, (u16*)(ws + WS_WSG), 65536 / 8, gtid, gthreads);
  cvt_fp8(a.peer_u, (unsigned char*)(ws + WS_UB), (size_t)16384 * 1024 / 16, PEER_SU, gtid, gthreads);
  cvt_fp8(a.peer_v, (unsigned char*)(ws + WS_VB), (size_t)16384 * 1024 / 16, PEER_SV, gtid, gthreads);
  {
    float* cs = (float*)(ws + WS_CS);
    for (int idx = gtid; idx < T * 32; idx += gthreads) {
      const int t = idx >> 5, i = idx & 31;
      const float inv = INVF[i];
      const float ang = (float)a.pos[t] * inv;
      float sn, c_; sincos_acc(ang, sn, c_);
      cs[(size_t)t * 64 + i] = c_; cs[(size_t)t * 64 + 32 + i] = sn;
    }
  }
}

__device__ void phase1(const Args& a, char* lds) {
  unsigned char* ws = a.ws;
  const int tid = threadIdx.x, lane = tid & 63, wv = tid >> 6;
  const float* modp = (const float*)(ws + WS_MODP);
  float* mod = (float*)(ws + WS_MOD);
  for (int idx = blockIdx.x * 512 + tid; idx < 4 * 6144; idx += gridDim.x * 512) {
    const int b = idx / 6144, m = idx % 6144;
    float s = a.b_ada[m];
#pragma unroll
    for (int ks = 0; ks < 8; ++ks) s += modp[(ks * 4 + b) * 6144 + m];
    mod[idx] = s;
  }
  float* sh = (float*)(lds + LDS_DATA);
  u16* H = (u16*)(ws + WS_H);
  for (int u = blockIdx.x; u < T / 64; u += gridDim.x) {
    const int b = u >> 6;
    __syncthreads();
    for (int j = tid; j < 2048; j += 512) {
      float s = a.b_ada[j];
#pragma unroll
      for (int ks = 0; ks < 8; ++ks) s += modp[(ks * 4 + b) * 6144 + j];
      sh[j] = s;
    }
    __syncthreads();
    for (int i = 0; i < 8; ++i) {
      const int r = u * 64 + wv * 8 + i;
      float4 xv[4]; float ssq = 0.f;
#pragma unroll
      for (int j = 0; j < 4; ++j) { xv[j] = *(const float4*)(a.x + (size_t)r * 1024 + j * 256 + lane * 4); ssq += xv[j].x * xv[j].x + xv[j].y * xv[j].y + xv[j].z * xv[j].z + xv[j].w * xv[j].w; }
      ssq = wave_sum(ssq);
      const float rstd = rsqrtf(ssq * (1.f / 1024.f) + EPS);
#pragma unroll
      for (int j = 0; j < 4; ++j) {
        const int col = j * 256 + lane * 4;
        const float4 g = *(const float4*)(a.g_norm1 + col);
        const float h0 = xv[j].x * rstd * g.x * (1.f + sh[1024 + col]) + sh[col];
        const float h1 = xv[j].y * rstd * g.y * (1.f + sh[1024 + col + 1]) + sh[col + 1];
        const float h2 = xv[j].z * rstd * g.z * (1.f + sh[1024 + col + 2]) + sh[col + 2];
        const float h3 = xv[j].w * rstd * g.w * (1.f + sh[1024 + col + 3]) + sh[col + 3];
        uint2 o = {pack2(h0, h1), pack2(h2, h3)};
        *(uint2*)(H + (size_t)r * 1024 + col) = o;
      }
    }
  }
}

constexpr int G_STAGE = 49152;
__device__ __forceinline__ void dma16(const void* gsrc, unsigned lds_dst) {
  unsigned keep;
  asm volatile("s_mov_b32 %0, m0\n\ts_mov_b32 m0, %2\n\ts_nop 0\n\tglobal_load_lds_dwordx4 %1, off\n\ts_mov_b32 m0, %0"
               : "=&s"(keep) : "v"(gsrc), "s"(lds_dst) : "memory");
}
__device__ __forceinline__ void gemm_128x256(const u16* __restrict__ A, int lda, const u16* __restrict__ Bt, int ldb, int KT,
                                             f32x16 (&acc)[2][2], char* lds) {
  const int tid = threadIdx.x, lane = tid & 63, wv = __builtin_amdgcn_readfirstlane(tid >> 6), r32 = lane & 31, hi = lane >> 5;
  const int wm = wv >> 2, wn = wv & 3;
  const int rin = lane >> 3, cc = lane & 7;
  const u16* pa[2]; const u16* pb[4];
#pragma unroll
  for (int j = 0; j < 2; ++j) pa[j] = A + (size_t)(16 * wv + 8 * j + rin) * lda + 8 * (cc ^ (4 * j + (rin >> 1)));
#pragma unroll
  for (int i = 0; i < 4; ++i) pb[i] = Bt + (size_t)(32 * wv + 8 * i + rin) * ldb + 8 * (cc ^ (4 * (i & 1) + (rin >> 1)));
  const unsigned lb = __builtin_amdgcn_readfirstlane((unsigned)(uintptr_t)lds);
  const unsigned dA = lb + 2048 * wv, dB = lb + 16384 + 4096 * wv;
#define G_ISSUE(stage, kt_) do { const unsigned _so = (unsigned)(stage) * G_STAGE; const int _ko = (kt_) * 64;                     \
    dma16(pa[0] + _ko, dA + _so); dma16(pa[1] + _ko, dA + _so + 1024);                                                           \
    dma16(pb[0] + _ko, dB + _so); dma16(pb[1] + _ko, dB + _so + 1024); dma16(pb[2] + _ko, dB + _so + 2048); dma16(pb[3] + _ko, dB + _so + 3072); } while (0)
#pragma unroll
  for (int m = 0; m < 2; ++m)
#pragma unroll
    for (int n = 0; n < 2; ++n)
#pragma unroll
      for (int r = 0; r < 16; ++r) acc[m][n][r] = 0.f;
  __syncthreads();
  G_ISSUE(0, 0);
  if (KT > 1) G_ISSUE(1, 1);
  const int xa = (r32 >> 1) & 7;
  const int aoff = (64 * wm + r32) * 128, boff = 16384 + (64 * wn + r32) * 128;
  int st = 0;
  for (int kt = 0; kt < KT; ++kt) {
    if (kt + 1 < KT) asm volatile("s_waitcnt vmcnt(6)\n\ts_barrier" ::: "memory");
    else             asm volatile("s_waitcnt vmcnt(0)\n\ts_barrier" ::: "memory");
    const int s2 = st == 0 ? 2 : st - 1;
    if (kt + 2 < KT && wv < 4) G_ISSUE(s2, kt + 2);
    const char* buf = lds + st * G_STAGE;
    __builtin_amdgcn_s_setprio(1);
#pragma unroll
    for (int s = 0; s < 4; ++s) {
      const int cb = ((2 * s + hi) ^ xa) << 4;
      const bf16x8 a0 = *(const bf16x8*)(buf + aoff + cb), a1 = *(const bf16x8*)(buf + aoff + 4096 + cb);
      const bf16x8 b0 = *(const bf16x8*)(buf + boff + cb), b1 = *(const bf16x8*)(buf + boff + 4096 + cb);
      acc[0][0] = MFMA32(a0, b0, acc[0][0]); acc[0][1] = MFMA32(a0, b1, acc[0][1]);
      acc[1][0] = MFMA32(a1, b0, acc[1][0]); acc[1][1] = MFMA32(a1, b1, acc[1][1]);
    }
    __builtin_amdgcn_s_setprio(0);
    if (kt + 2 < KT && wv >= 4) G_ISSUE(s2, kt + 2);
    st = st == 2 ? 0 : st + 1;
  }
#undef G_ISSUE
  __syncthreads();
}
constexpr int CLD = 257;
__device__ __forceinline__ void acc_to_lds(const f32x16 (&acc)[2][2], float* Cl) {
  const int lane = threadIdx.x & 63, wv = threadIdx.x >> 6, r32 = lane & 31, hi = lane >> 5, wm = wv >> 2, wn = wv & 3;
#pragma unroll
  for (int m = 0; m < 2; ++m)
#pragma unroll
    for (int n = 0; n < 2; ++n)
#pragma unroll
      for (int r = 0; r < 16; ++r) Cl[(64 * wm + 32 * m + crow(r, hi)) * CLD + 64 * wn + 32 * n + r32] = acc[m][n][r];
}

__device__ void phase2(const Args& a, char* lds) {
  unsigned char* ws = a.ws;
  const int tid = threadIdx.x, lane = tid & 63, wv = tid >> 6;
  const u16* H = (const u16*)(ws + WS_H); const u16* WIN = (const u16*)(ws + WS_WIN);
  u16* QA = (u16*)(ws + WS_QA); u16* KV = (u16*)(ws + WS_KV); u16* UACT = (u16*)(ws + WS_UACT); u16* GVT = (u16*)(ws + WS_GVT);
  float* SSQV = (float*)(ws + WS_SSQV); const float* CS = (const float*)(ws + WS_CS);
  char* gl = lds + LDS_DATA; float* Cl = (float*)gl;
  for (int u = blockIdx.x; u < 128 * 6; u += gridDim.x) {
    const int mt = u / 6, nt = u % 6, R0 = mt * 128;
    f32x16 acc[2][2];
    gemm_128x256(H + (size_t)R0 * 1024, 1024, WIN + (size_t)(nt * 256) * 1024, 1024, 16, acc, gl);
    acc_to_lds(acc, Cl);
    __syncthreads();
    if (nt == 0) {
      for (int i = 0; i < 16; ++i) {
        const int row = wv * 16 + i; float v[4], ssq = 0.f;
#pragma unroll
        for (int j = 0; j < 4; ++j) { v[j] = Cl[row * CLD + lane + 64 * j]; ssq += v[j] * v[j]; }
        ssq = wave_sum(ssq);
        const float rstd = rsqrtf(ssq * (1.f / 256.f) + EPS);
#pragma unroll
        for (int j = 0; j < 4; ++j) { const int col = lane + 64 * j; QA[(size_t)(R0 + row) * 256 + col] = f2bf(v[j] * rstd * a.g_q_a[col]); }
      }
    } else if (nt == 1) {
#pragma unroll 4
      for (int i = 0; i < 16; ++i) {
        const int row = wv * 16 + i, tok = R0 + row;
        const float v0 = Cl[row * CLD + lane], v1 = Cl[row * CLD + 64 + lane];
        const float ssq = wave_sum(v0 * v0 + v1 * v1);
        const float rstd = rsqrtf(ssq * (1.f / 128.f) + EPS);
        KV[(size_t)tok * 192 + lane] = f2bf(v0 * rstd * a.g_kv_a[lane]);
        KV[(size_t)tok * 192 + 64 + lane] = f2bf(v1 * rstd * a.g_kv_a[64 + lane]);
        if (lane < 32) {
          const float x1 = Cl[row * CLD + 128 + lane], x2 = Cl[row * CLD + 160 + lane];
          const float cs = CS[(size_t)tok * 64 + lane], sn = CS[(size_t)tok * 64 + 32 + lane];
          KV[(size_t)tok * 192 + 128 + lane] = f2bf(x1 * cs - x2 * sn);
          KV[(size_t)tok * 192 + 160 + lane] = f2bf(x2 * cs + x1 * sn);
        }
      }
    } else if (nt < 4) {
      for (int i = 0; i < 16; ++i) {
        const int row = wv * 16 + i;
#pragma unroll
        for (int j = 0; j < 4; ++j) { const int col = lane + 64 * j; UACT[(size_t)(R0 + row) * 512 + (nt - 2) * 256 + col] = f2bf(gelu_exact(Cl[row * CLD + col])); }
      }
    } else {
      for (int i = 0; i < 16; ++i) {
        const int row = wv * 16 + i; float ssq = 0.f;
#pragma unroll
        for (int j = 0; j < 4; ++j) { const int col = lane + 64 * j; const float g = gelu_exact(Cl[row * CLD + col]); const float gb = bflo((unsigned)f2bf(g)); ssq += gb * gb; Cl[row * CLD + col] = gb; }
        ssq = wave_sum(ssq);
        if (lane == 0) SSQV[(size_t)(R0 + row) * 2 + (nt - 4)] = ssq;
      }
      __syncthreads();
      for (int i = 0; i < 32; ++i) {
        const int c = wv * 32 + i;
        const float g0 = Cl[(2 * lane) * CLD + c], g1 = Cl[(2 * lane + 1) * CLD + c];
        *(unsigned*)(GVT + ((size_t)mt * 512 + (nt - 4) * 256 + c) * 128 + 2 * lane) = pack2(g0, g1);
      }
    }
    __syncthreads();
  }
}

__device__ void phase3(const Args& a, char* lds) {
  unsigned char* ws = a.ws;
  const int tid = threadIdx.x, lane = tid & 63, wv = tid >> 6, r32 = lane & 31, hi = lane >> 5;
  const u16* QA = (const u16*)(ws + WS_QA); const u16* WQ2 = (const u16*)(ws + WS_WQ2);
  u16* Q = (u16*)(ws + WS_Q); const float* CS = (const float*)(ws + WS_CS);
  const u16* UACT = (const u16*)(ws + WS_UACT); const u16* GVT = (const u16*)(ws + WS_GVT); const u16* WSG = (const u16*)(ws + WS_WSG);
  const float* SSQV = (const float*)(ws + WS_SSQV); u16* Y = (u16*)(ws + WS_Y);
  char* gl = lds + LDS_DATA; float* Cl = (float*)gl;
  for (int u = blockIdx.x; u < 384; u += gridDim.x) {
    {
      const int mt = u / 3, nt = u % 3, R0 = mt * 128;
      f32x16 acc[2][2];
      gemm_128x256(QA + (size_t)R0 * 256, 256, WQ2 + (size_t)(nt * 256) * 256, 256, 4, acc, gl);
      acc_to_lds(acc, Cl);
      __syncthreads();
      if (nt < 2) {
        for (int i = 0; i < 16; ++i) {
          const int row = wv * 16 + i;
#pragma unroll
          for (int j = 0; j < 4; ++j) { const int n = nt * 256 + lane + 64 * j; Q[(size_t)(R0 + row) * 768 + (n >> 7) * 192 + (n & 127)] = f2bf(Cl[row * CLD + lane + 64 * j]); }
        }
      } else {
#pragma unroll 4
        for (int i = 0; i < 16; ++i) {
          const int row = wv * 16 + i, tok = R0 + row;
#pragma unroll
          for (int j = 0; j < 2; ++j) {
            const int idx = lane + 64 * j, h = idx >> 5, jj = idx & 31;
            const float x1 = Cl[row * CLD + h * 64 + jj], x2 = Cl[row * CLD + h * 64 + 32 + jj];
            const float cs = CS[(size_t)tok * 64 + jj], sn = CS[(size_t)tok * 64 + 32 + jj];
            Q[(size_t)tok * 768 + h * 192 + 128 + jj] = f2bf(x1 * cs - x2 * sn);
            Q[(size_t)tok * 768 + h * 192 + 160 + jj] = f2bf(x2 * cs + x1 * sn);
          }
        }
      }
      __syncthreads();
    }
  }
  for (int su = blockIdx.x; su < 256; su += gridDim.x) {
    {
      const int c = su >> 1, ph = su & 1;
      float* rs = (float*)gl;
      float* Yl = (float*)(gl + 512);
      __syncthreads();
      if (tid < 128) { const size_t t = (size_t)c * 128 + tid; rs[tid] = rsqrtf((SSQV[t * 2] + SSQV[t * 2 + 1]) * (1.f / 512.f) + EPS); }
      __syncthreads();
      const int h = wv >> 1, dh = wv & 1;
      f32x16 acc[2][2];
#pragma unroll
      for (int m = 0; m < 2; ++m)
#pragma unroll
        for (int n = 0; n < 2; ++n)
#pragma unroll
          for (int r = 0; r < 16; ++r) acc[m][n][r] = 0.f;
      for (int s = 0; s < 8; ++s) {
        const int q0 = 16 * s + 8 * hi;
        bf16x8 af[2], bfr[2];
#pragma unroll
        for (int m = 0; m < 2; ++m) af[m] = *(const bf16x8*)(WSG + ((size_t)h * 128 + ph * 64 + 32 * m + r32) * 128 + q0);
        float rq[8];
#pragma unroll
        for (int j = 0; j < 8; ++j) rq[j] = rs[q0 + j];
#pragma unroll
        for (int n = 0; n < 2; ++n) {
          const u32x4 w = *(const u32x4*)(GVT + ((size_t)c * 512 + h * 128 + dh * 64 + 32 * n + r32) * 128 + q0);
          u32x4 o;
#pragma unroll
          for (int k = 0; k < 4; ++k) o[k] = pack2(bflo(w[k]) * rq[2 * k], bfhi(w[k]) * rq[2 * k + 1]);
          bfr[n] = __builtin_bit_cast(bf16x8, o);
        }
#pragma unroll
        for (int m = 0; m < 2; ++m)
#pragma unroll
          for (int n = 0; n < 2; ++n) acc[m][n] = MFMA32(af[m], bfr[n], acc[m][n]);
      }
#pragma unroll
      for (int m = 0; m < 2; ++m)
#pragma unroll
        for (int n = 0; n < 2; ++n)
#pragma unroll
          for (int r = 0; r < 16; ++r) {
            const int pl = 32 * m + crow(r, hi), col = h * 128 + dh * 64 + 32 * n + r32;
            const size_t tok = (size_t)c * 128 + ph * 64 + pl;
            const float mix = acc[m][n][r] * a.g_sg[col] + a.b_sg[h * 128 + ph * 64 + pl];
            Yl[pl * 513 + col] = bflo((unsigned)UACT[tok * 512 + col]) * mix;
          }
      __syncthreads();
      for (int i = 0; i < 8; ++i) {
        const int pl = wv * 8 + i; const size_t tok = (size_t)c * 128 + ph * 64 + pl;
        float v[8], ssq = 0.f;
#pragma unroll
        for (int j = 0; j < 8; ++j) { v[j] = Yl[pl * 513 + lane + 64 * j]; ssq += v[j] * v[j]; }
        ssq = wave_sum(ssq);
        const float rstd = rsqrtf(ssq * (1.f / 512.f) + EPS);
#pragma unroll
        for (int j = 0; j < 8; ++j) { const int col = lane + 64 * j; Y[tok * 1024 + 512 + col] = f2bf(v[j] * rstd * a.g_sg_out[col]); }
      }
      __syncthreads();
    }
  }
}

constexpr float ATT_SCALE = 0.07216878364870322f;
constexpr float ATT_THR = 8.f;
constexpr int KVBUF = 24576;
#define SBAR() __builtin_amdgcn_sched_barrier(0)
__device__ __forceinline__ unsigned cvtpk(float lo, float hi) { unsigned r; asm volatile("v_cvt_pk_bf16_f32 %0, %1, %2" : "=v"(r) : "v"(lo), "v"(hi)); return r; }
__device__ __forceinline__ unsigned off_a(unsigned row, unsigned ch) { return 2048u * (row >> 3) + 512u * (ch >> 2) + 64u * (row & 7) + 16u * ((ch & 3) ^ ((row >> 2) & 3)); }

__device__ __forceinline__ void partialSM(f32x16& p0, f32x16& p1, float& m_reg, float& mn, float& alpha) {
  constexpr float C = ATT_SCALE * 1.4426950408889634f;
  float pmax = p0[0];
#pragma unroll
  for (int r = 1; r < 16; ++r) pmax = fmaxf(pmax, p0[r]);
#pragma unroll
  for (int r = 0; r < 16; ++r) pmax = fmaxf(pmax, p1[r]);
  { auto rr = __builtin_amdgcn_permlane32_swap(__float_as_uint(pmax), __float_as_uint(pmax), false, false);
    pmax = fmaxf(__uint_as_float(rr[0]), __uint_as_float(rr[1])); }
  if (__builtin_expect(__all(pmax - m_reg <= ATT_THR / ATT_SCALE), 1)) { mn = m_reg; alpha = 1.f; }
  else { mn = fmaxf(m_reg, pmax); alpha = __builtin_amdgcn_exp2f((m_reg - mn) * C); m_reg = mn; }
  const float mnC = -mn * C;
#pragma unroll
  for (int r = 0; r < 16; ++r) p0[r] = fmaf(p0[r], C, mnC);
#pragma unroll
  for (int r = 0; r < 16; ++r) p1[r] = fmaf(p1[r], C, mnC);
#pragma unroll
  for (int r = 0; r < 16; ++r) p0[r] = __builtin_amdgcn_exp2f(p0[r]);
}
__device__ __forceinline__ void finishSM(f32x16& p0, f32x16& p1, float alpha, float& l_reg, bf16x8& pa0, bf16x8& pa1, bf16x8& pa2, bf16x8& pa3) {
#pragma unroll
  for (int r = 0; r < 16; ++r) p1[r] = __builtin_amdgcn_exp2f(p1[r]);
  float ps = 0;
#pragma unroll
  for (int r = 0; r < 16; ++r) ps += p0[r];
#pragma unroll
  for (int r = 0; r < 16; ++r) ps += p1[r];
  { auto rr = __builtin_amdgcn_permlane32_swap(__float_as_uint(ps), __float_as_uint(ps), false, false);
    ps = __uint_as_float(rr[0]) + __uint_as_float(rr[1]); }
  l_reg = l_reg * alpha + ps;
#define PK4(P, BASE, OUT) do { unsigned a0 = cvtpk(P[BASE + 0], P[BASE + 1]), a1 = cvtpk(P[BASE + 2], P[BASE + 3]);   \
    unsigned b0 = cvtpk(P[BASE + 4], P[BASE + 5]), b1 = cvtpk(P[BASE + 6], P[BASE + 7]);                              \
    auto r0 = __builtin_amdgcn_permlane32_swap(a0, b0, false, false); auto r1 = __builtin_amdgcn_permlane32_swap(a1, b1, false, false); \
    u32x4 w = {r0[0], r1[0], r0[1], r1[1]}; OUT = __builtin_bit_cast(bf16x8, w); } while (0)
  PK4(p0, 0, pa0); PK4(p0, 8, pa1); PK4(p1, 0, pa2); PK4(p1, 8, pa3);
#undef PK4
}
__device__ __forceinline__ void qkt192(f32x16& p0, f32x16& p1, const char* kb, const bf16x8* qr, int ke, int ko, int kr) {
#pragma unroll
  for (int r = 0; r < 16; ++r) { p0[r] = 0.f; p1[r] = 0.f; }
#pragma unroll
  for (int d0 = 0; d0 < 8; ++d0) {
    const int o = ((d0 & 1) ? ko : ke) + 512 * (d0 >> 1);
    const bf16x8 b0 = *(const bf16x8*)(kb + o), b1 = *(const bf16x8*)(kb + o + 8192);
    p0 = MFMA32(b0, qr[d0], p0); p1 = MFMA32(b1, qr[d0], p1);
  }
#pragma unroll
  for (int d1 = 0; d1 < 4; ++d1) {
    const int o = 16384 + (kr ^ (32 * d1));
    const bf16x8 b0 = *(const bf16x8*)(kb + o), b1 = *(const bf16x8*)(kb + o + 4096);
    p0 = MFMA32(b0, qr[8 + d1], p0); p1 = MFMA32(b1, qr[8 + d1], p1);
  }
}
template <int OFF> __device__ __forceinline__ s16x4 tr_read(int vb) {
  s16x4 r; asm volatile("ds_read_b64_tr_b16 %0, %1 offset:%2" : "=&v"(r) : "v"(vb), "i"(OFF) : "memory"); return r;
}
template <int C> __device__ __forceinline__ void pv_one(f32x16& od, int vb0, int vb1, bf16x8 pa0, bf16x8 pa1, bf16x8 pa2, bf16x8 pa3) {
  const s16x4 l0 = tr_read<512 * C>(vb0), h0 = tr_read<512 * C>(vb1), l1 = tr_read<4096 + 512 * C>(vb0), h1 = tr_read<4096 + 512 * C>(vb1);
  const s16x4 l2 = tr_read<8192 + 512 * C>(vb0), h2 = tr_read<8192 + 512 * C>(vb1), l3 = tr_read<12288 + 512 * C>(vb0), h3 = tr_read<12288 + 512 * C>(vb1);
  asm volatile("s_waitcnt lgkmcnt(0)" ::: "memory"); SBAR();
#define PKV(L, H) (bf16x8){L[0], L[1], L[2], L[3], H[0], H[1], H[2], H[3]}
  od = MFMA32(pa0, PKV(l0, h0), od); od = MFMA32(pa1, PKV(l1, h1), od);
  od = MFMA32(pa2, PKV(l2, h2), od); od = MFMA32(pa3, PKV(l3, h3), od);
#undef PKV
}
__device__ __forceinline__ void pv_all(f32x16* o, int vb0, int vb1, bf16x8 pa0, bf16x8 pa1, bf16x8 pa2, bf16x8 pa3) {
  pv_one<0>(o[0], vb0, vb1, pa0, pa1, pa2, pa3); pv_one<1>(o[1], vb0, vb1, pa0, pa1, pa2, pa3);
  pv_one<2>(o[2], vb0, vb1, pa0, pa1, pa2, pa3); pv_one<3>(o[3], vb0, vb1, pa0, pa1, pa2, pa3);
}

__device__ void phase4(const Args& a, char* lds) {
  unsigned char* ws = a.ws;
  const int tid = threadIdx.x, wid = tid >> 6, lane = tid & 63, r32 = lane & 31, hi = lane >> 5;
  const u16* Qg = (const u16*)(ws + WS_Q); const u16* KVg = (const u16*)(ws + WS_KV); const u16* WUV = (const u16*)(ws + WS_WUV);
  u16* Y = (u16*)(ws + WS_Y);
  char* gl = lds + LDS_DATA;
  char* kvl = gl;
  float* wsl = (float*)(gl + 2 * KVBUF) + wid * 64; float* li_l = wsl; float* al_l = wsl + 32;
  char* Ol = gl + 2 * KVBUF + 2048 + wid * 8704;
  float* Yl = (float*)gl;
  const int head = wid >> 1, qh = wid & 1;
  int sdst[3];
#pragma unroll
  for (int j = 0; j < 3; ++j) { const int id = tid + 512 * j, key = id / 24, ch = id % 24;
    sdst[j] = ch < 16 ? (int)off_a(key, ch) : 16384 + key * 128 + (((ch - 16) ^ ((key >> 1) & 7)) << 4); }
  const int xq = (r32 >> 2) & 3;
  const int ke = 2048 * (r32 >> 3) + 64 * (r32 & 7) + 16 * (hi ^ xq), ko = 2048 * (r32 >> 3) + 64 * (r32 & 7) + 16 * ((2 + hi) ^ xq);
  const int kr = r32 * 128 + ((hi ^ ((r32 >> 1) & 7)) << 4);
  const int tb = lane >> 4 & 1, tq = (lane & 15) >> 2, tp = lane & 3;
  const int vbl = 2048 * hi + 64 * tq + 32 * (tb ^ hi) + 8 * (tp & 1);
  const int lbase = (int)(uintptr_t)kvl;
  const int vb0 = lbase + vbl + 16 * (tp >> 1), vb1 = lbase + vbl + 256 + 16 * ((tp >> 1) ^ 1);
  for (int u = blockIdx.x; u < 256; u += gridDim.x) {
    const int b = u >> 6, qb = u & 63;
    const size_t tok0 = (size_t)b * SEQ + qb * 64 + qh * 32;
    const u16* KVb = KVg + (size_t)b * SEQ * 192;
    float m_reg = -1e30f, l_reg = 0.f; f32x16 o[4]; bf16x8 qr[12];
#pragma unroll
    for (int d = 0; d < 4; ++d)
#pragma unroll
      for (int r = 0; r < 16; ++r) o[d][r] = 0.f;
    { const u16* Qw = Qg + (tok0 + r32) * 768 + head * 192 + hi * 8;
#pragma unroll
      for (int d0 = 0; d0 < 12; ++d0) qr[d0] = *(const bf16x8*)(Qw + d0 * 16); }
    u32x4 st0[3];
#define SLOAD(S, k0) do { const u16* _p = KVb + (size_t)(k0) * 192 + tid * 8; S[0] = *(const u32x4*)_p; S[1] = *(const u32x4*)(_p + 4096); S[2] = *(const u32x4*)(_p + 8192); } while (0)
#define SWRITE(bufi, S) do { char* _d = kvl + (bufi) * KVBUF; *(u32x4*)(_d + sdst[0]) = S[0]; *(u32x4*)(_d + sdst[1]) = S[1]; *(u32x4*)(_d + sdst[2]) = S[2]; } while (0)
#define RESC(al) do { if (__any((al) < 1.f)) { if (hi == 0) al_l[r32] = (al); asm volatile("s_waitcnt lgkmcnt(0)" ::: "memory"); \
    _Pragma("unroll") for (int d = 0; d < 4; ++d) _Pragma("unroll") for (int r = 0; r < 16; ++r) o[d][r] *= al_l[crow(r, hi)]; } } while (0)
    constexpr int NT = SEQ / 64;
    __syncthreads();
    SLOAD(st0, 0); SWRITE(0, st0); SLOAD(st0, 64); __syncthreads();
    for (int j = 0; j < NT; ++j) {
      const int bo = (j & 1) * KVBUF;
      f32x16 p0, p1; float mn, al; bf16x8 pa0, pa1, pa2, pa3;
      qkt192(p0, p1, kvl + bo, qr, ke, ko, kr);
      partialSM(p0, p1, m_reg, mn, al);
      RESC(al);
      finishSM(p0, p1, al, l_reg, pa0, pa1, pa2, pa3);
      if (j + 1 < NT) { SWRITE((j + 1) & 1, st0); if (j + 2 < NT) SLOAD(st0, (j + 2) * 64); }
      SBAR();
      pv_all(o, vb0 + bo, vb1 + bo, pa0, pa1, pa2, pa3);
      __syncthreads();
    }
#undef SLOAD
#undef SWRITE
#undef RESC
    int r32e = r32, hie = hi, lne = lane;
    asm volatile("" : "+v"(r32e), "+v"(hie), "+v"(lne));
    if (hie == 0) li_l[r32e] = l_reg;
    asm volatile("s_waitcnt lgkmcnt(0)" ::: "memory");
#pragma unroll
    for (int r = 0; r < 16; ++r) {
      const int q = crow(r, hie); const float rl = __builtin_amdgcn_rcpf(li_l[q]);
#pragma unroll
      for (int d = 0; d < 4; ++d) *(u16*)(Ol + q * 272 + (32 * d + r32e) * 2) = f2bf(o[d][r] * rl);
    }
    asm volatile("s_waitcnt lgkmcnt(0)" ::: "memory");
    f32x16 y[4];
#pragma unroll
    for (int n = 0; n < 4; ++n)
#pragma unroll
      for (int r = 0; r < 16; ++r) y[n][r] = 0.f;
    const u16* wuv = WUV + ((size_t)head * 128 + r32e) * 128 + 8 * hie;
#pragma unroll 2
    for (int s = 0; s < 8; ++s) {
      const bf16x8 af = *(const bf16x8*)(Ol + r32e * 272 + (16 * s + 8 * hie) * 2);
#pragma unroll
      for (int n = 0; n < 4; ++n) {
        const bf16x8 bw = *(const bf16x8*)(wuv + 32 * n * 128 + 16 * s);
        y[n] = MFMA32(af, bw, y[n]);
      }
    }
    __syncthreads();
#pragma unroll
    for (int n = 0; n < 4; ++n)
#pragma unroll
      for (int r = 0; r < 16; ++r) Yl[(qh * 32 + crow(r, hie)) * 513 + head * 128 + 32 * n + r32e] = y[n][r];
    __syncthreads();
    for (int i = 0; i < 8; ++i) {
      const int pl = wid * 8 + i; const size_t tok = (size_t)b * SEQ + qb * 64 + pl;
      float v[8], ssq = 0.f;
#pragma unroll
      for (int jj = 0; jj < 8; ++jj) { v[jj] = Yl[pl * 513 + lne + 64 * jj]; ssq += v[jj] * v[jj]; }
      ssq = wave_sum(ssq);
      const float rstd = rsqrtf(ssq * (1.f / 512.f) + EPS);
#pragma unroll
      for (int jj = 0; jj < 8; ++jj) { const int col = lne + 64 * jj; Y[tok * 1024 + col] = f2bf(v[jj] * rstd * a.g_attn_out[col]); }
    }
    __syncthreads();
  }
}

__device__ void phase5(const Args& a, char* lds) {
  unsigned char* ws = a.ws;
  const int tid = threadIdx.x, lane = tid & 63, wv = tid >> 6;
  const u16* Y = (const u16*)(ws + WS_Y); const u16* WO = (const u16*)(ws + WS_WO);
  float* X1 = (float*)(ws + WS_X1); float* SSQ = (float*)(ws + WS_SSQ); const float* mod = (const float*)(ws + WS_MOD);
  char* gl = lds + LDS_DATA; float* Cl = (float*)gl;
  for (int u = blockIdx.x; u < 128 * 4; u += gridDim.x) {
    const int mt = u >> 2, nt = u & 3, R0 = mt * 128, b = R0 >> 12;
    f32x16 acc[2][2];
    gemm_128x256(Y + (size_t)R0 * 1024, 1024, WO + (size_t)(nt * 256) * 1024, 1024, 16, acc, gl);
    acc_to_lds(acc, Cl);
    __syncthreads();
    float g1[4];
#pragma unroll
    for (int j = 0; j < 4; ++j) g1[j] = mod[b * 6144 + 2048 + nt * 256 + lane + 64 * j];
    for (int i0 = 0; i0 < 16; i0 += 8) {
      float xv[8][4];
#pragma unroll
      for (int i = 0; i < 8; ++i)
#pragma unroll
        for (int j = 0; j < 4; ++j) xv[i][j] = a.x[(size_t)(R0 + wv * 16 + i0 + i) * 1024 + nt * 256 + lane + 64 * j];
#pragma unroll
      for (int i = 0; i < 8; ++i) {
        const int row = wv * 16 + i0 + i; const size_t tok = R0 + row; float ssq = 0.f;
#pragma unroll
        for (int j = 0; j < 4; ++j) {
          const int col = nt * 256 + lane + 64 * j;
          const float v = xv[i][j] + g1[j] * Cl[row * CLD + lane + 64 * j];
          X1[tok * 1024 + col] = v; ssq += v * v;
        }
        ssq = wave_sum(ssq);
        if (lane == 0) SSQ[tok * 4 + nt] = ssq;
      }
    }
    __syncthreads();
  }
}
__device__ void phase5b(const Args& a) {
  unsigned char* ws = a.ws;
  const int tid = threadIdx.x, lane = tid & 63, wv = tid >> 6;
  const float* X1 = (const float*)(ws + WS_X1); const float* SSQ = (const float*)(ws + WS_SSQ); const float* mod = (const float*)(ws + WS_MOD);
  u16* H = (u16*)(ws + WS_H);
  for (int u = blockIdx.x; u < T / 64; u += gridDim.x) {
    const int b = u >> 6;
    float4 sh[4], sc[4], g[4];
#pragma unroll
    for (int j = 0; j < 4; ++j) {
      const int col = j * 256 + lane * 4;
      sh[j] = *(const float4*)(mod + b * 6144 + 3072 + col); sc[j] = *(const float4*)(mod + b * 6144 + 4096 + col); g[j] = *(const float4*)(a.g_norm2 + col);
    }
    for (int i = 0; i < 8; ++i) {
      const size_t r = (size_t)u * 64 + wv * 8 + i;
      const float4 sq = *(const float4*)(SSQ + r * 4);
      const float rstd = rsqrtf((sq.x + sq.y + sq.z + sq.w) * (1.f / 1024.f) + EPS);
#pragma unroll
      for (int j = 0; j < 4; ++j) {
        const int col = j * 256 + lane * 4;
        const float4 xv = *(const float4*)(X1 + r * 1024 + col);
        const float h0 = xv.x * rstd * g[j].x * (1.f + sc[j].x) + sh[j].x, h1 = xv.y * rstd * g[j].y * (1.f + sc[j].y) + sh[j].y;
        const float h2 = xv.z * rstd * g[j].z * (1.f + sc[j].z) + sh[j].z, h3 = xv.w * rstd * g[j].w * (1.f + sc[j].w) + sh[j].w;
        uint2 o = {pack2(h0, h1), pack2(h2, h3)};
        *(uint2*)(H + r * 1024 + col) = o;
      }
    }
  }
}

__device__ __forceinline__ float vmaxf(float a, float b) { float r; asm("v_max_f32 %0, %1, %2" : "=v"(r) : "v"(a), "v"(b)); return r; }
__device__ __forceinline__ float vminf(float a, float b) { float r; asm("v_min_f32 %0, %1, %2" : "=v"(r) : "v"(a), "v"(b)); return r; }
#define TOP_INSERT(t, v) do { float _v = (v); _Pragma("unroll") for (int _i = 0; _i < 16; ++_i) { const float _h = vmaxf(t[_i], _v); _v = vminf(t[_i], _v); t[_i] = _h; } } while (0)

__device__ void phase6(const Args& a, char* lds) {
  unsigned char* ws = a.ws;
  const int tid = threadIdx.x, lane = tid & 63, wv = tid >> 6, r32 = lane & 31, hi = lane >> 5;
  const u16* H = (const u16*)(ws + WS_H); const u16* WPQ = (const u16*)(ws + WS_WPQ); const u16* KEYS = (const u16*)(ws + WS_KEYS);
  uint2* TOPK = (uint2*)(ws + WS_TOPK);
  char* gl = lds + LDS_DATA;
  char* Ql = gl;
  float* TK = (float*)(gl + 67584);
  for (int u = blockIdx.x; u < 128 * 8; u += gridDim.x) {
    const int mt = u >> 3, hd = u & 7, R0 = mt * 128;
    f32x16 acc[2][2];
    gemm_128x256(H + (size_t)R0 * 1024, 1024, WPQ + (size_t)(hd * 256) * 1024, 1024, 16, acc, gl);
    { const int wm = wv >> 2, wn = wv & 3;
#pragma unroll
      for (int m = 0; m < 2; ++m)
#pragma unroll
        for (int n = 0; n < 2; ++n)
#pragma unroll
          for (int r = 0; r < 16; ++r) *(u16*)(Ql + (64 * wm + 32 * m + crow(r, hi)) * 528 + (64 * wn + 32 * n + r32) * 2) = f2bf(acc[m][n][r]); }
    __syncthreads();
    {
      const int half = wv & 1, tb = wv >> 1;
      f32x16 sc[4];
#pragma unroll
      for (int k = 0; k < 4; ++k)
#pragma unroll
        for (int r = 0; r < 16; ++r) sc[k][r] = 0.f;
#pragma unroll
      for (int s = 0; s < 8; ++s) {
        const bf16x8 bq = *(const bf16x8*)(Ql + (32 * tb + r32) * 528 + (half * 128 + 16 * s + 8 * hi) * 2);
#pragma unroll
        for (int k = 0; k < 4; ++k) {
          const bf16x8 ak = *(const bf16x8*)(KEYS + ((size_t)(hd * 2 + half) * 128 + 32 * k + r32) * 128 + 16 * s + 8 * hi);
          sc[k] = MFMA32(ak, bq, sc[k]);
        }
      }
      float t[16];
#pragma unroll
      for (int i = 0; i < 16; ++i) t[i] = __uint_as_float(0xff800000u);
#pragma unroll
      for (int k = 0; k < 4; ++k)
#pragma unroll
        for (int r = 0; r < 16; ++r) {
          const unsigned key = 32 * k + crow(r, hi);
          TOP_INSERT(t, __uint_as_float((__float_as_uint(sc[k][r]) & ~127u) | key));
        }
      float p[16];
#pragma unroll
      for (int i = 0; i < 16; ++i) {
        auto rr = __builtin_amdgcn_permlane32_swap(__float_as_uint(t[i]), __float_as_uint(t[i]), false, false);
        p[i] = __uint_as_float(hi ? rr[0] : rr[1]);
      }
#pragma unroll
      for (int i = 0; i < 16; ++i) TOP_INSERT(t, p[i]);
      if (hi == 0) {
        float* dst = TK + ((size_t)half * 128 + 32 * tb + r32) * 16;
#pragma unroll
        for (int i = 0; i < 16; i += 4) *(float4*)(dst + i) = make_float4(t[i], t[i + 1], t[i + 2], t[i + 3]);
      }
    }
    __syncthreads();
    if (tid < 128) {
      float v1[16], v2[16], t[16];
#pragma unroll
      for (int i = 0; i < 16; i += 4) {
        const float4 x = *(const float4*)(TK + (size_t)tid * 16 + i), y = *(const float4*)(TK + (size_t)(128 + tid) * 16 + i);
        v1[i] = x.x; v1[i + 1] = x.y; v1[i + 2] = x.z; v1[i + 3] = x.w; v2[i] = y.x; v2[i + 1] = y.y; v2[i + 2] = y.z; v2[i + 3] = y.w;
      }
#pragma unroll
      for (int i = 0; i < 16; ++i) t[i] = __uint_as_float(0xff800000u);
#pragma unroll
      for (int i = 0; i < 16; ++i)
#pragma unroll
        for (int j = 0; j < 16; ++j)
          if ((i + 1) * (j + 1) <= 16) TOP_INSERT(t, __uint_as_float((__float_as_uint(v1[i] + v2[j]) & ~255u) | (unsigned)(i * 16 + j)));
      float e[16], sum = 0.f; unsigned ex[16];
      const float m0 = __uint_as_float(__float_as_uint(t[0]) & ~255u);
#pragma unroll
      for (int i = 0; i < 16; ++i) {
        const unsigned bits = __float_as_uint(t[i]), id = bits & 255u;
        const unsigned i1 = __float_as_uint(TK[(size_t)tid * 16 + (id >> 4)]) & 127u, i2 = __float_as_uint(TK[(size_t)(128 + tid) * 16 + (id & 15u)]) & 127u;
        ex[i] = i1 * 128u + i2;
        e[i] = __expf(__uint_as_float(bits & ~255u) - m0); sum += e[i];
      }
      const float inv = 1.f / sum;
      uint2* dst = TOPK + ((size_t)(R0 + tid) * 8 + hd) * 16;
#pragma unroll
      for (int i = 0; i < 16; i += 2) {
        uint4 o = {ex[i], __float_as_uint(e[i] * inv), ex[i + 1], __float_as_uint(e[i + 1] * inv)};
        *(uint4*)(dst + i) = o;
      }
    }
    __syncthreads();
  }
}

typedef __attribute__((ext_vector_type(4))) float f32x4;
#define MFMA4(a, b, c) __builtin_amdgcn_mfma_f32_4x4x4bf16_1k((a), (b), (c), 0, 0, 0)
constexpr int P7_VROW = 2112, P7_VBUF = 4 * P7_VROW;
constexpr int P7_RING = 64;
constexpr int P7_ENT  = P7_RING + 8 * 2 * P7_VBUF;
constexpr int P7_CNT  = P7_ENT + 8 * 2048;
static_assert(P7_CNT + 8 * 256 <= LDS_BYTES, "phase 7 LDS map");
__device__ __forceinline__ float sel4(const f32x4& d, int k) { return k == 0 ? d[0] : (k == 1 ? d[1] : (k == 2 ? d[2] : d[3])); }
__device__ __forceinline__ unsigned fp8x2_bf16(unsigned x, float sc, bool hi) {
  return hi ? __builtin_bit_cast(unsigned, __builtin_amdgcn_cvt_scalef32_pk_bf16_fp8(x, sc, true)) : __builtin_bit_cast(unsigned, __builtin_amdgcn_cvt_scalef32_pk_bf16_fp8(x, sc, false));
}

__device__ void phase7(const Args& a, char* lds) {
  unsigned char* ws = a.ws;
  const int tid = threadIdx.x, lane = tid & 63, wv = __builtin_amdgcn_readfirstlane(tid >> 6), blk = lane >> 2, j4 = lane & 3;
  const u16* H = (const u16*)(ws + WS_H); const unsigned char* U8 = ws + WS_UB; const unsigned char* V8 = ws + WS_VB;
  const uint2* TOPK = (const uint2*)(ws + WS_TOPK); const float* X1 = (const float*)(ws + WS_X1); const float* mod = (const float*)(ws + WS_MOD);
  const unsigned lbase = (unsigned)(uintptr_t)lds;
  char* ring = lds + P7_RING + wv * 2 * P7_VBUF;
  unsigned* ents = (unsigned*)(lds + P7_ENT + wv * 2048);
  int* cntw = (int*)(lds + P7_CNT + wv * 256);
  const int trb = (int)(lbase + P7_RING + wv * 2 * P7_VBUF) + ((lane & 15) >> 2) * P7_VROW + 32 * (lane >> 4) + 8 * (lane & 3);
  const int NWV = gridDim.x * 8;
  for (int qd = blockIdx.x * 8 + wv; qd < T / 4; qd += NWV) {
    const int tok0 = qd * 4, b = tok0 >> 12;
    cntw[lane] = 0;
    asm volatile("s_waitcnt lgkmcnt(0)" ::: "memory");
    {
      uint2 en[8];
#pragma unroll
      for (int i = 0; i < 8; ++i) { const int e = lane + 64 * i; en[i] = TOPK[(size_t)(tok0 + (e >> 7)) * 128 + (e & 127)]; }
#pragma unroll
      for (int i = 0; i < 8; ++i) atomicAdd(&cntw[en[i].x >> 8], 1);
      asm volatile("s_waitcnt lgkmcnt(0)" ::: "memory");
      const int c = cntw[lane]; int inc = c;
#pragma unroll
      for (int o = 1; o < 64; o <<= 1) { const int v = __shfl_up(inc, o, 64); if (lane >= o) inc += v; }
      asm volatile("s_waitcnt lgkmcnt(0)" ::: "memory");
      cntw[lane] = inc - c;
      asm volatile("s_waitcnt lgkmcnt(0)" ::: "memory");
#pragma unroll
      for (int i = 0; i < 8; ++i) {
        const int e = lane + 64 * i;
        const int pos = atomicAdd(&cntw[en[i].x >> 8], 1);
        ents[pos] = en[i].x | ((unsigned)(e >> 7) << 14) | (pack2(0.f, __uint_as_float(en[i].y)) & 0xFFFF0000u);
      }
      asm volatile("s_waitcnt lgkmcnt(0)" ::: "memory");
    }
    u32x4 hA[4][2];
#pragma unroll
    for (int i = 0; i < 4; ++i) { const u16* ph = H + (size_t)(tok0 + j4) * 1024 + 256 * i + 16 * blk; hA[i][0] = *(const u32x4*)ph; hA[i][1] = *(const u32x4*)(ph + 8); }
    f32x4 acc[16];
#pragma unroll
    for (int c = 0; c < 16; ++c) acc[c] = (f32x4){0.f, 0.f, 0.f, 0.f};
#define P7_VPHASE(bufi) do { const int _vb = trb + (bufi) * P7_VBUF;                                                            \
      { const s16x4 v0 = tr_read<0>(_vb), v1 = tr_read<128>(_vb), v2 = tr_read<256>(_vb), v3 = tr_read<384>(_vb),               \
                    v4 = tr_read<512>(_vb), v5 = tr_read<640>(_vb), v6 = tr_read<768>(_vb), v7 = tr_read<896>(_vb);               \
        asm volatile("s_waitcnt lgkmcnt(0)" ::: "memory"); SBAR();                                                                \
        acc[0] = MFMA4(awp, v0, acc[0]); acc[1] = MFMA4(awp, v1, acc[1]); acc[2] = MFMA4(awp, v2, acc[2]); acc[3] = MFMA4(awp, v3, acc[3]);   \
        acc[4] = MFMA4(awp, v4, acc[4]); acc[5] = MFMA4(awp, v5, acc[5]); acc[6] = MFMA4(awp, v6, acc[6]); acc[7] = MFMA4(awp, v7, acc[7]); } \
      { const s16x4 v0 = tr_read<1024>(_vb), v1 = tr_read<1152>(_vb), v2 = tr_read<1280>(_vb), v3 = tr_read<1408>(_vb),         \
                    v4 = tr_read<1536>(_vb), v5 = tr_read<1664>(_vb), v6 = tr_read<1792>(_vb), v7 = tr_read<1920>(_vb);           \
        asm volatile("s_waitcnt lgkmcnt(0)" ::: "memory"); SBAR();                                                                \
        acc[8] = MFMA4(awp, v0, acc[8]); acc[9] = MFMA4(awp, v1, acc[9]); acc[10] = MFMA4(awp, v2, acc[10]); acc[11] = MFMA4(awp, v3, acc[11]); \
        acc[12] = MFMA4(awp, v4, acc[12]); acc[13] = MFMA4(awp, v5, acc[13]); acc[14] = MFMA4(awp, v6, acc[14]); acc[15] = MFMA4(awp, v7, acc[15]); } } while (0)
    u32x4 u8[4], v8[4];
#define P7_LOADG(EN) do { const unsigned _ex = (EN) & 0x3FFFu; const unsigned char* _pu = U8 + (size_t)_ex * 1024 + 16 * blk;      \
      _Pragma("unroll") for (int _i = 0; _i < 4; ++_i) u8[_i] = *(const u32x4*)(_pu + 256 * _i);                                 \
      _Pragma("unroll") for (int _q = 0; _q < 4; ++_q) { const unsigned _eq = (unsigned)__builtin_amdgcn_readlane((int)_ex, _q);  \
        v8[_q] = *(const u32x4*)(V8 + (size_t)_eq * 1024 + 16 * lane); } } while (0)
    unsigned enc = ents[j4], enn = ents[4 + j4];
    P7_LOADG(enc);
    s16x4 awp = {0, 0, 0, 0};
    constexpr int NG = 128;
    for (int g = 0; g < NG; ++g) {
      if (g > 0) P7_VPHASE((g - 1) & 1);
      f32x4 d0 = {0.f, 0.f, 0.f, 0.f}, d1 = {0.f, 0.f, 0.f, 0.f};
#pragma unroll
      for (int i = 0; i < 4; ++i)
#pragma unroll
        for (int w = 0; w < 4; ++w) {
          const uint2 ub = {fp8x2_bf16(u8[i][w], 1.f / PEER_SU, false), fp8x2_bf16(u8[i][w], 1.f / PEER_SU, true)};
          const uint2 ha = {hA[i][w >> 1][2 * (w & 1)], hA[i][w >> 1][2 * (w & 1) + 1]};
          if (w & 1) d1 = MFMA4(__builtin_bit_cast(s16x4, ha), __builtin_bit_cast(s16x4, ub), d1);
          else       d0 = MFMA4(__builtin_bit_cast(s16x4, ha), __builtin_bit_cast(s16x4, ub), d0);
        }
      { char* vw = ring + (g & 1) * P7_VBUF + lane * 32;
#pragma unroll
        for (int q = 0; q < 4; ++q) {
          u32x4 o0, o1;
          o0[0] = fp8x2_bf16(v8[q][0], 1.f / PEER_SV, false); o0[1] = fp8x2_bf16(v8[q][0], 1.f / PEER_SV, true);
          o0[2] = fp8x2_bf16(v8[q][1], 1.f / PEER_SV, false); o0[3] = fp8x2_bf16(v8[q][1], 1.f / PEER_SV, true);
          o1[0] = fp8x2_bf16(v8[q][2], 1.f / PEER_SV, false); o1[1] = fp8x2_bf16(v8[q][2], 1.f / PEER_SV, true);
          o1[2] = fp8x2_bf16(v8[q][3], 1.f / PEER_SV, false); o1[3] = fp8x2_bf16(v8[q][3], 1.f / PEER_SV, true);
          *(u32x4*)(vw + q * P7_VROW) = o0; *(u32x4*)(vw + q * P7_VROW + 16) = o1;
        } }
      unsigned en2 = 0u;
      if (g + 1 < NG) { P7_LOADG(enn); if (g + 2 < NG) en2 = ents[4 * (g + 2) + j4]; }
      const int tk = (enc >> 14) & 3;
      float av = sel4(d0, tk) + sel4(d1, tk);
      av += __uint_as_float(__builtin_amdgcn_update_dpp(0, __float_as_uint(av), 0x124, 0xf, 0xf, false));
      av += __uint_as_float(__builtin_amdgcn_update_dpp(0, __float_as_uint(av), 0x128, 0xf, 0xf, false));
      av += __shfl_xor(av, 16, 64);
      { auto rr = __builtin_amdgcn_permlane32_swap(__float_as_uint(av), __float_as_uint(av), false, false); av = __uint_as_float(rr[0]) + __uint_as_float(rr[1]); }
      const float wgt = gelu_exact(av) * __uint_as_float(enc & 0xFFFF0000u);
      float z[4];
#define P7_QB(x, k) __builtin_amdgcn_update_dpp(0, (x), (k) * 0x55, 0xf, 0xf, false)
      { const unsigned wb = __float_as_uint(wgt), tb = (unsigned)tk;
        unsigned w0 = P7_QB(wb, 0), w1 = P7_QB(wb, 1), w2 = P7_QB(wb, 2), w3 = P7_QB(wb, 3);
        unsigned t0 = P7_QB(tb, 0), t1 = P7_QB(tb, 1), t2 = P7_QB(tb, 2), t3 = P7_QB(tb, 3);
        asm volatile("" : "+v"(w0), "+v"(w1), "+v"(w2), "+v"(w3), "+v"(t0), "+v"(t1), "+v"(t2), "+v"(t3));
        z[0] = ((int)t0 == j4) ? __uint_as_float(w0) : 0.f; z[1] = ((int)t1 == j4) ? __uint_as_float(w1) : 0.f;
        z[2] = ((int)t2 == j4) ? __uint_as_float(w2) : 0.f; z[3] = ((int)t3 == j4) ? __uint_as_float(w3) : 0.f; }
#undef P7_QB
      { const uint2 pk = {pack2(z[0], z[1]), pack2(z[2], z[3])}; awp = __builtin_bit_cast(s16x4, pk); }
      enc = enn; enn = en2;
    }
#undef P7_LOADG
    P7_VPHASE((NG - 1) & 1);
#undef P7_VPHASE
    int lne = lane; asm volatile("" : "+v"(lne));
    float ss[4] = {0.f, 0.f, 0.f, 0.f};
#pragma unroll
    for (int c = 0; c < 16; ++c) {
      const float g2 = mod[b * 6144 + 5120 + 64 * c + lne];
#pragma unroll
      for (int r = 0; r < 4; ++r) { const float v = X1[(size_t)(tok0 + r) * 1024 + 64 * c + lne] + g2 * acc[c][r]; acc[c][r] = v; ss[r] += v * v; }
    }
    float rstd[4];
#pragma unroll
    for (int r = 0; r < 4; ++r) rstd[r] = rsqrtf(wave_sum(ss[r]) * (1.f / 1024.f) + EPS);
#pragma unroll
    for (int c = 0; c < 16; ++c) {
      const float gf = a.g_final[64 * c + lne];
#pragma unroll
      for (int r = 0; r < 4; ++r) a.out[(size_t)(tok0 + r) * 1024 + 64 * c + lne] = acc[c][r] * rstd[r] * gf;
    }
  }
}

constexpr int N_PHASES = 9;
__global__ void __launch_bounds__(512, 2) fwd(Args args) {
  extern __shared__ __attribute__((aligned(16))) char lds[];
  if (threadIdx.x == 0) *(uint4*)lds = make_uint4(0u, 0u, 0u, 0u);
  __syncthreads();
  const int lo = args.ph_lo, hi = args.ph_hi;
  XcdBarrier bar; bar.bar = (unsigned*)(args.ws + WS_BAR); bar.x = 0; bar.st = (volatile LAS unsigned*)lds;
  if (hi - lo > 1) bar = xcd_barrier_post((unsigned*)(args.ws + WS_BAR), (volatile LAS unsigned*)lds);
#ifndef ONLY_PHASE
#define ONLY_PHASE -1
#endif
#define IN(k) (lo <= (k) && (k) < hi && (ONLY_PHASE < 0 || ONLY_PHASE == (k)))
#define SEAM(k) do { if (IN(k) && IN((k) + 1)) xcd_barrier(bar); } while (0)
  if (IN(0)) phase0(args, lds);
  SEAM(0);
  if (IN(1)) phase1(args, lds);
  SEAM(1);
  if (IN(2)) phase2(args, lds);
  SEAM(2);
  if (IN(3)) phase3(args, lds);
  SEAM(3);
  if (IN(4)) phase4(args, lds);
  SEAM(4);
  if (IN(5)) phase5(args, lds);
  SEAM(5);
  if (IN(6)) phase5b(args);
  SEAM(6);
  if (IN(7)) phase6(args, lds);
  SEAM(7);
  if (IN(8)) phase7(args, lds);
#undef IN
#undef SEAM
}

extern "C" void kernel_launch(void* const* d_in, const int* in_sizes, int n_in, void* d_out, int out_size, void* d_ws, size_t ws_size, hipStream_t stream) {
  static int grid = 0;
  if (grid == 0) {
    if (n_in != 23 || out_size != T * DM || ws_size < WS_END) { fprintf(stderr, "kernel_launch: unexpected shapes (n_in %d out %d ws %zu need %zu)\n", n_in, out_size, ws_size, (size_t)WS_END); grid = -1; return; }
    int dev = 0, cus = 0, per_cu = 0;
    (void)hipGetDevice(&dev); (void)hipDeviceGetAttribute(&cus, hipDeviceAttributeMultiprocessorCount, dev);
    if (hipFuncSetAttribute((const void*)fwd, hipFuncAttributeMaxDynamicSharedMemorySize, LDS_BYTES) != hipSuccess) { fprintf(stderr, "kernel_launch: hipFuncSetAttribute failed\n"); grid = -1; return; }
    if (hipOccupancyMaxActiveBlocksPerMultiprocessor(&per_cu, (const void*)fwd, 512, LDS_BYTES) != hipSuccess || per_cu < 1) { fprintf(stderr, "kernel_launch: occupancy query says %d\n", per_cu); per_cu = 1; }
    (void)hipGetLastError();
    grid = cus;
  }
  if (grid < 0) return;
  (void)hipMemsetAsync((char*)d_ws + WS_BAR, 0, 16384, stream);
  Args a{};
  a.x = (const float*)d_in[0]; a.c = (const float*)d_in[1]; a.pos = (const int*)d_in[2];
  a.w_ada = (const float*)d_in[3]; a.b_ada = (const float*)d_in[4]; a.g_norm1 = (const float*)d_in[5]; a.w_in = (const float*)d_in[6];
  a.g_q_a = (const float*)d_in[7]; a.w_uq = (const float*)d_in[8]; a.g_kv_a = (const float*)d_in[9]; a.w_ukv = (const float*)d_in[10];
  a.g_sg = (const float*)d_in[11]; a.w_sg = (const float*)d_in[12]; a.b_sg = (const float*)d_in[13]; a.g_attn_out = (const float*)d_in[14];
  a.g_sg_out = (const float*)d_in[15]; a.w_o = (const float*)d_in[16]; a.g_norm2 = (const float*)d_in[17]; a.w_peer_q = (const float*)d_in[18];
  a.peer_keys = (const float*)d_in[19]; a.peer_u = (const float*)d_in[20]; a.peer_v = (const float*)d_in[21]; a.g_final = (const float*)d_in[22];
  a.out = (float*)d_out; a.ws = (unsigned char*)d_ws;
#if N_LAUNCH_MODE == 0
  a.ph_lo = 0; a.ph_hi = N_PHASES;
  hipLaunchKernelGGL(fwd, dim3(grid), dim3(512), LDS_BYTES, stream, a);
#else
  for (int p = 0; p < N_PHASES; ++p) for (int rep = 0; rep <= ((DUP_MASK >> p) & 1); ++rep) { a.ph_lo = p; a.ph_hi = p + 1; hipLaunchKernelGGL(fwd, dim3(grid), dim3(512), LDS_BYTES, stream, a); }
#endif
  const hipError_t le = hipPeekAtLastError();
  if (le != hipSuccess) fprintf(stderr, "kernel_launch: launch failed: %s\n", hipGetErrorName(le));
}
```

```cpp
#include <hip/hip_runtime.h>
#include <stdint.h>
#include <stdio.h>

#define N_LAUNCH_MODE 0
#define DUP_MASK 0x000

typedef unsigned short u16;
typedef __attribute__((ext_vector_type(8))) short bf16x8;
typedef __attribute__((ext_vector_type(4))) short s16x4;
typedef __attribute__((ext_vector_type(16))) float f32x16;
typedef __attribute__((ext_vector_type(4))) unsigned u32x4;

constexpr int T = 16384, DM = 1024, SEQ = 4096;
constexpr float EPS = 1e-6f;

constexpr size_t WS_BAR  = 0;
constexpr size_t WS_MODP = 16384;
constexpr size_t WS_MOD  = WS_MODP + 786432;
constexpr size_t WS_CS   = WS_MOD + 98304;
constexpr size_t WS_WIN  = WS_CS + 4194304;
constexpr size_t WS_WQ2  = WS_WIN + 3145728;
constexpr size_t WS_WUV  = WS_WQ2 + 393216;
constexpr size_t WS_WO   = WS_WUV + 131072;
constexpr size_t WS_WPQ  = WS_WO + 2097152;
constexpr size_t WS_KEYS = WS_WPQ + 4194304;
constexpr size_t WS_WSG  = WS_KEYS + 524288;
constexpr size_t WS_UB   = WS_WSG + 131072;
constexpr size_t WS_VB   = WS_UB + 33554432;
constexpr size_t WS_H    = WS_VB + 33554432;
constexpr size_t WS_Y    = WS_H + 33554432;
constexpr size_t WS_KV   = WS_Y + 33554432;
constexpr size_t WS_TOPK = WS_KV + 6291456;
constexpr size_t WS_SSQ  = WS_TOPK + 16777216;
constexpr size_t WS_SSQV = WS_SSQ + 262144;
constexpr size_t WS_R1   = WS_SSQV + 131072;
constexpr size_t WS_Q    = WS_R1;
constexpr size_t WS_QA   = WS_Q + 25165824;
constexpr size_t WS_UACT = WS_QA + 8388608;
constexpr size_t WS_GVT  = WS_UACT + 16777216;
constexpr size_t WS_X1   = WS_R1;
constexpr size_t WS_WST  = WS_R1 + 67108864;
constexpr size_t WS_END  = WS_WST + 4194304;

constexpr int LDS_BYTES = 155648;
constexpr int LDS_DATA  = 64;

struct Args {
  const float *x, *c; const int* pos;
  const float *w_ada, *b_ada, *g_norm1, *w_in, *g_q_a, *w_uq, *g_kv_a, *w_ukv, *g_sg, *w_sg, *b_sg, *g_attn_out, *g_sg_out,
              *w_o, *g_norm2, *w_peer_q, *peer_keys, *peer_u, *peer_v, *g_final;
  float* out; unsigned char* ws; int ph_lo, ph_hi;
};

#define XB_TMO      128
#define XB_XCNT(j)  (256  + 64 * (j))
#define XB_XSUB(j)  (1280 + 64 * (j))
#define XB_XGEN(j)  (2304 + 64 * (j))
#define XB_TOP      3328
#define XB_TOPGEN   3392
#define XCD_BAR_WORDS 3456
#define XB_SPIN_CAP (1u << 18)
#define LAS __attribute__((address_space(3)))

__device__ __forceinline__ unsigned xb_ld(unsigned* p)              { return __hip_atomic_load(p, __ATOMIC_RELAXED, __HIP_MEMORY_SCOPE_AGENT); }
__device__ __forceinline__ unsigned xb_add(unsigned* p, unsigned v) { return __hip_atomic_fetch_add(p, v, __ATOMIC_RELAXED, __HIP_MEMORY_SCOPE_AGENT); }
__device__ __forceinline__ unsigned xb_xcc_id() { return (unsigned)__builtin_amdgcn_s_getreg((3 << 11) | 20) & 0xFu; }
#define XB_SPIN(cond, bar) do { unsigned _sp = 0; while (cond) { __builtin_amdgcn_s_sleep(1); \
    if ((++_sp & 255u) == 0u) { if (xb_ld(&(bar)[XB_TMO])) break; if (_sp > XB_SPIN_CAP) { atomicAdd(&(bar)[XB_TMO], 1u); break; } } } } while (0)

struct XcdBarrier { unsigned* bar; unsigned x; volatile LAS unsigned* st; };

__device__ __forceinline__ XcdBarrier xcd_barrier_post(unsigned* bar, volatile LAS unsigned* st) {
    XcdBarrier b; b.bar = bar; b.x = xb_xcc_id(); b.st = st;
    if (threadIdx.x == 0) (void)xb_add(&bar[XB_XCNT(b.x)], 1u);
    return b;
}
__device__ __forceinline__ void xcd_barrier_complete(unsigned* bar, unsigned x, unsigned& nloc, unsigned& nx) {
    const unsigned G = gridDim.x * gridDim.y * gridDim.z;
    unsigned sum, cnt, mine, sp = 0u;
    for (;;) {
        sum = 0u; cnt = 0u; mine = 0u;
#pragma unroll
        for (unsigned j = 0; j < 16; ++j) { const unsigned c = xb_ld(&bar[XB_XCNT(j)]); sum += c; cnt += (c > 0u) ? 1u : 0u; mine = (j == x) ? c : mine; }
        if (sum == G) break;
        __builtin_amdgcn_s_sleep(1);
        if ((++sp & 255u) == 0u) { if (xb_ld(&bar[XB_TMO])) break; if (sp > XB_SPIN_CAP) { atomicAdd(&bar[XB_TMO], 1u); break; } }
    }
    nloc = mine > 0u ? mine : 1u; nx = cnt > 0u ? cnt : 1u;
}
__device__ __forceinline__ void xcd_barrier(const XcdBarrier& b) {
    asm volatile("s_waitcnt vmcnt(0)" ::: "memory");
    __syncthreads();
    if (threadIdx.x == 0) {
        unsigned* bar = b.bar;
        __builtin_amdgcn_s_waitcnt(0);
        unsigned nloc = b.st[0], nx = b.st[1];
        if (nloc == 0u) { xcd_barrier_complete(bar, b.x, nloc, nx); b.st[0] = nloc; b.st[1] = nx; }
        const unsigned old = xb_add(&bar[XB_XSUB(b.x)], 1u);
        const unsigned gen = old / nloc;
        if (old + 1u == (gen + 1u) * nloc) {
            __builtin_amdgcn_fence(__ATOMIC_RELEASE, "agent");
            asm volatile("s_waitcnt vmcnt(0)" ::: "memory");
            const unsigned og = xb_add(&bar[XB_TOP], 1u);
            const unsigned tg = og / nx;
            if (og + 1u == (tg + 1u) * nx) xb_add(&bar[XB_TOPGEN], 1u);
            else XB_SPIN(xb_ld(&bar[XB_TOPGEN]) == tg, bar);
            __builtin_amdgcn_fence(__ATOMIC_ACQUIRE, "agent");
            xb_add(&bar[XB_XGEN(b.x)], 1u);
            asm volatile("s_waitcnt vmcnt(0)" ::: "memory");
        } else {
            XB_SPIN(xb_ld(&bar[XB_XGEN(b.x)]) == gen, bar);
            __builtin_amdgcn_fence(__ATOMIC_ACQUIRE, "agent");
            asm volatile("s_waitcnt vmcnt(0)" ::: "memory");
        }
    }
    __syncthreads();
}

__device__ __forceinline__ unsigned pack2(float lo, float hi) {
  typedef __attribute__((ext_vector_type(2))) float f2; typedef __attribute__((ext_vector_type(2))) __bf16 b2;
  f2 v = {lo, hi}; b2 r = __builtin_convertvector(v, b2); return __builtin_bit_cast(unsigned, r);
}
__device__ __forceinline__ u16 f2bf(float f) { return (u16)(pack2(f, 0.f) & 0xFFFFu); }
__device__ __forceinline__ float bflo(unsigned w) { return __uint_as_float(w << 16); }
__device__ __forceinline__ float bfhi(unsigned w) { return __uint_as_float(w & 0xFFFF0000u); }
__device__ __forceinline__ float gelu_exact(float x) {
  const float z = fabsf(x) * 0.70710678118654752f;
  const float t = __builtin_amdgcn_rcpf(fmaf(0.3275911f, z, 1.f));
  float p = fmaf(1.061405429f, t, -1.453152027f); p = fmaf(p, t, 1.421413741f); p = fmaf(p, t, -0.284496736f); p = fmaf(p, t, 0.254829592f);
  const float e = p * t * __expf(-z * z);
  const float erfz = 1.f - e;
  return 0.5f * x * (1.f + copysignf(erfz, x));
}
__device__ __forceinline__ float wave_sum(float v) {
#pragma unroll
  for (int o = 32; o > 0; o >>= 1) v += __shfl_xor(v, o, 64);
  return v;
}
__device__ __forceinline__ int crow(int r, int hi) { return (r & 3) + 8 * (r >> 2) + 4 * hi; }
#define MFMA32(a, b, c) __builtin_amdgcn_mfma_f32_32x32x16_bf16((a), (b), (c), 0, 0, 0)

template <int MAP> __device__ __forceinline__ int colmap(int n) {
  if (MAP == 0) return n;
  if (MAP == 1) return n < 448 ? n : (n < 512 ? -1 : n - 64);
  if (MAP == 2) return (n >> 6) * 192 + 128 + (n & 63);
  return (n >> 7) * 256 + 128 + (n & 127);
}
template <int MAP> __device__ void cvt_transpose(const float* __restrict__ src, int src_ld, int K, int N, u16* __restrict__ dst, int gtid, int gthreads) {
  const int total = N * (K >> 3);
  for (int idx = gtid; idx < total; idx += gthreads) {
    const int n = idx % N, k8 = idx / N, sc = colmap<MAP>(n);
    float v[8];
#pragma unroll
    for (int j = 0; j < 8; ++j) v[j] = sc < 0 ? 0.f : src[(size_t)(k8 * 8 + j) * src_ld + sc];
    u32x4 w = {pack2(v[0], v[1]), pack2(v[2], v[3]), pack2(v[4], v[5]), pack2(v[6], v[7])};
    *(u32x4*)(dst + (size_t)n * K + k8 * 8) = w;
  }
}
template <int MAP> __device__ void cvt_transpose_tiled(const float* __restrict__ src, int src_ld, int K, int N, u16* __restrict__ dst, float* tile) {
  const int tid = threadIdx.x, tk = K >> 6, ntile = tk * (N >> 6);
  for (int t = blockIdx.x; t < ntile; t += gridDim.x) {
    const int k0 = (t % tk) * 64, n0 = (t / tk) * 64;
    __syncthreads();
    { const int nl = tid & 63, sc = colmap<MAP>(n0 + nl);
#pragma unroll
      for (int i = 0; i < 8; ++i) { const int k = (tid >> 6) + 8 * i; tile[k * 65 + nl] = sc < 0 ? 0.f : src[(size_t)(k0 + k) * src_ld + sc]; } }
    __syncthreads();
    { const int n = tid >> 3, kk = tid & 7; float v[8];
#pragma unroll
      for (int j = 0; j < 8; ++j) v[j] = tile[(8 * kk + j) * 65 + n];
      u32x4 w = {pack2(v[0], v[1]), pack2(v[2], v[3]), pack2(v[4], v[5]), pack2(v[6], v[7])};
      *(u32x4*)(dst + (size_t)(n0 + n) * K + k0 + 8 * kk) = w; }
  }
}
__device__ void cvt_direct(const float* __restrict__ src, u16* __restrict__ dst, size_t n8, int gtid, int gthreads) {
  for (size_t i = gtid; i < n8; i += gthreads) {
    const float4 a = *(const float4*)(src + i * 8), b = *(const float4*)(src + i * 8 + 4);
    u32x4 w = {pack2(a.x, a.y), pack2(a.z, a.w), pack2(b.x, b.y), pack2(b.z, b.w)};
    *(u32x4*)(dst + i * 8) = w;
  }
}
constexpr float PEER_SU = 32.f, PEER_SV = 4.f;
__device__ void cvt_fp8(const float* __restrict__ src, unsigned char* __restrict__ dst, size_t n16, float sc, int gtid, int gthreads) {
  for (size_t i = gtid; i < n16; i += gthreads) {
    u32x4 w;
#pragma unroll
    for (int k = 0; k < 4; ++k) {
      const float4 a = *(const float4*)(src + i * 16 + 4 * k);
      int p = __builtin_amdgcn_cvt_pk_fp8_f32(a.x * sc, a.y * sc, 0, false);
      p = __builtin_amdgcn_cvt_pk_fp8_f32(a.z * sc, a.w * sc, p, true);
      w[k] = (unsigned)p;
    }
    *(u32x4*)(dst + i * 16) = w;
  }
}
__device__ __forceinline__ void sincos_acc(float angf, float& sn, float& cs) {
  const double a = (double)angf;
  const double q = __builtin_rint(a * 0.63661977236758134308);
  double r = __builtin_fma(-q, 1.5707963267948966, a);
  r = __builtin_fma(-q, 6.123233995736766e-17, r);
  const double r2 = r * r;
  double s = r2 * (1.0 / 6227020800.0) - 1.0 / 39916800.0;
  s = s * r2 + 1.0 / 362880.0; s = s * r2 - 1.0 / 5040.0; s = s * r2 + 1.0 / 120.0; s = s * r2 - 1.0 / 6.0; s = r + r * r2 * s;
  double c = -r2 * (1.0 / 87178291200.0) + 1.0 / 479001600.0;
  c = c * r2 - 1.0 / 3628800.0; c = c * r2 + 1.0 / 40320.0; c = c * r2 - 1.0 / 720.0; c = c * r2 + 1.0 / 24.0; c = c * r2 - 0.5; c = 1.0 + r2 * c;
  const int n = ((int)q) & 3;
  const double ss = (n & 1) ? c : s, cc = (n & 1) ? s : c;
  sn = (float)((n & 2) ? -ss : ss);
  cs = (float)(((n + 1) & 2) ? -cc : cc);
}

__constant__ float INVF[32] = {1.000000000e+00f, 7.498942018e-01f, 5.623413324e-01f, 4.216965139e-01f, 3.162277639e-01f, 2.371373922e-01f, 1.778279394e-01f, 1.333521456e-01f,
  1.000000015e-01f, 7.498941571e-02f, 5.623412877e-02f, 4.216964915e-02f, 3.162277862e-02f, 2.371373586e-02f, 1.778279431e-02f, 1.333521493e-02f,
  9.999999776e-03f, 7.498942316e-03f, 5.623413250e-03f, 4.216964822e-03f, 3.162277862e-03f, 2.371373819e-03f, 1.778279431e-03f, 1.333521446e-03f,
  1.000000047e-03f, 7.498941850e-04f, 5.623413017e-04f, 4.216965463e-04f, 3.162277862e-04f, 2.371373848e-04f, 1.778279402e-04f, 1.333521504e-04f};
__device__ void phase0(const Args& a, char* lds) {
  unsigned char* ws = a.ws;
  const int tid = threadIdx.x, lane = tid & 63, wv = tid >> 6;
  const int NWV = gridDim.x * 8, gw = blockIdx.x * 8 + wv;
  const int gthreads = gridDim.x * 512, gtid = blockIdx.x * 512 + tid;
  float* modp = (float*)(ws + WS_MODP);
  for (int job = gw; job < 768; job += NWV) {
    const int cg = job % 96, ks = job / 96, col = cg * 64 + lane;
    float a0 = 0.f, a1 = 0.f, a2 = 0.f, a3 = 0.f;
    const float* w = a.w_ada + (size_t)(ks * 128) * 6144 + col;
    float sv[2][4];
#pragma unroll
    for (int h = 0; h < 2; ++h)
#pragma unroll
      for (int bb = 0; bb < 4; ++bb) { const float cv = a.c[bb * 1024 + ks * 128 + 64 * h + lane]; sv[h][bb] = cv / (1.f + __expf(-cv)); }
#pragma unroll
    for (int h = 0; h < 2; ++h) {
#pragma unroll 8
      for (int k = 0; k < 64; ++k) {
        const float wv_ = w[(size_t)(64 * h + k) * 6144];
        a0 += __uint_as_float(__builtin_amdgcn_readlane(__float_as_uint(sv[h][0]), k)) * wv_;
        a1 += __uint_as_float(__builtin_amdgcn_readlane(__float_as_uint(sv[h][1]), k)) * wv_;
        a2 += __uint_as_float(__builtin_amdgcn_readlane(__float_as_uint(sv[h][2]), k)) * wv_;
        a3 += __uint_as_float(__builtin_amdgcn_readlane(__float_as_uint(sv[h][3]), k)) * wv_;
      }
    }
    modp[(ks * 4 + 0) * 6144 + col] = a0; modp[(ks * 4 + 1) * 6144 + col] = a1;
    modp[(ks * 4 + 2) * 6144 + col] = a2; modp[(ks * 4 + 3) * 6144 + col] = a3;
  }
  { float* tile = (float*)(lds + LDS_DATA);
    cvt_transpose_tiled<1>(a.w_in, 1472, 1024, 1536, (u16*)(ws + WS_WIN), tile);
    cvt_transpose_tiled<0>(a.w_o, 1024, 1024, 1024, (u16*)(ws + WS_WO), tile);
    cvt_transpose_tiled<2>(a.w_uq, 768, 256, 256, (u16*)(ws + WS_WQ2) + 512 * 256, tile);
    cvt_transpose_tiled<3>(a.w_ukv, 1024, 128, 512, (u16*)(ws + WS_WUV), tile); }
  {
    u16* wq2 = (u16*)(ws + WS_WQ2);
    for (int idx = gtid; idx < 512 * 256; idx += gthreads) {
      const int n = idx >> 8, i = idx & 255, h = n >> 7, cc = n & 127;
      const float* pu = a.w_uq + (size_t)i * 768 + h * 192;
      const float* pk = a.w_ukv + (size_t)cc * 1024 + h * 256;
      float s = 0.f;
#pragma unroll 8
      for (int d = 0; d < 128; d += 4) {
        const float4 u = *(const float4*)(pu + d), k = *(const float4*)(pk + d);
        s += u.x * k.x + u.y * k.y + u.z * k.z + u.w * k.w;
      }
      wq2[(size_t)n * 256 + i] = f2bf(s);
    }
  }
  cvt_direct(a.peer_keys, (u16*)(ws + WS_KEYS), 262144 / 8, gtid, gthreads);
  cvt_direct(a.w_peer_q, (u16*)(ws + WS_WPQ), (size_t)1024 * 2048 / 8, gtid, gthreads);
  cvt_direct(a.w_sg, (u16*)(ws + WS_WSG), 65536 / 8, gtid, gthreads);
  cvt_fp8(a.peer_u, (unsigned char*)(ws + WS_UB), (size_t)16384 * 1024 / 16, PEER_SU, gtid, gthreads);
  cvt_fp8(a.peer_v, (unsigned char*)(ws + WS_VB), (size_t)16384 * 1024 / 16, PEER_SV, gtid, gthreads);
  {
    float* cs = (float*)(ws + WS_CS);
    for (int idx = gtid; idx < T * 32; idx += gthreads) {
      const int t = idx >> 5, i = idx & 31;
      const float inv = INVF[i];
      const float ang = (float)a.pos[t] * inv;
      float sn, c_; sincos_acc(ang, sn, c_);
      cs[(size_t)t * 64 + i] = c_; cs[(size_t)t * 64 + 32 + i] = sn;
    }
  }
}

__device__ void phase1(const Args& a, char* lds) {
  unsigned char* ws = a.ws;
  const int tid = threadIdx.x, lane = tid & 63, wv = tid >> 6;
  const float* modp = (const float*)(ws + WS_MODP);
  float* mod = (float*)(ws + WS_MOD);
  for (int idx = blockIdx.x * 512 + tid; idx < 4 * 6144; idx += gridDim.x * 512) {
    const int b = idx / 6144, m = idx % 6144;
    float s = a.b_ada[m];
#pragma unroll
    for (int ks = 0; ks < 8; ++ks) s += modp[(ks * 4 + b) * 6144 + m];
    mod[idx] = s;
  }
  float* sh = (float*)(lds + LDS_DATA);
  u16* H = (u16*)(ws + WS_H);
  for (int u = blockIdx.x; u < T / 64; u += gridDim.x) {
    const int b = u >> 6;
    __syncthreads();
    for (int j = tid; j < 2048; j += 512) {
      float s = a.b_ada[j];
#pragma unroll
      for (int ks = 0; ks < 8; ++ks) s += modp[(ks * 4 + b) * 6144 + j];
      sh[j] = s;
    }
    __syncthreads();
    for (int i = 0; i < 8; ++i) {
      const int r = u * 64 + wv * 8 + i;
      float4 xv[4]; float ssq = 0.f;
#pragma unroll
      for (int j = 0; j < 4; ++j) { xv[j] = *(const float4*)(a.x + (size_t)r * 1024 + j * 256 + lane * 4); ssq += xv[j].x * xv[j].x + xv[j].y * xv[j].y + xv[j].z * xv[j].z + xv[j].w * xv[j].w; }
      ssq = wave_sum(ssq);
      const float rstd = rsqrtf(ssq * (1.f / 1024.f) + EPS);
#pragma unroll
      for (int j = 0; j < 4; ++j) {
        const int col = j * 256 + lane * 4;
        const float4 g = *(const float4*)(a.g_norm1 + col);
        const float h0 = xv[j].x * rstd * g.x * (1.f + sh[1024 + col]) + sh[col];
        const float h1 = xv[j].y * rstd * g.y * (1.f + sh[1024 + col + 1]) + sh[col + 1];
        const float h2 = xv[j].z * rstd * g.z * (1.f + sh[1024 + col + 2]) + sh[col + 2];
        const float h3 = xv[j].w * rstd * g.w * (1.f + sh[1024 + col + 3]) + sh[col + 3];
        uint2 o = {pack2(h0, h1), pack2(h2, h3)};
        *(uint2*)(H + (size_t)r * 1024 + col) = o;
      }
    }
  }
}

constexpr int G_STAGE = 49152;
__device__ __forceinline__ void dma16(const void* gsrc, unsigned lds_dst) {
  unsigned keep;
  asm volatile("s_mov_b32 %0, m0\n\ts_mov_b32 m0, %2\n\ts_nop 0\n\tglobal_load_lds_dwordx4 %1, off\n\ts_mov_b32 m0, %0"
               : "=&s"(keep) : "v"(gsrc), "s"(lds_dst) : "memory");
}
__device__ __forceinline__ void gemm_128x256(const u16* __restrict__ A, int lda, const u16* __restrict__ Bt, int ldb, int KT,
                                             f32x16 (&acc)[2][2], char* lds) {
  const int tid = threadIdx.x, lane = tid & 63, wv = __builtin_amdgcn_readfirstlane(tid >> 6), r32 = lane & 31, hi = lane >> 5;
  const int wm = wv >> 2, wn = wv & 3;
  const int rin = lane >> 3, cc = lane & 7;
  const u16* pa[2]; const u16* pb[4];
#pragma unroll
  for (int j = 0; j < 2; ++j) pa[j] = A + (size_t)(16 * wv + 8 * j + rin) * lda + 8 * (cc ^ (4 * j + (rin >> 1)));
#pragma unroll
  for (int i = 0; i < 4; ++i) pb[i] = Bt + (size_t)(32 * wv + 8 * i + rin) * ldb + 8 * (cc ^ (4 * (i & 1) + (rin >> 1)));
  const unsigned lb = __builtin_amdgcn_readfirstlane((unsigned)(uintptr_t)lds);
  const unsigned dA = lb + 2048 * wv, dB = lb + 16384 + 4096 * wv;
#define G_ISSUE(stage, kt_) do { const unsigned _so = (unsigned)(stage) * G_STAGE; const int _ko = (kt_) * 64;                     \
    dma16(pa[0] + _ko, dA + _so); dma16(pa[1] + _ko, dA + _so + 1024);                                                           \
    dma16(pb[0] + _ko, dB + _so); dma16(pb[1] + _ko, dB + _so + 1024); dma16(pb[2] + _ko, dB + _so + 2048); dma16(pb[3] + _ko, dB + _so + 3072); } while (0)
#pragma unroll
  for (int m = 0; m < 2; ++m)
#pragma unroll
    for (int n = 0; n < 2; ++n)
#pragma unroll
      for (int r = 0; r < 16; ++r) acc[m][n][r] = 0.f;
  __syncthreads();
  G_ISSUE(0, 0);
  if (KT > 1) G_ISSUE(1, 1);
  const int xa = (r32 >> 1) & 7;
  const int aoff = (64 * wm + r32) * 128, boff = 16384 + (64 * wn + r32) * 128;
  int st = 0;
  for (int kt = 0; kt < KT; ++kt) {
    if (kt + 1 < KT) asm volatile("s_waitcnt vmcnt(6)\n\ts_barrier" ::: "memory");
    else             asm volatile("s_waitcnt vmcnt(0)\n\ts_barrier" ::: "memory");
    const int s2 = st == 0 ? 2 : st - 1;
    if (kt + 2 < KT && wv < 4) G_ISSUE(s2, kt + 2);
    const char* buf = lds + st * G_STAGE;
    __builtin_amdgcn_s_setprio(1);
    bf16x8 fa[2][2], fb[2][2];
#define G_LDF(S, SET) do { const int _cb = ((2 * (S) + hi) ^ xa) << 4;                                                      \
      fa[SET][0] = *(const bf16x8*)(buf + aoff + _cb); fa[SET][1] = *(const bf16x8*)(buf + aoff + 4096 + _cb);              \
      fb[SET][0] = *(const bf16x8*)(buf + boff + _cb); fb[SET][1] = *(const bf16x8*)(buf + boff + 4096 + _cb); } while (0)
#define G_MM(SET) do { acc[0][0] = MFMA32(fa[SET][0], fb[SET][0], acc[0][0]); acc[0][1] = MFMA32(fa[SET][0], fb[SET][1], acc[0][1]);   \
      acc[1][0] = MFMA32(fa[SET][1], fb[SET][0], acc[1][0]); acc[1][1] = MFMA32(fa[SET][1], fb[SET][1], acc[1][1]); } while (0)
    G_LDF(0, 0); __builtin_amdgcn_sched_barrier(0);
    G_LDF(1, 1); __builtin_amdgcn_sched_barrier(0); G_MM(0); __builtin_amdgcn_sched_barrier(0);
    G_LDF(2, 0); __builtin_amdgcn_sched_barrier(0); G_MM(1); __builtin_amdgcn_sched_barrier(0);
    G_LDF(3, 1); __builtin_amdgcn_sched_barrier(0); G_MM(0); __builtin_amdgcn_sched_barrier(0);
    G_MM(1);
#undef G_LDF
#undef G_MM
    __builtin_amdgcn_s_setprio(0);
    if (kt + 2 < KT && wv >= 4) G_ISSUE(s2, kt + 2);
    st = st == 2 ? 0 : st + 1;
  }
#undef G_ISSUE
  __syncthreads();
}
constexpr int CLD = 257;
__device__ __forceinline__ void acc_to_lds(const f32x16 (&acc)[2][2], float* Cl) {
  const int lane = threadIdx.x & 63, wv = threadIdx.x >> 6, r32 = lane & 31, hi = lane >> 5, wm = wv >> 2, wn = wv & 3;
#pragma unroll
  for (int m = 0; m < 2; ++m)
#pragma unroll
    for (int n = 0; n < 2; ++n)
#pragma unroll
      for (int r = 0; r < 16; ++r) Cl[(64 * wm + 32 * m + crow(r, hi)) * CLD + 64 * wn + 32 * n + r32] = acc[m][n][r];
}

__device__ __forceinline__ void gemm_128x256_wide(const u16* __restrict__ A, int lda, const u16* __restrict__ Bt, int ldb, int KT, f32x16 (&acc)[4], char* lds) {
  const int tid = threadIdx.x, lane = tid & 63, wv = __builtin_amdgcn_readfirstlane(tid >> 6), r32 = lane & 31, hi = lane >> 5;
  const int rin = lane >> 3, cc = lane & 7;
  const u16* pa[2]; const u16* pb[4];
#pragma unroll
  for (int j = 0; j < 2; ++j) pa[j] = A + (size_t)(16 * wv + 8 * j + rin) * lda + 8 * (cc ^ (4 * j + (rin >> 1)));
#pragma unroll
  for (int i = 0; i < 4; ++i) pb[i] = Bt + (size_t)(32 * wv + 8 * i + rin) * ldb + 8 * (cc ^ (4 * (i & 1) + (rin >> 1)));
  const unsigned lb = __builtin_amdgcn_readfirstlane((unsigned)(uintptr_t)lds);
  const unsigned dA = lb + 2048 * wv, dB = lb + 16384 + 4096 * wv;
#define G_ISSUE(stage, kt_) do { const unsigned _so = (unsigned)(stage) * G_STAGE; const int _ko = (kt_) * 64;                     \
    dma16(pa[0] + _ko, dA + _so); dma16(pa[1] + _ko, dA + _so + 1024);                                                           \
    dma16(pb[0] + _ko, dB + _so); dma16(pb[1] + _ko, dB + _so + 1024); dma16(pb[2] + _ko, dB + _so + 2048); dma16(pb[3] + _ko, dB + _so + 3072); } while (0)
#pragma unroll
  for (int m = 0; m < 4; ++m)
#pragma unroll
    for (int r = 0; r < 16; ++r) acc[m][r] = 0.f;
  __syncthreads();
  G_ISSUE(0, 0);
  if (KT > 1) G_ISSUE(1, 1);
  const int xa = (r32 >> 1) & 7;
  const int aoff = r32 * 128, boff = 16384 + (32 * wv + r32) * 128;
  int st = 0;
  for (int kt = 0; kt < KT; ++kt) {
    if (kt + 1 < KT) asm volatile("s_waitcnt vmcnt(6)\n\ts_barrier" ::: "memory");
    else             asm volatile("s_waitcnt vmcnt(0)\n\ts_barrier" ::: "memory");
    const int s2 = st == 0 ? 2 : st - 1;
    if (kt + 2 < KT && wv < 4) G_ISSUE(s2, kt + 2);
    const char* buf = lds + st * G_STAGE;
    __builtin_amdgcn_s_setprio(1);
    bf16x8 fa[2][4], fb[2];
#define G_LDF(S, SET) do { const int _cb = ((2 * (S) + hi) ^ xa) << 4;                                                      \
      fa[SET][0] = *(const bf16x8*)(buf + aoff + _cb); fa[SET][1] = *(const bf16x8*)(buf + aoff + 4096 + _cb);              \
      fa[SET][2] = *(const bf16x8*)(buf + aoff + 8192 + _cb); fa[SET][3] = *(const bf16x8*)(buf + aoff + 12288 + _cb);      \
      fb[SET] = *(const bf16x8*)(buf + boff + _cb); } while (0)
#define G_MM(SET) do { acc[0] = MFMA32(fa[SET][0], fb[SET], acc[0]); acc[1] = MFMA32(fa[SET][1], fb[SET], acc[1]);         \
      acc[2] = MFMA32(fa[SET][2], fb[SET], acc[2]); acc[3] = MFMA32(fa[SET][3], fb[SET], acc[3]); } while (0)
    G_LDF(0, 0); __builtin_amdgcn_sched_barrier(0);
    G_LDF(1, 1); __builtin_amdgcn_sched_barrier(0); G_MM(0); __builtin_amdgcn_sched_barrier(0);
    G_LDF(2, 0); __builtin_amdgcn_sched_barrier(0); G_MM(1); __builtin_amdgcn_sched_barrier(0);
    G_LDF(3, 1); __builtin_amdgcn_sched_barrier(0); G_MM(0); __builtin_amdgcn_sched_barrier(0);
    G_MM(1);
#undef G_LDF
#undef G_MM
    __builtin_amdgcn_s_setprio(0);
    if (kt + 2 < KT && wv >= 4) G_ISSUE(s2, kt + 2);
    st = st == 2 ? 0 : st + 1;
  }
#undef G_ISSUE
  __syncthreads();
}

__device__ void phase1b(const Args& a, char* lds) {
  unsigned char* ws = a.ws;
  const int tid = threadIdx.x, lane = tid & 63, wv = tid >> 6;
  const u16* KEYS = (const u16*)(ws + WS_KEYS); const u16* WPQB = (const u16*)(ws + WS_WPQ); u16* WST = (u16*)(ws + WS_WST);
  char* gl = lds + LDS_DATA; float* Cl = (float*)gl;
  for (int u = blockIdx.x; u < 64; u += gridDim.x) {
    const int hh = u >> 2, nt = u & 3;
    f32x16 acc[2][2];
    gemm_128x256(KEYS + (size_t)hh * 16384, 128, WPQB + (size_t)(nt * 256) * 2048 + hh * 128, 2048, 2, acc, gl);
    acc_to_lds(acc, Cl);
    __syncthreads();
    for (int i = 0; i < 16; ++i) {
      const int row = wv * 16 + i;
      const float v0 = Cl[row * CLD + 4 * lane], v1 = Cl[row * CLD + 4 * lane + 1], v2 = Cl[row * CLD + 4 * lane + 2], v3 = Cl[row * CLD + 4 * lane + 3];
      *(uint2*)(WST + (size_t)(hh * 128 + row) * 1024 + nt * 256 + 4 * lane) = make_uint2(pack2(v0, v1), pack2(v2, v3));
    }
    __syncthreads();
  }
}

__device__ void phase2(const Args& a, char* lds) {
  unsigned char* ws = a.ws;
  const int tid = threadIdx.x, lane = tid & 63, wv = tid >> 6;
  const u16* H = (const u16*)(ws + WS_H); const u16* WIN = (const u16*)(ws + WS_WIN);
  u16* QA = (u16*)(ws + WS_QA); u16* KV = (u16*)(ws + WS_KV); u16* UACT = (u16*)(ws + WS_UACT); u16* GVT = (u16*)(ws + WS_GVT);
  float* SSQV = (float*)(ws + WS_SSQV); const float* CS = (const float*)(ws + WS_CS);
  char* gl = lds + LDS_DATA; float* Cl = (float*)gl;
  for (int u = blockIdx.x; u < 128 * 6; u += gridDim.x) {
    const int mt = u / 6, nt = u % 6, R0 = mt * 128;
    f32x16 acc[2][2];
    gemm_128x256(H + (size_t)R0 * 1024, 1024, WIN + (size_t)(nt * 256) * 1024, 1024, 16, acc, gl);
    acc_to_lds(acc, Cl);
    __syncthreads();
    if (nt == 0) {
      for (int i = 0; i < 16; ++i) {
        const int row = wv * 16 + i; float v[4], ssq = 0.f;
#pragma unroll
        for (int j = 0; j < 4; ++j) { v[j] = Cl[row * CLD + lane + 64 * j]; ssq += v[j] * v[j]; }
        ssq = wave_sum(ssq);
        const float rstd = rsqrtf(ssq * (1.f / 256.f) + EPS);
#pragma unroll
        for (int j = 0; j < 4; ++j) { const int col = lane + 64 * j; QA[(size_t)(R0 + row) * 256 + col] = f2bf(v[j] * rstd * a.g_q_a[col]); }
      }
    } else if (nt == 1) {
#pragma unroll 4
      for (int i = 0; i < 16; ++i) {
        const int row = wv * 16 + i, tok = R0 + row;
        const float v0 = Cl[row * CLD + lane], v1 = Cl[row * CLD + 64 + lane];
        const float ssq = wave_sum(v0 * v0 + v1 * v1);
        const float rstd = rsqrtf(ssq * (1.f / 128.f) + EPS);
        KV[(size_t)tok * 192 + lane] = f2bf(v0 * rstd * a.g_kv_a[lane]);
        KV[(size_t)tok * 192 + 64 + lane] = f2bf(v1 * rstd * a.g_kv_a[64 + lane]);
        if (lane < 32) {
          const float x1 = Cl[row * CLD + 128 + lane], x2 = Cl[row * CLD + 160 + lane];
          const float cs = CS[(size_t)tok * 64 + lane], sn = CS[(size_t)tok * 64 + 32 + lane];
          KV[(size_t)tok * 192 + 128 + lane] = f2bf(x1 * cs - x2 * sn);
          KV[(size_t)tok * 192 + 160 + lane] = f2bf(x2 * cs + x1 * sn);
        }
      }
    } else if (nt < 4) {
      for (int i = 0; i < 16; ++i) {
        const int row = wv * 16 + i;
#pragma unroll
        for (int j = 0; j < 4; ++j) { const int col = lane + 64 * j; UACT[(size_t)(R0 + row) * 512 + (nt - 2) * 256 + col] = f2bf(gelu_exact(Cl[row * CLD + col])); }
      }
    } else {
      for (int i = 0; i < 16; ++i) {
        const int row = wv * 16 + i; float ssq = 0.f;
#pragma unroll
        for (int j = 0; j < 4; ++j) { const int col = lane + 64 * j; const float g = gelu_exact(Cl[row * CLD + col]); const float gb = bflo((unsigned)f2bf(g)); ssq += gb * gb; Cl[row * CLD + col] = gb; }
        ssq = wave_sum(ssq);
        if (lane == 0) SSQV[(size_t)(R0 + row) * 2 + (nt - 4)] = ssq;
      }
      __syncthreads();
      for (int i = 0; i < 32; ++i) {
        const int c = wv * 32 + i;
        const float g0 = Cl[(2 * lane) * CLD + c], g1 = Cl[(2 * lane + 1) * CLD + c];
        *(unsigned*)(GVT + ((size_t)mt * 512 + (nt - 4) * 256 + c) * 128 + 2 * lane) = pack2(g0, g1);
      }
    }
    __syncthreads();
  }
}

__device__ void phase3(const Args& a, char* lds) {
  unsigned char* ws = a.ws;
  const int tid = threadIdx.x, lane = tid & 63, wv = tid >> 6, r32 = lane & 31, hi = lane >> 5;
  const u16* QA = (const u16*)(ws + WS_QA); const u16* WQ2 = (const u16*)(ws + WS_WQ2);
  u16* Q = (u16*)(ws + WS_Q); const float* CS = (const float*)(ws + WS_CS);
  const u16* UACT = (const u16*)(ws + WS_UACT); const u16* GVT = (const u16*)(ws + WS_GVT); const u16* WSG = (const u16*)(ws + WS_WSG);
  const float* SSQV = (const float*)(ws + WS_SSQV); u16* Y = (u16*)(ws + WS_Y);
  char* gl = lds + LDS_DATA; float* Cl = (float*)gl;
  for (int u = blockIdx.x; u < 384; u += gridDim.x) {
    {
      const int mt = u / 3, nt = u % 3, R0 = mt * 128;
      f32x16 acc[2][2];
      gemm_128x256(QA + (size_t)R0 * 256, 256, WQ2 + (size_t)(nt * 256) * 256, 256, 4, acc, gl);
      acc_to_lds(acc, Cl);
      __syncthreads();
      if (nt < 2) {
        for (int i = 0; i < 16; ++i) {
          const int row = wv * 16 + i;
#pragma unroll
          for (int j = 0; j < 4; ++j) { const int n = nt * 256 + lane + 64 * j; Q[(size_t)(R0 + row) * 768 + (n >> 7) * 192 + (n & 127)] = f2bf(Cl[row * CLD + lane + 64 * j]); }
        }
      } else {
#pragma unroll 4
        for (int i = 0; i < 16; ++i) {
          const int row = wv * 16 + i, tok = R0 + row;
#pragma unroll
          for (int j = 0; j < 2; ++j) {
            const int idx = lane + 64 * j, h = idx >> 5, jj = idx & 31;
            const float x1 = Cl[row * CLD + h * 64 + jj], x2 = Cl[row * CLD + h * 64 + 32 + jj];
            const float cs = CS[(size_t)tok * 64 + jj], sn = CS[(size_t)tok * 64 + 32 + jj];
            Q[(size_t)tok * 768 + h * 192 + 128 + jj] = f2bf(x1 * cs - x2 * sn);
            Q[(size_t)tok * 768 + h * 192 + 160 + jj] = f2bf(x2 * cs + x1 * sn);
          }
        }
      }
      __syncthreads();
    }
  }
  for (int su = blockIdx.x; su < 256; su += gridDim.x) {
    {
      const int c = su >> 1, ph = su & 1;
      float* rs = (float*)gl;
      float* Yl = (float*)(gl + 512);
      __syncthreads();
      if (tid < 128) { const size_t t = (size_t)c * 128 + tid; rs[tid] = rsqrtf((SSQV[t * 2] + SSQV[t * 2 + 1]) * (1.f / 512.f) + EPS); }
      __syncthreads();
      const int h = wv >> 1, dh = wv & 1;
      f32x16 acc[2][2];
#pragma unroll
      for (int m = 0; m < 2; ++m)
#pragma unroll
        for (int n = 0; n < 2; ++n)
#pragma unroll
          for (int r = 0; r < 16; ++r) acc[m][n][r] = 0.f;
      for (int s = 0; s < 8; ++s) {
        const int q0 = 16 * s + 8 * hi;
        bf16x8 af[2], bfr[2];
#pragma unroll
        for (int m = 0; m < 2; ++m) af[m] = *(const bf16x8*)(WSG + ((size_t)h * 128 + ph * 64 + 32 * m + r32) * 128 + q0);
        float rq[8];
#pragma unroll
        for (int j = 0; j < 8; ++j) rq[j] = rs[q0 + j];
#pragma unroll
        for (int n = 0; n < 2; ++n) {
          const u32x4 w = *(const u32x4*)(GVT + ((size_t)c * 512 + h * 128 + dh * 64 + 32 * n + r32) * 128 + q0);
          u32x4 o;
#pragma unroll
          for (int k = 0; k < 4; ++k) o[k] = pack2(bflo(w[k]) * rq[2 * k], bfhi(w[k]) * rq[2 * k + 1]);
          bfr[n] = __builtin_bit_cast(bf16x8, o);
        }
#pragma unroll
        for (int m = 0; m < 2; ++m)
#pragma unroll
          for (int n = 0; n < 2; ++n) acc[m][n] = MFMA32(af[m], bfr[n], acc[m][n]);
      }
#pragma unroll
      for (int m = 0; m < 2; ++m)
#pragma unroll
        for (int n = 0; n < 2; ++n)
#pragma unroll
          for (int r = 0; r < 16; ++r) {
            const int pl = 32 * m + crow(r, hi), col = h * 128 + dh * 64 + 32 * n + r32;
            const size_t tok = (size_t)c * 128 + ph * 64 + pl;
            const float mix = acc[m][n][r] * a.g_sg[col] + a.b_sg[h * 128 + ph * 64 + pl];
            Yl[pl * 513 + col] = bflo((unsigned)UACT[tok * 512 + col]) * mix;
          }
      __syncthreads();
      for (int i = 0; i < 8; ++i) {
        const int pl = wv * 8 + i; const size_t tok = (size_t)c * 128 + ph * 64 + pl;
        float v[8], ssq = 0.f;
#pragma unroll
        for (int j = 0; j < 8; ++j) { v[j] = Yl[pl * 513 + lane + 64 * j]; ssq += v[j] * v[j]; }
        ssq = wave_sum(ssq);
        const float rstd = rsqrtf(ssq * (1.f / 512.f) + EPS);
#pragma unroll
        for (int j = 0; j < 8; ++j) { const int col = lane + 64 * j; Y[tok * 1024 + 512 + col] = f2bf(v[j] * rstd * a.g_sg_out[col]); }
      }
      __syncthreads();
    }
  }
}

constexpr float ATT_SCALE = 0.07216878364870322f;
constexpr float ATT_THR = 8.f;
constexpr int KVBUF = 24576;
#define SBAR() __builtin_amdgcn_sched_barrier(0)
__device__ __forceinline__ unsigned cvtpk(float lo, float hi) { unsigned r; asm volatile("v_cvt_pk_bf16_f32 %0, %1, %2" : "=v"(r) : "v"(lo), "v"(hi)); return r; }
__device__ __forceinline__ unsigned off_a(unsigned row, unsigned ch) { return 2048u * (row >> 3) + 512u * (ch >> 2) + 64u * (row & 7) + 16u * ((ch & 3) ^ ((row >> 2) & 3)); }

__device__ __forceinline__ void partialSM(f32x16& p0, f32x16& p1, float& m_reg, float& mn, float& alpha) {
  constexpr float C = ATT_SCALE * 1.4426950408889634f;
  float pmax = p0[0];
#pragma unroll
  for (int r = 1; r < 16; ++r) pmax = fmaxf(pmax, p0[r]);
#pragma unroll
  for (int r = 0; r < 16; ++r) pmax = fmaxf(pmax, p1[r]);
  { auto rr = __builtin_amdgcn_permlane32_swap(__float_as_uint(pmax), __float_as_uint(pmax), false, false);
    pmax = fmaxf(__uint_as_float(rr[0]), __uint_as_float(rr[1])); }
  if (__builtin_expect(__all(pmax - m_reg <= ATT_THR / ATT_SCALE), 1)) { mn = m_reg; alpha = 1.f; }
  else { mn = fmaxf(m_reg, pmax); alpha = __builtin_amdgcn_exp2f((m_reg - mn) * C); m_reg = mn; }
  const float mnC = -mn * C;
#pragma unroll
  for (int r = 0; r < 16; ++r) p0[r] = fmaf(p0[r], C, mnC);
#pragma unroll
  for (int r = 0; r < 16; ++r) p1[r] = fmaf(p1[r], C, mnC);
#pragma unroll
  for (int r = 0; r < 16; ++r) p0[r] = __builtin_amdgcn_exp2f(p0[r]);
}
__device__ __forceinline__ void finishSM(f32x16& p0, f32x16& p1, float alpha, float& l_reg, bf16x8& pa0, bf16x8& pa1, bf16x8& pa2, bf16x8& pa3) {
#pragma unroll
  for (int r = 0; r < 16; ++r) p1[r] = __builtin_amdgcn_exp2f(p1[r]);
  float ps = 0;
#pragma unroll
  for (int r = 0; r < 16; ++r) ps += p0[r];
#pragma unroll
  for (int r = 0; r < 16; ++r) ps += p1[r];
  { auto rr = __builtin_amdgcn_permlane32_swap(__float_as_uint(ps), __float_as_uint(ps), false, false);
    ps = __uint_as_float(rr[0]) + __uint_as_float(rr[1]); }
  l_reg = l_reg * alpha + ps;
#define PK4(P, BASE, OUT) do { unsigned a0 = cvtpk(P[BASE + 0], P[BASE + 1]), a1 = cvtpk(P[BASE + 2], P[BASE + 3]);   \
    unsigned b0 = cvtpk(P[BASE + 4], P[BASE + 5]), b1 = cvtpk(P[BASE + 6], P[BASE + 7]);                              \
    auto r0 = __builtin_amdgcn_permlane32_swap(a0, b0, false, false); auto r1 = __builtin_amdgcn_permlane32_swap(a1, b1, false, false); \
    u32x4 w = {r0[0], r1[0], r0[1], r1[1]}; OUT = __builtin_bit_cast(bf16x8, w); } while (0)
  PK4(p0, 0, pa0); PK4(p0, 8, pa1); PK4(p1, 0, pa2); PK4(p1, 8, pa3);
#undef PK4
}
__device__ __forceinline__ void qkt192(f32x16& p0, f32x16& p1, const char* kb, const bf16x8* qr, int ke, int ko, int kr) {
#pragma unroll
  for (int r = 0; r < 16; ++r) { p0[r] = 0.f; p1[r] = 0.f; }
#pragma unroll
  for (int d0 = 0; d0 < 8; ++d0) {
    const int o = ((d0 & 1) ? ko : ke) + 512 * (d0 >> 1);
    const bf16x8 b0 = *(const bf16x8*)(kb + o), b1 = *(const bf16x8*)(kb + o + 8192);
    p0 = MFMA32(b0, qr[d0], p0); p1 = MFMA32(b1, qr[d0], p1);
  }
#pragma unroll
  for (int d1 = 0; d1 < 4; ++d1) {
    const int o = 16384 + (kr ^ (32 * d1));
    const bf16x8 b0 = *(const bf16x8*)(kb + o), b1 = *(const bf16x8*)(kb + o + 4096);
    p0 = MFMA32(b0, qr[8 + d1], p0); p1 = MFMA32(b1, qr[8 + d1], p1);
  }
}
template <int OFF> __device__ __forceinline__ s16x4 tr_read(int vb) {
  s16x4 r; asm volatile("ds_read_b64_tr_b16 %0, %1 offset:%2" : "=&v"(r) : "v"(vb), "i"(OFF) : "memory"); return r;
}
template <int C> __device__ __forceinline__ void pv_one(f32x16& od, int vb0, int vb1, bf16x8 pa0, bf16x8 pa1, bf16x8 pa2, bf16x8 pa3) {
  const s16x4 l0 = tr_read<512 * C>(vb0), h0 = tr_read<512 * C>(vb1), l1 = tr_read<4096 + 512 * C>(vb0), h1 = tr_read<4096 + 512 * C>(vb1);
  const s16x4 l2 = tr_read<8192 + 512 * C>(vb0), h2 = tr_read<8192 + 512 * C>(vb1), l3 = tr_read<12288 + 512 * C>(vb0), h3 = tr_read<12288 + 512 * C>(vb1);
  asm volatile("s_waitcnt lgkmcnt(0)" ::: "memory"); SBAR();
#define PKV(L, H) (bf16x8){L[0], L[1], L[2], L[3], H[0], H[1], H[2], H[3]}
  od = MFMA32(pa0, PKV(l0, h0), od); od = MFMA32(pa1, PKV(l1, h1), od);
  od = MFMA32(pa2, PKV(l2, h2), od); od = MFMA32(pa3, PKV(l3, h3), od);
#undef PKV
}
__device__ __forceinline__ void pv_all(f32x16* o, int vb0, int vb1, bf16x8 pa0, bf16x8 pa1, bf16x8 pa2, bf16x8 pa3) {
  pv_one<0>(o[0], vb0, vb1, pa0, pa1, pa2, pa3); pv_one<1>(o[1], vb0, vb1, pa0, pa1, pa2, pa3);
  pv_one<2>(o[2], vb0, vb1, pa0, pa1, pa2, pa3); pv_one<3>(o[3], vb0, vb1, pa0, pa1, pa2, pa3);
}

__device__ void phase4(const Args& a, char* lds) {
  unsigned char* ws = a.ws;
  const int tid = threadIdx.x, wid = tid >> 6, lane = tid & 63, r32 = lane & 31, hi = lane >> 5;
  const u16* Qg = (const u16*)(ws + WS_Q); const u16* KVg = (const u16*)(ws + WS_KV); const u16* WUV = (const u16*)(ws + WS_WUV);
  u16* Y = (u16*)(ws + WS_Y);
  char* gl = lds + LDS_DATA;
  char* kvl = gl;
  float* wsl = (float*)(gl + 2 * KVBUF) + wid * 64; float* li_l = wsl; float* al_l = wsl + 32;
  char* Ol = gl + 2 * KVBUF + 2048 + wid * 8704;
  float* Yl = (float*)gl;
  const int head = wid >> 1, qh = wid & 1;
  int sdst[3];
#pragma unroll
  for (int j = 0; j < 3; ++j) { const int id = tid + 512 * j, key = id / 24, ch = id % 24;
    sdst[j] = ch < 16 ? (int)off_a(key, ch) : 16384 + key * 128 + (((ch - 16) ^ ((key >> 1) & 7)) << 4); }
  const int xq = (r32 >> 2) & 3;
  const int ke = 2048 * (r32 >> 3) + 64 * (r32 & 7) + 16 * (hi ^ xq), ko = 2048 * (r32 >> 3) + 64 * (r32 & 7) + 16 * ((2 + hi) ^ xq);
  const int kr = r32 * 128 + ((hi ^ ((r32 >> 1) & 7)) << 4);
  const int tb = lane >> 4 & 1, tq = (lane & 15) >> 2, tp = lane & 3;
  const int vbl = 2048 * hi + 64 * tq + 32 * (tb ^ hi) + 8 * (tp & 1);
  const int lbase = (int)(uintptr_t)kvl;
  const int vb0 = lbase + vbl + 16 * (tp >> 1), vb1 = lbase + vbl + 256 + 16 * ((tp >> 1) ^ 1);
  for (int u = blockIdx.x; u < 256; u += gridDim.x) {
    const int b = u >> 6, qb = u & 63;
    const size_t tok0 = (size_t)b * SEQ + qb * 64 + qh * 32;
    const u16* KVb = KVg + (size_t)b * SEQ * 192;
    float m_reg = -1e30f, l_reg = 0.f; f32x16 o[4]; bf16x8 qr[12];
#pragma unroll
    for (int d = 0; d < 4; ++d)
#pragma unroll
      for (int r = 0; r < 16; ++r) o[d][r] = 0.f;
    { const u16* Qw = Qg + (tok0 + r32) * 768 + head * 192 + hi * 8;
#pragma unroll
      for (int d0 = 0; d0 < 12; ++d0) qr[d0] = *(const bf16x8*)(Qw + d0 * 16); }
    u32x4 st0[3];
#define SLOAD(S, k0) do { const u16* _p = KVb + (size_t)(k0) * 192 + tid * 8; S[0] = *(const u32x4*)_p; S[1] = *(const u32x4*)(_p + 4096); S[2] = *(const u32x4*)(_p + 8192); } while (0)
#define SWRITE(bufi, S) do { char* _d = kvl + (bufi) * KVBUF; *(u32x4*)(_d + sdst[0]) = S[0]; *(u32x4*)(_d + sdst[1]) = S[1]; *(u32x4*)(_d + sdst[2]) = S[2]; } while (0)
#define RESC(al) do { if (__any((al) < 1.f)) { if (hi == 0) al_l[r32] = (al); asm volatile("s_waitcnt lgkmcnt(0)" ::: "memory"); \
    _Pragma("unroll") for (int d = 0; d < 4; ++d) _Pragma("unroll") for (int r = 0; r < 16; ++r) o[d][r] *= al_l[crow(r, hi)]; } } while (0)
    constexpr int NT = SEQ / 64;
    __syncthreads();
    SLOAD(st0, 0); SWRITE(0, st0); SLOAD(st0, 64); __syncthreads();
    for (int j = 0; j < NT; ++j) {
      const int bo = (j & 1) * KVBUF;
      f32x16 p0, p1; float mn, al; bf16x8 pa0, pa1, pa2, pa3;
      qkt192(p0, p1, kvl + bo, qr, ke, ko, kr);
      partialSM(p0, p1, m_reg, mn, al);
      RESC(al);
      finishSM(p0, p1, al, l_reg, pa0, pa1, pa2, pa3);
      if (j + 1 < NT) { SWRITE((j + 1) & 1, st0); if (j + 2 < NT) SLOAD(st0, (j + 2) * 64); }
      SBAR();
      pv_all(o, vb0 + bo, vb1 + bo, pa0, pa1, pa2, pa3);
      __syncthreads();
    }
#undef SLOAD
#undef SWRITE
#undef RESC
    int r32e = r32, hie = hi, lne = lane;
    asm volatile("" : "+v"(r32e), "+v"(hie), "+v"(lne));
    if (hie == 0) li_l[r32e] = l_reg;
    asm volatile("s_waitcnt lgkmcnt(0)" ::: "memory");
#pragma unroll
    for (int r = 0; r < 16; ++r) {
      const int q = crow(r, hie); const float rl = __builtin_amdgcn_rcpf(li_l[q]);
#pragma unroll
      for (int d = 0; d < 4; ++d) *(u16*)(Ol + q * 272 + (32 * d + r32e) * 2) = f2bf(o[d][r] * rl);
    }
    asm volatile("s_waitcnt lgkmcnt(0)" ::: "memory");
    f32x16 y[4];
#pragma unroll
    for (int n = 0; n < 4; ++n)
#pragma unroll
      for (int r = 0; r < 16; ++r) y[n][r] = 0.f;
    const u16* wuv = WUV + ((size_t)head * 128 + r32e) * 128 + 8 * hie;
#pragma unroll 2
    for (int s = 0; s < 8; ++s) {
      const bf16x8 af = *(const bf16x8*)(Ol + r32e * 272 + (16 * s + 8 * hie) * 2);
#pragma unroll
      for (int n = 0; n < 4; ++n) {
        const bf16x8 bw = *(const bf16x8*)(wuv + 32 * n * 128 + 16 * s);
        y[n] = MFMA32(af, bw, y[n]);
      }
    }
    __syncthreads();
#pragma unroll
    for (int n = 0; n < 4; ++n)
#pragma unroll
      for (int r = 0; r < 16; ++r) Yl[(qh * 32 + crow(r, hie)) * 513 + head * 128 + 32 * n + r32e] = y[n][r];
    __syncthreads();
    for (int i = 0; i < 8; ++i) {
      const int pl = wid * 8 + i; const size_t tok = (size_t)b * SEQ + qb * 64 + pl;
      float v[8], ssq = 0.f;
#pragma unroll
      for (int jj = 0; jj < 8; ++jj) { v[jj] = Yl[pl * 513 + lne + 64 * jj]; ssq += v[jj] * v[jj]; }
      ssq = wave_sum(ssq);
      const float rstd = rsqrtf(ssq * (1.f / 512.f) + EPS);
#pragma unroll
      for (int jj = 0; jj < 8; ++jj) { const int col = lne + 64 * jj; Y[tok * 1024 + col] = f2bf(v[jj] * rstd * a.g_attn_out[col]); }
    }
    __syncthreads();
  }
}

__device__ void phase5(const Args& a, char* lds) {
  unsigned char* ws = a.ws;
  const int tid = threadIdx.x, lane = tid & 63, wv = tid >> 6;
  const u16* Y = (const u16*)(ws + WS_Y); const u16* WO = (const u16*)(ws + WS_WO);
  float* X1 = (float*)(ws + WS_X1); float* SSQ = (float*)(ws + WS_SSQ); const float* mod = (const float*)(ws + WS_MOD);
  char* gl = lds + LDS_DATA; float* Cl = (float*)gl;
  for (int u = blockIdx.x; u < 128 * 4; u += gridDim.x) {
    const int mt = u >> 2, nt = u & 3, R0 = mt * 128, b = R0 >> 12;
    f32x16 acc[2][2];
    gemm_128x256(Y + (size_t)R0 * 1024, 1024, WO + (size_t)(nt * 256) * 1024, 1024, 16, acc, gl);
    acc_to_lds(acc, Cl);
    __syncthreads();
    float g1[4];
#pragma unroll
    for (int j = 0; j < 4; ++j) g1[j] = mod[b * 6144 + 2048 + nt * 256 + lane + 64 * j];
    for (int i0 = 0; i0 < 16; i0 += 8) {
      float xv[8][4];
#pragma unroll
      for (int i = 0; i < 8; ++i)
#pragma unroll
        for (int j = 0; j < 4; ++j) xv[i][j] = a.x[(size_t)(R0 + wv * 16 + i0 + i) * 1024 + nt * 256 + lane + 64 * j];
#pragma unroll
      for (int i = 0; i < 8; ++i) {
        const int row = wv * 16 + i0 + i; const size_t tok = R0 + row; float ssq = 0.f;
#pragma unroll
        for (int j = 0; j < 4; ++j) {
          const int col = nt * 256 + lane + 64 * j;
          const float v = xv[i][j] + g1[j] * Cl[row * CLD + lane + 64 * j];
          X1[tok * 1024 + col] = v; ssq += v * v;
        }
        ssq = wave_sum(ssq);
        if (lane == 0) SSQ[tok * 4 + nt] = ssq;
      }
    }
    __syncthreads();
  }
}
__device__ void phase5b(const Args& a) {
  unsigned char* ws = a.ws;
  const int tid = threadIdx.x, lane = tid & 63, wv = tid >> 6;
  const float* X1 = (const float*)(ws + WS_X1); const float* SSQ = (const float*)(ws + WS_SSQ); const float* mod = (const float*)(ws + WS_MOD);
  u16* H = (u16*)(ws + WS_H);
  for (int u = blockIdx.x; u < T / 64; u += gridDim.x) {
    const int b = u >> 6;
    float4 sh[4], sc[4], g[4];
#pragma unroll
    for (int j = 0; j < 4; ++j) {
      const int col = j * 256 + lane * 4;
      sh[j] = *(const float4*)(mod + b * 6144 + 3072 + col); sc[j] = *(const float4*)(mod + b * 6144 + 4096 + col); g[j] = *(const float4*)(a.g_norm2 + col);
    }
    for (int i = 0; i < 8; ++i) {
      const size_t r = (size_t)u * 64 + wv * 8 + i;
      const float4 sq = *(const float4*)(SSQ + r * 4);
      const float rstd = rsqrtf((sq.x + sq.y + sq.z + sq.w) * (1.f / 1024.f) + EPS);
#pragma unroll
      for (int j = 0; j < 4; ++j) {
        const int col = j * 256 + lane * 4;
        const float4 xv = *(const float4*)(X1 + r * 1024 + col);
        const float h0 = xv.x * rstd * g[j].x * (1.f + sc[j].x) + sh[j].x, h1 = xv.y * rstd * g[j].y * (1.f + sc[j].y) + sh[j].y;
        const float h2 = xv.z * rstd * g[j].z * (1.f + sc[j].z) + sh[j].z, h3 = xv.w * rstd * g[j].w * (1.f + sc[j].w) + sh[j].w;
        uint2 o = {pack2(h0, h1), pack2(h2, h3)};
        *(uint2*)(H + r * 1024 + col) = o;
      }
    }
  }
}

__device__ __forceinline__ float vmaxf(float a, float b) { float r; asm("v_max_f32 %0, %1, %2" : "=v"(r) : "v"(a), "v"(b)); return r; }
__device__ __forceinline__ float vminf(float a, float b) { float r; asm("v_min_f32 %0, %1, %2" : "=v"(r) : "v"(a), "v"(b)); return r; }
#define TK_CE(x, y) do { const float _h = vmaxf((x), (y)); (y) = vminf((x), (y)); (x) = _h; } while (0)
#define TK_SORT16(t) do { TK_CE(t[0], t[1]); TK_CE(t[2], t[3]); TK_CE(t[0], t[2]); TK_CE(t[1], t[3]); TK_CE(t[1], t[2]); TK_CE(t[4], t[5]); TK_CE(t[6], t[7]); TK_CE(t[4], t[6]); TK_CE(t[5], t[7]); TK_CE(t[5], t[6]); TK_CE(t[0], t[4]); TK_CE(t[2], t[6]); TK_CE(t[2], t[4]); TK_CE(t[1], t[5]); TK_CE(t[3], t[7]); TK_CE(t[3], t[5]); TK_CE(t[1], t[2]); TK_CE(t[3], t[4]); TK_CE(t[5], t[6]); TK_CE(t[8], t[9]); TK_CE(t[10], t[11]); TK_CE(t[8], t[10]); TK_CE(t[9], t[11]); TK_CE(t[9], t[10]); TK_CE(t[12], t[13]); TK_CE(t[14], t[15]); TK_CE(t[12], t[14]); TK_CE(t[13], t[15]); TK_CE(t[13], t[14]); TK_CE(t[8], t[12]); TK_CE(t[10], t[14]); TK_CE(t[10], t[12]); TK_CE(t[9], t[13]); TK_CE(t[11], t[15]); TK_CE(t[11], t[13]); TK_CE(t[9], t[10]); TK_CE(t[11], t[12]); TK_CE(t[13], t[14]); TK_CE(t[0], t[8]); TK_CE(t[4], t[12]); TK_CE(t[4], t[8]); TK_CE(t[2], t[10]); TK_CE(t[6], t[14]); TK_CE(t[6], t[10]); TK_CE(t[2], t[4]); TK_CE(t[6], t[8]); TK_CE(t[10], t[12]); TK_CE(t[1], t[9]); TK_CE(t[5], t[13]); TK_CE(t[5], t[9]); TK_CE(t[3], t[11]); TK_CE(t[7], t[15]); TK_CE(t[7], t[11]); TK_CE(t[3], t[5]); TK_CE(t[7], t[9]); TK_CE(t[11], t[13]); TK_CE(t[1], t[2]); TK_CE(t[3], t[4]); TK_CE(t[5], t[6]); TK_CE(t[7], t[8]); TK_CE(t[9], t[10]); TK_CE(t[11], t[12]); TK_CE(t[13], t[14]); } while (0)
#define TK_BMERGE16(t) do { TK_CE(t[0], t[8]); TK_CE(t[1], t[9]); TK_CE(t[2], t[10]); TK_CE(t[3], t[11]); TK_CE(t[4], t[12]); TK_CE(t[5], t[13]); TK_CE(t[6], t[14]); TK_CE(t[7], t[15]); TK_CE(t[0], t[4]); TK_CE(t[1], t[5]); TK_CE(t[2], t[6]); TK_CE(t[3], t[7]); TK_CE(t[8], t[12]); TK_CE(t[9], t[13]); TK_CE(t[10], t[14]); TK_CE(t[11], t[15]); TK_CE(t[0], t[2]); TK_CE(t[1], t[3]); TK_CE(t[4], t[6]); TK_CE(t[5], t[7]); TK_CE(t[8], t[10]); TK_CE(t[9], t[11]); TK_CE(t[12], t[14]); TK_CE(t[13], t[15]); TK_CE(t[0], t[1]); TK_CE(t[2], t[3]); TK_CE(t[4], t[5]); TK_CE(t[6], t[7]); TK_CE(t[8], t[9]); TK_CE(t[10], t[11]); TK_CE(t[12], t[13]); TK_CE(t[14], t[15]); } while (0)
#define TK_MERGE(A, B) do { _Pragma("unroll") for (int _i = 0; _i < 16; ++_i) A[_i] = vmaxf(A[_i], B[15 - _i]); TK_BMERGE16(A); } while (0)
__constant__ unsigned long long TK_I[4] = {0x0000000000000000ull, 0x0007744411111111ull, 0x0006655333322222ull, 0x00000000FEDCBA98ull};
__constant__ unsigned long long TK_J[4] = {0xFEDCBA9876543210ull, 0x0001021076543210ull, 0x0001010321043210ull, 0x0000000000000000ull};
__constant__ int TK_N[4] = {16, 13, 13, 8};
#define TOP_INSERT(t, v) do { float _v = (v); _Pragma("unroll") for (int _i = 0; _i < 16; ++_i) { const float _h = vmaxf(t[_i], _v); _v = vminf(t[_i], _v); t[_i] = _h; } } while (0)

__device__ void phase6(const Args& a, char* lds) {
  unsigned char* ws = a.ws;
  const int tid = threadIdx.x, lane = tid & 63, wv = tid >> 6, r32 = lane & 31, hi = lane >> 5;
  const u16* H = (const u16*)(ws + WS_H); const u16* WST = (const u16*)(ws + WS_WST);
  float* TOPS = (float*)(ws + WS_TOPK);
  char* gl = lds + LDS_DATA;
  for (int u = blockIdx.x; u < 16 * 64; u += gridDim.x) {
    const int hh = u & 15, tb = u >> 4;
    f32x16 sc[4];
    gemm_128x256_wide(WST + (size_t)hh * 128 * 1024, 1024, H + (size_t)tb * 256 * 1024, 1024, 16, sc, gl);
    float g0[16], g1[16], g2[16], g3[16], p[16];
#pragma unroll
    for (int r = 0; r < 16; ++r) {
      const unsigned key = crow(r, hi);
      g0[r] = __uint_as_float((__float_as_uint(sc[0][r]) & ~127u) | key);        g1[r] = __uint_as_float((__float_as_uint(sc[1][r]) & ~127u) | (32u + key));
      g2[r] = __uint_as_float((__float_as_uint(sc[2][r]) & ~127u) | (64u + key)); g3[r] = __uint_as_float((__float_as_uint(sc[3][r]) & ~127u) | (96u + key));
    }
    TK_SORT16(g0); TK_SORT16(g1); TK_SORT16(g2); TK_SORT16(g3);
    TK_MERGE(g0, g1); TK_MERGE(g2, g3); TK_MERGE(g0, g2);
#pragma unroll
    for (int i = 0; i < 16; ++i) {
      auto rr = __builtin_amdgcn_permlane32_swap(__float_as_uint(g0[i]), __float_as_uint(g0[i]), false, false);
      p[i] = __uint_as_float(hi ? rr[0] : rr[1]);
    }
    TK_MERGE(g0, p);
    if (hi == 0) {
      float* dst = TOPS + ((size_t)(tb * 256 + 32 * wv + r32) * 16 + hh) * 16;
#pragma unroll
      for (int i = 0; i < 16; i += 4) *(float4*)(dst + i) = make_float4(g0[i], g0[i + 1], g0[i + 2], g0[i + 3]);
    }
  }
}

typedef __attribute__((ext_vector_type(4))) float f32x4;
#define MFMA4(a, b, c) __builtin_amdgcn_mfma_f32_4x4x4bf16_1k((a), (b), (c), 0, 0, 0)
constexpr int P7_VROW = 2112, P7_VBUF = 4 * P7_VROW;
constexpr int P7_RING = 64;
constexpr int P7_ENT  = P7_RING + 8 * 2 * P7_VBUF;
constexpr int P7_CNT  = P7_ENT + 8 * 2048;
static_assert(P7_CNT + 8 * 256 <= LDS_BYTES, "phase 7 LDS map");
__device__ __forceinline__ float sel4(const f32x4& d, int k) { return k == 0 ? d[0] : (k == 1 ? d[1] : (k == 2 ? d[2] : d[3])); }
__device__ __forceinline__ unsigned fp8x2_bf16(unsigned x, float sc, bool hi) {
  return hi ? __builtin_bit_cast(unsigned, __builtin_amdgcn_cvt_scalef32_pk_bf16_fp8(x, sc, true)) : __builtin_bit_cast(unsigned, __builtin_amdgcn_cvt_scalef32_pk_bf16_fp8(x, sc, false));
}

__device__ void phase7(const Args& a, char* lds) {
  unsigned char* ws = a.ws;
  const int tid = threadIdx.x, lane = tid & 63, wv = __builtin_amdgcn_readfirstlane(tid >> 6), blk = lane >> 2, j4 = lane & 3;
  const u16* H = (const u16*)(ws + WS_H); const unsigned char* U8 = ws + WS_UB; const unsigned char* V8 = ws + WS_VB;
  const float* TOPS = (const float*)(ws + WS_TOPK); const float* X1 = (const float*)(ws + WS_X1); const float* mod = (const float*)(ws + WS_MOD);
  const unsigned lbase = (unsigned)(uintptr_t)lds;
  char* ring = lds + P7_RING + wv * 2 * P7_VBUF;
  unsigned* ents = (unsigned*)(lds + P7_ENT + wv * 2048);
  int* cntw = (int*)(lds + P7_CNT + wv * 256);
  const int trb = (int)(lbase + P7_RING + wv * 2 * P7_VBUF) + ((lane & 15) >> 2) * P7_VROW + 32 * (lane >> 4) + 8 * (lane & 3);
  const int NWV = gridDim.x * 8;
  for (int qd = blockIdx.x * 8 + wv; qd < T / 4; qd += NWV) {
    const int tok0 = qd * 4, b = tok0 >> 12;
    float* TS = (float*)ring;
#pragma unroll
    for (int i = 0; i < 4; ++i) *(float4*)(TS + 256 * i + 4 * lane) = *(const float4*)(TOPS + (size_t)tok0 * 256 + 256 * i + 4 * lane);
    cntw[lane] = 0;
    asm volatile("s_waitcnt lgkmcnt(0)" ::: "memory");
    unsigned ec[8];
#pragma unroll
    for (int rd = 0; rd < 2; ++rd) {
      const int combo = (lane >> 2) + 16 * rd, tl = combo >> 3, hd = combo & 7, q = lane & 3;
      const float* t1 = TS + (tl * 16 + hd * 2) * 16; const float* t2 = t1 + 16;
      const unsigned long long ip = TK_I[q], jp = TK_J[q]; const int cn = TK_N[q];
      float L[16], P[16];
#pragma unroll
      for (int c = 0; c < 16; ++c) {
        const unsigned i = (unsigned)(ip >> (4 * c)) & 15u, j = (unsigned)(jp >> (4 * c)) & 15u;
        const float sm = t1[i] + t2[j];
        L[c] = c < cn ? __uint_as_float((__float_as_uint(sm) & ~255u) | (i << 4) | j) : -3.0e38f;
      }
      TK_SORT16(L);
#pragma unroll
      for (int c = 0; c < 16; ++c) P[c] = __uint_as_float(__builtin_amdgcn_update_dpp(0, __float_as_uint(L[c]), 0xB1, 0xf, 0xf, false));
      TK_MERGE(L, P);
#pragma unroll
      for (int c = 0; c < 16; ++c) P[c] = __uint_as_float(__builtin_amdgcn_update_dpp(0, __float_as_uint(L[c]), 0x4E, 0xf, 0xf, false));
      TK_MERGE(L, P);
      float sum = 0.f;
      const float m0 = __uint_as_float(__float_as_uint(L[0]) & ~255u);
#pragma unroll
      for (int c = 0; c < 16; ++c) sum += __expf(__uint_as_float(__float_as_uint(L[c]) & ~255u) - m0);
      const float inv = 1.f / sum;
#pragma unroll
      for (int r = 0; r < 4; ++r) {
        const float lv = q == 0 ? L[r] : (q == 1 ? L[4 + r] : (q == 2 ? L[8 + r] : L[12 + r]));
        const unsigned bits = __float_as_uint(lv), id = bits & 255u;
        const unsigned i1 = __float_as_uint(t1[id >> 4]) & 127u, i2 = __float_as_uint(t2[id & 15u]) & 127u;
        const float gate = __expf(__uint_as_float(bits & ~255u) - m0) * inv;
        ec[4 * rd + r] = (i1 * 128u + i2) | ((unsigned)tl << 14) | (pack2(0.f, gate) & 0xFFFF0000u);
      }
    }
    {
#pragma unroll
      for (int i = 0; i < 8; ++i) atomicAdd(&cntw[(ec[i] & 0x3FFFu) >> 8], 1);
      asm volatile("s_waitcnt lgkmcnt(0)" ::: "memory");
      const int c = cntw[lane]; int inc = c;
#pragma unroll
      for (int o = 1; o < 64; o <<= 1) { const int v = __shfl_up(inc, o, 64); if (lane >= o) inc += v; }
      asm volatile("s_waitcnt lgkmcnt(0)" ::: "memory");
      cntw[lane] = inc - c;
      asm volatile("s_waitcnt lgkmcnt(0)" ::: "memory");
#pragma unroll
      for (int i = 0; i < 8; ++i) { const int pos = atomicAdd(&cntw[(ec[i] & 0x3FFFu) >> 8], 1); ents[pos] = ec[i]; }
      asm volatile("s_waitcnt lgkmcnt(0)" ::: "memory");
    }
    u32x4 hA[4][2];
#pragma unroll
    for (int i = 0; i < 4; ++i) { const u16* ph = H + (size_t)(tok0 + j4) * 1024 + 256 * i + 16 * blk; hA[i][0] = *(const u32x4*)ph; hA[i][1] = *(const u32x4*)(ph + 8); }
    f32x4 acc[16];
#pragma unroll
    for (int c = 0; c < 16; ++c) acc[c] = (f32x4){0.f, 0.f, 0.f, 0.f};
#define P7_VPHASE(bufi) do { const int _vb = trb + (bufi) * P7_VBUF;                                                            \
      { const s16x4 v0 = tr_read<0>(_vb), v1 = tr_read<128>(_vb), v2 = tr_read<256>(_vb), v3 = tr_read<384>(_vb),               \
                    v4 = tr_read<512>(_vb), v5 = tr_read<640>(_vb), v6 = tr_read<768>(_vb), v7 = tr_read<896>(_vb);               \
        asm volatile("s_waitcnt lgkmcnt(0)" ::: "memory"); SBAR();                                                                \
        acc[0] = MFMA4(awp, v0, acc[0]); acc[1] = MFMA4(awp, v1, acc[1]); acc[2] = MFMA4(awp, v2, acc[2]); acc[3] = MFMA4(awp, v3, acc[3]);   \
        acc[4] = MFMA4(awp, v4, acc[4]); acc[5] = MFMA4(awp, v5, acc[5]); acc[6] = MFMA4(awp, v6, acc[6]); acc[7] = MFMA4(awp, v7, acc[7]); } \
      { const s16x4 v0 = tr_read<1024>(_vb), v1 = tr_read<1152>(_vb), v2 = tr_read<1280>(_vb), v3 = tr_read<1408>(_vb),         \
                    v4 = tr_read<1536>(_vb), v5 = tr_read<1664>(_vb), v6 = tr_read<1792>(_vb), v7 = tr_read<1920>(_vb);           \
        asm volatile("s_waitcnt lgkmcnt(0)" ::: "memory"); SBAR();                                                                \
        acc[8] = MFMA4(awp, v0, acc[8]); acc[9] = MFMA4(awp, v1, acc[9]); acc[10] = MFMA4(awp, v2, acc[10]); acc[11] = MFMA4(awp, v3, acc[11]); \
        acc[12] = MFMA4(awp, v4, acc[12]); acc[13] = MFMA4(awp, v5, acc[13]); acc[14] = MFMA4(awp, v6, acc[14]); acc[15] = MFMA4(awp, v7, acc[15]); } } while (0)
    u32x4 u8[4], v8[4];
#define P7_LOADG(EN) do { const unsigned _ex = (EN) & 0x3FFFu; const unsigned char* _pu = U8 + (size_t)_ex * 1024 + 16 * blk;      \
      _Pragma("unroll") for (int _i = 0; _i < 4; ++_i) u8[_i] = *(const u32x4*)(_pu + 256 * _i);                                 \
      _Pragma("unroll") for (int _q = 0; _q < 4; ++_q) { const unsigned _eq = (unsigned)__builtin_amdgcn_readlane((int)_ex, _q);  \
        v8[_q] = *(const u32x4*)(V8 + (size_t)_eq * 1024 + 16 * lane); } } while (0)
    unsigned enc = ents[j4], enn = ents[4 + j4];
    P7_LOADG(enc);
    s16x4 awp = {0, 0, 0, 0};
    constexpr int NG = 128;
    for (int g = 0; g < NG; ++g) {
      if (g > 0) P7_VPHASE((g - 1) & 1);
      f32x4 d0 = {0.f, 0.f, 0.f, 0.f}, d1 = {0.f, 0.f, 0.f, 0.f};
#pragma unroll
      for (int i = 0; i < 4; ++i)
#pragma unroll
        for (int w = 0; w < 4; ++w) {
          const uint2 ub = {fp8x2_bf16(u8[i][w], 1.f / PEER_SU, false), fp8x2_bf16(u8[i][w], 1.f / PEER_SU, true)};
          const uint2 ha = {hA[i][w >> 1][2 * (w & 1)], hA[i][w >> 1][2 * (w & 1) + 1]};
          if (w & 1) d1 = MFMA4(__builtin_bit_cast(s16x4, ha), __builtin_bit_cast(s16x4, ub), d1);
          else       d0 = MFMA4(__builtin_bit_cast(s16x4, ha), __builtin_bit_cast(s16x4, ub), d0);
        }
      { char* vw = ring + (g & 1) * P7_VBUF + lane * 32;
#pragma unroll
        for (int q = 0; q < 4; ++q) {
          u32x4 o0, o1;
          o0[0] = fp8x2_bf16(v8[q][0], 1.f / PEER_SV, false); o0[1] = fp8x2_bf16(v8[q][0], 1.f / PEER_SV, true);
          o0[2] = fp8x2_bf16(v8[q][1], 1.f / PEER_SV, false); o0[3] = fp8x2_bf16(v8[q][1], 1.f / PEER_SV, true);
          o1[0] = fp8x2_bf16(v8[q][2], 1.f / PEER_SV, false); o1[1] = fp8x2_bf16(v8[q][2], 1.f / PEER_SV, true);
          o1[2] = fp8x2_bf16(v8[q][3], 1.f / PEER_SV, false); o1[3] = fp8x2_bf16(v8[q][3], 1.f / PEER_SV, true);
          *(u32x4*)(vw + q * P7_VROW) = o0; *(u32x4*)(vw + q * P7_VROW + 16) = o1;
        } }
      unsigned en2 = 0u;
      if (g + 1 < NG) { P7_LOADG(enn); if (g + 2 < NG) en2 = ents[4 * (g + 2) + j4]; }
      const int tk = (enc >> 14) & 3;
      float av = sel4(d0, tk) + sel4(d1, tk);
      av += __uint_as_float(__builtin_amdgcn_update_dpp(0, __float_as_uint(av), 0x124, 0xf, 0xf, false));
      av += __uint_as_float(__builtin_amdgcn_update_dpp(0, __float_as_uint(av), 0x128, 0xf, 0xf, false));
      av += __shfl_xor(av, 16, 64);
      { auto rr = __builtin_amdgcn_permlane32_swap(__float_as_uint(av), __float_as_uint(av), false, false); av = __uint_as_float(rr[0]) + __uint_as_float(rr[1]); }
      const float wgt = gelu_exact(av) * __uint_as_float(enc & 0xFFFF0000u);
      float z[4];
#define P7_QB(x, k) __builtin_amdgcn_update_dpp(0, (x), (k) * 0x55, 0xf, 0xf, false)
      { const unsigned wb = __float_as_uint(wgt), tb = (unsigned)tk;
        unsigned w0 = P7_QB(wb, 0), w1 = P7_QB(wb, 1), w2 = P7_QB(wb, 2), w3 = P7_QB(wb, 3);
        unsigned t0 = P7_QB(tb, 0), t1 = P7_QB(tb, 1), t2 = P7_QB(tb, 2), t3 = P7_QB(tb, 3);
        asm volatile("" : "+v"(w0), "+v"(w1), "+v"(w2), "+v"(w3), "+v"(t0), "+v"(t1), "+v"(t2), "+v"(t3));
        z[0] = ((int)t0 == j4) ? __uint_as_float(w0) : 0.f; z[1] = ((int)t1 == j4) ? __uint_as_float(w1) : 0.f;
        z[2] = ((int)t2 == j4) ? __uint_as_float(w2) : 0.f; z[3] = ((int)t3 == j4) ? __uint_as_float(w3) : 0.f; }
#undef P7_QB
      { const uint2 pk = {pack2(z[0], z[1]), pack2(z[2], z[3])}; awp = __builtin_bit_cast(s16x4, pk); }
      enc = enn; enn = en2;
    }
#undef P7_LOADG
    P7_VPHASE((NG - 1) & 1);
#undef P7_VPHASE
    int lne = lane; asm volatile("" : "+v"(lne));
    float ss[4] = {0.f, 0.f, 0.f, 0.f};
#pragma unroll
    for (int c = 0; c < 16; ++c) {
      const float g2 = mod[b * 6144 + 5120 + 64 * c + lne];
#pragma unroll
      for (int r = 0; r < 4; ++r) { const float v = X1[(size_t)(tok0 + r) * 1024 + 64 * c + lne] + g2 * acc[c][r]; acc[c][r] = v; ss[r] += v * v; }
    }
    float rstd[4];
#pragma unroll
    for (int r = 0; r < 4; ++r) rstd[r] = rsqrtf(wave_sum(ss[r]) * (1.f / 1024.f) + EPS);
#pragma unroll
    for (int c = 0; c < 16; ++c) {
      const float gf = a.g_final[64 * c + lne];
#pragma unroll
      for (int r = 0; r < 4; ++r) a.out[(size_t)(tok0 + r) * 1024 + 64 * c + lne] = acc[c][r] * rstd[r] * gf;
    }
  }
}

constexpr int N_PHASES = 9;
__global__ void __launch_bounds__(512, 2) fwd(Args args) {
  extern __shared__ __attribute__((aligned(16))) char lds[];
  if (threadIdx.x == 0) *(uint4*)lds = make_uint4(0u, 0u, 0u, 0u);
  __syncthreads();
  const int lo = args.ph_lo, hi = args.ph_hi;
  XcdBarrier bar; bar.bar = (unsigned*)(args.ws + WS_BAR); bar.x = 0; bar.st = (volatile LAS unsigned*)lds;
  if (hi - lo > 1) bar = xcd_barrier_post((unsigned*)(args.ws + WS_BAR), (volatile LAS unsigned*)lds);
#ifndef ONLY_PHASE
#define ONLY_PHASE -1
#endif
#define IN(k) (lo <= (k) && (k) < hi && (ONLY_PHASE < 0 || ONLY_PHASE == (k)))
#define SEAM(k) do { if (IN(k) && IN((k) + 1)) xcd_barrier(bar); } while (0)
  if (IN(0)) phase0(args, lds);
  SEAM(0);
  if (IN(1)) { phase1(args, lds); phase1b(args, lds); }
  SEAM(1);
  if (IN(2)) phase2(args, lds);
  SEAM(2);
  if (IN(3)) phase3(args, lds);
  SEAM(3);
  if (IN(4)) phase4(args, lds);
  SEAM(4);
  if (IN(5)) phase5(args, lds);
  SEAM(5);
  if (IN(6)) phase5b(args);
  SEAM(6);
  if (IN(7)) phase6(args, lds);
  SEAM(7);
  if (IN(8)) phase7(args, lds);
#undef IN
#undef SEAM
}

extern "C" void kernel_launch(void* const* d_in, const int* in_sizes, int n_in, void* d_out, int out_size, void* d_ws, size_t ws_size, hipStream_t stream) {
  static int grid = 0;
  if (grid == 0) {
    if (n_in != 23 || out_size != T * DM || ws_size < WS_END) { fprintf(stderr, "kernel_launch: unexpected shapes (n_in %d out %d ws %zu need %zu)\n", n_in, out_size, ws_size, (size_t)WS_END); grid = -1; return; }
    int dev = 0, cus = 0, per_cu = 0;
    (void)hipGetDevice(&dev); (void)hipDeviceGetAttribute(&cus, hipDeviceAttributeMultiprocessorCount, dev);
    if (hipFuncSetAttribute((const void*)fwd, hipFuncAttributeMaxDynamicSharedMemorySize, LDS_BYTES) != hipSuccess) { fprintf(stderr, "kernel_launch: hipFuncSetAttribute failed\n"); grid = -1; return; }
    if (hipOccupancyMaxActiveBlocksPerMultiprocessor(&per_cu, (const void*)fwd, 512, LDS_BYTES) != hipSuccess || per_cu < 1) { fprintf(stderr, "kernel_launch: occupancy query says %d\n", per_cu); per_cu = 1; }
    (void)hipGetLastError();
    grid = cus;
  }
  if (grid < 0) return;
  (void)hipMemsetAsync((char*)d_ws + WS_BAR, 0, 16384, stream);
  Args a{};
  a.x = (const float*)d_in[0]; a.c = (const float*)d_in[1]; a.pos = (const int*)d_in[2];
  a.w_ada = (const float*)d_in[3]; a.b_ada = (const float*)d_in[4]; a.g_norm1 = (const float*)d_in[5]; a.w_in = (const float*)d_in[6];
  a.g_q_a = (const float*)d_in[7]; a.w_uq = (const float*)d_in[8]; a.g_kv_a = (const float*)d_in[9]; a.w_ukv = (const float*)d_in[10];
  a.g_sg = (const float*)d_in[11]; a.w_sg = (const float*)d_in[12]; a.b_sg = (const float*)d_in[13]; a.g_attn_out = (const float*)d_in[14];
  a.g_sg_out = (const float*)d_in[15]; a.w_o = (const float*)d_in[16]; a.g_norm2 = (const float*)d_in[17]; a.w_peer_q = (const float*)d_in[18];
  a.peer_keys = (const float*)d_in[19]; a.peer_u = (const float*)d_in[20]; a.peer_v = (const float*)d_in[21]; a.g_final = (const float*)d_in[22];
  a.out = (float*)d_out; a.ws = (unsigned char*)d_ws;
#if N_LAUNCH_MODE == 0
  a.ph_lo = 0; a.ph_hi = N_PHASES;
  hipLaunchKernelGGL(fwd, dim3(grid), dim3(512), LDS_BYTES, stream, a);
#else
  for (int p = 0; p < N_PHASES; ++p) for (int rep = 0; rep <= ((DUP_MASK >> p) & 1); ++rep) { a.ph_lo = p; a.ph_hi = p + 1; hipLaunchKernelGGL(fwd, dim3(grid), dim3(512), LDS_BYTES, stream, a); }
#endif
  const hipError_t le = hipPeekAtLastError();
  if (le != hipSuccess) fprintf(stderr, "kernel_launch: launch failed: %s\n", hipGetErrorName(le));
}
```

```cpp
#include <hip/hip_runtime.h>
#include <stdint.h>
#include <stdio.h>

#define N_LAUNCH_MODE 0
#define DUP_MASK 0x000

typedef unsigned short u16;
typedef __attribute__((ext_vector_type(8))) short bf16x8;
typedef __attribute__((ext_vector_type(4))) short s16x4;
typedef __attribute__((ext_vector_type(16))) float f32x16;
typedef __attribute__((ext_vector_type(4))) unsigned u32x4;

constexpr int T = 16384, DM = 1024, SEQ = 4096;
constexpr float EPS = 1e-6f;

constexpr size_t WS_BAR  = 0;
constexpr size_t WS_MODP = 16384;
constexpr size_t WS_MOD  = WS_MODP + 786432;
constexpr size_t WS_CS   = WS_MOD + 98304;
constexpr size_t WS_WIN  = WS_CS + 4194304;
constexpr size_t WS_WQ2  = WS_WIN + 3145728;
constexpr size_t WS_WUV  = WS_WQ2 + 393216;
constexpr size_t WS_WO   = WS_WUV + 131072;
constexpr size_t WS_WPQ  = WS_WO + 2097152;
constexpr size_t WS_KEYS = WS_WPQ + 4194304;
constexpr size_t WS_WSG  = WS_KEYS + 524288;
constexpr size_t WS_UB   = WS_WSG + 131072;
constexpr size_t WS_VB   = WS_UB + 33554432;
constexpr size_t WS_H    = WS_VB + 33554432;
constexpr size_t WS_Y    = WS_H + 33554432;
constexpr size_t WS_KV   = WS_Y + 33554432;
constexpr size_t WS_TOPK = WS_KV + 6291456;
constexpr size_t WS_SSQ  = WS_TOPK + 16777216;
constexpr size_t WS_SSQV = WS_SSQ + 262144;
constexpr size_t WS_R1   = WS_SSQV + 131072;
constexpr size_t WS_Q    = WS_R1;
constexpr size_t WS_QA   = WS_Q + 25165824;
constexpr size_t WS_UACT = WS_QA + 8388608;
constexpr size_t WS_GVT  = WS_UACT + 16777216;
constexpr size_t WS_X1   = WS_R1;
constexpr size_t WS_WST  = WS_R1 + 67108864;
constexpr size_t WS_BIASP = WS_WST + 4 * 4194304;
constexpr size_t WS_END  = WS_BIASP + 131072;

constexpr int LDS_BYTES = 155648;
constexpr int LDS_DATA  = 64;

struct Args {
  const float *x, *c; const int* pos;
  const float *w_ada, *b_ada, *g_norm1, *w_in, *g_q_a, *w_uq, *g_kv_a, *w_ukv, *g_sg, *w_sg, *b_sg, *g_attn_out, *g_sg_out,
              *w_o, *g_norm2, *w_peer_q, *peer_keys, *peer_u, *peer_v, *g_final;
  float* out; unsigned char* ws; int ph_lo, ph_hi;
};

#define XB_TMO      128
#define XB_XCNT(j)  (256  + 64 * (j))
#define XB_XSUB(j)  (1280 + 64 * (j))
#define XB_XGEN(j)  (2304 + 64 * (j))
#define XB_TOP      3328
#define XB_TOPGEN   3392
#define XCD_BAR_WORDS 3456
#define XB_SPIN_CAP (1u << 18)
#define LAS __attribute__((address_space(3)))

__device__ __forceinline__ unsigned xb_ld(unsigned* p)              { return __hip_atomic_load(p, __ATOMIC_RELAXED, __HIP_MEMORY_SCOPE_AGENT); }
__device__ __forceinline__ unsigned xb_add(unsigned* p, unsigned v) { return __hip_atomic_fetch_add(p, v, __ATOMIC_RELAXED, __HIP_MEMORY_SCOPE_AGENT); }
__device__ __forceinline__ unsigned xb_xcc_id() { return (unsigned)__builtin_amdgcn_s_getreg((3 << 11) | 20) & 0xFu; }
#define XB_SPIN(cond, bar) do { unsigned _sp = 0; while (cond) { __builtin_amdgcn_s_sleep(1); \
    if ((++_sp & 255u) == 0u) { if (xb_ld(&(bar)[XB_TMO])) break; if (_sp > XB_SPIN_CAP) { atomicAdd(&(bar)[XB_TMO], 1u); break; } } } } while (0)

struct XcdBarrier { unsigned* bar; unsigned x; volatile LAS unsigned* st; };

__device__ __forceinline__ XcdBarrier xcd_barrier_post(unsigned* bar, volatile LAS unsigned* st) {
    XcdBarrier b; b.bar = bar; b.x = xb_xcc_id(); b.st = st;
    if (threadIdx.x == 0) (void)xb_add(&bar[XB_XCNT(b.x)], 1u);
    return b;
}
__device__ __forceinline__ void xcd_barrier_complete(unsigned* bar, unsigned x, unsigned& nloc, unsigned& nx) {
    const unsigned G = gridDim.x * gridDim.y * gridDim.z;
    unsigned sum, cnt, mine, sp = 0u;
    for (;;) {
        sum = 0u; cnt = 0u; mine = 0u;
#pragma unroll
        for (unsigned j = 0; j < 16; ++j) { const unsigned c = xb_ld(&bar[XB_XCNT(j)]); sum += c; cnt += (c > 0u) ? 1u : 0u; mine = (j == x) ? c : mine; }
        if (sum == G) break;
        __builtin_amdgcn_s_sleep(1);
        if ((++sp & 255u) == 0u) { if (xb_ld(&bar[XB_TMO])) break; if (sp > XB_SPIN_CAP) { atomicAdd(&bar[XB_TMO], 1u); break; } }
    }
    nloc = mine > 0u ? mine : 1u; nx = cnt > 0u ? cnt : 1u;
}
__device__ __forceinline__ void xcd_barrier(const XcdBarrier& b) {
    asm volatile("s_waitcnt vmcnt(0)" ::: "memory");
    __syncthreads();
    if (threadIdx.x == 0) {
        unsigned* bar = b.bar;
        __builtin_amdgcn_s_waitcnt(0);
        unsigned nloc = b.st[0], nx = b.st[1];
        if (nloc == 0u) { xcd_barrier_complete(bar, b.x, nloc, nx); b.st[0] = nloc; b.st[1] = nx; }
        const unsigned old = xb_add(&bar[XB_XSUB(b.x)], 1u);
        const unsigned gen = old / nloc;
        if (old + 1u == (gen + 1u) * nloc) {
            __builtin_amdgcn_fence(__ATOMIC_RELEASE, "agent");
            asm volatile("s_waitcnt vmcnt(0)" ::: "memory");
            const unsigned og = xb_add(&bar[XB_TOP], 1u);
            const unsigned tg = og / nx;
            if (og + 1u == (tg + 1u) * nx) xb_add(&bar[XB_TOPGEN], 1u);
            else XB_SPIN(xb_ld(&bar[XB_TOPGEN]) == tg, bar);
            __builtin_amdgcn_fence(__ATOMIC_ACQUIRE, "agent");
            xb_add(&bar[XB_XGEN(b.x)], 1u);
            asm volatile("s_waitcnt vmcnt(0)" ::: "memory");
        } else {
            XB_SPIN(xb_ld(&bar[XB_XGEN(b.x)]) == gen, bar);
            __builtin_amdgcn_fence(__ATOMIC_ACQUIRE, "agent");
            asm volatile("s_waitcnt vmcnt(0)" ::: "memory");
        }
    }
    __syncthreads();
}

__device__ __forceinline__ unsigned pack2(float lo, float hi) {
  typedef __attribute__((ext_vector_type(2))) float f2; typedef __attribute__((ext_vector_type(2))) __bf16 b2;
  f2 v = {lo, hi}; b2 r = __builtin_convertvector(v, b2); return __builtin_bit_cast(unsigned, r);
}
__device__ __forceinline__ u16 f2bf(float f) { return (u16)(pack2(f, 0.f) & 0xFFFFu); }
__device__ __forceinline__ float bflo(unsigned w) { return __uint_as_float(w << 16); }
__device__ __forceinline__ float bfhi(unsigned w) { return __uint_as_float(w & 0xFFFF0000u); }
__device__ __forceinline__ float gelu_exact(float x) {
  const float z = fabsf(x) * 0.70710678118654752f;
  const float t = __builtin_amdgcn_rcpf(fmaf(0.3275911f, z, 1.f));
  float p = fmaf(1.061405429f, t, -1.453152027f); p = fmaf(p, t, 1.421413741f); p = fmaf(p, t, -0.284496736f); p = fmaf(p, t, 0.254829592f);
  const float e = p * t * __expf(-z * z);
  const float erfz = 1.f - e;
  return 0.5f * x * (1.f + copysignf(erfz, x));
}
__device__ __forceinline__ float wave_sum(float v) {
#pragma unroll
  for (int o = 32; o > 0; o >>= 1) v += __shfl_xor(v, o, 64);
  return v;
}
__device__ __forceinline__ int crow(int r, int hi) { return (r & 3) + 8 * (r >> 2) + 4 * hi; }
#define MFMA32(a, b, c) __builtin_amdgcn_mfma_f32_32x32x16_bf16((a), (b), (c), 0, 0, 0)

template <int MAP> __device__ __forceinline__ int colmap(int n) {
  if (MAP == 0) return n;
  if (MAP == 1) return n < 448 ? n : (n < 512 ? -1 : n - 64);
  if (MAP == 2) return (n >> 6) * 192 + 128 + (n & 63);
  return (n >> 7) * 256 + 128 + (n & 127);
}
template <int MAP> __device__ void cvt_transpose(const float* __restrict__ src, int src_ld, int K, int N, u16* __restrict__ dst, int gtid, int gthreads) {
  const int total = N * (K >> 3);
  for (int idx = gtid; idx < total; idx += gthreads) {
    const int n = idx % N, k8 = idx / N, sc = colmap<MAP>(n);
    float v[8];
#pragma unroll
    for (int j = 0; j < 8; ++j) v[j] = sc < 0 ? 0.f : src[(size_t)(k8 * 8 + j) * src_ld + sc];
    u32x4 w = {pack2(v[0], v[1]), pack2(v[2], v[3]), pack2(v[4], v[5]), pack2(v[6], v[7])};
    *(u32x4*)(dst + (size_t)n * K + k8 * 8) = w;
  }
}
template <int MAP> __device__ void cvt_transpose_tiled(const float* __restrict__ src, int src_ld, int K, int N, u16* __restrict__ dst, float* tile) {
  const int tid = threadIdx.x, tk = K >> 6, ntile = tk * (N >> 6);
  for (int t = blockIdx.x; t < ntile; t += gridDim.x) {
    const int k0 = (t % tk) * 64, n0 = (t / tk) * 64;
    __syncthreads();
    { const int nl = tid & 63, sc = colmap<MAP>(n0 + nl);
#pragma unroll
      for (int i = 0; i < 8; ++i) { const int k = (tid >> 6) + 8 * i; tile[k * 65 + nl] = sc < 0 ? 0.f : src[(size_t)(k0 + k) * src_ld + sc]; } }
    __syncthreads();
    { const int n = tid >> 3, kk = tid & 7; float v[8];
#pragma unroll
      for (int j = 0; j < 8; ++j) v[j] = tile[(8 * kk + j) * 65 + n];
      u32x4 w = {pack2(v[0], v[1]), pack2(v[2], v[3]), pack2(v[4], v[5]), pack2(v[6], v[7])};
      *(u32x4*)(dst + (size_t)(n0 + n) * K + k0 + 8 * kk) = w; }
  }
}
__device__ void cvt_direct(const float* __restrict__ src, u16* __restrict__ dst, size_t n8, int gtid, int gthreads) {
  for (size_t i = gtid; i < n8; i += gthreads) {
    const float4 a = *(const float4*)(src + i * 8), b = *(const float4*)(src + i * 8 + 4);
    u32x4 w = {pack2(a.x, a.y), pack2(a.z, a.w), pack2(b.x, b.y), pack2(b.z, b.w)};
    *(u32x4*)(dst + i * 8) = w;
  }
}
constexpr float PEER_SU = 32.f, PEER_SV = 4.f;
__device__ void cvt_fp8(const float* __restrict__ src, unsigned char* __restrict__ dst, size_t n16, float sc, int gtid, int gthreads) {
  for (size_t i = gtid; i < n16; i += gthreads) {
    u32x4 w;
#pragma unroll
    for (int k = 0; k < 4; ++k) {
      const float4 a = *(const float4*)(src + i * 16 + 4 * k);
      int p = __builtin_amdgcn_cvt_pk_fp8_f32(a.x * sc, a.y * sc, 0, false);
      p = __builtin_amdgcn_cvt_pk_fp8_f32(a.z * sc, a.w * sc, p, true);
      w[k] = (unsigned)p;
    }
    *(u32x4*)(dst + i * 16) = w;
  }
}
__device__ __forceinline__ void sincos_acc(float angf, float& sn, float& cs) {
  const double a = (double)angf;
  const double q = __builtin_rint(a * 0.63661977236758134308);
  double r = __builtin_fma(-q, 1.5707963267948966, a);
  r = __builtin_fma(-q, 6.123233995736766e-17, r);
  const double r2 = r * r;
  double s = r2 * (1.0 / 6227020800.0) - 1.0 / 39916800.0;
  s = s * r2 + 1.0 / 362880.0; s = s * r2 - 1.0 / 5040.0; s = s * r2 + 1.0 / 120.0; s = s * r2 - 1.0 / 6.0; s = r + r * r2 * s;
  double c = -r2 * (1.0 / 87178291200.0) + 1.0 / 479001600.0;
  c = c * r2 - 1.0 / 3628800.0; c = c * r2 + 1.0 / 40320.0; c = c * r2 - 1.0 / 720.0; c = c * r2 + 1.0 / 24.0; c = c * r2 - 0.5; c = 1.0 + r2 * c;
  const int n = ((int)q) & 3;
  const double ss = (n & 1) ? c : s, cc = (n & 1) ? s : c;
  sn = (float)((n & 2) ? -ss : ss);
  cs = (float)(((n + 1) & 2) ? -cc : cc);
}

__constant__ float INVF[32] = {1.000000000e+00f, 7.498942018e-01f, 5.623413324e-01f, 4.216965139e-01f, 3.162277639e-01f, 2.371373922e-01f, 1.778279394e-01f, 1.333521456e-01f,
  1.000000015e-01f, 7.498941571e-02f, 5.623412877e-02f, 4.216964915e-02f, 3.162277862e-02f, 2.371373586e-02f, 1.778279431e-02f, 1.333521493e-02f,
  9.999999776e-03f, 7.498942316e-03f, 5.623413250e-03f, 4.216964822e-03f, 3.162277862e-03f, 2.371373819e-03f, 1.778279431e-03f, 1.333521446e-03f,
  1.000000047e-03f, 7.498941850e-04f, 5.623413017e-04f, 4.216965463e-04f, 3.162277862e-04f, 2.371373848e-04f, 1.778279402e-04f, 1.333521504e-04f};
__device__ void phase0(const Args& a, char* lds) {
  unsigned char* ws = a.ws;
  const int tid = threadIdx.x, lane = tid & 63, wv = tid >> 6;
  const int NWV = gridDim.x * 8, gw = blockIdx.x * 8 + wv;
  const int gthreads = gridDim.x * 512, gtid = blockIdx.x * 512 + tid;
  float* modp = (float*)(ws + WS_MODP);
  for (int job = gw; job < 768; job += NWV) {
    const int cg = job % 96, ks = job / 96, col = cg * 64 + lane;
    float a0 = 0.f, a1 = 0.f, a2 = 0.f, a3 = 0.f;
    const float* w = a.w_ada + (size_t)(ks * 128) * 6144 + col;
    float sv[2][4];
#pragma unroll
    for (int h = 0; h < 2; ++h)
#pragma unroll
      for (int bb = 0; bb < 4; ++bb) { const float cv = a.c[bb * 1024 + ks * 128 + 64 * h + lane]; sv[h][bb] = cv / (1.f + __expf(-cv)); }
#pragma unroll
    for (int h = 0; h < 2; ++h) {
#pragma unroll 8
      for (int k = 0; k < 64; ++k) {
        const float wv_ = w[(size_t)(64 * h + k) * 6144];
        a0 += __uint_as_float(__builtin_amdgcn_readlane(__float_as_uint(sv[h][0]), k)) * wv_;
        a1 += __uint_as_float(__builtin_amdgcn_readlane(__float_as_uint(sv[h][1]), k)) * wv_;
        a2 += __uint_as_float(__builtin_amdgcn_readlane(__float_as_uint(sv[h][2]), k)) * wv_;
        a3 += __uint_as_float(__builtin_amdgcn_readlane(__float_as_uint(sv[h][3]), k)) * wv_;
      }
    }
    modp[(ks * 4 + 0) * 6144 + col] = a0; modp[(ks * 4 + 1) * 6144 + col] = a1;
    modp[(ks * 4 + 2) * 6144 + col] = a2; modp[(ks * 4 + 3) * 6144 + col] = a3;
  }
  { float* tile = (float*)(lds + LDS_DATA);
    cvt_transpose_tiled<1>(a.w_in, 1472, 1024, 1536, (u16*)(ws + WS_WIN), tile);
    cvt_transpose_tiled<0>(a.w_o, 1024, 1024, 1024, (u16*)(ws + WS_WO), tile);
    cvt_transpose_tiled<2>(a.w_uq, 768, 256, 256, (u16*)(ws + WS_WQ2) + 512 * 256, tile);
    cvt_transpose_tiled<3>(a.w_ukv, 1024, 128, 512, (u16*)(ws + WS_WUV), tile); }
  {
    u16* wq2 = (u16*)(ws + WS_WQ2);
    for (int idx = gtid; idx < 512 * 256; idx += gthreads) {
      const int n = idx >> 8, i = idx & 255, h = n >> 7, cc = n & 127;
      const float* pu = a.w_uq + (size_t)i * 768 + h * 192;
      const float* pk = a.w_ukv + (size_t)cc * 1024 + h * 256;
      float s = 0.f;
#pragma unroll 8
      for (int d = 0; d < 128; d += 4) {
        const float4 u = *(const float4*)(pu + d), k = *(const float4*)(pk + d);
        s += u.x * k.x + u.y * k.y + u.z * k.z + u.w * k.w;
      }
      wq2[(size_t)n * 256 + i] = f2bf(s);
    }
  }
  cvt_direct(a.peer_keys, (u16*)(ws + WS_KEYS), 262144 / 8, gtid, gthreads);
  cvt_direct(a.w_peer_q, (u16*)(ws + WS_WPQ), (size_t)1024 * 2048 / 8, gtid, gthreads);
  cvt_direct(a.w_sg, (u16*)(ws + WS_WSG), 65536 / 8, gtid, gthreads);
  cvt_fp8(a.peer_u, (unsigned char*)(ws + WS_UB), (size_t)16384 * 1024 / 16, PEER_SU, gtid, gthreads);
  cvt_fp8(a.peer_v, (unsigned char*)(ws + WS_VB), (size_t)16384 * 1024 / 16, PEER_SV, gtid, gthreads);
  {
    float* cs = (float*)(ws + WS_CS);
    for (int idx = gtid; idx < T * 32; idx += gthreads) {
      const int t = idx >> 5, i = idx & 31;
      const float inv = INVF[i];
      const float ang = (float)a.pos[t] * inv;
      float sn, c_; sincos_acc(ang, sn, c_);
      cs[(size_t)t * 64 + i] = c_; cs[(size_t)t * 64 + 32 + i] = sn;
    }
  }
}

__device__ void phase1(const Args& a, char* lds) {
  unsigned char* ws = a.ws;
  const int tid = threadIdx.x, lane = tid & 63, wv = tid >> 6;
  const float* modp = (const float*)(ws + WS_MODP);
  float* mod = (float*)(ws + WS_MOD);
  for (int idx = blockIdx.x * 512 + tid; idx < 4 * 6144; idx += gridDim.x * 512) {
    const int b = idx / 6144, m = idx % 6144;
    float s = a.b_ada[m];
#pragma unroll
    for (int ks = 0; ks < 8; ++ks) s += modp[(ks * 4 + b) * 6144 + m];
    mod[idx] = s;
  }
  float* sh = (float*)(lds + LDS_DATA);
  u16* H = (u16*)(ws + WS_H);
  for (int u = blockIdx.x; u < T / 64; u += gridDim.x) {
    const int b = u >> 6;
    __syncthreads();
    for (int j = tid; j < 2048; j += 512) {
      float s = a.b_ada[j];
#pragma unroll
      for (int ks = 0; ks < 8; ++ks) s += modp[(ks * 4 + b) * 6144 + j];
      sh[j] = s;
    }
    __syncthreads();
    for (int i = 0; i < 8; ++i) {
      const int r = u * 64 + wv * 8 + i;
      float4 xv[4]; float ssq = 0.f;
#pragma unroll
      for (int j = 0; j < 4; ++j) { xv[j] = *(const float4*)(a.x + (size_t)r * 1024 + j * 256 + lane * 4); ssq += xv[j].x * xv[j].x + xv[j].y * xv[j].y + xv[j].z * xv[j].z + xv[j].w * xv[j].w; }
      ssq = wave_sum(ssq);
      const float rstd = rsqrtf(ssq * (1.f / 1024.f) + EPS);
#pragma unroll
      for (int j = 0; j < 4; ++j) {
        const int col = j * 256 + lane * 4;
        const float4 g = *(const float4*)(a.g_norm1 + col);
        const float h0 = xv[j].x * rstd * g.x * (1.f + sh[1024 + col]) + sh[col];
        const float h1 = xv[j].y * rstd * g.y * (1.f + sh[1024 + col + 1]) + sh[col + 1];
        const float h2 = xv[j].z * rstd * g.z * (1.f + sh[1024 + col + 2]) + sh[col + 2];
        const float h3 = xv[j].w * rstd * g.w * (1.f + sh[1024 + col + 3]) + sh[col + 3];
        uint2 o = {pack2(h0, h1), pack2(h2, h3)};
        *(uint2*)(H + (size_t)r * 1024 + col) = o;
      }
    }
  }
}

constexpr int G_STAGE = 49152;
__device__ __forceinline__ void dma16(const void* gsrc, unsigned lds_dst) {
  unsigned keep;
  asm volatile("s_mov_b32 %0, m0\n\ts_mov_b32 m0, %2\n\ts_nop 0\n\tglobal_load_lds_dwordx4 %1, off\n\ts_mov_b32 m0, %0"
               : "=&s"(keep) : "v"(gsrc), "s"(lds_dst) : "memory");
}
__device__ __forceinline__ void gemm_128x256(const u16* __restrict__ A, int lda, const u16* __restrict__ Bt, int ldb, int KT,
                                             f32x16 (&acc)[2][2], char* lds) {
  const int tid = threadIdx.x, lane = tid & 63, wv = __builtin_amdgcn_readfirstlane(tid >> 6), r32 = lane & 31, hi = lane >> 5;
  const int wm = wv >> 2, wn = wv & 3;
  const int rin = lane >> 3, cc = lane & 7;
  const u16* pa[2]; const u16* pb[4];
#pragma unroll
  for (int j = 0; j < 2; ++j) pa[j] = A + (size_t)(16 * wv + 8 * j + rin) * lda + 8 * (cc ^ (4 * j + (rin >> 1)));
#pragma unroll
  for (int i = 0; i < 4; ++i) pb[i] = Bt + (size_t)(32 * wv + 8 * i + rin) * ldb + 8 * (cc ^ (4 * (i & 1) + (rin >> 1)));
  const unsigned lb = __builtin_amdgcn_readfirstlane((unsigned)(uintptr_t)lds);
  const unsigned dA = lb + 2048 * wv, dB = lb + 16384 + 4096 * wv;
#define G_ISSUE(stage, kt_) do { const unsigned _so = (unsigned)(stage) * G_STAGE; const int _ko = (kt_) * 64;                     \
    dma16(pa[0] + _ko, dA + _so); dma16(pa[1] + _ko, dA + _so + 1024);                                                           \
    dma16(pb[0] + _ko, dB + _so); dma16(pb[1] + _ko, dB + _so + 1024); dma16(pb[2] + _ko, dB + _so + 2048); dma16(pb[3] + _ko, dB + _so + 3072); } while (0)
#pragma unroll
  for (int m = 0; m < 2; ++m)
#pragma unroll
    for (int n = 0; n < 2; ++n)
#pragma unroll
      for (int r = 0; r < 16; ++r) acc[m][n][r] = 0.f;
  __syncthreads();
  G_ISSUE(0, 0);
  if (KT > 1) G_ISSUE(1, 1);
  const int xa = (r32 >> 1) & 7;
  const int aoff = (64 * wm + r32) * 128, boff = 16384 + (64 * wn + r32) * 128;
  int st = 0;
  for (int kt = 0; kt < KT; ++kt) {
    if (kt + 1 < KT) asm volatile("s_waitcnt vmcnt(6)\n\ts_barrier" ::: "memory");
    else             asm volatile("s_waitcnt vmcnt(0)\n\ts_barrier" ::: "memory");
    const int s2 = st == 0 ? 2 : st - 1;
    if (kt + 2 < KT && wv < 4) G_ISSUE(s2, kt + 2);
    const char* buf = lds + st * G_STAGE;
    __builtin_amdgcn_s_setprio(1);
    bf16x8 fa[2][2], fb[2][2];
#define G_LDF(S, SET) do { const int _cb = ((2 * (S) + hi) ^ xa) << 4;                                                      \
      fa[SET][0] = *(const bf16x8*)(buf + aoff + _cb); fa[SET][1] = *(const bf16x8*)(buf + aoff + 4096 + _cb);              \
      fb[SET][0] = *(const bf16x8*)(buf + boff + _cb); fb[SET][1] = *(const bf16x8*)(buf + boff + 4096 + _cb); } while (0)
#define G_MM(SET) do { acc[0][0] = MFMA32(fa[SET][0], fb[SET][0], acc[0][0]); acc[0][1] = MFMA32(fa[SET][0], fb[SET][1], acc[0][1]);   \
      acc[1][0] = MFMA32(fa[SET][1], fb[SET][0], acc[1][0]); acc[1][1] = MFMA32(fa[SET][1], fb[SET][1], acc[1][1]); } while (0)
    G_LDF(0, 0); __builtin_amdgcn_sched_barrier(0);
    G_LDF(1, 1); __builtin_amdgcn_sched_barrier(0); G_MM(0); __builtin_amdgcn_sched_barrier(0);
    G_LDF(2, 0); __builtin_amdgcn_sched_barrier(0); G_MM(1); __builtin_amdgcn_sched_barrier(0);
    G_LDF(3, 1); __builtin_amdgcn_sched_barrier(0); G_MM(0); __builtin_amdgcn_sched_barrier(0);
    G_MM(1);
#undef G_LDF
#undef G_MM
    __builtin_amdgcn_s_setprio(0);
    if (kt + 2 < KT && wv >= 4) G_ISSUE(s2, kt + 2);
    st = st == 2 ? 0 : st + 1;
  }
#undef G_ISSUE
  __syncthreads();
}
constexpr int CLD = 257;
__device__ __forceinline__ void acc_to_lds(const f32x16 (&acc)[2][2], float* Cl) {
  const int lane = threadIdx.x & 63, wv = threadIdx.x >> 6, r32 = lane & 31, hi = lane >> 5, wm = wv >> 2, wn = wv & 3;
#pragma unroll
  for (int m = 0; m < 2; ++m)
#pragma unroll
    for (int n = 0; n < 2; ++n)
#pragma unroll
      for (int r = 0; r < 16; ++r) Cl[(64 * wm + 32 * m + crow(r, hi)) * CLD + 64 * wn + 32 * n + r32] = acc[m][n][r];
}

__device__ __forceinline__ void gemm_128x256_wide(const u16* __restrict__ A, int lda, const u16* __restrict__ Bt, int ldb, int KT, f32x16 (&acc)[4], char* lds) {
  const int tid = threadIdx.x, lane = tid & 63, wv = __builtin_amdgcn_readfirstlane(tid >> 6), r32 = lane & 31, hi = lane >> 5;
  const int rin = lane >> 3, cc = lane & 7;
  const u16* pa[2]; const u16* pb[4];
#pragma unroll
  for (int j = 0; j < 2; ++j) pa[j] = A + (size_t)(16 * wv + 8 * j + rin) * lda + 8 * (cc ^ (4 * j + (rin >> 1)));
#pragma unroll
  for (int i = 0; i < 4; ++i) pb[i] = Bt + (size_t)(32 * wv + 8 * i + rin) * ldb + 8 * (cc ^ (4 * (i & 1) + (rin >> 1)));
  const unsigned lb = __builtin_amdgcn_readfirstlane((unsigned)(uintptr_t)lds);
  const unsigned dA = lb + 2048 * wv, dB = lb + 16384 + 4096 * wv;
#define G_ISSUE(stage, kt_) do { const unsigned _so = (unsigned)(stage) * G_STAGE; const int _ko = (kt_) * 64;                     \
    dma16(pa[0] + _ko, dA + _so); dma16(pa[1] + _ko, dA + _so + 1024);                                                           \
    dma16(pb[0] + _ko, dB + _so); dma16(pb[1] + _ko, dB + _so + 1024); dma16(pb[2] + _ko, dB + _so + 2048); dma16(pb[3] + _ko, dB + _so + 3072); } while (0)
#pragma unroll
  for (int m = 0; m < 4; ++m)
#pragma unroll
    for (int r = 0; r < 16; ++r) acc[m][r] = 0.f;
  __syncthreads();
  G_ISSUE(0, 0);
  if (KT > 1) G_ISSUE(1, 1);
  const int xa = (r32 >> 1) & 7;
  const int aoff = r32 * 128, boff = 16384 + (32 * wv + r32) * 128;
  int st = 0;
  for (int kt = 0; kt < KT; ++kt) {
    if (kt + 1 < KT) asm volatile("s_waitcnt vmcnt(6)\n\ts_barrier" ::: "memory");
    else             asm volatile("s_waitcnt vmcnt(0)\n\ts_barrier" ::: "memory");
    const int s2 = st == 0 ? 2 : st - 1;
    if (kt + 2 < KT && wv < 4) G_ISSUE(s2, kt + 2);
    const char* buf = lds + st * G_STAGE;
    __builtin_amdgcn_s_setprio(1);
    bf16x8 fa[2][4], fb[2];
#define G_LDF(S, SET) do { const int _cb = ((2 * (S) + hi) ^ xa) << 4;                                                      \
      fa[SET][0] = *(const bf16x8*)(buf + aoff + _cb); fa[SET][1] = *(const bf16x8*)(buf + aoff + 4096 + _cb);              \
      fa[SET][2] = *(const bf16x8*)(buf + aoff + 8192 + _cb); fa[SET][3] = *(const bf16x8*)(buf + aoff + 12288 + _cb);      \
      fb[SET] = *(const bf16x8*)(buf + boff + _cb); } while (0)
#define G_MM(SET) do { acc[0] = MFMA32(fa[SET][0], fb[SET], acc[0]); acc[1] = MFMA32(fa[SET][1], fb[SET], acc[1]);         \
      acc[2] = MFMA32(fa[SET][2], fb[SET], acc[2]); acc[3] = MFMA32(fa[SET][3], fb[SET], acc[3]); } while (0)
    G_LDF(0, 0); __builtin_amdgcn_sched_barrier(0);
    G_LDF(1, 1); __builtin_amdgcn_sched_barrier(0); G_MM(0); __builtin_amdgcn_sched_barrier(0);
    G_LDF(2, 0); __builtin_amdgcn_sched_barrier(0); G_MM(1); __builtin_amdgcn_sched_barrier(0);
    G_LDF(3, 1); __builtin_amdgcn_sched_barrier(0); G_MM(0); __builtin_amdgcn_sched_barrier(0);
    G_MM(1);
#undef G_LDF
#undef G_MM
    __builtin_amdgcn_s_setprio(0);
    if (kt + 2 < KT && wv >= 4) G_ISSUE(s2, kt + 2);
    st = st == 2 ? 0 : st + 1;
  }
#undef G_ISSUE
  __syncthreads();
}

__device__ __forceinline__ void xcd_unit(int u, int per, int& panel, int& sub) {
  if (gridDim.x == 256) { const int x = u & 7, k = ((u & 255) >> 3) + 32 * (u >> 8); panel = x + 8 * (k / per); sub = k % per; }
  else { panel = u / per; sub = u % per; }
}
__device__ void phase1b(const Args& a, char* lds) {
  unsigned char* ws = a.ws;
  const int tid = threadIdx.x, lane = tid & 63, wv = tid >> 6;
  const u16* KEYS = (const u16*)(ws + WS_KEYS); const u16* WPQB = (const u16*)(ws + WS_WPQ); u16* WST = (u16*)(ws + WS_WST);
  const float* modp = (const float*)(ws + WS_MODP); float* BIASP = (float*)(ws + WS_BIASP);
  char* gl = lds + LDS_DATA; float* Cl = (float*)gl;
  float* gsl = (float*)(gl + 131584);
  for (int u = blockIdx.x; u < 256; u += gridDim.x) {
    const int hh = u >> 4, nt = (u >> 2) & 3, b = u & 3;
    f32x16 acc[2][2];
    gemm_128x256(KEYS + (size_t)hh * 16384, 128, WPQB + (size_t)(nt * 256) * 2048 + hh * 128, 2048, 2, acc, gl);
    acc_to_lds(acc, Cl);
    for (int j = tid; j < 512; j += 512) {
      const int which = j >> 8, k = nt * 256 + (j & 255), m = (which ? 3072 : 4096) + k;
      float v = a.b_ada[m];
#pragma unroll
      for (int ks = 0; ks < 8; ++ks) v += modp[(ks * 4 + b) * 6144 + m];
      gsl[j] = which ? v : a.g_norm2[k] * (1.f + v);
    }
    __syncthreads();
    for (int i = 0; i < 16; ++i) {
      const int row = wv * 16 + i; const size_t n = (size_t)hh * 128 + row;
      float bp = 0.f, w[4];
#pragma unroll
      for (int j = 0; j < 4; ++j) { const float v = Cl[row * CLD + 4 * lane + j]; w[j] = v * gsl[4 * lane + j]; bp += v * gsl[256 + 4 * lane + j]; }
      *(uint2*)(WST + ((size_t)b * 2048 + n) * 1024 + nt * 256 + 4 * lane) = make_uint2(pack2(w[0], w[1]), pack2(w[2], w[3]));
      bp = wave_sum(bp);
      if (lane == 0) BIASP[((size_t)nt * 4 + b) * 2048 + n] = bp;
    }
    __syncthreads();
  }
}

__device__ void phase2(const Args& a, char* lds) {
  unsigned char* ws = a.ws;
  const int tid = threadIdx.x, lane = tid & 63, wv = tid >> 6;
  const u16* H = (const u16*)(ws + WS_H); const u16* WIN = (const u16*)(ws + WS_WIN);
  u16* QA = (u16*)(ws + WS_QA); u16* KV = (u16*)(ws + WS_KV); u16* UACT = (u16*)(ws + WS_UACT); u16* GVT = (u16*)(ws + WS_GVT);
  float* SSQV = (float*)(ws + WS_SSQV); const float* CS = (const float*)(ws + WS_CS);
  char* gl = lds + LDS_DATA; float* Cl = (float*)gl;
  for (int u = blockIdx.x; u < 128 * 6; u += gridDim.x) {
    int mt, nt; xcd_unit(u, 6, mt, nt); const int R0 = mt * 128;
    f32x16 acc[2][2];
    gemm_128x256(H + (size_t)R0 * 1024, 1024, WIN + (size_t)(nt * 256) * 1024, 1024, 16, acc, gl);
    acc_to_lds(acc, Cl);
    __syncthreads();
    if (nt == 0) {
      for (int i = 0; i < 16; ++i) {
        const int row = wv * 16 + i; float v[4], ssq = 0.f;
#pragma unroll
        for (int j = 0; j < 4; ++j) { v[j] = Cl[row * CLD + lane + 64 * j]; ssq += v[j] * v[j]; }
        ssq = wave_sum(ssq);
        const float rstd = rsqrtf(ssq * (1.f / 256.f) + EPS);
#pragma unroll
        for (int j = 0; j < 4; ++j) { const int col = lane + 64 * j; QA[(size_t)(R0 + row) * 256 + col] = f2bf(v[j] * rstd * a.g_q_a[col]); }
      }
    } else if (nt == 1) {
#pragma unroll 4
      for (int i = 0; i < 16; ++i) {
        const int row = wv * 16 + i, tok = R0 + row;
        const float v0 = Cl[row * CLD + lane], v1 = Cl[row * CLD + 64 + lane];
        const float ssq = wave_sum(v0 * v0 + v1 * v1);
        const float rstd = rsqrtf(ssq * (1.f / 128.f) + EPS);
        KV[(size_t)tok * 192 + lane] = f2bf(v0 * rstd * a.g_kv_a[lane]);
        KV[(size_t)tok * 192 + 64 + lane] = f2bf(v1 * rstd * a.g_kv_a[64 + lane]);
        if (lane < 32) {
          const float x1 = Cl[row * CLD + 128 + lane], x2 = Cl[row * CLD + 160 + lane];
          const float cs = CS[(size_t)tok * 64 + lane], sn = CS[(size_t)tok * 64 + 32 + lane];
          KV[(size_t)tok * 192 + 128 + lane] = f2bf(x1 * cs - x2 * sn);
          KV[(size_t)tok * 192 + 160 + lane] = f2bf(x2 * cs + x1 * sn);
        }
      }
    } else if (nt < 4) {
      for (int i = 0; i < 16; ++i) {
        const int row = wv * 16 + i;
#pragma unroll
        for (int j = 0; j < 4; ++j) { const int col = lane + 64 * j; UACT[(size_t)(R0 + row) * 512 + (nt - 2) * 256 + col] = f2bf(gelu_exact(Cl[row * CLD + col])); }
      }
    } else {
      for (int i = 0; i < 16; ++i) {
        const int row = wv * 16 + i; float ssq = 0.f;
#pragma unroll
        for (int j = 0; j < 4; ++j) { const int col = lane + 64 * j; const float g = gelu_exact(Cl[row * CLD + col]); const float gb = bflo((unsigned)f2bf(g)); ssq += gb * gb; Cl[row * CLD + col] = gb; }
        ssq = wave_sum(ssq);
        if (lane == 0) SSQV[(size_t)(R0 + row) * 2 + (nt - 4)] = ssq;
      }
      __syncthreads();
      for (int i = 0; i < 32; ++i) {
        const int c = wv * 32 + i;
        const float g0 = Cl[(2 * lane) * CLD + c], g1 = Cl[(2 * lane + 1) * CLD + c];
        *(unsigned*)(GVT + ((size_t)mt * 512 + (nt - 4) * 256 + c) * 128 + 2 * lane) = pack2(g0, g1);
      }
    }
    __syncthreads();
  }
}

__device__ void phase3(const Args& a, char* lds) {
  unsigned char* ws = a.ws;
  const int tid = threadIdx.x, lane = tid & 63, wv = tid >> 6, r32 = lane & 31, hi = lane >> 5;
  const u16* QA = (const u16*)(ws + WS_QA); const u16* WQ2 = (const u16*)(ws + WS_WQ2);
  u16* Q = (u16*)(ws + WS_Q); const float* CS = (const float*)(ws + WS_CS);
  const u16* UACT = (const u16*)(ws + WS_UACT); const u16* GVT = (const u16*)(ws + WS_GVT); const u16* WSG = (const u16*)(ws + WS_WSG);
  const float* SSQV = (const float*)(ws + WS_SSQV); u16* Y = (u16*)(ws + WS_Y);
  char* gl = lds + LDS_DATA; float* Cl = (float*)gl;
  for (int u = blockIdx.x; u < 384; u += gridDim.x) {
    {
      int mt, nt; xcd_unit(u, 3, mt, nt); const int R0 = mt * 128;
      f32x16 acc[2][2];
      gemm_128x256(QA + (size_t)R0 * 256, 256, WQ2 + (size_t)(nt * 256) * 256, 256, 4, acc, gl);
      acc_to_lds(acc, Cl);
      __syncthreads();
      if (nt < 2) {
        for (int i = 0; i < 16; ++i) {
          const int row = wv * 16 + i;
#pragma unroll
          for (int j = 0; j < 4; ++j) { const int n = nt * 256 + lane + 64 * j; Q[(size_t)(R0 + row) * 768 + (n >> 7) * 192 + (n & 127)] = f2bf(Cl[row * CLD + lane + 64 * j]); }
        }
      } else {
#pragma unroll 4
        for (int i = 0; i < 16; ++i) {
          const int row = wv * 16 + i, tok = R0 + row;
#pragma unroll
          for (int j = 0; j < 2; ++j) {
            const int idx = lane + 64 * j, h = idx >> 5, jj = idx & 31;
            const float x1 = Cl[row * CLD + h * 64 + jj], x2 = Cl[row * CLD + h * 64 + 32 + jj];
            const float cs = CS[(size_t)tok * 64 + jj], sn = CS[(size_t)tok * 64 + 32 + jj];
            Q[(size_t)tok * 768 + h * 192 + 128 + jj] = f2bf(x1 * cs - x2 * sn);
            Q[(size_t)tok * 768 + h * 192 + 160 + jj] = f2bf(x2 * cs + x1 * sn);
          }
        }
      }
      __syncthreads();
    }
  }
  for (int su = blockIdx.x; su < 256; su += gridDim.x) {
    {
      const int c = su >> 1, ph = su & 1;
      float* rs = (float*)gl;
      float* Yl = (float*)(gl + 512);
      __syncthreads();
      if (tid < 128) { const size_t t = (size_t)c * 128 + tid; rs[tid] = rsqrtf((SSQV[t * 2] + SSQV[t * 2 + 1]) * (1.f / 512.f) + EPS); }
      __syncthreads();
      const int h = wv >> 1, dh = wv & 1;
      f32x16 acc[2][2];
#pragma unroll
      for (int m = 0; m < 2; ++m)
#pragma unroll
        for (int n = 0; n < 2; ++n)
#pragma unroll
          for (int r = 0; r < 16; ++r) acc[m][n][r] = 0.f;
      for (int s = 0; s < 8; ++s) {
        const int q0 = 16 * s + 8 * hi;
        bf16x8 af[2], bfr[2];
#pragma unroll
        for (int m = 0; m < 2; ++m) af[m] = *(const bf16x8*)(WSG + ((size_t)h * 128 + ph * 64 + 32 * m + r32) * 128 + q0);
        float rq[8];
#pragma unroll
        for (int j = 0; j < 8; ++j) rq[j] = rs[q0 + j];
#pragma unroll
        for (int n = 0; n < 2; ++n) {
          const u32x4 w = *(const u32x4*)(GVT + ((size_t)c * 512 + h * 128 + dh * 64 + 32 * n + r32) * 128 + q0);
          u32x4 o;
#pragma unroll
          for (int k = 0; k < 4; ++k) o[k] = pack2(bflo(w[k]) * rq[2 * k], bfhi(w[k]) * rq[2 * k + 1]);
          bfr[n] = __builtin_bit_cast(bf16x8, o);
        }
#pragma unroll
        for (int m = 0; m < 2; ++m)
#pragma unroll
          for (int n = 0; n < 2; ++n) acc[m][n] = MFMA32(af[m], bfr[n], acc[m][n]);
      }
#pragma unroll
      for (int m = 0; m < 2; ++m)
#pragma unroll
        for (int n = 0; n < 2; ++n)
#pragma unroll
          for (int r = 0; r < 16; ++r) {
            const int pl = 32 * m + crow(r, hi), col = h * 128 + dh * 64 + 32 * n + r32;
            const size_t tok = (size_t)c * 128 + ph * 64 + pl;
            const float mix = acc[m][n][r] * a.g_sg[col] + a.b_sg[h * 128 + ph * 64 + pl];
            Yl[pl * 513 + col] = bflo((unsigned)UACT[tok * 512 + col]) * mix;
          }
      __syncthreads();
      for (int i = 0; i < 8; ++i) {
        const int pl = wv * 8 + i; const size_t tok = (size_t)c * 128 + ph * 64 + pl;
        float v[8], ssq = 0.f;
#pragma unroll
        for (int j = 0; j < 8; ++j) { v[j] = Yl[pl * 513 + lane + 64 * j]; ssq += v[j] * v[j]; }
        ssq = wave_sum(ssq);
        const float rstd = rsqrtf(ssq * (1.f / 512.f) + EPS);
#pragma unroll
        for (int j = 0; j < 8; ++j) { const int col = lane + 64 * j; Y[tok * 1024 + 512 + col] = f2bf(v[j] * rstd * a.g_sg_out[col]); }
      }
      __syncthreads();
    }
  }
}

constexpr float ATT_SCALE = 0.07216878364870322f;
constexpr float ATT_THR = 8.f;
constexpr int KVBUF = 24576;
#define SBAR() __builtin_amdgcn_sched_barrier(0)
__device__ __forceinline__ unsigned cvtpk(float lo, float hi) { unsigned r; asm volatile("v_cvt_pk_bf16_f32 %0, %1, %2" : "=v"(r) : "v"(lo), "v"(hi)); return r; }
__device__ __forceinline__ unsigned off_a(unsigned row, unsigned ch) { return 2048u * (row >> 3) + 512u * (ch >> 2) + 64u * (row & 7) + 16u * ((ch & 3) ^ ((row >> 2) & 3)); }

__device__ __forceinline__ void partialSM(f32x16& p0, f32x16& p1, float& m_reg, float& mn, float& alpha) {
  constexpr float C = ATT_SCALE * 1.4426950408889634f;
  float pmax = p0[0];
#pragma unroll
  for (int r = 1; r < 16; ++r) pmax = fmaxf(pmax, p0[r]);
#pragma unroll
  for (int r = 0; r < 16; ++r) pmax = fmaxf(pmax, p1[r]);
  { auto rr = __builtin_amdgcn_permlane32_swap(__float_as_uint(pmax), __float_as_uint(pmax), false, false);
    pmax = fmaxf(__uint_as_float(rr[0]), __uint_as_float(rr[1])); }
  if (__builtin_expect(__all(pmax - m_reg <= ATT_THR / ATT_SCALE), 1)) { mn = m_reg; alpha = 1.f; }
  else { mn = fmaxf(m_reg, pmax); alpha = __builtin_amdgcn_exp2f((m_reg - mn) * C); m_reg = mn; }
  const float mnC = -mn * C;
#pragma unroll
  for (int r = 0; r < 16; ++r) p0[r] = fmaf(p0[r], C, mnC);
#pragma unroll
  for (int r = 0; r < 16; ++r) p1[r] = fmaf(p1[r], C, mnC);
#pragma unroll
  for (int r = 0; r < 16; ++r) p0[r] = __builtin_amdgcn_exp2f(p0[r]);
}
__device__ __forceinline__ void finishSM(f32x16& p0, f32x16& p1, float alpha, float& l_reg, bf16x8& pa0, bf16x8& pa1, bf16x8& pa2, bf16x8& pa3) {
#pragma unroll
  for (int r = 0; r < 16; ++r) p1[r] = __builtin_amdgcn_exp2f(p1[r]);
  float ps = 0;
#pragma unroll
  for (int r = 0; r < 16; ++r) ps += p0[r];
#pragma unroll
  for (int r = 0; r < 16; ++r) ps += p1[r];
  { auto rr = __builtin_amdgcn_permlane32_swap(__float_as_uint(ps), __float_as_uint(ps), false, false);
    ps = __uint_as_float(rr[0]) + __uint_as_float(rr[1]); }
  l_reg = l_reg * alpha + ps;
#define PK4(P, BASE, OUT) do { unsigned a0 = cvtpk(P[BASE + 0], P[BASE + 1]), a1 = cvtpk(P[BASE + 2], P[BASE + 3]);   \
    unsigned b0 = cvtpk(P[BASE + 4], P[BASE + 5]), b1 = cvtpk(P[BASE + 6], P[BASE + 7]);                              \
    auto r0 = __builtin_amdgcn_permlane32_swap(a0, b0, false, false); auto r1 = __builtin_amdgcn_permlane32_swap(a1, b1, false, false); \
    u32x4 w = {r0[0], r1[0], r0[1], r1[1]}; OUT = __builtin_bit_cast(bf16x8, w); } while (0)
  PK4(p0, 0, pa0); PK4(p0, 8, pa1); PK4(p1, 0, pa2); PK4(p1, 8, pa3);
#undef PK4
}
__device__ __forceinline__ void qkt192(f32x16& p0, f32x16& p1, const char* kb, const bf16x8* qr, int ke, int ko, int kr) {
#pragma unroll
  for (int r = 0; r < 16; ++r) { p0[r] = 0.f; p1[r] = 0.f; }
#pragma unroll
  for (int d0 = 0; d0 < 8; ++d0) {
    const int o = ((d0 & 1) ? ko : ke) + 512 * (d0 >> 1);
    const bf16x8 b0 = *(const bf16x8*)(kb + o), b1 = *(const bf16x8*)(kb + o + 8192);
    p0 = MFMA32(b0, qr[d0], p0); p1 = MFMA32(b1, qr[d0], p1);
  }
#pragma unroll
  for (int d1 = 0; d1 < 4; ++d1) {
    const int o = 16384 + (kr ^ (32 * d1));
    const bf16x8 b0 = *(const bf16x8*)(kb + o), b1 = *(const bf16x8*)(kb + o + 4096);
    p0 = MFMA32(b0, qr[8 + d1], p0); p1 = MFMA32(b1, qr[8 + d1], p1);
  }
}
template <int OFF> __device__ __forceinline__ s16x4 tr_read(int vb) {
  s16x4 r; asm volatile("ds_read_b64_tr_b16 %0, %1 offset:%2" : "=&v"(r) : "v"(vb), "i"(OFF) : "memory"); return r;
}
template <int C> __device__ __forceinline__ void pv_one(f32x16& od, int vb0, int vb1, bf16x8 pa0, bf16x8 pa1, bf16x8 pa2, bf16x8 pa3) {
  const s16x4 l0 = tr_read<512 * C>(vb0), h0 = tr_read<512 * C>(vb1), l1 = tr_read<4096 + 512 * C>(vb0), h1 = tr_read<4096 + 512 * C>(vb1);
  const s16x4 l2 = tr_read<8192 + 512 * C>(vb0), h2 = tr_read<8192 + 512 * C>(vb1), l3 = tr_read<12288 + 512 * C>(vb0), h3 = tr_read<12288 + 512 * C>(vb1);
  asm volatile("s_waitcnt lgkmcnt(0)" ::: "memory"); SBAR();
#define PKV(L, H) (bf16x8){L[0], L[1], L[2], L[3], H[0], H[1], H[2], H[3]}
  od = MFMA32(pa0, PKV(l0, h0), od); od = MFMA32(pa1, PKV(l1, h1), od);
  od = MFMA32(pa2, PKV(l2, h2), od); od = MFMA32(pa3, PKV(l3, h3), od);
#undef PKV
}
__device__ __forceinline__ void pv_all(f32x16* o, int vb0, int vb1, bf16x8 pa0, bf16x8 pa1, bf16x8 pa2, bf16x8 pa3) {
  pv_one<0>(o[0], vb0, vb1, pa0, pa1, pa2, pa3); pv_one<1>(o[1], vb0, vb1, pa0, pa1, pa2, pa3);
  pv_one<2>(o[2], vb0, vb1, pa0, pa1, pa2, pa3); pv_one<3>(o[3], vb0, vb1, pa0, pa1, pa2, pa3);
}

__device__ void phase4(const Args& a, char* lds) {
  unsigned char* ws = a.ws;
  const int tid = threadIdx.x, wid = tid >> 6, lane = tid & 63, r32 = lane & 31, hi = lane >> 5;
  const u16* Qg = (const u16*)(ws + WS_Q); const u16* KVg = (const u16*)(ws + WS_KV); const u16* WUV = (const u16*)(ws + WS_WUV);
  u16* Y = (u16*)(ws + WS_Y);
  char* gl = lds + LDS_DATA;
  char* kvl = gl;
  float* wsl = (float*)(gl + 2 * KVBUF) + wid * 64; float* li_l = wsl; float* al_l = wsl + 32;
  char* Ol = gl + 2 * KVBUF + 2048 + wid * 8704;
  float* Yl = (float*)gl;
  const int head = wid >> 1, qh = wid & 1;
  int sdst[3];
#pragma unroll
  for (int j = 0; j < 3; ++j) { const int id = tid + 512 * j, key = id / 24, ch = id % 24;
    sdst[j] = ch < 16 ? (int)off_a(key, ch) : 16384 + key * 128 + (((ch - 16) ^ ((key >> 1) & 7)) << 4); }
  const int xq = (r32 >> 2) & 3;
  const int ke = 2048 * (r32 >> 3) + 64 * (r32 & 7) + 16 * (hi ^ xq), ko = 2048 * (r32 >> 3) + 64 * (r32 & 7) + 16 * ((2 + hi) ^ xq);
  const int kr = r32 * 128 + ((hi ^ ((r32 >> 1) & 7)) << 4);
  const int tb = lane >> 4 & 1, tq = (lane & 15) >> 2, tp = lane & 3;
  const int vbl = 2048 * hi + 64 * tq + 32 * (tb ^ hi) + 8 * (tp & 1);
  const int lbase = (int)(uintptr_t)kvl;
  const int vb0 = lbase + vbl + 16 * (tp >> 1), vb1 = lbase + vbl + 256 + 16 * ((tp >> 1) ^ 1);
  for (int u = blockIdx.x; u < 256; u += gridDim.x) {
    const int b = u >> 6, qb = u & 63;
    const size_t tok0 = (size_t)b * SEQ + qb * 64 + qh * 32;
    const u16* KVb = KVg + (size_t)b * SEQ * 192;
    float m_reg = -1e30f, l_reg = 0.f; f32x16 o[4]; bf16x8 qr[12];
#pragma unroll
    for (int d = 0; d < 4; ++d)
#pragma unroll
      for (int r = 0; r < 16; ++r) o[d][r] = 0.f;
    { const u16* Qw = Qg + (tok0 + r32) * 768 + head * 192 + hi * 8;
#pragma unroll
      for (int d0 = 0; d0 < 12; ++d0) qr[d0] = *(const bf16x8*)(Qw + d0 * 16); }
    u32x4 st0[3];
#define SLOAD(S, k0) do { const u16* _p = KVb + (size_t)(k0) * 192 + tid * 8; S[0] = *(const u32x4*)_p; S[1] = *(const u32x4*)(_p + 4096); S[2] = *(const u32x4*)(_p + 8192); } while (0)
#define SWRITE(bufi, S) do { char* _d = kvl + (bufi) * KVBUF; *(u32x4*)(_d + sdst[0]) = S[0]; *(u32x4*)(_d + sdst[1]) = S[1]; *(u32x4*)(_d + sdst[2]) = S[2]; } while (0)
#define RESC(al) do { if (__any((al) < 1.f)) { if (hi == 0) al_l[r32] = (al); asm volatile("s_waitcnt lgkmcnt(0)" ::: "memory"); \
    _Pragma("unroll") for (int d = 0; d < 4; ++d) _Pragma("unroll") for (int r = 0; r < 16; ++r) o[d][r] *= al_l[crow(r, hi)]; } } while (0)
    constexpr int NT = SEQ / 64;
    __syncthreads();
    SLOAD(st0, 0); SWRITE(0, st0); SLOAD(st0, 64); __syncthreads();
    for (int j = 0; j < NT; ++j) {
      const int bo = (j & 1) * KVBUF;
      f32x16 p0, p1; float mn, al; bf16x8 pa0, pa1, pa2, pa3;
      qkt192(p0, p1, kvl + bo, qr, ke, ko, kr);
      partialSM(p0, p1, m_reg, mn, al);
      RESC(al);
      finishSM(p0, p1, al, l_reg, pa0, pa1, pa2, pa3);
      if (j + 1 < NT) { SWRITE((j + 1) & 1, st0); if (j + 2 < NT) SLOAD(st0, (j + 2) * 64); }
      SBAR();
      pv_all(o, vb0 + bo, vb1 + bo, pa0, pa1, pa2, pa3);
      __syncthreads();
    }
#undef SLOAD
#undef SWRITE
#undef RESC
    int r32e = r32, hie = hi, lne = lane;
    asm volatile("" : "+v"(r32e), "+v"(hie), "+v"(lne));
    if (hie == 0) li_l[r32e] = l_reg;
    asm volatile("s_waitcnt lgkmcnt(0)" ::: "memory");
#pragma unroll
    for (int r = 0; r < 16; ++r) {
      const int q = crow(r, hie); const float rl = __builtin_amdgcn_rcpf(li_l[q]);
#pragma unroll
      for (int d = 0; d < 4; ++d) *(u16*)(Ol + q * 272 + (32 * d + r32e) * 2) = f2bf(o[d][r] * rl);
    }
    asm volatile("s_waitcnt lgkmcnt(0)" ::: "memory");
    f32x16 y[4];
#pragma unroll
    for (int n = 0; n < 4; ++n)
#pragma unroll
      for (int r = 0; r < 16; ++r) y[n][r] = 0.f;
    const u16* wuv = WUV + ((size_t)head * 128 + r32e) * 128 + 8 * hie;
#pragma unroll 2
    for (int s = 0; s < 8; ++s) {
      const bf16x8 af = *(const bf16x8*)(Ol + r32e * 272 + (16 * s + 8 * hie) * 2);
#pragma unroll
      for (int n = 0; n < 4; ++n) {
        const bf16x8 bw = *(const bf16x8*)(wuv + 32 * n * 128 + 16 * s);
        y[n] = MFMA32(af, bw, y[n]);
      }
    }
    __syncthreads();
#pragma unroll
    for (int n = 0; n < 4; ++n)
#pragma unroll
      for (int r = 0; r < 16; ++r) Yl[(qh * 32 + crow(r, hie)) * 513 + head * 128 + 32 * n + r32e] = y[n][r];
    __syncthreads();
    for (int i = 0; i < 8; ++i) {
      const int pl = wid * 8 + i; const size_t tok = (size_t)b * SEQ + qb * 64 + pl;
      float v[8], ssq = 0.f;
#pragma unroll
      for (int jj = 0; jj < 8; ++jj) { v[jj] = Yl[pl * 513 + lne + 64 * jj]; ssq += v[jj] * v[jj]; }
      ssq = wave_sum(ssq);
      const float rstd = rsqrtf(ssq * (1.f / 512.f) + EPS);
#pragma unroll
      for (int jj = 0; jj < 8; ++jj) { const int col = lne + 64 * jj; Y[tok * 1024 + col] = f2bf(v[jj] * rstd * a.g_attn_out[col]); }
    }
    __syncthreads();
  }
}

__device__ void phase5(const Args& a, char* lds) {
  unsigned char* ws = a.ws;
  const int tid = threadIdx.x, lane = tid & 63, wv = tid >> 6;
  const u16* Y = (const u16*)(ws + WS_Y); const u16* WO = (const u16*)(ws + WS_WO);
  float* X1 = (float*)(ws + WS_X1); float* SSQ = (float*)(ws + WS_SSQ); const float* mod = (const float*)(ws + WS_MOD);
  u16* X1B = (u16*)(ws + WS_H);
  char* gl = lds + LDS_DATA; float* Cl = (float*)gl;
  for (int u = blockIdx.x; u < 128 * 4; u += gridDim.x) {
    int mt, nt; xcd_unit(u, 4, mt, nt); const int R0 = mt * 128, b = R0 >> 12;
    f32x16 acc[2][2];
    gemm_128x256(Y + (size_t)R0 * 1024, 1024, WO + (size_t)(nt * 256) * 1024, 1024, 16, acc, gl);
    acc_to_lds(acc, Cl);
    __syncthreads();
    float2 g1[2];
#pragma unroll
    for (int j = 0; j < 2; ++j) g1[j] = *(const float2*)(mod + b * 6144 + 2048 + nt * 256 + 2 * lane + 128 * j);
    for (int i0 = 0; i0 < 16; i0 += 8) {
      float2 xv[8][2];
#pragma unroll
      for (int i = 0; i < 8; ++i)
#pragma unroll
        for (int j = 0; j < 2; ++j) xv[i][j] = *(const float2*)(a.x + (size_t)(R0 + wv * 16 + i0 + i) * 1024 + nt * 256 + 2 * lane + 128 * j);
#pragma unroll
      for (int i = 0; i < 8; ++i) {
        const int row = wv * 16 + i0 + i; const size_t tok = R0 + row; float ssq = 0.f;
#pragma unroll
        for (int j = 0; j < 2; ++j) {
          const int col = nt * 256 + 2 * lane + 128 * j;
          const float v0 = xv[i][j].x + g1[j].x * Cl[row * CLD + 2 * lane + 128 * j], v1 = xv[i][j].y + g1[j].y * Cl[row * CLD + 2 * lane + 128 * j + 1];
          *(float2*)(X1 + tok * 1024 + col) = make_float2(v0, v1); *(unsigned*)(X1B + tok * 1024 + col) = pack2(v0, v1); ssq += v0 * v0 + v1 * v1;
        }
        ssq = wave_sum(ssq);
        if (lane == 0) SSQ[tok * 4 + nt] = ssq;
      }
    }
    __syncthreads();
  }
}
__device__ void phase5b(const Args& a) {
  unsigned char* ws = a.ws;
  const int tid = threadIdx.x, lane = tid & 63, wv = tid >> 6;
  const float* X1 = (const float*)(ws + WS_X1); const float* SSQ = (const float*)(ws + WS_SSQ); const float* mod = (const float*)(ws + WS_MOD);
  u16* H = (u16*)(ws + WS_H);
  for (int u = blockIdx.x; u < T / 64; u += gridDim.x) {
    const int b = u >> 6;
    float4 sh[4], sc[4], g[4];
#pragma unroll
    for (int j = 0; j < 4; ++j) {
      const int col = j * 256 + lane * 4;
      sh[j] = *(const float4*)(mod + b * 6144 + 3072 + col); sc[j] = *(const float4*)(mod + b * 6144 + 4096 + col); g[j] = *(const float4*)(a.g_norm2 + col);
    }
    for (int i = 0; i < 8; ++i) {
      const size_t r = (size_t)u * 64 + wv * 8 + i;
      const float4 sq = *(const float4*)(SSQ + r * 4);
      const float rstd = rsqrtf((sq.x + sq.y + sq.z + sq.w) * (1.f / 1024.f) + EPS);
#pragma unroll
      for (int j = 0; j < 4; ++j) {
        const int col = j * 256 + lane * 4;
        const float4 xv = *(const float4*)(X1 + r * 1024 + col);
        const float h0 = xv.x * rstd * g[j].x * (1.f + sc[j].x) + sh[j].x, h1 = xv.y * rstd * g[j].y * (1.f + sc[j].y) + sh[j].y;
        const float h2 = xv.z * rstd * g[j].z * (1.f + sc[j].z) + sh[j].z, h3 = xv.w * rstd * g[j].w * (1.f + sc[j].w) + sh[j].w;
        uint2 o = {pack2(h0, h1), pack2(h2, h3)};
        *(uint2*)(H + r * 1024 + col) = o;
      }
    }
  }
}

__device__ __forceinline__ float vmaxf(float a, float b) { float r; asm("v_max_f32 %0, %1, %2" : "=v"(r) : "v"(a), "v"(b)); return r; }
__device__ __forceinline__ float vminf(float a, float b) { float r; asm("v_min_f32 %0, %1, %2" : "=v"(r) : "v"(a), "v"(b)); return r; }
#define TK_CE(x, y) do { const float _h = vmaxf((x), (y)); (y) = vminf((x), (y)); (x) = _h; } while (0)
#define TK_SORT16(t) do { TK_CE(t[0], t[1]); TK_CE(t[2], t[3]); TK_CE(t[0], t[2]); TK_CE(t[1], t[3]); TK_CE(t[1], t[2]); TK_CE(t[4], t[5]); TK_CE(t[6], t[7]); TK_CE(t[4], t[6]); TK_CE(t[5], t[7]); TK_CE(t[5], t[6]); TK_CE(t[0], t[4]); TK_CE(t[2], t[6]); TK_CE(t[2], t[4]); TK_CE(t[1], t[5]); TK_CE(t[3], t[7]); TK_CE(t[3], t[5]); TK_CE(t[1], t[2]); TK_CE(t[3], t[4]); TK_CE(t[5], t[6]); TK_CE(t[8], t[9]); TK_CE(t[10], t[11]); TK_CE(t[8], t[10]); TK_CE(t[9], t[11]); TK_CE(t[9], t[10]); TK_CE(t[12], t[13]); TK_CE(t[14], t[15]); TK_CE(t[12], t[14]); TK_CE(t[13], t[15]); TK_CE(t[13], t[14]); TK_CE(t[8], t[12]); TK_CE(t[10], t[14]); TK_CE(t[10], t[12]); TK_CE(t[9], t[13]); TK_CE(t[11], t[15]); TK_CE(t[11], t[13]); TK_CE(t[9], t[10]); TK_CE(t[11], t[12]); TK_CE(t[13], t[14]); TK_CE(t[0], t[8]); TK_CE(t[4], t[12]); TK_CE(t[4], t[8]); TK_CE(t[2], t[10]); TK_CE(t[6], t[14]); TK_CE(t[6], t[10]); TK_CE(t[2], t[4]); TK_CE(t[6], t[8]); TK_CE(t[10], t[12]); TK_CE(t[1], t[9]); TK_CE(t[5], t[13]); TK_CE(t[5], t[9]); TK_CE(t[3], t[11]); TK_CE(t[7], t[15]); TK_CE(t[7], t[11]); TK_CE(t[3], t[5]); TK_CE(t[7], t[9]); TK_CE(t[11], t[13]); TK_CE(t[1], t[2]); TK_CE(t[3], t[4]); TK_CE(t[5], t[6]); TK_CE(t[7], t[8]); TK_CE(t[9], t[10]); TK_CE(t[11], t[12]); TK_CE(t[13], t[14]); } while (0)
#define TK_BMERGE16(t) do { TK_CE(t[0], t[8]); TK_CE(t[1], t[9]); TK_CE(t[2], t[10]); TK_CE(t[3], t[11]); TK_CE(t[4], t[12]); TK_CE(t[5], t[13]); TK_CE(t[6], t[14]); TK_CE(t[7], t[15]); TK_CE(t[0], t[4]); TK_CE(t[1], t[5]); TK_CE(t[2], t[6]); TK_CE(t[3], t[7]); TK_CE(t[8], t[12]); TK_CE(t[9], t[13]); TK_CE(t[10], t[14]); TK_CE(t[11], t[15]); TK_CE(t[0], t[2]); TK_CE(t[1], t[3]); TK_CE(t[4], t[6]); TK_CE(t[5], t[7]); TK_CE(t[8], t[10]); TK_CE(t[9], t[11]); TK_CE(t[12], t[14]); TK_CE(t[13], t[15]); TK_CE(t[0], t[1]); TK_CE(t[2], t[3]); TK_CE(t[4], t[5]); TK_CE(t[6], t[7]); TK_CE(t[8], t[9]); TK_CE(t[10], t[11]); TK_CE(t[12], t[13]); TK_CE(t[14], t[15]); } while (0)
#define TK_MERGE(A, B) do { _Pragma("unroll") for (int _i = 0; _i < 16; ++_i) A[_i] = vmaxf(A[_i], B[15 - _i]); TK_BMERGE16(A); } while (0)
__constant__ unsigned long long TK_I[4] = {0x0000000000000000ull, 0x0007744411111111ull, 0x0006655333322222ull, 0x00000000FEDCBA98ull};
__constant__ unsigned long long TK_J[4] = {0xFEDCBA9876543210ull, 0x0001021076543210ull, 0x0001010321043210ull, 0x0000000000000000ull};
__constant__ int TK_N[4] = {16, 13, 13, 8};
#define TOP_INSERT(t, v) do { float _v = (v); _Pragma("unroll") for (int _i = 0; _i < 16; ++_i) { const float _h = vmaxf(t[_i], _v); _v = vminf(t[_i], _v); t[_i] = _h; } } while (0)

__device__ void phase6(const Args& a, char* lds) {
  unsigned char* ws = a.ws;
  const int tid = threadIdx.x, lane = tid & 63, wv = tid >> 6, r32 = lane & 31, hi = lane >> 5;
  const u16* H = (const u16*)(ws + WS_H); const u16* WST = (const u16*)(ws + WS_WST);
  float* TOPS = (float*)(ws + WS_TOPK);
  const float* BIASP = (const float*)(ws + WS_BIASP); const float* SSQ = (const float*)(ws + WS_SSQ);
  char* gl = lds + LDS_DATA;
  for (int u = blockIdx.x; u < 16 * 64; u += gridDim.x) {
    int tb, hh; xcd_unit(u, 16, tb, hh);
    const int b = tb >> 4;
    f32x16 sc[4];
    gemm_128x256_wide(WST + ((size_t)b * 2048 + hh * 128) * 1024, 1024, H + (size_t)tb * 256 * 1024, 1024, 16, sc, gl);
    float* bl = (float*)gl;
    if (tid < 128) bl[tid] = BIASP[((size_t)0 * 4 + b) * 2048 + hh * 128 + tid] + BIASP[((size_t)1 * 4 + b) * 2048 + hh * 128 + tid]
                           + BIASP[((size_t)2 * 4 + b) * 2048 + hh * 128 + tid] + BIASP[((size_t)3 * 4 + b) * 2048 + hh * 128 + tid];
    const float4 sq = *(const float4*)(SSQ + (size_t)(tb * 256 + 32 * wv + r32) * 4);
    const float rstd = rsqrtf((sq.x + sq.y + sq.z + sq.w) * (1.f / 1024.f) + EPS);
    __syncthreads();
    float g0[16], g1[16], g2[16], g3[16], p[16];
#pragma unroll
    for (int r = 0; r < 16; ++r) {
      const unsigned key = crow(r, hi);
      g0[r] = __uint_as_float((__float_as_uint(fmaf(sc[0][r], rstd, bl[key])) & ~127u) | key);
      g1[r] = __uint_as_float((__float_as_uint(fmaf(sc[1][r], rstd, bl[32 + key])) & ~127u) | (32u + key));
      g2[r] = __uint_as_float((__float_as_uint(fmaf(sc[2][r], rstd, bl[64 + key])) & ~127u) | (64u + key));
      g3[r] = __uint_as_float((__float_as_uint(fmaf(sc[3][r], rstd, bl[96 + key])) & ~127u) | (96u + key));
    }
    TK_SORT16(g0); TK_SORT16(g1); TK_SORT16(g2); TK_SORT16(g3);
    TK_MERGE(g0, g1); TK_MERGE(g2, g3); TK_MERGE(g0, g2);
#pragma unroll
    for (int i = 0; i < 16; ++i) {
      auto rr = __builtin_amdgcn_permlane32_swap(__float_as_uint(g0[i]), __float_as_uint(g0[i]), false, false);
      p[i] = __uint_as_float(hi ? rr[0] : rr[1]);
    }
    TK_MERGE(g0, p);
    if (hi == 0) {
      float* dst = TOPS + ((size_t)(tb * 256 + 32 * wv + r32) * 16 + hh) * 16;
#pragma unroll
      for (int i = 0; i < 16; i += 4) *(float4*)(dst + i) = make_float4(g0[i], g0[i + 1], g0[i + 2], g0[i + 3]);
    }
  }
}

typedef __attribute__((ext_vector_type(4))) float f32x4;
#define MFMA4(a, b, c) __builtin_amdgcn_mfma_f32_4x4x4bf16_1k((a), (b), (c), 0, 0, 0)
constexpr int P7_VROW = 2112, P7_VBUF = 4 * P7_VROW;
constexpr int P7_RING = 64;
constexpr int P7_ENT  = P7_RING + 8 * 2 * P7_VBUF;
constexpr int P7_CNT  = P7_ENT + 8 * 2048;
static_assert(P7_CNT + 8 * 256 <= LDS_BYTES, "phase 7 LDS map");
__device__ __forceinline__ float sel4(const f32x4& d, int k) { return k == 0 ? d[0] : (k == 1 ? d[1] : (k == 2 ? d[2] : d[3])); }
__device__ __forceinline__ unsigned fp8x2_bf16(unsigned x, float sc, bool hi) {
  return hi ? __builtin_bit_cast(unsigned, __builtin_amdgcn_cvt_scalef32_pk_bf16_fp8(x, sc, true)) : __builtin_bit_cast(unsigned, __builtin_amdgcn_cvt_scalef32_pk_bf16_fp8(x, sc, false));
}

__device__ void phase7(const Args& a, char* lds) {
  unsigned char* ws = a.ws;
  const int tid = threadIdx.x, lane = tid & 63, wv = __builtin_amdgcn_readfirstlane(tid >> 6), blk = lane >> 2, j4 = lane & 3;
  const u16* H = (const u16*)(ws + WS_H); const unsigned char* U8 = ws + WS_UB; const unsigned char* V8 = ws + WS_VB;
  const float* TOPS = (const float*)(ws + WS_TOPK); const float* X1 = (const float*)(ws + WS_X1); const float* mod = (const float*)(ws + WS_MOD);
  const float* SSQ = (const float*)(ws + WS_SSQ);
  const unsigned lbase = (unsigned)(uintptr_t)lds;
  char* ring = lds + P7_RING + wv * 2 * P7_VBUF;
  unsigned* ents = (unsigned*)(lds + P7_ENT + wv * 2048);
  int* cntw = (int*)(lds + P7_CNT + wv * 256);
  const int trb = (int)(lbase + P7_RING + wv * 2 * P7_VBUF) + ((lane & 15) >> 2) * P7_VROW + 32 * (lane >> 4) + 8 * (lane & 3);
  const int NWV = gridDim.x * 8;
  for (int qd = blockIdx.x * 8 + wv; qd < T / 4; qd += NWV) {
    const int tok0 = qd * 4, b = tok0 >> 12;
    float* TS = (float*)ring;
#pragma unroll
    for (int i = 0; i < 4; ++i) *(float4*)(TS + 256 * i + 4 * lane) = *(const float4*)(TOPS + (size_t)tok0 * 256 + 256 * i + 4 * lane);
    cntw[lane] = 0;
    asm volatile("s_waitcnt lgkmcnt(0)" ::: "memory");
    unsigned ec[8];
#pragma unroll
    for (int rd = 0; rd < 2; ++rd) {
      const int combo = (lane >> 2) + 16 * rd, tl = combo >> 3, hd = combo & 7, q = lane & 3;
      const float* t1 = TS + (tl * 16 + hd * 2) * 16; const float* t2 = t1 + 16;
      const unsigned long long ip = TK_I[q], jp = TK_J[q]; const int cn = TK_N[q];
      float L[16], P[16];
#pragma unroll
      for (int c = 0; c < 16; ++c) {
        const unsigned i = (unsigned)(ip >> (4 * c)) & 15u, j = (unsigned)(jp >> (4 * c)) & 15u;
        const float sm = t1[i] + t2[j];
        L[c] = c < cn ? __uint_as_float((__float_as_uint(sm) & ~255u) | (i << 4) | j) : -3.0e38f;
      }
      TK_SORT16(L);
#pragma unroll
      for (int c = 0; c < 16; ++c) P[c] = __uint_as_float(__builtin_amdgcn_update_dpp(0, __float_as_uint(L[c]), 0xB1, 0xf, 0xf, false));
      TK_MERGE(L, P);
#pragma unroll
      for (int c = 0; c < 16; ++c) P[c] = __uint_as_float(__builtin_amdgcn_update_dpp(0, __float_as_uint(L[c]), 0x4E, 0xf, 0xf, false));
      TK_MERGE(L, P);
      float sum = 0.f;
      const float m0 = __uint_as_float(__float_as_uint(L[0]) & ~255u);
#pragma unroll
      for (int c = 0; c < 16; ++c) sum += __expf(__uint_as_float(__float_as_uint(L[c]) & ~255u) - m0);
      const float inv = 1.f / sum;
#pragma unroll
      for (int r = 0; r < 4; ++r) {
        const float lv = q == 0 ? L[r] : (q == 1 ? L[4 + r] : (q == 2 ? L[8 + r] : L[12 + r]));
        const unsigned bits = __float_as_uint(lv), id = bits & 255u;
        const unsigned i1 = __float_as_uint(t1[id >> 4]) & 127u, i2 = __float_as_uint(t2[id & 15u]) & 127u;
        const float gate = __expf(__uint_as_float(bits & ~255u) - m0) * inv;
        ec[4 * rd + r] = (i1 * 128u + i2) | ((unsigned)tl << 14) | (pack2(0.f, gate) & 0xFFFF0000u);
      }
    }
    {
#pragma unroll
      for (int i = 0; i < 8; ++i) atomicAdd(&cntw[(ec[i] & 0x3FFFu) >> 8], 1);
      asm volatile("s_waitcnt lgkmcnt(0)" ::: "memory");
      const int c = cntw[lane]; int inc = c;
#pragma unroll
      for (int o = 1; o < 64; o <<= 1) { const int v = __shfl_up(inc, o, 64); if (lane >= o) inc += v; }
      asm volatile("s_waitcnt lgkmcnt(0)" ::: "memory");
      cntw[lane] = inc - c;
      asm volatile("s_waitcnt lgkmcnt(0)" ::: "memory");
#pragma unroll
      for (int i = 0; i < 8; ++i) { const int pos = atomicAdd(&cntw[(ec[i] & 0x3FFFu) >> 8], 1); ents[pos] = ec[i]; }
      asm volatile("s_waitcnt lgkmcnt(0)" ::: "memory");
    }
    u32x4 hA[4][2];
    { const float4 sq = *(const float4*)(SSQ + (size_t)(tok0 + j4) * 4);
      const float rstd = rsqrtf((sq.x + sq.y + sq.z + sq.w) * (1.f / 1024.f) + EPS);
#pragma unroll
      for (int i = 0; i < 4; ++i)
#pragma unroll
        for (int hf = 0; hf < 2; ++hf) {
          const int k0 = 256 * i + 16 * blk + 8 * hf;
          const u32x4 xb = *(const u32x4*)(H + (size_t)(tok0 + j4) * 1024 + k0);
          float hv[8];
#pragma unroll
          for (int e = 0; e < 8; e += 4) {
            const float4 g = *(const float4*)(a.g_norm2 + k0 + e), sc4 = *(const float4*)(mod + b * 6144 + 4096 + k0 + e), sh4 = *(const float4*)(mod + b * 6144 + 3072 + k0 + e);
            hv[e]     = bflo(xb[e >> 1]) * rstd * g.x * (1.f + sc4.x) + sh4.x;     hv[e + 1] = bfhi(xb[e >> 1]) * rstd * g.y * (1.f + sc4.y) + sh4.y;
            hv[e + 2] = bflo(xb[(e >> 1) + 1]) * rstd * g.z * (1.f + sc4.z) + sh4.z; hv[e + 3] = bfhi(xb[(e >> 1) + 1]) * rstd * g.w * (1.f + sc4.w) + sh4.w;
          }
          hA[i][hf] = (u32x4){pack2(hv[0], hv[1]), pack2(hv[2], hv[3]), pack2(hv[4], hv[5]), pack2(hv[6], hv[7])};
        } }
    f32x4 acc[16];
#pragma unroll
    for (int c = 0; c < 16; ++c) acc[c] = (f32x4){0.f, 0.f, 0.f, 0.f};
#define P7_VPHASE(bufi) do { const int _vb = trb + (bufi) * P7_VBUF;                                                            \
      { const s16x4 v0 = tr_read<0>(_vb), v1 = tr_read<128>(_vb), v2 = tr_read<256>(_vb), v3 = tr_read<384>(_vb),               \
                    v4 = tr_read<512>(_vb), v5 = tr_read<640>(_vb), v6 = tr_read<768>(_vb), v7 = tr_read<896>(_vb);               \
        asm volatile("s_waitcnt lgkmcnt(0)" ::: "memory"); SBAR();                                                                \
        acc[0] = MFMA4(awp, v0, acc[0]); acc[1] = MFMA4(awp, v1, acc[1]); acc[2] = MFMA4(awp, v2, acc[2]); acc[3] = MFMA4(awp, v3, acc[3]);   \
        acc[4] = MFMA4(awp, v4, acc[4]); acc[5] = MFMA4(awp, v5, acc[5]); acc[6] = MFMA4(awp, v6, acc[6]); acc[7] = MFMA4(awp, v7, acc[7]); } \
      { const s16x4 v0 = tr_read<1024>(_vb), v1 = tr_read<1152>(_vb), v2 = tr_read<1280>(_vb), v3 = tr_read<1408>(_vb),         \
                    v4 = tr_read<1536>(_vb), v5 = tr_read<1664>(_vb), v6 = tr_read<1792>(_vb), v7 = tr_read<1920>(_vb);           \
        asm volatile("s_waitcnt lgkmcnt(0)" ::: "memory"); SBAR();                                                                \
        acc[8] = MFMA4(awp, v0, acc[8]); acc[9] = MFMA4(awp, v1, acc[9]); acc[10] = MFMA4(awp, v2, acc[10]); acc[11] = MFMA4(awp, v3, acc[11]); \
        acc[12] = MFMA4(awp, v4, acc[12]); acc[13] = MFMA4(awp, v5, acc[13]); acc[14] = MFMA4(awp, v6, acc[14]); acc[15] = MFMA4(awp, v7, acc[15]); } } while (0)
    u32x4 u8[4], v8[4];
#define P7_LOADG(EN) do { const unsigned _ex = (EN) & 0x3FFFu; const unsigned char* _pu = U8 + (size_t)_ex * 1024 + 16 * blk;      \
      _Pragma("unroll") for (int _i = 0; _i < 4; ++_i) u8[_i] = *(const u32x4*)(_pu + 256 * _i);                                 \
      _Pragma("unroll") for (int _q = 0; _q < 4; ++_q) { const unsigned _eq = (unsigned)__builtin_amdgcn_readlane((int)_ex, _q);  \
        v8[_q] = *(const u32x4*)(V8 + (size_t)_eq * 1024 + 16 * lane); } } while (0)
    unsigned enc = ents[j4], enn = ents[4 + j4];
    P7_LOADG(enc);
    s16x4 awp = {0, 0, 0, 0};
    constexpr int NG = 128;
    for (int g = 0; g < NG; ++g) {
      if (g > 0) P7_VPHASE((g - 1) & 1);
      f32x4 d0 = {0.f, 0.f, 0.f, 0.f}, d1 = {0.f, 0.f, 0.f, 0.f};
#pragma unroll
      for (int i = 0; i < 4; ++i)
#pragma unroll
        for (int w = 0; w < 4; ++w) {
          const uint2 ub = {fp8x2_bf16(u8[i][w], 1.f / PEER_SU, false), fp8x2_bf16(u8[i][w], 1.f / PEER_SU, true)};
          const uint2 ha = {hA[i][w >> 1][2 * (w & 1)], hA[i][w >> 1][2 * (w & 1) + 1]};
          if (w & 1) d1 = MFMA4(__builtin_bit_cast(s16x4, ha), __builtin_bit_cast(s16x4, ub), d1);
          else       d0 = MFMA4(__builtin_bit_cast(s16x4, ha), __builtin_bit_cast(s16x4, ub), d0);
        }
      { char* vw = ring + (g & 1) * P7_VBUF + lane * 32;
#pragma unroll
        for (int q = 0; q < 4; ++q) {
          u32x4 o0, o1;
          o0[0] = fp8x2_bf16(v8[q][0], 1.f / PEER_SV, false); o0[1] = fp8x2_bf16(v8[q][0], 1.f / PEER_SV, true);
          o0[2] = fp8x2_bf16(v8[q][1], 1.f / PEER_SV, false); o0[3] = fp8x2_bf16(v8[q][1], 1.f / PEER_SV, true);
          o1[0] = fp8x2_bf16(v8[q][2], 1.f / PEER_SV, false); o1[1] = fp8x2_bf16(v8[q][2], 1.f / PEER_SV, true);
          o1[2] = fp8x2_bf16(v8[q][3], 1.f / PEER_SV, false); o1[3] = fp8x2_bf16(v8[q][3], 1.f / PEER_SV, true);
          *(u32x4*)(vw + q * P7_VROW) = o0; *(u32x4*)(vw + q * P7_VROW + 16) = o1;
        } }
      unsigned en2 = 0u;
      if (g + 1 < NG) { P7_LOADG(enn); if (g + 2 < NG) en2 = ents[4 * (g + 2) + j4]; }
      const int tk = (enc >> 14) & 3;
      float av = sel4(d0, tk) + sel4(d1, tk);
      av += __uint_as_float(__builtin_amdgcn_update_dpp(0, __float_as_uint(av), 0x124, 0xf, 0xf, false));
      av += __uint_as_float(__builtin_amdgcn_update_dpp(0, __float_as_uint(av), 0x128, 0xf, 0xf, false));
      av += __shfl_xor(av, 16, 64);
      { auto rr = __builtin_amdgcn_permlane32_swap(__float_as_uint(av), __float_as_uint(av), false, false); av = __uint_as_float(rr[0]) + __uint_as_float(rr[1]); }
      const float wgt = gelu_exact(av) * __uint_as_float(enc & 0xFFFF0000u);
      float z[4];
#define P7_QB(x, k) __builtin_amdgcn_update_dpp(0, (x), (k) * 0x55, 0xf, 0xf, false)
      { const unsigned wb = __float_as_uint(wgt), tb = (unsigned)tk;
        unsigned w0 = P7_QB(wb, 0), w1 = P7_QB(wb, 1), w2 = P7_QB(wb, 2), w3 = P7_QB(wb, 3);
        unsigned t0 = P7_QB(tb, 0), t1 = P7_QB(tb, 1), t2 = P7_QB(tb, 2), t3 = P7_QB(tb, 3);
        asm volatile("" : "+v"(w0), "+v"(w1), "+v"(w2), "+v"(w3), "+v"(t0), "+v"(t1), "+v"(t2), "+v"(t3));
        z[0] = ((int)t0 == j4) ? __uint_as_float(w0) : 0.f; z[1] = ((int)t1 == j4) ? __uint_as_float(w1) : 0.f;
        z[2] = ((int)t2 == j4) ? __uint_as_float(w2) : 0.f; z[3] = ((int)t3 == j4) ? __uint_as_float(w3) : 0.f; }
#undef P7_QB
      { const uint2 pk = {pack2(z[0], z[1]), pack2(z[2], z[3])}; awp = __builtin_bit_cast(s16x4, pk); }
      enc = enn; enn = en2;
    }
#undef P7_LOADG
    P7_VPHASE((NG - 1) & 1);
#undef P7_VPHASE
    int lne = lane; asm volatile("" : "+v"(lne));
    float ss[4] = {0.f, 0.f, 0.f, 0.f};
#pragma unroll
    for (int c = 0; c < 16; ++c) {
      const float g2 = mod[b * 6144 + 5120 + 64 * c + lne];
#pragma unroll
      for (int r = 0; r < 4; ++r) { const float v = X1[(size_t)(tok0 + r) * 1024 + 64 * c + lne] + g2 * acc[c][r]; acc[c][r] = v; ss[r] += v * v; }
    }
    float rstd[4];
#pragma unroll
    for (int r = 0; r < 4; ++r) rstd[r] = rsqrtf(wave_sum(ss[r]) * (1.f / 1024.f) + EPS);
#pragma unroll
    for (int c = 0; c < 16; ++c) {
      const float gf = a.g_final[64 * c + lne];
#pragma unroll
      for (int r = 0; r < 4; ++r) a.out[(size_t)(tok0 + r) * 1024 + 64 * c + lne] = acc[c][r] * rstd[r] * gf;
    }
  }
}

constexpr int N_PHASES = 8;
__global__ void __launch_bounds__(512, 2) fwd(Args args) {
  extern __shared__ __attribute__((aligned(16))) char lds[];
  if (threadIdx.x == 0) *(uint4*)lds = make_uint4(0u, 0u, 0u, 0u);
  __syncthreads();
  const int lo = args.ph_lo, hi = args.ph_hi;
  XcdBarrier bar; bar.bar = (unsigned*)(args.ws + WS_BAR); bar.x = 0; bar.st = (volatile LAS unsigned*)lds;
  if (hi - lo > 1) bar = xcd_barrier_post((unsigned*)(args.ws + WS_BAR), (volatile LAS unsigned*)lds);
#ifndef ONLY_PHASE
#define ONLY_PHASE -1
#endif
#define IN(k) (lo <= (k) && (k) < hi && (ONLY_PHASE < 0 || ONLY_PHASE == (k)))
#define SEAM(k) do { if (IN(k) && IN((k) + 1)) xcd_barrier(bar); } while (0)
  if (IN(0)) phase0(args, lds);
  SEAM(0);
  if (IN(1)) { phase1(args, lds); phase1b(args, lds); }
  SEAM(1);
  if (IN(2)) phase2(args, lds);
  SEAM(2);
  if (IN(3)) phase3(args, lds);
  SEAM(3);
  if (IN(4)) phase4(args, lds);
  SEAM(4);
  if (IN(5)) phase5(args, lds);
  SEAM(5);
  if (IN(6)) phase6(args, lds);
  SEAM(6);
  if (IN(7)) phase7(args, lds);
#undef IN
#undef SEAM
}

extern "C" void kernel_launch(void* const* d_in, const int* in_sizes, int n_in, void* d_out, int out_size, void* d_ws, size_t ws_size, hipStream_t stream) {
  static int grid = 0;
  if (grid == 0) {
    if (n_in != 23 || out_size != T * DM || ws_size < WS_END) { fprintf(stderr, "kernel_launch: unexpected shapes (n_in %d out %d ws %zu need %zu)\n", n_in, out_size, ws_size, (size_t)WS_END); grid = -1; return; }
    int dev = 0, cus = 0, per_cu = 0;
    (void)hipGetDevice(&dev); (void)hipDeviceGetAttribute(&cus, hipDeviceAttributeMultiprocessorCount, dev);
    if (hipFuncSetAttribute((const void*)fwd, hipFuncAttributeMaxDynamicSharedMemorySize, LDS_BYTES) != hipSuccess) { fprintf(stderr, "kernel_launch: hipFuncSetAttribute failed\n"); grid = -1; return; }
    if (hipOccupancyMaxActiveBlocksPerMultiprocessor(&per_cu, (const void*)fwd, 512, LDS_BYTES) != hipSuccess || per_cu < 1) { fprintf(stderr, "kernel_launch: occupancy query says %d\n", per_cu); per_cu = 1; }
    (void)hipGetLastError();
    grid = cus;
  }
  if (grid < 0) return;
  (void)hipMemsetAsync((char*)d_ws + WS_BAR, 0, 16384, stream);
  Args a{};
  a.x = (const float*)d_in[0]; a.c = (const float*)d_in[1]; a.pos = (const int*)d_in[2];
  a.w_ada = (const float*)d_in[3]; a.b_ada = (const float*)d_in[4]; a.g_norm1 = (const float*)d_in[5]; a.w_in = (const float*)d_in[6];
  a.g_q_a = (const float*)d_in[7]; a.w_uq = (const float*)d_in[8]; a.g_kv_a = (const float*)d_in[9]; a.w_ukv = (const float*)d_in[10];
  a.g_sg = (const float*)d_in[11]; a.w_sg = (const float*)d_in[12]; a.b_sg = (const float*)d_in[13]; a.g_attn_out = (const float*)d_in[14];
  a.g_sg_out = (const float*)d_in[15]; a.w_o = (const float*)d_in[16]; a.g_norm2 = (const float*)d_in[17]; a.w_peer_q = (const float*)d_in[18];
  a.peer_keys = (const float*)d_in[19]; a.peer_u = (const float*)d_in[20]; a.peer_v = (const float*)d_in[21]; a.g_final = (const float*)d_in[22];
  a.out = (float*)d_out; a.ws = (unsigned char*)d_ws;
#if N_LAUNCH_MODE == 0
  a.ph_lo = 0; a.ph_hi = N_PHASES;
  hipLaunchKernelGGL(fwd, dim3(grid), dim3(512), LDS_BYTES, stream, a);
#else
  for (int p = 0; p < N_PHASES; ++p) for (int rep = 0; rep <= ((DUP_MASK >> p) & 1); ++rep) { a.ph_lo = p; a.ph_hi = p + 1; hipLaunchKernelGGL(fwd, dim3(grid), dim3(512), LDS_BYTES, stream, a); }
#endif
  const hipError_t le = hipPeekAtLastError();
  if (le != hipSuccess) fprintf(stderr, "kernel_launch: launch failed: %s\n", hipGetErrorName(le));
}
```

```cpp
#include <hip/hip_runtime.h>
#include <stdint.h>
#include <stdio.h>

#define N_LAUNCH_MODE 0
#define DUP_MASK 0x000

typedef unsigned short u16;
typedef __attribute__((ext_vector_type(8))) short bf16x8;
typedef __attribute__((ext_vector_type(4))) short s16x4;
typedef __attribute__((ext_vector_type(16))) float f32x16;
typedef __attribute__((ext_vector_type(4))) unsigned u32x4;

constexpr int T = 16384, DM = 1024, SEQ = 4096;
constexpr float EPS = 1e-6f;

constexpr size_t WS_BAR  = 0;
constexpr size_t WS_MODP = 16384;
constexpr size_t WS_MOD  = WS_MODP + 786432;
constexpr size_t WS_CS   = WS_MOD + 98304;
constexpr size_t WS_WIN  = WS_CS + 4194304;
constexpr size_t WS_WQ2  = WS_WIN + 3145728;
constexpr size_t WS_WUV  = WS_WQ2 + 393216;
constexpr size_t WS_WO   = WS_WUV + 131072;
constexpr size_t WS_WPQ  = WS_WO + 2097152;
constexpr size_t WS_KEYS = WS_WPQ + 4194304;
constexpr size_t WS_WSG  = WS_KEYS + 524288;
constexpr size_t WS_UB   = WS_WSG + 131072;
constexpr size_t WS_VB   = WS_UB + 33554432;
constexpr size_t WS_H    = WS_VB + 33554432;
constexpr size_t WS_Y    = WS_H + 33554432;
constexpr size_t WS_KV   = WS_Y + 33554432;
constexpr size_t WS_TOPK = WS_KV + 6291456;
constexpr size_t WS_SSQ  = WS_TOPK + 16777216;
constexpr size_t WS_SSQV = WS_SSQ + 262144;
constexpr size_t WS_R1   = WS_SSQV + 131072;
constexpr size_t WS_Q    = WS_R1;
constexpr size_t WS_QA   = WS_Q + 25165824;
constexpr size_t WS_UACT = WS_QA + 8388608;
constexpr size_t WS_GVT  = WS_UACT + 16777216;
constexpr size_t WS_X1   = WS_R1;
constexpr size_t WS_WST  = WS_R1 + 67108864;
constexpr size_t WS_BIASP = WS_WST + 4 * 4194304;
constexpr size_t WS_END  = WS_BIASP + 131072;

constexpr int LDS_BYTES = 155648;
constexpr int LDS_DATA  = 64;

struct Args {
  const float *x, *c; const int* pos;
  const float *w_ada, *b_ada, *g_norm1, *w_in, *g_q_a, *w_uq, *g_kv_a, *w_ukv, *g_sg, *w_sg, *b_sg, *g_attn_out, *g_sg_out,
              *w_o, *g_norm2, *w_peer_q, *peer_keys, *peer_u, *peer_v, *g_final;
  float* out; unsigned char* ws; int ph_lo, ph_hi;
};

#define XB_TMO      128
#define XB_XCNT(j)  (256  + 64 * (j))
#define XB_XSUB(j)  (1280 + 64 * (j))
#define XB_XGEN(j)  (2304 + 64 * (j))
#define XB_TOP      3328
#define XB_TOPGEN   3392
#define XCD_BAR_WORDS 3456
#define XB_SPIN_CAP (1u << 18)
#define LAS __attribute__((address_space(3)))

__device__ __forceinline__ unsigned xb_ld(unsigned* p)              { return __hip_atomic_load(p, __ATOMIC_RELAXED, __HIP_MEMORY_SCOPE_AGENT); }
__device__ __forceinline__ unsigned xb_add(unsigned* p, unsigned v) { return __hip_atomic_fetch_add(p, v, __ATOMIC_RELAXED, __HIP_MEMORY_SCOPE_AGENT); }
__device__ __forceinline__ unsigned xb_xcc_id() { return (unsigned)__builtin_amdgcn_s_getreg((3 << 11) | 20) & 0xFu; }
#define XB_SPIN(cond, bar) do { unsigned _sp = 0; while (cond) { __builtin_amdgcn_s_sleep(1); \
    if ((++_sp & 255u) == 0u) { if (xb_ld(&(bar)[XB_TMO])) break; if (_sp > XB_SPIN_CAP) { atomicAdd(&(bar)[XB_TMO], 1u); break; } } } } while (0)

struct XcdBarrier { unsigned* bar; unsigned x; volatile LAS unsigned* st; };

__device__ __forceinline__ XcdBarrier xcd_barrier_post(unsigned* bar, volatile LAS unsigned* st) {
    XcdBarrier b; b.bar = bar; b.x = xb_xcc_id(); b.st = st;
    if (threadIdx.x == 0) (void)xb_add(&bar[XB_XCNT(b.x)], 1u);
    return b;
}
__device__ __forceinline__ void xcd_barrier_complete(unsigned* bar, unsigned x, unsigned& nloc, unsigned& nx) {
    const unsigned G = gridDim.x * gridDim.y * gridDim.z;
    unsigned sum, cnt, mine, sp = 0u;
    for (;;) {
        sum = 0u; cnt = 0u; mine = 0u;
#pragma unroll
        for (unsigned j = 0; j < 16; ++j) { const unsigned c = xb_ld(&bar[XB_XCNT(j)]); sum += c; cnt += (c > 0u) ? 1u : 0u; mine = (j == x) ? c : mine; }
        if (sum == G) break;
        __builtin_amdgcn_s_sleep(1);
        if ((++sp & 255u) == 0u) { if (xb_ld(&bar[XB_TMO])) break; if (sp > XB_SPIN_CAP) { atomicAdd(&bar[XB_TMO], 1u); break; } }
    }
    nloc = mine > 0u ? mine : 1u; nx = cnt > 0u ? cnt : 1u;
}
__device__ __forceinline__ void xcd_barrier(const XcdBarrier& b) {
    asm volatile("s_waitcnt vmcnt(0)" ::: "memory");
    __syncthreads();
    if (threadIdx.x == 0) {
        unsigned* bar = b.bar;
        __builtin_amdgcn_s_waitcnt(0);
        unsigned nloc = b.st[0], nx = b.st[1];
        if (nloc == 0u) { xcd_barrier_complete(bar, b.x, nloc, nx); b.st[0] = nloc; b.st[1] = nx; }
        const unsigned old = xb_add(&bar[XB_XSUB(b.x)], 1u);
        const unsigned gen = old / nloc;
        if (old + 1u == (gen + 1u) * nloc) {
            __builtin_amdgcn_fence(__ATOMIC_RELEASE, "agent");
            asm volatile("s_waitcnt vmcnt(0)" ::: "memory");
            const unsigned og = xb_add(&bar[XB_TOP], 1u);
            const unsigned tg = og / nx;
            if (og + 1u == (tg + 1u) * nx) xb_add(&bar[XB_TOPGEN], 1u);
            else XB_SPIN(xb_ld(&bar[XB_TOPGEN]) == tg, bar);
            __builtin_amdgcn_fence(__ATOMIC_ACQUIRE, "agent");
            xb_add(&bar[XB_XGEN(b.x)], 1u);
            asm volatile("s_waitcnt vmcnt(0)" ::: "memory");
        } else {
            XB_SPIN(xb_ld(&bar[XB_XGEN(b.x)]) == gen, bar);
            __builtin_amdgcn_fence(__ATOMIC_ACQUIRE, "agent");
            asm volatile("s_waitcnt vmcnt(0)" ::: "memory");
        }
    }
    __syncthreads();
}

__device__ __forceinline__ unsigned pack2(float lo, float hi) {
  typedef __attribute__((ext_vector_type(2))) float f2; typedef __attribute__((ext_vector_type(2))) __bf16 b2;
  f2 v = {lo, hi}; b2 r = __builtin_convertvector(v, b2); return __builtin_bit_cast(unsigned, r);
}
__device__ __forceinline__ u16 f2bf(float f) { return (u16)(pack2(f, 0.f) & 0xFFFFu); }
__device__ __forceinline__ float bflo(unsigned w) { return __uint_as_float(w << 16); }
__device__ __forceinline__ float bfhi(unsigned w) { return __uint_as_float(w & 0xFFFF0000u); }
__device__ __forceinline__ float gelu_exact(float x) {
  const float z = fabsf(x) * 0.70710678118654752f;
  const float t = __builtin_amdgcn_rcpf(fmaf(0.3275911f, z, 1.f));
  float p = fmaf(1.061405429f, t, -1.453152027f); p = fmaf(p, t, 1.421413741f); p = fmaf(p, t, -0.284496736f); p = fmaf(p, t, 0.254829592f);
  const float e = p * t * __expf(-z * z);
  const float erfz = 1.f - e;
  return 0.5f * x * (1.f + copysignf(erfz, x));
}
__device__ __forceinline__ float wave_sum(float v) {
#pragma unroll
  for (int o = 32; o > 0; o >>= 1) v += __shfl_xor(v, o, 64);
  return v;
}
__device__ __forceinline__ int crow(int r, int hi) { return (r & 3) + 8 * (r >> 2) + 4 * hi; }
#define MFMA32(a, b, c) __builtin_amdgcn_mfma_f32_32x32x16_bf16((a), (b), (c), 0, 0, 0)

template <int MAP> __device__ __forceinline__ int colmap(int n) {
  if (MAP == 0) return n;
  if (MAP == 1) return n < 448 ? n : (n < 512 ? -1 : n - 64);
  if (MAP == 2) return (n >> 6) * 192 + 128 + (n & 63);
  return (n >> 7) * 256 + 128 + (n & 127);
}
template <int MAP> __device__ void cvt_transpose(const float* __restrict__ src, int src_ld, int K, int N, u16* __restrict__ dst, int gtid, int gthreads) {
  const int total = N * (K >> 3);
  for (int idx = gtid; idx < total; idx += gthreads) {
    const int n = idx % N, k8 = idx / N, sc = colmap<MAP>(n);
    float v[8];
#pragma unroll
    for (int j = 0; j < 8; ++j) v[j] = sc < 0 ? 0.f : src[(size_t)(k8 * 8 + j) * src_ld + sc];
    u32x4 w = {pack2(v[0], v[1]), pack2(v[2], v[3]), pack2(v[4], v[5]), pack2(v[6], v[7])};
    *(u32x4*)(dst + (size_t)n * K + k8 * 8) = w;
  }
}
template <int MAP> __device__ void cvt_transpose_tiled(const float* __restrict__ src, int src_ld, int K, int N, u16* __restrict__ dst, float* tile) {
  const int tid = threadIdx.x, tk = K >> 6, ntile = tk * (N >> 6);
  for (int t = blockIdx.x; t < ntile; t += gridDim.x) {
    const int k0 = (t % tk) * 64, n0 = (t / tk) * 64;
    __syncthreads();
    { const int nl = tid & 63, sc = colmap<MAP>(n0 + nl);
#pragma unroll
      for (int i = 0; i < 8; ++i) { const int k = (tid >> 6) + 8 * i; tile[k * 65 + nl] = sc < 0 ? 0.f : src[(size_t)(k0 + k) * src_ld + sc]; } }
    __syncthreads();
    { const int n = tid >> 3, kk = tid & 7; float v[8];
#pragma unroll
      for (int j = 0; j < 8; ++j) v[j] = tile[(8 * kk + j) * 65 + n];
      u32x4 w = {pack2(v[0], v[1]), pack2(v[2], v[3]), pack2(v[4], v[5]), pack2(v[6], v[7])};
      *(u32x4*)(dst + (size_t)(n0 + n) * K + k0 + 8 * kk) = w; }
  }
}
__device__ void cvt_direct(const float* __restrict__ src, u16* __restrict__ dst, size_t n8, int gtid, int gthreads) {
  for (size_t i = gtid; i < n8; i += gthreads) {
    const float4 a = *(const float4*)(src + i * 8), b = *(const float4*)(src + i * 8 + 4);
    u32x4 w = {pack2(a.x, a.y), pack2(a.z, a.w), pack2(b.x, b.y), pack2(b.z, b.w)};
    *(u32x4*)(dst + i * 8) = w;
  }
}
constexpr float PEER_SU = 32.f, PEER_SV = 4.f;
__device__ void cvt_fp8(const float* __restrict__ src, unsigned char* __restrict__ dst, size_t n16, float sc, int gtid, int gthreads) {
  for (size_t i = gtid; i < n16; i += gthreads) {
    u32x4 w;
#pragma unroll
    for (int k = 0; k < 4; ++k) {
      const float4 a = *(const float4*)(src + i * 16 + 4 * k);
      int p = __builtin_amdgcn_cvt_pk_fp8_f32(a.x * sc, a.y * sc, 0, false);
      p = __builtin_amdgcn_cvt_pk_fp8_f32(a.z * sc, a.w * sc, p, true);
      w[k] = (unsigned)p;
    }
    *(u32x4*)(dst + i * 16) = w;
  }
}
__device__ __forceinline__ void sincos_acc(float angf, float& sn, float& cs) {
  const double a = (double)angf;
  const double q = __builtin_rint(a * 0.63661977236758134308);
  double r = __builtin_fma(-q, 1.5707963267948966, a);
  r = __builtin_fma(-q, 6.123233995736766e-17, r);
  const double r2 = r * r;
  double s = r2 * (1.0 / 6227020800.0) - 1.0 / 39916800.0;
  s = s * r2 + 1.0 / 362880.0; s = s * r2 - 1.0 / 5040.0; s = s * r2 + 1.0 / 120.0; s = s * r2 - 1.0 / 6.0; s = r + r * r2 * s;
  double c = -r2 * (1.0 / 87178291200.0) + 1.0 / 479001600.0;
  c = c * r2 - 1.0 / 3628800.0; c = c * r2 + 1.0 / 40320.0; c = c * r2 - 1.0 / 720.0; c = c * r2 + 1.0 / 24.0; c = c * r2 - 0.5; c = 1.0 + r2 * c;
  const int n = ((int)q) & 3;
  const double ss = (n & 1) ? c : s, cc = (n & 1) ? s : c;
  sn = (float)((n & 2) ? -ss : ss);
  cs = (float)(((n + 1) & 2) ? -cc : cc);
}

__constant__ float INVF[32] = {1.000000000e+00f, 7.498942018e-01f, 5.623413324e-01f, 4.216965139e-01f, 3.162277639e-01f, 2.371373922e-01f, 1.778279394e-01f, 1.333521456e-01f,
  1.000000015e-01f, 7.498941571e-02f, 5.623412877e-02f, 4.216964915e-02f, 3.162277862e-02f, 2.371373586e-02f, 1.778279431e-02f, 1.333521493e-02f,
  9.999999776e-03f, 7.498942316e-03f, 5.623413250e-03f, 4.216964822e-03f, 3.162277862e-03f, 2.371373819e-03f, 1.778279431e-03f, 1.333521446e-03f,
  1.000000047e-03f, 7.498941850e-04f, 5.623413017e-04f, 4.216965463e-04f, 3.162277862e-04f, 2.371373848e-04f, 1.778279402e-04f, 1.333521504e-04f};
__device__ void phase0(const Args& a, char* lds) {
  unsigned char* ws = a.ws;
  const int tid = threadIdx.x, lane = tid & 63, wv = tid >> 6;
  const int NWV = gridDim.x * 8, gw = blockIdx.x * 8 + wv;
  const int gthreads = gridDim.x * 512, gtid = blockIdx.x * 512 + tid;
  float* modp = (float*)(ws + WS_MODP);
  for (int job = gw; job < 768; job += NWV) {
    const int cg = job % 96, ks = job / 96, col = cg * 64 + lane;
    float a0 = 0.f, a1 = 0.f, a2 = 0.f, a3 = 0.f;
    const float* w = a.w_ada + (size_t)(ks * 128) * 6144 + col;
    float sv[2][4];
#pragma unroll
    for (int h = 0; h < 2; ++h)
#pragma unroll
      for (int bb = 0; bb < 4; ++bb) { const float cv = a.c[bb * 1024 + ks * 128 + 64 * h + lane]; sv[h][bb] = cv / (1.f + __expf(-cv)); }
#pragma unroll
    for (int h = 0; h < 2; ++h) {
#pragma unroll 8
      for (int k = 0; k < 64; ++k) {
        const float wv_ = w[(size_t)(64 * h + k) * 6144];
        a0 += __uint_as_float(__builtin_amdgcn_readlane(__float_as_uint(sv[h][0]), k)) * wv_;
        a1 += __uint_as_float(__builtin_amdgcn_readlane(__float_as_uint(sv[h][1]), k)) * wv_;
        a2 += __uint_as_float(__builtin_amdgcn_readlane(__float_as_uint(sv[h][2]), k)) * wv_;
        a3 += __uint_as_float(__builtin_amdgcn_readlane(__float_as_uint(sv[h][3]), k)) * wv_;
      }
    }
    modp[(ks * 4 + 0) * 6144 + col] = a0; modp[(ks * 4 + 1) * 6144 + col] = a1;
    modp[(ks * 4 + 2) * 6144 + col] = a2; modp[(ks * 4 + 3) * 6144 + col] = a3;
  }
  { float* tile = (float*)(lds + LDS_DATA);
    cvt_transpose_tiled<1>(a.w_in, 1472, 1024, 1536, (u16*)(ws + WS_WIN), tile);
    cvt_transpose_tiled<0>(a.w_o, 1024, 1024, 1024, (u16*)(ws + WS_WO), tile);
    cvt_transpose_tiled<2>(a.w_uq, 768, 256, 256, (u16*)(ws + WS_WQ2) + 512 * 256, tile);
    cvt_transpose_tiled<3>(a.w_ukv, 1024, 128, 512, (u16*)(ws + WS_WUV), tile); }
  {
    u16* wq2 = (u16*)(ws + WS_WQ2);
    for (int idx = gtid; idx < 512 * 256; idx += gthreads) {
      const int n = idx >> 8, i = idx & 255, h = n >> 7, cc = n & 127;
      const float* pu = a.w_uq + (size_t)i * 768 + h * 192;
      const float* pk = a.w_ukv + (size_t)cc * 1024 + h * 256;
      float s = 0.f;
#pragma unroll 8
      for (int d = 0; d < 128; d += 4) {
        const float4 u = *(const float4*)(pu + d), k = *(const float4*)(pk + d);
        s += u.x * k.x + u.y * k.y + u.z * k.z + u.w * k.w;
      }
      wq2[(size_t)n * 256 + i] = f2bf(s);
    }
  }
  cvt_direct(a.peer_keys, (u16*)(ws + WS_KEYS), 262144 / 8, gtid, gthreads);
  cvt_direct(a.w_peer_q, (u16*)(ws + WS_WPQ), (size_t)1024 * 2048 / 8, gtid, gthreads);
  cvt_direct(a.w_sg, (u16*)(ws + WS_WSG), 65536 / 8, gtid, gthreads);
  {
    float* cs = (float*)(ws + WS_CS);
    for (int idx = gtid; idx < T * 32; idx += gthreads) {
      const int t = idx >> 5, i = idx & 31;
      const float inv = INVF[i];
      const float ang = (float)a.pos[t] * inv;
      float sn, c_; sincos_acc(ang, sn, c_);
      cs[(size_t)t * 64 + i] = c_; cs[(size_t)t * 64 + 32 + i] = sn;
    }
  }
}

__device__ void phase1(const Args& a, char* lds) {
  unsigned char* ws = a.ws;
  const int tid = threadIdx.x, lane = tid & 63, wv = tid >> 6;
  const float* modp = (const float*)(ws + WS_MODP);
  float* mod = (float*)(ws + WS_MOD);
  for (int idx = blockIdx.x * 512 + tid; idx < 4 * 6144; idx += gridDim.x * 512) {
    const int b = idx / 6144, m = idx % 6144;
    float s = a.b_ada[m];
#pragma unroll
    for (int ks = 0; ks < 8; ++ks) s += modp[(ks * 4 + b) * 6144 + m];
    mod[idx] = s;
  }
  float* sh = (float*)(lds + LDS_DATA);
  u16* H = (u16*)(ws + WS_H);
  for (int u = blockIdx.x; u < T / 64; u += gridDim.x) {
    const int b = u >> 6;
    __syncthreads();
    for (int j = tid; j < 2048; j += 512) {
      float s = a.b_ada[j];
#pragma unroll
      for (int ks = 0; ks < 8; ++ks) s += modp[(ks * 4 + b) * 6144 + j];
      sh[j] = s;
    }
    __syncthreads();
    for (int i = 0; i < 8; ++i) {
      const int r = u * 64 + wv * 8 + i;
      float4 xv[4]; float ssq = 0.f;
#pragma unroll
      for (int j = 0; j < 4; ++j) { xv[j] = *(const float4*)(a.x + (size_t)r * 1024 + j * 256 + lane * 4); ssq += xv[j].x * xv[j].x + xv[j].y * xv[j].y + xv[j].z * xv[j].z + xv[j].w * xv[j].w; }
      ssq = wave_sum(ssq);
      const float rstd = rsqrtf(ssq * (1.f / 1024.f) + EPS);
#pragma unroll
      for (int j = 0; j < 4; ++j) {
        const int col = j * 256 + lane * 4;
        const float4 g = *(const float4*)(a.g_norm1 + col);
        const float h0 = xv[j].x * rstd * g.x * (1.f + sh[1024 + col]) + sh[col];
        const float h1 = xv[j].y * rstd * g.y * (1.f + sh[1024 + col + 1]) + sh[col + 1];
        const float h2 = xv[j].z * rstd * g.z * (1.f + sh[1024 + col + 2]) + sh[col + 2];
        const float h3 = xv[j].w * rstd * g.w * (1.f + sh[1024 + col + 3]) + sh[col + 3];
        uint2 o = {pack2(h0, h1), pack2(h2, h3)};
        *(uint2*)(H + (size_t)r * 1024 + col) = o;
      }
    }
  }
}

constexpr int G_STAGE = 49152;
__device__ __forceinline__ void dma16(const void* gsrc, unsigned lds_dst) {
  unsigned keep;
  asm volatile("s_mov_b32 %0, m0\n\ts_mov_b32 m0, %2\n\ts_nop 0\n\tglobal_load_lds_dwordx4 %1, off\n\ts_mov_b32 m0, %0"
               : "=&s"(keep) : "v"(gsrc), "s"(lds_dst) : "memory");
}
__device__ __forceinline__ void gemm_128x256(const u16* __restrict__ A, int lda, const u16* __restrict__ Bt, int ldb, int KT,
                                             f32x16 (&acc)[2][2], char* lds) {
  const int tid = threadIdx.x, lane = tid & 63, wv = __builtin_amdgcn_readfirstlane(tid >> 6), r32 = lane & 31, hi = lane >> 5;
  const int wm = wv >> 2, wn = wv & 3;
  const int rin = lane >> 3, cc = lane & 7;
  const u16* pa[2]; const u16* pb[4];
#pragma unroll
  for (int j = 0; j < 2; ++j) pa[j] = A + (size_t)(16 * wv + 8 * j + rin) * lda + 8 * (cc ^ (4 * j + (rin >> 1)));
#pragma unroll
  for (int i = 0; i < 4; ++i) pb[i] = Bt + (size_t)(32 * wv + 8 * i + rin) * ldb + 8 * (cc ^ (4 * (i & 1) + (rin >> 1)));
  const unsigned lb = __builtin_amdgcn_readfirstlane((unsigned)(uintptr_t)lds);
  const unsigned dA = lb + 2048 * wv, dB = lb + 16384 + 4096 * wv;
#define G_ISSUE(stage, kt_) do { const unsigned _so = (unsigned)(stage) * G_STAGE; const int _ko = (kt_) * 64;                     \
    dma16(pa[0] + _ko, dA + _so); dma16(pa[1] + _ko, dA + _so + 1024);                                                           \
    dma16(pb[0] + _ko, dB + _so); dma16(pb[1] + _ko, dB + _so + 1024); dma16(pb[2] + _ko, dB + _so + 2048); dma16(pb[3] + _ko, dB + _so + 3072); } while (0)
#pragma unroll
  for (int m = 0; m < 2; ++m)
#pragma unroll
    for (int n = 0; n < 2; ++n)
#pragma unroll
      for (int r = 0; r < 16; ++r) acc[m][n][r] = 0.f;
  __syncthreads();
  G_ISSUE(0, 0);
  if (KT > 1) G_ISSUE(1, 1);
  const int xa = (r32 >> 1) & 7;
  const int aoff = (64 * wm + r32) * 128, boff = 16384 + (64 * wn + r32) * 128;
  int st = 0;
  for (int kt = 0; kt < KT; ++kt) {
    if (kt + 1 < KT) asm volatile("s_waitcnt vmcnt(6)\n\ts_barrier" ::: "memory");
    else             asm volatile("s_waitcnt vmcnt(0)\n\ts_barrier" ::: "memory");
    const int s2 = st == 0 ? 2 : st - 1;
    if (kt + 2 < KT && wv < 4) G_ISSUE(s2, kt + 2);
    const char* buf = lds + st * G_STAGE;
    __builtin_amdgcn_s_setprio(1);
    bf16x8 fa[2][2], fb[2][2];
#define G_LDF(S, SET) do { const int _cb = ((2 * (S) + hi) ^ xa) << 4;                                                      \
      fa[SET][0] = *(const bf16x8*)(buf + aoff + _cb); fa[SET][1] = *(const bf16x8*)(buf + aoff + 4096 + _cb);              \
      fb[SET][0] = *(const bf16x8*)(buf + boff + _cb); fb[SET][1] = *(const bf16x8*)(buf + boff + 4096 + _cb); } while (0)
#define G_MM(SET) do { acc[0][0] = MFMA32(fa[SET][0], fb[SET][0], acc[0][0]); acc[0][1] = MFMA32(fa[SET][0], fb[SET][1], acc[0][1]);   \
      acc[1][0] = MFMA32(fa[SET][1], fb[SET][0], acc[1][0]); acc[1][1] = MFMA32(fa[SET][1], fb[SET][1], acc[1][1]); } while (0)
    G_LDF(0, 0); __builtin_amdgcn_sched_barrier(0);
    G_LDF(1, 1); __builtin_amdgcn_sched_barrier(0); G_MM(0); __builtin_amdgcn_sched_barrier(0);
    G_LDF(2, 0); __builtin_amdgcn_sched_barrier(0); G_MM(1); __builtin_amdgcn_sched_barrier(0);
    G_LDF(3, 1); __builtin_amdgcn_sched_barrier(0); G_MM(0); __builtin_amdgcn_sched_barrier(0);
    G_MM(1);
#undef G_LDF
#undef G_MM
    __builtin_amdgcn_s_setprio(0);
    if (kt + 2 < KT && wv >= 4) G_ISSUE(s2, kt + 2);
    st = st == 2 ? 0 : st + 1;
  }
#undef G_ISSUE
  __syncthreads();
}
constexpr int CLD = 257;
__device__ __forceinline__ void acc_to_lds(const f32x16 (&acc)[2][2], float* Cl) {
  const int lane = threadIdx.x & 63, wv = threadIdx.x >> 6, r32 = lane & 31, hi = lane >> 5, wm = wv >> 2, wn = wv & 3;
#pragma unroll
  for (int m = 0; m < 2; ++m)
#pragma unroll
    for (int n = 0; n < 2; ++n)
#pragma unroll
      for (int r = 0; r < 16; ++r) Cl[(64 * wm + 32 * m + crow(r, hi)) * CLD + 64 * wn + 32 * n + r32] = acc[m][n][r];
}

__device__ __forceinline__ void gemm_128x256_wide(const u16* __restrict__ A, int lda, const u16* __restrict__ Bt, int ldb, int KT, f32x16 (&acc)[4], char* lds) {
  const int tid = threadIdx.x, lane = tid & 63, wv = __builtin_amdgcn_readfirstlane(tid >> 6), r32 = lane & 31, hi = lane >> 5;
  const int rin = lane >> 3, cc = lane & 7;
  const u16* pa[2]; const u16* pb[4];
#pragma unroll
  for (int j = 0; j < 2; ++j) pa[j] = A + (size_t)(16 * wv + 8 * j + rin) * lda + 8 * (cc ^ (4 * j + (rin >> 1)));
#pragma unroll
  for (int i = 0; i < 4; ++i) pb[i] = Bt + (size_t)(32 * wv + 8 * i + rin) * ldb + 8 * (cc ^ (4 * (i & 1) + (rin >> 1)));
  const unsigned lb = __builtin_amdgcn_readfirstlane((unsigned)(uintptr_t)lds);
  const unsigned dA = lb + 2048 * wv, dB = lb + 16384 + 4096 * wv;
#define G_ISSUE(stage, kt_) do { const unsigned _so = (unsigned)(stage) * G_STAGE; const int _ko = (kt_) * 64;                     \
    dma16(pa[0] + _ko, dA + _so); dma16(pa[1] + _ko, dA + _so + 1024);                                                           \
    dma16(pb[0] + _ko, dB + _so); dma16(pb[1] + _ko, dB + _so + 1024); dma16(pb[2] + _ko, dB + _so + 2048); dma16(pb[3] + _ko, dB + _so + 3072); } while (0)
#pragma unroll
  for (int m = 0; m < 4; ++m)
#pragma unroll
    for (int r = 0; r < 16; ++r) acc[m][r] = 0.f;
  __syncthreads();
  G_ISSUE(0, 0);
  if (KT > 1) G_ISSUE(1, 1);
  const int xa = (r32 >> 1) & 7;
  const int aoff = r32 * 128, boff = 16384 + (32 * wv + r32) * 128;
  int st = 0;
  for (int kt = 0; kt < KT; ++kt) {
    if (kt + 1 < KT) asm volatile("s_waitcnt vmcnt(6)\n\ts_barrier" ::: "memory");
    else             asm volatile("s_waitcnt vmcnt(0)\n\ts_barrier" ::: "memory");
    const int s2 = st == 0 ? 2 : st - 1;
    if (kt + 2 < KT && wv < 4) G_ISSUE(s2, kt + 2);
    const char* buf = lds + st * G_STAGE;
    __builtin_amdgcn_s_setprio(1);
    bf16x8 fa[2][4], fb[2];
#define G_LDF(S, SET) do { const int _cb = ((2 * (S) + hi) ^ xa) << 4;                                                      \
      fa[SET][0] = *(const bf16x8*)(buf + aoff + _cb); fa[SET][1] = *(const bf16x8*)(buf + aoff + 4096 + _cb);              \
      fa[SET][2] = *(const bf16x8*)(buf + aoff + 8192 + _cb); fa[SET][3] = *(const bf16x8*)(buf + aoff + 12288 + _cb);      \
      fb[SET] = *(const bf16x8*)(buf + boff + _cb); } while (0)
#define G_MM(SET) do { acc[0] = MFMA32(fa[SET][0], fb[SET], acc[0]); acc[1] = MFMA32(fa[SET][1], fb[SET], acc[1]);         \
      acc[2] = MFMA32(fa[SET][2], fb[SET], acc[2]); acc[3] = MFMA32(fa[SET][3], fb[SET], acc[3]); } while (0)
    G_LDF(0, 0); __builtin_amdgcn_sched_barrier(0);
    G_LDF(1, 1); __builtin_amdgcn_sched_barrier(0); G_MM(0); __builtin_amdgcn_sched_barrier(0);
    G_LDF(2, 0); __builtin_amdgcn_sched_barrier(0); G_MM(1); __builtin_amdgcn_sched_barrier(0);
    G_LDF(3, 1); __builtin_amdgcn_sched_barrier(0); G_MM(0); __builtin_amdgcn_sched_barrier(0);
    G_MM(1);
#undef G_LDF
#undef G_MM
    __builtin_amdgcn_s_setprio(0);
    if (kt + 2 < KT && wv >= 4) G_ISSUE(s2, kt + 2);
    st = st == 2 ? 0 : st + 1;
  }
#undef G_ISSUE
  __syncthreads();
}

__device__ __forceinline__ void xcd_unit(int u, int per, int& panel, int& sub) {
  if (gridDim.x == 256) { const int x = u & 7, k = ((u & 255) >> 3) + 32 * (u >> 8); panel = x + 8 * (k / per); sub = k % per; }
  else { panel = u / per; sub = u % per; }
}
__device__ void phase1b(const Args& a, char* lds) {
  unsigned char* ws = a.ws;
  const int tid = threadIdx.x, lane = tid & 63, wv = tid >> 6;
  const u16* KEYS = (const u16*)(ws + WS_KEYS); const u16* WPQB = (const u16*)(ws + WS_WPQ); u16* WST = (u16*)(ws + WS_WST);
  const float* modp = (const float*)(ws + WS_MODP); float* BIASP = (float*)(ws + WS_BIASP);
  char* gl = lds + LDS_DATA; float* Cl = (float*)gl;
  float* gsl = (float*)(gl + 131584);
  for (int u = blockIdx.x; u < 256; u += gridDim.x) {
    const int hh = u >> 4, nt = (u >> 2) & 3, b = u & 3;
    f32x16 acc[2][2];
    gemm_128x256(KEYS + (size_t)hh * 16384, 128, WPQB + (size_t)(nt * 256) * 2048 + hh * 128, 2048, 2, acc, gl);
    acc_to_lds(acc, Cl);
    for (int j = tid; j < 512; j += 512) {
      const int which = j >> 8, k = nt * 256 + (j & 255), m = (which ? 3072 : 4096) + k;
      float v = a.b_ada[m];
#pragma unroll
      for (int ks = 0; ks < 8; ++ks) v += modp[(ks * 4 + b) * 6144 + m];
      gsl[j] = which ? v : a.g_norm2[k] * (1.f + v);
    }
    __syncthreads();
    for (int i = 0; i < 16; ++i) {
      const int row = wv * 16 + i; const size_t n = (size_t)hh * 128 + row;
      float bp = 0.f, w[4];
#pragma unroll
      for (int j = 0; j < 4; ++j) { const float v = Cl[row * CLD + 4 * lane + j]; w[j] = v * gsl[4 * lane + j]; bp += v * gsl[256 + 4 * lane + j]; }
      *(uint2*)(WST + ((size_t)b * 2048 + n) * 1024 + nt * 256 + 4 * lane) = make_uint2(pack2(w[0], w[1]), pack2(w[2], w[3]));
      bp = wave_sum(bp);
      if (lane == 0) BIASP[((size_t)nt * 4 + b) * 2048 + n] = bp;
    }
    __syncthreads();
  }
}

__device__ void phase2(const Args& a, char* lds) {
  unsigned char* ws = a.ws;
  const int tid = threadIdx.x, lane = tid & 63, wv = tid >> 6;
  const u16* H = (const u16*)(ws + WS_H); const u16* WIN = (const u16*)(ws + WS_WIN);
  u16* QA = (u16*)(ws + WS_QA); u16* KV = (u16*)(ws + WS_KV); u16* UACT = (u16*)(ws + WS_UACT); u16* GVT = (u16*)(ws + WS_GVT);
  float* SSQV = (float*)(ws + WS_SSQV); const float* CS = (const float*)(ws + WS_CS);
  char* gl = lds + LDS_DATA; float* Cl = (float*)gl;
  for (int u = blockIdx.x; u < 128 * 6; u += gridDim.x) {
    int mt, nt; xcd_unit(u, 6, mt, nt); const int R0 = mt * 128;
    f32x16 acc[2][2];
    gemm_128x256(H + (size_t)R0 * 1024, 1024, WIN + (size_t)(nt * 256) * 1024, 1024, 16, acc, gl);
    acc_to_lds(acc, Cl);
    __syncthreads();
    if (nt == 0) {
      for (int i = 0; i < 16; ++i) {
        const int row = wv * 16 + i; float v[4], ssq = 0.f;
#pragma unroll
        for (int j = 0; j < 4; ++j) { v[j] = Cl[row * CLD + lane + 64 * j]; ssq += v[j] * v[j]; }
        ssq = wave_sum(ssq);
        const float rstd = rsqrtf(ssq * (1.f / 256.f) + EPS);
#pragma unroll
        for (int j = 0; j < 4; ++j) { const int col = lane + 64 * j; QA[(size_t)(R0 + row) * 256 + col] = f2bf(v[j] * rstd * a.g_q_a[col]); }
      }
    } else if (nt == 1) {
#pragma unroll 4
      for (int i = 0; i < 16; ++i) {
        const int row = wv * 16 + i, tok = R0 + row;
        const float v0 = Cl[row * CLD + lane], v1 = Cl[row * CLD + 64 + lane];
        const float ssq = wave_sum(v0 * v0 + v1 * v1);
        const float rstd = rsqrtf(ssq * (1.f / 128.f) + EPS);
        KV[(size_t)tok * 192 + lane] = f2bf(v0 * rstd * a.g_kv_a[lane]);
        KV[(size_t)tok * 192 + 64 + lane] = f2bf(v1 * rstd * a.g_kv_a[64 + lane]);
        if (lane < 32) {
          const float x1 = Cl[row * CLD + 128 + lane], x2 = Cl[row * CLD + 160 + lane];
          const float cs = CS[(size_t)tok * 64 + lane], sn = CS[(size_t)tok * 64 + 32 + lane];
          KV[(size_t)tok * 192 + 128 + lane] = f2bf(x1 * cs - x2 * sn);
          KV[(size_t)tok * 192 + 160 + lane] = f2bf(x2 * cs + x1 * sn);
        }
      }
    } else if (nt < 4) {
      for (int i = 0; i < 16; ++i) {
        const int row = wv * 16 + i;
#pragma unroll
        for (int j = 0; j < 4; ++j) { const int col = lane + 64 * j; UACT[(size_t)(R0 + row) * 512 + (nt - 2) * 256 + col] = f2bf(gelu_exact(Cl[row * CLD + col])); }
      }
    } else {
      for (int i = 0; i < 16; ++i) {
        const int row = wv * 16 + i; float ssq = 0.f;
#pragma unroll
        for (int j = 0; j < 4; ++j) { const int col = lane + 64 * j; const float g = gelu_exact(Cl[row * CLD + col]); const float gb = bflo((unsigned)f2bf(g)); ssq += gb * gb; Cl[row * CLD + col] = gb; }
        ssq = wave_sum(ssq);
        if (lane == 0) SSQV[(size_t)(R0 + row) * 2 + (nt - 4)] = ssq;
      }
      __syncthreads();
      for (int i = 0; i < 32; ++i) {
        const int c = wv * 32 + i;
        const float g0 = Cl[(2 * lane) * CLD + c], g1 = Cl[(2 * lane + 1) * CLD + c];
        *(unsigned*)(GVT + ((size_t)mt * 512 + (nt - 4) * 256 + c) * 128 + 2 * lane) = pack2(g0, g1);
      }
    }
    __syncthreads();
  }
}

__device__ void phase3(const Args& a, char* lds) {
  unsigned char* ws = a.ws;
  const int tid = threadIdx.x, lane = tid & 63, wv = tid >> 6, r32 = lane & 31, hi = lane >> 5;
  const u16* QA = (const u16*)(ws + WS_QA); const u16* WQ2 = (const u16*)(ws + WS_WQ2);
  u16* Q = (u16*)(ws + WS_Q); const float* CS = (const float*)(ws + WS_CS);
  const u16* UACT = (const u16*)(ws + WS_UACT); const u16* GVT = (const u16*)(ws + WS_GVT); const u16* WSG = (const u16*)(ws + WS_WSG);
  const float* SSQV = (const float*)(ws + WS_SSQV); u16* Y = (u16*)(ws + WS_Y);
  char* gl = lds + LDS_DATA; float* Cl = (float*)gl;
  for (int u = blockIdx.x; u < 384; u += gridDim.x) {
    {
      int mt, nt; xcd_unit(u, 3, mt, nt); const int R0 = mt * 128;
      f32x16 acc[2][2];
      gemm_128x256(QA + (size_t)R0 * 256, 256, WQ2 + (size_t)(nt * 256) * 256, 256, 4, acc, gl);
      acc_to_lds(acc, Cl);
      __syncthreads();
      if (nt < 2) {
        for (int i = 0; i < 16; ++i) {
          const int row = wv * 16 + i;
#pragma unroll
          for (int j = 0; j < 4; ++j) { const int n = nt * 256 + lane + 64 * j; Q[(size_t)(R0 + row) * 768 + (n >> 7) * 192 + (n & 127)] = f2bf(Cl[row * CLD + lane + 64 * j]); }
        }
      } else {
#pragma unroll 4
        for (int i = 0; i < 16; ++i) {
          const int row = wv * 16 + i, tok = R0 + row;
#pragma unroll
          for (int j = 0; j < 2; ++j) {
            const int idx = lane + 64 * j, h = idx >> 5, jj = idx & 31;
            const float x1 = Cl[row * CLD + h * 64 + jj], x2 = Cl[row * CLD + h * 64 + 32 + jj];
            const float cs = CS[(size_t)tok * 64 + jj], sn = CS[(size_t)tok * 64 + 32 + jj];
            Q[(size_t)tok * 768 + h * 192 + 128 + jj] = f2bf(x1 * cs - x2 * sn);
            Q[(size_t)tok * 768 + h * 192 + 160 + jj] = f2bf(x2 * cs + x1 * sn);
          }
        }
      }
      __syncthreads();
    }
  }
  for (int su = blockIdx.x; su < 256; su += gridDim.x) {
    {
      const int c = su >> 1, ph = su & 1;
      float* rs = (float*)gl;
      float* Yl = (float*)(gl + 512);
      __syncthreads();
      if (tid < 128) { const size_t t = (size_t)c * 128 + tid; rs[tid] = rsqrtf((SSQV[t * 2] + SSQV[t * 2 + 1]) * (1.f / 512.f) + EPS); }
      __syncthreads();
      const int h = wv >> 1, dh = wv & 1;
      f32x16 acc[2][2];
#pragma unroll
      for (int m = 0; m < 2; ++m)
#pragma unroll
        for (int n = 0; n < 2; ++n)
#pragma unroll
          for (int r = 0; r < 16; ++r) acc[m][n][r] = 0.f;
      for (int s = 0; s < 8; ++s) {
        const int q0 = 16 * s + 8 * hi;
        bf16x8 af[2], bfr[2];
#pragma unroll
        for (int m = 0; m < 2; ++m) af[m] = *(const bf16x8*)(WSG + ((size_t)h * 128 + ph * 64 + 32 * m + r32) * 128 + q0);
        float rq[8];
#pragma unroll
        for (int j = 0; j < 8; ++j) rq[j] = rs[q0 + j];
#pragma unroll
        for (int n = 0; n < 2; ++n) {
          const u32x4 w = *(const u32x4*)(GVT + ((size_t)c * 512 + h * 128 + dh * 64 + 32 * n + r32) * 128 + q0);
          u32x4 o;
#pragma unroll
          for (int k = 0; k < 4; ++k) o[k] = pack2(bflo(w[k]) * rq[2 * k], bfhi(w[k]) * rq[2 * k + 1]);
          bfr[n] = __builtin_bit_cast(bf16x8, o);
        }
#pragma unroll
        for (int m = 0; m < 2; ++m)
#pragma unroll
          for (int n = 0; n < 2; ++n) acc[m][n] = MFMA32(af[m], bfr[n], acc[m][n]);
      }
#pragma unroll
      for (int m = 0; m < 2; ++m)
#pragma unroll
        for (int n = 0; n < 2; ++n)
#pragma unroll
          for (int r = 0; r < 16; ++r) {
            const int pl = 32 * m + crow(r, hi), col = h * 128 + dh * 64 + 32 * n + r32;
            const size_t tok = (size_t)c * 128 + ph * 64 + pl;
            const float mix = acc[m][n][r] * a.g_sg[col] + a.b_sg[h * 128 + ph * 64 + pl];
            Yl[pl * 513 + col] = bflo((unsigned)UACT[tok * 512 + col]) * mix;
          }
      __syncthreads();
      for (int i = 0; i < 8; ++i) {
        const int pl = wv * 8 + i; const size_t tok = (size_t)c * 128 + ph * 64 + pl;
        float v[8], ssq = 0.f;
#pragma unroll
        for (int j = 0; j < 8; ++j) { v[j] = Yl[pl * 513 + lane + 64 * j]; ssq += v[j] * v[j]; }
        ssq = wave_sum(ssq);
        const float rstd = rsqrtf(ssq * (1.f / 512.f) + EPS);
#pragma unroll
        for (int j = 0; j < 8; ++j) { const int col = lane + 64 * j; Y[tok * 1024 + 512 + col] = f2bf(v[j] * rstd * a.g_sg_out[col]); }
      }
      __syncthreads();
    }
  }
}

constexpr float ATT_SCALE = 0.07216878364870322f;
constexpr float ATT_THR = 8.f;
constexpr int KVBUF = 24576;
#define SBAR() __builtin_amdgcn_sched_barrier(0)
__device__ __forceinline__ unsigned cvtpk(float lo, float hi) { unsigned r; asm volatile("v_cvt_pk_bf16_f32 %0, %1, %2" : "=v"(r) : "v"(lo), "v"(hi)); return r; }
__device__ __forceinline__ unsigned off_a(unsigned row, unsigned ch) { return 2048u * (row >> 3) + 512u * (ch >> 2) + 64u * (row & 7) + 16u * ((ch & 3) ^ ((row >> 2) & 3)); }

__device__ __forceinline__ void partialSM(f32x16& p0, f32x16& p1, float& m_reg, float& mn, float& alpha) {
  constexpr float C = ATT_SCALE * 1.4426950408889634f;
  float pmax = p0[0];
#pragma unroll
  for (int r = 1; r < 16; ++r) pmax = fmaxf(pmax, p0[r]);
#pragma unroll
  for (int r = 0; r < 16; ++r) pmax = fmaxf(pmax, p1[r]);
  { auto rr = __builtin_amdgcn_permlane32_swap(__float_as_uint(pmax), __float_as_uint(pmax), false, false);
    pmax = fmaxf(__uint_as_float(rr[0]), __uint_as_float(rr[1])); }
  if (__builtin_expect(__all(pmax - m_reg <= ATT_THR / ATT_SCALE), 1)) { mn = m_reg; alpha = 1.f; }
  else { mn = fmaxf(m_reg, pmax); alpha = __builtin_amdgcn_exp2f((m_reg - mn) * C); m_reg = mn; }
  const float mnC = -mn * C;
#pragma unroll
  for (int r = 0; r < 16; ++r) p0[r] = fmaf(p0[r], C, mnC);
#pragma unroll
  for (int r = 0; r < 16; ++r) p1[r] = fmaf(p1[r], C, mnC);
#pragma unroll
  for (int r = 0; r < 16; ++r) p0[r] = __builtin_amdgcn_exp2f(p0[r]);
}
__device__ __forceinline__ void finishSM(f32x16& p0, f32x16& p1, float alpha, float& l_reg, bf16x8& pa0, bf16x8& pa1, bf16x8& pa2, bf16x8& pa3) {
#pragma unroll
  for (int r = 0; r < 16; ++r) p1[r] = __builtin_amdgcn_exp2f(p1[r]);
  float ps = 0;
#pragma unroll
  for (int r = 0; r < 16; ++r) ps += p0[r];
#pragma unroll
  for (int r = 0; r < 16; ++r) ps += p1[r];
  { auto rr = __builtin_amdgcn_permlane32_swap(__float_as_uint(ps), __float_as_uint(ps), false, false);
    ps = __uint_as_float(rr[0]) + __uint_as_float(rr[1]); }
  l_reg = l_reg * alpha + ps;
#define PK4(P, BASE, OUT) do { unsigned a0 = cvtpk(P[BASE + 0], P[BASE + 1]), a1 = cvtpk(P[BASE + 2], P[BASE + 3]);   \
    unsigned b0 = cvtpk(P[BASE + 4], P[BASE + 5]), b1 = cvtpk(P[BASE + 6], P[BASE + 7]);                              \
    auto r0 = __builtin_amdgcn_permlane32_swap(a0, b0, false, false); auto r1 = __builtin_amdgcn_permlane32_swap(a1, b1, false, false); \
    u32x4 w = {r0[0], r1[0], r0[1], r1[1]}; OUT = __builtin_bit_cast(bf16x8, w); } while (0)
  PK4(p0, 0, pa0); PK4(p0, 8, pa1); PK4(p1, 0, pa2); PK4(p1, 8, pa3);
#undef PK4
}
__device__ __forceinline__ void qkt192(f32x16& p0, f32x16& p1, const char* kb, const bf16x8* qr, int ke, int ko, int kr) {
#pragma unroll
  for (int r = 0; r < 16; ++r) { p0[r] = 0.f; p1[r] = 0.f; }
#pragma unroll
  for (int d0 = 0; d0 < 8; ++d0) {
    const int o = ((d0 & 1) ? ko : ke) + 512 * (d0 >> 1);
    const bf16x8 b0 = *(const bf16x8*)(kb + o), b1 = *(const bf16x8*)(kb + o + 8192);
    p0 = MFMA32(b0, qr[d0], p0); p1 = MFMA32(b1, qr[d0], p1);
  }
#pragma unroll
  for (int d1 = 0; d1 < 4; ++d1) {
    const int o = 16384 + (kr ^ (32 * d1));
    const bf16x8 b0 = *(const bf16x8*)(kb + o), b1 = *(const bf16x8*)(kb + o + 4096);
    p0 = MFMA32(b0, qr[8 + d1], p0); p1 = MFMA32(b1, qr[8 + d1], p1);
  }
}
template <int OFF> __device__ __forceinline__ s16x4 tr_read(int vb) {
  s16x4 r; asm volatile("ds_read_b64_tr_b16 %0, %1 offset:%2" : "=&v"(r) : "v"(vb), "i"(OFF) : "memory"); return r;
}
template <int C> __device__ __forceinline__ void pv_one(f32x16& od, int vb0, int vb1, bf16x8 pa0, bf16x8 pa1, bf16x8 pa2, bf16x8 pa3) {
  const s16x4 l0 = tr_read<512 * C>(vb0), h0 = tr_read<512 * C>(vb1), l1 = tr_read<4096 + 512 * C>(vb0), h1 = tr_read<4096 + 512 * C>(vb1);
  const s16x4 l2 = tr_read<8192 + 512 * C>(vb0), h2 = tr_read<8192 + 512 * C>(vb1), l3 = tr_read<12288 + 512 * C>(vb0), h3 = tr_read<12288 + 512 * C>(vb1);
  asm volatile("s_waitcnt lgkmcnt(0)" ::: "memory"); SBAR();
#define PKV(L, H) (bf16x8){L[0], L[1], L[2], L[3], H[0], H[1], H[2], H[3]}
  od = MFMA32(pa0, PKV(l0, h0), od); od = MFMA32(pa1, PKV(l1, h1), od);
  od = MFMA32(pa2, PKV(l2, h2), od); od = MFMA32(pa3, PKV(l3, h3), od);
#undef PKV
}
__device__ __forceinline__ void pv_all(f32x16* o, int vb0, int vb1, bf16x8 pa0, bf16x8 pa1, bf16x8 pa2, bf16x8 pa3) {
  pv_one<0>(o[0], vb0, vb1, pa0, pa1, pa2, pa3); pv_one<1>(o[1], vb0, vb1, pa0, pa1, pa2, pa3);
  pv_one<2>(o[2], vb0, vb1, pa0, pa1, pa2, pa3); pv_one<3>(o[3], vb0, vb1, pa0, pa1, pa2, pa3);
}

__device__ void phase4(const Args& a, char* lds) {
  unsigned char* ws = a.ws;
  const int tid = threadIdx.x, wid = tid >> 6, lane = tid & 63, r32 = lane & 31, hi = lane >> 5;
  const u16* Qg = (const u16*)(ws + WS_Q); const u16* KVg = (const u16*)(ws + WS_KV); const u16* WUV = (const u16*)(ws + WS_WUV);
  u16* Y = (u16*)(ws + WS_Y);
  char* gl = lds + LDS_DATA;
  char* kvl = gl;
  float* wsl = (float*)(gl + 2 * KVBUF) + wid * 64; float* li_l = wsl; float* al_l = wsl + 32;
  char* Ol = gl + 2 * KVBUF + 2048 + wid * 8704;
  float* Yl = (float*)gl;
  const int head = wid >> 1, qh = wid & 1;
  int sdst[3];
#pragma unroll
  for (int j = 0; j < 3; ++j) { const int id = tid + 512 * j, key = id / 24, ch = id % 24;
    sdst[j] = ch < 16 ? (int)off_a(key, ch) : 16384 + key * 128 + (((ch - 16) ^ ((key >> 1) & 7)) << 4); }
  const int xq = (r32 >> 2) & 3;
  const int ke = 2048 * (r32 >> 3) + 64 * (r32 & 7) + 16 * (hi ^ xq), ko = 2048 * (r32 >> 3) + 64 * (r32 & 7) + 16 * ((2 + hi) ^ xq);
  const int kr = r32 * 128 + ((hi ^ ((r32 >> 1) & 7)) << 4);
  const int tb = lane >> 4 & 1, tq = (lane & 15) >> 2, tp = lane & 3;
  const int vbl = 2048 * hi + 64 * tq + 32 * (tb ^ hi) + 8 * (tp & 1);
  const int lbase = (int)(uintptr_t)kvl;
  const int vb0 = lbase + vbl + 16 * (tp >> 1), vb1 = lbase + vbl + 256 + 16 * ((tp >> 1) ^ 1);
  for (int u = blockIdx.x; u < 256; u += gridDim.x) {
    const int b = u >> 6, qb = u & 63;
    const size_t tok0 = (size_t)b * SEQ + qb * 64 + qh * 32;
    const u16* KVb = KVg + (size_t)b * SEQ * 192;
    float m_reg = -1e30f, l_reg = 0.f; f32x16 o[4]; bf16x8 qr[12];
#pragma unroll
    for (int d = 0; d < 4; ++d)
#pragma unroll
      for (int r = 0; r < 16; ++r) o[d][r] = 0.f;
    { const u16* Qw = Qg + (tok0 + r32) * 768 + head * 192 + hi * 8;
#pragma unroll
      for (int d0 = 0; d0 < 12; ++d0) qr[d0] = *(const bf16x8*)(Qw + d0 * 16); }
    u32x4 st0[3];
#define SLOAD(S, k0) do { const u16* _p = KVb + (size_t)(k0) * 192 + tid * 8; S[0] = *(const u32x4*)_p; S[1] = *(const u32x4*)(_p + 4096); S[2] = *(const u32x4*)(_p + 8192); } while (0)
#define SWRITE(bufi, S) do { char* _d = kvl + (bufi) * KVBUF; *(u32x4*)(_d + sdst[0]) = S[0]; *(u32x4*)(_d + sdst[1]) = S[1]; *(u32x4*)(_d + sdst[2]) = S[2]; } while (0)
#define RESC(al) do { if (__any((al) < 1.f)) { if (hi == 0) al_l[r32] = (al); asm volatile("s_waitcnt lgkmcnt(0)" ::: "memory"); \
    _Pragma("unroll") for (int d = 0; d < 4; ++d) _Pragma("unroll") for (int r = 0; r < 16; ++r) o[d][r] *= al_l[crow(r, hi)]; } } while (0)
    constexpr int NT = SEQ / 64;
    __syncthreads();
    SLOAD(st0, 0); SWRITE(0, st0); SLOAD(st0, 64); __syncthreads();
    for (int j = 0; j < NT; ++j) {
      const int bo = (j & 1) * KVBUF;
      f32x16 p0, p1; float mn, al; bf16x8 pa0, pa1, pa2, pa3;
      qkt192(p0, p1, kvl + bo, qr, ke, ko, kr);
      partialSM(p0, p1, m_reg, mn, al);
      RESC(al);
      finishSM(p0, p1, al, l_reg, pa0, pa1, pa2, pa3);
      if (j + 1 < NT) { SWRITE((j + 1) & 1, st0); if (j + 2 < NT) SLOAD(st0, (j + 2) * 64); }
      const unsigned cit = ((unsigned)(u * 64 + j) << 9) | (unsigned)tid;
      const bool cisv = cit >= 4194304u; const unsigned cio = cisv ? cit - 4194304u : cit;
      const float4 cf = *(const float4*)((cisv ? a.peer_v : a.peer_u) + (size_t)cio * 4);
      SBAR();
      pv_all(o, vb0 + bo, vb1 + bo, pa0, pa1, pa2, pa3);
      { const float csc = cisv ? PEER_SV : PEER_SU;
        int cp = __builtin_amdgcn_cvt_pk_fp8_f32(cf.x * csc, cf.y * csc, 0, false); cp = __builtin_amdgcn_cvt_pk_fp8_f32(cf.z * csc, cf.w * csc, cp, true);
        *(int*)(ws + (cisv ? WS_VB : WS_UB) + (size_t)cio * 4) = cp; }
      __syncthreads();
    }
#undef SLOAD
#undef SWRITE
#undef RESC
    int r32e = r32, hie = hi, lne = lane;
    asm volatile("" : "+v"(r32e), "+v"(hie), "+v"(lne));
    if (hie == 0) li_l[r32e] = l_reg;
    asm volatile("s_waitcnt lgkmcnt(0)" ::: "memory");
#pragma unroll
    for (int r = 0; r < 16; ++r) {
      const int q = crow(r, hie); const float rl = __builtin_amdgcn_rcpf(li_l[q]);
#pragma unroll
      for (int d = 0; d < 4; ++d) *(u16*)(Ol + q * 272 + (32 * d + r32e) * 2) = f2bf(o[d][r] * rl);
    }
    asm volatile("s_waitcnt lgkmcnt(0)" ::: "memory");
    f32x16 y[4];
#pragma unroll
    for (int n = 0; n < 4; ++n)
#pragma unroll
      for (int r = 0; r < 16; ++r) y[n][r] = 0.f;
    const u16* wuv = WUV + ((size_t)head * 128 + r32e) * 128 + 8 * hie;
#pragma unroll 2
    for (int s = 0; s < 8; ++s) {
      const bf16x8 af = *(const bf16x8*)(Ol + r32e * 272 + (16 * s + 8 * hie) * 2);
#pragma unroll
      for (int n = 0; n < 4; ++n) {
        const bf16x8 bw = *(const bf16x8*)(wuv + 32 * n * 128 + 16 * s);
        y[n] = MFMA32(af, bw, y[n]);
      }
    }
    __syncthreads();
#pragma unroll
    for (int n = 0; n < 4; ++n)
#pragma unroll
      for (int r = 0; r < 16; ++r) Yl[(qh * 32 + crow(r, hie)) * 513 + head * 128 + 32 * n + r32e] = y[n][r];
    __syncthreads();
    for (int i = 0; i < 8; ++i) {
      const int pl = wid * 8 + i; const size_t tok = (size_t)b * SEQ + qb * 64 + pl;
      float v[8], ssq = 0.f;
#pragma unroll
      for (int jj = 0; jj < 8; ++jj) { v[jj] = Yl[pl * 513 + lne + 64 * jj]; ssq += v[jj] * v[jj]; }
      ssq = wave_sum(ssq);
      const float rstd = rsqrtf(ssq * (1.f / 512.f) + EPS);
#pragma unroll
      for (int jj = 0; jj < 8; ++jj) { const int col = lne + 64 * jj; Y[tok * 1024 + col] = f2bf(v[jj] * rstd * a.g_attn_out[col]); }
    }
    __syncthreads();
  }
}

__device__ void phase5(const Args& a, char* lds) {
  unsigned char* ws = a.ws;
  const int tid = threadIdx.x, lane = tid & 63, wv = tid >> 6;
  const u16* Y = (const u16*)(ws + WS_Y); const u16* WO = (const u16*)(ws + WS_WO);
  float* X1 = (float*)(ws + WS_X1); float* SSQ = (float*)(ws + WS_SSQ); const float* mod = (const float*)(ws + WS_MOD);
  u16* X1B = (u16*)(ws + WS_H);
  char* gl = lds + LDS_DATA; float* Cl = (float*)gl;
  for (int u = blockIdx.x; u < 128 * 4; u += gridDim.x) {
    int mt, nt; xcd_unit(u, 4, mt, nt); const int R0 = mt * 128, b = R0 >> 12;
    f32x16 acc[2][2];
    gemm_128x256(Y + (size_t)R0 * 1024, 1024, WO + (size_t)(nt * 256) * 1024, 1024, 16, acc, gl);
    acc_to_lds(acc, Cl);
    __syncthreads();
    float2 g1[2];
#pragma unroll
    for (int j = 0; j < 2; ++j) g1[j] = *(const float2*)(mod + b * 6144 + 2048 + nt * 256 + 2 * lane + 128 * j);
    for (int i0 = 0; i0 < 16; i0 += 8) {
      float2 xv[8][2];
#pragma unroll
      for (int i = 0; i < 8; ++i)
#pragma unroll
        for (int j = 0; j < 2; ++j) xv[i][j] = *(const float2*)(a.x + (size_t)(R0 + wv * 16 + i0 + i) * 1024 + nt * 256 + 2 * lane + 128 * j);
#pragma unroll
      for (int i = 0; i < 8; ++i) {
        const int row = wv * 16 + i0 + i; const size_t tok = R0 + row; float ssq = 0.f;
#pragma unroll
        for (int j = 0; j < 2; ++j) {
          const int col = nt * 256 + 2 * lane + 128 * j;
          const float v0 = xv[i][j].x + g1[j].x * Cl[row * CLD + 2 * lane + 128 * j], v1 = xv[i][j].y + g1[j].y * Cl[row * CLD + 2 * lane + 128 * j + 1];
          *(float2*)(X1 + tok * 1024 + col) = make_float2(v0, v1); *(unsigned*)(X1B + tok * 1024 + col) = pack2(v0, v1); ssq += v0 * v0 + v1 * v1;
        }
        ssq = wave_sum(ssq);
        if (lane == 0) SSQ[tok * 4 + nt] = ssq;
      }
    }
    __syncthreads();
  }
}
__device__ void phase5b(const Args& a) {
  unsigned char* ws = a.ws;
  const int tid = threadIdx.x, lane = tid & 63, wv = tid >> 6;
  const float* X1 = (const float*)(ws + WS_X1); const float* SSQ = (const float*)(ws + WS_SSQ); const float* mod = (const float*)(ws + WS_MOD);
  u16* H = (u16*)(ws + WS_H);
  for (int u = blockIdx.x; u < T / 64; u += gridDim.x) {
    const int b = u >> 6;
    float4 sh[4], sc[4], g[4];
#pragma unroll
    for (int j = 0; j < 4; ++j) {
      const int col = j * 256 + lane * 4;
      sh[j] = *(const float4*)(mod + b * 6144 + 3072 + col); sc[j] = *(const float4*)(mod + b * 6144 + 4096 + col); g[j] = *(const float4*)(a.g_norm2 + col);
    }
    for (int i = 0; i < 8; ++i) {
      const size_t r = (size_t)u * 64 + wv * 8 + i;
      const float4 sq = *(const float4*)(SSQ + r * 4);
      const float rstd = rsqrtf((sq.x + sq.y + sq.z + sq.w) * (1.f / 1024.f) + EPS);
#pragma unroll
      for (int j = 0; j < 4; ++j) {
        const int col = j * 256 + lane * 4;
        const float4 xv = *(const float4*)(X1 + r * 1024 + col);
        const float h0 = xv.x * rstd * g[j].x * (1.f + sc[j].x) + sh[j].x, h1 = xv.y * rstd * g[j].y * (1.f + sc[j].y) + sh[j].y;
        const float h2 = xv.z * rstd * g[j].z * (1.f + sc[j].z) + sh[j].z, h3 = xv.w * rstd * g[j].w * (1.f + sc[j].w) + sh[j].w;
        uint2 o = {pack2(h0, h1), pack2(h2, h3)};
        *(uint2*)(H + r * 1024 + col) = o;
      }
    }
  }
}

__device__ __forceinline__ float vmaxf(float a, float b) { float r; asm("v_max_f32 %0, %1, %2" : "=v"(r) : "v"(a), "v"(b)); return r; }
__device__ __forceinline__ float vminf(float a, float b) { float r; asm("v_min_f32 %0, %1, %2" : "=v"(r) : "v"(a), "v"(b)); return r; }
#define TK_CE(x, y) do { const float _h = vmaxf((x), (y)); (y) = vminf((x), (y)); (x) = _h; } while (0)
#define TK_SORT16(t) do { TK_CE(t[0], t[1]); TK_CE(t[2], t[3]); TK_CE(t[0], t[2]); TK_CE(t[1], t[3]); TK_CE(t[1], t[2]); TK_CE(t[4], t[5]); TK_CE(t[6], t[7]); TK_CE(t[4], t[6]); TK_CE(t[5], t[7]); TK_CE(t[5], t[6]); TK_CE(t[0], t[4]); TK_CE(t[2], t[6]); TK_CE(t[2], t[4]); TK_CE(t[1], t[5]); TK_CE(t[3], t[7]); TK_CE(t[3], t[5]); TK_CE(t[1], t[2]); TK_CE(t[3], t[4]); TK_CE(t[5], t[6]); TK_CE(t[8], t[9]); TK_CE(t[10], t[11]); TK_CE(t[8], t[10]); TK_CE(t[9], t[11]); TK_CE(t[9], t[10]); TK_CE(t[12], t[13]); TK_CE(t[14], t[15]); TK_CE(t[12], t[14]); TK_CE(t[13], t[15]); TK_CE(t[13], t[14]); TK_CE(t[8], t[12]); TK_CE(t[10], t[14]); TK_CE(t[10], t[12]); TK_CE(t[9], t[13]); TK_CE(t[11], t[15]); TK_CE(t[11], t[13]); TK_CE(t[9], t[10]); TK_CE(t[11], t[12]); TK_CE(t[13], t[14]); TK_CE(t[0], t[8]); TK_CE(t[4], t[12]); TK_CE(t[4], t[8]); TK_CE(t[2], t[10]); TK_CE(t[6], t[14]); TK_CE(t[6], t[10]); TK_CE(t[2], t[4]); TK_CE(t[6], t[8]); TK_CE(t[10], t[12]); TK_CE(t[1], t[9]); TK_CE(t[5], t[13]); TK_CE(t[5], t[9]); TK_CE(t[3], t[11]); TK_CE(t[7], t[15]); TK_CE(t[7], t[11]); TK_CE(t[3], t[5]); TK_CE(t[7], t[9]); TK_CE(t[11], t[13]); TK_CE(t[1], t[2]); TK_CE(t[3], t[4]); TK_CE(t[5], t[6]); TK_CE(t[7], t[8]); TK_CE(t[9], t[10]); TK_CE(t[11], t[12]); TK_CE(t[13], t[14]); } while (0)
#define TK_BMERGE16(t) do { TK_CE(t[0], t[8]); TK_CE(t[1], t[9]); TK_CE(t[2], t[10]); TK_CE(t[3], t[11]); TK_CE(t[4], t[12]); TK_CE(t[5], t[13]); TK_CE(t[6], t[14]); TK_CE(t[7], t[15]); TK_CE(t[0], t[4]); TK_CE(t[1], t[5]); TK_CE(t[2], t[6]); TK_CE(t[3], t[7]); TK_CE(t[8], t[12]); TK_CE(t[9], t[13]); TK_CE(t[10], t[14]); TK_CE(t[11], t[15]); TK_CE(t[0], t[2]); TK_CE(t[1], t[3]); TK_CE(t[4], t[6]); TK_CE(t[5], t[7]); TK_CE(t[8], t[10]); TK_CE(t[9], t[11]); TK_CE(t[12], t[14]); TK_CE(t[13], t[15]); TK_CE(t[0], t[1]); TK_CE(t[2], t[3]); TK_CE(t[4], t[5]); TK_CE(t[6], t[7]); TK_CE(t[8], t[9]); TK_CE(t[10], t[11]); TK_CE(t[12], t[13]); TK_CE(t[14], t[15]); } while (0)
#define TK_MERGE(A, B) do { _Pragma("unroll") for (int _i = 0; _i < 16; ++_i) A[_i] = vmaxf(A[_i], B[15 - _i]); TK_BMERGE16(A); } while (0)
__constant__ unsigned long long TK_I[4] = {0x0000000000000000ull, 0x0007744411111111ull, 0x0006655333322222ull, 0x00000000FEDCBA98ull};
__constant__ unsigned long long TK_J[4] = {0xFEDCBA9876543210ull, 0x0001021076543210ull, 0x0001010321043210ull, 0x0000000000000000ull};
__constant__ int TK_N[4] = {16, 13, 13, 8};
#define TOP_INSERT(t, v) do { float _v = (v); _Pragma("unroll") for (int _i = 0; _i < 16; ++_i) { const float _h = vmaxf(t[_i], _v); _v = vminf(t[_i], _v); t[_i] = _h; } } while (0)

__device__ void phase6(const Args& a, char* lds) {
  unsigned char* ws = a.ws;
  const int tid = threadIdx.x, lane = tid & 63, wv = tid >> 6, r32 = lane & 31, hi = lane >> 5;
  const u16* H = (const u16*)(ws + WS_H); const u16* WST = (const u16*)(ws + WS_WST);
  float* TOPS = (float*)(ws + WS_TOPK);
  const float* BIASP = (const float*)(ws + WS_BIASP); const float* SSQ = (const float*)(ws + WS_SSQ);
  char* gl = lds + LDS_DATA;
  for (int u = blockIdx.x; u < 16 * 64; u += gridDim.x) {
    int tb, hh; xcd_unit(u, 16, tb, hh);
    const int b = tb >> 4;
    f32x16 sc[4];
    gemm_128x256_wide(WST + ((size_t)b * 2048 + hh * 128) * 1024, 1024, H + (size_t)tb * 256 * 1024, 1024, 16, sc, gl);
    float* bl = (float*)gl;
    if (tid < 128) bl[tid] = BIASP[((size_t)0 * 4 + b) * 2048 + hh * 128 + tid] + BIASP[((size_t)1 * 4 + b) * 2048 + hh * 128 + tid]
                           + BIASP[((size_t)2 * 4 + b) * 2048 + hh * 128 + tid] + BIASP[((size_t)3 * 4 + b) * 2048 + hh * 128 + tid];
    const float4 sq = *(const float4*)(SSQ + (size_t)(tb * 256 + 32 * wv + r32) * 4);
    const float rstd = rsqrtf((sq.x + sq.y + sq.z + sq.w) * (1.f / 1024.f) + EPS);
    __syncthreads();
    float g0[16], g1[16], g2[16], g3[16], p[16];
#pragma unroll
    for (int r = 0; r < 16; ++r) {
      const unsigned key = crow(r, hi);
      g0[r] = __uint_as_float((__float_as_uint(fmaf(sc[0][r], rstd, bl[key])) & ~127u) | key);
      g1[r] = __uint_as_float((__float_as_uint(fmaf(sc[1][r], rstd, bl[32 + key])) & ~127u) | (32u + key));
      g2[r] = __uint_as_float((__float_as_uint(fmaf(sc[2][r], rstd, bl[64 + key])) & ~127u) | (64u + key));
      g3[r] = __uint_as_float((__float_as_uint(fmaf(sc[3][r], rstd, bl[96 + key])) & ~127u) | (96u + key));
    }
    TK_SORT16(g0); TK_SORT16(g1); TK_SORT16(g2); TK_SORT16(g3);
    TK_MERGE(g0, g1); TK_MERGE(g2, g3); TK_MERGE(g0, g2);
#pragma unroll
    for (int i = 0; i < 16; ++i) {
      auto rr = __builtin_amdgcn_permlane32_swap(__float_as_uint(g0[i]), __float_as_uint(g0[i]), false, false);
      p[i] = __uint_as_float(hi ? rr[0] : rr[1]);
    }
    TK_MERGE(g0, p);
    if (hi == 0) {
      float* dst = TOPS + ((size_t)(tb * 256 + 32 * wv + r32) * 16 + hh) * 16;
#pragma unroll
      for (int i = 0; i < 16; i += 4) *(float4*)(dst + i) = make_float4(g0[i], g0[i + 1], g0[i + 2], g0[i + 3]);
    }
  }
}

typedef __attribute__((ext_vector_type(4))) float f32x4;
#define MFMA4(a, b, c) __builtin_amdgcn_mfma_f32_4x4x4bf16_1k((a), (b), (c), 0, 0, 0)
constexpr int P7_VROW = 2112, P7_VBUF = 4 * P7_VROW;
constexpr int P7_RING = 64;
constexpr int P7_ENT  = P7_RING + 8 * 2 * P7_VBUF;
constexpr int P7_CNT  = P7_ENT + 8 * 2048;
static_assert(P7_CNT + 8 * 256 <= LDS_BYTES, "phase 7 LDS map");
__device__ __forceinline__ float sel4(const f32x4& d, int k) { return k == 0 ? d[0] : (k == 1 ? d[1] : (k == 2 ? d[2] : d[3])); }
__device__ __forceinline__ unsigned fp8x2_bf16(unsigned x, float sc, bool hi) {
  return hi ? __builtin_bit_cast(unsigned, __builtin_amdgcn_cvt_scalef32_pk_bf16_fp8(x, sc, true)) : __builtin_bit_cast(unsigned, __builtin_amdgcn_cvt_scalef32_pk_bf16_fp8(x, sc, false));
}

__device__ void phase7(const Args& a, char* lds) {
  unsigned char* ws = a.ws;
  const int tid = threadIdx.x, lane = tid & 63, wv = __builtin_amdgcn_readfirstlane(tid >> 6), blk = lane >> 2, j4 = lane & 3;
  const u16* H = (const u16*)(ws + WS_H); const unsigned char* U8 = ws + WS_UB; const unsigned char* V8 = ws + WS_VB;
  const float* TOPS = (const float*)(ws + WS_TOPK); const float* X1 = (const float*)(ws + WS_X1); const float* mod = (const float*)(ws + WS_MOD);
  const float* SSQ = (const float*)(ws + WS_SSQ);
  const unsigned lbase = (unsigned)(uintptr_t)lds;
  char* ring = lds + P7_RING + wv * 2 * P7_VBUF;
  unsigned* ents = (unsigned*)(lds + P7_ENT + wv * 2048);
  int* cntw = (int*)(lds + P7_CNT + wv * 256);
  const int trb = (int)(lbase + P7_RING + wv * 2 * P7_VBUF) + ((lane & 15) >> 2) * P7_VROW + 32 * (lane >> 4) + 8 * (lane & 3);
  const int NWV = gridDim.x * 8;
  for (int qd = blockIdx.x * 8 + wv; qd < T / 4; qd += NWV) {
    const int tok0 = qd * 4, b = tok0 >> 12;
    float* TS = (float*)ring;
#pragma unroll
    for (int i = 0; i < 4; ++i) *(float4*)(TS + 256 * i + 4 * lane) = *(const float4*)(TOPS + (size_t)tok0 * 256 + 256 * i + 4 * lane);
    cntw[lane] = 0;
    asm volatile("s_waitcnt lgkmcnt(0)" ::: "memory");
    unsigned ec[8];
#pragma unroll
    for (int rd = 0; rd < 2; ++rd) {
      const int combo = (lane >> 2) + 16 * rd, tl = combo >> 3, hd = combo & 7, q = lane & 3;
      const float* t1 = TS + (tl * 16 + hd * 2) * 16; const float* t2 = t1 + 16;
      const unsigned long long ip = TK_I[q], jp = TK_J[q]; const int cn = TK_N[q];
      float L[16], P[16];
#pragma unroll
      for (int c = 0; c < 16; ++c) {
        const unsigned i = (unsigned)(ip >> (4 * c)) & 15u, j = (unsigned)(jp >> (4 * c)) & 15u;
        const float sm = t1[i] + t2[j];
        L[c] = c < cn ? __uint_as_float((__float_as_uint(sm) & ~255u) | (i << 4) | j) : -3.0e38f;
      }
      TK_SORT16(L);
#pragma unroll
      for (int c = 0; c < 16; ++c) P[c] = __uint_as_float(__builtin_amdgcn_update_dpp(0, __float_as_uint(L[c]), 0xB1, 0xf, 0xf, false));
      TK_MERGE(L, P);
#pragma unroll
      for (int c = 0; c < 16; ++c) P[c] = __uint_as_float(__builtin_amdgcn_update_dpp(0, __float_as_uint(L[c]), 0x4E, 0xf, 0xf, false));
      TK_MERGE(L, P);
      float sum = 0.f;
      const float m0 = __uint_as_float(__float_as_uint(L[0]) & ~255u);
#pragma unroll
      for (int c = 0; c < 16; ++c) sum += __expf(__uint_as_float(__float_as_uint(L[c]) & ~255u) - m0);
      const float inv = 1.f / sum;
#pragma unroll
      for (int r = 0; r < 4; ++r) {
        const float lv = q == 0 ? L[r] : (q == 1 ? L[4 + r] : (q == 2 ? L[8 + r] : L[12 + r]));
        const unsigned bits = __float_as_uint(lv), id = bits & 255u;
        const unsigned i1 = __float_as_uint(t1[id >> 4]) & 127u, i2 = __float_as_uint(t2[id & 15u]) & 127u;
        const float gate = __expf(__uint_as_float(bits & ~255u) - m0) * inv;
        ec[4 * rd + r] = (i1 * 128u + i2) | ((unsigned)tl << 14) | (pack2(0.f, gate) & 0xFFFF0000u);
      }
    }
    {
#pragma unroll
      for (int i = 0; i < 8; ++i) atomicAdd(&cntw[(ec[i] & 0x3FFFu) >> 8], 1);
      asm volatile("s_waitcnt lgkmcnt(0)" ::: "memory");
      const int c = cntw[lane]; int inc = c;
#pragma unroll
      for (int o = 1; o < 64; o <<= 1) { const int v = __shfl_up(inc, o, 64); if (lane >= o) inc += v; }
      asm volatile("s_waitcnt lgkmcnt(0)" ::: "memory");
      cntw[lane] = inc - c;
      asm volatile("s_waitcnt lgkmcnt(0)" ::: "memory");
#pragma unroll
      for (int i = 0; i < 8; ++i) { const int pos = atomicAdd(&cntw[(ec[i] & 0x3FFFu) >> 8], 1); ents[pos] = ec[i]; }
      asm volatile("s_waitcnt lgkmcnt(0)" ::: "memory");
    }
    u32x4 hA[4][2];
    { const float4 sq = *(const float4*)(SSQ + (size_t)(tok0 + j4) * 4);
      const float rstd = rsqrtf((sq.x + sq.y + sq.z + sq.w) * (1.f / 1024.f) + EPS);
#pragma unroll
      for (int i = 0; i < 4; ++i)
#pragma unroll
        for (int hf = 0; hf < 2; ++hf) {
          const int k0 = 256 * i + 16 * blk + 8 * hf;
          const u32x4 xb = *(const u32x4*)(H + (size_t)(tok0 + j4) * 1024 + k0);
          float hv[8];
#pragma unroll
          for (int e = 0; e < 8; e += 4) {
            const float4 g = *(const float4*)(a.g_norm2 + k0 + e), sc4 = *(const float4*)(mod + b * 6144 + 4096 + k0 + e), sh4 = *(const float4*)(mod + b * 6144 + 3072 + k0 + e);
            hv[e]     = bflo(xb[e >> 1]) * rstd * g.x * (1.f + sc4.x) + sh4.x;     hv[e + 1] = bfhi(xb[e >> 1]) * rstd * g.y * (1.f + sc4.y) + sh4.y;
            hv[e + 2] = bflo(xb[(e >> 1) + 1]) * rstd * g.z * (1.f + sc4.z) + sh4.z; hv[e + 3] = bfhi(xb[(e >> 1) + 1]) * rstd * g.w * (1.f + sc4.w) + sh4.w;
          }
          hA[i][hf] = (u32x4){pack2(hv[0], hv[1]), pack2(hv[2], hv[3]), pack2(hv[4], hv[5]), pack2(hv[6], hv[7])};
        } }
    f32x4 acc[16];
#pragma unroll
    for (int c = 0; c < 16; ++c) acc[c] = (f32x4){0.f, 0.f, 0.f, 0.f};
#define P7_VPHASE(bufi) do { const int _vb = trb + (bufi) * P7_VBUF;                                                            \
      { const s16x4 v0 = tr_read<0>(_vb), v1 = tr_read<128>(_vb), v2 = tr_read<256>(_vb), v3 = tr_read<384>(_vb),               \
                    v4 = tr_read<512>(_vb), v5 = tr_read<640>(_vb), v6 = tr_read<768>(_vb), v7 = tr_read<896>(_vb);               \
        asm volatile("s_waitcnt lgkmcnt(0)" ::: "memory"); SBAR();                                                                \
        acc[0] = MFMA4(awp, v0, acc[0]); acc[1] = MFMA4(awp, v1, acc[1]); acc[2] = MFMA4(awp, v2, acc[2]); acc[3] = MFMA4(awp, v3, acc[3]);   \
        acc[4] = MFMA4(awp, v4, acc[4]); acc[5] = MFMA4(awp, v5, acc[5]); acc[6] = MFMA4(awp, v6, acc[6]); acc[7] = MFMA4(awp, v7, acc[7]); } \
      { const s16x4 v0 = tr_read<1024>(_vb), v1 = tr_read<1152>(_vb), v2 = tr_read<1280>(_vb), v3 = tr_read<1408>(_vb),         \
                    v4 = tr_read<1536>(_vb), v5 = tr_read<1664>(_vb), v6 = tr_read<1792>(_vb), v7 = tr_read<1920>(_vb);           \
        asm volatile("s_waitcnt lgkmcnt(0)" ::: "memory"); SBAR();                                                                \
        acc[8] = MFMA4(awp, v0, acc[8]); acc[9] = MFMA4(awp, v1, acc[9]); acc[10] = MFMA4(awp, v2, acc[10]); acc[11] = MFMA4(awp, v3, acc[11]); \
        acc[12] = MFMA4(awp, v4, acc[12]); acc[13] = MFMA4(awp, v5, acc[13]); acc[14] = MFMA4(awp, v6, acc[14]); acc[15] = MFMA4(awp, v7, acc[15]); } } while (0)
    u32x4 u8[4], v8[4];
#define P7_LOADG(EN) do { const unsigned _ex = (EN) & 0x3FFFu; const unsigned char* _pu = U8 + (size_t)_ex * 1024 + 16 * blk;      \
      _Pragma("unroll") for (int _i = 0; _i < 4; ++_i) u8[_i] = *(const u32x4*)(_pu + 256 * _i);                                 \
      _Pragma("unroll") for (int _q = 0; _q < 4; ++_q) { const unsigned _eq = (unsigned)__builtin_amdgcn_readlane((int)_ex, _q);  \
        v8[_q] = *(const u32x4*)(V8 + (size_t)_eq * 1024 + 16 * lane); } } while (0)
    unsigned enc = ents[j4], enn = ents[4 + j4];
    P7_LOADG(enc);
    s16x4 awp = {0, 0, 0, 0};
    constexpr int NG = 128;
    for (int g = 0; g < NG; ++g) {
      if (g > 0) P7_VPHASE((g - 1) & 1);
      f32x4 d0 = {0.f, 0.f, 0.f, 0.f}, d1 = {0.f, 0.f, 0.f, 0.f};
#pragma unroll
      for (int i = 0; i < 4; ++i)
#pragma unroll
        for (int w = 0; w < 4; ++w) {
          const uint2 ub = {fp8x2_bf16(u8[i][w], 1.f / PEER_SU, false), fp8x2_bf16(u8[i][w], 1.f / PEER_SU, true)};
          const uint2 ha = {hA[i][w >> 1][2 * (w & 1)], hA[i][w >> 1][2 * (w & 1) + 1]};
          if (w & 1) d1 = MFMA4(__builtin_bit_cast(s16x4, ha), __builtin_bit_cast(s16x4, ub), d1);
          else       d0 = MFMA4(__builtin_bit_cast(s16x4, ha), __builtin_bit_cast(s16x4, ub), d0);
        }
      { char* vw = ring + (g & 1) * P7_VBUF + lane * 32;
#pragma unroll
        for (int q = 0; q < 4; ++q) {
          u32x4 o0, o1;
          o0[0] = fp8x2_bf16(v8[q][0], 1.f / PEER_SV, false); o0[1] = fp8x2_bf16(v8[q][0], 1.f / PEER_SV, true);
          o0[2] = fp8x2_bf16(v8[q][1], 1.f / PEER_SV, false); o0[3] = fp8x2_bf16(v8[q][1], 1.f / PEER_SV, true);
          o1[0] = fp8x2_bf16(v8[q][2], 1.f / PEER_SV, false); o1[1] = fp8x2_bf16(v8[q][2], 1.f / PEER_SV, true);
          o1[2] = fp8x2_bf16(v8[q][3], 1.f / PEER_SV, false); o1[3] = fp8x2_bf16(v8[q][3], 1.f / PEER_SV, true);
          *(u32x4*)(vw + q * P7_VROW) = o0; *(u32x4*)(vw + q * P7_VROW + 16) = o1;
        } }
      unsigned en2 = 0u;
      if (g + 1 < NG) { P7_LOADG(enn); if (g + 2 < NG) en2 = ents[4 * (g + 2) + j4]; }
      const int tk = (enc >> 14) & 3;
      float av = sel4(d0, tk) + sel4(d1, tk);
      av += __uint_as_float(__builtin_amdgcn_update_dpp(0, __float_as_uint(av), 0x124, 0xf, 0xf, false));
      av += __uint_as_float(__builtin_amdgcn_update_dpp(0, __float_as_uint(av), 0x128, 0xf, 0xf, false));
      av += __shfl_xor(av, 16, 64);
      { auto rr = __builtin_amdgcn_permlane32_swap(__float_as_uint(av), __float_as_uint(av), false, false); av = __uint_as_float(rr[0]) + __uint_as_float(rr[1]); }
      const float wgt = gelu_exact(av) * __uint_as_float(enc & 0xFFFF0000u);
      float z[4];
#define P7_QB(x, k) __builtin_amdgcn_update_dpp(0, (x), (k) * 0x55, 0xf, 0xf, false)
      { const unsigned wb = __float_as_uint(wgt), tb = (unsigned)tk;
        unsigned w0 = P7_QB(wb, 0), w1 = P7_QB(wb, 1), w2 = P7_QB(wb, 2), w3 = P7_QB(wb, 3);
        unsigned t0 = P7_QB(tb, 0), t1 = P7_QB(tb, 1), t2 = P7_QB(tb, 2), t3 = P7_QB(tb, 3);
        asm volatile("" : "+v"(w0), "+v"(w1), "+v"(w2), "+v"(w3), "+v"(t0), "+v"(t1), "+v"(t2), "+v"(t3));
        z[0] = ((int)t0 == j4) ? __uint_as_float(w0) : 0.f; z[1] = ((int)t1 == j4) ? __uint_as_float(w1) : 0.f;
        z[2] = ((int)t2 == j4) ? __uint_as_float(w2) : 0.f; z[3] = ((int)t3 == j4) ? __uint_as_float(w3) : 0.f; }
#undef P7_QB
      { const uint2 pk = {pack2(z[0], z[1]), pack2(z[2], z[3])}; awp = __builtin_bit_cast(s16x4, pk); }
      enc = enn; enn = en2;
    }
#undef P7_LOADG
    P7_VPHASE((NG - 1) & 1);
#undef P7_VPHASE
    int lne = lane; asm volatile("" : "+v"(lne));
    float ss[4] = {0.f, 0.f, 0.f, 0.f};
#pragma unroll
    for (int c = 0; c < 16; ++c) {
      const float g2 = mod[b * 6144 + 5120 + 64 * c + lne];
#pragma unroll
      for (int r = 0; r < 4; ++r) { const float v = X1[(size_t)(tok0 + r) * 1024 + 64 * c + lne] + g2 * acc[c][r]; acc[c][r] = v; ss[r] += v * v; }
    }
    float rstd[4];
#pragma unroll
    for (int r = 0; r < 4; ++r) rstd[r] = rsqrtf(wave_sum(ss[r]) * (1.f / 1024.f) + EPS);
#pragma unroll
    for (int c = 0; c < 16; ++c) {
      const float gf = a.g_final[64 * c + lne];
#pragma unroll
      for (int r = 0; r < 4; ++r) a.out[(size_t)(tok0 + r) * 1024 + 64 * c + lne] = acc[c][r] * rstd[r] * gf;
    }
  }
}

constexpr int N_PHASES = 8;
__global__ void __launch_bounds__(512, 2) fwd(Args args) {
  extern __shared__ __attribute__((aligned(16))) char lds[];
  if (threadIdx.x == 0) *(uint4*)lds = make_uint4(0u, 0u, 0u, 0u);
  __syncthreads();
  const int lo = args.ph_lo, hi = args.ph_hi;
  XcdBarrier bar; bar.bar = (unsigned*)(args.ws + WS_BAR); bar.x = 0; bar.st = (volatile LAS unsigned*)lds;
  if (hi - lo > 1) bar = xcd_barrier_post((unsigned*)(args.ws + WS_BAR), (volatile LAS unsigned*)lds);
#ifndef ONLY_PHASE
#define ONLY_PHASE -1
#endif
#define IN(k) (lo <= (k) && (k) < hi && (ONLY_PHASE < 0 || ONLY_PHASE == (k)))
#define SEAM(k) do { if (IN(k) && IN((k) + 1)) xcd_barrier(bar); } while (0)
  if (IN(0)) phase0(args, lds);
  SEAM(0);
  if (IN(1)) { phase1(args, lds); phase1b(args, lds); }
  SEAM(1);
  if (IN(2)) phase2(args, lds);
  SEAM(2);
  if (IN(3)) phase3(args, lds);
  SEAM(3);
  if (IN(4)) phase4(args, lds);
  SEAM(4);
  if (IN(5)) phase5(args, lds);
  SEAM(5);
  if (IN(6)) phase6(args, lds);
  SEAM(6);
  if (IN(7)) phase7(args, lds);
#undef IN
#undef SEAM
}

extern "C" void kernel_launch(void* const* d_in, const int* in_sizes, int n_in, void* d_out, int out_size, void* d_ws, size_t ws_size, hipStream_t stream) {
  static int grid = 0;
  if (grid == 0) {
    if (n_in != 23 || out_size != T * DM || ws_size < WS_END) { fprintf(stderr, "kernel_launch: unexpected shapes (n_in %d out %d ws %zu need %zu)\n", n_in, out_size, ws_size, (size_t)WS_END); grid = -1; return; }
    int dev = 0, cus = 0, per_cu = 0;
    (void)hipGetDevice(&dev); (void)hipDeviceGetAttribute(&cus, hipDeviceAttributeMultiprocessorCount, dev);
    if (hipFuncSetAttribute((const void*)fwd, hipFuncAttributeMaxDynamicSharedMemorySize, LDS_BYTES) != hipSuccess) { fprintf(stderr, "kernel_launch: hipFuncSetAttribute failed\n"); grid = -1; return; }
    if (hipOccupancyMaxActiveBlocksPerMultiprocessor(&per_cu, (const void*)fwd, 512, LDS_BYTES) != hipSuccess || per_cu < 1) { fprintf(stderr, "kernel_launch: occupancy query says %d\n", per_cu); per_cu = 1; }
    (void)hipGetLastError();
    grid = cus;
  }
  if (grid < 0) return;
  (void)hipMemsetAsync((char*)d_ws + WS_BAR, 0, 16384, stream);
  Args a{};
  a.x = (const float*)d_in[0]; a.c = (const float*)d_in[1]; a.pos = (const int*)d_in[2];
  a.w_ada = (const float*)d_in[3]; a.b_ada = (const float*)d_in[4]; a.g_norm1 = (const float*)d_in[5]; a.w_in = (const float*)d_in[6];
  a.g_q_a = (const float*)d_in[7]; a.w_uq = (const float*)d_in[8]; a.g_kv_a = (const float*)d_in[9]; a.w_ukv = (const float*)d_in[10];
  a.g_sg = (const float*)d_in[11]; a.w_sg = (const float*)d_in[12]; a.b_sg = (const float*)d_in[13]; a.g_attn_out = (const float*)d_in[14];
  a.g_sg_out = (const float*)d_in[15]; a.w_o = (const float*)d_in[16]; a.g_norm2 = (const float*)d_in[17]; a.w_peer_q = (const float*)d_in[18];
  a.peer_keys = (const float*)d_in[19]; a.peer_u = (const float*)d_in[20]; a.peer_v = (const float*)d_in[21]; a.g_final = (const float*)d_in[22];
  a.out = (float*)d_out; a.ws = (unsigned char*)d_ws;
#if N_LAUNCH_MODE == 0
  a.ph_lo = 0; a.ph_hi = N_PHASES;
  hipLaunchKernelGGL(fwd, dim3(grid), dim3(512), LDS_BYTES, stream, a);
#else
  for (int p = 0; p < N_PHASES; ++p) for (int rep = 0; rep <= ((DUP_MASK >> p) & 1); ++rep) { a.ph_lo = p; a.ph_hi = p + 1; hipLaunchKernelGGL(fwd, dim3(grid), dim3(512), LDS_BYTES, stream, a); }
#endif
  const hipError_t le = hipPeekAtLastError();
  if (le != hipSuccess) fprintf(stderr, "kernel_launch: launch failed: %s\n", hipGetErrorName(le));
}
```

```cpp
#include <hip/hip_runtime.h>
#include <stdint.h>
#include <stdio.h>

#define N_LAUNCH_MODE 0
#define DUP_MASK 0x000

typedef unsigned short u16;
typedef __attribute__((ext_vector_type(8))) short bf16x8;
typedef __attribute__((ext_vector_type(4))) short s16x4;
typedef __attribute__((ext_vector_type(16))) float f32x16;
typedef __attribute__((ext_vector_type(4))) unsigned u32x4;

constexpr int T = 16384, DM = 1024, SEQ = 4096;
constexpr float EPS = 1e-6f;

constexpr size_t WS_BAR  = 0;
constexpr size_t WS_MODP = 16384;
constexpr size_t WS_MOD  = WS_MODP + 786432;
constexpr size_t WS_CS   = WS_MOD + 98304;
constexpr size_t WS_WIN  = WS_CS + 4194304;
constexpr size_t WS_WQ2  = WS_WIN + 3145728;
constexpr size_t WS_WUV  = WS_WQ2 + 393216;
constexpr size_t WS_WO   = WS_WUV + 131072;
constexpr size_t WS_WPQ  = WS_WO + 2097152;
constexpr size_t WS_KEYS = WS_WPQ + 4194304;
constexpr size_t WS_WSG  = WS_KEYS + 524288;
constexpr size_t WS_UB   = WS_WSG + 131072;
constexpr size_t WS_VB   = WS_UB + 33554432;
constexpr size_t WS_H    = WS_VB + 33554432;
constexpr size_t WS_Y    = WS_H + 33554432;
constexpr size_t WS_KV   = WS_Y + 33554432;
constexpr size_t WS_TOPK = WS_KV + 6291456;
constexpr size_t WS_SSQ  = WS_TOPK + 16777216;
constexpr size_t WS_SSQV = WS_SSQ + 262144;
constexpr size_t WS_R1   = WS_SSQV + 131072;
constexpr size_t WS_Q    = WS_R1;
constexpr size_t WS_QA   = WS_Q + 25165824;
constexpr size_t WS_UACT = WS_QA + 8388608;
constexpr size_t WS_GVT  = WS_UACT + 16777216;
constexpr size_t WS_X1   = WS_R1;
constexpr size_t WS_WST  = WS_R1 + 67108864;
constexpr size_t WS_BIASP = WS_WST + 4 * 4194304;
constexpr size_t WS_END  = WS_BIASP + 131072;

constexpr int LDS_BYTES = 155648;
constexpr int LDS_DATA  = 64;

struct Args {
  const float *x, *c; const int* pos;
  const float *w_ada, *b_ada, *g_norm1, *w_in, *g_q_a, *w_uq, *g_kv_a, *w_ukv, *g_sg, *w_sg, *b_sg, *g_attn_out, *g_sg_out,
              *w_o, *g_norm2, *w_peer_q, *peer_keys, *peer_u, *peer_v, *g_final;
  float* out; unsigned char* ws; int ph_lo, ph_hi;
};

#define XB_TMO      128
#define XB_XCNT(j)  (256  + 64 * (j))
#define XB_XSUB(j)  (1280 + 64 * (j))
#define XB_XGEN(j)  (2304 + 64 * (j))
#define XB_TOP      3328
#define XB_TOPGEN   3392
#define XCD_BAR_WORDS 3456
#define XB_SPIN_CAP (1u << 18)
#define LAS __attribute__((address_space(3)))

__device__ __forceinline__ unsigned xb_ld(unsigned* p)              { return __hip_atomic_load(p, __ATOMIC_RELAXED, __HIP_MEMORY_SCOPE_AGENT); }
__device__ __forceinline__ unsigned xb_add(unsigned* p, unsigned v) { return __hip_atomic_fetch_add(p, v, __ATOMIC_RELAXED, __HIP_MEMORY_SCOPE_AGENT); }
__device__ __forceinline__ unsigned xb_xcc_id() { return (unsigned)__builtin_amdgcn_s_getreg((3 << 11) | 20) & 0xFu; }
#define XB_SPIN(cond, bar) do { unsigned _sp = 0; while (cond) { __builtin_amdgcn_s_sleep(1); \
    if ((++_sp & 255u) == 0u) { if (xb_ld(&(bar)[XB_TMO])) break; if (_sp > XB_SPIN_CAP) { atomicAdd(&(bar)[XB_TMO], 1u); break; } } } } while (0)

struct XcdBarrier { unsigned* bar; unsigned x; volatile LAS unsigned* st; };

__device__ __forceinline__ XcdBarrier xcd_barrier_post(unsigned* bar, volatile LAS unsigned* st) {
    XcdBarrier b; b.bar = bar; b.x = xb_xcc_id(); b.st = st;
    if (threadIdx.x == 0) (void)xb_add(&bar[XB_XCNT(b.x)], 1u);
    return b;
}
__device__ __forceinline__ void xcd_barrier_complete(unsigned* bar, unsigned x, unsigned& nloc, unsigned& nx) {
    const unsigned G = gridDim.x * gridDim.y * gridDim.z;
    unsigned sum, cnt, mine, sp = 0u;
    for (;;) {
        sum = 0u; cnt = 0u; mine = 0u;
#pragma unroll
        for (unsigned j = 0; j < 16; ++j) { const unsigned c = xb_ld(&bar[XB_XCNT(j)]); sum += c; cnt += (c > 0u) ? 1u : 0u; mine = (j == x) ? c : mine; }
        if (sum == G) break;
        __builtin_amdgcn_s_sleep(1);
        if ((++sp & 255u) == 0u) { if (xb_ld(&bar[XB_TMO])) break; if (sp > XB_SPIN_CAP) { atomicAdd(&bar[XB_TMO], 1u); break; } }
    }
    nloc = mine > 0u ? mine : 1u; nx = cnt > 0u ? cnt : 1u;
}
__device__ __forceinline__ void xcd_barrier(const XcdBarrier& b) {
    asm volatile("s_waitcnt vmcnt(0)" ::: "memory");
    __syncthreads();
    if (threadIdx.x == 0) {
        unsigned* bar = b.bar;
        __builtin_amdgcn_s_waitcnt(0);
        unsigned nloc = b.st[0], nx = b.st[1];
        if (nloc == 0u) { xcd_barrier_complete(bar, b.x, nloc, nx); b.st[0] = nloc; b.st[1] = nx; }
        const unsigned old = xb_add(&bar[XB_XSUB(b.x)], 1u);
        const unsigned gen = old / nloc;
        if (old + 1u == (gen + 1u) * nloc) {
            __builtin_amdgcn_fence(__ATOMIC_RELEASE, "agent");
            asm volatile("s_waitcnt vmcnt(0)" ::: "memory");
            const unsigned og = xb_add(&bar[XB_TOP], 1u);
            const unsigned tg = og / nx;
            if (og + 1u == (tg + 1u) * nx) xb_add(&bar[XB_TOPGEN], 1u);
            else XB_SPIN(xb_ld(&bar[XB_TOPGEN]) == tg, bar);
            __builtin_amdgcn_fence(__ATOMIC_ACQUIRE, "agent");
            xb_add(&bar[XB_XGEN(b.x)], 1u);
            asm volatile("s_waitcnt vmcnt(0)" ::: "memory");
        } else {
            XB_SPIN(xb_ld(&bar[XB_XGEN(b.x)]) == gen, bar);
            __builtin_amdgcn_fence(__ATOMIC_ACQUIRE, "agent");
            asm volatile("s_waitcnt vmcnt(0)" ::: "memory");
        }
    }
    __syncthreads();
}

__device__ __forceinline__ unsigned pack2(float lo, float hi) {
  typedef __attribute__((ext_vector_type(2))) float f2; typedef __attribute__((ext_vector_type(2))) __bf16 b2;
  f2 v = {lo, hi}; b2 r = __builtin_convertvector(v, b2); return __builtin_bit_cast(unsigned, r);
}
__device__ __forceinline__ u16 f2bf(float f) { return (u16)(pack2(f, 0.f) & 0xFFFFu); }
__device__ __forceinline__ float bflo(unsigned w) { return __uint_as_float(w << 16); }
__device__ __forceinline__ float bfhi(unsigned w) { return __uint_as_float(w & 0xFFFF0000u); }
__device__ __forceinline__ float gelu_exact(float x) {
  const float z = fabsf(x) * 0.70710678118654752f;
  const float t = __builtin_amdgcn_rcpf(fmaf(0.3275911f, z, 1.f));
  float p = fmaf(1.061405429f, t, -1.453152027f); p = fmaf(p, t, 1.421413741f); p = fmaf(p, t, -0.284496736f); p = fmaf(p, t, 0.254829592f);
  const float e = p * t * __expf(-z * z);
  const float erfz = 1.f - e;
  return 0.5f * x * (1.f + copysignf(erfz, x));
}
__device__ __forceinline__ float wave_sum(float v) {
#pragma unroll
  for (int o = 32; o > 0; o >>= 1) v += __shfl_xor(v, o, 64);
  return v;
}
__device__ __forceinline__ int crow(int r, int hi) { return (r & 3) + 8 * (r >> 2) + 4 * hi; }
#define MFMA32(a, b, c) __builtin_amdgcn_mfma_f32_32x32x16_bf16((a), (b), (c), 0, 0, 0)

template <int MAP> __device__ __forceinline__ int colmap(int n) {
  if (MAP == 0) return n;
  if (MAP == 1) return n < 448 ? n : (n < 512 ? -1 : n - 64);
  if (MAP == 2) return (n >> 6) * 192 + 128 + (n & 63);
  return (n >> 7) * 256 + 128 + (n & 127);
}
template <int MAP> __device__ void cvt_transpose(const float* __restrict__ src, int src_ld, int K, int N, u16* __restrict__ dst, int gtid, int gthreads) {
  const int total = N * (K >> 3);
  for (int idx = gtid; idx < total; idx += gthreads) {
    const int n = idx % N, k8 = idx / N, sc = colmap<MAP>(n);
    float v[8];
#pragma unroll
    for (int j = 0; j < 8; ++j) v[j] = sc < 0 ? 0.f : src[(size_t)(k8 * 8 + j) * src_ld + sc];
    u32x4 w = {pack2(v[0], v[1]), pack2(v[2], v[3]), pack2(v[4], v[5]), pack2(v[6], v[7])};
    *(u32x4*)(dst + (size_t)n * K + k8 * 8) = w;
  }
}
template <int MAP> __device__ void cvt_transpose_tiled(const float* __restrict__ src, int src_ld, int K, int N, u16* __restrict__ dst, float* tile) {
  const int tid = threadIdx.x, tk = K >> 6, ntile = tk * (N >> 6);
  for (int t = blockIdx.x; t < ntile; t += gridDim.x) {
    const int k0 = (t % tk) * 64, n0 = (t / tk) * 64;
    __syncthreads();
    { const int nl = tid & 63, sc = colmap<MAP>(n0 + nl);
#pragma unroll
      for (int i = 0; i < 8; ++i) { const int k = (tid >> 6) + 8 * i; tile[k * 65 + nl] = sc < 0 ? 0.f : src[(size_t)(k0 + k) * src_ld + sc]; } }
    __syncthreads();
    { const int n = tid >> 3, kk = tid & 7; float v[8];
#pragma unroll
      for (int j = 0; j < 8; ++j) v[j] = tile[(8 * kk + j) * 65 + n];
      u32x4 w = {pack2(v[0], v[1]), pack2(v[2], v[3]), pack2(v[4], v[5]), pack2(v[6], v[7])};
      *(u32x4*)(dst + (size_t)(n0 + n) * K + k0 + 8 * kk) = w; }
  }
}
__device__ void cvt_direct(const float* __restrict__ src, u16* __restrict__ dst, size_t n8, int gtid, int gthreads) {
  for (size_t i = gtid; i < n8; i += gthreads) {
    const float4 a = *(const float4*)(src + i * 8), b = *(const float4*)(src + i * 8 + 4);
    u32x4 w = {pack2(a.x, a.y), pack2(a.z, a.w), pack2(b.x, b.y), pack2(b.z, b.w)};
    *(u32x4*)(dst + i * 8) = w;
  }
}
constexpr float PEER_SU = 32.f, PEER_SV = 4.f;
__device__ void cvt_fp8(const float* __restrict__ src, unsigned char* __restrict__ dst, size_t n16, float sc, int gtid, int gthreads) {
  for (size_t i = gtid; i < n16; i += gthreads) {
    u32x4 w;
#pragma unroll
    for (int k = 0; k < 4; ++k) {
      const float4 a = *(const float4*)(src + i * 16 + 4 * k);
      int p = __builtin_amdgcn_cvt_pk_fp8_f32(a.x * sc, a.y * sc, 0, false);
      p = __builtin_amdgcn_cvt_pk_fp8_f32(a.z * sc, a.w * sc, p, true);
      w[k] = (unsigned)p;
    }
    *(u32x4*)(dst + i * 16) = w;
  }
}
__device__ __forceinline__ void sincos_acc(float angf, float& sn, float& cs) {
  const double a = (double)angf;
  const double q = __builtin_rint(a * 0.63661977236758134308);
  double r = __builtin_fma(-q, 1.5707963267948966, a);
  r = __builtin_fma(-q, 6.123233995736766e-17, r);
  const double r2 = r * r;
  double s = r2 * (1.0 / 6227020800.0) - 1.0 / 39916800.0;
  s = s * r2 + 1.0 / 362880.0; s = s * r2 - 1.0 / 5040.0; s = s * r2 + 1.0 / 120.0; s = s * r2 - 1.0 / 6.0; s = r + r * r2 * s;
  double c = -r2 * (1.0 / 87178291200.0) + 1.0 / 479001600.0;
  c = c * r2 - 1.0 / 3628800.0; c = c * r2 + 1.0 / 40320.0; c = c * r2 - 1.0 / 720.0; c = c * r2 + 1.0 / 24.0; c = c * r2 - 0.5; c = 1.0 + r2 * c;
  const int n = ((int)q) & 3;
  const double ss = (n & 1) ? c : s, cc = (n & 1) ? s : c;
  sn = (float)((n & 2) ? -ss : ss);
  cs = (float)(((n + 1) & 2) ? -cc : cc);
}

__constant__ float INVF[32] = {1.000000000e+00f, 7.498942018e-01f, 5.623413324e-01f, 4.216965139e-01f, 3.162277639e-01f, 2.371373922e-01f, 1.778279394e-01f, 1.333521456e-01f,
  1.000000015e-01f, 7.498941571e-02f, 5.623412877e-02f, 4.216964915e-02f, 3.162277862e-02f, 2.371373586e-02f, 1.778279431e-02f, 1.333521493e-02f,
  9.999999776e-03f, 7.498942316e-03f, 5.623413250e-03f, 4.216964822e-03f, 3.162277862e-03f, 2.371373819e-03f, 1.778279431e-03f, 1.333521446e-03f,
  1.000000047e-03f, 7.498941850e-04f, 5.623413017e-04f, 4.216965463e-04f, 3.162277862e-04f, 2.371373848e-04f, 1.778279402e-04f, 1.333521504e-04f};
__device__ void phase0(const Args& a, char* lds) {
  unsigned char* ws = a.ws;
  const int tid = threadIdx.x, lane = tid & 63, wv = tid >> 6;
  const int NWV = gridDim.x * 8, gw = blockIdx.x * 8 + wv;
  const int gthreads = gridDim.x * 512, gtid = blockIdx.x * 512 + tid;
  float* modp = (float*)(ws + WS_MODP);
  for (int job = gw; job < 768; job += NWV) {
    const int cg = job % 96, ks = job / 96, col = cg * 64 + lane;
    float a0 = 0.f, a1 = 0.f, a2 = 0.f, a3 = 0.f;
    const float* w = a.w_ada + (size_t)(ks * 128) * 6144 + col;
    float sv[2][4];
#pragma unroll
    for (int h = 0; h < 2; ++h)
#pragma unroll
      for (int bb = 0; bb < 4; ++bb) { const float cv = a.c[bb * 1024 + ks * 128 + 64 * h + lane]; sv[h][bb] = cv / (1.f + __expf(-cv)); }
#pragma unroll
    for (int h = 0; h < 2; ++h) {
#pragma unroll 8
      for (int k = 0; k < 64; ++k) {
        const float wv_ = w[(size_t)(64 * h + k) * 6144];
        a0 += __uint_as_float(__builtin_amdgcn_readlane(__float_as_uint(sv[h][0]), k)) * wv_;
        a1 += __uint_as_float(__builtin_amdgcn_readlane(__float_as_uint(sv[h][1]), k)) * wv_;
        a2 += __uint_as_float(__builtin_amdgcn_readlane(__float_as_uint(sv[h][2]), k)) * wv_;
        a3 += __uint_as_float(__builtin_amdgcn_readlane(__float_as_uint(sv[h][3]), k)) * wv_;
      }
    }
    modp[(ks * 4 + 0) * 6144 + col] = a0; modp[(ks * 4 + 1) * 6144 + col] = a1;
    modp[(ks * 4 + 2) * 6144 + col] = a2; modp[(ks * 4 + 3) * 6144 + col] = a3;
  }
  { float* tile = (float*)(lds + LDS_DATA);
    cvt_transpose_tiled<1>(a.w_in, 1472, 1024, 1536, (u16*)(ws + WS_WIN), tile);
    cvt_transpose_tiled<0>(a.w_o, 1024, 1024, 1024, (u16*)(ws + WS_WO), tile);
    cvt_transpose_tiled<2>(a.w_uq, 768, 256, 256, (u16*)(ws + WS_WQ2) + 512 * 256, tile);
    cvt_transpose_tiled<3>(a.w_ukv, 1024, 128, 512, (u16*)(ws + WS_WUV), tile); }
  {
    u16* wq2 = (u16*)(ws + WS_WQ2);
    for (int idx = gtid; idx < 512 * 256; idx += gthreads) {
      const int n = idx >> 8, i = idx & 255, h = n >> 7, cc = n & 127;
      const float* pu = a.w_uq + (size_t)i * 768 + h * 192;
      const float* pk = a.w_ukv + (size_t)cc * 1024 + h * 256;
      float s = 0.f;
#pragma unroll 8
      for (int d = 0; d < 128; d += 4) {
        const float4 u = *(const float4*)(pu + d), k = *(const float4*)(pk + d);
        s += u.x * k.x + u.y * k.y + u.z * k.z + u.w * k.w;
      }
      wq2[(size_t)n * 256 + i] = f2bf(s);
    }
  }
  cvt_direct(a.peer_keys, (u16*)(ws + WS_KEYS), 262144 / 8, gtid, gthreads);
  cvt_direct(a.w_peer_q, (u16*)(ws + WS_WPQ), (size_t)1024 * 2048 / 8, gtid, gthreads);
  cvt_direct(a.w_sg, (u16*)(ws + WS_WSG), 65536 / 8, gtid, gthreads);
  {
    float* cs = (float*)(ws + WS_CS);
    for (int idx = gtid; idx < T * 32; idx += gthreads) {
      const int t = idx >> 5, i = idx & 31;
      const float inv = INVF[i];
      const float ang = (float)a.pos[t] * inv;
      float sn, c_; sincos_acc(ang, sn, c_);
      cs[(size_t)t * 64 + i] = c_; cs[(size_t)t * 64 + 32 + i] = sn;
    }
  }
}

__device__ void phase1(const Args& a, char* lds) {
  unsigned char* ws = a.ws;
  const int tid = threadIdx.x, lane = tid & 63, wv = tid >> 6;
  const float* modp = (const float*)(ws + WS_MODP);
  float* mod = (float*)(ws + WS_MOD);
  for (int idx = blockIdx.x * 512 + tid; idx < 4 * 6144; idx += gridDim.x * 512) {
    const int b = idx / 6144, m = idx % 6144;
    float s = a.b_ada[m];
#pragma unroll
    for (int ks = 0; ks < 8; ++ks) s += modp[(ks * 4 + b) * 6144 + m];
    mod[idx] = s;
  }
  float* sh = (float*)(lds + LDS_DATA);
  u16* H = (u16*)(ws + WS_H);
  for (int u = blockIdx.x; u < T / 64; u += gridDim.x) {
    const int b = u >> 6;
    __syncthreads();
    for (int j = tid; j < 2048; j += 512) {
      float s = a.b_ada[j];
#pragma unroll
      for (int ks = 0; ks < 8; ++ks) s += modp[(ks * 4 + b) * 6144 + j];
      sh[j] = s;
    }
    __syncthreads();
    for (int i = 0; i < 8; ++i) {
      const int r = u * 64 + wv * 8 + i;
      float4 xv[4]; float ssq = 0.f;
#pragma unroll
      for (int j = 0; j < 4; ++j) { xv[j] = *(const float4*)(a.x + (size_t)r * 1024 + j * 256 + lane * 4); ssq += xv[j].x * xv[j].x + xv[j].y * xv[j].y + xv[j].z * xv[j].z + xv[j].w * xv[j].w; }
      ssq = wave_sum(ssq);
      const float rstd = rsqrtf(ssq * (1.f / 1024.f) + EPS);
#pragma unroll
      for (int j = 0; j < 4; ++j) {
        const int col = j * 256 + lane * 4;
        const float4 g = *(const float4*)(a.g_norm1 + col);
        const float h0 = xv[j].x * rstd * g.x * (1.f + sh[1024 + col]) + sh[col];
        const float h1 = xv[j].y * rstd * g.y * (1.f + sh[1024 + col + 1]) + sh[col + 1];
        const float h2 = xv[j].z * rstd * g.z * (1.f + sh[1024 + col + 2]) + sh[col + 2];
        const float h3 = xv[j].w * rstd * g.w * (1.f + sh[1024 + col + 3]) + sh[col + 3];
        uint2 o = {pack2(h0, h1), pack2(h2, h3)};
        *(uint2*)(H + (size_t)r * 1024 + col) = o;
      }
    }
  }
}

constexpr int G_STAGE = 49152;
__device__ __forceinline__ void dma16(const void* gsrc, unsigned lds_dst) {
  unsigned keep;
  asm volatile("s_mov_b32 %0, m0\n\ts_mov_b32 m0, %2\n\ts_nop 0\n\tglobal_load_lds_dwordx4 %1, off\n\ts_mov_b32 m0, %0"
               : "=&s"(keep) : "v"(gsrc), "s"(lds_dst) : "memory");
}
__device__ __forceinline__ void gemm_128x256(const u16* __restrict__ A, int lda, const u16* __restrict__ Bt, int ldb, int KT,
                                             f32x16 (&acc)[2][2], char* lds) {
  const int tid = threadIdx.x, lane = tid & 63, wv = __builtin_amdgcn_readfirstlane(tid >> 6), r32 = lane & 31, hi = lane >> 5;
  const int wm = wv >> 2, wn = wv & 3;
  const int rin = lane >> 3, cc = lane & 7;
  const u16* pa[2]; const u16* pb[4];
#pragma unroll
  for (int j = 0; j < 2; ++j) pa[j] = A + (size_t)(16 * wv + 8 * j + rin) * lda + 8 * (cc ^ (4 * j + (rin >> 1)));
#pragma unroll
  for (int i = 0; i < 4; ++i) pb[i] = Bt + (size_t)(32 * wv + 8 * i + rin) * ldb + 8 * (cc ^ (4 * (i & 1) + (rin >> 1)));
  const unsigned lb = __builtin_amdgcn_readfirstlane((unsigned)(uintptr_t)lds);
  const unsigned dA = lb + 2048 * wv, dB = lb + 16384 + 4096 * wv;
#define G_ISSUE(stage, kt_) do { const unsigned _so = (unsigned)(stage) * G_STAGE; const int _ko = (kt_) * 64;                     \
    dma16(pa[0] + _ko, dA + _so); dma16(pa[1] + _ko, dA + _so + 1024);                                                           \
    dma16(pb[0] + _ko, dB + _so); dma16(pb[1] + _ko, dB + _so + 1024); dma16(pb[2] + _ko, dB + _so + 2048); dma16(pb[3] + _ko, dB + _so + 3072); } while (0)
#pragma unroll
  for (int m = 0; m < 2; ++m)
#pragma unroll
    for (int n = 0; n < 2; ++n)
#pragma unroll
      for (int r = 0; r < 16; ++r) acc[m][n][r] = 0.f;
  __syncthreads();
  G_ISSUE(0, 0);
  if (KT > 1) G_ISSUE(1, 1);
  const int xa = (r32 >> 1) & 7;
  const int aoff = (64 * wm + r32) * 128, boff = 16384 + (64 * wn + r32) * 128;
  int st = 0;
  for (int kt = 0; kt < KT; ++kt) {
    if (kt + 1 < KT) asm volatile("s_waitcnt vmcnt(6)\n\ts_barrier" ::: "memory");
    else             asm volatile("s_waitcnt vmcnt(0)\n\ts_barrier" ::: "memory");
    const int s2 = st == 0 ? 2 : st - 1;
    if (kt + 2 < KT && wv < 4) G_ISSUE(s2, kt + 2);
    const char* buf = lds + st * G_STAGE;
    __builtin_amdgcn_s_setprio(1);
    bf16x8 fa[2][2], fb[2][2];
#define G_LDF(S, SET) do { const int _cb = ((2 * (S) + hi) ^ xa) << 4;                                                      \
      fa[SET][0] = *(const bf16x8*)(buf + aoff + _cb); fa[SET][1] = *(const bf16x8*)(buf + aoff + 4096 + _cb);              \
      fb[SET][0] = *(const bf16x8*)(buf + boff + _cb); fb[SET][1] = *(const bf16x8*)(buf + boff + 4096 + _cb); } while (0)
#define G_MM(SET) do { acc[0][0] = MFMA32(fa[SET][0], fb[SET][0], acc[0][0]); acc[0][1] = MFMA32(fa[SET][0], fb[SET][1], acc[0][1]);   \
      acc[1][0] = MFMA32(fa[SET][1], fb[SET][0], acc[1][0]); acc[1][1] = MFMA32(fa[SET][1], fb[SET][1], acc[1][1]); } while (0)
    G_LDF(0, 0); __builtin_amdgcn_sched_barrier(0);
    G_LDF(1, 1); __builtin_amdgcn_sched_barrier(0); G_MM(0); __builtin_amdgcn_sched_barrier(0);
    G_LDF(2, 0); __builtin_amdgcn_sched_barrier(0); G_MM(1); __builtin_amdgcn_sched_barrier(0);
    G_LDF(3, 1); __builtin_amdgcn_sched_barrier(0); G_MM(0); __builtin_amdgcn_sched_barrier(0);
    G_MM(1);
#undef G_LDF
#undef G_MM
    __builtin_amdgcn_s_setprio(0);
    if (kt + 2 < KT && wv >= 4) G_ISSUE(s2, kt + 2);
    st = st == 2 ? 0 : st + 1;
  }
#undef G_ISSUE
  __syncthreads();
}
constexpr int CLD = 257;
__device__ __forceinline__ void acc_to_lds(const f32x16 (&acc)[2][2], float* Cl) {
  const int lane = threadIdx.x & 63, wv = threadIdx.x >> 6, r32 = lane & 31, hi = lane >> 5, wm = wv >> 2, wn = wv & 3;
#pragma unroll
  for (int m = 0; m < 2; ++m)
#pragma unroll
    for (int n = 0; n < 2; ++n)
#pragma unroll
      for (int r = 0; r < 16; ++r) Cl[(64 * wm + 32 * m + crow(r, hi)) * CLD + 64 * wn + 32 * n + r32] = acc[m][n][r];
}

__device__ __forceinline__ void gemm_128x256_wide(const u16* __restrict__ A, int lda, const u16* __restrict__ Bt, int ldb, int KT, f32x16 (&acc)[4], char* lds) {
  const int tid = threadIdx.x, lane = tid & 63, wv = __builtin_amdgcn_readfirstlane(tid >> 6), r32 = lane & 31, hi = lane >> 5;
  const int rin = lane >> 3, cc = lane & 7;
  const u16* pa[2]; const u16* pb[4];
#pragma unroll
  for (int j = 0; j < 2; ++j) pa[j] = A + (size_t)(16 * wv + 8 * j + rin) * lda + 8 * (cc ^ (4 * j + (rin >> 1)));
#pragma unroll
  for (int i = 0; i < 4; ++i) pb[i] = Bt + (size_t)(32 * wv + 8 * i + rin) * ldb + 8 * (cc ^ (4 * (i & 1) + (rin >> 1)));
  const unsigned lb = __builtin_amdgcn_readfirstlane((unsigned)(uintptr_t)lds);
  const unsigned dA = lb + 2048 * wv, dB = lb + 16384 + 4096 * wv;
#define G_ISSUE(stage, kt_) do { const unsigned _so = (unsigned)(stage) * G_STAGE; const int _ko = (kt_) * 64;                     \
    dma16(pa[0] + _ko, dA + _so); dma16(pa[1] + _ko, dA + _so + 1024);                                                           \
    dma16(pb[0] + _ko, dB + _so); dma16(pb[1] + _ko, dB + _so + 1024); dma16(pb[2] + _ko, dB + _so + 2048); dma16(pb[3] + _ko, dB + _so + 3072); } while (0)
#pragma unroll
  for (int m = 0; m < 4; ++m)
#pragma unroll
    for (int r = 0; r < 16; ++r) acc[m][r] = 0.f;
  __syncthreads();
  G_ISSUE(0, 0);
  if (KT > 1) G_ISSUE(1, 1);
  const int xa = (r32 >> 1) & 7;
  const int aoff = r32 * 128, boff = 16384 + (32 * wv + r32) * 128;
  int st = 0;
  for (int kt = 0; kt < KT; ++kt) {
    if (kt + 1 < KT) asm volatile("s_waitcnt vmcnt(6)\n\ts_barrier" ::: "memory");
    else             asm volatile("s_waitcnt vmcnt(0)\n\ts_barrier" ::: "memory");
    const int s2 = st == 0 ? 2 : st - 1;
    if (kt + 2 < KT && wv < 4) G_ISSUE(s2, kt + 2);
    const char* buf = lds + st * G_STAGE;
    __builtin_amdgcn_s_setprio(1);
    bf16x8 fa[2][4], fb[2];
#define G_LDF(S, SET) do { const int _cb = ((2 * (S) + hi) ^ xa) << 4;                                                      \
      fa[SET][0] = *(const bf16x8*)(buf + aoff + _cb); fa[SET][1] = *(const bf16x8*)(buf + aoff + 4096 + _cb);              \
      fa[SET][2] = *(const bf16x8*)(buf + aoff + 8192 + _cb); fa[SET][3] = *(const bf16x8*)(buf + aoff + 12288 + _cb);      \
      fb[SET] = *(const bf16x8*)(buf + boff + _cb); } while (0)
#define G_MM(SET) do { acc[0] = MFMA32(fa[SET][0], fb[SET], acc[0]); acc[1] = MFMA32(fa[SET][1], fb[SET], acc[1]);         \
      acc[2] = MFMA32(fa[SET][2], fb[SET], acc[2]); acc[3] = MFMA32(fa[SET][3], fb[SET], acc[3]); } while (0)
    G_LDF(0, 0); __builtin_amdgcn_sched_barrier(0);
    G_LDF(1, 1); __builtin_amdgcn_sched_barrier(0); G_MM(0); __builtin_amdgcn_sched_barrier(0);
    G_LDF(2, 0); __builtin_amdgcn_sched_barrier(0); G_MM(1); __builtin_amdgcn_sched_barrier(0);
    G_LDF(3, 1); __builtin_amdgcn_sched_barrier(0); G_MM(0); __builtin_amdgcn_sched_barrier(0);
    G_MM(1);
#undef G_LDF
#undef G_MM
    __builtin_amdgcn_s_setprio(0);
    if (kt + 2 < KT && wv >= 4) G_ISSUE(s2, kt + 2);
    st = st == 2 ? 0 : st + 1;
  }
#undef G_ISSUE
  __syncthreads();
}

__device__ __forceinline__ void xcd_unit(int u, int per, int& panel, int& sub) {
  if (gridDim.x == 256) { const int x = u & 7, k = ((u & 255) >> 3) + 32 * (u >> 8); panel = x + 8 * (k / per); sub = k % per; }
  else { panel = u / per; sub = u % per; }
}
__device__ void phase1b(const Args& a, char* lds) {
  unsigned char* ws = a.ws;
  const int tid = threadIdx.x, lane = tid & 63, wv = tid >> 6;
  const u16* KEYS = (const u16*)(ws + WS_KEYS); const u16* WPQB = (const u16*)(ws + WS_WPQ); u16* WST = (u16*)(ws + WS_WST);
  const float* modp = (const float*)(ws + WS_MODP); float* BIASP = (float*)(ws + WS_BIASP);
  char* gl = lds + LDS_DATA; float* Cl = (float*)gl;
  float* gsl = (float*)(gl + 131584);
  for (int u = blockIdx.x; u < 256; u += gridDim.x) {
    const int hh = u >> 4, nt = (u >> 2) & 3, b = u & 3;
    f32x16 acc[2][2];
    gemm_128x256(KEYS + (size_t)hh * 16384, 128, WPQB + (size_t)(nt * 256) * 2048 + hh * 128, 2048, 2, acc, gl);
    acc_to_lds(acc, Cl);
    for (int j = tid; j < 512; j += 512) {
      const int which = j >> 8, k = nt * 256 + (j & 255), m = (which ? 3072 : 4096) + k;
      float v = a.b_ada[m];
#pragma unroll
      for (int ks = 0; ks < 8; ++ks) v += modp[(ks * 4 + b) * 6144 + m];
      gsl[j] = which ? v : a.g_norm2[k] * (1.f + v);
    }
    __syncthreads();
    for (int i = 0; i < 16; ++i) {
      const int row = wv * 16 + i; const size_t n = (size_t)hh * 128 + row;
      float bp = 0.f, w[4];
#pragma unroll
      for (int j = 0; j < 4; ++j) { const float v = Cl[row * CLD + 4 * lane + j]; w[j] = v * gsl[4 * lane + j]; bp += v * gsl[256 + 4 * lane + j]; }
      *(uint2*)(WST + ((size_t)b * 2048 + n) * 1024 + nt * 256 + 4 * lane) = make_uint2(pack2(w[0], w[1]), pack2(w[2], w[3]));
      bp = wave_sum(bp);
      if (lane == 0) BIASP[((size_t)nt * 4 + b) * 2048 + n] = bp;
    }
    __syncthreads();
  }
}

__device__ void phase2(const Args& a, char* lds) {
  unsigned char* ws = a.ws;
  const int tid = threadIdx.x, lane = tid & 63, wv = tid >> 6;
  const u16* H = (const u16*)(ws + WS_H); const u16* WIN = (const u16*)(ws + WS_WIN);
  u16* QA = (u16*)(ws + WS_QA); u16* KV = (u16*)(ws + WS_KV); u16* UACT = (u16*)(ws + WS_UACT); u16* GVT = (u16*)(ws + WS_GVT);
  float* SSQV = (float*)(ws + WS_SSQV); const float* CS = (const float*)(ws + WS_CS);
  char* gl = lds + LDS_DATA; float* Cl = (float*)gl;
  for (int u = blockIdx.x; u < 128 * 6; u += gridDim.x) {
    int mt, nt; xcd_unit(u, 6, mt, nt); const int R0 = mt * 128;
    f32x16 acc[2][2];
    gemm_128x256(H + (size_t)R0 * 1024, 1024, WIN + (size_t)(nt * 256) * 1024, 1024, 16, acc, gl);
    acc_to_lds(acc, Cl);
    __syncthreads();
    if (nt == 0) {
      for (int i = 0; i < 16; ++i) {
        const int row = wv * 16 + i; float v[4], ssq = 0.f;
#pragma unroll
        for (int j = 0; j < 4; ++j) { v[j] = Cl[row * CLD + lane + 64 * j]; ssq += v[j] * v[j]; }
        ssq = wave_sum(ssq);
        const float rstd = rsqrtf(ssq * (1.f / 256.f) + EPS);
#pragma unroll
        for (int j = 0; j < 4; ++j) { const int col = lane + 64 * j; QA[(size_t)(R0 + row) * 256 + col] = f2bf(v[j] * rstd * a.g_q_a[col]); }
      }
    } else if (nt == 1) {
#pragma unroll 4
      for (int i = 0; i < 16; ++i) {
        const int row = wv * 16 + i, tok = R0 + row;
        const float v0 = Cl[row * CLD + lane], v1 = Cl[row * CLD + 64 + lane];
        const float ssq = wave_sum(v0 * v0 + v1 * v1);
        const float rstd = rsqrtf(ssq * (1.f / 128.f) + EPS);
        KV[(size_t)tok * 192 + lane] = f2bf(v0 * rstd * a.g_kv_a[lane]);
        KV[(size_t)tok * 192 + 64 + lane] = f2bf(v1 * rstd * a.g_kv_a[64 + lane]);
        if (lane < 32) {
          const float x1 = Cl[row * CLD + 128 + lane], x2 = Cl[row * CLD + 160 + lane];
          const float cs = CS[(size_t)tok * 64 + lane], sn = CS[(size_t)tok * 64 + 32 + lane];
          KV[(size_t)tok * 192 + 128 + lane] = f2bf(x1 * cs - x2 * sn);
          KV[(size_t)tok * 192 + 160 + lane] = f2bf(x2 * cs + x1 * sn);
        }
      }
    } else if (nt < 4) {
      for (int i = 0; i < 16; ++i) {
        const int row = wv * 16 + i;
#pragma unroll
        for (int j = 0; j < 4; ++j) { const int col = lane + 64 * j; UACT[(size_t)(R0 + row) * 512 + (nt - 2) * 256 + col] = f2bf(gelu_exact(Cl[row * CLD + col])); }
      }
    } else {
      for (int i = 0; i < 16; ++i) {
        const int row = wv * 16 + i; float ssq = 0.f;
#pragma unroll
        for (int j = 0; j < 4; ++j) { const int col = lane + 64 * j; const float g = gelu_exact(Cl[row * CLD + col]); const float gb = bflo((unsigned)f2bf(g)); ssq += gb * gb; Cl[row * CLD + col] = gb; }
        ssq = wave_sum(ssq);
        if (lane == 0) SSQV[(size_t)(R0 + row) * 2 + (nt - 4)] = ssq;
      }
      __syncthreads();
      for (int i = 0; i < 32; ++i) {
        const int c = wv * 32 + i;
        const float g0 = Cl[(2 * lane) * CLD + c], g1 = Cl[(2 * lane + 1) * CLD + c];
        *(unsigned*)(GVT + ((size_t)mt * 512 + (nt - 4) * 256 + c) * 128 + 2 * lane) = pack2(g0, g1);
      }
    }
    __syncthreads();
  }
}

__device__ void phase3(const Args& a, char* lds) {
  unsigned char* ws = a.ws;
  const int tid = threadIdx.x, lane = tid & 63, wv = tid >> 6, r32 = lane & 31, hi = lane >> 5;
  const u16* QA = (const u16*)(ws + WS_QA); const u16* WQ2 = (const u16*)(ws + WS_WQ2);
  u16* Q = (u16*)(ws + WS_Q); const float* CS = (const float*)(ws + WS_CS);
  const u16* UACT = (const u16*)(ws + WS_UACT); const u16* GVT = (const u16*)(ws + WS_GVT); const u16* WSG = (const u16*)(ws + WS_WSG);
  const float* SSQV = (const float*)(ws + WS_SSQV); u16* Y = (u16*)(ws + WS_Y);
  char* gl = lds + LDS_DATA; float* Cl = (float*)gl;
  for (int u = blockIdx.x; u < 384; u += gridDim.x) {
    {
      int mt, nt; xcd_unit(u, 3, mt, nt); const int R0 = mt * 128;
      f32x16 acc[2][2];
      gemm_128x256(QA + (size_t)R0 * 256, 256, WQ2 + (size_t)(nt * 256) * 256, 256, 4, acc, gl);
      acc_to_lds(acc, Cl);
      __syncthreads();
      if (nt < 2) {
        for (int i = 0; i < 16; ++i) {
          const int row = wv * 16 + i;
#pragma unroll
          for (int j = 0; j < 4; ++j) { const int n = nt * 256 + lane + 64 * j; Q[(size_t)(R0 + row) * 768 + (n >> 7) * 192 + (n & 127)] = f2bf(Cl[row * CLD + lane + 64 * j]); }
        }
      } else {
#pragma unroll 4
        for (int i = 0; i < 16; ++i) {
          const int row = wv * 16 + i, tok = R0 + row;
#pragma unroll
          for (int j = 0; j < 2; ++j) {
            const int idx = lane + 64 * j, h = idx >> 5, jj = idx & 31;
            const float x1 = Cl[row * CLD + h * 64 + jj], x2 = Cl[row * CLD + h * 64 + 32 + jj];
            const float cs = CS[(size_t)tok * 64 + jj], sn = CS[(size_t)tok * 64 + 32 + jj];
            Q[(size_t)tok * 768 + h * 192 + 128 + jj] = f2bf(x1 * cs - x2 * sn);
            Q[(size_t)tok * 768 + h * 192 + 160 + jj] = f2bf(x2 * cs + x1 * sn);
          }
        }
      }
      __syncthreads();
    }
  }
  for (int su = blockIdx.x; su < 256; su += gridDim.x) {
    {
      const int c = su >> 1, ph = su & 1;
      float* rs = (float*)gl;
      float* Yl = (float*)(gl + 512);
      __syncthreads();
      if (tid < 128) { const size_t t = (size_t)c * 128 + tid; rs[tid] = rsqrtf((SSQV[t * 2] + SSQV[t * 2 + 1]) * (1.f / 512.f) + EPS); }
      __syncthreads();
      const int h = wv >> 1, dh = wv & 1;
      f32x16 acc[2][2];
#pragma unroll
      for (int m = 0; m < 2; ++m)
#pragma unroll
        for (int n = 0; n < 2; ++n)
#pragma unroll
          for (int r = 0; r < 16; ++r) acc[m][n][r] = 0.f;
      for (int s = 0; s < 8; ++s) {
        const int q0 = 16 * s + 8 * hi;
        bf16x8 af[2], bfr[2];
#pragma unroll
        for (int m = 0; m < 2; ++m) af[m] = *(const bf16x8*)(WSG + ((size_t)h * 128 + ph * 64 + 32 * m + r32) * 128 + q0);
        float rq[8];
#pragma unroll
        for (int j = 0; j < 8; ++j) rq[j] = rs[q0 + j];
#pragma unroll
        for (int n = 0; n < 2; ++n) {
          const u32x4 w = *(const u32x4*)(GVT + ((size_t)c * 512 + h * 128 + dh * 64 + 32 * n + r32) * 128 + q0);
          u32x4 o;
#pragma unroll
          for (int k = 0; k < 4; ++k) o[k] = pack2(bflo(w[k]) * rq[2 * k], bfhi(w[k]) * rq[2 * k + 1]);
          bfr[n] = __builtin_bit_cast(bf16x8, o);
        }
#pragma unroll
        for (int m = 0; m < 2; ++m)
#pragma unroll
          for (int n = 0; n < 2; ++n) acc[m][n] = MFMA32(af[m], bfr[n], acc[m][n]);
      }
#pragma unroll
      for (int m = 0; m < 2; ++m)
#pragma unroll
        for (int n = 0; n < 2; ++n)
#pragma unroll
          for (int r = 0; r < 16; ++r) {
            const int pl = 32 * m + crow(r, hi), col = h * 128 + dh * 64 + 32 * n + r32;
            const size_t tok = (size_t)c * 128 + ph * 64 + pl;
            const float mix = acc[m][n][r] * a.g_sg[col] + a.b_sg[h * 128 + ph * 64 + pl];
            Yl[pl * 513 + col] = bflo((unsigned)UACT[tok * 512 + col]) * mix;
          }
      __syncthreads();
      for (int i = 0; i < 8; ++i) {
        const int pl = wv * 8 + i; const size_t tok = (size_t)c * 128 + ph * 64 + pl;
        float v[8], ssq = 0.f;
#pragma unroll
        for (int j = 0; j < 8; ++j) { v[j] = Yl[pl * 513 + lane + 64 * j]; ssq += v[j] * v[j]; }
        ssq = wave_sum(ssq);
        const float rstd = rsqrtf(ssq * (1.f / 512.f) + EPS);
#pragma unroll
        for (int j = 0; j < 8; ++j) { const int col = lane + 64 * j; Y[tok * 1024 + 512 + col] = f2bf(v[j] * rstd * a.g_sg_out[col]); }
      }
      __syncthreads();
    }
  }
}

constexpr float ATT_SCALE = 0.07216878364870322f;
constexpr float ATT_THR = 8.f;
constexpr int KVBUF = 24576;
#define SBAR() __builtin_amdgcn_sched_barrier(0)
__device__ __forceinline__ unsigned cvtpk(float lo, float hi) { unsigned r; asm volatile("v_cvt_pk_bf16_f32 %0, %1, %2" : "=v"(r) : "v"(lo), "v"(hi)); return r; }
__device__ __forceinline__ unsigned off_a(unsigned row, unsigned ch) { return 2048u * (row >> 3) + 512u * (ch >> 2) + 64u * (row & 7) + 16u * ((ch & 3) ^ ((row >> 2) & 3)); }

__device__ __forceinline__ void partialSM(f32x16& p0, f32x16& p1, float& m_reg, float& mn, float& alpha) {
  constexpr float C = ATT_SCALE * 1.4426950408889634f;
  float pmax = p0[0];
#pragma unroll
  for (int r = 1; r < 16; ++r) pmax = fmaxf(pmax, p0[r]);
#pragma unroll
  for (int r = 0; r < 16; ++r) pmax = fmaxf(pmax, p1[r]);
  { auto rr = __builtin_amdgcn_permlane32_swap(__float_as_uint(pmax), __float_as_uint(pmax), false, false);
    pmax = fmaxf(__uint_as_float(rr[0]), __uint_as_float(rr[1])); }
  if (__builtin_expect(__all(pmax - m_reg <= ATT_THR / ATT_SCALE), 1)) { mn = m_reg; alpha = 1.f; }
  else { mn = fmaxf(m_reg, pmax); alpha = __builtin_amdgcn_exp2f((m_reg - mn) * C); m_reg = mn; }
  const float mnC = -mn * C;
#pragma unroll
  for (int r = 0; r < 16; ++r) p0[r] = fmaf(p0[r], C, mnC);
#pragma unroll
  for (int r = 0; r < 16; ++r) p1[r] = fmaf(p1[r], C, mnC);
#pragma unroll
  for (int r = 0; r < 16; ++r) p0[r] = __builtin_amdgcn_exp2f(p0[r]);
}
__device__ __forceinline__ void finishSM(f32x16& p0, f32x16& p1, float alpha, float& l_reg, bf16x8& pa0, bf16x8& pa1, bf16x8& pa2, bf16x8& pa3) {
#pragma unroll
  for (int r = 0; r < 16; ++r) p1[r] = __builtin_amdgcn_exp2f(p1[r]);
  float ps = 0;
#pragma unroll
  for (int r = 0; r < 16; ++r) ps += p0[r];
#pragma unroll
  for (int r = 0; r < 16; ++r) ps += p1[r];
  { auto rr = __builtin_amdgcn_permlane32_swap(__float_as_uint(ps), __float_as_uint(ps), false, false);
    ps = __uint_as_float(rr[0]) + __uint_as_float(rr[1]); }
  l_reg = l_reg * alpha + ps;
#define PK4(P, BASE, OUT) do { unsigned a0 = cvtpk(P[BASE + 0], P[BASE + 1]), a1 = cvtpk(P[BASE + 2], P[BASE + 3]);   \
    unsigned b0 = cvtpk(P[BASE + 4], P[BASE + 5]), b1 = cvtpk(P[BASE + 6], P[BASE + 7]);                              \
    auto r0 = __builtin_amdgcn_permlane32_swap(a0, b0, false, false); auto r1 = __builtin_amdgcn_permlane32_swap(a1, b1, false, false); \
    u32x4 w = {r0[0], r1[0], r0[1], r1[1]}; OUT = __builtin_bit_cast(bf16x8, w); } while (0)
  PK4(p0, 0, pa0); PK4(p0, 8, pa1); PK4(p1, 0, pa2); PK4(p1, 8, pa3);
#undef PK4
}
__device__ __forceinline__ void qkt192(f32x16& p0, f32x16& p1, const char* kb, const bf16x8* qr, int ke, int ko, int kr) {
#pragma unroll
  for (int r = 0; r < 16; ++r) { p0[r] = 0.f; p1[r] = 0.f; }
#pragma unroll
  for (int d0 = 0; d0 < 8; ++d0) {
    const int o = ((d0 & 1) ? ko : ke) + 512 * (d0 >> 1);
    const bf16x8 b0 = *(const bf16x8*)(kb + o), b1 = *(const bf16x8*)(kb + o + 8192);
    p0 = MFMA32(b0, qr[d0], p0); p1 = MFMA32(b1, qr[d0], p1);
  }
#pragma unroll
  for (int d1 = 0; d1 < 4; ++d1) {
    const int o = 16384 + (kr ^ (32 * d1));
    const bf16x8 b0 = *(const bf16x8*)(kb + o), b1 = *(const bf16x8*)(kb + o + 4096);
    p0 = MFMA32(b0, qr[8 + d1], p0); p1 = MFMA32(b1, qr[8 + d1], p1);
  }
}
template <int OFF> __device__ __forceinline__ s16x4 tr_read(int vb) {
  s16x4 r; asm volatile("ds_read_b64_tr_b16 %0, %1 offset:%2" : "=&v"(r) : "v"(vb), "i"(OFF) : "memory"); return r;
}
template <int C> __device__ __forceinline__ void pv_one(f32x16& od, int vb0, int vb1, bf16x8 pa0, bf16x8 pa1, bf16x8 pa2, bf16x8 pa3) {
  const s16x4 l0 = tr_read<512 * C>(vb0), h0 = tr_read<512 * C>(vb1), l1 = tr_read<4096 + 512 * C>(vb0), h1 = tr_read<4096 + 512 * C>(vb1);
  const s16x4 l2 = tr_read<8192 + 512 * C>(vb0), h2 = tr_read<8192 + 512 * C>(vb1), l3 = tr_read<12288 + 512 * C>(vb0), h3 = tr_read<12288 + 512 * C>(vb1);
  asm volatile("s_waitcnt lgkmcnt(0)" ::: "memory"); SBAR();
#define PKV(L, H) (bf16x8){L[0], L[1], L[2], L[3], H[0], H[1], H[2], H[3]}
  od = MFMA32(pa0, PKV(l0, h0), od); od = MFMA32(pa1, PKV(l1, h1), od);
  od = MFMA32(pa2, PKV(l2, h2), od); od = MFMA32(pa3, PKV(l3, h3), od);
#undef PKV
}
__device__ __forceinline__ void pv_all(f32x16* o, int vb0, int vb1, bf16x8 pa0, bf16x8 pa1, bf16x8 pa2, bf16x8 pa3) {
  pv_one<0>(o[0], vb0, vb1, pa0, pa1, pa2, pa3); pv_one<1>(o[1], vb0, vb1, pa0, pa1, pa2, pa3);
  pv_one<2>(o[2], vb0, vb1, pa0, pa1, pa2, pa3); pv_one<3>(o[3], vb0, vb1, pa0, pa1, pa2, pa3);
}

__device__ void phase4(const Args& a, char* lds) {
  unsigned char* ws = a.ws;
  const int tid = threadIdx.x, wid = tid >> 6, lane = tid & 63, r32 = lane & 31, hi = lane >> 5;
  const u16* Qg = (const u16*)(ws + WS_Q); const u16* KVg = (const u16*)(ws + WS_KV); const u16* WUV = (const u16*)(ws + WS_WUV);
  u16* Y = (u16*)(ws + WS_Y);
  char* gl = lds + LDS_DATA;
  char* kvl = gl;
  float* wsl = (float*)(gl + 2 * KVBUF) + wid * 64; float* li_l = wsl; float* al_l = wsl + 32;
  char* Ol = gl + 2 * KVBUF + 2048 + wid * 8704;
  float* Yl = (float*)gl;
  const int head = wid >> 1, qh = wid & 1;
  int sdst[3];
#pragma unroll
  for (int j = 0; j < 3; ++j) { const int id = tid + 512 * j, key = id / 24, ch = id % 24;
    sdst[j] = ch < 16 ? (int)off_a(key, ch) : 16384 + key * 128 + (((ch - 16) ^ ((key >> 1) & 7)) << 4); }
  const int xq = (r32 >> 2) & 3;
  const int ke = 2048 * (r32 >> 3) + 64 * (r32 & 7) + 16 * (hi ^ xq), ko = 2048 * (r32 >> 3) + 64 * (r32 & 7) + 16 * ((2 + hi) ^ xq);
  const int kr = r32 * 128 + ((hi ^ ((r32 >> 1) & 7)) << 4);
  const int tb = lane >> 4 & 1, tq = (lane & 15) >> 2, tp = lane & 3;
  const int vbl = 2048 * hi + 64 * tq + 32 * (tb ^ hi) + 8 * (tp & 1);
  const int lbase = (int)(uintptr_t)kvl;
  const int vb0 = lbase + vbl + 16 * (tp >> 1), vb1 = lbase + vbl + 256 + 16 * ((tp >> 1) ^ 1);
  for (int u = blockIdx.x; u < 256; u += gridDim.x) {
    const int b = u >> 6, qb = u & 63;
    const size_t tok0 = (size_t)b * SEQ + qb * 64 + qh * 32;
    const u16* KVb = KVg + (size_t)b * SEQ * 192;
    float m_reg = -1e30f, l_reg = 0.f; f32x16 o[4]; bf16x8 qr[12];
#pragma unroll
    for (int d = 0; d < 4; ++d)
#pragma unroll
      for (int r = 0; r < 16; ++r) o[d][r] = 0.f;
    { const u16* Qw = Qg + (tok0 + r32) * 768 + head * 192 + hi * 8;
#pragma unroll
      for (int d0 = 0; d0 < 12; ++d0) qr[d0] = *(const bf16x8*)(Qw + d0 * 16); }
    u32x4 st0[3];
#define SLOAD(S, k0) do { const u16* _p = KVb + (size_t)(k0) * 192 + tid * 8; S[0] = *(const u32x4*)_p; S[1] = *(const u32x4*)(_p + 4096); S[2] = *(const u32x4*)(_p + 8192); } while (0)
#define SWRITE(bufi, S) do { char* _d = kvl + (bufi) * KVBUF; *(u32x4*)(_d + sdst[0]) = S[0]; *(u32x4*)(_d + sdst[1]) = S[1]; *(u32x4*)(_d + sdst[2]) = S[2]; } while (0)
#define RESC(al) do { if (__any((al) < 1.f)) { if (hi == 0) al_l[r32] = (al); asm volatile("s_waitcnt lgkmcnt(0)" ::: "memory"); \
    _Pragma("unroll") for (int d = 0; d < 4; ++d) _Pragma("unroll") for (int r = 0; r < 16; ++r) o[d][r] *= al_l[crow(r, hi)]; } } while (0)
    constexpr int NT = SEQ / 64;
    __syncthreads();
    SLOAD(st0, 0); SWRITE(0, st0); SLOAD(st0, 64); __syncthreads();
    for (int j = 0; j < NT; ++j) {
      const int bo = (j & 1) * KVBUF;
      f32x16 p0, p1; float mn, al; bf16x8 pa0, pa1, pa2, pa3;
      qkt192(p0, p1, kvl + bo, qr, ke, ko, kr);
      partialSM(p0, p1, m_reg, mn, al);
      RESC(al);
      finishSM(p0, p1, al, l_reg, pa0, pa1, pa2, pa3);
      if (j + 1 < NT) { SWRITE((j + 1) & 1, st0); if (j + 2 < NT) SLOAD(st0, (j + 2) * 64); }
      const unsigned cit = ((unsigned)(u * 64 + j) << 9) | (unsigned)tid;
      const bool cisv = cit >= 4194304u; const unsigned cio = cisv ? cit - 4194304u : cit;
      const float4 cf = *(const float4*)((cisv ? a.peer_v : a.peer_u) + (size_t)cio * 4);
      SBAR();
      pv_all(o, vb0 + bo, vb1 + bo, pa0, pa1, pa2, pa3);
      { const float csc = cisv ? PEER_SV : PEER_SU;
        int cp = __builtin_amdgcn_cvt_pk_fp8_f32(cf.x * csc, cf.y * csc, 0, false); cp = __builtin_amdgcn_cvt_pk_fp8_f32(cf.z * csc, cf.w * csc, cp, true);
        *(int*)(ws + (cisv ? WS_VB : WS_UB) + (size_t)cio * 4) = cp; }
      __syncthreads();
    }
#undef SLOAD
#undef SWRITE
#undef RESC
    int r32e = r32, hie = hi, lne = lane;
    asm volatile("" : "+v"(r32e), "+v"(hie), "+v"(lne));
    if (hie == 0) li_l[r32e] = l_reg;
    asm volatile("s_waitcnt lgkmcnt(0)" ::: "memory");
#pragma unroll
    for (int r = 0; r < 16; ++r) {
      const int q = crow(r, hie); const float rl = __builtin_amdgcn_rcpf(li_l[q]);
#pragma unroll
      for (int d = 0; d < 4; ++d) *(u16*)(Ol + q * 272 + (32 * d + r32e) * 2) = f2bf(o[d][r] * rl);
    }
    asm volatile("s_waitcnt lgkmcnt(0)" ::: "memory");
    f32x16 y[4];
#pragma unroll
    for (int n = 0; n < 4; ++n)
#pragma unroll
      for (int r = 0; r < 16; ++r) y[n][r] = 0.f;
    const u16* wuv = WUV + ((size_t)head * 128 + r32e) * 128 + 8 * hie;
#pragma unroll 2
    for (int s = 0; s < 8; ++s) {
      const bf16x8 af = *(const bf16x8*)(Ol + r32e * 272 + (16 * s + 8 * hie) * 2);
#pragma unroll
      for (int n = 0; n < 4; ++n) {
        const bf16x8 bw = *(const bf16x8*)(wuv + 32 * n * 128 + 16 * s);
        y[n] = MFMA32(af, bw, y[n]);
      }
    }
    __syncthreads();
#pragma unroll
    for (int n = 0; n < 4; ++n)
#pragma unroll
      for (int r = 0; r < 16; ++r) Yl[(qh * 32 + crow(r, hie)) * 513 + head * 128 + 32 * n + r32e] = y[n][r];
    __syncthreads();
    for (int i = 0; i < 8; ++i) {
      const int pl = wid * 8 + i; const size_t tok = (size_t)b * SEQ + qb * 64 + pl;
      float v[8], ssq = 0.f;
#pragma unroll
      for (int jj = 0; jj < 8; ++jj) { v[jj] = Yl[pl * 513 + lne + 64 * jj]; ssq += v[jj] * v[jj]; }
      ssq = wave_sum(ssq);
      const float rstd = rsqrtf(ssq * (1.f / 512.f) + EPS);
#pragma unroll
      for (int jj = 0; jj < 8; ++jj) { const int col = lne + 64 * jj; Y[tok * 1024 + col] = f2bf(v[jj] * rstd * a.g_attn_out[col]); }
    }
    __syncthreads();
  }
}

__device__ void phase5(const Args& a, char* lds) {
  unsigned char* ws = a.ws;
  const int tid = threadIdx.x, lane = tid & 63, wv = tid >> 6;
  const u16* Y = (const u16*)(ws + WS_Y); const u16* WO = (const u16*)(ws + WS_WO);
  float* X1 = (float*)(ws + WS_X1); float* SSQ = (float*)(ws + WS_SSQ); const float* mod = (const float*)(ws + WS_MOD);
  u16* X1B = (u16*)(ws + WS_H);
  char* gl = lds + LDS_DATA; float* Cl = (float*)gl;
  for (int u = blockIdx.x; u < 128 * 4; u += gridDim.x) {
    int mt, nt; xcd_unit(u, 4, mt, nt); const int R0 = mt * 128, b = R0 >> 12;
    f32x16 acc[2][2];
    gemm_128x256(Y + (size_t)R0 * 1024, 1024, WO + (size_t)(nt * 256) * 1024, 1024, 16, acc, gl);
    acc_to_lds(acc, Cl);
    __syncthreads();
    float2 g1[2];
#pragma unroll
    for (int j = 0; j < 2; ++j) g1[j] = *(const float2*)(mod + b * 6144 + 2048 + nt * 256 + 2 * lane + 128 * j);
    for (int i0 = 0; i0 < 16; i0 += 8) {
      float2 xv[8][2];
#pragma unroll
      for (int i = 0; i < 8; ++i)
#pragma unroll
        for (int j = 0; j < 2; ++j) xv[i][j] = *(const float2*)(a.x + (size_t)(R0 + wv * 16 + i0 + i) * 1024 + nt * 256 + 2 * lane + 128 * j);
#pragma unroll
      for (int i = 0; i < 8; ++i) {
        const int row = wv * 16 + i0 + i; const size_t tok = R0 + row; float ssq = 0.f;
#pragma unroll
        for (int j = 0; j < 2; ++j) {
          const int col = nt * 256 + 2 * lane + 128 * j;
          const float v0 = xv[i][j].x + g1[j].x * Cl[row * CLD + 2 * lane + 128 * j], v1 = xv[i][j].y + g1[j].y * Cl[row * CLD + 2 * lane + 128 * j + 1];
          *(unsigned*)(X1B + tok * 1024 + col) = pack2(v0, v1); ssq += v0 * v0 + v1 * v1;
        }
        ssq = wave_sum(ssq);
        if (lane == 0) SSQ[tok * 4 + nt] = ssq;
      }
    }
    __syncthreads();
  }
}
__device__ void phase5b(const Args& a) {
  unsigned char* ws = a.ws;
  const int tid = threadIdx.x, lane = tid & 63, wv = tid >> 6;
  const float* X1 = (const float*)(ws + WS_X1); const float* SSQ = (const float*)(ws + WS_SSQ); const float* mod = (const float*)(ws + WS_MOD);
  u16* H = (u16*)(ws + WS_H);
  for (int u = blockIdx.x; u < T / 64; u += gridDim.x) {
    const int b = u >> 6;
    float4 sh[4], sc[4], g[4];
#pragma unroll
    for (int j = 0; j < 4; ++j) {
      const int col = j * 256 + lane * 4;
      sh[j] = *(const float4*)(mod + b * 6144 + 3072 + col); sc[j] = *(const float4*)(mod + b * 6144 + 4096 + col); g[j] = *(const float4*)(a.g_norm2 + col);
    }
    for (int i = 0; i < 8; ++i) {
      const size_t r = (size_t)u * 64 + wv * 8 + i;
      const float4 sq = *(const float4*)(SSQ + r * 4);
      const float rstd = rsqrtf((sq.x + sq.y + sq.z + sq.w) * (1.f / 1024.f) + EPS);
#pragma unroll
      for (int j = 0; j < 4; ++j) {
        const int col = j * 256 + lane * 4;
        const float4 xv = *(const float4*)(X1 + r * 1024 + col);
        const float h0 = xv.x * rstd * g[j].x * (1.f + sc[j].x) + sh[j].x, h1 = xv.y * rstd * g[j].y * (1.f + sc[j].y) + sh[j].y;
        const float h2 = xv.z * rstd * g[j].z * (1.f + sc[j].z) + sh[j].z, h3 = xv.w * rstd * g[j].w * (1.f + sc[j].w) + sh[j].w;
        uint2 o = {pack2(h0, h1), pack2(h2, h3)};
        *(uint2*)(H + r * 1024 + col) = o;
      }
    }
  }
}

__device__ __forceinline__ float vmaxf(float a, float b) { float r; asm("v_max_f32 %0, %1, %2" : "=v"(r) : "v"(a), "v"(b)); return r; }
__device__ __forceinline__ float vminf(float a, float b) { float r; asm("v_min_f32 %0, %1, %2" : "=v"(r) : "v"(a), "v"(b)); return r; }
#define TK_CE(x, y) do { const float _h = vmaxf((x), (y)); (y) = vminf((x), (y)); (x) = _h; } while (0)
#define TK_SORT16(t) do { TK_CE(t[0], t[1]); TK_CE(t[2], t[3]); TK_CE(t[0], t[2]); TK_CE(t[1], t[3]); TK_CE(t[1], t[2]); TK_CE(t[4], t[5]); TK_CE(t[6], t[7]); TK_CE(t[4], t[6]); TK_CE(t[5], t[7]); TK_CE(t[5], t[6]); TK_CE(t[0], t[4]); TK_CE(t[2], t[6]); TK_CE(t[2], t[4]); TK_CE(t[1], t[5]); TK_CE(t[3], t[7]); TK_CE(t[3], t[5]); TK_CE(t[1], t[2]); TK_CE(t[3], t[4]); TK_CE(t[5], t[6]); TK_CE(t[8], t[9]); TK_CE(t[10], t[11]); TK_CE(t[8], t[10]); TK_CE(t[9], t[11]); TK_CE(t[9], t[10]); TK_CE(t[12], t[13]); TK_CE(t[14], t[15]); TK_CE(t[12], t[14]); TK_CE(t[13], t[15]); TK_CE(t[13], t[14]); TK_CE(t[8], t[12]); TK_CE(t[10], t[14]); TK_CE(t[10], t[12]); TK_CE(t[9], t[13]); TK_CE(t[11], t[15]); TK_CE(t[11], t[13]); TK_CE(t[9], t[10]); TK_CE(t[11], t[12]); TK_CE(t[13], t[14]); TK_CE(t[0], t[8]); TK_CE(t[4], t[12]); TK_CE(t[4], t[8]); TK_CE(t[2], t[10]); TK_CE(t[6], t[14]); TK_CE(t[6], t[10]); TK_CE(t[2], t[4]); TK_CE(t[6], t[8]); TK_CE(t[10], t[12]); TK_CE(t[1], t[9]); TK_CE(t[5], t[13]); TK_CE(t[5], t[9]); TK_CE(t[3], t[11]); TK_CE(t[7], t[15]); TK_CE(t[7], t[11]); TK_CE(t[3], t[5]); TK_CE(t[7], t[9]); TK_CE(t[11], t[13]); TK_CE(t[1], t[2]); TK_CE(t[3], t[4]); TK_CE(t[5], t[6]); TK_CE(t[7], t[8]); TK_CE(t[9], t[10]); TK_CE(t[11], t[12]); TK_CE(t[13], t[14]); } while (0)
#define TK_BMERGE16(t) do { TK_CE(t[0], t[8]); TK_CE(t[1], t[9]); TK_CE(t[2], t[10]); TK_CE(t[3], t[11]); TK_CE(t[4], t[12]); TK_CE(t[5], t[13]); TK_CE(t[6], t[14]); TK_CE(t[7], t[15]); TK_CE(t[0], t[4]); TK_CE(t[1], t[5]); TK_CE(t[2], t[6]); TK_CE(t[3], t[7]); TK_CE(t[8], t[12]); TK_CE(t[9], t[13]); TK_CE(t[10], t[14]); TK_CE(t[11], t[15]); TK_CE(t[0], t[2]); TK_CE(t[1], t[3]); TK_CE(t[4], t[6]); TK_CE(t[5], t[7]); TK_CE(t[8], t[10]); TK_CE(t[9], t[11]); TK_CE(t[12], t[14]); TK_CE(t[13], t[15]); TK_CE(t[0], t[1]); TK_CE(t[2], t[3]); TK_CE(t[4], t[5]); TK_CE(t[6], t[7]); TK_CE(t[8], t[9]); TK_CE(t[10], t[11]); TK_CE(t[12], t[13]); TK_CE(t[14], t[15]); } while (0)
#define TK_MERGE(A, B) do { _Pragma("unroll") for (int _i = 0; _i < 16; ++_i) A[_i] = vmaxf(A[_i], B[15 - _i]); TK_BMERGE16(A); } while (0)
__constant__ unsigned long long TK_I[4] = {0x0000000000000000ull, 0x0007744411111111ull, 0x0006655333322222ull, 0x00000000FEDCBA98ull};
__constant__ unsigned long long TK_J[4] = {0xFEDCBA9876543210ull, 0x0001021076543210ull, 0x0001010321043210ull, 0x0000000000000000ull};
__constant__ int TK_N[4] = {16, 13, 13, 8};
#define TOP_INSERT(t, v) do { float _v = (v); _Pragma("unroll") for (int _i = 0; _i < 16; ++_i) { const float _h = vmaxf(t[_i], _v); _v = vminf(t[_i], _v); t[_i] = _h; } } while (0)

__device__ void phase6(const Args& a, char* lds) {
  unsigned char* ws = a.ws;
  const int tid = threadIdx.x, lane = tid & 63, wv = tid >> 6, r32 = lane & 31, hi = lane >> 5;
  const u16* H = (const u16*)(ws + WS_H); const u16* WST = (const u16*)(ws + WS_WST);
  float* TOPS = (float*)(ws + WS_TOPK);
  const float* BIASP = (const float*)(ws + WS_BIASP); const float* SSQ = (const float*)(ws + WS_SSQ);
  char* gl = lds + LDS_DATA;
  for (int u = blockIdx.x; u < 16 * 64; u += gridDim.x) {
    int tb, hh; xcd_unit(u, 16, tb, hh);
    const int b = tb >> 4;
    f32x16 sc[4];
    gemm_128x256_wide(WST + ((size_t)b * 2048 + hh * 128) * 1024, 1024, H + (size_t)tb * 256 * 1024, 1024, 16, sc, gl);
    float* bl = (float*)gl;
    if (tid < 128) bl[tid] = BIASP[((size_t)0 * 4 + b) * 2048 + hh * 128 + tid] + BIASP[((size_t)1 * 4 + b) * 2048 + hh * 128 + tid]
                           + BIASP[((size_t)2 * 4 + b) * 2048 + hh * 128 + tid] + BIASP[((size_t)3 * 4 + b) * 2048 + hh * 128 + tid];
    const float4 sq = *(const float4*)(SSQ + (size_t)(tb * 256 + 32 * wv + r32) * 4);
    const float rstd = rsqrtf((sq.x + sq.y + sq.z + sq.w) * (1.f / 1024.f) + EPS);
    __syncthreads();
    float g0[16], g1[16], g2[16], g3[16], p[16];
#pragma unroll
    for (int r = 0; r < 16; ++r) {
      const unsigned key = crow(r, hi);
      g0[r] = __uint_as_float((__float_as_uint(fmaf(sc[0][r], rstd, bl[key])) & ~127u) | key);
      g1[r] = __uint_as_float((__float_as_uint(fmaf(sc[1][r], rstd, bl[32 + key])) & ~127u) | (32u + key));
      g2[r] = __uint_as_float((__float_as_uint(fmaf(sc[2][r], rstd, bl[64 + key])) & ~127u) | (64u + key));
      g3[r] = __uint_as_float((__float_as_uint(fmaf(sc[3][r], rstd, bl[96 + key])) & ~127u) | (96u + key));
    }
    TK_SORT16(g0); TK_SORT16(g1); TK_SORT16(g2); TK_SORT16(g3);
    TK_MERGE(g0, g1); TK_MERGE(g2, g3); TK_MERGE(g0, g2);
#pragma unroll
    for (int i = 0; i < 16; ++i) {
      auto rr = __builtin_amdgcn_permlane32_swap(__float_as_uint(g0[i]), __float_as_uint(g0[i]), false, false);
      p[i] = __uint_as_float(hi ? rr[0] : rr[1]);
    }
    TK_MERGE(g0, p);
    if (hi == 0) {
      float* dst = TOPS + ((size_t)(tb * 256 + 32 * wv + r32) * 16 + hh) * 16;
#pragma unroll
      for (int i = 0; i < 16; i += 4) *(float4*)(dst + i) = make_float4(g0[i], g0[i + 1], g0[i + 2], g0[i + 3]);
    }
  }
}

typedef __attribute__((ext_vector_type(4))) float f32x4;
#define MFMA4(a, b, c) __builtin_amdgcn_mfma_f32_4x4x4bf16_1k((a), (b), (c), 0, 0, 0)
constexpr int P7_VROW = 2112, P7_VBUF = 4 * P7_VROW;
constexpr int P7_RING = 64;
constexpr int P7_ENT  = P7_RING + 8 * 2 * P7_VBUF;
constexpr int P7_CNT  = P7_ENT + 8 * 2048;
static_assert(P7_CNT + 8 * 256 <= LDS_BYTES, "phase 7 LDS map");
__device__ __forceinline__ float sel4(const f32x4& d, int k) { return k == 0 ? d[0] : (k == 1 ? d[1] : (k == 2 ? d[2] : d[3])); }
__device__ __forceinline__ unsigned fp8x2_bf16(unsigned x, float sc, bool hi) {
  return hi ? __builtin_bit_cast(unsigned, __builtin_amdgcn_cvt_scalef32_pk_bf16_fp8(x, sc, true)) : __builtin_bit_cast(unsigned, __builtin_amdgcn_cvt_scalef32_pk_bf16_fp8(x, sc, false));
}

__device__ void phase7(const Args& a, char* lds) {
  unsigned char* ws = a.ws;
  const int tid = threadIdx.x, lane = tid & 63, wv = __builtin_amdgcn_readfirstlane(tid >> 6), blk = lane >> 2, j4 = lane & 3;
  const u16* H = (const u16*)(ws + WS_H); const unsigned char* U8 = ws + WS_UB; const unsigned char* V8 = ws + WS_VB;
  const float* TOPS = (const float*)(ws + WS_TOPK); const float* X1 = (const float*)(ws + WS_X1); const float* mod = (const float*)(ws + WS_MOD);
  const float* SSQ = (const float*)(ws + WS_SSQ);
  const unsigned lbase = (unsigned)(uintptr_t)lds;
  char* ring = lds + P7_RING + wv * 2 * P7_VBUF;
  unsigned* ents = (unsigned*)(lds + P7_ENT + wv * 2048);
  int* cntw = (int*)(lds + P7_CNT + wv * 256);
  const int trb = (int)(lbase + P7_RING + wv * 2 * P7_VBUF) + ((lane & 15) >> 2) * P7_VROW + 32 * (lane >> 4) + 8 * (lane & 3);
  const int NWV = gridDim.x * 8;
  for (int qd = blockIdx.x * 8 + wv; qd < T / 4; qd += NWV) {
    const int tok0 = qd * 4, b = tok0 >> 12;
    float* TS = (float*)ring;
#pragma unroll
    for (int i = 0; i < 4; ++i) *(float4*)(TS + 256 * i + 4 * lane) = *(const float4*)(TOPS + (size_t)tok0 * 256 + 256 * i + 4 * lane);
    cntw[lane] = 0;
    asm volatile("s_waitcnt lgkmcnt(0)" ::: "memory");
    unsigned ec[8];
#pragma unroll
    for (int rd = 0; rd < 2; ++rd) {
      const int combo = (lane >> 2) + 16 * rd, tl = combo >> 3, hd = combo & 7, q = lane & 3;
      const float* t1 = TS + (tl * 16 + hd * 2) * 16; const float* t2 = t1 + 16;
      const unsigned long long ip = TK_I[q], jp = TK_J[q]; const int cn = TK_N[q];
      float L[16], P[16];
#pragma unroll
      for (int c = 0; c < 16; ++c) {
        const unsigned i = (unsigned)(ip >> (4 * c)) & 15u, j = (unsigned)(jp >> (4 * c)) & 15u;
        const float sm = t1[i] + t2[j];
        L[c] = c < cn ? __uint_as_float((__float_as_uint(sm) & ~255u) | (i << 4) | j) : -3.0e38f;
      }
      TK_SORT16(L);
#pragma unroll
      for (int c = 0; c < 16; ++c) P[c] = __uint_as_float(__builtin_amdgcn_update_dpp(0, __float_as_uint(L[c]), 0xB1, 0xf, 0xf, false));
      TK_MERGE(L, P);
#pragma unroll
      for (int c = 0; c < 16; ++c) P[c] = __uint_as_float(__builtin_amdgcn_update_dpp(0, __float_as_uint(L[c]), 0x4E, 0xf, 0xf, false));
      TK_MERGE(L, P);
      float sum = 0.f;
      const float m0 = __uint_as_float(__float_as_uint(L[0]) & ~255u);
#pragma unroll
      for (int c = 0; c < 16; ++c) sum += __expf(__uint_as_float(__float_as_uint(L[c]) & ~255u) - m0);
      const float inv = 1.f / sum;
#pragma unroll
      for (int r = 0; r < 4; ++r) {
        const float lv = q == 0 ? L[r] : (q == 1 ? L[4 + r] : (q == 2 ? L[8 + r] : L[12 + r]));
        const unsigned bits = __float_as_uint(lv), id = bits & 255u;
        const unsigned i1 = __float_as_uint(t1[id >> 4]) & 127u, i2 = __float_as_uint(t2[id & 15u]) & 127u;
        const float gate = __expf(__uint_as_float(bits & ~255u) - m0) * inv;
        ec[4 * rd + r] = (i1 * 128u + i2) | ((unsigned)tl << 14) | (pack2(0.f, gate) & 0xFFFF0000u);
      }
    }
    {
#pragma unroll
      for (int i = 0; i < 8; ++i) atomicAdd(&cntw[(ec[i] & 0x3FFFu) >> 8], 1);
      asm volatile("s_waitcnt lgkmcnt(0)" ::: "memory");
      const int c = cntw[lane]; int inc = c;
#pragma unroll
      for (int o = 1; o < 64; o <<= 1) { const int v = __shfl_up(inc, o, 64); if (lane >= o) inc += v; }
      asm volatile("s_waitcnt lgkmcnt(0)" ::: "memory");
      cntw[lane] = inc - c;
      asm volatile("s_waitcnt lgkmcnt(0)" ::: "memory");
#pragma unroll
      for (int i = 0; i < 8; ++i) { const int pos = atomicAdd(&cntw[(ec[i] & 0x3FFFu) >> 8], 1); ents[pos] = ec[i]; }
      asm volatile("s_waitcnt lgkmcnt(0)" ::: "memory");
    }
    u32x4 hA[4][2];
    { const float4 sq = *(const float4*)(SSQ + (size_t)(tok0 + j4) * 4);
      const float rstd = rsqrtf((sq.x + sq.y + sq.z + sq.w) * (1.f / 1024.f) + EPS);
#pragma unroll
      for (int i = 0; i < 4; ++i)
#pragma unroll
        for (int hf = 0; hf < 2; ++hf) {
          const int k0 = 256 * i + 16 * blk + 8 * hf;
          const u32x4 xb = *(const u32x4*)(H + (size_t)(tok0 + j4) * 1024 + k0);
          float hv[8];
#pragma unroll
          for (int e = 0; e < 8; e += 4) {
            const float4 g = *(const float4*)(a.g_norm2 + k0 + e), sc4 = *(const float4*)(mod + b * 6144 + 4096 + k0 + e), sh4 = *(const float4*)(mod + b * 6144 + 3072 + k0 + e);
            hv[e]     = bflo(xb[e >> 1]) * rstd * g.x * (1.f + sc4.x) + sh4.x;     hv[e + 1] = bfhi(xb[e >> 1]) * rstd * g.y * (1.f + sc4.y) + sh4.y;
            hv[e + 2] = bflo(xb[(e >> 1) + 1]) * rstd * g.z * (1.f + sc4.z) + sh4.z; hv[e + 3] = bfhi(xb[(e >> 1) + 1]) * rstd * g.w * (1.f + sc4.w) + sh4.w;
          }
          hA[i][hf] = (u32x4){pack2(hv[0], hv[1]), pack2(hv[2], hv[3]), pack2(hv[4], hv[5]), pack2(hv[6], hv[7])};
        } }
    f32x4 acc[16];
#pragma unroll
    for (int c = 0; c < 16; ++c) acc[c] = (f32x4){0.f, 0.f, 0.f, 0.f};
#define P7_VPHASE(bufi) do { const int _vb = trb + (bufi) * P7_VBUF;                                                            \
      { const s16x4 v0 = tr_read<0>(_vb), v1 = tr_read<128>(_vb), v2 = tr_read<256>(_vb), v3 = tr_read<384>(_vb),               \
                    v4 = tr_read<512>(_vb), v5 = tr_read<640>(_vb), v6 = tr_read<768>(_vb), v7 = tr_read<896>(_vb);               \
        asm volatile("s_waitcnt lgkmcnt(0)" ::: "memory"); SBAR();                                                                \
        acc[0] = MFMA4(awp, v0, acc[0]); acc[1] = MFMA4(awp, v1, acc[1]); acc[2] = MFMA4(awp, v2, acc[2]); acc[3] = MFMA4(awp, v3, acc[3]);   \
        acc[4] = MFMA4(awp, v4, acc[4]); acc[5] = MFMA4(awp, v5, acc[5]); acc[6] = MFMA4(awp, v6, acc[6]); acc[7] = MFMA4(awp, v7, acc[7]); } \
      { const s16x4 v0 = tr_read<1024>(_vb), v1 = tr_read<1152>(_vb), v2 = tr_read<1280>(_vb), v3 = tr_read<1408>(_vb),         \
                    v4 = tr_read<1536>(_vb), v5 = tr_read<1664>(_vb), v6 = tr_read<1792>(_vb), v7 = tr_read<1920>(_vb);           \
        asm volatile("s_waitcnt lgkmcnt(0)" ::: "memory"); SBAR();                                                                \
        acc[8] = MFMA4(awp, v0, acc[8]); acc[9] = MFMA4(awp, v1, acc[9]); acc[10] = MFMA4(awp, v2, acc[10]); acc[11] = MFMA4(awp, v3, acc[11]); \
        acc[12] = MFMA4(awp, v4, acc[12]); acc[13] = MFMA4(awp, v5, acc[13]); acc[14] = MFMA4(awp, v6, acc[14]); acc[15] = MFMA4(awp, v7, acc[15]); } } while (0)
    u32x4 u8[4], v8[4];
#define P7_LOADG(EN) do { const unsigned _ex = (EN) & 0x3FFFu; const unsigned char* _pu = U8 + (size_t)_ex * 1024 + 16 * blk;      \
      _Pragma("unroll") for (int _i = 0; _i < 4; ++_i) u8[_i] = *(const u32x4*)(_pu + 256 * _i);                                 \
      _Pragma("unroll") for (int _q = 0; _q < 4; ++_q) { const unsigned _eq = (unsigned)__builtin_amdgcn_readlane((int)_ex, _q);  \
        v8[_q] = *(const u32x4*)(V8 + (size_t)_eq * 1024 + 16 * lane); } } while (0)
    unsigned enc = ents[j4], enn = ents[4 + j4];
    P7_LOADG(enc);
    s16x4 awp = {0, 0, 0, 0};
    constexpr int NG = 128;
#pragma unroll 2
    for (int g = 0; g < NG; ++g) {
      if (g > 0) P7_VPHASE((g - 1) & 1);
      f32x4 d0 = {0.f, 0.f, 0.f, 0.f}, d1 = {0.f, 0.f, 0.f, 0.f};
#pragma unroll
      for (int i = 0; i < 4; ++i)
#pragma unroll
        for (int w = 0; w < 4; ++w) {
          const uint2 ub = {fp8x2_bf16(u8[i][w], 1.f / PEER_SU, false), fp8x2_bf16(u8[i][w], 1.f / PEER_SU, true)};
          const uint2 ha = {hA[i][w >> 1][2 * (w & 1)], hA[i][w >> 1][2 * (w & 1) + 1]};
          if (w & 1) d1 = MFMA4(__builtin_bit_cast(s16x4, ha), __builtin_bit_cast(s16x4, ub), d1);
          else       d0 = MFMA4(__builtin_bit_cast(s16x4, ha), __builtin_bit_cast(s16x4, ub), d0);
        }
      { char* vw = ring + (g & 1) * P7_VBUF + lane * 32;
#pragma unroll
        for (int q = 0; q < 4; ++q) {
          u32x4 o0, o1;
          o0[0] = fp8x2_bf16(v8[q][0], 1.f / PEER_SV, false); o0[1] = fp8x2_bf16(v8[q][0], 1.f / PEER_SV, true);
          o0[2] = fp8x2_bf16(v8[q][1], 1.f / PEER_SV, false); o0[3] = fp8x2_bf16(v8[q][1], 1.f / PEER_SV, true);
          o1[0] = fp8x2_bf16(v8[q][2], 1.f / PEER_SV, false); o1[1] = fp8x2_bf16(v8[q][2], 1.f / PEER_SV, true);
          o1[2] = fp8x2_bf16(v8[q][3], 1.f / PEER_SV, false); o1[3] = fp8x2_bf16(v8[q][3], 1.f / PEER_SV, true);
          *(u32x4*)(vw + q * P7_VROW) = o0; *(u32x4*)(vw + q * P7_VROW + 16) = o1;
        } }
      unsigned en2 = 0u;
      if (g + 1 < NG) { P7_LOADG(enn); if (g + 2 < NG) en2 = ents[4 * (g + 2) + j4]; }
      const int tk = (enc >> 14) & 3;
      float av = sel4(d0, tk) + sel4(d1, tk);
      av += __uint_as_float(__builtin_amdgcn_update_dpp(0, __float_as_uint(av), 0x124, 0xf, 0xf, false));
      av += __uint_as_float(__builtin_amdgcn_update_dpp(0, __float_as_uint(av), 0x128, 0xf, 0xf, false));
      av += __shfl_xor(av, 16, 64);
      { auto rr = __builtin_amdgcn_permlane32_swap(__float_as_uint(av), __float_as_uint(av), false, false); av = __uint_as_float(rr[0]) + __uint_as_float(rr[1]); }
      const float wgt = gelu_exact(av) * __uint_as_float(enc & 0xFFFF0000u);
      float z[4];
#define P7_QB(x, k) __builtin_amdgcn_update_dpp(0, (x), (k) * 0x55, 0xf, 0xf, false)
      { const unsigned wb = __float_as_uint(wgt), tb = (unsigned)tk;
        unsigned w0 = P7_QB(wb, 0), w1 = P7_QB(wb, 1), w2 = P7_QB(wb, 2), w3 = P7_QB(wb, 3);
        unsigned t0 = P7_QB(tb, 0), t1 = P7_QB(tb, 1), t2 = P7_QB(tb, 2), t3 = P7_QB(tb, 3);
        asm volatile("" : "+v"(w0), "+v"(w1), "+v"(w2), "+v"(w3), "+v"(t0), "+v"(t1), "+v"(t2), "+v"(t3));
        z[0] = ((int)t0 == j4) ? __uint_as_float(w0) : 0.f; z[1] = ((int)t1 == j4) ? __uint_as_float(w1) : 0.f;
        z[2] = ((int)t2 == j4) ? __uint_as_float(w2) : 0.f; z[3] = ((int)t3 == j4) ? __uint_as_float(w3) : 0.f; }
#undef P7_QB
      { const uint2 pk = {pack2(z[0], z[1]), pack2(z[2], z[3])}; awp = __builtin_bit_cast(s16x4, pk); }
      enc = enn; enn = en2;
    }
#undef P7_LOADG
    P7_VPHASE((NG - 1) & 1);
#undef P7_VPHASE
    int lne = lane; asm volatile("" : "+v"(lne));
    float ss[4] = {0.f, 0.f, 0.f, 0.f};
#pragma unroll
    for (int c = 0; c < 16; ++c) {
      const float g2 = mod[b * 6144 + 5120 + 64 * c + lne];
#pragma unroll
      for (int r = 0; r < 4; ++r) { const float v = bflo((unsigned)H[(size_t)(tok0 + r) * 1024 + 64 * c + lne]) + g2 * acc[c][r]; acc[c][r] = v; ss[r] += v * v; }
    }
    float rstd[4];
#pragma unroll
    for (int r = 0; r < 4; ++r) rstd[r] = rsqrtf(wave_sum(ss[r]) * (1.f / 1024.f) + EPS);
#pragma unroll
    for (int c = 0; c < 16; ++c) {
      const float gf = a.g_final[64 * c + lne];
#pragma unroll
      for (int r = 0; r < 4; ++r) a.out[(size_t)(tok0 + r) * 1024 + 64 * c + lne] = acc[c][r] * rstd[r] * gf;
    }
  }
}

constexpr int N_PHASES = 8;
__global__ void __launch_bounds__(512, 2) fwd(Args args) {
  extern __shared__ __attribute__((aligned(16))) char lds[];
  if (threadIdx.x == 0) *(uint4*)lds = make_uint4(0u, 0u, 0u, 0u);
  __syncthreads();
  const int lo = args.ph_lo, hi = args.ph_hi;
  XcdBarrier bar; bar.bar = (unsigned*)(args.ws + WS_BAR); bar.x = 0; bar.st = (volatile LAS unsigned*)lds;
  if (hi - lo > 1) bar = xcd_barrier_post((unsigned*)(args.ws + WS_BAR), (volatile LAS unsigned*)lds);
#ifndef ONLY_PHASE
#define ONLY_PHASE -1
#endif
#define IN(k) (lo <= (k) && (k) < hi && (ONLY_PHASE < 0 || ONLY_PHASE == (k)))
#define SEAM(k) do { if (IN(k) && IN((k) + 1)) xcd_barrier(bar); } while (0)
  if (IN(0)) phase0(args, lds);
  SEAM(0);
  if (IN(1)) { phase1(args, lds); phase1b(args, lds); }
  SEAM(1);
  if (IN(2)) phase2(args, lds);
  SEAM(2);
  if (IN(3)) phase3(args, lds);
  SEAM(3);
  if (IN(4)) phase4(args, lds);
  SEAM(4);
  if (IN(5)) phase5(args, lds);
  SEAM(5);
  if (IN(6)) phase6(args, lds);
  SEAM(6);
  if (IN(7)) phase7(args, lds);
#undef IN
#undef SEAM
}

extern "C" void kernel_launch(void* const* d_in, const int* in_sizes, int n_in, void* d_out, int out_size, void* d_ws, size_t ws_size, hipStream_t stream) {
  static int grid = 0;
  if (grid == 0) {
    if (n_in != 23 || out_size != T * DM || ws_size < WS_END) { fprintf(stderr, "kernel_launch: unexpected shapes (n_in %d out %d ws %zu need %zu)\n", n_in, out_size, ws_size, (size_t)WS_END); grid = -1; return; }
    int dev = 0, cus = 0, per_cu = 0;
    (void)hipGetDevice(&dev); (void)hipDeviceGetAttribute(&cus, hipDeviceAttributeMultiprocessorCount, dev);
    if (hipFuncSetAttribute((const void*)fwd, hipFuncAttributeMaxDynamicSharedMemorySize, LDS_BYTES) != hipSuccess) { fprintf(stderr, "kernel_launch: hipFuncSetAttribute failed\n"); grid = -1; return; }
    if (hipOccupancyMaxActiveBlocksPerMultiprocessor(&per_cu, (const void*)fwd, 512, LDS_BYTES) != hipSuccess || per_cu < 1) { fprintf(stderr, "kernel_launch: occupancy query says %d\n", per_cu); per_cu = 1; }
    (void)hipGetLastError();
    grid = cus;
  }
  if (grid < 0) return;
  (void)hipMemsetAsync((char*)d_ws + WS_BAR, 0, 16384, stream);
  Args a{};
  a.x = (const float*)d_in[0]; a.c = (const float*)d_in[1]; a.pos = (const int*)d_in[2];
  a.w_ada = (const float*)d_in[3]; a.b_ada = (const float*)d_in[4]; a.g_norm1 = (const float*)d_in[5]; a.w_in = (const float*)d_in[6];
  a.g_q_a = (const float*)d_in[7]; a.w_uq = (const float*)d_in[8]; a.g_kv_a = (const float*)d_in[9]; a.w_ukv = (const float*)d_in[10];
  a.g_sg = (const float*)d_in[11]; a.w_sg = (const float*)d_in[12]; a.b_sg = (const float*)d_in[13]; a.g_attn_out = (const float*)d_in[14];
  a.g_sg_out = (const float*)d_in[15]; a.w_o = (const float*)d_in[16]; a.g_norm2 = (const float*)d_in[17]; a.w_peer_q = (const float*)d_in[18];
  a.peer_keys = (const float*)d_in[19]; a.peer_u = (const float*)d_in[20]; a.peer_v = (const float*)d_in[21]; a.g_final = (const float*)d_in[22];
  a.out = (float*)d_out; a.ws = (unsigned char*)d_ws;
#if N_LAUNCH_MODE == 0
  a.ph_lo = 0; a.ph_hi = N_PHASES;
  hipLaunchKernelGGL(fwd, dim3(grid), dim3(512), LDS_BYTES, stream, a);
#else
  for (int p = 0; p < N_PHASES; ++p) for (int rep = 0; rep <= ((DUP_MASK >> p) & 1); ++rep) { a.ph_lo = p; a.ph_hi = p + 1; hipLaunchKernelGGL(fwd, dim3(grid), dim3(512), LDS_BYTES, stream, a); }
#endif
  const hipError_t le = hipPeekAtLastError();
  if (le != hipSuccess) fprintf(stderr, "kernel_launch: launch failed: %s\n", hipGetErrorName(le));
}
```

```cpp
#include <hip/hip_runtime.h>
#include <stdint.h>
#include <stdio.h>

#define N_LAUNCH_MODE 0
#define DUP_MASK 0x000

typedef unsigned short u16;
typedef __attribute__((ext_vector_type(8))) short bf16x8;
typedef __attribute__((ext_vector_type(4))) short s16x4;
typedef __attribute__((ext_vector_type(16))) float f32x16;
typedef __attribute__((ext_vector_type(4))) unsigned u32x4;

constexpr int T = 16384, DM = 1024, SEQ = 4096;
constexpr float EPS = 1e-6f;

constexpr size_t WS_BAR  = 0;
constexpr size_t WS_MODP = 16384;
constexpr size_t WS_MOD  = WS_MODP + 786432;
constexpr size_t WS_CS   = WS_MOD + 98304;
constexpr size_t WS_WIN  = WS_CS + 4194304;
constexpr size_t WS_WQ2  = WS_WIN + 3145728;
constexpr size_t WS_WUV  = WS_WQ2 + 393216;
constexpr size_t WS_WO   = WS_WUV + 131072;
constexpr size_t WS_WPQ  = WS_WO + 2097152;
constexpr size_t WS_KEYS = WS_WPQ + 4194304;
constexpr size_t WS_WSG  = WS_KEYS + 524288;
constexpr size_t WS_UB   = WS_WSG + 131072;
constexpr size_t WS_VB   = WS_UB + 33554432;
constexpr size_t WS_H    = WS_VB + 33554432;
constexpr size_t WS_Y    = WS_H + 33554432;
constexpr size_t WS_KV   = WS_Y + 33554432;
constexpr size_t WS_TOPK = WS_KV + 6291456;
constexpr size_t WS_SSQ  = WS_TOPK + 16777216;
constexpr size_t WS_SSQV = WS_SSQ + 262144;
constexpr size_t WS_R1   = WS_SSQV + 131072;
constexpr size_t WS_Q    = WS_R1;
constexpr size_t WS_QA   = WS_Q + 25165824;
constexpr size_t WS_UACT = WS_QA + 8388608;
constexpr size_t WS_GVT  = WS_UACT + 16777216;
constexpr size_t WS_X1   = WS_R1;
constexpr size_t WS_WST  = WS_R1 + 67108864;
constexpr size_t WS_BIASP = WS_WST + 4 * 4194304;
constexpr size_t WS_END  = WS_BIASP + 131072;

constexpr int LDS_BYTES = 155648;
constexpr int LDS_DATA  = 64;

struct Args {
  const float *x, *c; const int* pos;
  const float *w_ada, *b_ada, *g_norm1, *w_in, *g_q_a, *w_uq, *g_kv_a, *w_ukv, *g_sg, *w_sg, *b_sg, *g_attn_out, *g_sg_out,
              *w_o, *g_norm2, *w_peer_q, *peer_keys, *peer_u, *peer_v, *g_final;
  float* out; unsigned char* ws; int ph_lo, ph_hi;
};

#define XB_TMO      128
#define XB_XCNT(j)  (256  + 64 * (j))
#define XB_XSUB(j)  (1280 + 64 * (j))
#define XB_XGEN(j)  (2304 + 64 * (j))
#define XB_TOP      3328
#define XB_TOPGEN   3392
#define XCD_BAR_WORDS 3456
#define XB_SPIN_CAP (1u << 18)
#define LAS __attribute__((address_space(3)))

__device__ __forceinline__ unsigned xb_ld(unsigned* p)              { return __hip_atomic_load(p, __ATOMIC_RELAXED, __HIP_MEMORY_SCOPE_AGENT); }
__device__ __forceinline__ unsigned xb_add(unsigned* p, unsigned v) { return __hip_atomic_fetch_add(p, v, __ATOMIC_RELAXED, __HIP_MEMORY_SCOPE_AGENT); }
__device__ __forceinline__ unsigned xb_xcc_id() { return (unsigned)__builtin_amdgcn_s_getreg((3 << 11) | 20) & 0xFu; }
#define XB_SPIN(cond, bar) do { unsigned _sp = 0; while (cond) { __builtin_amdgcn_s_sleep(1); \
    if ((++_sp & 255u) == 0u) { if (xb_ld(&(bar)[XB_TMO])) break; if (_sp > XB_SPIN_CAP) { atomicAdd(&(bar)[XB_TMO], 1u); break; } } } } while (0)

struct XcdBarrier { unsigned* bar; unsigned x; volatile LAS unsigned* st; };

__device__ __forceinline__ XcdBarrier xcd_barrier_post(unsigned* bar, volatile LAS unsigned* st) {
    XcdBarrier b; b.bar = bar; b.x = xb_xcc_id(); b.st = st;
    if (threadIdx.x == 0) (void)xb_add(&bar[XB_XCNT(b.x)], 1u);
    return b;
}
__device__ __forceinline__ void xcd_barrier_complete(unsigned* bar, unsigned x, unsigned& nloc, unsigned& nx) {
    const unsigned G = gridDim.x * gridDim.y * gridDim.z;
    unsigned sum, cnt, mine, sp = 0u;
    for (;;) {
        sum = 0u; cnt = 0u; mine = 0u;
#pragma unroll
        for (unsigned j = 0; j < 16; ++j) { const unsigned c = xb_ld(&bar[XB_XCNT(j)]); sum += c; cnt += (c > 0u) ? 1u : 0u; mine = (j == x) ? c : mine; }
        if (sum == G) break;
        __builtin_amdgcn_s_sleep(1);
        if ((++sp & 255u) == 0u) { if (xb_ld(&bar[XB_TMO])) break; if (sp > XB_SPIN_CAP) { atomicAdd(&bar[XB_TMO], 1u); break; } }
    }
    nloc = mine > 0u ? mine : 1u; nx = cnt > 0u ? cnt : 1u;
}
__device__ __forceinline__ void xcd_barrier(const XcdBarrier& b) {
    asm volatile("s_waitcnt vmcnt(0)" ::: "memory");
    __syncthreads();
    if (threadIdx.x == 0) {
        unsigned* bar = b.bar;
        __builtin_amdgcn_s_waitcnt(0);
        unsigned nloc = b.st[0], nx = b.st[1];
        if (nloc == 0u) { xcd_barrier_complete(bar, b.x, nloc, nx); b.st[0] = nloc; b.st[1] = nx; }
        const unsigned old = xb_add(&bar[XB_XSUB(b.x)], 1u);
        const unsigned gen = old / nloc;
        if (old + 1u == (gen + 1u) * nloc) {
            __builtin_amdgcn_fence(__ATOMIC_RELEASE, "agent");
            asm volatile("s_waitcnt vmcnt(0)" ::: "memory");
            const unsigned og = xb_add(&bar[XB_TOP], 1u);
            const unsigned tg = og / nx;
            if (og + 1u == (tg + 1u) * nx) xb_add(&bar[XB_TOPGEN], 1u);
            else XB_SPIN(xb_ld(&bar[XB_TOPGEN]) == tg, bar);
            __builtin_amdgcn_fence(__ATOMIC_ACQUIRE, "agent");
            xb_add(&bar[XB_XGEN(b.x)], 1u);
            asm volatile("s_waitcnt vmcnt(0)" ::: "memory");
        } else {
            XB_SPIN(xb_ld(&bar[XB_XGEN(b.x)]) == gen, bar);
            __builtin_amdgcn_fence(__ATOMIC_ACQUIRE, "agent");
            asm volatile("s_waitcnt vmcnt(0)" ::: "memory");
        }
    }
    __syncthreads();
}

__device__ __forceinline__ unsigned pack2(float lo, float hi) {
  typedef __attribute__((ext_vector_type(2))) float f2; typedef __attribute__((ext_vector_type(2))) __bf16 b2;
  f2 v = {lo, hi}; b2 r = __builtin_convertvector(v, b2); return __builtin_bit_cast(unsigned, r);
}
__device__ __forceinline__ u16 f2bf(float f) { return (u16)(pack2(f, 0.f) & 0xFFFFu); }
__device__ __forceinline__ float bflo(unsigned w) { return __uint_as_float(w << 16); }
__device__ __forceinline__ float bfhi(unsigned w) { return __uint_as_float(w & 0xFFFF0000u); }
__device__ __forceinline__ float gelu_exact(float x) {
  const float z = fabsf(x) * 0.70710678118654752f;
  const float t = __builtin_amdgcn_rcpf(fmaf(0.3275911f, z, 1.f));
  float p = fmaf(1.061405429f, t, -1.453152027f); p = fmaf(p, t, 1.421413741f); p = fmaf(p, t, -0.284496736f); p = fmaf(p, t, 0.254829592f);
  const float e = p * t * __expf(-z * z);
  const float erfz = 1.f - e;
  return 0.5f * x * (1.f + copysignf(erfz, x));
}
__device__ __forceinline__ float wave_sum(float v) {
#pragma unroll
  for (int o = 32; o > 0; o >>= 1) v += __shfl_xor(v, o, 64);
  return v;
}
__device__ __forceinline__ int crow(int r, int hi) { return (r & 3) + 8 * (r >> 2) + 4 * hi; }
#define MFMA32(a, b, c) __builtin_amdgcn_mfma_f32_32x32x16_bf16((a), (b), (c), 0, 0, 0)

template <int MAP> __device__ __forceinline__ int colmap(int n) {
  if (MAP == 0) return n;
  if (MAP == 1) return n < 448 ? n : (n < 512 ? -1 : n - 64);
  if (MAP == 2) return (n >> 6) * 192 + 128 + (n & 63);
  return (n >> 7) * 256 + 128 + (n & 127);
}
template <int MAP> __device__ void cvt_transpose(const float* __restrict__ src, int src_ld, int K, int N, u16* __restrict__ dst, int gtid, int gthreads) {
  const int total = N * (K >> 3);
  for (int idx = gtid; idx < total; idx += gthreads) {
    const int n = idx % N, k8 = idx / N, sc = colmap<MAP>(n);
    float v[8];
#pragma unroll
    for (int j = 0; j < 8; ++j) v[j] = sc < 0 ? 0.f : src[(size_t)(k8 * 8 + j) * src_ld + sc];
    u32x4 w = {pack2(v[0], v[1]), pack2(v[2], v[3]), pack2(v[4], v[5]), pack2(v[6], v[7])};
    *(u32x4*)(dst + (size_t)n * K + k8 * 8) = w;
  }
}
template <int MAP> __device__ void cvt_transpose_tiled(const float* __restrict__ src, int src_ld, int K, int N, u16* __restrict__ dst, float* tile) {
  const int tid = threadIdx.x, tk = K >> 6, ntile = tk * (N >> 6);
  for (int t = blockIdx.x; t < ntile; t += gridDim.x) {
    const int k0 = (t % tk) * 64, n0 = (t / tk) * 64;
    __syncthreads();
    { const int nl = tid & 63, sc = colmap<MAP>(n0 + nl);
#pragma unroll
      for (int i = 0; i < 8; ++i) { const int k = (tid >> 6) + 8 * i; tile[k * 65 + nl] = sc < 0 ? 0.f : src[(size_t)(k0 + k) * src_ld + sc]; } }
    __syncthreads();
    { const int n = tid >> 3, kk = tid & 7; float v[8];
#pragma unroll
      for (int j = 0; j < 8; ++j) v[j] = tile[(8 * kk + j) * 65 + n];
      u32x4 w = {pack2(v[0], v[1]), pack2(v[2], v[3]), pack2(v[4], v[5]), pack2(v[6], v[7])};
      *(u32x4*)(dst + (size_t)(n0 + n) * K + k0 + 8 * kk) = w; }
  }
}
__device__ void cvt_direct(const float* __restrict__ src, u16* __restrict__ dst, size_t n8, int gtid, int gthreads) {
  for (size_t i = gtid; i < n8; i += gthreads) {
    const float4 a = *(const float4*)(src + i * 8), b = *(const float4*)(src + i * 8 + 4);
    u32x4 w = {pack2(a.x, a.y), pack2(a.z, a.w), pack2(b.x, b.y), pack2(b.z, b.w)};
    *(u32x4*)(dst + i * 8) = w;
  }
}
constexpr float PEER_SU = 32.f, PEER_SV = 4.f;
__device__ void cvt_fp8(const float* __restrict__ src, unsigned char* __restrict__ dst, size_t n16, float sc, int gtid, int gthreads) {
  for (size_t i = gtid; i < n16; i += gthreads) {
    u32x4 w;
#pragma unroll
    for (int k = 0; k < 4; ++k) {
      const float4 a = *(const float4*)(src + i * 16 + 4 * k);
      int p = __builtin_amdgcn_cvt_pk_fp8_f32(a.x * sc, a.y * sc, 0, false);
      p = __builtin_amdgcn_cvt_pk_fp8_f32(a.z * sc, a.w * sc, p, true);
      w[k] = (unsigned)p;
    }
    *(u32x4*)(dst + i * 16) = w;
  }
}
__device__ __forceinline__ void sincos_acc(float angf, float& sn, float& cs) {
  const double a = (double)angf;
  const double q = __builtin_rint(a * 0.63661977236758134308);
  double r = __builtin_fma(-q, 1.5707963267948966, a);
  r = __builtin_fma(-q, 6.123233995736766e-17, r);
  const double r2 = r * r;
  double s = r2 * (1.0 / 6227020800.0) - 1.0 / 39916800.0;
  s = s * r2 + 1.0 / 362880.0; s = s * r2 - 1.0 / 5040.0; s = s * r2 + 1.0 / 120.0; s = s * r2 - 1.0 / 6.0; s = r + r * r2 * s;
  double c = -r2 * (1.0 / 87178291200.0) + 1.0 / 479001600.0;
  c = c * r2 - 1.0 / 3628800.0; c = c * r2 + 1.0 / 40320.0; c = c * r2 - 1.0 / 720.0; c = c * r2 + 1.0 / 24.0; c = c * r2 - 0.5; c = 1.0 + r2 * c;
  const int n = ((int)q) & 3;
  const double ss = (n & 1) ? c : s, cc = (n & 1) ? s : c;
  sn = (float)((n & 2) ? -ss : ss);
  cs = (float)(((n + 1) & 2) ? -cc : cc);
}

__constant__ float INVF[32] = {1.000000000e+00f, 7.498942018e-01f, 5.623413324e-01f, 4.216965139e-01f, 3.162277639e-01f, 2.371373922e-01f, 1.778279394e-01f, 1.333521456e-01f,
  1.000000015e-01f, 7.498941571e-02f, 5.623412877e-02f, 4.216964915e-02f, 3.162277862e-02f, 2.371373586e-02f, 1.778279431e-02f, 1.333521493e-02f,
  9.999999776e-03f, 7.498942316e-03f, 5.623413250e-03f, 4.216964822e-03f, 3.162277862e-03f, 2.371373819e-03f, 1.778279431e-03f, 1.333521446e-03f,
  1.000000047e-03f, 7.498941850e-04f, 5.623413017e-04f, 4.216965463e-04f, 3.162277862e-04f, 2.371373848e-04f, 1.778279402e-04f, 1.333521504e-04f};
__device__ void phase0(const Args& a, char* lds) {
  unsigned char* ws = a.ws;
  const int tid = threadIdx.x, lane = tid & 63, wv = tid >> 6;
  const int NWV = gridDim.x * 8, gw = blockIdx.x * 8 + wv;
  const int gthreads = gridDim.x * 512, gtid = blockIdx.x * 512 + tid;
  float* modp = (float*)(ws + WS_MODP);
  for (int job = gw; job < 768; job += NWV) {
    const int cg = job % 96, ks = job / 96, col = cg * 64 + lane;
    float a0 = 0.f, a1 = 0.f, a2 = 0.f, a3 = 0.f;
    const float* w = a.w_ada + (size_t)(ks * 128) * 6144 + col;
    float sv[2][4];
#pragma unroll
    for (int h = 0; h < 2; ++h)
#pragma unroll
      for (int bb = 0; bb < 4; ++bb) { const float cv = a.c[bb * 1024 + ks * 128 + 64 * h + lane]; sv[h][bb] = cv / (1.f + __expf(-cv)); }
#pragma unroll
    for (int h = 0; h < 2; ++h) {
#pragma unroll 8
      for (int k = 0; k < 64; ++k) {
        const float wv_ = w[(size_t)(64 * h + k) * 6144];
        a0 += __uint_as_float(__builtin_amdgcn_readlane(__float_as_uint(sv[h][0]), k)) * wv_;
        a1 += __uint_as_float(__builtin_amdgcn_readlane(__float_as_uint(sv[h][1]), k)) * wv_;
        a2 += __uint_as_float(__builtin_amdgcn_readlane(__float_as_uint(sv[h][2]), k)) * wv_;
        a3 += __uint_as_float(__builtin_amdgcn_readlane(__float_as_uint(sv[h][3]), k)) * wv_;
      }
    }
    modp[(ks * 4 + 0) * 6144 + col] = a0; modp[(ks * 4 + 1) * 6144 + col] = a1;
    modp[(ks * 4 + 2) * 6144 + col] = a2; modp[(ks * 4 + 3) * 6144 + col] = a3;
  }
  { float* tile = (float*)(lds + LDS_DATA);
    cvt_transpose_tiled<1>(a.w_in, 1472, 1024, 1536, (u16*)(ws + WS_WIN), tile);
    cvt_transpose_tiled<0>(a.w_o, 1024, 1024, 1024, (u16*)(ws + WS_WO), tile);
    cvt_transpose_tiled<2>(a.w_uq, 768, 256, 256, (u16*)(ws + WS_WQ2) + 512 * 256, tile);
    cvt_transpose_tiled<3>(a.w_ukv, 1024, 128, 512, (u16*)(ws + WS_WUV), tile); }
  {
    u16* wq2 = (u16*)(ws + WS_WQ2);
    for (int idx = gtid; idx < 512 * 256; idx += gthreads) {
      const int n = idx >> 8, i = idx & 255, h = n >> 7, cc = n & 127;
      const float* pu = a.w_uq + (size_t)i * 768 + h * 192;
      const float* pk = a.w_ukv + (size_t)cc * 1024 + h * 256;
      float s = 0.f;
#pragma unroll 8
      for (int d = 0; d < 128; d += 4) {
        const float4 u = *(const float4*)(pu + d), k = *(const float4*)(pk + d);
        s += u.x * k.x + u.y * k.y + u.z * k.z + u.w * k.w;
      }
      wq2[(size_t)n * 256 + i] = f2bf(s);
    }
  }
  cvt_direct(a.peer_keys, (u16*)(ws + WS_KEYS), 262144 / 8, gtid, gthreads);
  cvt_direct(a.w_peer_q, (u16*)(ws + WS_WPQ), (size_t)1024 * 2048 / 8, gtid, gthreads);
  cvt_direct(a.w_sg, (u16*)(ws + WS_WSG), 65536 / 8, gtid, gthreads);
  {
    float* cs = (float*)(ws + WS_CS);
    for (int idx = gtid; idx < T * 32; idx += gthreads) {
      const int t = idx >> 5, i = idx & 31;
      const float inv = INVF[i];
      const float ang = (float)a.pos[t] * inv;
      float sn, c_; sincos_acc(ang, sn, c_);
      cs[(size_t)t * 64 + i] = c_; cs[(size_t)t * 64 + 32 + i] = sn;
    }
  }
}

__device__ void phase1(const Args& a, char* lds) {
  unsigned char* ws = a.ws;
  const int tid = threadIdx.x, lane = tid & 63, wv = tid >> 6;
  const float* modp = (const float*)(ws + WS_MODP);
  float* mod = (float*)(ws + WS_MOD);
  for (int idx = blockIdx.x * 512 + tid; idx < 4 * 6144; idx += gridDim.x * 512) {
    const int b = idx / 6144, m = idx % 6144;
    float s = a.b_ada[m];
#pragma unroll
    for (int ks = 0; ks < 8; ++ks) s += modp[(ks * 4 + b) * 6144 + m];
    mod[idx] = s;
  }
  float* sh = (float*)(lds + LDS_DATA);
  u16* H = (u16*)(ws + WS_H);
  for (int u = blockIdx.x; u < T / 64; u += gridDim.x) {
    const int b = u >> 6;
    __syncthreads();
    for (int j = tid; j < 2048; j += 512) {
      float s = a.b_ada[j];
#pragma unroll
      for (int ks = 0; ks < 8; ++ks) s += modp[(ks * 4 + b) * 6144 + j];
      sh[j] = s;
    }
    __syncthreads();
    for (int i = 0; i < 8; ++i) {
      const int r = u * 64 + wv * 8 + i;
      float4 xv[4]; float ssq = 0.f;
#pragma unroll
      for (int j = 0; j < 4; ++j) { xv[j] = *(const float4*)(a.x + (size_t)r * 1024 + j * 256 + lane * 4); ssq += xv[j].x * xv[j].x + xv[j].y * xv[j].y + xv[j].z * xv[j].z + xv[j].w * xv[j].w; }
      ssq = wave_sum(ssq);
      const float rstd = rsqrtf(ssq * (1.f / 1024.f) + EPS);
#pragma unroll
      for (int j = 0; j < 4; ++j) {
        const int col = j * 256 + lane * 4;
        const float4 g = *(const float4*)(a.g_norm1 + col);
        const float h0 = xv[j].x * rstd * g.x * (1.f + sh[1024 + col]) + sh[col];
        const float h1 = xv[j].y * rstd * g.y * (1.f + sh[1024 + col + 1]) + sh[col + 1];
        const float h2 = xv[j].z * rstd * g.z * (1.f + sh[1024 + col + 2]) + sh[col + 2];
        const float h3 = xv[j].w * rstd * g.w * (1.f + sh[1024 + col + 3]) + sh[col + 3];
        uint2 o = {pack2(h0, h1), pack2(h2, h3)};
        *(uint2*)(H + (size_t)r * 1024 + col) = o;
      }
    }
  }
}

constexpr int G_STAGE = 49152;
__device__ __forceinline__ void dma16(const void* gsrc, unsigned lds_dst) {
  unsigned keep;
  asm volatile("s_mov_b32 %0, m0\n\ts_mov_b32 m0, %2\n\ts_nop 0\n\tglobal_load_lds_dwordx4 %1, off\n\ts_mov_b32 m0, %0"
               : "=&s"(keep) : "v"(gsrc), "s"(lds_dst) : "memory");
}
__device__ __forceinline__ void gemm_128x256(const u16* __restrict__ A, int lda, const u16* __restrict__ Bt, int ldb, int KT,
                                             f32x16 (&acc)[2][2], char* lds) {
  const int tid = threadIdx.x, lane = tid & 63, wv = __builtin_amdgcn_readfirstlane(tid >> 6), r32 = lane & 31, hi = lane >> 5;
  const int wm = wv >> 2, wn = wv & 3;
  const int rin = lane >> 3, cc = lane & 7;
  const u16* pa[2]; const u16* pb[4];
#pragma unroll
  for (int j = 0; j < 2; ++j) pa[j] = A + (size_t)(16 * wv + 8 * j + rin) * lda + 8 * (cc ^ (4 * j + (rin >> 1)));
#pragma unroll
  for (int i = 0; i < 4; ++i) pb[i] = Bt + (size_t)(32 * wv + 8 * i + rin) * ldb + 8 * (cc ^ (4 * (i & 1) + (rin >> 1)));
  const unsigned lb = __builtin_amdgcn_readfirstlane((unsigned)(uintptr_t)lds);
  const unsigned dA = lb + 2048 * wv, dB = lb + 16384 + 4096 * wv;
#define G_ISSUE(stage, kt_) do { const unsigned _so = (unsigned)(stage) * G_STAGE; const int _ko = (kt_) * 64;                     \
    dma16(pa[0] + _ko, dA + _so); dma16(pa[1] + _ko, dA + _so + 1024);                                                           \
    dma16(pb[0] + _ko, dB + _so); dma16(pb[1] + _ko, dB + _so + 1024); dma16(pb[2] + _ko, dB + _so + 2048); dma16(pb[3] + _ko, dB + _so + 3072); } while (0)
#pragma unroll
  for (int m = 0; m < 2; ++m)
#pragma unroll
    for (int n = 0; n < 2; ++n)
#pragma unroll
      for (int r = 0; r < 16; ++r) acc[m][n][r] = 0.f;
  __syncthreads();
  G_ISSUE(0, 0);
  if (KT > 1) G_ISSUE(1, 1);
  const int xa = (r32 >> 1) & 7;
  const int aoff = (64 * wm + r32) * 128, boff = 16384 + (64 * wn + r32) * 128;
  int st = 0;
  for (int kt = 0; kt < KT; ++kt) {
    if (kt + 1 < KT) asm volatile("s_waitcnt vmcnt(6)\n\ts_barrier" ::: "memory");
    else             asm volatile("s_waitcnt vmcnt(0)\n\ts_barrier" ::: "memory");
    const int s2 = st == 0 ? 2 : st - 1;
    if (kt + 2 < KT && wv < 4) G_ISSUE(s2, kt + 2);
    const char* buf = lds + st * G_STAGE;
    __builtin_amdgcn_s_setprio(1);
    bf16x8 fa[2][2], fb[2][2];
#define G_LDF(S, SET) do { const int _cb = ((2 * (S) + hi) ^ xa) << 4;                                                      \
      fa[SET][0] = *(const bf16x8*)(buf + aoff + _cb); fa[SET][1] = *(const bf16x8*)(buf + aoff + 4096 + _cb);              \
      fb[SET][0] = *(const bf16x8*)(buf + boff + _cb); fb[SET][1] = *(const bf16x8*)(buf + boff + 4096 + _cb); } while (0)
#define G_MM(SET) do { acc[0][0] = MFMA32(fa[SET][0], fb[SET][0], acc[0][0]); acc[0][1] = MFMA32(fa[SET][0], fb[SET][1], acc[0][1]);   \
      acc[1][0] = MFMA32(fa[SET][1], fb[SET][0], acc[1][0]); acc[1][1] = MFMA32(fa[SET][1], fb[SET][1], acc[1][1]); } while (0)
    G_LDF(0, 0); __builtin_amdgcn_sched_barrier(0);
    G_LDF(1, 1); __builtin_amdgcn_sched_barrier(0); G_MM(0); __builtin_amdgcn_sched_barrier(0);
    G_LDF(2, 0); __builtin_amdgcn_sched_barrier(0); G_MM(1); __builtin_amdgcn_sched_barrier(0);
    G_LDF(3, 1); __builtin_amdgcn_sched_barrier(0); G_MM(0); __builtin_amdgcn_sched_barrier(0);
    G_MM(1);
#undef G_LDF
#undef G_MM
    __builtin_amdgcn_s_setprio(0);
    if (kt + 2 < KT && wv >= 4) G_ISSUE(s2, kt + 2);
    st = st == 2 ? 0 : st + 1;
  }
#undef G_ISSUE
  __syncthreads();
}
constexpr int CLD = 257;
__device__ __forceinline__ void acc_to_lds(const f32x16 (&acc)[2][2], float* Cl) {
  const int lane = threadIdx.x & 63, wv = threadIdx.x >> 6, r32 = lane & 31, hi = lane >> 5, wm = wv >> 2, wn = wv & 3;
#pragma unroll
  for (int m = 0; m < 2; ++m)
#pragma unroll
    for (int n = 0; n < 2; ++n)
#pragma unroll
      for (int r = 0; r < 16; ++r) Cl[(64 * wm + 32 * m + crow(r, hi)) * CLD + 64 * wn + 32 * n + r32] = acc[m][n][r];
}

__device__ __forceinline__ void gemm_128x256_wide(const u16* __restrict__ A, int lda, const u16* __restrict__ Bt, int ldb, int KT, f32x16 (&acc)[4], char* lds) {
  const int tid = threadIdx.x, lane = tid & 63, wv = __builtin_amdgcn_readfirstlane(tid >> 6), r32 = lane & 31, hi = lane >> 5;
  const int rin = lane >> 3, cc = lane & 7;
  const u16* pa[2]; const u16* pb[4];
#pragma unroll
  for (int j = 0; j < 2; ++j) pa[j] = A + (size_t)(16 * wv + 8 * j + rin) * lda + 8 * (cc ^ (4 * j + (rin >> 1)));
#pragma unroll
  for (int i = 0; i < 4; ++i) pb[i] = Bt + (size_t)(32 * wv + 8 * i + rin) * ldb + 8 * (cc ^ (4 * (i & 1) + (rin >> 1)));
  const unsigned lb = __builtin_amdgcn_readfirstlane((unsigned)(uintptr_t)lds);
  const unsigned dA = lb + 2048 * wv, dB = lb + 16384 + 4096 * wv;
#define G_ISSUE(stage, kt_) do { const unsigned _so = (unsigned)(stage) * G_STAGE; const int _ko = (kt_) * 64;                     \
    dma16(pa[0] + _ko, dA + _so); dma16(pa[1] + _ko, dA + _so + 1024);                                                           \
    dma16(pb[0] + _ko, dB + _so); dma16(pb[1] + _ko, dB + _so + 1024); dma16(pb[2] + _ko, dB + _so + 2048); dma16(pb[3] + _ko, dB + _so + 3072); } while (0)
#pragma unroll
  for (int m = 0; m < 4; ++m)
#pragma unroll
    for (int r = 0; r < 16; ++r) acc[m][r] = 0.f;
  __syncthreads();
  G_ISSUE(0, 0);
  if (KT > 1) G_ISSUE(1, 1);
  const int xa = (r32 >> 1) & 7;
  const int aoff = r32 * 128, boff = 16384 + (32 * wv + r32) * 128;
  int st = 0;
  for (int kt = 0; kt < KT; ++kt) {
    if (kt + 1 < KT) asm volatile("s_waitcnt vmcnt(6)\n\ts_barrier" ::: "memory");
    else             asm volatile("s_waitcnt vmcnt(0)\n\ts_barrier" ::: "memory");
    const int s2 = st == 0 ? 2 : st - 1;
    if (kt + 2 < KT && wv < 4) G_ISSUE(s2, kt + 2);
    const char* buf = lds + st * G_STAGE;
    __builtin_amdgcn_s_setprio(1);
    bf16x8 fa[2][4], fb[2];
#define G_LDF(S, SET) do { const int _cb = ((2 * (S) + hi) ^ xa) << 4;                                                      \
      fa[SET][0] = *(const bf16x8*)(buf + aoff + _cb); fa[SET][1] = *(const bf16x8*)(buf + aoff + 4096 + _cb);              \
      fa[SET][2] = *(const bf16x8*)(buf + aoff + 8192 + _cb); fa[SET][3] = *(const bf16x8*)(buf + aoff + 12288 + _cb);      \
      fb[SET] = *(const bf16x8*)(buf + boff + _cb); } while (0)
#define G_MM(SET) do { acc[0] = MFMA32(fa[SET][0], fb[SET], acc[0]); acc[1] = MFMA32(fa[SET][1], fb[SET], acc[1]);         \
      acc[2] = MFMA32(fa[SET][2], fb[SET], acc[2]); acc[3] = MFMA32(fa[SET][3], fb[SET], acc[3]); } while (0)
    G_LDF(0, 0); __builtin_amdgcn_sched_barrier(0);
    G_LDF(1, 1); __builtin_amdgcn_sched_barrier(0); G_MM(0); __builtin_amdgcn_sched_barrier(0);
    G_LDF(2, 0); __builtin_amdgcn_sched_barrier(0); G_MM(1); __builtin_amdgcn_sched_barrier(0);
    G_LDF(3, 1); __builtin_amdgcn_sched_barrier(0); G_MM(0); __builtin_amdgcn_sched_barrier(0);
    G_MM(1);
#undef G_LDF
#undef G_MM
    __builtin_amdgcn_s_setprio(0);
    if (kt + 2 < KT && wv >= 4) G_ISSUE(s2, kt + 2);
    st = st == 2 ? 0 : st + 1;
  }
#undef G_ISSUE
  __syncthreads();
}

constexpr int G2_STAGE = 32768;
__device__ __forceinline__ void gemm_256x256_wide(const u16* __restrict__ A, int lda, const u16* __restrict__ Bt, int ldb, int KT, f32x16 (&acc)[8], char* lds) {
  const int tid = threadIdx.x, lane = tid & 63, wv = __builtin_amdgcn_readfirstlane(tid >> 6), r32 = lane & 31, hi = lane >> 5;
  const int rin = lane >> 2, cc = lane & 3;
  const u16* pa[2]; const u16* pb[2];
#pragma unroll
  for (int j = 0; j < 2; ++j) {
    pa[j] = A + (size_t)(32 * wv + 16 * j + rin) * lda + 8 * (cc ^ (rin >> 2));
    pb[j] = Bt + (size_t)(32 * wv + 16 * j + rin) * ldb + 8 * (cc ^ (rin >> 2));
  }
  const unsigned lb = __builtin_amdgcn_readfirstlane((unsigned)(uintptr_t)lds);
  const unsigned dA = lb + 2048 * wv, dB = lb + 16384 + 2048 * wv;
#define G_ISSUE(stage, kt_) do { const unsigned _so = (unsigned)(stage) * G2_STAGE; const int _ko = (kt_) * 32;                    \
    dma16(pa[0] + _ko, dA + _so); dma16(pa[1] + _ko, dA + _so + 1024); dma16(pb[0] + _ko, dB + _so); dma16(pb[1] + _ko, dB + _so + 1024); } while (0)
#pragma unroll
  for (int m = 0; m < 8; ++m)
#pragma unroll
    for (int r = 0; r < 16; ++r) acc[m][r] = 0.f;
  __syncthreads();
  G_ISSUE(0, 0); G_ISSUE(1, 1); G_ISSUE(2, 2);
  const int xa = (r32 >> 2) & 3;
  const int aoff = r32 * 64, boff = 16384 + (32 * wv + r32) * 64;
  int st = 0;
  for (int kt = 0; kt < KT; ++kt) {
    if (kt + 2 < KT)      asm volatile("s_waitcnt vmcnt(8)\n\ts_barrier" ::: "memory");
    else if (kt + 1 < KT) asm volatile("s_waitcnt vmcnt(4)\n\ts_barrier" ::: "memory");
    else                  asm volatile("s_waitcnt vmcnt(0)\n\ts_barrier" ::: "memory");
    const int s3 = (st + 3) & 3;
    if (kt + 3 < KT && wv < 4) G_ISSUE(s3, kt + 3);
    const char* buf = lds + st * G2_STAGE;
    __builtin_amdgcn_s_setprio(1);
    bf16x8 fa[8], fb0, fb1;
    { const int cb0 = (hi ^ xa) << 4, cb1 = ((2 + hi) ^ xa) << 4;
#pragma unroll
      for (int m = 0; m < 8; ++m) fa[m] = *(const bf16x8*)(buf + aoff + 2048 * m + cb0);
      fb0 = *(const bf16x8*)(buf + boff + cb0); fb1 = *(const bf16x8*)(buf + boff + cb1);
#pragma unroll
      for (int m = 0; m < 8; ++m) { acc[m] = MFMA32(fa[m], fb0, acc[m]); fa[m] = *(const bf16x8*)(buf + aoff + 2048 * m + cb1); }
#pragma unroll
      for (int m = 0; m < 8; ++m) acc[m] = MFMA32(fa[m], fb1, acc[m]);
    }
    __builtin_amdgcn_s_setprio(0);
    if (kt + 3 < KT && wv >= 4) G_ISSUE(s3, kt + 3);
    st = (st + 1) & 3;
  }
#undef G_ISSUE
  __syncthreads();
}

__device__ __forceinline__ void xcd_unit(int u, int per, int& panel, int& sub) {
  if (gridDim.x == 256) { const int x = u & 7, k = ((u & 255) >> 3) + 32 * (u >> 8); panel = x + 8 * (k / per); sub = k % per; }
  else { panel = u / per; sub = u % per; }
}
__device__ void phase1b(const Args& a, char* lds) {
  unsigned char* ws = a.ws;
  const int tid = threadIdx.x, lane = tid & 63, wv = tid >> 6;
  const u16* KEYS = (const u16*)(ws + WS_KEYS); const u16* WPQB = (const u16*)(ws + WS_WPQ); u16* WST = (u16*)(ws + WS_WST);
  const float* modp = (const float*)(ws + WS_MODP); float* BIASP = (float*)(ws + WS_BIASP);
  char* gl = lds + LDS_DATA; float* Cl = (float*)gl;
  float* gsl = (float*)(gl + 131584);
  for (int u = blockIdx.x; u < 256; u += gridDim.x) {
    const int hh = u >> 4, nt = (u >> 2) & 3, b = u & 3;
    f32x16 acc[2][2];
    gemm_128x256(KEYS + (size_t)hh * 16384, 128, WPQB + (size_t)(nt * 256) * 2048 + hh * 128, 2048, 2, acc, gl);
    acc_to_lds(acc, Cl);
    for (int j = tid; j < 512; j += 512) {
      const int which = j >> 8, k = nt * 256 + (j & 255), m = (which ? 3072 : 4096) + k;
      float v = a.b_ada[m];
#pragma unroll
      for (int ks = 0; ks < 8; ++ks) v += modp[(ks * 4 + b) * 6144 + m];
      gsl[j] = which ? v : a.g_norm2[k] * (1.f + v);
    }
    __syncthreads();
    for (int i = 0; i < 16; ++i) {
      const int row = wv * 16 + i; const size_t n = (size_t)hh * 128 + row;
      float bp = 0.f, w[4];
#pragma unroll
      for (int j = 0; j < 4; ++j) { const float v = Cl[row * CLD + 4 * lane + j]; w[j] = v * gsl[4 * lane + j]; bp += v * gsl[256 + 4 * lane + j]; }
      *(uint2*)(WST + ((size_t)b * 2048 + n) * 1024 + nt * 256 + 4 * lane) = make_uint2(pack2(w[0], w[1]), pack2(w[2], w[3]));
      bp = wave_sum(bp);
      if (lane == 0) BIASP[((size_t)nt * 4 + b) * 2048 + n] = bp;
    }
    __syncthreads();
  }
}

__device__ void phase2(const Args& a, char* lds) {
  unsigned char* ws = a.ws;
  const int tid = threadIdx.x, lane = tid & 63, wv = tid >> 6;
  const u16* H = (const u16*)(ws + WS_H); const u16* WIN = (const u16*)(ws + WS_WIN);
  u16* QA = (u16*)(ws + WS_QA); u16* KV = (u16*)(ws + WS_KV); u16* UACT = (u16*)(ws + WS_UACT); u16* GVT = (u16*)(ws + WS_GVT);
  float* SSQV = (float*)(ws + WS_SSQV); const float* CS = (const float*)(ws + WS_CS);
  char* gl = lds + LDS_DATA; float* Cl = (float*)gl;
  for (int u = blockIdx.x; u < 128 * 6; u += gridDim.x) {
    int mt, nt; xcd_unit(u, 6, mt, nt); const int R0 = mt * 128;
    f32x16 acc[2][2];
    gemm_128x256(H + (size_t)R0 * 1024, 1024, WIN + (size_t)(nt * 256) * 1024, 1024, 16, acc, gl);
    acc_to_lds(acc, Cl);
    __syncthreads();
    if (nt == 0) {
      for (int i = 0; i < 16; ++i) {
        const int row = wv * 16 + i; float v[4], ssq = 0.f;
#pragma unroll
        for (int j = 0; j < 4; ++j) { v[j] = Cl[row * CLD + lane + 64 * j]; ssq += v[j] * v[j]; }
        ssq = wave_sum(ssq);
        const float rstd = rsqrtf(ssq * (1.f / 256.f) + EPS);
#pragma unroll
        for (int j = 0; j < 4; ++j) { const int col = lane + 64 * j; QA[(size_t)(R0 + row) * 256 + col] = f2bf(v[j] * rstd * a.g_q_a[col]); }
      }
    } else if (nt == 1) {
#pragma unroll 4
      for (int i = 0; i < 16; ++i) {
        const int row = wv * 16 + i, tok = R0 + row;
        const float v0 = Cl[row * CLD + lane], v1 = Cl[row * CLD + 64 + lane];
        const float ssq = wave_sum(v0 * v0 + v1 * v1);
        const float rstd = rsqrtf(ssq * (1.f / 128.f) + EPS);
        KV[(size_t)tok * 192 + lane] = f2bf(v0 * rstd * a.g_kv_a[lane]);
        KV[(size_t)tok * 192 + 64 + lane] = f2bf(v1 * rstd * a.g_kv_a[64 + lane]);
        if (lane < 32) {
          const float x1 = Cl[row * CLD + 128 + lane], x2 = Cl[row * CLD + 160 + lane];
          const float cs = CS[(size_t)tok * 64 + lane], sn = CS[(size_t)tok * 64 + 32 + lane];
          KV[(size_t)tok * 192 + 128 + lane] = f2bf(x1 * cs - x2 * sn);
          KV[(size_t)tok * 192 + 160 + lane] = f2bf(x2 * cs + x1 * sn);
        }
      }
    } else if (nt < 4) {
      for (int i = 0; i < 16; ++i) {
        const int row = wv * 16 + i;
#pragma unroll
        for (int j = 0; j < 4; ++j) { const int col = lane + 64 * j; UACT[(size_t)(R0 + row) * 512 + (nt - 2) * 256 + col] = f2bf(gelu_exact(Cl[row * CLD + col])); }
      }
    } else {
      for (int i = 0; i < 16; ++i) {
        const int row = wv * 16 + i; float ssq = 0.f;
#pragma unroll
        for (int j = 0; j < 4; ++j) { const int col = lane + 64 * j; const float g = gelu_exact(Cl[row * CLD + col]); const float gb = bflo((unsigned)f2bf(g)); ssq += gb * gb; Cl[row * CLD + col] = gb; }
        ssq = wave_sum(ssq);
        if (lane == 0) SSQV[(size_t)(R0 + row) * 2 + (nt - 4)] = ssq;
      }
      __syncthreads();
      for (int i = 0; i < 32; ++i) {
        const int c = wv * 32 + i;
        const float g0 = Cl[(2 * lane) * CLD + c], g1 = Cl[(2 * lane + 1) * CLD + c];
        *(unsigned*)(GVT + ((size_t)mt * 512 + (nt - 4) * 256 + c) * 128 + 2 * lane) = pack2(g0, g1);
      }
    }
    __syncthreads();
  }
}

__device__ void phase3(const Args& a, char* lds) {
  unsigned char* ws = a.ws;
  const int tid = threadIdx.x, lane = tid & 63, wv = tid >> 6, r32 = lane & 31, hi = lane >> 5;
  const u16* QA = (const u16*)(ws + WS_QA); const u16* WQ2 = (const u16*)(ws + WS_WQ2);
  u16* Q = (u16*)(ws + WS_Q); const float* CS = (const float*)(ws + WS_CS);
  const u16* UACT = (const u16*)(ws + WS_UACT); const u16* GVT = (const u16*)(ws + WS_GVT); const u16* WSG = (const u16*)(ws + WS_WSG);
  const float* SSQV = (const float*)(ws + WS_SSQV); u16* Y = (u16*)(ws + WS_Y);
  char* gl = lds + LDS_DATA; float* Cl = (float*)gl;
  for (int u = blockIdx.x; u < 384; u += gridDim.x) {
    {
      int mt, nt; xcd_unit(u, 3, mt, nt); const int R0 = mt * 128;
      f32x16 acc[2][2];
      gemm_128x256(QA + (size_t)R0 * 256, 256, WQ2 + (size_t)(nt * 256) * 256, 256, 4, acc, gl);
      acc_to_lds(acc, Cl);
      __syncthreads();
      if (nt < 2) {
        for (int i = 0; i < 16; ++i) {
          const int row = wv * 16 + i;
#pragma unroll
          for (int j = 0; j < 4; ++j) { const int n = nt * 256 + lane + 64 * j; Q[(size_t)(R0 + row) * 768 + (n >> 7) * 192 + (n & 127)] = f2bf(Cl[row * CLD + lane + 64 * j]); }
        }
      } else {
#pragma unroll 4
        for (int i = 0; i < 16; ++i) {
          const int row = wv * 16 + i, tok = R0 + row;
#pragma unroll
          for (int j = 0; j < 2; ++j) {
            const int idx = lane + 64 * j, h = idx >> 5, jj = idx & 31;
            const float x1 = Cl[row * CLD + h * 64 + jj], x2 = Cl[row * CLD + h * 64 + 32 + jj];
            const float cs = CS[(size_t)tok * 64 + jj], sn = CS[(size_t)tok * 64 + 32 + jj];
            Q[(size_t)tok * 768 + h * 192 + 128 + jj] = f2bf(x1 * cs - x2 * sn);
            Q[(size_t)tok * 768 + h * 192 + 160 + jj] = f2bf(x2 * cs + x1 * sn);
          }
        }
      }
      __syncthreads();
    }
  }
  for (int su = blockIdx.x; su < 256; su += gridDim.x) {
    {
      const int c = su >> 1, ph = su & 1;
      float* rs = (float*)gl;
      float* Yl = (float*)(gl + 512);
      __syncthreads();
      if (tid < 128) { const size_t t = (size_t)c * 128 + tid; rs[tid] = rsqrtf((SSQV[t * 2] + SSQV[t * 2 + 1]) * (1.f / 512.f) + EPS); }
      __syncthreads();
      const int h = wv >> 1, dh = wv & 1;
      f32x16 acc[2][2];
#pragma unroll
      for (int m = 0; m < 2; ++m)
#pragma unroll
        for (int n = 0; n < 2; ++n)
#pragma unroll
          for (int r = 0; r < 16; ++r) acc[m][n][r] = 0.f;
      for (int s = 0; s < 8; ++s) {
        const int q0 = 16 * s + 8 * hi;
        bf16x8 af[2], bfr[2];
#pragma unroll
        for (int m = 0; m < 2; ++m) af[m] = *(const bf16x8*)(WSG + ((size_t)h * 128 + ph * 64 + 32 * m + r32) * 128 + q0);
        float rq[8];
#pragma unroll
        for (int j = 0; j < 8; ++j) rq[j] = rs[q0 + j];
#pragma unroll
        for (int n = 0; n < 2; ++n) {
          const u32x4 w = *(const u32x4*)(GVT + ((size_t)c * 512 + h * 128 + dh * 64 + 32 * n + r32) * 128 + q0);
          u32x4 o;
#pragma unroll
          for (int k = 0; k < 4; ++k) o[k] = pack2(bflo(w[k]) * rq[2 * k], bfhi(w[k]) * rq[2 * k + 1]);
          bfr[n] = __builtin_bit_cast(bf16x8, o);
        }
#pragma unroll
        for (int m = 0; m < 2; ++m)
#pragma unroll
          for (int n = 0; n < 2; ++n) acc[m][n] = MFMA32(af[m], bfr[n], acc[m][n]);
      }
#pragma unroll
      for (int m = 0; m < 2; ++m)
#pragma unroll
        for (int n = 0; n < 2; ++n)
#pragma unroll
          for (int r = 0; r < 16; ++r) {
            const int pl = 32 * m + crow(r, hi), col = h * 128 + dh * 64 + 32 * n + r32;
            const size_t tok = (size_t)c * 128 + ph * 64 + pl;
            const float mix = acc[m][n][r] * a.g_sg[col] + a.b_sg[h * 128 + ph * 64 + pl];
            Yl[pl * 513 + col] = bflo((unsigned)UACT[tok * 512 + col]) * mix;
          }
      __syncthreads();
      for (int i = 0; i < 8; ++i) {
        const int pl = wv * 8 + i; const size_t tok = (size_t)c * 128 + ph * 64 + pl;
        float v[8], ssq = 0.f;
#pragma unroll
        for (int j = 0; j < 8; ++j) { v[j] = Yl[pl * 513 + lane + 64 * j]; ssq += v[j] * v[j]; }
        ssq = wave_sum(ssq);
        const float rstd = rsqrtf(ssq * (1.f / 512.f) + EPS);
#pragma unroll
        for (int j = 0; j < 8; ++j) { const int col = lane + 64 * j; Y[tok * 1024 + 512 + col] = f2bf(v[j] * rstd * a.g_sg_out[col]); }
      }
      __syncthreads();
    }
  }
}

constexpr float ATT_SCALE = 0.07216878364870322f;
constexpr float ATT_THR = 8.f;
constexpr int KVBUF = 24576;
#define SBAR() __builtin_amdgcn_sched_barrier(0)
__device__ __forceinline__ unsigned cvtpk(float lo, float hi) { unsigned r; asm volatile("v_cvt_pk_bf16_f32 %0, %1, %2" : "=v"(r) : "v"(lo), "v"(hi)); return r; }
__device__ __forceinline__ unsigned off_a(unsigned row, unsigned ch) { return 2048u * (row >> 3) + 512u * (ch >> 2) + 64u * (row & 7) + 16u * ((ch & 3) ^ ((row >> 2) & 3)); }

__device__ __forceinline__ void partialSM(f32x16& p0, f32x16& p1, float& m_reg, float& mn, float& alpha) {
  constexpr float C = ATT_SCALE * 1.4426950408889634f;
  float pmax = p0[0];
#pragma unroll
  for (int r = 1; r < 16; ++r) pmax = fmaxf(pmax, p0[r]);
#pragma unroll
  for (int r = 0; r < 16; ++r) pmax = fmaxf(pmax, p1[r]);
  { auto rr = __builtin_amdgcn_permlane32_swap(__float_as_uint(pmax), __float_as_uint(pmax), false, false);
    pmax = fmaxf(__uint_as_float(rr[0]), __uint_as_float(rr[1])); }
  if (__builtin_expect(__all(pmax - m_reg <= ATT_THR / ATT_SCALE), 1)) { mn = m_reg; alpha = 1.f; }
  else { mn = fmaxf(m_reg, pmax); alpha = __builtin_amdgcn_exp2f((m_reg - mn) * C); m_reg = mn; }
  const float mnC = -mn * C;
#pragma unroll
  for (int r = 0; r < 16; ++r) p0[r] = fmaf(p0[r], C, mnC);
#pragma unroll
  for (int r = 0; r < 16; ++r) p1[r] = fmaf(p1[r], C, mnC);
#pragma unroll
  for (int r = 0; r < 16; ++r) p0[r] = __builtin_amdgcn_exp2f(p0[r]);
}
__device__ __forceinline__ void finishSM(f32x16& p0, f32x16& p1, float alpha, float& l_reg, bf16x8& pa0, bf16x8& pa1, bf16x8& pa2, bf16x8& pa3) {
#pragma unroll
  for (int r = 0; r < 16; ++r) p1[r] = __builtin_amdgcn_exp2f(p1[r]);
  float ps = 0;
#pragma unroll
  for (int r = 0; r < 16; ++r) ps += p0[r];
#pragma unroll
  for (int r = 0; r < 16; ++r) ps += p1[r];
  { auto rr = __builtin_amdgcn_permlane32_swap(__float_as_uint(ps), __float_as_uint(ps), false, false);
    ps = __uint_as_float(rr[0]) + __uint_as_float(rr[1]); }
  l_reg = l_reg * alpha + ps;
#define PK4(P, BASE, OUT) do { unsigned a0 = cvtpk(P[BASE + 0], P[BASE + 1]), a1 = cvtpk(P[BASE + 2], P[BASE + 3]);   \
    unsigned b0 = cvtpk(P[BASE + 4], P[BASE + 5]), b1 = cvtpk(P[BASE + 6], P[BASE + 7]);                              \
    auto r0 = __builtin_amdgcn_permlane32_swap(a0, b0, false, false); auto r1 = __builtin_amdgcn_permlane32_swap(a1, b1, false, false); \
    u32x4 w = {r0[0], r1[0], r0[1], r1[1]}; OUT = __builtin_bit_cast(bf16x8, w); } while (0)
  PK4(p0, 0, pa0); PK4(p0, 8, pa1); PK4(p1, 0, pa2); PK4(p1, 8, pa3);
#undef PK4
}
__device__ __forceinline__ void qkt192(f32x16& p0, f32x16& p1, const char* kb, const bf16x8* qr, int ke, int ko, int kr) {
#pragma unroll
  for (int r = 0; r < 16; ++r) { p0[r] = 0.f; p1[r] = 0.f; }
#pragma unroll
  for (int d0 = 0; d0 < 8; ++d0) {
    const int o = ((d0 & 1) ? ko : ke) + 512 * (d0 >> 1);
    const bf16x8 b0 = *(const bf16x8*)(kb + o), b1 = *(const bf16x8*)(kb + o + 8192);
    p0 = MFMA32(b0, qr[d0], p0); p1 = MFMA32(b1, qr[d0], p1);
  }
#pragma unroll
  for (int d1 = 0; d1 < 4; ++d1) {
    const int o = 16384 + (kr ^ (32 * d1));
    const bf16x8 b0 = *(const bf16x8*)(kb + o), b1 = *(const bf16x8*)(kb + o + 4096);
    p0 = MFMA32(b0, qr[8 + d1], p0); p1 = MFMA32(b1, qr[8 + d1], p1);
  }
}
template <int OFF> __device__ __forceinline__ s16x4 tr_read(int vb) {
  s16x4 r; asm volatile("ds_read_b64_tr_b16 %0, %1 offset:%2" : "=&v"(r) : "v"(vb), "i"(OFF) : "memory"); return r;
}
template <int C> __device__ __forceinline__ void pv_one(f32x16& od, int vb0, int vb1, bf16x8 pa0, bf16x8 pa1, bf16x8 pa2, bf16x8 pa3) {
  const s16x4 l0 = tr_read<512 * C>(vb0), h0 = tr_read<512 * C>(vb1), l1 = tr_read<4096 + 512 * C>(vb0), h1 = tr_read<4096 + 512 * C>(vb1);
  const s16x4 l2 = tr_read<8192 + 512 * C>(vb0), h2 = tr_read<8192 + 512 * C>(vb1), l3 = tr_read<12288 + 512 * C>(vb0), h3 = tr_read<12288 + 512 * C>(vb1);
  asm volatile("s_waitcnt lgkmcnt(0)" ::: "memory"); SBAR();
#define PKV(L, H) (bf16x8){L[0], L[1], L[2], L[3], H[0], H[1], H[2], H[3]}
  od = MFMA32(pa0, PKV(l0, h0), od); od = MFMA32(pa1, PKV(l1, h1), od);
  od = MFMA32(pa2, PKV(l2, h2), od); od = MFMA32(pa3, PKV(l3, h3), od);
#undef PKV
}
__device__ __forceinline__ void pv_all(f32x16* o, int vb0, int vb1, bf16x8 pa0, bf16x8 pa1, bf16x8 pa2, bf16x8 pa3) {
  pv_one<0>(o[0], vb0, vb1, pa0, pa1, pa2, pa3); pv_one<1>(o[1], vb0, vb1, pa0, pa1, pa2, pa3);
  pv_one<2>(o[2], vb0, vb1, pa0, pa1, pa2, pa3); pv_one<3>(o[3], vb0, vb1, pa0, pa1, pa2, pa3);
}

__device__ void phase4(const Args& a, char* lds) {
  unsigned char* ws = a.ws;
  const int tid = threadIdx.x, wid = tid >> 6, lane = tid & 63, r32 = lane & 31, hi = lane >> 5;
  const u16* Qg = (const u16*)(ws + WS_Q); const u16* KVg = (const u16*)(ws + WS_KV); const u16* WUV = (const u16*)(ws + WS_WUV);
  u16* Y = (u16*)(ws + WS_Y);
  char* gl = lds + LDS_DATA;
  char* kvl = gl;
  float* wsl = (float*)(gl + 2 * KVBUF) + wid * 64; float* li_l = wsl; float* al_l = wsl + 32;
  char* Ol = gl + 2 * KVBUF + 2048 + wid * 8704;
  float* Yl = (float*)gl;
  const int head = wid >> 1, qh = wid & 1;
  int sdst[3];
#pragma unroll
  for (int j = 0; j < 3; ++j) { const int id = tid + 512 * j, key = id / 24, ch = id % 24;
    sdst[j] = ch < 16 ? (int)off_a(key, ch) : 16384 + key * 128 + (((ch - 16) ^ ((key >> 1) & 7)) << 4); }
  const int xq = (r32 >> 2) & 3;
  const int ke = 2048 * (r32 >> 3) + 64 * (r32 & 7) + 16 * (hi ^ xq), ko = 2048 * (r32 >> 3) + 64 * (r32 & 7) + 16 * ((2 + hi) ^ xq);
  const int kr = r32 * 128 + ((hi ^ ((r32 >> 1) & 7)) << 4);
  const int tb = lane >> 4 & 1, tq = (lane & 15) >> 2, tp = lane & 3;
  const int vbl = 2048 * hi + 64 * tq + 32 * (tb ^ hi) + 8 * (tp & 1);
  const int lbase = (int)(uintptr_t)kvl;
  const int vb0 = lbase + vbl + 16 * (tp >> 1), vb1 = lbase + vbl + 256 + 16 * ((tp >> 1) ^ 1);
  for (int u = blockIdx.x; u < 256; u += gridDim.x) {
    const int b = u >> 6, qb = u & 63;
    const size_t tok0 = (size_t)b * SEQ + qb * 64 + qh * 32;
    const u16* KVb = KVg + (size_t)b * SEQ * 192;
    float m_reg = -1e30f, l_reg = 0.f; f32x16 o[4]; bf16x8 qr[12];
#pragma unroll
    for (int d = 0; d < 4; ++d)
#pragma unroll
      for (int r = 0; r < 16; ++r) o[d][r] = 0.f;
    { const u16* Qw = Qg + (tok0 + r32) * 768 + head * 192 + hi * 8;
#pragma unroll
      for (int d0 = 0; d0 < 12; ++d0) qr[d0] = *(const bf16x8*)(Qw + d0 * 16); }
    u32x4 st0[3];
#define SLOAD(S, k0) do { const u16* _p = KVb + (size_t)(k0) * 192 + tid * 8; S[0] = *(const u32x4*)_p; S[1] = *(const u32x4*)(_p + 4096); S[2] = *(const u32x4*)(_p + 8192); } while (0)
#define SWRITE(bufi, S) do { char* _d = kvl + (bufi) * KVBUF; *(u32x4*)(_d + sdst[0]) = S[0]; *(u32x4*)(_d + sdst[1]) = S[1]; *(u32x4*)(_d + sdst[2]) = S[2]; } while (0)
#define RESC(al) do { if (__any((al) < 1.f)) { if (hi == 0) al_l[r32] = (al); asm volatile("s_waitcnt lgkmcnt(0)" ::: "memory"); \
    _Pragma("unroll") for (int d = 0; d < 4; ++d) _Pragma("unroll") for (int r = 0; r < 16; ++r) o[d][r] *= al_l[crow(r, hi)]; } } while (0)
    constexpr int NT = SEQ / 64;
    __syncthreads();
    SLOAD(st0, 0); SWRITE(0, st0); SLOAD(st0, 64); __syncthreads();
    for (int j = 0; j < NT; ++j) {
      const int bo = (j & 1) * KVBUF;
      f32x16 p0, p1; float mn, al; bf16x8 pa0, pa1, pa2, pa3;
      qkt192(p0, p1, kvl + bo, qr, ke, ko, kr);
      partialSM(p0, p1, m_reg, mn, al);
      RESC(al);
      finishSM(p0, p1, al, l_reg, pa0, pa1, pa2, pa3);
      if (j + 1 < NT) { SWRITE((j + 1) & 1, st0); if (j + 2 < NT) SLOAD(st0, (j + 2) * 64); }
      const unsigned cit = ((unsigned)(u * 64 + j) << 9) | (unsigned)tid;
      const bool cisv = cit >= 4194304u; const unsigned cio = cisv ? cit - 4194304u : cit;
      const float4 cf = *(const float4*)((cisv ? a.peer_v : a.peer_u) + (size_t)cio * 4);
      SBAR();
      pv_all(o, vb0 + bo, vb1 + bo, pa0, pa1, pa2, pa3);
      { const float csc = cisv ? PEER_SV : PEER_SU;
        int cp = __builtin_amdgcn_cvt_pk_fp8_f32(cf.x * csc, cf.y * csc, 0, false); cp = __builtin_amdgcn_cvt_pk_fp8_f32(cf.z * csc, cf.w * csc, cp, true);
        *(int*)(ws + (cisv ? WS_VB : WS_UB) + (size_t)cio * 4) = cp; }
      __syncthreads();
    }
#undef SLOAD
#undef SWRITE
#undef RESC
    int r32e = r32, hie = hi, lne = lane;
    asm volatile("" : "+v"(r32e), "+v"(hie), "+v"(lne));
    if (hie == 0) li_l[r32e] = l_reg;
    asm volatile("s_waitcnt lgkmcnt(0)" ::: "memory");
#pragma unroll
    for (int r = 0; r < 16; ++r) {
      const int q = crow(r, hie); const float rl = __builtin_amdgcn_rcpf(li_l[q]);
#pragma unroll
      for (int d = 0; d < 4; ++d) *(u16*)(Ol + q * 272 + (32 * d + r32e) * 2) = f2bf(o[d][r] * rl);
    }
    asm volatile("s_waitcnt lgkmcnt(0)" ::: "memory");
    f32x16 y[4];
#pragma unroll
    for (int n = 0; n < 4; ++n)
#pragma unroll
      for (int r = 0; r < 16; ++r) y[n][r] = 0.f;
    const u16* wuv = WUV + ((size_t)head * 128 + r32e) * 128 + 8 * hie;
#pragma unroll 2
    for (int s = 0; s < 8; ++s) {
      const bf16x8 af = *(const bf16x8*)(Ol + r32e * 272 + (16 * s + 8 * hie) * 2);
#pragma unroll
      for (int n = 0; n < 4; ++n) {
        const bf16x8 bw = *(const bf16x8*)(wuv + 32 * n * 128 + 16 * s);
        y[n] = MFMA32(af, bw, y[n]);
      }
    }
    __syncthreads();
#pragma unroll
    for (int n = 0; n < 4; ++n)
#pragma unroll
      for (int r = 0; r < 16; ++r) Yl[(qh * 32 + crow(r, hie)) * 513 + head * 128 + 32 * n + r32e] = y[n][r];
    __syncthreads();
    for (int i = 0; i < 8; ++i) {
      const int pl = wid * 8 + i; const size_t tok = (size_t)b * SEQ + qb * 64 + pl;
      float v[8], ssq = 0.f;
#pragma unroll
      for (int jj = 0; jj < 8; ++jj) { v[jj] = Yl[pl * 513 + lne + 64 * jj]; ssq += v[jj] * v[jj]; }
      ssq = wave_sum(ssq);
      const float rstd = rsqrtf(ssq * (1.f / 512.f) + EPS);
#pragma unroll
      for (int jj = 0; jj < 8; ++jj) { const int col = lne + 64 * jj; Y[tok * 1024 + col] = f2bf(v[jj] * rstd * a.g_attn_out[col]); }
    }
    __syncthreads();
  }
}

__device__ void phase5(const Args& a, char* lds) {
  unsigned char* ws = a.ws;
  const int tid = threadIdx.x, lane = tid & 63, wv = tid >> 6;
  const u16* Y = (const u16*)(ws + WS_Y); const u16* WO = (const u16*)(ws + WS_WO);
  float* X1 = (float*)(ws + WS_X1); float* SSQ = (float*)(ws + WS_SSQ); const float* mod = (const float*)(ws + WS_MOD);
  u16* X1B = (u16*)(ws + WS_H);
  char* gl = lds + LDS_DATA; float* Cl = (float*)gl;
  for (int u = blockIdx.x; u < 128 * 4; u += gridDim.x) {
    int mt, nt; xcd_unit(u, 4, mt, nt); const int R0 = mt * 128, b = R0 >> 12;
    f32x16 acc[2][2];
    gemm_128x256(Y + (size_t)R0 * 1024, 1024, WO + (size_t)(nt * 256) * 1024, 1024, 16, acc, gl);
    acc_to_lds(acc, Cl);
    __syncthreads();
    float2 g1[2];
#pragma unroll
    for (int j = 0; j < 2; ++j) g1[j] = *(const float2*)(mod + b * 6144 + 2048 + nt * 256 + 2 * lane + 128 * j);
    for (int i0 = 0; i0 < 16; i0 += 8) {
      float2 xv[8][2];
#pragma unroll
      for (int i = 0; i < 8; ++i)
#pragma unroll
        for (int j = 0; j < 2; ++j) xv[i][j] = *(const float2*)(a.x + (size_t)(R0 + wv * 16 + i0 + i) * 1024 + nt * 256 + 2 * lane + 128 * j);
#pragma unroll
      for (int i = 0; i < 8; ++i) {
        const int row = wv * 16 + i0 + i; const size_t tok = R0 + row; float ssq = 0.f;
#pragma unroll
        for (int j = 0; j < 2; ++j) {
          const int col = nt * 256 + 2 * lane + 128 * j;
          const float v0 = xv[i][j].x + g1[j].x * Cl[row * CLD + 2 * lane + 128 * j], v1 = xv[i][j].y + g1[j].y * Cl[row * CLD + 2 * lane + 128 * j + 1];
          *(unsigned*)(X1B + tok * 1024 + col) = pack2(v0, v1); ssq += v0 * v0 + v1 * v1;
        }
        ssq = wave_sum(ssq);
        if (lane == 0) SSQ[tok * 4 + nt] = ssq;
      }
    }
    __syncthreads();
  }
}
__device__ void phase5b(const Args& a) {
  unsigned char* ws = a.ws;
  const int tid = threadIdx.x, lane = tid & 63, wv = tid >> 6;
  const float* X1 = (const float*)(ws + WS_X1); const float* SSQ = (const float*)(ws + WS_SSQ); const float* mod = (const float*)(ws + WS_MOD);
  u16* H = (u16*)(ws + WS_H);
  for (int u = blockIdx.x; u < T / 64; u += gridDim.x) {
    const int b = u >> 6;
    float4 sh[4], sc[4], g[4];
#pragma unroll
    for (int j = 0; j < 4; ++j) {
      const int col = j * 256 + lane * 4;
      sh[j] = *(const float4*)(mod + b * 6144 + 3072 + col); sc[j] = *(const float4*)(mod + b * 6144 + 4096 + col); g[j] = *(const float4*)(a.g_norm2 + col);
    }
    for (int i = 0; i < 8; ++i) {
      const size_t r = (size_t)u * 64 + wv * 8 + i;
      const float4 sq = *(const float4*)(SSQ + r * 4);
      const float rstd = rsqrtf((sq.x + sq.y + sq.z + sq.w) * (1.f / 1024.f) + EPS);
#pragma unroll
      for (int j = 0; j < 4; ++j) {
        const int col = j * 256 + lane * 4;
        const float4 xv = *(const float4*)(X1 + r * 1024 + col);
        const float h0 = xv.x * rstd * g[j].x * (1.f + sc[j].x) + sh[j].x, h1 = xv.y * rstd * g[j].y * (1.f + sc[j].y) + sh[j].y;
        const float h2 = xv.z * rstd * g[j].z * (1.f + sc[j].z) + sh[j].z, h3 = xv.w * rstd * g[j].w * (1.f + sc[j].w) + sh[j].w;
        uint2 o = {pack2(h0, h1), pack2(h2, h3)};
        *(uint2*)(H + r * 1024 + col) = o;
      }
    }
  }
}

__device__ __forceinline__ float vmaxf(float a, float b) { float r; asm("v_max_f32 %0, %1, %2" : "=v"(r) : "v"(a), "v"(b)); return r; }
__device__ __forceinline__ float vminf(float a, float b) { float r; asm("v_min_f32 %0, %1, %2" : "=v"(r) : "v"(a), "v"(b)); return r; }
#define TK_CE(x, y) do { const float _h = vmaxf((x), (y)); (y) = vminf((x), (y)); (x) = _h; } while (0)
#define TK_SORT16(t) do { TK_CE(t[0], t[1]); TK_CE(t[2], t[3]); TK_CE(t[0], t[2]); TK_CE(t[1], t[3]); TK_CE(t[1], t[2]); TK_CE(t[4], t[5]); TK_CE(t[6], t[7]); TK_CE(t[4], t[6]); TK_CE(t[5], t[7]); TK_CE(t[5], t[6]); TK_CE(t[0], t[4]); TK_CE(t[2], t[6]); TK_CE(t[2], t[4]); TK_CE(t[1], t[5]); TK_CE(t[3], t[7]); TK_CE(t[3], t[5]); TK_CE(t[1], t[2]); TK_CE(t[3], t[4]); TK_CE(t[5], t[6]); TK_CE(t[8], t[9]); TK_CE(t[10], t[11]); TK_CE(t[8], t[10]); TK_CE(t[9], t[11]); TK_CE(t[9], t[10]); TK_CE(t[12], t[13]); TK_CE(t[14], t[15]); TK_CE(t[12], t[14]); TK_CE(t[13], t[15]); TK_CE(t[13], t[14]); TK_CE(t[8], t[12]); TK_CE(t[10], t[14]); TK_CE(t[10], t[12]); TK_CE(t[9], t[13]); TK_CE(t[11], t[15]); TK_CE(t[11], t[13]); TK_CE(t[9], t[10]); TK_CE(t[11], t[12]); TK_CE(t[13], t[14]); TK_CE(t[0], t[8]); TK_CE(t[4], t[12]); TK_CE(t[4], t[8]); TK_CE(t[2], t[10]); TK_CE(t[6], t[14]); TK_CE(t[6], t[10]); TK_CE(t[2], t[4]); TK_CE(t[6], t[8]); TK_CE(t[10], t[12]); TK_CE(t[1], t[9]); TK_CE(t[5], t[13]); TK_CE(t[5], t[9]); TK_CE(t[3], t[11]); TK_CE(t[7], t[15]); TK_CE(t[7], t[11]); TK_CE(t[3], t[5]); TK_CE(t[7], t[9]); TK_CE(t[11], t[13]); TK_CE(t[1], t[2]); TK_CE(t[3], t[4]); TK_CE(t[5], t[6]); TK_CE(t[7], t[8]); TK_CE(t[9], t[10]); TK_CE(t[11], t[12]); TK_CE(t[13], t[14]); } while (0)
#define TK_BMERGE16(t) do { TK_CE(t[0], t[8]); TK_CE(t[1], t[9]); TK_CE(t[2], t[10]); TK_CE(t[3], t[11]); TK_CE(t[4], t[12]); TK_CE(t[5], t[13]); TK_CE(t[6], t[14]); TK_CE(t[7], t[15]); TK_CE(t[0], t[4]); TK_CE(t[1], t[5]); TK_CE(t[2], t[6]); TK_CE(t[3], t[7]); TK_CE(t[8], t[12]); TK_CE(t[9], t[13]); TK_CE(t[10], t[14]); TK_CE(t[11], t[15]); TK_CE(t[0], t[2]); TK_CE(t[1], t[3]); TK_CE(t[4], t[6]); TK_CE(t[5], t[7]); TK_CE(t[8], t[10]); TK_CE(t[9], t[11]); TK_CE(t[12], t[14]); TK_CE(t[13], t[15]); TK_CE(t[0], t[1]); TK_CE(t[2], t[3]); TK_CE(t[4], t[5]); TK_CE(t[6], t[7]); TK_CE(t[8], t[9]); TK_CE(t[10], t[11]); TK_CE(t[12], t[13]); TK_CE(t[14], t[15]); } while (0)
#define TK_MERGE(A, B) do { _Pragma("unroll") for (int _i = 0; _i < 16; ++_i) A[_i] = vmaxf(A[_i], B[15 - _i]); TK_BMERGE16(A); } while (0)
__constant__ unsigned long long TK_I[4] = {0x0000000000000000ull, 0x0007744411111111ull, 0x0006655333322222ull, 0x00000000FEDCBA98ull};
__constant__ unsigned long long TK_J[4] = {0xFEDCBA9876543210ull, 0x0001021076543210ull, 0x0001010321043210ull, 0x0000000000000000ull};
__constant__ int TK_N[4] = {16, 13, 13, 8};
#define TOP_INSERT(t, v) do { float _v = (v); _Pragma("unroll") for (int _i = 0; _i < 16; ++_i) { const float _h = vmaxf(t[_i], _v); _v = vminf(t[_i], _v); t[_i] = _h; } } while (0)

__device__ void phase6(const Args& a, char* lds) {
  unsigned char* ws = a.ws;
  const int tid = threadIdx.x, lane = tid & 63, wv = tid >> 6, r32 = lane & 31, hi = lane >> 5;
  const u16* H = (const u16*)(ws + WS_H); const u16* WST = (const u16*)(ws + WS_WST);
  float* TOPS = (float*)(ws + WS_TOPK);
  const float* BIASP = (const float*)(ws + WS_BIASP); const float* SSQ = (const float*)(ws + WS_SSQ);
  char* gl = lds + LDS_DATA;
  for (int u = blockIdx.x; u < 8 * 64; u += gridDim.x) {
    int tb, hd; xcd_unit(u, 8, tb, hd);
    const int b = tb >> 4;
    f32x16 sc[8];
    gemm_256x256_wide(WST + ((size_t)b * 2048 + hd * 256) * 1024, 1024, H + (size_t)tb * 256 * 1024, 1024, 32, sc, gl);
    float* bl = (float*)gl;
    if (tid < 256) bl[tid] = BIASP[((size_t)0 * 4 + b) * 2048 + hd * 256 + tid] + BIASP[((size_t)1 * 4 + b) * 2048 + hd * 256 + tid]
                           + BIASP[((size_t)2 * 4 + b) * 2048 + hd * 256 + tid] + BIASP[((size_t)3 * 4 + b) * 2048 + hd * 256 + tid];
    const float4 sq = *(const float4*)(SSQ + (size_t)(tb * 256 + 32 * wv + r32) * 4);
    const float rstd = rsqrtf((sq.x + sq.y + sq.z + sq.w) * (1.f / 1024.f) + EPS);
    __syncthreads();
#pragma unroll
    for (int half = 0; half < 2; ++half) {
      float g0[16], g1[16], g2[16], g3[16], p[16];
#pragma unroll
      for (int r = 0; r < 16; ++r) {
        const unsigned key = crow(r, hi);
        g0[r] = __uint_as_float((__float_as_uint(fmaf(sc[4 * half + 0][r], rstd, bl[128 * half + key])) & ~127u) | key);
        g1[r] = __uint_as_float((__float_as_uint(fmaf(sc[4 * half + 1][r], rstd, bl[128 * half + 32 + key])) & ~127u) | (32u + key));
        g2[r] = __uint_as_float((__float_as_uint(fmaf(sc[4 * half + 2][r], rstd, bl[128 * half + 64 + key])) & ~127u) | (64u + key));
        g3[r] = __uint_as_float((__float_as_uint(fmaf(sc[4 * half + 3][r], rstd, bl[128 * half + 96 + key])) & ~127u) | (96u + key));
      }
      TK_SORT16(g0); TK_SORT16(g1); TK_SORT16(g2); TK_SORT16(g3);
      TK_MERGE(g0, g1); TK_MERGE(g2, g3); TK_MERGE(g0, g2);
#pragma unroll
      for (int i = 0; i < 16; ++i) {
        auto rr = __builtin_amdgcn_permlane32_swap(__float_as_uint(g0[i]), __float_as_uint(g0[i]), false, false);
        p[i] = __uint_as_float(hi ? rr[0] : rr[1]);
      }
      TK_MERGE(g0, p);
      if (hi == 0) {
        float* dst = TOPS + ((size_t)(tb * 256 + 32 * wv + r32) * 16 + 2 * hd + half) * 16;
#pragma unroll
        for (int i = 0; i < 16; i += 4) *(float4*)(dst + i) = make_float4(g0[i], g0[i + 1], g0[i + 2], g0[i + 3]);
      }
    }
  }
}

typedef __attribute__((ext_vector_type(4))) float f32x4;
#define MFMA4(a, b, c) __builtin_amdgcn_mfma_f32_4x4x4bf16_1k((a), (b), (c), 0, 0, 0)
constexpr int P7_VROW = 2112, P7_VBUF = 4 * P7_VROW;
constexpr int P7_RING = 64;
constexpr int P7_ENT  = P7_RING + 8 * 2 * P7_VBUF;
constexpr int P7_CNT  = P7_ENT + 8 * 2048;
static_assert(P7_CNT + 8 * 256 <= LDS_BYTES, "phase 7 LDS map");
__device__ __forceinline__ float sel4(const f32x4& d, int k) { return k == 0 ? d[0] : (k == 1 ? d[1] : (k == 2 ? d[2] : d[3])); }
__device__ __forceinline__ unsigned fp8x2_bf16(unsigned x, float sc, bool hi) {
  return hi ? __builtin_bit_cast(unsigned, __builtin_amdgcn_cvt_scalef32_pk_bf16_fp8(x, sc, true)) : __builtin_bit_cast(unsigned, __builtin_amdgcn_cvt_scalef32_pk_bf16_fp8(x, sc, false));
}

__device__ void phase7(const Args& a, char* lds) {
  unsigned char* ws = a.ws;
  const int tid = threadIdx.x, lane = tid & 63, wv = __builtin_amdgcn_readfirstlane(tid >> 6), blk = lane >> 2, j4 = lane & 3;
  const u16* H = (const u16*)(ws + WS_H); const unsigned char* U8 = ws + WS_UB; const unsigned char* V8 = ws + WS_VB;
  const float* TOPS = (const float*)(ws + WS_TOPK); const float* X1 = (const float*)(ws + WS_X1); const float* mod = (const float*)(ws + WS_MOD);
  const float* SSQ = (const float*)(ws + WS_SSQ);
  const unsigned lbase = (unsigned)(uintptr_t)lds;
  char* ring = lds + P7_RING + wv * 2 * P7_VBUF;
  unsigned* ents = (unsigned*)(lds + P7_ENT + wv * 2048);
  int* cntw = (int*)(lds + P7_CNT + wv * 256);
  const int trb = (int)(lbase + P7_RING + wv * 2 * P7_VBUF) + ((lane & 15) >> 2) * P7_VROW + 32 * (lane >> 4) + 8 * (lane & 3);
  const int NWV = gridDim.x * 8;
  for (int qd = blockIdx.x * 8 + wv; qd < T / 4; qd += NWV) {
    const int tok0 = qd * 4, b = tok0 >> 12;
    float* TS = (float*)ring;
#pragma unroll
    for (int i = 0; i < 4; ++i) *(float4*)(TS + 256 * i + 4 * lane) = *(const float4*)(TOPS + (size_t)tok0 * 256 + 256 * i + 4 * lane);
    cntw[lane] = 0;
    asm volatile("s_waitcnt lgkmcnt(0)" ::: "memory");
    unsigned ec[8];
#pragma unroll
    for (int rd = 0; rd < 2; ++rd) {
      const int combo = (lane >> 2) + 16 * rd, tl = combo >> 3, hd = combo & 7, q = lane & 3;
      const float* t1 = TS + (tl * 16 + hd * 2) * 16; const float* t2 = t1 + 16;
      const unsigned long long ip = TK_I[q], jp = TK_J[q]; const int cn = TK_N[q];
      float L[16], P[16];
#pragma unroll
      for (int c = 0; c < 16; ++c) {
        const unsigned i = (unsigned)(ip >> (4 * c)) & 15u, j = (unsigned)(jp >> (4 * c)) & 15u;
        const float sm = t1[i] + t2[j];
        L[c] = c < cn ? __uint_as_float((__float_as_uint(sm) & ~255u) | (i << 4) | j) : -3.0e38f;
      }
      TK_SORT16(L);
#pragma unroll
      for (int c = 0; c < 16; ++c) P[c] = __uint_as_float(__builtin_amdgcn_update_dpp(0, __float_as_uint(L[c]), 0xB1, 0xf, 0xf, false));
      TK_MERGE(L, P);
#pragma unroll
      for (int c = 0; c < 16; ++c) P[c] = __uint_as_float(__builtin_amdgcn_update_dpp(0, __float_as_uint(L[c]), 0x4E, 0xf, 0xf, false));
      TK_MERGE(L, P);
      float sum = 0.f;
      const float m0 = __uint_as_float(__float_as_uint(L[0]) & ~255u);
#pragma unroll
      for (int c = 0; c < 16; ++c) sum += __expf(__uint_as_float(__float_as_uint(L[c]) & ~255u) - m0);
      const float inv = 1.f / sum;
#pragma unroll
      for (int r = 0; r < 4; ++r) {
        const float lv = q == 0 ? L[r] : (q == 1 ? L[4 + r] : (q == 2 ? L[8 + r] : L[12 + r]));
        const unsigned bits = __float_as_uint(lv), id = bits & 255u;
        const unsigned i1 = __float_as_uint(t1[id >> 4]) & 127u, i2 = __float_as_uint(t2[id & 15u]) & 127u;
        const float gate = __expf(__uint_as_float(bits & ~255u) - m0) * inv;
        ec[4 * rd + r] = (i1 * 128u + i2) | ((unsigned)tl << 14) | (pack2(0.f, gate) & 0xFFFF0000u);
      }
    }
    {
#pragma unroll
      for (int i = 0; i < 8; ++i) atomicAdd(&cntw[(ec[i] & 0x3FFFu) >> 8], 1);
      asm volatile("s_waitcnt lgkmcnt(0)" ::: "memory");
      const int c = cntw[lane]; int inc = c;
#pragma unroll
      for (int o = 1; o < 64; o <<= 1) { const int v = __shfl_up(inc, o, 64); if (lane >= o) inc += v; }
      asm volatile("s_waitcnt lgkmcnt(0)" ::: "memory");
      cntw[lane] = inc - c;
      asm volatile("s_waitcnt lgkmcnt(0)" ::: "memory");
#pragma unroll
      for (int i = 0; i < 8; ++i) { const int pos = atomicAdd(&cntw[(ec[i] & 0x3FFFu) >> 8], 1); ents[pos] = ec[i]; }
      asm volatile("s_waitcnt lgkmcnt(0)" ::: "memory");
    }
    u32x4 hA[4][2];
    { const float4 sq = *(const float4*)(SSQ + (size_t)(tok0 + j4) * 4);
      const float rstd = rsqrtf((sq.x + sq.y + sq.z + sq.w) * (1.f / 1024.f) + EPS);
#pragma unroll
      for (int i = 0; i < 4; ++i)
#pragma unroll
        for (int hf = 0; hf < 2; ++hf) {
          const int k0 = 256 * i + 16 * blk + 8 * hf;
          const u32x4 xb = *(const u32x4*)(H + (size_t)(tok0 + j4) * 1024 + k0);
          float hv[8];
#pragma unroll
          for (int e = 0; e < 8; e += 4) {
            const float4 g = *(const float4*)(a.g_norm2 + k0 + e), sc4 = *(const float4*)(mod + b * 6144 + 4096 + k0 + e), sh4 = *(const float4*)(mod + b * 6144 + 3072 + k0 + e);
            hv[e]     = bflo(xb[e >> 1]) * rstd * g.x * (1.f + sc4.x) + sh4.x;     hv[e + 1] = bfhi(xb[e >> 1]) * rstd * g.y * (1.f + sc4.y) + sh4.y;
            hv[e + 2] = bflo(xb[(e >> 1) + 1]) * rstd * g.z * (1.f + sc4.z) + sh4.z; hv[e + 3] = bfhi(xb[(e >> 1) + 1]) * rstd * g.w * (1.f + sc4.w) + sh4.w;
          }
          hA[i][hf] = (u32x4){pack2(hv[0], hv[1]), pack2(hv[2], hv[3]), pack2(hv[4], hv[5]), pack2(hv[6], hv[7])};
        } }
    f32x4 acc[16];
#pragma unroll
    for (int c = 0; c < 16; ++c) acc[c] = (f32x4){0.f, 0.f, 0.f, 0.f};
#define P7_VPHASE(bufi) do { const int _vb = trb + (bufi) * P7_VBUF;                                                            \
      { const s16x4 v0 = tr_read<0>(_vb), v1 = tr_read<128>(_vb), v2 = tr_read<256>(_vb), v3 = tr_read<384>(_vb),               \
                    v4 = tr_read<512>(_vb), v5 = tr_read<640>(_vb), v6 = tr_read<768>(_vb), v7 = tr_read<896>(_vb);               \
        asm volatile("s_waitcnt lgkmcnt(0)" ::: "memory"); SBAR();                                                                \
        acc[0] = MFMA4(awp, v0, acc[0]); acc[1] = MFMA4(awp, v1, acc[1]); acc[2] = MFMA4(awp, v2, acc[2]); acc[3] = MFMA4(awp, v3, acc[3]);   \
        acc[4] = MFMA4(awp, v4, acc[4]); acc[5] = MFMA4(awp, v5, acc[5]); acc[6] = MFMA4(awp, v6, acc[6]); acc[7] = MFMA4(awp, v7, acc[7]); } \
      { const s16x4 v0 = tr_read<1024>(_vb), v1 = tr_read<1152>(_vb), v2 = tr_read<1280>(_vb), v3 = tr_read<1408>(_vb),         \
                    v4 = tr_read<1536>(_vb), v5 = tr_read<1664>(_vb), v6 = tr_read<1792>(_vb), v7 = tr_read<1920>(_vb);           \
        asm volatile("s_waitcnt lgkmcnt(0)" ::: "memory"); SBAR();                                                                \
        acc[8] = MFMA4(awp, v0, acc[8]); acc[9] = MFMA4(awp, v1, acc[9]); acc[10] = MFMA4(awp, v2, acc[10]); acc[11] = MFMA4(awp, v3, acc[11]); \
        acc[12] = MFMA4(awp, v4, acc[12]); acc[13] = MFMA4(awp, v5, acc[13]); acc[14] = MFMA4(awp, v6, acc[14]); acc[15] = MFMA4(awp, v7, acc[15]); } } while (0)
    u32x4 u8[4], v8[4];
#define P7_LOADG(EN) do { const unsigned _ex = (EN) & 0x3FFFu; const unsigned char* _pu = U8 + (size_t)_ex * 1024 + 16 * blk;      \
      _Pragma("unroll") for (int _i = 0; _i < 4; ++_i) u8[_i] = *(const u32x4*)(_pu + 256 * _i);                                 \
      _Pragma("unroll") for (int _q = 0; _q < 4; ++_q) { const unsigned _eq = (unsigned)__builtin_amdgcn_readlane((int)_ex, _q);  \
        v8[_q] = *(const u32x4*)(V8 + (size_t)_eq * 1024 + 16 * lane); } } while (0)
    unsigned enc = ents[j4], enn = ents[4 + j4];
    P7_LOADG(enc);
    s16x4 awp = {0, 0, 0, 0};
    constexpr int NG = 128;
#pragma unroll 2
    for (int g = 0; g < NG; ++g) {
      if (g > 0) P7_VPHASE((g - 1) & 1);
      f32x4 d0 = {0.f, 0.f, 0.f, 0.f}, d1 = {0.f, 0.f, 0.f, 0.f};
#pragma unroll
      for (int i = 0; i < 4; ++i)
#pragma unroll
        for (int w = 0; w < 4; ++w) {
          const uint2 ub = {fp8x2_bf16(u8[i][w], 1.f / PEER_SU, false), fp8x2_bf16(u8[i][w], 1.f / PEER_SU, true)};
          const uint2 ha = {hA[i][w >> 1][2 * (w & 1)], hA[i][w >> 1][2 * (w & 1) + 1]};
          if (w & 1) d1 = MFMA4(__builtin_bit_cast(s16x4, ha), __builtin_bit_cast(s16x4, ub), d1);
          else       d0 = MFMA4(__builtin_bit_cast(s16x4, ha), __builtin_bit_cast(s16x4, ub), d0);
        }
      { char* vw = ring + (g & 1) * P7_VBUF + lane * 32;
#pragma unroll
        for (int q = 0; q < 4; ++q) {
          u32x4 o0, o1;
          o0[0] = fp8x2_bf16(v8[q][0], 1.f / PEER_SV, false); o0[1] = fp8x2_bf16(v8[q][0], 1.f / PEER_SV, true);
          o0[2] = fp8x2_bf16(v8[q][1], 1.f / PEER_SV, false); o0[3] = fp8x2_bf16(v8[q][1], 1.f / PEER_SV, true);
          o1[0] = fp8x2_bf16(v8[q][2], 1.f / PEER_SV, false); o1[1] = fp8x2_bf16(v8[q][2], 1.f / PEER_SV, true);
          o1[2] = fp8x2_bf16(v8[q][3], 1.f / PEER_SV, false); o1[3] = fp8x2_bf16(v8[q][3], 1.f / PEER_SV, true);
          *(u32x4*)(vw + q * P7_VROW) = o0; *(u32x4*)(vw + q * P7_VROW + 16) = o1;
        } }
      unsigned en2 = 0u;
      if (g + 1 < NG) { P7_LOADG(enn); if (g + 2 < NG) en2 = ents[4 * (g + 2) + j4]; }
      const int tk = (enc >> 14) & 3;
      float av = sel4(d0, tk) + sel4(d1, tk);
      av += __uint_as_float(__builtin_amdgcn_update_dpp(0, __float_as_uint(av), 0x124, 0xf, 0xf, false));
      av += __uint_as_float(__builtin_amdgcn_update_dpp(0, __float_as_uint(av), 0x128, 0xf, 0xf, false));
      av += __shfl_xor(av, 16, 64);
      { auto rr = __builtin_amdgcn_permlane32_swap(__float_as_uint(av), __float_as_uint(av), false, false); av = __uint_as_float(rr[0]) + __uint_as_float(rr[1]); }
      const float wgt = gelu_exact(av) * __uint_as_float(enc & 0xFFFF0000u);
      float z[4];
#define P7_QB(x, k) __builtin_amdgcn_update_dpp(0, (x), (k) * 0x55, 0xf, 0xf, false)
      { const unsigned wb = __float_as_uint(wgt), tb = (unsigned)tk;
        unsigned w0 = P7_QB(wb, 0), w1 = P7_QB(wb, 1), w2 = P7_QB(wb, 2), w3 = P7_QB(wb, 3);
        unsigned t0 = P7_QB(tb, 0), t1 = P7_QB(tb, 1), t2 = P7_QB(tb, 2), t3 = P7_QB(tb, 3);
        asm volatile("" : "+v"(w0), "+v"(w1), "+v"(w2), "+v"(w3), "+v"(t0), "+v"(t1), "+v"(t2), "+v"(t3));
        z[0] = ((int)t0 == j4) ? __uint_as_float(w0) : 0.f; z[1] = ((int)t1 == j4) ? __uint_as_float(w1) : 0.f;
        z[2] = ((int)t2 == j4) ? __uint_as_float(w2) : 0.f; z[3] = ((int)t3 == j4) ? __uint_as_float(w3) : 0.f; }
#undef P7_QB
      { const uint2 pk = {pack2(z[0], z[1]), pack2(z[2], z[3])}; awp = __builtin_bit_cast(s16x4, pk); }
      enc = enn; enn = en2;
    }
#undef P7_LOADG
    P7_VPHASE((NG - 1) & 1);
#undef P7_VPHASE
    int lne = lane; asm volatile("" : "+v"(lne));
    float ss[4] = {0.f, 0.f, 0.f, 0.f};
#pragma unroll
    for (int c = 0; c < 16; ++c) {
      const float g2 = mod[b * 6144 + 5120 + 64 * c + lne];
#pragma unroll
      for (int r = 0; r < 4; ++r) { const float v = bflo((unsigned)H[(size_t)(tok0 + r) * 1024 + 64 * c + lne]) + g2 * acc[c][r]; acc[c][r] = v; ss[r] += v * v; }
    }
    float rstd[4];
#pragma unroll
    for (int r = 0; r < 4; ++r) rstd[r] = rsqrtf(wave_sum(ss[r]) * (1.f / 1024.f) + EPS);
#pragma unroll
    for (int c = 0; c < 16; ++c) {
      const float gf = a.g_final[64 * c + lne];
#pragma unroll
      for (int r = 0; r < 4; ++r) a.out[(size_t)(tok0 + r) * 1024 + 64 * c + lne] = acc[c][r] * rstd[r] * gf;
    }
  }
}

constexpr int N_PHASES = 8;
__global__ void __launch_bounds__(512, 2) fwd(Args args) {
  extern __shared__ __attribute__((aligned(16))) char lds[];
  if (threadIdx.x == 0) *(uint4*)lds = make_uint4(0u, 0u, 0u, 0u);
  __syncthreads();
  const int lo = args.ph_lo, hi = args.ph_hi;
  XcdBarrier bar; bar.bar = (unsigned*)(args.ws + WS_BAR); bar.x = 0; bar.st = (volatile LAS unsigned*)lds;
  if (hi - lo > 1) bar = xcd_barrier_post((unsigned*)(args.ws + WS_BAR), (volatile LAS unsigned*)lds);
#ifndef ONLY_PHASE
#define ONLY_PHASE -1
#endif
#define IN(k) (lo <= (k) && (k) < hi && (ONLY_PHASE < 0 || ONLY_PHASE == (k)))
#define SEAM(k) do { if (IN(k) && IN((k) + 1)) xcd_barrier(bar); } while (0)
  if (IN(0)) phase0(args, lds);
  SEAM(0);
  if (IN(1)) { phase1(args, lds); phase1b(args, lds); }
  SEAM(1);
  if (IN(2)) phase2(args, lds);
  SEAM(2);
  if (IN(3)) phase3(args, lds);
  SEAM(3);
  if (IN(4)) phase4(args, lds);
  SEAM(4);
  if (IN(5)) phase5(args, lds);
  SEAM(5);
  if (IN(6)) phase6(args, lds);
  SEAM(6);
  if (IN(7)) phase7(args, lds);
#undef IN
#undef SEAM
}

extern "C" void kernel_launch(void* const* d_in, const int* in_sizes, int n_in, void* d_out, int out_size, void* d_ws, size_t ws_size, hipStream_t stream) {
  static int grid = 0;
  if (grid == 0) {
    if (n_in != 23 || out_size != T * DM || ws_size < WS_END) { fprintf(stderr, "kernel_launch: unexpected shapes (n_in %d out %d ws %zu need %zu)\n", n_in, out_size, ws_size, (size_t)WS_END); grid = -1; return; }
    int dev = 0, cus = 0, per_cu = 0;
    (void)hipGetDevice(&dev); (void)hipDeviceGetAttribute(&cus, hipDeviceAttributeMultiprocessorCount, dev);
    if (hipFuncSetAttribute((const void*)fwd, hipFuncAttributeMaxDynamicSharedMemorySize, LDS_BYTES) != hipSuccess) { fprintf(stderr, "kernel_launch: hipFuncSetAttribute failed\n"); grid = -1; return; }
    if (hipOccupancyMaxActiveBlocksPerMultiprocessor(&per_cu, (const void*)fwd, 512, LDS_BYTES) != hipSuccess || per_cu < 1) { fprintf(stderr, "kernel_launch: occupancy query says %d\n", per_cu); per_cu = 1; }
    (void)hipGetLastError();
    grid = cus;
  }
  if (grid < 0) return;
  (void)hipMemsetAsync((char*)d_ws + WS_BAR, 0, 16384, stream);
  Args a{};
  a.x = (const float*)d_in[0]; a.c = (const float*)d_in[1]; a.pos = (const int*)d_in[2];
  a.w_ada = (const float*)d_in[3]; a.b_ada = (const float*)d_in[4]; a.g_norm1 = (const float*)d_in[5]; a.w_in = (const float*)d_in[6];
  a.g_q_a = (const float*)d_in[7]; a.w_uq = (const float*)d_in[8]; a.g_kv_a = (const float*)d_in[9]; a.w_ukv = (const float*)d_in[10];
  a.g_sg = (const float*)d_in[11]; a.w_sg = (const float*)d_in[12]; a.b_sg = (const float*)d_in[13]; a.g_attn_out = (const float*)d_in[14];
  a.g_sg_out = (const float*)d_in[15]; a.w_o = (const float*)d_in[16]; a.g_norm2 = (const float*)d_in[17]; a.w_peer_q = (const float*)d_in[18];
  a.peer_keys = (const float*)d_in[19]; a.peer_u = (const float*)d_in[20]; a.peer_v = (const float*)d_in[21]; a.g_final = (const float*)d_in[22];
  a.out = (float*)d_out; a.ws = (unsigned char*)d_ws;
#if N_LAUNCH_MODE == 0
  a.ph_lo = 0; a.ph_hi = N_PHASES;
  hipLaunchKernelGGL(fwd, dim3(grid), dim3(512), LDS_BYTES, stream, a);
#else
  for (int p = 0; p < N_PHASES; ++p) for (int rep = 0; rep <= ((DUP_MASK >> p) & 1); ++rep) { a.ph_lo = p; a.ph_hi = p + 1; hipLaunchKernelGGL(fwd, dim3(grid), dim3(512), LDS_BYTES, stream, a); }
#endif
  const hipError_t le = hipPeekAtLastError();
  if (le != hipSuccess) fprintf(stderr, "kernel_launch: launch failed: %s\n", hipGetErrorName(le));
}
```

```cpp
#include <hip/hip_runtime.h>
#include <stdint.h>
#include <stdio.h>

#define N_LAUNCH_MODE 0
#define DUP_MASK 0x000

typedef unsigned short u16;
typedef __attribute__((ext_vector_type(8))) short bf16x8;
typedef __attribute__((ext_vector_type(4))) short s16x4;
typedef __attribute__((ext_vector_type(16))) float f32x16;
typedef __attribute__((ext_vector_type(4))) unsigned u32x4;

constexpr int T = 16384, DM = 1024, SEQ = 4096;
constexpr float EPS = 1e-6f;

constexpr size_t WS_BAR  = 0;
constexpr size_t WS_MODP = 16384;
constexpr size_t WS_MOD  = WS_MODP + 786432;
constexpr size_t WS_CS   = WS_MOD + 98304;
constexpr size_t WS_WIN  = WS_CS + 4194304;
constexpr size_t WS_WQ2  = WS_WIN + 3145728;
constexpr size_t WS_WUV  = WS_WQ2 + 393216;
constexpr size_t WS_WO   = WS_WUV + 131072;
constexpr size_t WS_WPQ  = WS_WO + 2097152;
constexpr size_t WS_KEYS = WS_WPQ + 4194304;
constexpr size_t WS_WSG  = WS_KEYS + 524288;
constexpr size_t WS_UB   = WS_WSG + 131072;
constexpr size_t WS_VB   = WS_UB + 33554432;
constexpr size_t WS_H    = WS_VB + 33554432;
constexpr size_t WS_Y    = WS_H + 33554432;
constexpr size_t WS_KV   = WS_Y + 33554432;
constexpr size_t WS_TOPK = WS_KV + 6291456;
constexpr size_t WS_SSQ  = WS_TOPK + 16777216;
constexpr size_t WS_SSQV = WS_SSQ + 262144;
constexpr size_t WS_R1   = WS_SSQV + 131072;
constexpr size_t WS_Q    = WS_R1;
constexpr size_t WS_QA   = WS_Q + 25165824;
constexpr size_t WS_UACT = WS_QA + 8388608;
constexpr size_t WS_GVT  = WS_UACT + 16777216;
constexpr size_t WS_X1   = WS_R1;
constexpr size_t WS_WST  = WS_R1 + 67108864;
constexpr size_t WS_BIASP = WS_WST + 4 * 4194304;
constexpr size_t WS_END  = WS_BIASP + 131072;

constexpr int LDS_BYTES = 155648;
constexpr int LDS_DATA  = 64;

struct Args {
  const float *x, *c; const int* pos;
  const float *w_ada, *b_ada, *g_norm1, *w_in, *g_q_a, *w_uq, *g_kv_a, *w_ukv, *g_sg, *w_sg, *b_sg, *g_attn_out, *g_sg_out,
              *w_o, *g_norm2, *w_peer_q, *peer_keys, *peer_u, *peer_v, *g_final;
  float* out; unsigned char* ws; int ph_lo, ph_hi;
};

#define XB_TMO      128
#define XB_XCNT(j)  (256  + 64 * (j))
#define XB_XSUB(j)  (1280 + 64 * (j))
#define XB_XGEN(j)  (2304 + 64 * (j))
#define XB_TOP      3328
#define XB_TOPGEN   3392
#define XCD_BAR_WORDS 3456
#define XB_SPIN_CAP (1u << 18)
#define LAS __attribute__((address_space(3)))

__device__ __forceinline__ unsigned xb_ld(unsigned* p)              { return __hip_atomic_load(p, __ATOMIC_RELAXED, __HIP_MEMORY_SCOPE_AGENT); }
__device__ __forceinline__ unsigned xb_add(unsigned* p, unsigned v) { return __hip_atomic_fetch_add(p, v, __ATOMIC_RELAXED, __HIP_MEMORY_SCOPE_AGENT); }
__device__ __forceinline__ unsigned xb_xcc_id() { return (unsigned)__builtin_amdgcn_s_getreg((3 << 11) | 20) & 0xFu; }
#define XB_SPIN(cond, bar) do { unsigned _sp = 0; while (cond) { __builtin_amdgcn_s_sleep(1); \
    if ((++_sp & 255u) == 0u) { if (xb_ld(&(bar)[XB_TMO])) break; if (_sp > XB_SPIN_CAP) { atomicAdd(&(bar)[XB_TMO], 1u); break; } } } } while (0)

struct XcdBarrier { unsigned* bar; unsigned x; volatile LAS unsigned* st; };

__device__ __forceinline__ XcdBarrier xcd_barrier_post(unsigned* bar, volatile LAS unsigned* st) {
    XcdBarrier b; b.bar = bar; b.x = xb_xcc_id(); b.st = st;
    if (threadIdx.x == 0) (void)xb_add(&bar[XB_XCNT(b.x)], 1u);
    return b;
}
__device__ __forceinline__ void xcd_barrier_complete(unsigned* bar, unsigned x, unsigned& nloc, unsigned& nx) {
    const unsigned G = gridDim.x * gridDim.y * gridDim.z;
    unsigned sum, cnt, mine, sp = 0u;
    for (;;) {
        sum = 0u; cnt = 0u; mine = 0u;
#pragma unroll
        for (unsigned j = 0; j < 16; ++j) { const unsigned c = xb_ld(&bar[XB_XCNT(j)]); sum += c; cnt += (c > 0u) ? 1u : 0u; mine = (j == x) ? c : mine; }
        if (sum == G) break;
        __builtin_amdgcn_s_sleep(1);
        if ((++sp & 255u) == 0u) { if (xb_ld(&bar[XB_TMO])) break; if (sp > XB_SPIN_CAP) { atomicAdd(&bar[XB_TMO], 1u); break; } }
    }
    nloc = mine > 0u ? mine : 1u; nx = cnt > 0u ? cnt : 1u;
}
__device__ __forceinline__ void xcd_barrier(const XcdBarrier& b) {
    asm volatile("s_waitcnt vmcnt(0)" ::: "memory");
    __syncthreads();
    if (threadIdx.x == 0) {
        unsigned* bar = b.bar;
        __builtin_amdgcn_s_waitcnt(0);
        unsigned nloc = b.st[0], nx = b.st[1];
        if (nloc == 0u) { xcd_barrier_complete(bar, b.x, nloc, nx); b.st[0] = nloc; b.st[1] = nx; }
        const unsigned old = xb_add(&bar[XB_XSUB(b.x)], 1u);
        const unsigned gen = old / nloc;
        if (old + 1u == (gen + 1u) * nloc) {
            __builtin_amdgcn_fence(__ATOMIC_RELEASE, "agent");
            asm volatile("s_waitcnt vmcnt(0)" ::: "memory");
            const unsigned og = xb_add(&bar[XB_TOP], 1u);
            const unsigned tg = og / nx;
            if (og + 1u == (tg + 1u) * nx) xb_add(&bar[XB_TOPGEN], 1u);
            else XB_SPIN(xb_ld(&bar[XB_TOPGEN]) == tg, bar);
            __builtin_amdgcn_fence(__ATOMIC_ACQUIRE, "agent");
            xb_add(&bar[XB_XGEN(b.x)], 1u);
            asm volatile("s_waitcnt vmcnt(0)" ::: "memory");
        } else {
            XB_SPIN(xb_ld(&bar[XB_XGEN(b.x)]) == gen, bar);
            __builtin_amdgcn_fence(__ATOMIC_ACQUIRE, "agent");
            asm volatile("s_waitcnt vmcnt(0)" ::: "memory");
        }
    }
    __syncthreads();
}

__device__ __forceinline__ unsigned pack2(float lo, float hi) {
  typedef __attribute__((ext_vector_type(2))) float f2; typedef __attribute__((ext_vector_type(2))) __bf16 b2;
  f2 v = {lo, hi}; b2 r = __builtin_convertvector(v, b2); return __builtin_bit_cast(unsigned, r);
}
__device__ __forceinline__ u16 f2bf(float f) { return (u16)(pack2(f, 0.f) & 0xFFFFu); }
__device__ __forceinline__ float bflo(unsigned w) { return __uint_as_float(w << 16); }
__device__ __forceinline__ float bfhi(unsigned w) { return __uint_as_float(w & 0xFFFF0000u); }
__device__ __forceinline__ float gelu_exact(float x) {
  const float z = fabsf(x) * 0.70710678118654752f;
  const float t = __builtin_amdgcn_rcpf(fmaf(0.3275911f, z, 1.f));
  float p = fmaf(1.061405429f, t, -1.453152027f); p = fmaf(p, t, 1.421413741f); p = fmaf(p, t, -0.284496736f); p = fmaf(p, t, 0.254829592f);
  const float e = p * t * __expf(-z * z);
  const float erfz = 1.f - e;
  return 0.5f * x * (1.f + copysignf(erfz, x));
}
__device__ __forceinline__ float wave_sum(float v) {
#pragma unroll
  for (int o = 32; o > 0; o >>= 1) v += __shfl_xor(v, o, 64);
  return v;
}
__device__ __forceinline__ int crow(int r, int hi) { return (r & 3) + 8 * (r >> 2) + 4 * hi; }
#define MFMA32(a, b, c) __builtin_amdgcn_mfma_f32_32x32x16_bf16((a), (b), (c), 0, 0, 0)

template <int MAP> __device__ __forceinline__ int colmap(int n) {
  if (MAP == 0) return n;
  if (MAP == 1) return n < 448 ? n : (n < 512 ? -1 : n - 64);
  if (MAP == 2) return (n >> 6) * 192 + 128 + (n & 63);
  return (n >> 7) * 256 + 128 + (n & 127);
}
template <int MAP> __device__ void cvt_transpose(const float* __restrict__ src, int src_ld, int K, int N, u16* __restrict__ dst, int gtid, int gthreads) {
  const int total = N * (K >> 3);
  for (int idx = gtid; idx < total; idx += gthreads) {
    const int n = idx % N, k8 = idx / N, sc = colmap<MAP>(n);
    float v[8];
#pragma unroll
    for (int j = 0; j < 8; ++j) v[j] = sc < 0 ? 0.f : src[(size_t)(k8 * 8 + j) * src_ld + sc];
    u32x4 w = {pack2(v[0], v[1]), pack2(v[2], v[3]), pack2(v[4], v[5]), pack2(v[6], v[7])};
    *(u32x4*)(dst + (size_t)n * K + k8 * 8) = w;
  }
}
template <int MAP> __device__ void cvt_transpose_tiled(const float* __restrict__ src, int src_ld, int K, int N, u16* __restrict__ dst, float* tile) {
  const int tid = threadIdx.x, tk = K >> 6, ntile = tk * (N >> 6);
  for (int t = blockIdx.x; t < ntile; t += gridDim.x) {
    const int k0 = (t % tk) * 64, n0 = (t / tk) * 64;
    __syncthreads();
    { const int nl = tid & 63, sc = colmap<MAP>(n0 + nl);
#pragma unroll
      for (int i = 0; i < 8; ++i) { const int k = (tid >> 6) + 8 * i; tile[k * 65 + nl] = sc < 0 ? 0.f : src[(size_t)(k0 + k) * src_ld + sc]; } }
    __syncthreads();
    { const int n = tid >> 3, kk = tid & 7; float v[8];
#pragma unroll
      for (int j = 0; j < 8; ++j) v[j] = tile[(8 * kk + j) * 65 + n];
      u32x4 w = {pack2(v[0], v[1]), pack2(v[2], v[3]), pack2(v[4], v[5]), pack2(v[6], v[7])};
      *(u32x4*)(dst + (size_t)(n0 + n) * K + k0 + 8 * kk) = w; }
  }
}
__device__ void cvt_direct(const float* __restrict__ src, u16* __restrict__ dst, size_t n8, int gtid, int gthreads) {
  for (size_t i = gtid; i < n8; i += gthreads) {
    const float4 a = *(const float4*)(src + i * 8), b = *(const float4*)(src + i * 8 + 4);
    u32x4 w = {pack2(a.x, a.y), pack2(a.z, a.w), pack2(b.x, b.y), pack2(b.z, b.w)};
    *(u32x4*)(dst + i * 8) = w;
  }
}
constexpr float PEER_SU = 32.f, PEER_SV = 4.f;
__device__ __forceinline__ void sincos_acc(float angf, float& sn, float& cs) {
  const double a = (double)angf;
  const double q = __builtin_rint(a * 0.63661977236758134308);
  double r = __builtin_fma(-q, 1.5707963267948966, a);
  r = __builtin_fma(-q, 6.123233995736766e-17, r);
  const double r2 = r * r;
  double s = r2 * (1.0 / 6227020800.0) - 1.0 / 39916800.0;
  s = s * r2 + 1.0 / 362880.0; s = s * r2 - 1.0 / 5040.0; s = s * r2 + 1.0 / 120.0; s = s * r2 - 1.0 / 6.0; s = r + r * r2 * s;
  double c = -r2 * (1.0 / 87178291200.0) + 1.0 / 479001600.0;
  c = c * r2 - 1.0 / 3628800.0; c = c * r2 + 1.0 / 40320.0; c = c * r2 - 1.0 / 720.0; c = c * r2 + 1.0 / 24.0; c = c * r2 - 0.5; c = 1.0 + r2 * c;
  const int n = ((int)q) & 3;
  const double ss = (n & 1) ? c : s, cc = (n & 1) ? s : c;
  sn = (float)((n & 2) ? -ss : ss);
  cs = (float)(((n + 1) & 2) ? -cc : cc);
}

__constant__ float INVF[32] = {1.000000000e+00f, 7.498942018e-01f, 5.623413324e-01f, 4.216965139e-01f, 3.162277639e-01f, 2.371373922e-01f, 1.778279394e-01f, 1.333521456e-01f,
  1.000000015e-01f, 7.498941571e-02f, 5.623412877e-02f, 4.216964915e-02f, 3.162277862e-02f, 2.371373586e-02f, 1.778279431e-02f, 1.333521493e-02f,
  9.999999776e-03f, 7.498942316e-03f, 5.623413250e-03f, 4.216964822e-03f, 3.162277862e-03f, 2.371373819e-03f, 1.778279431e-03f, 1.333521446e-03f,
  1.000000047e-03f, 7.498941850e-04f, 5.623413017e-04f, 4.216965463e-04f, 3.162277862e-04f, 2.371373848e-04f, 1.778279402e-04f, 1.333521504e-04f};
__device__ void phase0(const Args& a, char* lds) {
  unsigned char* ws = a.ws;
  const int tid = threadIdx.x, lane = tid & 63, wv = tid >> 6;
  const int NWV = gridDim.x * 8, gw = blockIdx.x * 8 + wv;
  const int gthreads = gridDim.x * 512, gtid = blockIdx.x * 512 + tid;
  float* modp = (float*)(ws + WS_MODP);
  for (int job = gw; job < 768; job += NWV) {
    const int cg = job % 96, ks = job / 96, col = cg * 64 + lane;
    float a0 = 0.f, a1 = 0.f, a2 = 0.f, a3 = 0.f;
    const float* w = a.w_ada + (size_t)(ks * 128) * 6144 + col;
    float sv[2][4];
#pragma unroll
    for (int h = 0; h < 2; ++h)
#pragma unroll
      for (int bb = 0; bb < 4; ++bb) { const float cv = a.c[bb * 1024 + ks * 128 + 64 * h + lane]; sv[h][bb] = cv / (1.f + __expf(-cv)); }
#pragma unroll
    for (int h = 0; h < 2; ++h) {
#pragma unroll 8
      for (int k = 0; k < 64; ++k) {
        const float wv_ = w[(size_t)(64 * h + k) * 6144];
        a0 += __uint_as_float(__builtin_amdgcn_readlane(__float_as_uint(sv[h][0]), k)) * wv_;
        a1 += __uint_as_float(__builtin_amdgcn_readlane(__float_as_uint(sv[h][1]), k)) * wv_;
        a2 += __uint_as_float(__builtin_amdgcn_readlane(__float_as_uint(sv[h][2]), k)) * wv_;
        a3 += __uint_as_float(__builtin_amdgcn_readlane(__float_as_uint(sv[h][3]), k)) * wv_;
      }
    }
    modp[(ks * 4 + 0) * 6144 + col] = a0; modp[(ks * 4 + 1) * 6144 + col] = a1;
    modp[(ks * 4 + 2) * 6144 + col] = a2; modp[(ks * 4 + 3) * 6144 + col] = a3;
  }
  { float* tile = (float*)(lds + LDS_DATA);
    cvt_transpose_tiled<1>(a.w_in, 1472, 1024, 1536, (u16*)(ws + WS_WIN), tile);
    cvt_transpose_tiled<0>(a.w_o, 1024, 1024, 1024, (u16*)(ws + WS_WO), tile);
    cvt_transpose_tiled<2>(a.w_uq, 768, 256, 256, (u16*)(ws + WS_WQ2) + 512 * 256, tile);
    cvt_transpose_tiled<3>(a.w_ukv, 1024, 128, 512, (u16*)(ws + WS_WUV), tile); }
  {
    u16* wq2 = (u16*)(ws + WS_WQ2);
    for (int idx = gtid; idx < 512 * 256; idx += gthreads) {
      const int n = idx >> 8, i = idx & 255, h = n >> 7, cc = n & 127;
      const float* pu = a.w_uq + (size_t)i * 768 + h * 192;
      const float* pk = a.w_ukv + (size_t)cc * 1024 + h * 256;
      float s = 0.f;
#pragma unroll 8
      for (int d = 0; d < 128; d += 4) {
        const float4 u = *(const float4*)(pu + d), k = *(const float4*)(pk + d);
        s += u.x * k.x + u.y * k.y + u.z * k.z + u.w * k.w;
      }
      wq2[(size_t)n * 256 + i] = f2bf(s);
    }
  }
  cvt_direct(a.peer_keys, (u16*)(ws + WS_KEYS), 262144 / 8, gtid, gthreads);
  cvt_direct(a.w_peer_q, (u16*)(ws + WS_WPQ), (size_t)1024 * 2048 / 8, gtid, gthreads);
  cvt_direct(a.w_sg, (u16*)(ws + WS_WSG), 65536 / 8, gtid, gthreads);
  {
    float* cs = (float*)(ws + WS_CS);
    for (int idx = gtid; idx < T * 32; idx += gthreads) {
      const int t = idx >> 5, i = idx & 31;
      const float inv = INVF[i];
      const float ang = (float)a.pos[t] * inv;
      float sn, c_; sincos_acc(ang, sn, c_);
      cs[(size_t)t * 64 + i] = c_; cs[(size_t)t * 64 + 32 + i] = sn;
    }
  }
}

__device__ void phase1(const Args& a, char* lds) {
  unsigned char* ws = a.ws;
  const int tid = threadIdx.x, lane = tid & 63, wv = tid >> 6;
  const float* modp = (const float*)(ws + WS_MODP);
  float* mod = (float*)(ws + WS_MOD);
  for (int idx = blockIdx.x * 512 + tid; idx < 4 * 6144; idx += gridDim.x * 512) {
    const int b = idx / 6144, m = idx % 6144;
    float s = a.b_ada[m];
#pragma unroll
    for (int ks = 0; ks < 8; ++ks) s += modp[(ks * 4 + b) * 6144 + m];
    mod[idx] = s;
  }
  float* sh = (float*)(lds + LDS_DATA);
  u16* H = (u16*)(ws + WS_H);
  for (int u = blockIdx.x; u < T / 64; u += gridDim.x) {
    const int b = u >> 6;
    __syncthreads();
    for (int j = tid; j < 2048; j += 512) {
      float s = a.b_ada[j];
#pragma unroll
      for (int ks = 0; ks < 8; ++ks) s += modp[(ks * 4 + b) * 6144 + j];
      sh[j] = s;
    }
    __syncthreads();
    for (int i = 0; i < 8; ++i) {
      const int r = u * 64 + wv * 8 + i;
      float4 xv[4]; float ssq = 0.f;
#pragma unroll
      for (int j = 0; j < 4; ++j) { xv[j] = *(const float4*)(a.x + (size_t)r * 1024 + j * 256 + lane * 4); ssq += xv[j].x * xv[j].x + xv[j].y * xv[j].y + xv[j].z * xv[j].z + xv[j].w * xv[j].w; }
      ssq = wave_sum(ssq);
      const float rstd = rsqrtf(ssq * (1.f / 1024.f) + EPS);
#pragma unroll
      for (int j = 0; j < 4; ++j) {
        const int col = j * 256 + lane * 4;
        const float4 g = *(const float4*)(a.g_norm1 + col);
        const float h0 = xv[j].x * rstd * g.x * (1.f + sh[1024 + col]) + sh[col];
        const float h1 = xv[j].y * rstd * g.y * (1.f + sh[1024 + col + 1]) + sh[col + 1];
        const float h2 = xv[j].z * rstd * g.z * (1.f + sh[1024 + col + 2]) + sh[col + 2];
        const float h3 = xv[j].w * rstd * g.w * (1.f + sh[1024 + col + 3]) + sh[col + 3];
        uint2 o = {pack2(h0, h1), pack2(h2, h3)};
        *(uint2*)(H + (size_t)r * 1024 + col) = o;
      }
    }
  }
}

constexpr int G_STAGE = 49152;
__device__ __forceinline__ void dma16(const void* gsrc, unsigned lds_dst) {
  unsigned keep;
  asm volatile("s_mov_b32 %0, m0\n\ts_mov_b32 m0, %2\n\ts_nop 0\n\tglobal_load_lds_dwordx4 %1, off\n\ts_mov_b32 m0, %0"
               : "=&s"(keep) : "v"(gsrc), "s"(lds_dst) : "memory");
}
__device__ __forceinline__ void gemm_128x256(const u16* __restrict__ A, int lda, const u16* __restrict__ Bt, int ldb, int KT,
                                             f32x16 (&acc)[2][2], char* lds) {
  const int tid = threadIdx.x, lane = tid & 63, wv = __builtin_amdgcn_readfirstlane(tid >> 6), r32 = lane & 31, hi = lane >> 5;
  const int wm = wv >> 2, wn = wv & 3;
  const int rin = lane >> 3, cc = lane & 7;
  const u16* pa[2]; const u16* pb[4];
#pragma unroll
  for (int j = 0; j < 2; ++j) pa[j] = A + (size_t)(16 * wv + 8 * j + rin) * lda + 8 * (cc ^ (4 * j + (rin >> 1)));
#pragma unroll
  for (int i = 0; i < 4; ++i) pb[i] = Bt + (size_t)(32 * wv + 8 * i + rin) * ldb + 8 * (cc ^ (4 * (i & 1) + (rin >> 1)));
  const unsigned lb = __builtin_amdgcn_readfirstlane((unsigned)(uintptr_t)lds);
  const unsigned dA = lb + 2048 * wv, dB = lb + 16384 + 4096 * wv;
#define G_ISSUE(stage, kt_) do { const unsigned _so = (unsigned)(stage) * G_STAGE; const int _ko = (kt_) * 64;                     \
    dma16(pa[0] + _ko, dA + _so); dma16(pa[1] + _ko, dA + _so + 1024);                                                           \
    dma16(pb[0] + _ko, dB + _so); dma16(pb[1] + _ko, dB + _so + 1024); dma16(pb[2] + _ko, dB + _so + 2048); dma16(pb[3] + _ko, dB + _so + 3072); } while (0)
#pragma unroll
  for (int m = 0; m < 2; ++m)
#pragma unroll
    for (int n = 0; n < 2; ++n)
#pragma unroll
      for (int r = 0; r < 16; ++r) acc[m][n][r] = 0.f;
  __syncthreads();
  G_ISSUE(0, 0);
  if (KT > 1) G_ISSUE(1, 1);
  const int xa = (r32 >> 1) & 7;
  const int aoff = (64 * wm + r32) * 128, boff = 16384 + (64 * wn + r32) * 128;
  int st = 0;
  for (int kt = 0; kt < KT; ++kt) {
    if (kt + 1 < KT) asm volatile("s_waitcnt vmcnt(6)\n\ts_barrier" ::: "memory");
    else             asm volatile("s_waitcnt vmcnt(0)\n\ts_barrier" ::: "memory");
    const int s2 = st == 0 ? 2 : st - 1;
    if (kt + 2 < KT && wv < 4) G_ISSUE(s2, kt + 2);
    const char* buf = lds + st * G_STAGE;
    __builtin_amdgcn_s_setprio(1);
    bf16x8 fa[2][2], fb[2][2];
#define G_LDF(S, SET) do { const int _cb = ((2 * (S) + hi) ^ xa) << 4;                                                      \
      fa[SET][0] = *(const bf16x8*)(buf + aoff + _cb); fa[SET][1] = *(const bf16x8*)(buf + aoff + 4096 + _cb);              \
      fb[SET][0] = *(const bf16x8*)(buf + boff + _cb); fb[SET][1] = *(const bf16x8*)(buf + boff + 4096 + _cb); } while (0)
#define G_MM(SET) do { acc[0][0] = MFMA32(fa[SET][0], fb[SET][0], acc[0][0]); acc[0][1] = MFMA32(fa[SET][0], fb[SET][1], acc[0][1]);   \
      acc[1][0] = MFMA32(fa[SET][1], fb[SET][0], acc[1][0]); acc[1][1] = MFMA32(fa[SET][1], fb[SET][1], acc[1][1]); } while (0)
    G_LDF(0, 0); __builtin_amdgcn_sched_barrier(0);
    G_LDF(1, 1); __builtin_amdgcn_sched_barrier(0); G_MM(0); __builtin_amdgcn_sched_barrier(0);
    G_LDF(2, 0); __builtin_amdgcn_sched_barrier(0); G_MM(1); __builtin_amdgcn_sched_barrier(0);
    G_LDF(3, 1); __builtin_amdgcn_sched_barrier(0); G_MM(0); __builtin_amdgcn_sched_barrier(0);
    G_MM(1);
#undef G_LDF
#undef G_MM
    __builtin_amdgcn_s_setprio(0);
    if (kt + 2 < KT && wv >= 4) G_ISSUE(s2, kt + 2);
    st = st == 2 ? 0 : st + 1;
  }
#undef G_ISSUE
  __syncthreads();
}
constexpr int CLD = 257;
__device__ __forceinline__ void acc_to_lds(const f32x16 (&acc)[2][2], float* Cl) {
  const int lane = threadIdx.x & 63, wv = threadIdx.x >> 6, r32 = lane & 31, hi = lane >> 5, wm = wv >> 2, wn = wv & 3;
#pragma unroll
  for (int m = 0; m < 2; ++m)
#pragma unroll
    for (int n = 0; n < 2; ++n)
#pragma unroll
      for (int r = 0; r < 16; ++r) Cl[(64 * wm + 32 * m + crow(r, hi)) * CLD + 64 * wn + 32 * n + r32] = acc[m][n][r];
}

constexpr int G2_STAGE = 65536;
__device__ __forceinline__ void gemm_256x256_wide(const u16* __restrict__ A, int lda, const u16* __restrict__ Bt, int ldb, int KT, f32x16 (&acc)[8], char* lds) {
  const int tid = threadIdx.x, lane = tid & 63, wv = __builtin_amdgcn_readfirstlane(tid >> 6), r32 = lane & 31, hi = lane >> 5;
  const int rin = lane >> 3, cc = lane & 7;
  const u16* pa[4]; const u16* pb[4];
#pragma unroll
  for (int i = 0; i < 4; ++i) {
    pa[i] = A + (size_t)(32 * wv + 8 * i + rin) * lda + 8 * (cc ^ (4 * (i & 1) + (rin >> 1)));
    pb[i] = Bt + (size_t)(32 * wv + 8 * i + rin) * ldb + 8 * (cc ^ (4 * (i & 1) + (rin >> 1)));
  }
  const unsigned lb = __builtin_amdgcn_readfirstlane((unsigned)(uintptr_t)lds);
  const unsigned dA = lb + 4096 * wv, dB = lb + 32768 + 4096 * wv;
#define G_ISSUE(stage, kt_) do { const unsigned _so = (unsigned)(stage) * G2_STAGE; const int _ko = (kt_) * 64;                    \
    dma16(pa[0] + _ko, dA + _so); dma16(pa[1] + _ko, dA + _so + 1024); dma16(pa[2] + _ko, dA + _so + 2048); dma16(pa[3] + _ko, dA + _so + 3072);   \
    dma16(pb[0] + _ko, dB + _so); dma16(pb[1] + _ko, dB + _so + 1024); dma16(pb[2] + _ko, dB + _so + 2048); dma16(pb[3] + _ko, dB + _so + 3072); } while (0)
#pragma unroll
  for (int m = 0; m < 8; ++m)
#pragma unroll
    for (int r = 0; r < 16; ++r) acc[m][r] = 0.f;
  __syncthreads();
  G_ISSUE(0, 0);
  const int xa = (r32 >> 1) & 7;
  const int aoff = r32 * 128, boff = 32768 + (32 * wv + r32) * 128;
  for (int kt = 0; kt < KT; ++kt) {
    asm volatile("s_waitcnt vmcnt(0)\n\ts_barrier" ::: "memory");
    if (kt + 1 < KT) G_ISSUE((kt + 1) & 1, kt + 1);
    const char* buf = lds + (kt & 1) * G2_STAGE;
    __builtin_amdgcn_s_setprio(1);
    bf16x8 fa[8], fb[4];
#pragma unroll
    for (int s = 0; s < 4; ++s) fb[s] = *(const bf16x8*)(buf + boff + (((2 * s + hi) ^ xa) << 4));
    { const int cb0 = (hi ^ xa) << 4;
#pragma unroll
      for (int m = 0; m < 8; ++m) fa[m] = *(const bf16x8*)(buf + aoff + 4096 * m + cb0); }
#pragma unroll
    for (int s = 0; s < 4; ++s) {
      const int cbn = ((2 * (s + 1) + hi) ^ xa) << 4;
#pragma unroll
      for (int m = 0; m < 8; ++m) { acc[m] = MFMA32(fa[m], fb[s], acc[m]); if (s < 3) fa[m] = *(const bf16x8*)(buf + aoff + 4096 * m + cbn); }
    }
    __builtin_amdgcn_s_setprio(0);
  }
#undef G_ISSUE
  __syncthreads();
}

__device__ __forceinline__ void xcd_unit(int u, int per, int& panel, int& sub) {
  if (gridDim.x == 256) { const int x = u & 7, k = ((u & 255) >> 3) + 32 * (u >> 8); panel = x + 8 * (k / per); sub = k % per; }
  else { panel = u / per; sub = u % per; }
}
__device__ void phase1b(const Args& a, char* lds) {
  unsigned char* ws = a.ws;
  const int tid = threadIdx.x, lane = tid & 63, wv = tid >> 6;
  const u16* KEYS = (const u16*)(ws + WS_KEYS); const u16* WPQB = (const u16*)(ws + WS_WPQ); u16* WST = (u16*)(ws + WS_WST);
  const float* modp = (const float*)(ws + WS_MODP); float* BIASP = (float*)(ws + WS_BIASP);
  char* gl = lds + LDS_DATA; float* Cl = (float*)gl;
  float* gsl = (float*)(gl + 131584);
  for (int u = blockIdx.x; u < 256; u += gridDim.x) {
    const int hh = u >> 4, nt = (u >> 2) & 3, b = u & 3;
    f32x16 acc[2][2];
    gemm_128x256(KEYS + (size_t)hh * 16384, 128, WPQB + (size_t)(nt * 256) * 2048 + hh * 128, 2048, 2, acc, gl);
    acc_to_lds(acc, Cl);
    for (int j = tid; j < 512; j += 512) {
      const int which = j >> 8, k = nt * 256 + (j & 255), m = (which ? 3072 : 4096) + k;
      float v = a.b_ada[m];
#pragma unroll
      for (int ks = 0; ks < 8; ++ks) v += modp[(ks * 4 + b) * 6144 + m];
      gsl[j] = which ? v : a.g_norm2[k] * (1.f + v);
    }
    __syncthreads();
    for (int i = 0; i < 16; ++i) {
      const int row = wv * 16 + i; const size_t n = (size_t)hh * 128 + row;
      float bp = 0.f, w[4];
#pragma unroll
      for (int j = 0; j < 4; ++j) { const float v = Cl[row * CLD + 4 * lane + j]; w[j] = v * gsl[4 * lane + j]; bp += v * gsl[256 + 4 * lane + j]; }
      *(uint2*)(WST + ((size_t)b * 2048 + n) * 1024 + nt * 256 + 4 * lane) = make_uint2(pack2(w[0], w[1]), pack2(w[2], w[3]));
      bp = wave_sum(bp);
      if (lane == 0) BIASP[((size_t)nt * 4 + b) * 2048 + n] = bp;
    }
    __syncthreads();
  }
}

__device__ void phase2(const Args& a, char* lds) {
  unsigned char* ws = a.ws;
  const int tid = threadIdx.x, lane = tid & 63, wv = tid >> 6;
  const u16* H = (const u16*)(ws + WS_H); const u16* WIN = (const u16*)(ws + WS_WIN);
  u16* QA = (u16*)(ws + WS_QA); u16* KV = (u16*)(ws + WS_KV); u16* UACT = (u16*)(ws + WS_UACT); u16* GVT = (u16*)(ws + WS_GVT);
  float* SSQV = (float*)(ws + WS_SSQV); const float* CS = (const float*)(ws + WS_CS);
  char* gl = lds + LDS_DATA; float* Cl = (float*)gl;
  for (int u = blockIdx.x; u < 128 * 6; u += gridDim.x) {
    int mt, nt; xcd_unit(u, 6, mt, nt); const int R0 = mt * 128;
    f32x16 acc[2][2];
    gemm_128x256(H + (size_t)R0 * 1024, 1024, WIN + (size_t)(nt * 256) * 1024, 1024, 16, acc, gl);
    acc_to_lds(acc, Cl);
    __syncthreads();
    if (nt == 0) {
      for (int i = 0; i < 16; ++i) {
        const int row = wv * 16 + i; float v[4], ssq = 0.f;
#pragma unroll
        for (int j = 0; j < 4; ++j) { v[j] = Cl[row * CLD + lane + 64 * j]; ssq += v[j] * v[j]; }
        ssq = wave_sum(ssq);
        const float rstd = rsqrtf(ssq * (1.f / 256.f) + EPS);
#pragma unroll
        for (int j = 0; j < 4; ++j) { const int col = lane + 64 * j; QA[(size_t)(R0 + row) * 256 + col] = f2bf(v[j] * rstd * a.g_q_a[col]); }
      }
    } else if (nt == 1) {
#pragma unroll 4
      for (int i = 0; i < 16; ++i) {
        const int row = wv * 16 + i, tok = R0 + row;
        const float v0 = Cl[row * CLD + lane], v1 = Cl[row * CLD + 64 + lane];
        const float ssq = wave_sum(v0 * v0 + v1 * v1);
        const float rstd = rsqrtf(ssq * (1.f / 128.f) + EPS);
        KV[(size_t)tok * 192 + lane] = f2bf(v0 * rstd * a.g_kv_a[lane]);
        KV[(size_t)tok * 192 + 64 + lane] = f2bf(v1 * rstd * a.g_kv_a[64 + lane]);
        if (lane < 32) {
          const float x1 = Cl[row * CLD + 128 + lane], x2 = Cl[row * CLD + 160 + lane];
          const float cs = CS[(size_t)tok * 64 + lane], sn = CS[(size_t)tok * 64 + 32 + lane];
          KV[(size_t)tok * 192 + 128 + lane] = f2bf(x1 * cs - x2 * sn);
          KV[(size_t)tok * 192 + 160 + lane] = f2bf(x2 * cs + x1 * sn);
        }
      }
    } else if (nt < 4) {
      for (int i = 0; i < 16; ++i) {
        const int row = wv * 16 + i;
#pragma unroll
        for (int j = 0; j < 4; ++j) { const int col = lane + 64 * j; UACT[(size_t)(R0 + row) * 512 + (nt - 2) * 256 + col] = f2bf(gelu_exact(Cl[row * CLD + col])); }
      }
    } else {
      for (int i = 0; i < 16; ++i) {
        const int row = wv * 16 + i; float ssq = 0.f;
#pragma unroll
        for (int j = 0; j < 4; ++j) { const int col = lane + 64 * j; const float g = gelu_exact(Cl[row * CLD + col]); const float gb = bflo((unsigned)f2bf(g)); ssq += gb * gb; Cl[row * CLD + col] = gb; }
        ssq = wave_sum(ssq);
        if (lane == 0) SSQV[(size_t)(R0 + row) * 2 + (nt - 4)] = ssq;
      }
      __syncthreads();
      for (int i = 0; i < 32; ++i) {
        const int c = wv * 32 + i;
        const float g0 = Cl[(2 * lane) * CLD + c], g1 = Cl[(2 * lane + 1) * CLD + c];
        *(unsigned*)(GVT + ((size_t)mt * 512 + (nt - 4) * 256 + c) * 128 + 2 * lane) = pack2(g0, g1);
      }
    }
    __syncthreads();
  }
}

__device__ void phase3(const Args& a, char* lds) {
  unsigned char* ws = a.ws;
  const int tid = threadIdx.x, lane = tid & 63, wv = tid >> 6, r32 = lane & 31, hi = lane >> 5;
  const u16* QA = (const u16*)(ws + WS_QA); const u16* WQ2 = (const u16*)(ws + WS_WQ2);
  u16* Q = (u16*)(ws + WS_Q); const float* CS = (const float*)(ws + WS_CS);
  const u16* UACT = (const u16*)(ws + WS_UACT); const u16* GVT = (const u16*)(ws + WS_GVT); const u16* WSG = (const u16*)(ws + WS_WSG);
  const float* SSQV = (const float*)(ws + WS_SSQV); u16* Y = (u16*)(ws + WS_Y);
  char* gl = lds + LDS_DATA; float* Cl = (float*)gl;
  for (int u = blockIdx.x; u < 384; u += gridDim.x) {
    {
      int mt, nt; xcd_unit(u, 3, mt, nt); const int R0 = mt * 128;
      f32x16 acc[2][2];
      gemm_128x256(QA + (size_t)R0 * 256, 256, WQ2 + (size_t)(nt * 256) * 256, 256, 4, acc, gl);
      acc_to_lds(acc, Cl);
      __syncthreads();
      if (nt < 2) {
        for (int i = 0; i < 16; ++i) {
          const int row = wv * 16 + i;
#pragma unroll
          for (int j = 0; j < 4; ++j) { const int n = nt * 256 + lane + 64 * j; Q[(size_t)(R0 + row) * 768 + (n >> 7) * 192 + (n & 127)] = f2bf(Cl[row * CLD + lane + 64 * j]); }
        }
      } else {
#pragma unroll 4
        for (int i = 0; i < 16; ++i) {
          const int row = wv * 16 + i, tok = R0 + row;
#pragma unroll
          for (int j = 0; j < 2; ++j) {
            const int idx = lane + 64 * j, h = idx >> 5, jj = idx & 31;
            const float x1 = Cl[row * CLD + h * 64 + jj], x2 = Cl[row * CLD + h * 64 + 32 + jj];
            const float cs = CS[(size_t)tok * 64 + jj], sn = CS[(size_t)tok * 64 + 32 + jj];
            Q[(size_t)tok * 768 + h * 192 + 128 + jj] = f2bf(x1 * cs - x2 * sn);
            Q[(size_t)tok * 768 + h * 192 + 160 + jj] = f2bf(x2 * cs + x1 * sn);
          }
        }
      }
      __syncthreads();
    }
  }
  for (int su = blockIdx.x; su < 256; su += gridDim.x) {
    {
      const int c = su >> 1, ph = su & 1;
      float* rs = (float*)gl;
      float* Yl = (float*)(gl + 512);
      __syncthreads();
      if (tid < 128) { const size_t t = (size_t)c * 128 + tid; rs[tid] = rsqrtf((SSQV[t * 2] + SSQV[t * 2 + 1]) * (1.f / 512.f) + EPS); }
      __syncthreads();
      const int h = wv >> 1, dh = wv & 1;
      f32x16 acc[2][2];
#pragma unroll
      for (int m = 0; m < 2; ++m)
#pragma unroll
        for (int n = 0; n < 2; ++n)
#pragma unroll
          for (int r = 0; r < 16; ++r) acc[m][n][r] = 0.f;
      for (int s = 0; s < 8; ++s) {
        const int q0 = 16 * s + 8 * hi;
        bf16x8 af[2], bfr[2];
#pragma unroll
        for (int m = 0; m < 2; ++m) af[m] = *(const bf16x8*)(WSG + ((size_t)h * 128 + ph * 64 + 32 * m + r32) * 128 + q0);
        float rq[8];
#pragma unroll
        for (int j = 0; j < 8; ++j) rq[j] = rs[q0 + j];
#pragma unroll
        for (int n = 0; n < 2; ++n) {
          const u32x4 w = *(const u32x4*)(GVT + ((size_t)c * 512 + h * 128 + dh * 64 + 32 * n + r32) * 128 + q0);
          u32x4 o;
#pragma unroll
          for (int k = 0; k < 4; ++k) o[k] = pack2(bflo(w[k]) * rq[2 * k], bfhi(w[k]) * rq[2 * k + 1]);
          bfr[n] = __builtin_bit_cast(bf16x8, o);
        }
#pragma unroll
        for (int m = 0; m < 2; ++m)
#pragma unroll
          for (int n = 0; n < 2; ++n) acc[m][n] = MFMA32(af[m], bfr[n], acc[m][n]);
      }
#pragma unroll
      for (int m = 0; m < 2; ++m)
#pragma unroll
        for (int n = 0; n < 2; ++n)
#pragma unroll
          for (int r = 0; r < 16; ++r) {
            const int pl = 32 * m + crow(r, hi), col = h * 128 + dh * 64 + 32 * n + r32;
            const size_t tok = (size_t)c * 128 + ph * 64 + pl;
            const float mix = acc[m][n][r] * a.g_sg[col] + a.b_sg[h * 128 + ph * 64 + pl];
            Yl[pl * 513 + col] = bflo((unsigned)UACT[tok * 512 + col]) * mix;
          }
      __syncthreads();
      for (int i = 0; i < 8; ++i) {
        const int pl = wv * 8 + i; const size_t tok = (size_t)c * 128 + ph * 64 + pl;
        float v[8], ssq = 0.f;
#pragma unroll
        for (int j = 0; j < 8; ++j) { v[j] = Yl[pl * 513 + lane + 64 * j]; ssq += v[j] * v[j]; }
        ssq = wave_sum(ssq);
        const float rstd = rsqrtf(ssq * (1.f / 512.f) + EPS);
#pragma unroll
        for (int j = 0; j < 8; ++j) { const int col = lane + 64 * j; Y[tok * 1024 + 512 + col] = f2bf(v[j] * rstd * a.g_sg_out[col]); }
      }
      __syncthreads();
    }
  }
}

constexpr float ATT_SCALE = 0.07216878364870322f;
constexpr float ATT_THR = 8.f;
constexpr int KVBUF = 24576;
#define SBAR() __builtin_amdgcn_sched_barrier(0)
__device__ __forceinline__ unsigned cvtpk(float lo, float hi) { unsigned r; asm volatile("v_cvt_pk_bf16_f32 %0, %1, %2" : "=v"(r) : "v"(lo), "v"(hi)); return r; }
__device__ __forceinline__ unsigned off_a(unsigned row, unsigned ch) { return 2048u * (row >> 3) + 512u * (ch >> 2) + 64u * (row & 7) + 16u * ((ch & 3) ^ ((row >> 2) & 3)); }

__device__ __forceinline__ void partialSM(f32x16& p0, f32x16& p1, float& m_reg, float& mn, float& alpha) {
  constexpr float C = ATT_SCALE * 1.4426950408889634f;
  float pmax = p0[0];
#pragma unroll
  for (int r = 1; r < 16; ++r) pmax = fmaxf(pmax, p0[r]);
#pragma unroll
  for (int r = 0; r < 16; ++r) pmax = fmaxf(pmax, p1[r]);
  { auto rr = __builtin_amdgcn_permlane32_swap(__float_as_uint(pmax), __float_as_uint(pmax), false, false);
    pmax = fmaxf(__uint_as_float(rr[0]), __uint_as_float(rr[1])); }
  if (__builtin_expect(__all(pmax - m_reg <= ATT_THR / ATT_SCALE), 1)) { mn = m_reg; alpha = 1.f; }
  else { mn = fmaxf(m_reg, pmax); alpha = __builtin_amdgcn_exp2f((m_reg - mn) * C); m_reg = mn; }
  const float mnC = -mn * C;
#pragma unroll
  for (int r = 0; r < 16; ++r) p0[r] = fmaf(p0[r], C, mnC);
#pragma unroll
  for (int r = 0; r < 16; ++r) p1[r] = fmaf(p1[r], C, mnC);
#pragma unroll
  for (int r = 0; r < 16; ++r) p0[r] = __builtin_amdgcn_exp2f(p0[r]);
}
__device__ __forceinline__ void finishSM(f32x16& p0, f32x16& p1, float alpha, float& l_reg, bf16x8& pa0, bf16x8& pa1, bf16x8& pa2, bf16x8& pa3) {
#pragma unroll
  for (int r = 0; r < 16; ++r) p1[r] = __builtin_amdgcn_exp2f(p1[r]);
  float ps = 0;
#pragma unroll
  for (int r = 0; r < 16; ++r) ps += p0[r];
#pragma unroll
  for (int r = 0; r < 16; ++r) ps += p1[r];
  { auto rr = __builtin_amdgcn_permlane32_swap(__float_as_uint(ps), __float_as_uint(ps), false, false);
    ps = __uint_as_float(rr[0]) + __uint_as_float(rr[1]); }
  l_reg = l_reg * alpha + ps;
#define PK4(P, BASE, OUT) do { unsigned a0 = cvtpk(P[BASE + 0], P[BASE + 1]), a1 = cvtpk(P[BASE + 2], P[BASE + 3]);   \
    unsigned b0 = cvtpk(P[BASE + 4], P[BASE + 5]), b1 = cvtpk(P[BASE + 6], P[BASE + 7]);                              \
    auto r0 = __builtin_amdgcn_permlane32_swap(a0, b0, false, false); auto r1 = __builtin_amdgcn_permlane32_swap(a1, b1, false, false); \
    u32x4 w = {r0[0], r1[0], r0[1], r1[1]}; OUT = __builtin_bit_cast(bf16x8, w); } while (0)
  PK4(p0, 0, pa0); PK4(p0, 8, pa1); PK4(p1, 0, pa2); PK4(p1, 8, pa3);
#undef PK4
}
__device__ __forceinline__ void qkt192(f32x16& p0, f32x16& p1, const char* kb, const bf16x8* qr, int ke, int ko, int kr) {
#pragma unroll
  for (int r = 0; r < 16; ++r) { p0[r] = 0.f; p1[r] = 0.f; }
#pragma unroll
  for (int d0 = 0; d0 < 8; ++d0) {
    const int o = ((d0 & 1) ? ko : ke) + 512 * (d0 >> 1);
    const bf16x8 b0 = *(const bf16x8*)(kb + o), b1 = *(const bf16x8*)(kb + o + 8192);
    p0 = MFMA32(b0, qr[d0], p0); p1 = MFMA32(b1, qr[d0], p1);
  }
#pragma unroll
  for (int d1 = 0; d1 < 4; ++d1) {
    const int o = 16384 + (kr ^ (32 * d1));
    const bf16x8 b0 = *(const bf16x8*)(kb + o), b1 = *(const bf16x8*)(kb + o + 4096);
    p0 = MFMA32(b0, qr[8 + d1], p0); p1 = MFMA32(b1, qr[8 + d1], p1);
  }
}
template <int OFF> __device__ __forceinline__ s16x4 tr_read(int vb) {
  s16x4 r; asm volatile("ds_read_b64_tr_b16 %0, %1 offset:%2" : "=&v"(r) : "v"(vb), "i"(OFF) : "memory"); return r;
}
template <int C> __device__ __forceinline__ void pv_one(f32x16& od, int vb0, int vb1, bf16x8 pa0, bf16x8 pa1, bf16x8 pa2, bf16x8 pa3) {
  const s16x4 l0 = tr_read<512 * C>(vb0), h0 = tr_read<512 * C>(vb1), l1 = tr_read<4096 + 512 * C>(vb0), h1 = tr_read<4096 + 512 * C>(vb1);
  const s16x4 l2 = tr_read<8192 + 512 * C>(vb0), h2 = tr_read<8192 + 512 * C>(vb1), l3 = tr_read<12288 + 512 * C>(vb0), h3 = tr_read<12288 + 512 * C>(vb1);
  asm volatile("s_waitcnt lgkmcnt(0)" ::: "memory"); SBAR();
#define PKV(L, H) (bf16x8){L[0], L[1], L[2], L[3], H[0], H[1], H[2], H[3]}
  od = MFMA32(pa0, PKV(l0, h0), od); od = MFMA32(pa1, PKV(l1, h1), od);
  od = MFMA32(pa2, PKV(l2, h2), od); od = MFMA32(pa3, PKV(l3, h3), od);
#undef PKV
}
__device__ __forceinline__ void pv_all(f32x16* o, int vb0, int vb1, bf16x8 pa0, bf16x8 pa1, bf16x8 pa2, bf16x8 pa3) {
  pv_one<0>(o[0], vb0, vb1, pa0, pa1, pa2, pa3); pv_one<1>(o[1], vb0, vb1, pa0, pa1, pa2, pa3);
  pv_one<2>(o[2], vb0, vb1, pa0, pa1, pa2, pa3); pv_one<3>(o[3], vb0, vb1, pa0, pa1, pa2, pa3);
}

__device__ void phase4(const Args& a, char* lds) {
  unsigned char* ws = a.ws;
  const int tid = threadIdx.x, wid = tid >> 6, lane = tid & 63, r32 = lane & 31, hi = lane >> 5;
  const u16* Qg = (const u16*)(ws + WS_Q); const u16* KVg = (const u16*)(ws + WS_KV); const u16* WUV = (const u16*)(ws + WS_WUV);
  u16* Y = (u16*)(ws + WS_Y);
  char* gl = lds + LDS_DATA;
  char* kvl = gl;
  float* wsl = (float*)(gl + 2 * KVBUF) + wid * 64; float* li_l = wsl; float* al_l = wsl + 32;
  char* Ol = gl + 2 * KVBUF + 2048 + wid * 8704;
  float* Yl = (float*)gl;
  const int head = wid >> 1, qh = wid & 1;
  int sdst[3];
#pragma unroll
  for (int j = 0; j < 3; ++j) { const int id = tid + 512 * j, key = id / 24, ch = id % 24;
    sdst[j] = ch < 16 ? (int)off_a(key, ch) : 16384 + key * 128 + (((ch - 16) ^ ((key >> 1) & 7)) << 4); }
  const int xq = (r32 >> 2) & 3;
  const int ke = 2048 * (r32 >> 3) + 64 * (r32 & 7) + 16 * (hi ^ xq), ko = 2048 * (r32 >> 3) + 64 * (r32 & 7) + 16 * ((2 + hi) ^ xq);
  const int kr = r32 * 128 + ((hi ^ ((r32 >> 1) & 7)) << 4);
  const int tb = lane >> 4 & 1, tq = (lane & 15) >> 2, tp = lane & 3;
  const int vbl = 2048 * hi + 64 * tq + 32 * (tb ^ hi) + 8 * (tp & 1);
  const int lbase = (int)(uintptr_t)kvl;
  const int vb0 = lbase + vbl + 16 * (tp >> 1), vb1 = lbase + vbl + 256 + 16 * ((tp >> 1) ^ 1);
  for (int u = blockIdx.x; u < 256; u += gridDim.x) {
    const int b = u >> 6, qb = u & 63;
    const size_t tok0 = (size_t)b * SEQ + qb * 64 + qh * 32;
    const u16* KVb = KVg + (size_t)b * SEQ * 192;
    float m_reg = -1e30f, l_reg = 0.f; f32x16 o[4]; bf16x8 qr[12];
#pragma unroll
    for (int d = 0; d < 4; ++d)
#pragma unroll
      for (int r = 0; r < 16; ++r) o[d][r] = 0.f;
    { const u16* Qw = Qg + (tok0 + r32) * 768 + head * 192 + hi * 8;
#pragma unroll
      for (int d0 = 0; d0 < 12; ++d0) qr[d0] = *(const bf16x8*)(Qw + d0 * 16); }
    u32x4 st0[3];
#define SLOAD(S, k0) do { const u16* _p = KVb + (size_t)(k0) * 192 + tid * 8; S[0] = *(const u32x4*)_p; S[1] = *(const u32x4*)(_p + 4096); S[2] = *(const u32x4*)(_p + 8192); } while (0)
#define SWRITE(bufi, S) do { char* _d = kvl + (bufi) * KVBUF; *(u32x4*)(_d + sdst[0]) = S[0]; *(u32x4*)(_d + sdst[1]) = S[1]; *(u32x4*)(_d + sdst[2]) = S[2]; } while (0)
#define RESC(al) do { if (__any((al) < 1.f)) { if (hi == 0) al_l[r32] = (al); asm volatile("s_waitcnt lgkmcnt(0)" ::: "memory"); \
    _Pragma("unroll") for (int d = 0; d < 4; ++d) _Pragma("unroll") for (int r = 0; r < 16; ++r) o[d][r] *= al_l[crow(r, hi)]; } } while (0)
    constexpr int NT = SEQ / 64;
    __syncthreads();
    SLOAD(st0, 0); SWRITE(0, st0); SLOAD(st0, 64); __syncthreads();
    for (int j = 0; j < NT; ++j) {
      const int bo = (j & 1) * KVBUF;
      f32x16 p0, p1; float mn, al; bf16x8 pa0, pa1, pa2, pa3;
      qkt192(p0, p1, kvl + bo, qr, ke, ko, kr);
      partialSM(p0, p1, m_reg, mn, al);
      RESC(al);
      finishSM(p0, p1, al, l_reg, pa0, pa1, pa2, pa3);
      if (j + 1 < NT) { SWRITE((j + 1) & 1, st0); if (j + 2 < NT) SLOAD(st0, (j + 2) * 64); }
      const unsigned cit = ((unsigned)(u * 64 + j) << 9) | (unsigned)tid;
      const bool cisv = cit >= 4194304u; const unsigned cio = cisv ? cit - 4194304u : cit;
      const float4 cf = *(const float4*)((cisv ? a.peer_v : a.peer_u) + (size_t)cio * 4);
      SBAR();
      pv_all(o, vb0 + bo, vb1 + bo, pa0, pa1, pa2, pa3);
      { const float csc = cisv ? PEER_SV : PEER_SU;
        int cp = __builtin_amdgcn_cvt_pk_fp8_f32(cf.x * csc, cf.y * csc, 0, false); cp = __builtin_amdgcn_cvt_pk_fp8_f32(cf.z * csc, cf.w * csc, cp, true);
        *(int*)(ws + (cisv ? WS_VB : WS_UB) + (size_t)cio * 4) = cp; }
      __syncthreads();
    }
#undef SLOAD
#undef SWRITE
#undef RESC
    int r32e = r32, hie = hi, lne = lane;
    asm volatile("" : "+v"(r32e), "+v"(hie), "+v"(lne));
    if (hie == 0) li_l[r32e] = l_reg;
    asm volatile("s_waitcnt lgkmcnt(0)" ::: "memory");
#pragma unroll
    for (int r = 0; r < 16; ++r) {
      const int q = crow(r, hie); const float rl = __builtin_amdgcn_rcpf(li_l[q]);
#pragma unroll
      for (int d = 0; d < 4; ++d) *(u16*)(Ol + q * 272 + (32 * d + r32e) * 2) = f2bf(o[d][r] * rl);
    }
    asm volatile("s_waitcnt lgkmcnt(0)" ::: "memory");
    f32x16 y[4];
#pragma unroll
    for (int n = 0; n < 4; ++n)
#pragma unroll
      for (int r = 0; r < 16; ++r) y[n][r] = 0.f;
    const u16* wuv = WUV + ((size_t)head * 128 + r32e) * 128 + 8 * hie;
#pragma unroll 2
    for (int s = 0; s < 8; ++s) {
      const bf16x8 af = *(const bf16x8*)(Ol + r32e * 272 + (16 * s + 8 * hie) * 2);
#pragma unroll
      for (int n = 0; n < 4; ++n) {
        const bf16x8 bw = *(const bf16x8*)(wuv + 32 * n * 128 + 16 * s);
        y[n] = MFMA32(af, bw, y[n]);
      }
    }
    __syncthreads();
#pragma unroll
    for (int n = 0; n < 4; ++n)
#pragma unroll
      for (int r = 0; r < 16; ++r) Yl[(qh * 32 + crow(r, hie)) * 513 + head * 128 + 32 * n + r32e] = y[n][r];
    __syncthreads();
    for (int i = 0; i < 8; ++i) {
      const int pl = wid * 8 + i; const size_t tok = (size_t)b * SEQ + qb * 64 + pl;
      float v[8], ssq = 0.f;
#pragma unroll
      for (int jj = 0; jj < 8; ++jj) { v[jj] = Yl[pl * 513 + lne + 64 * jj]; ssq += v[jj] * v[jj]; }
      ssq = wave_sum(ssq);
      const float rstd = rsqrtf(ssq * (1.f / 512.f) + EPS);
#pragma unroll
      for (int jj = 0; jj < 8; ++jj) { const int col = lne + 64 * jj; Y[tok * 1024 + col] = f2bf(v[jj] * rstd * a.g_attn_out[col]); }
    }
    __syncthreads();
  }
}

__device__ void phase5(const Args& a, char* lds) {
  unsigned char* ws = a.ws;
  const int tid = threadIdx.x, lane = tid & 63, wv = tid >> 6;
  const u16* Y = (const u16*)(ws + WS_Y); const u16* WO = (const u16*)(ws + WS_WO);
  float* X1 = (float*)(ws + WS_X1); float* SSQ = (float*)(ws + WS_SSQ); const float* mod = (const float*)(ws + WS_MOD);
  u16* X1B = (u16*)(ws + WS_H);
  char* gl = lds + LDS_DATA; float* Cl = (float*)gl;
  for (int u = blockIdx.x; u < 128 * 4; u += gridDim.x) {
    int mt, nt; xcd_unit(u, 4, mt, nt); const int R0 = mt * 128, b = R0 >> 12;
    f32x16 acc[2][2];
    gemm_128x256(Y + (size_t)R0 * 1024, 1024, WO + (size_t)(nt * 256) * 1024, 1024, 16, acc, gl);
    acc_to_lds(acc, Cl);
    __syncthreads();
    float2 g1[2];
#pragma unroll
    for (int j = 0; j < 2; ++j) g1[j] = *(const float2*)(mod + b * 6144 + 2048 + nt * 256 + 2 * lane + 128 * j);
    for (int i0 = 0; i0 < 16; i0 += 8) {
      float2 xv[8][2];
#pragma unroll
      for (int i = 0; i < 8; ++i)
#pragma unroll
        for (int j = 0; j < 2; ++j) xv[i][j] = *(const float2*)(a.x + (size_t)(R0 + wv * 16 + i0 + i) * 1024 + nt * 256 + 2 * lane + 128 * j);
#pragma unroll
      for (int i = 0; i < 8; ++i) {
        const int row = wv * 16 + i0 + i; const size_t tok = R0 + row; float ssq = 0.f;
#pragma unroll
        for (int j = 0; j < 2; ++j) {
          const int col = nt * 256 + 2 * lane + 128 * j;
          const float v0 = xv[i][j].x + g1[j].x * Cl[row * CLD + 2 * lane + 128 * j], v1 = xv[i][j].y + g1[j].y * Cl[row * CLD + 2 * lane + 128 * j + 1];
          *(unsigned*)(X1B + tok * 1024 + col) = pack2(v0, v1); ssq += v0 * v0 + v1 * v1;
        }
        ssq = wave_sum(ssq);
        if (lane == 0) SSQ[tok * 4 + nt] = ssq;
      }
    }
    __syncthreads();
  }
}
__device__ __forceinline__ float vmaxf(float a, float b) { float r; asm("v_max_f32 %0, %1, %2" : "=v"(r) : "v"(a), "v"(b)); return r; }
__device__ __forceinline__ float vminf(float a, float b) { float r; asm("v_min_f32 %0, %1, %2" : "=v"(r) : "v"(a), "v"(b)); return r; }
#define TK_CE(x, y) do { const float _h = vmaxf((x), (y)); (y) = vminf((x), (y)); (x) = _h; } while (0)
#define TK_SORT16(t) do { TK_CE(t[0], t[1]); TK_CE(t[2], t[3]); TK_CE(t[0], t[2]); TK_CE(t[1], t[3]); TK_CE(t[1], t[2]); TK_CE(t[4], t[5]); TK_CE(t[6], t[7]); TK_CE(t[4], t[6]); TK_CE(t[5], t[7]); TK_CE(t[5], t[6]); TK_CE(t[0], t[4]); TK_CE(t[2], t[6]); TK_CE(t[2], t[4]); TK_CE(t[1], t[5]); TK_CE(t[3], t[7]); TK_CE(t[3], t[5]); TK_CE(t[1], t[2]); TK_CE(t[3], t[4]); TK_CE(t[5], t[6]); TK_CE(t[8], t[9]); TK_CE(t[10], t[11]); TK_CE(t[8], t[10]); TK_CE(t[9], t[11]); TK_CE(t[9], t[10]); TK_CE(t[12], t[13]); TK_CE(t[14], t[15]); TK_CE(t[12], t[14]); TK_CE(t[13], t[15]); TK_CE(t[13], t[14]); TK_CE(t[8], t[12]); TK_CE(t[10], t[14]); TK_CE(t[10], t[12]); TK_CE(t[9], t[13]); TK_CE(t[11], t[15]); TK_CE(t[11], t[13]); TK_CE(t[9], t[10]); TK_CE(t[11], t[12]); TK_CE(t[13], t[14]); TK_CE(t[0], t[8]); TK_CE(t[4], t[12]); TK_CE(t[4], t[8]); TK_CE(t[2], t[10]); TK_CE(t[6], t[14]); TK_CE(t[6], t[10]); TK_CE(t[2], t[4]); TK_CE(t[6], t[8]); TK_CE(t[10], t[12]); TK_CE(t[1], t[9]); TK_CE(t[5], t[13]); TK_CE(t[5], t[9]); TK_CE(t[3], t[11]); TK_CE(t[7], t[15]); TK_CE(t[7], t[11]); TK_CE(t[3], t[5]); TK_CE(t[7], t[9]); TK_CE(t[11], t[13]); TK_CE(t[1], t[2]); TK_CE(t[3], t[4]); TK_CE(t[5], t[6]); TK_CE(t[7], t[8]); TK_CE(t[9], t[10]); TK_CE(t[11], t[12]); TK_CE(t[13], t[14]); } while (0)
#define TK_BMERGE16(t) do { TK_CE(t[0], t[8]); TK_CE(t[1], t[9]); TK_CE(t[2], t[10]); TK_CE(t[3], t[11]); TK_CE(t[4], t[12]); TK_CE(t[5], t[13]); TK_CE(t[6], t[14]); TK_CE(t[7], t[15]); TK_CE(t[0], t[4]); TK_CE(t[1], t[5]); TK_CE(t[2], t[6]); TK_CE(t[3], t[7]); TK_CE(t[8], t[12]); TK_CE(t[9], t[13]); TK_CE(t[10], t[14]); TK_CE(t[11], t[15]); TK_CE(t[0], t[2]); TK_CE(t[1], t[3]); TK_CE(t[4], t[6]); TK_CE(t[5], t[7]); TK_CE(t[8], t[10]); TK_CE(t[9], t[11]); TK_CE(t[12], t[14]); TK_CE(t[13], t[15]); TK_CE(t[0], t[1]); TK_CE(t[2], t[3]); TK_CE(t[4], t[5]); TK_CE(t[6], t[7]); TK_CE(t[8], t[9]); TK_CE(t[10], t[11]); TK_CE(t[12], t[13]); TK_CE(t[14], t[15]); } while (0)
#define TK_MERGE(A, B) do { _Pragma("unroll") for (int _i = 0; _i < 16; ++_i) A[_i] = vmaxf(A[_i], B[15 - _i]); TK_BMERGE16(A); } while (0)
__constant__ unsigned long long TK_I[4] = {0x0000000000000000ull, 0x0007744411111111ull, 0x0006655333322222ull, 0x00000000FEDCBA98ull};
__constant__ unsigned long long TK_J[4] = {0xFEDCBA9876543210ull, 0x0001021076543210ull, 0x0001010321043210ull, 0x0000000000000000ull};
__constant__ int TK_N[4] = {16, 13, 13, 8};

__device__ void phase6(const Args& a, char* lds) {
  unsigned char* ws = a.ws;
  const int tid = threadIdx.x, lane = tid & 63, wv = tid >> 6, r32 = lane & 31, hi = lane >> 5;
  const u16* H = (const u16*)(ws + WS_H); const u16* WST = (const u16*)(ws + WS_WST);
  float* TOPS = (float*)(ws + WS_TOPK);
  const float* BIASP = (const float*)(ws + WS_BIASP); const float* SSQ = (const float*)(ws + WS_SSQ);
  char* gl = lds + LDS_DATA;
  for (int u = blockIdx.x; u < 8 * 64; u += gridDim.x) {
    int tb, hd; xcd_unit(u, 8, tb, hd);
    const int b = tb >> 4;
    f32x16 sc[8];
    gemm_256x256_wide(WST + ((size_t)b * 2048 + hd * 256) * 1024, 1024, H + (size_t)tb * 256 * 1024, 1024, 16, sc, gl);
    float* bl = (float*)gl;
    if (tid < 256) bl[tid] = BIASP[((size_t)0 * 4 + b) * 2048 + hd * 256 + tid] + BIASP[((size_t)1 * 4 + b) * 2048 + hd * 256 + tid]
                           + BIASP[((size_t)2 * 4 + b) * 2048 + hd * 256 + tid] + BIASP[((size_t)3 * 4 + b) * 2048 + hd * 256 + tid];
    const float4 sq = *(const float4*)(SSQ + (size_t)(tb * 256 + 32 * wv + r32) * 4);
    const float rstd = rsqrtf((sq.x + sq.y + sq.z + sq.w) * (1.f / 1024.f) + EPS);
    __syncthreads();
#pragma unroll
    for (int half = 0; half < 2; ++half) {
      float g0[16], g1[16], g2[16], g3[16], p[16];
#pragma unroll
      for (int r = 0; r < 16; ++r) {
        const unsigned key = crow(r, hi);
        g0[r] = __uint_as_float((__float_as_uint(fmaf(sc[4 * half + 0][r], rstd, bl[128 * half + key])) & ~127u) | key);
        g1[r] = __uint_as_float((__float_as_uint(fmaf(sc[4 * half + 1][r], rstd, bl[128 * half + 32 + key])) & ~127u) | (32u + key));
        g2[r] = __uint_as_float((__float_as_uint(fmaf(sc[4 * half + 2][r], rstd, bl[128 * half + 64 + key])) & ~127u) | (64u + key));
        g3[r] = __uint_as_float((__float_as_uint(fmaf(sc[4 * half + 3][r], rstd, bl[128 * half + 96 + key])) & ~127u) | (96u + key));
      }
      TK_SORT16(g0); TK_SORT16(g1); TK_SORT16(g2); TK_SORT16(g3);
      TK_MERGE(g0, g1); TK_MERGE(g2, g3); TK_MERGE(g0, g2);
#pragma unroll
      for (int i = 0; i < 16; ++i) {
        auto rr = __builtin_amdgcn_permlane32_swap(__float_as_uint(g0[i]), __float_as_uint(g0[i]), false, false);
        p[i] = __uint_as_float(hi ? rr[0] : rr[1]);
      }
      TK_MERGE(g0, p);
      if (hi == 0) {
        float* dst = TOPS + ((size_t)(tb * 256 + 32 * wv + r32) * 16 + 2 * hd + half) * 16;
#pragma unroll
        for (int i = 0; i < 16; i += 4) *(float4*)(dst + i) = make_float4(g0[i], g0[i + 1], g0[i + 2], g0[i + 3]);
      }
    }
  }
}

typedef __attribute__((ext_vector_type(4))) float f32x4;
#define MFMA4(a, b, c) __builtin_amdgcn_mfma_f32_4x4x4bf16_1k((a), (b), (c), 0, 0, 0)
constexpr int P7_VROW = 2112, P7_VBUF = 4 * P7_VROW;
constexpr int P7_RING = 64;
constexpr int P7_ENT  = P7_RING + 8 * 2 * P7_VBUF;
constexpr int P7_CNT  = P7_ENT + 8 * 2048;
static_assert(P7_CNT + 8 * 256 <= LDS_BYTES, "phase 7 LDS map");
__device__ __forceinline__ float sel4(const f32x4& d, int k) { return k == 0 ? d[0] : (k == 1 ? d[1] : (k == 2 ? d[2] : d[3])); }
__device__ __forceinline__ unsigned fp8x2_bf16(unsigned x, float sc, bool hi) {
  return hi ? __builtin_bit_cast(unsigned, __builtin_amdgcn_cvt_scalef32_pk_bf16_fp8(x, sc, true)) : __builtin_bit_cast(unsigned, __builtin_amdgcn_cvt_scalef32_pk_bf16_fp8(x, sc, false));
}

__device__ void phase7(const Args& a, char* lds) {
  unsigned char* ws = a.ws;
  const int tid = threadIdx.x, lane = tid & 63, wv = __builtin_amdgcn_readfirstlane(tid >> 6), blk = lane >> 2, j4 = lane & 3;
  const u16* H = (const u16*)(ws + WS_H); const unsigned char* U8 = ws + WS_UB; const unsigned char* V8 = ws + WS_VB;
  const float* TOPS = (const float*)(ws + WS_TOPK); const float* X1 = (const float*)(ws + WS_X1); const float* mod = (const float*)(ws + WS_MOD);
  const float* SSQ = (const float*)(ws + WS_SSQ);
  const unsigned lbase = (unsigned)(uintptr_t)lds;
  char* ring = lds + P7_RING + wv * 2 * P7_VBUF;
  unsigned* ents = (unsigned*)(lds + P7_ENT + wv * 2048);
  int* cntw = (int*)(lds + P7_CNT + wv * 256);
  const int trb = (int)(lbase + P7_RING + wv * 2 * P7_VBUF) + ((lane & 15) >> 2) * P7_VROW + 32 * (lane >> 4) + 8 * (lane & 3);
  const int NWV = gridDim.x * 8;
  for (int qd = blockIdx.x * 8 + wv; qd < T / 4; qd += NWV) {
    const int tok0 = qd * 4, b = tok0 >> 12;
    float* TS = (float*)ring;
#pragma unroll
    for (int i = 0; i < 4; ++i) *(float4*)(TS + 256 * i + 4 * lane) = *(const float4*)(TOPS + (size_t)tok0 * 256 + 256 * i + 4 * lane);
    cntw[lane] = 0;
    asm volatile("s_waitcnt lgkmcnt(0)" ::: "memory");
    unsigned ec[8];
#pragma unroll
    for (int rd = 0; rd < 2; ++rd) {
      const int combo = (lane >> 2) + 16 * rd, tl = combo >> 3, hd = combo & 7, q = lane & 3;
      const float* t1 = TS + (tl * 16 + hd * 2) * 16; const float* t2 = t1 + 16;
      const unsigned long long ip = TK_I[q], jp = TK_J[q]; const int cn = TK_N[q];
      float L[16], P[16];
#pragma unroll
      for (int c = 0; c < 16; ++c) {
        const unsigned i = (unsigned)(ip >> (4 * c)) & 15u, j = (unsigned)(jp >> (4 * c)) & 15u;
        const float sm = t1[i] + t2[j];
        L[c] = c < cn ? __uint_as_float((__float_as_uint(sm) & ~255u) | (i << 4) | j) : -3.0e38f;
      }
      TK_SORT16(L);
#pragma unroll
      for (int c = 0; c < 16; ++c) P[c] = __uint_as_float(__builtin_amdgcn_update_dpp(0, __float_as_uint(L[c]), 0xB1, 0xf, 0xf, false));
      TK_MERGE(L, P);
#pragma unroll
      for (int c = 0; c < 16; ++c) P[c] = __uint_as_float(__builtin_amdgcn_update_dpp(0, __float_as_uint(L[c]), 0x4E, 0xf, 0xf, false));
      TK_MERGE(L, P);
      float sum = 0.f;
      const float m0 = __uint_as_float(__float_as_uint(L[0]) & ~255u);
#pragma unroll
      for (int c = 0; c < 16; ++c) sum += __expf(__uint_as_float(__float_as_uint(L[c]) & ~255u) - m0);
      const float inv = 1.f / sum;
#pragma unroll
      for (int r = 0; r < 4; ++r) {
        const float lv = q == 0 ? L[r] : (q == 1 ? L[4 + r] : (q == 2 ? L[8 + r] : L[12 + r]));
        const unsigned bits = __float_as_uint(lv), id = bits & 255u;
        const unsigned i1 = __float_as_uint(t1[id >> 4]) & 127u, i2 = __float_as_uint(t2[id & 15u]) & 127u;
        const float gate = __expf(__uint_as_float(bits & ~255u) - m0) * inv;
        ec[4 * rd + r] = (i1 * 128u + i2) | ((unsigned)tl << 14) | (pack2(0.f, gate) & 0xFFFF0000u);
      }
    }
    {
#pragma unroll
      for (int i = 0; i < 8; ++i) atomicAdd(&cntw[(ec[i] & 0x3FFFu) >> 8], 1);
      asm volatile("s_waitcnt lgkmcnt(0)" ::: "memory");
      const int c = cntw[lane]; int inc = c;
#pragma unroll
      for (int o = 1; o < 64; o <<= 1) { const int v = __shfl_up(inc, o, 64); if (lane >= o) inc += v; }
      asm volatile("s_waitcnt lgkmcnt(0)" ::: "memory");
      cntw[lane] = inc - c;
      asm volatile("s_waitcnt lgkmcnt(0)" ::: "memory");
#pragma unroll
      for (int i = 0; i < 8; ++i) { const int pos = atomicAdd(&cntw[(ec[i] & 0x3FFFu) >> 8], 1); ents[pos] = ec[i]; }
      asm volatile("s_waitcnt lgkmcnt(0)" ::: "memory");
    }
    u32x4 hA[4][2];
    { const float4 sq = *(const float4*)(SSQ + (size_t)(tok0 + j4) * 4);
      const float rstd = rsqrtf((sq.x + sq.y + sq.z + sq.w) * (1.f / 1024.f) + EPS);
#pragma unroll
      for (int i = 0; i < 4; ++i)
#pragma unroll
        for (int hf = 0; hf < 2; ++hf) {
          const int k0 = 256 * i + 16 * blk + 8 * hf;
          const u32x4 xb = *(const u32x4*)(H + (size_t)(tok0 + j4) * 1024 + k0);
          float hv[8];
#pragma unroll
          for (int e = 0; e < 8; e += 4) {
            const float4 g = *(const float4*)(a.g_norm2 + k0 + e), sc4 = *(const float4*)(mod + b * 6144 + 4096 + k0 + e), sh4 = *(const float4*)(mod + b * 6144 + 3072 + k0 + e);
            hv[e]     = bflo(xb[e >> 1]) * rstd * g.x * (1.f + sc4.x) + sh4.x;     hv[e + 1] = bfhi(xb[e >> 1]) * rstd * g.y * (1.f + sc4.y) + sh4.y;
            hv[e + 2] = bflo(xb[(e >> 1) + 1]) * rstd * g.z * (1.f + sc4.z) + sh4.z; hv[e + 3] = bfhi(xb[(e >> 1) + 1]) * rstd * g.w * (1.f + sc4.w) + sh4.w;
          }
          hA[i][hf] = (u32x4){pack2(hv[0], hv[1]), pack2(hv[2], hv[3]), pack2(hv[4], hv[5]), pack2(hv[6], hv[7])};
        } }
    f32x4 acc[16];
#pragma unroll
    for (int c = 0; c < 16; ++c) acc[c] = (f32x4){0.f, 0.f, 0.f, 0.f};
#define P7_VPHASE(bufi) do { const int _vb = trb + (bufi) * P7_VBUF;                                                            \
      { const s16x4 v0 = tr_read<0>(_vb), v1 = tr_read<128>(_vb), v2 = tr_read<256>(_vb), v3 = tr_read<384>(_vb),               \
                    v4 = tr_read<512>(_vb), v5 = tr_read<640>(_vb), v6 = tr_read<768>(_vb), v7 = tr_read<896>(_vb);               \
        asm volatile("s_waitcnt lgkmcnt(0)" ::: "memory"); SBAR();                                                                \
        acc[0] = MFMA4(awp, v0, acc[0]); acc[1] = MFMA4(awp, v1, acc[1]); acc[2] = MFMA4(awp, v2, acc[2]); acc[3] = MFMA4(awp, v3, acc[3]);   \
        acc[4] = MFMA4(awp, v4, acc[4]); acc[5] = MFMA4(awp, v5, acc[5]); acc[6] = MFMA4(awp, v6, acc[6]); acc[7] = MFMA4(awp, v7, acc[7]); } \
      { const s16x4 v0 = tr_read<1024>(_vb), v1 = tr_read<1152>(_vb), v2 = tr_read<1280>(_vb), v3 = tr_read<1408>(_vb),         \
                    v4 = tr_read<1536>(_vb), v5 = tr_read<1664>(_vb), v6 = tr_read<1792>(_vb), v7 = tr_read<1920>(_vb);           \
        asm volatile("s_waitcnt lgkmcnt(0)" ::: "memory"); SBAR();                                                                \
        acc[8] = MFMA4(awp, v0, acc[8]); acc[9] = MFMA4(awp, v1, acc[9]); acc[10] = MFMA4(awp, v2, acc[10]); acc[11] = MFMA4(awp, v3, acc[11]); \
        acc[12] = MFMA4(awp, v4, acc[12]); acc[13] = MFMA4(awp, v5, acc[13]); acc[14] = MFMA4(awp, v6, acc[14]); acc[15] = MFMA4(awp, v7, acc[15]); } } while (0)
    u32x4 u8[4], v8[4];
#define P7_LOADG(EN) do { const unsigned _ex = (EN) & 0x3FFFu; const unsigned char* _pu = U8 + (size_t)_ex * 1024 + 16 * blk;      \
      _Pragma("unroll") for (int _i = 0; _i < 4; ++_i) u8[_i] = *(const u32x4*)(_pu + 256 * _i);                                 \
      _Pragma("unroll") for (int _q = 0; _q < 4; ++_q) { const unsigned _eq = (unsigned)__builtin_amdgcn_readlane((int)_ex, _q);  \
        v8[_q] = *(const u32x4*)(V8 + (size_t)_eq * 1024 + 16 * lane); } } while (0)
    unsigned enc = ents[j4], enn = ents[4 + j4];
    P7_LOADG(enc);
    s16x4 awp = {0, 0, 0, 0};
    constexpr int NG = 128;
#pragma unroll 2
    for (int g = 0; g < NG; ++g) {
      if (g > 0) P7_VPHASE((g - 1) & 1);
      f32x4 d0 = {0.f, 0.f, 0.f, 0.f}, d1 = {0.f, 0.f, 0.f, 0.f};
#pragma unroll
      for (int i = 0; i < 4; ++i)
#pragma unroll
        for (int w = 0; w < 4; ++w) {
          const uint2 ub = {fp8x2_bf16(u8[i][w], 1.f / PEER_SU, false), fp8x2_bf16(u8[i][w], 1.f / PEER_SU, true)};
          const uint2 ha = {hA[i][w >> 1][2 * (w & 1)], hA[i][w >> 1][2 * (w & 1) + 1]};
          if (w & 1) d1 = MFMA4(__builtin_bit_cast(s16x4, ha), __builtin_bit_cast(s16x4, ub), d1);
          else       d0 = MFMA4(__builtin_bit_cast(s16x4, ha), __builtin_bit_cast(s16x4, ub), d0);
        }
      { char* vw = ring + (g & 1) * P7_VBUF + lane * 32;
#pragma unroll
        for (int q = 0; q < 4; ++q) {
          u32x4 o0, o1;
          o0[0] = fp8x2_bf16(v8[q][0], 1.f / PEER_SV, false); o0[1] = fp8x2_bf16(v8[q][0], 1.f / PEER_SV, true);
          o0[2] = fp8x2_bf16(v8[q][1], 1.f / PEER_SV, false); o0[3] = fp8x2_bf16(v8[q][1], 1.f / PEER_SV, true);
          o1[0] = fp8x2_bf16(v8[q][2], 1.f / PEER_SV, false); o1[1] = fp8x2_bf16(v8[q][2], 1.f / PEER_SV, true);
          o1[2] = fp8x2_bf16(v8[q][3], 1.f / PEER_SV, false); o1[3] = fp8x2_bf16(v8[q][3], 1.f / PEER_SV, true);
          *(u32x4*)(vw + q * P7_VROW) = o0; *(u32x4*)(vw + q * P7_VROW + 16) = o1;
        } }
      unsigned en2 = 0u;
      if (g + 1 < NG) { P7_LOADG(enn); if (g + 2 < NG) en2 = ents[4 * (g + 2) + j4]; }
      const int tk = (enc >> 14) & 3;
      float av = sel4(d0, tk) + sel4(d1, tk);
      av += __uint_as_float(__builtin_amdgcn_update_dpp(0, __float_as_uint(av), 0x124, 0xf, 0xf, false));
      av += __uint_as_float(__builtin_amdgcn_update_dpp(0, __float_as_uint(av), 0x128, 0xf, 0xf, false));
      av += __shfl_xor(av, 16, 64);
      { auto rr = __builtin_amdgcn_permlane32_swap(__float_as_uint(av), __float_as_uint(av), false, false); av = __uint_as_float(rr[0]) + __uint_as_float(rr[1]); }
      const float wgt = gelu_exact(av) * __uint_as_float(enc & 0xFFFF0000u);
      float z[4];
#define P7_QB(x, k) __builtin_amdgcn_update_dpp(0, (x), (k) * 0x55, 0xf, 0xf, false)
      { const unsigned wb = __float_as_uint(wgt), tb = (unsigned)tk;
        unsigned w0 = P7_QB(wb, 0), w1 = P7_QB(wb, 1), w2 = P7_QB(wb, 2), w3 = P7_QB(wb, 3);
        unsigned t0 = P7_QB(tb, 0), t1 = P7_QB(tb, 1), t2 = P7_QB(tb, 2), t3 = P7_QB(tb, 3);
        asm volatile("" : "+v"(w0), "+v"(w1), "+v"(w2), "+v"(w3), "+v"(t0), "+v"(t1), "+v"(t2), "+v"(t3));
        z[0] = ((int)t0 == j4) ? __uint_as_float(w0) : 0.f; z[1] = ((int)t1 == j4) ? __uint_as_float(w1) : 0.f;
        z[2] = ((int)t2 == j4) ? __uint_as_float(w2) : 0.f; z[3] = ((int)t3 == j4) ? __uint_as_float(w3) : 0.f; }
#undef P7_QB
      { const uint2 pk = {pack2(z[0], z[1]), pack2(z[2], z[3])}; awp = __builtin_bit_cast(s16x4, pk); }
      enc = enn; enn = en2;
    }
#undef P7_LOADG
    P7_VPHASE((NG - 1) & 1);
#undef P7_VPHASE
    int lne = lane; asm volatile("" : "+v"(lne));
    float ss[4] = {0.f, 0.f, 0.f, 0.f};
#pragma unroll
    for (int c = 0; c < 16; ++c) {
      const float g2 = mod[b * 6144 + 5120 + 64 * c + lne];
#pragma unroll
      for (int r = 0; r < 4; ++r) { const float v = bflo((unsigned)H[(size_t)(tok0 + r) * 1024 + 64 * c + lne]) + g2 * acc[c][r]; acc[c][r] = v; ss[r] += v * v; }
    }
    float rstd[4];
#pragma unroll
    for (int r = 0; r < 4; ++r) rstd[r] = rsqrtf(wave_sum(ss[r]) * (1.f / 1024.f) + EPS);
#pragma unroll
    for (int c = 0; c < 16; ++c) {
      const float gf = a.g_final[64 * c + lne];
#pragma unroll
      for (int r = 0; r < 4; ++r) a.out[(size_t)(tok0 + r) * 1024 + 64 * c + lne] = acc[c][r] * rstd[r] * gf;
    }
  }
}

constexpr int N_PHASES = 8;
__global__ void __launch_bounds__(512, 2) fwd(Args args) {
  extern __shared__ __attribute__((aligned(16))) char lds[];
  if (threadIdx.x == 0) *(uint4*)lds = make_uint4(0u, 0u, 0u, 0u);
  __syncthreads();
  const int lo = args.ph_lo, hi = args.ph_hi;
  XcdBarrier bar; bar.bar = (unsigned*)(args.ws + WS_BAR); bar.x = 0; bar.st = (volatile LAS unsigned*)lds;
  if (hi - lo > 1) bar = xcd_barrier_post((unsigned*)(args.ws + WS_BAR), (volatile LAS unsigned*)lds);
#ifndef ONLY_PHASE
#define ONLY_PHASE -1
#endif
#define IN(k) (lo <= (k) && (k) < hi && (ONLY_PHASE < 0 || ONLY_PHASE == (k)))
#define SEAM(k) do { if (IN(k) && IN((k) + 1)) xcd_barrier(bar); } while (0)
  if (IN(0)) phase0(args, lds);
  SEAM(0);
  if (IN(1)) { phase1(args, lds); phase1b(args, lds); }
  SEAM(1);
  if (IN(2)) phase2(args, lds);
  SEAM(2);
  if (IN(3)) phase3(args, lds);
  SEAM(3);
  if (IN(4)) phase4(args, lds);
  SEAM(4);
  if (IN(5)) phase5(args, lds);
  SEAM(5);
  if (IN(6)) phase6(args, lds);
  SEAM(6);
  if (IN(7)) phase7(args, lds);
#undef IN
#undef SEAM
}

extern "C" void kernel_launch(void* const* d_in, const int* in_sizes, int n_in, void* d_out, int out_size, void* d_ws, size_t ws_size, hipStream_t stream) {
  static int grid = 0;
  if (grid == 0) {
    if (n_in != 23 || out_size != T * DM || ws_size < WS_END) { fprintf(stderr, "kernel_launch: unexpected shapes (n_in %d out %d ws %zu need %zu)\n", n_in, out_size, ws_size, (size_t)WS_END); grid = -1; return; }
    int dev = 0, cus = 0, per_cu = 0;
    (void)hipGetDevice(&dev); (void)hipDeviceGetAttribute(&cus, hipDeviceAttributeMultiprocessorCount, dev);
    if (hipFuncSetAttribute((const void*)fwd, hipFuncAttributeMaxDynamicSharedMemorySize, LDS_BYTES) != hipSuccess) { fprintf(stderr, "kernel_launch: hipFuncSetAttribute failed\n"); grid = -1; return; }
    if (hipOccupancyMaxActiveBlocksPerMultiprocessor(&per_cu, (const void*)fwd, 512, LDS_BYTES) != hipSuccess || per_cu < 1) { fprintf(stderr, "kernel_launch: occupancy query says %d\n", per_cu); per_cu = 1; }
    (void)hipGetLastError();
    grid = cus;
  }
  if (grid < 0) return;
  (void)hipMemsetAsync((char*)d_ws + WS_BAR, 0, 16384, stream);
  Args a{};
  a.x = (const float*)d_in[0]; a.c = (const float*)d_in[1]; a.pos = (const int*)d_in[2];
  a.w_ada = (const float*)d_in[3]; a.b_ada = (const float*)d_in[4]; a.g_norm1 = (const float*)d_in[5]; a.w_in = (const float*)d_in[6];
  a.g_q_a = (const float*)d_in[7]; a.w_uq = (const float*)d_in[8]; a.g_kv_a = (const float*)d_in[9]; a.w_ukv = (const float*)d_in[10];
  a.g_sg = (const float*)d_in[11]; a.w_sg = (const float*)d_in[12]; a.b_sg = (const float*)d_in[13]; a.g_attn_out = (const float*)d_in[14];
  a.g_sg_out = (const float*)d_in[15]; a.w_o = (const float*)d_in[16]; a.g_norm2 = (const float*)d_in[17]; a.w_peer_q = (const float*)d_in[18];
  a.peer_keys = (const float*)d_in[19]; a.peer_u = (const float*)d_in[20]; a.peer_v = (const float*)d_in[21]; a.g_final = (const float*)d_in[22];
  a.out = (float*)d_out; a.ws = (unsigned char*)d_ws;
#if N_LAUNCH_MODE == 0
  a.ph_lo = 0; a.ph_hi = N_PHASES;
  hipLaunchKernelGGL(fwd, dim3(grid), dim3(512), LDS_BYTES, stream, a);
#else
  for (int p = 0; p < N_PHASES; ++p) for (int rep = 0; rep <= ((DUP_MASK >> p) & 1); ++rep) { a.ph_lo = p; a.ph_hi = p + 1; hipLaunchKernelGGL(fwd, dim3(grid), dim3(512), LDS_BYTES, stream, a); }
#endif
  const hipError_t le = hipPeekAtLastError();
  if (le != hipSuccess) fprintf(stderr, "kernel_launch: launch failed: %s\n", hipGetErrorName(le));
}
```

```cpp
#include <hip/hip_runtime.h>
#include <stdint.h>
#include <stdio.h>

#define N_LAUNCH_MODE 0
#define DUP_MASK 0x000

typedef unsigned short u16;
typedef __attribute__((ext_vector_type(8))) short bf16x8;
typedef __attribute__((ext_vector_type(4))) short s16x4;
typedef __attribute__((ext_vector_type(16))) float f32x16;
typedef __attribute__((ext_vector_type(4))) unsigned u32x4;

constexpr int T = 16384, DM = 1024, SEQ = 4096;
constexpr float EPS = 1e-6f;

constexpr size_t WS_BAR  = 0;
constexpr size_t WS_MODP = 16384;
constexpr size_t WS_MOD  = WS_MODP + 786432;
constexpr size_t WS_CS   = WS_MOD + 98304;
constexpr size_t WS_WIN  = WS_CS + 4194304;
constexpr size_t WS_WQ2  = WS_WIN + 3145728;
constexpr size_t WS_WUV  = WS_WQ2 + 393216;
constexpr size_t WS_WO   = WS_WUV + 131072;
constexpr size_t WS_WPQ  = WS_WO + 2097152;
constexpr size_t WS_KEYS = WS_WPQ + 4194304;
constexpr size_t WS_WSG  = WS_KEYS + 524288;
constexpr size_t WS_UB   = WS_WSG + 131072;
constexpr size_t WS_VB   = WS_UB + 33554432;
constexpr size_t WS_H    = WS_VB + 33554432;
constexpr size_t WS_Y    = WS_H + 33554432;
constexpr size_t WS_KV   = WS_Y + 33554432;
constexpr size_t WS_TOPK = WS_KV + 6291456;
constexpr size_t WS_SSQ  = WS_TOPK + 16777216;
constexpr size_t WS_SSQV = WS_SSQ + 262144;
constexpr size_t WS_R1   = WS_SSQV + 131072;
constexpr size_t WS_Q    = WS_R1;
constexpr size_t WS_QA   = WS_Q + 25165824;
constexpr size_t WS_UACT = WS_QA + 8388608;
constexpr size_t WS_GVT  = WS_UACT + 16777216;
constexpr size_t WS_X1   = WS_R1;
constexpr size_t WS_WST  = WS_R1 + 67108864;
constexpr size_t WS_BIASP = WS_WST + 4 * 4194304;
constexpr size_t WS_END  = WS_BIASP + 131072;

constexpr int LDS_BYTES = 155648;
constexpr int LDS_DATA  = 64;

struct Args {
  const float *x, *c; const int* pos;
  const float *w_ada, *b_ada, *g_norm1, *w_in, *g_q_a, *w_uq, *g_kv_a, *w_ukv, *g_sg, *w_sg, *b_sg, *g_attn_out, *g_sg_out,
              *w_o, *g_norm2, *w_peer_q, *peer_keys, *peer_u, *peer_v, *g_final;
  float* out; unsigned char* ws; int ph_lo, ph_hi;
};

#define XB_TMO      128
#define XB_XCNT(j)  (256  + 64 * (j))
#define XB_XSUB(j)  (1280 + 64 * (j))
#define XB_XGEN(j)  (2304 + 64 * (j))
#define XB_TOP      3328
#define XB_TOPGEN   3392
#define XCD_BAR_WORDS 3456
#define XB_SPIN_CAP (1u << 18)
#define LAS __attribute__((address_space(3)))

__device__ __forceinline__ unsigned xb_ld(unsigned* p)              { return __hip_atomic_load(p, __ATOMIC_RELAXED, __HIP_MEMORY_SCOPE_AGENT); }
__device__ __forceinline__ unsigned xb_add(unsigned* p, unsigned v) { return __hip_atomic_fetch_add(p, v, __ATOMIC_RELAXED, __HIP_MEMORY_SCOPE_AGENT); }
__device__ __forceinline__ unsigned xb_xcc_id() { return (unsigned)__builtin_amdgcn_s_getreg((3 << 11) | 20) & 0xFu; }
#define XB_SPIN(cond, bar) do { unsigned _sp = 0; while (cond) { __builtin_amdgcn_s_sleep(1); \
    if ((++_sp & 255u) == 0u) { if (xb_ld(&(bar)[XB_TMO])) break; if (_sp > XB_SPIN_CAP) { atomicAdd(&(bar)[XB_TMO], 1u); break; } } } } while (0)

struct XcdBarrier { unsigned* bar; unsigned x; volatile LAS unsigned* st; };

__device__ __forceinline__ XcdBarrier xcd_barrier_post(unsigned* bar, volatile LAS unsigned* st) {
    XcdBarrier b; b.bar = bar; b.x = xb_xcc_id(); b.st = st;
    if (threadIdx.x == 0) (void)xb_add(&bar[XB_XCNT(b.x)], 1u);
    return b;
}
__device__ __forceinline__ void xcd_barrier_complete(unsigned* bar, unsigned x, unsigned& nloc, unsigned& nx) {
    const unsigned G = gridDim.x * gridDim.y * gridDim.z;
    unsigned sum, cnt, mine, sp = 0u;
    for (;;) {
        sum = 0u; cnt = 0u; mine = 0u;
#pragma unroll
        for (unsigned j = 0; j < 16; ++j) { const unsigned c = xb_ld(&bar[XB_XCNT(j)]); sum += c; cnt += (c > 0u) ? 1u : 0u; mine = (j == x) ? c : mine; }
        if (sum == G) break;
        __builtin_amdgcn_s_sleep(1);
        if ((++sp & 255u) == 0u) { if (xb_ld(&bar[XB_TMO])) break; if (sp > XB_SPIN_CAP) { atomicAdd(&bar[XB_TMO], 1u); break; } }
    }
    nloc = mine > 0u ? mine : 1u; nx = cnt > 0u ? cnt : 1u;
}
__device__ __forceinline__ void xcd_barrier(const XcdBarrier& b) {
    asm volatile("s_waitcnt vmcnt(0)" ::: "memory");
    __syncthreads();
    if (threadIdx.x == 0) {
        unsigned* bar = b.bar;
        __builtin_amdgcn_s_waitcnt(0);
        unsigned nloc = b.st[0], nx = b.st[1];
        if (nloc == 0u) { xcd_barrier_complete(bar, b.x, nloc, nx); b.st[0] = nloc; b.st[1] = nx; }
        const unsigned old = xb_add(&bar[XB_XSUB(b.x)], 1u);
        const unsigned gen = old / nloc;
        if (old + 1u == (gen + 1u) * nloc) {
            __builtin_amdgcn_fence(__ATOMIC_RELEASE, "agent");
            asm volatile("s_waitcnt vmcnt(0)" ::: "memory");
            const unsigned og = xb_add(&bar[XB_TOP], 1u);
            const unsigned tg = og / nx;
            if (og + 1u == (tg + 1u) * nx) xb_add(&bar[XB_TOPGEN], 1u);
            else XB_SPIN(xb_ld(&bar[XB_TOPGEN]) == tg, bar);
            __builtin_amdgcn_fence(__ATOMIC_ACQUIRE, "agent");
            xb_add(&bar[XB_XGEN(b.x)], 1u);
            asm volatile("s_waitcnt vmcnt(0)" ::: "memory");
        } else {
            XB_SPIN(xb_ld(&bar[XB_XGEN(b.x)]) == gen, bar);
            __builtin_amdgcn_fence(__ATOMIC_ACQUIRE, "agent");
            asm volatile("s_waitcnt vmcnt(0)" ::: "memory");
        }
    }
    __syncthreads();
}

__device__ __forceinline__ unsigned pack2(float lo, float hi) {
  typedef __attribute__((ext_vector_type(2))) float f2; typedef __attribute__((ext_vector_type(2))) __bf16 b2;
  f2 v = {lo, hi}; b2 r = __builtin_convertvector(v, b2); return __builtin_bit_cast(unsigned, r);
}
__device__ __forceinline__ u16 f2bf(float f) { return (u16)(pack2(f, 0.f) & 0xFFFFu); }
__device__ __forceinline__ float bflo(unsigned w) { return __uint_as_float(w << 16); }
__device__ __forceinline__ float bfhi(unsigned w) { return __uint_as_float(w & 0xFFFF0000u); }
__device__ __forceinline__ float gelu_exact(float x) {
  const float z = fabsf(x) * 0.70710678118654752f;
  const float t = __builtin_amdgcn_rcpf(fmaf(0.3275911f, z, 1.f));
  float p = fmaf(1.061405429f, t, -1.453152027f); p = fmaf(p, t, 1.421413741f); p = fmaf(p, t, -0.284496736f); p = fmaf(p, t, 0.254829592f);
  const float e = p * t * __expf(-z * z);
  const float erfz = 1.f - e;
  return 0.5f * x * (1.f + copysignf(erfz, x));
}
__device__ __forceinline__ float wave_sum(float v) {
#pragma unroll
  for (int o = 32; o > 0; o >>= 1) v += __shfl_xor(v, o, 64);
  return v;
}
__device__ __forceinline__ int crow(int r, int hi) { return (r & 3) + 8 * (r >> 2) + 4 * hi; }
#define MFMA32(a, b, c) __builtin_amdgcn_mfma_f32_32x32x16_bf16((a), (b), (c), 0, 0, 0)

template <int MAP> __device__ __forceinline__ int colmap(int n) {
  if (MAP == 0) return n;
  if (MAP == 1) return n < 448 ? n : (n < 512 ? -1 : n - 64);
  if (MAP == 2) return (n >> 6) * 192 + 128 + (n & 63);
  return (n >> 7) * 256 + 128 + (n & 127);
}
template <int MAP> __device__ void cvt_transpose(const float* __restrict__ src, int src_ld, int K, int N, u16* __restrict__ dst, int gtid, int gthreads) {
  const int total = N * (K >> 3);
  for (int idx = gtid; idx < total; idx += gthreads) {
    const int n = idx % N, k8 = idx / N, sc = colmap<MAP>(n);
    float v[8];
#pragma unroll
    for (int j = 0; j < 8; ++j) v[j] = sc < 0 ? 0.f : src[(size_t)(k8 * 8 + j) * src_ld + sc];
    u32x4 w = {pack2(v[0], v[1]), pack2(v[2], v[3]), pack2(v[4], v[5]), pack2(v[6], v[7])};
    *(u32x4*)(dst + (size_t)n * K + k8 * 8) = w;
  }
}
template <int MAP> __device__ void cvt_transpose_tiled(const float* __restrict__ src, int src_ld, int K, int N, u16* __restrict__ dst, float* tile) {
  const int tid = threadIdx.x, tk = K >> 6, ntile = tk * (N >> 6);
  for (int t = blockIdx.x; t < ntile; t += gridDim.x) {
    const int k0 = (t % tk) * 64, n0 = (t / tk) * 64;
    __syncthreads();
    { const int nl = tid & 63, sc = colmap<MAP>(n0 + nl);
#pragma unroll
      for (int i = 0; i < 8; ++i) { const int k = (tid >> 6) + 8 * i; tile[k * 65 + nl] = sc < 0 ? 0.f : src[(size_t)(k0 + k) * src_ld + sc]; } }
    __syncthreads();
    { const int n = tid >> 3, kk = tid & 7; float v[8];
#pragma unroll
      for (int j = 0; j < 8; ++j) v[j] = tile[(8 * kk + j) * 65 + n];
      u32x4 w = {pack2(v[0], v[1]), pack2(v[2], v[3]), pack2(v[4], v[5]), pack2(v[6], v[7])};
      *(u32x4*)(dst + (size_t)(n0 + n) * K + k0 + 8 * kk) = w; }
  }
}
__device__ void cvt_direct(const float* __restrict__ src, u16* __restrict__ dst, size_t n8, int gtid, int gthreads) {
  for (size_t i = gtid; i < n8; i += gthreads) {
    const float4 a = *(const float4*)(src + i * 8), b = *(const float4*)(src + i * 8 + 4);
    u32x4 w = {pack2(a.x, a.y), pack2(a.z, a.w), pack2(b.x, b.y), pack2(b.z, b.w)};
    *(u32x4*)(dst + i * 8) = w;
  }
}
constexpr float PEER_SU = 32.f, PEER_SV = 4.f;
__device__ __forceinline__ void sincos_acc(float angf, float& sn, float& cs) {
  const double a = (double)angf;
  const double q = __builtin_rint(a * 0.63661977236758134308);
  double r = __builtin_fma(-q, 1.5707963267948966, a);
  r = __builtin_fma(-q, 6.123233995736766e-17, r);
  const double r2 = r * r;
  double s = r2 * (1.0 / 6227020800.0) - 1.0 / 39916800.0;
  s = s * r2 + 1.0 / 362880.0; s = s * r2 - 1.0 / 5040.0; s = s * r2 + 1.0 / 120.0; s = s * r2 - 1.0 / 6.0; s = r + r * r2 * s;
  double c = -r2 * (1.0 / 87178291200.0) + 1.0 / 479001600.0;
  c = c * r2 - 1.0 / 3628800.0; c = c * r2 + 1.0 / 40320.0; c = c * r2 - 1.0 / 720.0; c = c * r2 + 1.0 / 24.0; c = c * r2 - 0.5; c = 1.0 + r2 * c;
  const int n = ((int)q) & 3;
  const double ss = (n & 1) ? c : s, cc = (n & 1) ? s : c;
  sn = (float)((n & 2) ? -ss : ss);
  cs = (float)(((n + 1) & 2) ? -cc : cc);
}

__constant__ float INVF[32] = {1.000000000e+00f, 7.498942018e-01f, 5.623413324e-01f, 4.216965139e-01f, 3.162277639e-01f, 2.371373922e-01f, 1.778279394e-01f, 1.333521456e-01f,
  1.000000015e-01f, 7.498941571e-02f, 5.623412877e-02f, 4.216964915e-02f, 3.162277862e-02f, 2.371373586e-02f, 1.778279431e-02f, 1.333521493e-02f,
  9.999999776e-03f, 7.498942316e-03f, 5.623413250e-03f, 4.216964822e-03f, 3.162277862e-03f, 2.371373819e-03f, 1.778279431e-03f, 1.333521446e-03f,
  1.000000047e-03f, 7.498941850e-04f, 5.623413017e-04f, 4.216965463e-04f, 3.162277862e-04f, 2.371373848e-04f, 1.778279402e-04f, 1.333521504e-04f};
__device__ void phase0(const Args& a, char* lds) {
  unsigned char* ws = a.ws;
  const int tid = threadIdx.x, lane = tid & 63, wv = tid >> 6;
  const int NWV = gridDim.x * 8, gw = blockIdx.x * 8 + wv;
  const int gthreads = gridDim.x * 512, gtid = blockIdx.x * 512 + tid;
  float* modp = (float*)(ws + WS_MODP);
  for (int job = gw; job < 768; job += NWV) {
    const int cg = job % 96, ks = job / 96, col = cg * 64 + lane;
    float a0 = 0.f, a1 = 0.f, a2 = 0.f, a3 = 0.f;
    const float* w = a.w_ada + (size_t)(ks * 128) * 6144 + col;
    float sv[2][4];
#pragma unroll
    for (int h = 0; h < 2; ++h)
#pragma unroll
      for (int bb = 0; bb < 4; ++bb) { const float cv = a.c[bb * 1024 + ks * 128 + 64 * h + lane]; sv[h][bb] = cv / (1.f + __expf(-cv)); }
#pragma unroll
    for (int h = 0; h < 2; ++h) {
#pragma unroll 8
      for (int k = 0; k < 64; ++k) {
        const float wv_ = w[(size_t)(64 * h + k) * 6144];
        a0 += __uint_as_float(__builtin_amdgcn_readlane(__float_as_uint(sv[h][0]), k)) * wv_;
        a1 += __uint_as_float(__builtin_amdgcn_readlane(__float_as_uint(sv[h][1]), k)) * wv_;
        a2 += __uint_as_float(__builtin_amdgcn_readlane(__float_as_uint(sv[h][2]), k)) * wv_;
        a3 += __uint_as_float(__builtin_amdgcn_readlane(__float_as_uint(sv[h][3]), k)) * wv_;
      }
    }
    modp[(ks * 4 + 0) * 6144 + col] = a0; modp[(ks * 4 + 1) * 6144 + col] = a1;
    modp[(ks * 4 + 2) * 6144 + col] = a2; modp[(ks * 4 + 3) * 6144 + col] = a3;
  }
  { float* tile = (float*)(lds + LDS_DATA);
    cvt_transpose_tiled<1>(a.w_in, 1472, 1024, 1536, (u16*)(ws + WS_WIN), tile);
    cvt_transpose_tiled<0>(a.w_o, 1024, 1024, 1024, (u16*)(ws + WS_WO), tile);
    cvt_transpose_tiled<2>(a.w_uq, 768, 256, 256, (u16*)(ws + WS_WQ2) + 512 * 256, tile);
    cvt_transpose_tiled<3>(a.w_ukv, 1024, 128, 512, (u16*)(ws + WS_WUV), tile); }
  {
    u16* wq2 = (u16*)(ws + WS_WQ2);
    for (int idx = gtid; idx < 512 * 256; idx += gthreads) {
      const int n = idx >> 8, i = idx & 255, h = n >> 7, cc = n & 127;
      const float* pu = a.w_uq + (size_t)i * 768 + h * 192;
      const float* pk = a.w_ukv + (size_t)cc * 1024 + h * 256;
      float s = 0.f;
#pragma unroll 8
      for (int d = 0; d < 128; d += 4) {
        const float4 u = *(const float4*)(pu + d), k = *(const float4*)(pk + d);
        s += u.x * k.x + u.y * k.y + u.z * k.z + u.w * k.w;
      }
      wq2[(size_t)n * 256 + i] = f2bf(s);
    }
  }
  cvt_direct(a.peer_keys, (u16*)(ws + WS_KEYS), 262144 / 8, gtid, gthreads);
  cvt_direct(a.w_peer_q, (u16*)(ws + WS_WPQ), (size_t)1024 * 2048 / 8, gtid, gthreads);
  cvt_direct(a.w_sg, (u16*)(ws + WS_WSG), 65536 / 8, gtid, gthreads);
  {
    float* cs = (float*)(ws + WS_CS);
    for (int idx = gtid; idx < T * 32; idx += gthreads) {
      const int t = idx >> 5, i = idx & 31;
      const float inv = INVF[i];
      const float ang = (float)a.pos[t] * inv;
      float sn, c_; sincos_acc(ang, sn, c_);
      cs[(size_t)t * 64 + i] = c_; cs[(size_t)t * 64 + 32 + i] = sn;
    }
  }
}

__device__ void phase1(const Args& a, char* lds) {
  unsigned char* ws = a.ws;
  const int tid = threadIdx.x, lane = tid & 63, wv = tid >> 6;
  const float* modp = (const float*)(ws + WS_MODP);
  float* mod = (float*)(ws + WS_MOD);
  for (int idx = blockIdx.x * 512 + tid; idx < 4 * 6144; idx += gridDim.x * 512) {
    const int b = idx / 6144, m = idx % 6144;
    float s = a.b_ada[m];
#pragma unroll
    for (int ks = 0; ks < 8; ++ks) s += modp[(ks * 4 + b) * 6144 + m];
    mod[idx] = s;
  }
  float* sh = (float*)(lds + LDS_DATA);
  u16* H = (u16*)(ws + WS_H);
  for (int u = blockIdx.x; u < T / 64; u += gridDim.x) {
    const int b = u >> 6;
    __syncthreads();
    for (int j = tid; j < 2048; j += 512) {
      float s = a.b_ada[j];
#pragma unroll
      for (int ks = 0; ks < 8; ++ks) s += modp[(ks * 4 + b) * 6144 + j];
      sh[j] = s;
    }
    __syncthreads();
    for (int i = 0; i < 8; ++i) {
      const int r = u * 64 + wv * 8 + i;
      float4 xv[4]; float ssq = 0.f;
#pragma unroll
      for (int j = 0; j < 4; ++j) { xv[j] = *(const float4*)(a.x + (size_t)r * 1024 + j * 256 + lane * 4); ssq += xv[j].x * xv[j].x + xv[j].y * xv[j].y + xv[j].z * xv[j].z + xv[j].w * xv[j].w; }
      ssq = wave_sum(ssq);
      const float rstd = rsqrtf(ssq * (1.f / 1024.f) + EPS);
#pragma unroll
      for (int j = 0; j < 4; ++j) {
        const int col = j * 256 + lane * 4;
        const float4 g = *(const float4*)(a.g_norm1 + col);
        const float h0 = xv[j].x * rstd * g.x * (1.f + sh[1024 + col]) + sh[col];
        const float h1 = xv[j].y * rstd * g.y * (1.f + sh[1024 + col + 1]) + sh[col + 1];
        const float h2 = xv[j].z * rstd * g.z * (1.f + sh[1024 + col + 2]) + sh[col + 2];
        const float h3 = xv[j].w * rstd * g.w * (1.f + sh[1024 + col + 3]) + sh[col + 3];
        uint2 o = {pack2(h0, h1), pack2(h2, h3)};
        *(uint2*)(H + (size_t)r * 1024 + col) = o;
      }
    }
  }
}

constexpr int G_STAGE = 49152;
__device__ __forceinline__ void dma16(const void* gsrc, unsigned lds_dst) {
  unsigned keep;
  asm volatile("s_mov_b32 %0, m0\n\ts_mov_b32 m0, %2\n\ts_nop 0\n\tglobal_load_lds_dwordx4 %1, off\n\ts_mov_b32 m0, %0"
               : "=&s"(keep) : "v"(gsrc), "s"(lds_dst) : "memory");
}
__device__ __forceinline__ void gemm_128x256(const u16* __restrict__ A, int lda, const u16* __restrict__ Bt, int ldb, int KT,
                                             f32x16 (&acc)[2][2], char* lds) {
  const int tid = threadIdx.x, lane = tid & 63, wv = __builtin_amdgcn_readfirstlane(tid >> 6), r32 = lane & 31, hi = lane >> 5;
  const int wm = wv >> 2, wn = wv & 3;
  const int rin = lane >> 3, cc = lane & 7;
  const u16* pa[2]; const u16* pb[4];
#pragma unroll
  for (int j = 0; j < 2; ++j) pa[j] = A + (size_t)(16 * wv + 8 * j + rin) * lda + 8 * (cc ^ (4 * j + (rin >> 1)));
#pragma unroll
  for (int i = 0; i < 4; ++i) pb[i] = Bt + (size_t)(32 * wv + 8 * i + rin) * ldb + 8 * (cc ^ (4 * (i & 1) + (rin >> 1)));
  const unsigned lb = __builtin_amdgcn_readfirstlane((unsigned)(uintptr_t)lds);
  const unsigned dA = lb + 2048 * wv, dB = lb + 16384 + 4096 * wv;
#define G_ISSUE(stage, kt_) do { const unsigned _so = (unsigned)(stage) * G_STAGE; const int _ko = (kt_) * 64;                     \
    dma16(pa[0] + _ko, dA + _so); dma16(pa[1] + _ko, dA + _so + 1024);                                                           \
    dma16(pb[0] + _ko, dB + _so); dma16(pb[1] + _ko, dB + _so + 1024); dma16(pb[2] + _ko, dB + _so + 2048); dma16(pb[3] + _ko, dB + _so + 3072); } while (0)
#pragma unroll
  for (int m = 0; m < 2; ++m)
#pragma unroll
    for (int n = 0; n < 2; ++n)
#pragma unroll
      for (int r = 0; r < 16; ++r) acc[m][n][r] = 0.f;
  __syncthreads();
  G_ISSUE(0, 0);
  if (KT > 1) G_ISSUE(1, 1);
  const int xa = (r32 >> 1) & 7;
  const int aoff = (64 * wm + r32) * 128, boff = 16384 + (64 * wn + r32) * 128;
  int st = 0;
  for (int kt = 0; kt < KT; ++kt) {
    if (kt + 1 < KT) asm volatile("s_waitcnt vmcnt(6)\n\ts_barrier" ::: "memory");
    else             asm volatile("s_waitcnt vmcnt(0)\n\ts_barrier" ::: "memory");
    const int s2 = st == 0 ? 2 : st - 1;
    if (kt + 2 < KT && wv < 4) G_ISSUE(s2, kt + 2);
    const char* buf = lds + st * G_STAGE;
    __builtin_amdgcn_s_setprio(1);
    bf16x8 fa[2][2], fb[2][2];
#define G_LDF(S, SET) do { const int _cb = ((2 * (S) + hi) ^ xa) << 4;                                                      \
      fa[SET][0] = *(const bf16x8*)(buf + aoff + _cb); fa[SET][1] = *(const bf16x8*)(buf + aoff + 4096 + _cb);              \
      fb[SET][0] = *(const bf16x8*)(buf + boff + _cb); fb[SET][1] = *(const bf16x8*)(buf + boff + 4096 + _cb); } while (0)
#define G_MM(SET) do { acc[0][0] = MFMA32(fa[SET][0], fb[SET][0], acc[0][0]); acc[0][1] = MFMA32(fa[SET][0], fb[SET][1], acc[0][1]);   \
      acc[1][0] = MFMA32(fa[SET][1], fb[SET][0], acc[1][0]); acc[1][1] = MFMA32(fa[SET][1], fb[SET][1], acc[1][1]); } while (0)
    G_LDF(0, 0); __builtin_amdgcn_sched_barrier(0);
    G_LDF(1, 1); __builtin_amdgcn_sched_barrier(0); G_MM(0); __builtin_amdgcn_sched_barrier(0);
    G_LDF(2, 0); __builtin_amdgcn_sched_barrier(0); G_MM(1); __builtin_amdgcn_sched_barrier(0);
    G_LDF(3, 1); __builtin_amdgcn_sched_barrier(0); G_MM(0); __builtin_amdgcn_sched_barrier(0);
    G_MM(1);
#undef G_LDF
#undef G_MM
    __builtin_amdgcn_s_setprio(0);
    if (kt + 2 < KT && wv >= 4) G_ISSUE(s2, kt + 2);
    st = st == 2 ? 0 : st + 1;
  }
#undef G_ISSUE
  __syncthreads();
}
constexpr int CLD = 257;
__device__ __forceinline__ void acc_to_lds(const f32x16 (&acc)[2][2], float* Cl) {
  const int lane = threadIdx.x & 63, wv = threadIdx.x >> 6, r32 = lane & 31, hi = lane >> 5, wm = wv >> 2, wn = wv & 3;
#pragma unroll
  for (int m = 0; m < 2; ++m)
#pragma unroll
    for (int n = 0; n < 2; ++n)
#pragma unroll
      for (int r = 0; r < 16; ++r) Cl[(64 * wm + 32 * m + crow(r, hi)) * CLD + 64 * wn + 32 * n + r32] = acc[m][n][r];
}

constexpr int G2_STAGE = 65536;
__device__ __forceinline__ void gemm_256x256_wide(const u16* __restrict__ A, int lda, const u16* __restrict__ Bt, int ldb, int KT, f32x16 (&acc)[8], char* lds) {
  const int tid = threadIdx.x, lane = tid & 63, wv = __builtin_amdgcn_readfirstlane(tid >> 6), r32 = lane & 31, hi = lane >> 5;
  const int rin = lane >> 3, cc = lane & 7;
  const u16* pa[4]; const u16* pb[4];
#pragma unroll
  for (int i = 0; i < 4; ++i) {
    pa[i] = A + (size_t)(32 * wv + 8 * i + rin) * lda + 8 * (cc ^ (4 * (i & 1) + (rin >> 1)));
    pb[i] = Bt + (size_t)(32 * wv + 8 * i + rin) * ldb + 8 * (cc ^ (4 * (i & 1) + (rin >> 1)));
  }
  const unsigned lb = __builtin_amdgcn_readfirstlane((unsigned)(uintptr_t)lds);
  const unsigned dA = lb + 4096 * wv, dB = lb + 32768 + 4096 * wv;
#define G_ISSUE(stage, kt_) do { const unsigned _so = (unsigned)(stage) * G2_STAGE; const int _ko = (kt_) * 64;                    \
    dma16(pa[0] + _ko, dA + _so); dma16(pa[1] + _ko, dA + _so + 1024); dma16(pa[2] + _ko, dA + _so + 2048); dma16(pa[3] + _ko, dA + _so + 3072);   \
    dma16(pb[0] + _ko, dB + _so); dma16(pb[1] + _ko, dB + _so + 1024); dma16(pb[2] + _ko, dB + _so + 2048); dma16(pb[3] + _ko, dB + _so + 3072); } while (0)
#pragma unroll
  for (int m = 0; m < 8; ++m)
#pragma unroll
    for (int r = 0; r < 16; ++r) acc[m][r] = 0.f;
  __syncthreads();
  G_ISSUE(0, 0);
  const int xa = (r32 >> 1) & 7;
  const int aoff = r32 * 128, boff = 32768 + (32 * wv + r32) * 128;
  for (int kt = 0; kt < KT; ++kt) {
    asm volatile("s_waitcnt vmcnt(0)\n\ts_barrier" ::: "memory");
    if (kt + 1 < KT) G_ISSUE((kt + 1) & 1, kt + 1);
    const char* buf = lds + (kt & 1) * G2_STAGE;
    __builtin_amdgcn_s_setprio(1);
    bf16x8 fa[8], fb[4];
#pragma unroll
    for (int s = 0; s < 4; ++s) fb[s] = *(const bf16x8*)(buf + boff + (((2 * s + hi) ^ xa) << 4));
    { const int cb0 = (hi ^ xa) << 4;
#pragma unroll
      for (int m = 0; m < 8; ++m) fa[m] = *(const bf16x8*)(buf + aoff + 4096 * m + cb0); }
#pragma unroll
    for (int s = 0; s < 4; ++s) {
      const int cbn = ((2 * (s + 1) + hi) ^ xa) << 4;
#pragma unroll
      for (int m = 0; m < 8; ++m) { acc[m] = MFMA32(fa[m], fb[s], acc[m]); if (s < 3) fa[m] = *(const bf16x8*)(buf + aoff + 4096 * m + cbn); }
    }
    __builtin_amdgcn_s_setprio(0);
  }
#undef G_ISSUE
  __syncthreads();
}

__device__ __forceinline__ void xcd_unit(int u, int per, int& panel, int& sub) {
  if (gridDim.x == 256) { const int x = u & 7, k = ((u & 255) >> 3) + 32 * (u >> 8); panel = x + 8 * (k / per); sub = k % per; }
  else { panel = u / per; sub = u % per; }
}
__device__ void phase1b(const Args& a, char* lds) {
  unsigned char* ws = a.ws;
  const int tid = threadIdx.x, lane = tid & 63, wv = tid >> 6;
  const u16* KEYS = (const u16*)(ws + WS_KEYS); const u16* WPQB = (const u16*)(ws + WS_WPQ); u16* WST = (u16*)(ws + WS_WST);
  const float* modp = (const float*)(ws + WS_MODP); float* BIASP = (float*)(ws + WS_BIASP);
  char* gl = lds + LDS_DATA; float* Cl = (float*)gl;
  float* gsl = (float*)(gl + 131584);
  for (int u = blockIdx.x; u < 256; u += gridDim.x) {
    const int hh = u >> 4, nt = (u >> 2) & 3, b = u & 3;
    f32x16 acc[2][2];
    gemm_128x256(KEYS + (size_t)hh * 16384, 128, WPQB + (size_t)(nt * 256) * 2048 + hh * 128, 2048, 2, acc, gl);
    acc_to_lds(acc, Cl);
    for (int j = tid; j < 512; j += 512) {
      const int which = j >> 8, k = nt * 256 + (j & 255), m = (which ? 3072 : 4096) + k;
      float v = a.b_ada[m];
#pragma unroll
      for (int ks = 0; ks < 8; ++ks) v += modp[(ks * 4 + b) * 6144 + m];
      gsl[j] = which ? v : a.g_norm2[k] * (1.f + v);
    }
    __syncthreads();
    for (int i = 0; i < 16; ++i) {
      const int row = wv * 16 + i; const size_t n = (size_t)hh * 128 + row;
      float bp = 0.f, w[4];
#pragma unroll
      for (int j = 0; j < 4; ++j) { const float v = Cl[row * CLD + 4 * lane + j]; w[j] = v * gsl[4 * lane + j]; bp += v * gsl[256 + 4 * lane + j]; }
      *(uint2*)(WST + ((size_t)b * 2048 + n) * 1024 + nt * 256 + 4 * lane) = make_uint2(pack2(w[0], w[1]), pack2(w[2], w[3]));
      bp = wave_sum(bp);
      if (lane == 0) BIASP[((size_t)nt * 4 + b) * 2048 + n] = bp;
    }
    __syncthreads();
  }
}

__device__ void phase2(const Args& a, char* lds) {
  unsigned char* ws = a.ws;
  const int tid = threadIdx.x, lane = tid & 63, wv = tid >> 6;
  const u16* H = (const u16*)(ws + WS_H); const u16* WIN = (const u16*)(ws + WS_WIN);
  u16* QA = (u16*)(ws + WS_QA); u16* KV = (u16*)(ws + WS_KV); u16* UACT = (u16*)(ws + WS_UACT); u16* GVT = (u16*)(ws + WS_GVT);
  float* SSQV = (float*)(ws + WS_SSQV); const float* CS = (const float*)(ws + WS_CS);
  char* gl = lds + LDS_DATA; float* Cl = (float*)gl;
  for (int u = blockIdx.x; u < 128 * 6; u += gridDim.x) {
    int mt, nt; xcd_unit(u, 6, mt, nt); const int R0 = mt * 128;
    f32x16 acc[2][2];
    gemm_128x256(H + (size_t)R0 * 1024, 1024, WIN + (size_t)(nt * 256) * 1024, 1024, 16, acc, gl);
    acc_to_lds(acc, Cl);
    __syncthreads();
    if (nt == 0) {
      for (int i = 0; i < 16; ++i) {
        const int row = wv * 16 + i; float v[4], ssq = 0.f;
#pragma unroll
        for (int j = 0; j < 4; ++j) { v[j] = Cl[row * CLD + lane + 64 * j]; ssq += v[j] * v[j]; }
        ssq = wave_sum(ssq);
        const float rstd = rsqrtf(ssq * (1.f / 256.f) + EPS);
#pragma unroll
        for (int j = 0; j < 4; ++j) { const int col = lane + 64 * j; QA[(size_t)(R0 + row) * 256 + col] = f2bf(v[j] * rstd * a.g_q_a[col]); }
      }
    } else if (nt == 1) {
#pragma unroll 4
      for (int i = 0; i < 16; ++i) {
        const int row = wv * 16 + i, tok = R0 + row;
        const float v0 = Cl[row * CLD + lane], v1 = Cl[row * CLD + 64 + lane];
        const float ssq = wave_sum(v0 * v0 + v1 * v1);
        const float rstd = rsqrtf(ssq * (1.f / 128.f) + EPS);
        KV[(size_t)tok * 192 + lane] = f2bf(v0 * rstd * a.g_kv_a[lane]);
        KV[(size_t)tok * 192 + 64 + lane] = f2bf(v1 * rstd * a.g_kv_a[64 + lane]);
        if (lane < 32) {
          const float x1 = Cl[row * CLD + 128 + lane], x2 = Cl[row * CLD + 160 + lane];
          const float cs = CS[(size_t)tok * 64 + lane], sn = CS[(size_t)tok * 64 + 32 + lane];
          KV[(size_t)tok * 192 + 128 + lane] = f2bf(x1 * cs - x2 * sn);
          KV[(size_t)tok * 192 + 160 + lane] = f2bf(x2 * cs + x1 * sn);
        }
      }
    } else if (nt < 4) {
      for (int i = 0; i < 16; ++i) {
        const int row = wv * 16 + i;
#pragma unroll
        for (int j = 0; j < 4; ++j) { const int col = lane + 64 * j; UACT[(size_t)(R0 + row) * 512 + (nt - 2) * 256 + col] = f2bf(gelu_exact(Cl[row * CLD + col])); }
      }
    } else {
      for (int i = 0; i < 16; ++i) {
        const int row = wv * 16 + i; float ssq = 0.f;
#pragma unroll
        for (int j = 0; j < 4; ++j) { const int col = lane + 64 * j; const float g = gelu_exact(Cl[row * CLD + col]); const float gb = bflo((unsigned)f2bf(g)); ssq += gb * gb; Cl[row * CLD + col] = gb; }
        ssq = wave_sum(ssq);
        if (lane == 0) SSQV[(size_t)(R0 + row) * 2 + (nt - 4)] = ssq;
      }
      __syncthreads();
      for (int i = 0; i < 32; ++i) {
        const int c = wv * 32 + i;
        const float g0 = Cl[(2 * lane) * CLD + c], g1 = Cl[(2 * lane + 1) * CLD + c];
        *(unsigned*)(GVT + ((size_t)mt * 512 + (nt - 4) * 256 + c) * 128 + 2 * lane) = pack2(g0, g1);
      }
    }
    __syncthreads();
  }
}

__device__ void phase3(const Args& a, char* lds) {
  unsigned char* ws = a.ws;
  const int tid = threadIdx.x, lane = tid & 63, wv = tid >> 6, r32 = lane & 31, hi = lane >> 5;
  const u16* QA = (const u16*)(ws + WS_QA); const u16* WQ2 = (const u16*)(ws + WS_WQ2);
  u16* Q = (u16*)(ws + WS_Q); const float* CS = (const float*)(ws + WS_CS);
  const u16* UACT = (const u16*)(ws + WS_UACT); const u16* GVT = (const u16*)(ws + WS_GVT); const u16* WSG = (const u16*)(ws + WS_WSG);
  const float* SSQV = (const float*)(ws + WS_SSQV); u16* Y = (u16*)(ws + WS_Y);
  char* gl = lds + LDS_DATA; float* Cl = (float*)gl;
  for (int u = blockIdx.x; u < 384; u += gridDim.x) {
    {
      int mt, nt; xcd_unit(u, 3, mt, nt); const int R0 = mt * 128;
      f32x16 acc[2][2];
      gemm_128x256(QA + (size_t)R0 * 256, 256, WQ2 + (size_t)(nt * 256) * 256, 256, 4, acc, gl);
      acc_to_lds(acc, Cl);
      __syncthreads();
      if (nt < 2) {
        for (int i = 0; i < 16; ++i) {
          const int row = wv * 16 + i;
#pragma unroll
          for (int j = 0; j < 4; ++j) { const int n = nt * 256 + lane + 64 * j; Q[(size_t)(R0 + row) * 768 + (n >> 7) * 192 + (n & 127)] = f2bf(Cl[row * CLD + lane + 64 * j]); }
        }
      } else {
#pragma unroll 4
        for (int i = 0; i < 16; ++i) {
          const int row = wv * 16 + i, tok = R0 + row;
#pragma unroll
          for (int j = 0; j < 2; ++j) {
            const int idx = lane + 64 * j, h = idx >> 5, jj = idx & 31;
            const float x1 = Cl[row * CLD + h * 64 + jj], x2 = Cl[row * CLD + h * 64 + 32 + jj];
            const float cs = CS[(size_t)tok * 64 + jj], sn = CS[(size_t)tok * 64 + 32 + jj];
            Q[(size_t)tok * 768 + h * 192 + 128 + jj] = f2bf(x1 * cs - x2 * sn);
            Q[(size_t)tok * 768 + h * 192 + 160 + jj] = f2bf(x2 * cs + x1 * sn);
          }
        }
      }
      __syncthreads();
    }
  }
  for (int su = blockIdx.x; su < 256; su += gridDim.x) {
    {
      const int c = su >> 1, ph = su & 1;
      float* rs = (float*)gl;
      float* Yl = (float*)(gl + 512);
      __syncthreads();
      if (tid < 128) { const size_t t = (size_t)c * 128 + tid; rs[tid] = rsqrtf((SSQV[t * 2] + SSQV[t * 2 + 1]) * (1.f / 512.f) + EPS); }
      __syncthreads();
      const int h = wv >> 1, dh = wv & 1;
      f32x16 acc[2][2];
#pragma unroll
      for (int m = 0; m < 2; ++m)
#pragma unroll
        for (int n = 0; n < 2; ++n)
#pragma unroll
          for (int r = 0; r < 16; ++r) acc[m][n][r] = 0.f;
      for (int s = 0; s < 8; ++s) {
        const int q0 = 16 * s + 8 * hi;
        bf16x8 af[2], bfr[2];
#pragma unroll
        for (int m = 0; m < 2; ++m) af[m] = *(const bf16x8*)(WSG + ((size_t)h * 128 + ph * 64 + 32 * m + r32) * 128 + q0);
        float rq[8];
#pragma unroll
        for (int j = 0; j < 8; ++j) rq[j] = rs[q0 + j];
#pragma unroll
        for (int n = 0; n < 2; ++n) {
          const u32x4 w = *(const u32x4*)(GVT + ((size_t)c * 512 + h * 128 + dh * 64 + 32 * n + r32) * 128 + q0);
          u32x4 o;
#pragma unroll
          for (int k = 0; k < 4; ++k) o[k] = pack2(bflo(w[k]) * rq[2 * k], bfhi(w[k]) * rq[2 * k + 1]);
          bfr[n] = __builtin_bit_cast(bf16x8, o);
        }
#pragma unroll
        for (int m = 0; m < 2; ++m)
#pragma unroll
          for (int n = 0; n < 2; ++n) acc[m][n] = MFMA32(af[m], bfr[n], acc[m][n]);
      }
#pragma unroll
      for (int m = 0; m < 2; ++m)
#pragma unroll
        for (int n = 0; n < 2; ++n)
#pragma unroll
          for (int r = 0; r < 16; ++r) {
            const int pl = 32 * m + crow(r, hi), col = h * 128 + dh * 64 + 32 * n + r32;
            const size_t tok = (size_t)c * 128 + ph * 64 + pl;
            const float mix = acc[m][n][r] * a.g_sg[col] + a.b_sg[h * 128 + ph * 64 + pl];
            Yl[pl * 513 + col] = bflo((unsigned)UACT[tok * 512 + col]) * mix;
          }
      __syncthreads();
      for (int i = 0; i < 8; ++i) {
        const int pl = wv * 8 + i; const size_t tok = (size_t)c * 128 + ph * 64 + pl;
        float v[8], ssq = 0.f;
#pragma unroll
        for (int j = 0; j < 8; ++j) { v[j] = Yl[pl * 513 + lane + 64 * j]; ssq += v[j] * v[j]; }
        ssq = wave_sum(ssq);
        const float rstd = rsqrtf(ssq * (1.f / 512.f) + EPS);
#pragma unroll
        for (int j = 0; j < 8; ++j) { const int col = lane + 64 * j; Y[tok * 1024 + 512 + col] = f2bf(v[j] * rstd * a.g_sg_out[col]); }
      }
      __syncthreads();
    }
  }
}

constexpr float ATT_SCALE = 0.07216878364870322f;
constexpr float ATT_THR = 8.f;
constexpr int KVBUF = 24576;
#define SBAR() __builtin_amdgcn_sched_barrier(0)
__device__ __forceinline__ unsigned cvtpk(float lo, float hi) { unsigned r; asm volatile("v_cvt_pk_bf16_f32 %0, %1, %2" : "=v"(r) : "v"(lo), "v"(hi)); return r; }
__device__ __forceinline__ unsigned off_a(unsigned row, unsigned ch) { return 2048u * (row >> 3) + 512u * (ch >> 2) + 64u * (row & 7) + 16u * ((ch & 3) ^ ((row >> 2) & 3)); }

__device__ __forceinline__ void partialSM(f32x16& p0, f32x16& p1, float& m_reg, float& mn, float& alpha) {
  constexpr float C = ATT_SCALE * 1.4426950408889634f;
  float pmax = p0[0];
#pragma unroll
  for (int r = 1; r < 16; ++r) pmax = fmaxf(pmax, p0[r]);
#pragma unroll
  for (int r = 0; r < 16; ++r) pmax = fmaxf(pmax, p1[r]);
  { auto rr = __builtin_amdgcn_permlane32_swap(__float_as_uint(pmax), __float_as_uint(pmax), false, false);
    pmax = fmaxf(__uint_as_float(rr[0]), __uint_as_float(rr[1])); }
  if (__builtin_expect(__all(pmax - m_reg <= ATT_THR / ATT_SCALE), 1)) { mn = m_reg; alpha = 1.f; }
  else { mn = fmaxf(m_reg, pmax); alpha = __builtin_amdgcn_exp2f((m_reg - mn) * C); m_reg = mn; }
  const float mnC = -mn * C;
#pragma unroll
  for (int r = 0; r < 16; ++r) p0[r] = fmaf(p0[r], C, mnC);
#pragma unroll
  for (int r = 0; r < 16; ++r) p1[r] = fmaf(p1[r], C, mnC);
#pragma unroll
  for (int r = 0; r < 16; ++r) p0[r] = __builtin_amdgcn_exp2f(p0[r]);
}
__device__ __forceinline__ void finishSM(f32x16& p0, f32x16& p1, float alpha, float& l_reg, bf16x8& pa0, bf16x8& pa1, bf16x8& pa2, bf16x8& pa3) {
#pragma unroll
  for (int r = 0; r < 16; ++r) p1[r] = __builtin_amdgcn_exp2f(p1[r]);
  float ps = 0;
#pragma unroll
  for (int r = 0; r < 16; ++r) ps += p0[r];
#pragma unroll
  for (int r = 0; r < 16; ++r) ps += p1[r];
  { auto rr = __builtin_amdgcn_permlane32_swap(__float_as_uint(ps), __float_as_uint(ps), false, false);
    ps = __uint_as_float(rr[0]) + __uint_as_float(rr[1]); }
  l_reg = l_reg * alpha + ps;
#define PK4(P, BASE, OUT) do { unsigned a0 = cvtpk(P[BASE + 0], P[BASE + 1]), a1 = cvtpk(P[BASE + 2], P[BASE + 3]);   \
    unsigned b0 = cvtpk(P[BASE + 4], P[BASE + 5]), b1 = cvtpk(P[BASE + 6], P[BASE + 7]);                              \
    auto r0 = __builtin_amdgcn_permlane32_swap(a0, b0, false, false); auto r1 = __builtin_amdgcn_permlane32_swap(a1, b1, false, false); \
    u32x4 w = {r0[0], r1[0], r0[1], r1[1]}; OUT = __builtin_bit_cast(bf16x8, w); } while (0)
  PK4(p0, 0, pa0); PK4(p0, 8, pa1); PK4(p1, 0, pa2); PK4(p1, 8, pa3);
#undef PK4
}
__device__ __forceinline__ void qkt192(f32x16& p0, f32x16& p1, const char* kb, const char* qb, int ke, int ko, int kr) {
#pragma unroll
  for (int r = 0; r < 16; ++r) { p0[r] = 0.f; p1[r] = 0.f; }
#pragma unroll
  for (int d0 = 0; d0 < 8; ++d0) {
    const int o = ((d0 & 1) ? ko : ke) + 512 * (d0 >> 1);
    const bf16x8 b0 = *(const bf16x8*)(kb + o), b1 = *(const bf16x8*)(kb + o + 8192), q = *(const bf16x8*)(qb + 32 * d0);
    p0 = MFMA32(b0, q, p0); p1 = MFMA32(b1, q, p1);
  }
#pragma unroll
  for (int d1 = 0; d1 < 4; ++d1) {
    const int o = 16384 + (kr ^ (32 * d1));
    const bf16x8 b0 = *(const bf16x8*)(kb + o), b1 = *(const bf16x8*)(kb + o + 4096), q = *(const bf16x8*)(qb + 256 + 32 * d1);
    p0 = MFMA32(b0, q, p0); p1 = MFMA32(b1, q, p1);
  }
}
template <int OFF> __device__ __forceinline__ s16x4 tr_read(int vb) {
  s16x4 r; asm volatile("ds_read_b64_tr_b16 %0, %1 offset:%2" : "=&v"(r) : "v"(vb), "i"(OFF) : "memory"); return r;
}
template <int C> __device__ __forceinline__ void pv_one(f32x16& od, int vb0, int vb1, bf16x8 pa0, bf16x8 pa1, bf16x8 pa2, bf16x8 pa3) {
  const s16x4 l0 = tr_read<512 * C>(vb0), h0 = tr_read<512 * C>(vb1), l1 = tr_read<4096 + 512 * C>(vb0), h1 = tr_read<4096 + 512 * C>(vb1);
  const s16x4 l2 = tr_read<8192 + 512 * C>(vb0), h2 = tr_read<8192 + 512 * C>(vb1), l3 = tr_read<12288 + 512 * C>(vb0), h3 = tr_read<12288 + 512 * C>(vb1);
  asm volatile("s_waitcnt lgkmcnt(0)" ::: "memory"); SBAR();
#define PKV(L, H) (bf16x8){L[0], L[1], L[2], L[3], H[0], H[1], H[2], H[3]}
  od = MFMA32(pa0, PKV(l0, h0), od); od = MFMA32(pa1, PKV(l1, h1), od);
  od = MFMA32(pa2, PKV(l2, h2), od); od = MFMA32(pa3, PKV(l3, h3), od);
#undef PKV
}
__device__ __forceinline__ void pv_all(f32x16* o, int vb0, int vb1, bf16x8 pa0, bf16x8 pa1, bf16x8 pa2, bf16x8 pa3) {
  pv_one<0>(o[0], vb0, vb1, pa0, pa1, pa2, pa3); pv_one<1>(o[1], vb0, vb1, pa0, pa1, pa2, pa3);
  pv_one<2>(o[2], vb0, vb1, pa0, pa1, pa2, pa3); pv_one<3>(o[3], vb0, vb1, pa0, pa1, pa2, pa3);
}

__device__ void phase4(const Args& a, char* lds) {
  unsigned char* ws = a.ws;
  const int tid = threadIdx.x, wid = tid >> 6, lane = tid & 63, r32 = lane & 31, hi = lane >> 5;
  const u16* Qg = (const u16*)(ws + WS_Q); const u16* KVg = (const u16*)(ws + WS_KV); const u16* WUV = (const u16*)(ws + WS_WUV);
  u16* Y = (u16*)(ws + WS_Y);
  char* gl = lds + LDS_DATA;
  char* kvl = gl;
  float* wsl = (float*)(gl + 2 * KVBUF) + wid * 64; float* li_l = wsl; float* al_l = wsl + 32;
  float* Yl = (float*)gl;
  const int head = wid >> 1, qh = wid & 1;
  int sdst[3];
#pragma unroll
  for (int j = 0; j < 3; ++j) { const int id = tid + 512 * j, key = id / 24, ch = id % 24;
    sdst[j] = ch < 16 ? (int)off_a(key, ch) : 16384 + key * 128 + (((ch - 16) ^ ((key >> 1) & 7)) << 4); }
  const int xq = (r32 >> 2) & 3;
  const int ke = 2048 * (r32 >> 3) + 64 * (r32 & 7) + 16 * (hi ^ xq), ko = 2048 * (r32 >> 3) + 64 * (r32 & 7) + 16 * ((2 + hi) ^ xq);
  const int kr = r32 * 128 + ((hi ^ ((r32 >> 1) & 7)) << 4);
  const int tb = lane >> 4 & 1, tq = (lane & 15) >> 2, tp = lane & 3;
  const int vbl = 2048 * hi + 64 * tq + 32 * (tb ^ hi) + 8 * (tp & 1);
  const int lbase = (int)(uintptr_t)kvl;
  const int vb0 = lbase + vbl + 16 * (tp >> 1), vb1 = lbase + vbl + 256 + 16 * ((tp >> 1) ^ 1);
  for (int u = blockIdx.x; u < 256; u += gridDim.x) {
    const int b = u >> 6, qb_ = u & 63;
    const size_t tok0 = (size_t)b * SEQ + qb_ * 64 + qh * 32;
    const u16* KVb = KVg + (size_t)b * SEQ * 192;
    float m_reg = -1e30f, l_reg = 0.f; f32x16 o[4];
#pragma unroll
    for (int d = 0; d < 4; ++d)
#pragma unroll
      for (int r = 0; r < 16; ++r) o[d][r] = 0.f;
    char* Ql = gl + 2 * KVBUF + 2048;
    const char* qb = Ql + (qh * 32 + r32) * 1552 + (head * 192 + 8 * hi) * 2;
    u32x4 st0[3];
#define SLOAD(S, k0) do { const u16* _p = KVb + (size_t)(k0) * 192 + tid * 8; S[0] = *(const u32x4*)_p; S[1] = *(const u32x4*)(_p + 4096); S[2] = *(const u32x4*)(_p + 8192); } while (0)
#define SWRITE(bufi, S) do { char* _d = kvl + (bufi) * KVBUF; *(u32x4*)(_d + sdst[0]) = S[0]; *(u32x4*)(_d + sdst[1]) = S[1]; *(u32x4*)(_d + sdst[2]) = S[2]; } while (0)
#define RESC(al) do { if (__any((al) < 1.f)) { if (hi == 0) al_l[r32] = (al); asm volatile("s_waitcnt lgkmcnt(0)" ::: "memory"); \
    _Pragma("unroll") for (int d = 0; d < 4; ++d) _Pragma("unroll") for (int r = 0; r < 16; ++r) o[d][r] *= al_l[crow(r, hi)]; } } while (0)
#define CVT_LOAD(tile) const unsigned cit = ((unsigned)(u * 64 + (tile)) << 9) | (unsigned)tid; const bool cisv = cit >= 4194304u;                \
      const unsigned cio = cisv ? cit - 4194304u : cit; const float4 cf = *(const float4*)((cisv ? a.peer_v : a.peer_u) + (size_t)cio * 4)
#define CVT_STORE() do { const float csc = cisv ? PEER_SV : PEER_SU;                                                                               \
      int cp = __builtin_amdgcn_cvt_pk_fp8_f32(cf.x * csc, cf.y * csc, 0, false); cp = __builtin_amdgcn_cvt_pk_fp8_f32(cf.z * csc, cf.w * csc, cp, true); \
      *(int*)(ws + (cisv ? WS_VB : WS_UB) + (size_t)cio * 4) = cp; } while (0)
    constexpr int NT = SEQ / 64;
    f32x16 pA0, pA1, pB0, pB1; float mnA, mnB, alA, alB; bf16x8 pa0, pa1, pa2, pa3;
    __syncthreads();
    { const u16* Qu = Qg + ((size_t)b * SEQ + qb_ * 64) * 768; int tq_ = tid; asm volatile("" : "+v"(tq_));
#pragma unroll
      for (int i = 0; i < 12; ++i) { const int id = tq_ + 512 * i, row = id / 96, c = id % 96; *(u32x4*)(Ql + row * 1552 + c * 16) = *(const u32x4*)(Qu + (size_t)row * 768 + c * 8); } }
    SLOAD(st0, 0); SWRITE(0, st0); SLOAD(st0, 64); __syncthreads();
    { CVT_LOAD(0);
      qkt192(pA0, pA1, kvl, qb, ke, ko, kr); partialSM(pA0, pA1, m_reg, mnA, alA);
      SWRITE(1, st0); CVT_STORE(); }
    __syncthreads();
    for (int j = 1; j + 1 < NT; j += 2) {
      { CVT_LOAD(j);
        SBAR(); qkt192(pB0, pB1, kvl + KVBUF, qb, ke, ko, kr);
        finishSM(pA0, pA1, alA, l_reg, pa0, pa1, pa2, pa3); SBAR();
        SLOAD(st0, (j + 1) * 64); SBAR();
        pv_all(o, vb0, vb1, pa0, pa1, pa2, pa3); partialSM(pB0, pB1, m_reg, mnB, alB);
        __syncthreads(); SWRITE(0, st0); CVT_STORE();
        RESC(alB); __syncthreads(); }
      { CVT_LOAD(j + 1);
        SBAR(); qkt192(pA0, pA1, kvl, qb, ke, ko, kr);
        finishSM(pB0, pB1, alB, l_reg, pa0, pa1, pa2, pa3); SBAR();
        if (j + 2 < NT) SLOAD(st0, (j + 2) * 64); SBAR();
        pv_all(o, vb0 + KVBUF, vb1 + KVBUF, pa0, pa1, pa2, pa3); partialSM(pA0, pA1, m_reg, mnA, alA);
        __syncthreads(); if (j + 2 < NT) SWRITE(1, st0); CVT_STORE();
        RESC(alA); __syncthreads(); }
    }
    { CVT_LOAD(NT - 1);
      SBAR(); qkt192(pB0, pB1, kvl + KVBUF, qb, ke, ko, kr);
      finishSM(pA0, pA1, alA, l_reg, pa0, pa1, pa2, pa3); SBAR();
      pv_all(o, vb0, vb1, pa0, pa1, pa2, pa3); partialSM(pB0, pB1, m_reg, mnB, alB);
      CVT_STORE();
      __syncthreads(); RESC(alB);
      finishSM(pB0, pB1, alB, l_reg, pa0, pa1, pa2, pa3); SBAR();
      pv_all(o, vb0 + KVBUF, vb1 + KVBUF, pa0, pa1, pa2, pa3); }
    __syncthreads();
#undef SLOAD
#undef SWRITE
#undef RESC
#undef CVT_LOAD
#undef CVT_STORE
    int r32e = r32, hie = hi, lne = lane, wide = __builtin_amdgcn_readfirstlane(wid);
    asm volatile("" : "+v"(r32e), "+v"(hie), "+v"(lne), "+s"(wide));
    const int heade = wide >> 1, qhe = wide & 1;
    char* Ole = gl + 2 * KVBUF + 2048 + wide * 8704;
    if (hie == 0) li_l[r32e] = l_reg;
    asm volatile("s_waitcnt lgkmcnt(0)" ::: "memory");
#pragma unroll
    for (int r = 0; r < 16; ++r) {
      const int q = crow(r, hie); const float rl = __builtin_amdgcn_rcpf(li_l[q]);
#pragma unroll
      for (int d = 0; d < 4; ++d) *(u16*)(Ole + q * 272 + (32 * d + r32e) * 2) = f2bf(o[d][r] * rl);
    }
    asm volatile("s_waitcnt lgkmcnt(0)" ::: "memory");
    f32x16 y[4];
#pragma unroll
    for (int n = 0; n < 4; ++n)
#pragma unroll
      for (int r = 0; r < 16; ++r) y[n][r] = 0.f;
    const u16* wuv = WUV + ((size_t)heade * 128 + r32e) * 128 + 8 * hie;
#pragma unroll 2
    for (int s = 0; s < 8; ++s) {
      const bf16x8 af = *(const bf16x8*)(Ole + r32e * 272 + (16 * s + 8 * hie) * 2);
#pragma unroll
      for (int n = 0; n < 4; ++n) {
        const bf16x8 bw = *(const bf16x8*)(wuv + 32 * n * 128 + 16 * s);
        y[n] = MFMA32(af, bw, y[n]);
      }
    }
    __syncthreads();
#pragma unroll
    for (int n = 0; n < 4; ++n)
#pragma unroll
      for (int r = 0; r < 16; ++r) Yl[(qhe * 32 + crow(r, hie)) * 513 + heade * 128 + 32 * n + r32e] = y[n][r];
    __syncthreads();
    for (int i = 0; i < 8; ++i) {
      const int pl = wide * 8 + i; const size_t tok = (size_t)b * SEQ + qb_ * 64 + pl;
      float v[8], ssq = 0.f;
#pragma unroll
      for (int jj = 0; jj < 8; ++jj) { v[jj] = Yl[pl * 513 + lne + 64 * jj]; ssq += v[jj] * v[jj]; }
      ssq = wave_sum(ssq);
      const float rstd = rsqrtf(ssq * (1.f / 512.f) + EPS);
#pragma unroll
      for (int jj = 0; jj < 8; ++jj) { const int col = lne + 64 * jj; Y[tok * 1024 + col] = f2bf(v[jj] * rstd * a.g_attn_out[col]); }
    }
    __syncthreads();
  }
}

__device__ void phase5(const Args& a, char* lds) {
  unsigned char* ws = a.ws;
  const int tid = threadIdx.x, lane = tid & 63, wv = tid >> 6;
  const u16* Y = (const u16*)(ws + WS_Y); const u16* WO = (const u16*)(ws + WS_WO);
  float* X1 = (float*)(ws + WS_X1); float* SSQ = (float*)(ws + WS_SSQ); const float* mod = (const float*)(ws + WS_MOD);
  u16* X1B = (u16*)(ws + WS_H);
  char* gl = lds + LDS_DATA; float* Cl = (float*)gl;
  for (int u = blockIdx.x; u < 128 * 4; u += gridDim.x) {
    int mt, nt; xcd_unit(u, 4, mt, nt); const int R0 = mt * 128, b = R0 >> 12;
    f32x16 acc[2][2];
    gemm_128x256(Y + (size_t)R0 * 1024, 1024, WO + (size_t)(nt * 256) * 1024, 1024, 16, acc, gl);
    acc_to_lds(acc, Cl);
    __syncthreads();
    float2 g1[2];
#pragma unroll
    for (int j = 0; j < 2; ++j) g1[j] = *(const float2*)(mod + b * 6144 + 2048 + nt * 256 + 2 * lane + 128 * j);
    for (int i0 = 0; i0 < 16; i0 += 8) {
      float2 xv[8][2];
#pragma unroll
      for (int i = 0; i < 8; ++i)
#pragma unroll
        for (int j = 0; j < 2; ++j) xv[i][j] = *(const float2*)(a.x + (size_t)(R0 + wv * 16 + i0 + i) * 1024 + nt * 256 + 2 * lane + 128 * j);
#pragma unroll
      for (int i = 0; i < 8; ++i) {
        const int row = wv * 16 + i0 + i; const size_t tok = R0 + row; float ssq = 0.f;
#pragma unroll
        for (int j = 0; j < 2; ++j) {
          const int col = nt * 256 + 2 * lane + 128 * j;
          const float v0 = xv[i][j].x + g1[j].x * Cl[row * CLD + 2 * lane + 128 * j], v1 = xv[i][j].y + g1[j].y * Cl[row * CLD + 2 * lane + 128 * j + 1];
          *(unsigned*)(X1B + tok * 1024 + col) = pack2(v0, v1); ssq += v0 * v0 + v1 * v1;
        }
        ssq = wave_sum(ssq);
        if (lane == 0) SSQ[tok * 4 + nt] = ssq;
      }
    }
    __syncthreads();
  }
}
__device__ __forceinline__ float vmaxf(float a, float b) { float r; asm("v_max_f32 %0, %1, %2" : "=v"(r) : "v"(a), "v"(b)); return r; }
__device__ __forceinline__ float vminf(float a, float b) { float r; asm("v_min_f32 %0, %1, %2" : "=v"(r) : "v"(a), "v"(b)); return r; }
#define TK_CE(x, y) do { const float _h = vmaxf((x), (y)); (y) = vminf((x), (y)); (x) = _h; } while (0)
#define TK_SORT16(t) do { TK_CE(t[0], t[1]); TK_CE(t[2], t[3]); TK_CE(t[0], t[2]); TK_CE(t[1], t[3]); TK_CE(t[1], t[2]); TK_CE(t[4], t[5]); TK_CE(t[6], t[7]); TK_CE(t[4], t[6]); TK_CE(t[5], t[7]); TK_CE(t[5], t[6]); TK_CE(t[0], t[4]); TK_CE(t[2], t[6]); TK_CE(t[2], t[4]); TK_CE(t[1], t[5]); TK_CE(t[3], t[7]); TK_CE(t[3], t[5]); TK_CE(t[1], t[2]); TK_CE(t[3], t[4]); TK_CE(t[5], t[6]); TK_CE(t[8], t[9]); TK_CE(t[10], t[11]); TK_CE(t[8], t[10]); TK_CE(t[9], t[11]); TK_CE(t[9], t[10]); TK_CE(t[12], t[13]); TK_CE(t[14], t[15]); TK_CE(t[12], t[14]); TK_CE(t[13], t[15]); TK_CE(t[13], t[14]); TK_CE(t[8], t[12]); TK_CE(t[10], t[14]); TK_CE(t[10], t[12]); TK_CE(t[9], t[13]); TK_CE(t[11], t[15]); TK_CE(t[11], t[13]); TK_CE(t[9], t[10]); TK_CE(t[11], t[12]); TK_CE(t[13], t[14]); TK_CE(t[0], t[8]); TK_CE(t[4], t[12]); TK_CE(t[4], t[8]); TK_CE(t[2], t[10]); TK_CE(t[6], t[14]); TK_CE(t[6], t[10]); TK_CE(t[2], t[4]); TK_CE(t[6], t[8]); TK_CE(t[10], t[12]); TK_CE(t[1], t[9]); TK_CE(t[5], t[13]); TK_CE(t[5], t[9]); TK_CE(t[3], t[11]); TK_CE(t[7], t[15]); TK_CE(t[7], t[11]); TK_CE(t[3], t[5]); TK_CE(t[7], t[9]); TK_CE(t[11], t[13]); TK_CE(t[1], t[2]); TK_CE(t[3], t[4]); TK_CE(t[5], t[6]); TK_CE(t[7], t[8]); TK_CE(t[9], t[10]); TK_CE(t[11], t[12]); TK_CE(t[13], t[14]); } while (0)
#define TK_BMERGE16(t) do { TK_CE(t[0], t[8]); TK_CE(t[1], t[9]); TK_CE(t[2], t[10]); TK_CE(t[3], t[11]); TK_CE(t[4], t[12]); TK_CE(t[5], t[13]); TK_CE(t[6], t[14]); TK_CE(t[7], t[15]); TK_CE(t[0], t[4]); TK_CE(t[1], t[5]); TK_CE(t[2], t[6]); TK_CE(t[3], t[7]); TK_CE(t[8], t[12]); TK_CE(t[9], t[13]); TK_CE(t[10], t[14]); TK_CE(t[11], t[15]); TK_CE(t[0], t[2]); TK_CE(t[1], t[3]); TK_CE(t[4], t[6]); TK_CE(t[5], t[7]); TK_CE(t[8], t[10]); TK_CE(t[9], t[11]); TK_CE(t[12], t[14]); TK_CE(t[13], t[15]); TK_CE(t[0], t[1]); TK_CE(t[2], t[3]); TK_CE(t[4], t[5]); TK_CE(t[6], t[7]); TK_CE(t[8], t[9]); TK_CE(t[10], t[11]); TK_CE(t[12], t[13]); TK_CE(t[14], t[15]); } while (0)
#define TK_MERGE(A, B) do { _Pragma("unroll") for (int _i = 0; _i < 16; ++_i) A[_i] = vmaxf(A[_i], B[15 - _i]); TK_BMERGE16(A); } while (0)
__constant__ unsigned long long TK_I[4] = {0x0000000000000000ull, 0x0007744411111111ull, 0x0006655333322222ull, 0x00000000FEDCBA98ull};
__constant__ unsigned long long TK_J[4] = {0xFEDCBA9876543210ull, 0x0001021076543210ull, 0x0001010321043210ull, 0x0000000000000000ull};
__constant__ int TK_N[4] = {16, 13, 13, 8};

__device__ void phase6(const Args& a, char* lds) {
  unsigned char* ws = a.ws;
  const int tid = threadIdx.x, lane = tid & 63, wv = tid >> 6, r32 = lane & 31, hi = lane >> 5;
  const u16* H = (const u16*)(ws + WS_H); const u16* WST = (const u16*)(ws + WS_WST);
  float* TOPS = (float*)(ws + WS_TOPK);
  const float* BIASP = (const float*)(ws + WS_BIASP); const float* SSQ = (const float*)(ws + WS_SSQ);
  char* gl = lds + LDS_DATA;
  for (int u = blockIdx.x; u < 8 * 64; u += gridDim.x) {
    int tb, hd; xcd_unit(u, 8, tb, hd);
    const int b = tb >> 4;
    f32x16 sc[8];
    gemm_256x256_wide(WST + ((size_t)b * 2048 + hd * 256) * 1024, 1024, H + (size_t)tb * 256 * 1024, 1024, 16, sc, gl);
    float* bl = (float*)gl;
    if (tid < 256) bl[tid] = BIASP[((size_t)0 * 4 + b) * 2048 + hd * 256 + tid] + BIASP[((size_t)1 * 4 + b) * 2048 + hd * 256 + tid]
                           + BIASP[((size_t)2 * 4 + b) * 2048 + hd * 256 + tid] + BIASP[((size_t)3 * 4 + b) * 2048 + hd * 256 + tid];
    const float4 sq = *(const float4*)(SSQ + (size_t)(tb * 256 + 32 * wv + r32) * 4);
    const float rstd = rsqrtf((sq.x + sq.y + sq.z + sq.w) * (1.f / 1024.f) + EPS);
    __syncthreads();
#pragma unroll
    for (int half = 0; half < 2; ++half) {
      float g0[16], g1[16], g2[16], g3[16], p[16];
#pragma unroll
      for (int r = 0; r < 16; ++r) {
        const unsigned key = crow(r, hi);
        g0[r] = __uint_as_float((__float_as_uint(fmaf(sc[4 * half + 0][r], rstd, bl[128 * half + key])) & ~127u) | key);
        g1[r] = __uint_as_float((__float_as_uint(fmaf(sc[4 * half + 1][r], rstd, bl[128 * half + 32 + key])) & ~127u) | (32u + key));
        g2[r] = __uint_as_float((__float_as_uint(fmaf(sc[4 * half + 2][r], rstd, bl[128 * half + 64 + key])) & ~127u) | (64u + key));
        g3[r] = __uint_as_float((__float_as_uint(fmaf(sc[4 * half + 3][r], rstd, bl[128 * half + 96 + key])) & ~127u) | (96u + key));
      }
      TK_SORT16(g0); TK_SORT16(g1); TK_SORT16(g2); TK_SORT16(g3);
      TK_MERGE(g0, g1); TK_MERGE(g2, g3); TK_MERGE(g0, g2);
#pragma unroll
      for (int i = 0; i < 16; ++i) {
        auto rr = __builtin_amdgcn_permlane32_swap(__float_as_uint(g0[i]), __float_as_uint(g0[i]), false, false);
        p[i] = __uint_as_float(hi ? rr[0] : rr[1]);
      }
      TK_MERGE(g0, p);
      if (hi == 0) {
        float* dst = TOPS + ((size_t)(tb * 256 + 32 * wv + r32) * 16 + 2 * hd + half) * 16;
#pragma unroll
        for (int i = 0; i < 16; i += 4) *(float4*)(dst + i) = make_float4(g0[i], g0[i + 1], g0[i + 2], g0[i + 3]);
      }
    }
  }
}

typedef __attribute__((ext_vector_type(4))) float f32x4;
#define MFMA4(a, b, c) __builtin_amdgcn_mfma_f32_4x4x4bf16_1k((a), (b), (c), 0, 0, 0)
constexpr int P7_VROW = 2112, P7_VBUF = 4 * P7_VROW;
constexpr int P7_RING = 64;
constexpr int P7_ENT  = P7_RING + 8 * 2 * P7_VBUF;
constexpr int P7_CNT  = P7_ENT + 8 * 2048;
static_assert(P7_CNT + 8 * 256 <= LDS_BYTES, "phase 7 LDS map");
__device__ __forceinline__ float sel4(const f32x4& d, int k) { return k == 0 ? d[0] : (k == 1 ? d[1] : (k == 2 ? d[2] : d[3])); }
__device__ __forceinline__ unsigned fp8x2_bf16(unsigned x, float sc, bool hi) {
  return hi ? __builtin_bit_cast(unsigned, __builtin_amdgcn_cvt_scalef32_pk_bf16_fp8(x, sc, true)) : __builtin_bit_cast(unsigned, __builtin_amdgcn_cvt_scalef32_pk_bf16_fp8(x, sc, false));
}

__device__ void phase7(const Args& a, char* lds) {
  unsigned char* ws = a.ws;
  const int tid = threadIdx.x, lane = tid & 63, wv = __builtin_amdgcn_readfirstlane(tid >> 6), blk = lane >> 2, j4 = lane & 3;
  const u16* H = (const u16*)(ws + WS_H); const unsigned char* U8 = ws + WS_UB; const unsigned char* V8 = ws + WS_VB;
  const float* TOPS = (const float*)(ws + WS_TOPK); const float* X1 = (const float*)(ws + WS_X1); const float* mod = (const float*)(ws + WS_MOD);
  const float* SSQ = (const float*)(ws + WS_SSQ);
  const unsigned lbase = (unsigned)(uintptr_t)lds;
  char* ring = lds + P7_RING + wv * 2 * P7_VBUF;
  unsigned* ents = (unsigned*)(lds + P7_ENT + wv * 2048);
  int* cntw = (int*)(lds + P7_CNT + wv * 256);
  const int trb = (int)(lbase + P7_RING + wv * 2 * P7_VBUF) + ((lane & 15) >> 2) * P7_VROW + 32 * (lane >> 4) + 8 * (lane & 3);
  const int NWV = gridDim.x * 8;
  for (int qd = blockIdx.x * 8 + wv; qd < T / 4; qd += NWV) {
    const int tok0 = qd * 4, b = tok0 >> 12;
    float* TS = (float*)ring;
#pragma unroll
    for (int i = 0; i < 4; ++i) *(float4*)(TS + 256 * i + 4 * lane) = *(const float4*)(TOPS + (size_t)tok0 * 256 + 256 * i + 4 * lane);
    cntw[lane] = 0;
    asm volatile("s_waitcnt lgkmcnt(0)" ::: "memory");
    unsigned ec[8];
#pragma unroll
    for (int rd = 0; rd < 2; ++rd) {
      const int combo = (lane >> 2) + 16 * rd, tl = combo >> 3, hd = combo & 7, q = lane & 3;
      const float* t1 = TS + (tl * 16 + hd * 2) * 16; const float* t2 = t1 + 16;
      const unsigned long long ip = TK_I[q], jp = TK_J[q]; const int cn = TK_N[q];
      float L[16], P[16];
#pragma unroll
      for (int c = 0; c < 16; ++c) {
        const unsigned i = (unsigned)(ip >> (4 * c)) & 15u, j = (unsigned)(jp >> (4 * c)) & 15u;
        const float sm = t1[i] + t2[j];
        L[c] = c < cn ? __uint_as_float((__float_as_uint(sm) & ~255u) | (i << 4) | j) : -3.0e38f;
      }
      TK_SORT16(L);
#pragma unroll
      for (int c = 0; c < 16; ++c) P[c] = __uint_as_float(__builtin_amdgcn_update_dpp(0, __float_as_uint(L[c]), 0xB1, 0xf, 0xf, false));
      TK_MERGE(L, P);
#pragma unroll
      for (int c = 0; c < 16; ++c) P[c] = __uint_as_float(__builtin_amdgcn_update_dpp(0, __float_as_uint(L[c]), 0x4E, 0xf, 0xf, false));
      TK_MERGE(L, P);
      float sum = 0.f;
      const float m0 = __uint_as_float(__float_as_uint(L[0]) & ~255u);
#pragma unroll
      for (int c = 0; c < 16; ++c) sum += __expf(__uint_as_float(__float_as_uint(L[c]) & ~255u) - m0);
      const float inv = 1.f / sum;
#pragma unroll
      for (int r = 0; r < 4; ++r) {
        const float lv = q == 0 ? L[r] : (q == 1 ? L[4 + r] : (q == 2 ? L[8 + r] : L[12 + r]));
        const unsigned bits = __float_as_uint(lv), id = bits & 255u;
        const unsigned i1 = __float_as_uint(t1[id >> 4]) & 127u, i2 = __float_as_uint(t2[id & 15u]) & 127u;
        const float gate = __expf(__uint_as_float(bits & ~255u) - m0) * inv;
        ec[4 * rd + r] = (i1 * 128u + i2) | ((unsigned)tl << 14) | (pack2(0.f, gate) & 0xFFFF0000u);
      }
    }
    {
#pragma unroll
      for (int i = 0; i < 8; ++i) atomicAdd(&cntw[(ec[i] & 0x3FFFu) >> 8], 1);
      asm volatile("s_waitcnt lgkmcnt(0)" ::: "memory");
      const int c = cntw[lane]; int inc = c;
#pragma unroll
      for (int o = 1; o < 64; o <<= 1) { const int v = __shfl_up(inc, o, 64); if (lane >= o) inc += v; }
      asm volatile("s_waitcnt lgkmcnt(0)" ::: "memory");
      cntw[lane] = inc - c;
      asm volatile("s_waitcnt lgkmcnt(0)" ::: "memory");
#pragma unroll
      for (int i = 0; i < 8; ++i) { const int pos = atomicAdd(&cntw[(ec[i] & 0x3FFFu) >> 8], 1); ents[pos] = ec[i]; }
      asm volatile("s_waitcnt lgkmcnt(0)" ::: "memory");
    }
    u32x4 hA[4][2];
    { const float4 sq = *(const float4*)(SSQ + (size_t)(tok0 + j4) * 4);
      const float rstd = rsqrtf((sq.x + sq.y + sq.z + sq.w) * (1.f / 1024.f) + EPS);
#pragma unroll
      for (int i = 0; i < 4; ++i)
#pragma unroll
        for (int hf = 0; hf < 2; ++hf) {
          const int k0 = 256 * i + 16 * blk + 8 * hf;
          const u32x4 xb = *(const u32x4*)(H + (size_t)(tok0 + j4) * 1024 + k0);
          float hv[8];
#pragma unroll
          for (int e = 0; e < 8; e += 4) {
            const float4 g = *(const float4*)(a.g_norm2 + k0 + e), sc4 = *(const float4*)(mod + b * 6144 + 4096 + k0 + e), sh4 = *(const float4*)(mod + b * 6144 + 3072 + k0 + e);
            hv[e]     = bflo(xb[e >> 1]) * rstd * g.x * (1.f + sc4.x) + sh4.x;     hv[e + 1] = bfhi(xb[e >> 1]) * rstd * g.y * (1.f + sc4.y) + sh4.y;
            hv[e + 2] = bflo(xb[(e >> 1) + 1]) * rstd * g.z * (1.f + sc4.z) + sh4.z; hv[e + 3] = bfhi(xb[(e >> 1) + 1]) * rstd * g.w * (1.f + sc4.w) + sh4.w;
          }
          hA[i][hf] = (u32x4){pack2(hv[0], hv[1]), pack2(hv[2], hv[3]), pack2(hv[4], hv[5]), pack2(hv[6], hv[7])};
        } }
    f32x4 acc[16];
#pragma unroll
    for (int c = 0; c < 16; ++c) acc[c] = (f32x4){0.f, 0.f, 0.f, 0.f};
#define P7_VPHASE(bufi) do { const int _vb = trb + (bufi) * P7_VBUF;                                                            \
      { const s16x4 v0 = tr_read<0>(_vb), v1 = tr_read<128>(_vb), v2 = tr_read<256>(_vb), v3 = tr_read<384>(_vb),               \
                    v4 = tr_read<512>(_vb), v5 = tr_read<640>(_vb), v6 = tr_read<768>(_vb), v7 = tr_read<896>(_vb);               \
        asm volatile("s_waitcnt lgkmcnt(0)" ::: "memory"); SBAR();                                                                \
        acc[0] = MFMA4(awp, v0, acc[0]); acc[1] = MFMA4(awp, v1, acc[1]); acc[2] = MFMA4(awp, v2, acc[2]); acc[3] = MFMA4(awp, v3, acc[3]);   \
        acc[4] = MFMA4(awp, v4, acc[4]); acc[5] = MFMA4(awp, v5, acc[5]); acc[6] = MFMA4(awp, v6, acc[6]); acc[7] = MFMA4(awp, v7, acc[7]); } \
      { const s16x4 v0 = tr_read<1024>(_vb), v1 = tr_read<1152>(_vb), v2 = tr_read<1280>(_vb), v3 = tr_read<1408>(_vb),         \
                    v4 = tr_read<1536>(_vb), v5 = tr_read<1664>(_vb), v6 = tr_read<1792>(_vb), v7 = tr_read<1920>(_vb);           \
        asm volatile("s_waitcnt lgkmcnt(0)" ::: "memory"); SBAR();                                                                \
        acc[8] = MFMA4(awp, v0, acc[8]); acc[9] = MFMA4(awp, v1, acc[9]); acc[10] = MFMA4(awp, v2, acc[10]); acc[11] = MFMA4(awp, v3, acc[11]); \
        acc[12] = MFMA4(awp, v4, acc[12]); acc[13] = MFMA4(awp, v5, acc[13]); acc[14] = MFMA4(awp, v6, acc[14]); acc[15] = MFMA4(awp, v7, acc[15]); } } while (0)
    u32x4 u8[4], v8[4];
#define P7_LOADG(EN) do { const unsigned _ex = (EN) & 0x3FFFu; const unsigned char* _pu = U8 + (size_t)_ex * 1024 + 16 * blk;      \
      _Pragma("unroll") for (int _i = 0; _i < 4; ++_i) u8[_i] = *(const u32x4*)(_pu + 256 * _i);                                 \
      _Pragma("unroll") for (int _q = 0; _q < 4; ++_q) { const unsigned _eq = (unsigned)__builtin_amdgcn_readlane((int)_ex, _q);  \
        v8[_q] = *(const u32x4*)(V8 + (size_t)_eq * 1024 + 16 * lane); } } while (0)
    unsigned enc = ents[j4], enn = ents[4 + j4];
    P7_LOADG(enc);
    s16x4 awp = {0, 0, 0, 0};
    constexpr int NG = 128;
#pragma unroll 2
    for (int g = 0; g < NG; ++g) {
      if (g > 0) P7_VPHASE((g - 1) & 1);
      f32x4 d0 = {0.f, 0.f, 0.f, 0.f}, d1 = {0.f, 0.f, 0.f, 0.f};
#pragma unroll
      for (int i = 0; i < 4; ++i)
#pragma unroll
        for (int w = 0; w < 4; ++w) {
          const uint2 ub = {fp8x2_bf16(u8[i][w], 1.f / PEER_SU, false), fp8x2_bf16(u8[i][w], 1.f / PEER_SU, true)};
          const uint2 ha = {hA[i][w >> 1][2 * (w & 1)], hA[i][w >> 1][2 * (w & 1) + 1]};
          if (w & 1) d1 = MFMA4(__builtin_bit_cast(s16x4, ha), __builtin_bit_cast(s16x4, ub), d1);
          else       d0 = MFMA4(__builtin_bit_cast(s16x4, ha), __builtin_bit_cast(s16x4, ub), d0);
        }
      { char* vw = ring + (g & 1) * P7_VBUF + lane * 32;
#pragma unroll
        for (int q = 0; q < 4; ++q) {
          u32x4 o0, o1;
          o0[0] = fp8x2_bf16(v8[q][0], 1.f / PEER_SV, false); o0[1] = fp8x2_bf16(v8[q][0], 1.f / PEER_SV, true);
          o0[2] = fp8x2_bf16(v8[q][1], 1.f / PEER_SV, false); o0[3] = fp8x2_bf16(v8[q][1], 1.f / PEER_SV, true);
          o1[0] = fp8x2_bf16(v8[q][2], 1.f / PEER_SV, false); o1[1] = fp8x2_bf16(v8[q][2], 1.f / PEER_SV, true);
          o1[2] = fp8x2_bf16(v8[q][3], 1.f / PEER_SV, false); o1[3] = fp8x2_bf16(v8[q][3], 1.f / PEER_SV, true);
          *(u32x4*)(vw + q * P7_VROW) = o0; *(u32x4*)(vw + q * P7_VROW + 16) = o1;
        } }
      unsigned en2 = 0u;
      if (g + 1 < NG) { P7_LOADG(enn); if (g + 2 < NG) en2 = ents[4 * (g + 2) + j4]; }
      const int tk = (enc >> 14) & 3;
      float av = sel4(d0, tk) + sel4(d1, tk);
      av += __uint_as_float(__builtin_amdgcn_update_dpp(0, __float_as_uint(av), 0x124, 0xf, 0xf, false));
      av += __uint_as_float(__builtin_amdgcn_update_dpp(0, __float_as_uint(av), 0x128, 0xf, 0xf, false));
      av += __shfl_xor(av, 16, 64);
      { auto rr = __builtin_amdgcn_permlane32_swap(__float_as_uint(av), __float_as_uint(av), false, false); av = __uint_as_float(rr[0]) + __uint_as_float(rr[1]); }
      const float wgt = gelu_exact(av) * __uint_as_float(enc & 0xFFFF0000u);
      float z[4];
#define P7_QB(x, k) __builtin_amdgcn_update_dpp(0, (x), (k) * 0x55, 0xf, 0xf, false)
      { const unsigned wb = __float_as_uint(wgt), tb = (unsigned)tk;
        unsigned w0 = P7_QB(wb, 0), w1 = P7_QB(wb, 1), w2 = P7_QB(wb, 2), w3 = P7_QB(wb, 3);
        unsigned t0 = P7_QB(tb, 0), t1 = P7_QB(tb, 1), t2 = P7_QB(tb, 2), t3 = P7_QB(tb, 3);
        asm volatile("" : "+v"(w0), "+v"(w1), "+v"(w2), "+v"(w3), "+v"(t0), "+v"(t1), "+v"(t2), "+v"(t3));
        z[0] = ((int)t0 == j4) ? __uint_as_float(w0) : 0.f; z[1] = ((int)t1 == j4) ? __uint_as_float(w1) : 0.f;
        z[2] = ((int)t2 == j4) ? __uint_as_float(w2) : 0.f; z[3] = ((int)t3 == j4) ? __uint_as_float(w3) : 0.f; }
#undef P7_QB
      { const uint2 pk = {pack2(z[0], z[1]), pack2(z[2], z[3])}; awp = __builtin_bit_cast(s16x4, pk); }
      enc = enn; enn = en2;
    }
#undef P7_LOADG
    P7_VPHASE((NG - 1) & 1);
#undef P7_VPHASE
    int lne = lane; asm volatile("" : "+v"(lne));
    float ss[4] = {0.f, 0.f, 0.f, 0.f};
#pragma unroll
    for (int c = 0; c < 16; ++c) {
      const float g2 = mod[b * 6144 + 5120 + 64 * c + lne];
#pragma unroll
      for (int r = 0; r < 4; ++r) { const float v = bflo((unsigned)H[(size_t)(tok0 + r) * 1024 + 64 * c + lne]) + g2 * acc[c][r]; acc[c][r] = v; ss[r] += v * v; }
    }
    float rstd[4];
#pragma unroll
    for (int r = 0; r < 4; ++r) rstd[r] = rsqrtf(wave_sum(ss[r]) * (1.f / 1024.f) + EPS);
#pragma unroll
    for (int c = 0; c < 16; ++c) {
      const float gf = a.g_final[64 * c + lne];
#pragma unroll
      for (int r = 0; r < 4; ++r) a.out[(size_t)(tok0 + r) * 1024 + 64 * c + lne] = acc[c][r] * rstd[r] * gf;
    }
  }
}

constexpr int N_PHASES = 8;
__global__ void __launch_bounds__(512, 2) fwd(Args args) {
  extern __shared__ __attribute__((aligned(16))) char lds[];
  if (threadIdx.x == 0) *(uint4*)lds = make_uint4(0u, 0u, 0u, 0u);
  __syncthreads();
  const int lo = args.ph_lo, hi = args.ph_hi;
  XcdBarrier bar; bar.bar = (unsigned*)(args.ws + WS_BAR); bar.x = 0; bar.st = (volatile LAS unsigned*)lds;
  if (hi - lo > 1) bar = xcd_barrier_post((unsigned*)(args.ws + WS_BAR), (volatile LAS unsigned*)lds);
#ifndef ONLY_PHASE
#define ONLY_PHASE -1
#endif
#define IN(k) (lo <= (k) && (k) < hi && (ONLY_PHASE < 0 || ONLY_PHASE == (k)))
#define SEAM(k) do { if (IN(k) && IN((k) + 1)) xcd_barrier(bar); } while (0)
  if (IN(0)) phase0(args, lds);
  SEAM(0);
  if (IN(1)) { phase1(args, lds); phase1b(args, lds); }
  SEAM(1);
  if (IN(2)) phase2(args, lds);
  SEAM(2);
  if (IN(3)) phase3(args, lds);
  SEAM(3);
  if (IN(4)) phase4(args, lds);
  SEAM(4);
  if (IN(5)) phase5(args, lds);
  SEAM(5);
  if (IN(6)) phase6(args, lds);
  SEAM(6);
  if (IN(7)) phase7(args, lds);
#undef IN
#undef SEAM
}

extern "C" void kernel_launch(void* const* d_in, const int* in_sizes, int n_in, void* d_out, int out_size, void* d_ws, size_t ws_size, hipStream_t stream) {
  static int grid = 0;
  if (grid == 0) {
    if (n_in != 23 || out_size != T * DM || ws_size < WS_END) { fprintf(stderr, "kernel_launch: unexpected shapes (n_in %d out %d ws %zu need %zu)\n", n_in, out_size, ws_size, (size_t)WS_END); grid = -1; return; }
    int dev = 0, cus = 0, per_cu = 0;
    (void)hipGetDevice(&dev); (void)hipDeviceGetAttribute(&cus, hipDeviceAttributeMultiprocessorCount, dev);
    if (hipFuncSetAttribute((const void*)fwd, hipFuncAttributeMaxDynamicSharedMemorySize, LDS_BYTES) != hipSuccess) { fprintf(stderr, "kernel_launch: hipFuncSetAttribute failed\n"); grid = -1; return; }
    if (hipOccupancyMaxActiveBlocksPerMultiprocessor(&per_cu, (const void*)fwd, 512, LDS_BYTES) != hipSuccess || per_cu < 1) { fprintf(stderr, "kernel_launch: occupancy query says %d\n", per_cu); per_cu = 1; }
    (void)hipGetLastError();
    grid = cus;
  }
  if (grid < 0) return;
  (void)hipMemsetAsync((char*)d_ws + WS_BAR, 0, 16384, stream);
  Args a{};
  a.x = (const float*)d_in[0]; a.c = (const float*)d_in[1]; a.pos = (const int*)d_in[2];
  a.w_ada = (const float*)d_in[3]; a.b_ada = (const float*)d_in[4]; a.g_norm1 = (const float*)d_in[5]; a.w_in = (const float*)d_in[6];
  a.g_q_a = (const float*)d_in[7]; a.w_uq = (const float*)d_in[8]; a.g_kv_a = (const float*)d_in[9]; a.w_ukv = (const float*)d_in[10];
  a.g_sg = (const float*)d_in[11]; a.w_sg = (const float*)d_in[12]; a.b_sg = (const float*)d_in[13]; a.g_attn_out = (const float*)d_in[14];
  a.g_sg_out = (const float*)d_in[15]; a.w_o = (const float*)d_in[16]; a.g_norm2 = (const float*)d_in[17]; a.w_peer_q = (const float*)d_in[18];
  a.peer_keys = (const float*)d_in[19]; a.peer_u = (const float*)d_in[20]; a.peer_v = (const float*)d_in[21]; a.g_final = (const float*)d_in[22];
  a.out = (float*)d_out; a.ws = (unsigned char*)d_ws;
#if N_LAUNCH_MODE == 0
  a.ph_lo = 0; a.ph_hi = N_PHASES;
  hipLaunchKernelGGL(fwd, dim3(grid), dim3(512), LDS_BYTES, stream, a);
#else
  for (int p = 0; p < N_PHASES; ++p) for (int rep = 0; rep <= ((DUP_MASK >> p) & 1); ++rep) { a.ph_lo = p; a.ph_hi = p + 1; hipLaunchKernelGGL(fwd, dim3(grid), dim3(512), LDS_BYTES, stream, a); }
#endif
  const hipError_t le = hipPeekAtLastError();
  if (le != hipSuccess) fprintf(stderr, "kernel_launch: launch failed: %s\n", hipGetErrorName(le));
}
```

```cpp
#include <hip/hip_runtime.h>
#include <stdint.h>
#include <stdio.h>

#define N_LAUNCH_MODE 0
#define DUP_MASK 0x000

typedef unsigned short u16;
typedef __attribute__((ext_vector_type(8))) short bf16x8;
typedef __attribute__((ext_vector_type(4))) short s16x4;
typedef __attribute__((ext_vector_type(16))) float f32x16;
typedef __attribute__((ext_vector_type(4))) unsigned u32x4;

constexpr int T = 16384, DM = 1024, SEQ = 4096;
constexpr float EPS = 1e-6f;

constexpr size_t WS_BAR  = 0;
constexpr int ADA_KS = 16;
constexpr size_t WS_MODP = 16384;
constexpr size_t WS_MOD  = WS_MODP + (size_t)ADA_KS * 4 * 6144 * 4;
constexpr size_t WS_CS   = WS_MOD + 98304;
constexpr size_t WS_WIN  = WS_CS + 4194304;
constexpr size_t WS_WQ2  = WS_WIN + 3145728;
constexpr size_t WS_WUV  = WS_WQ2 + 393216;
constexpr size_t WS_WO   = WS_WUV + 131072;
constexpr size_t WS_WPQ  = WS_WO + 2097152;
constexpr size_t WS_KEYS = WS_WPQ + 4194304;
constexpr size_t WS_WSG  = WS_KEYS + 524288;
constexpr size_t WS_UB   = WS_WSG + 131072;
constexpr size_t WS_VB   = WS_UB + 33554432;
constexpr size_t WS_H    = WS_VB + 33554432;
constexpr size_t WS_Y    = WS_H + 33554432;
constexpr size_t WS_KV   = WS_Y + 33554432;
constexpr size_t WS_TOPK = WS_KV + 6291456;
constexpr size_t WS_SSQ  = WS_TOPK + 16777216;
constexpr size_t WS_SSQV = WS_SSQ + 262144;
constexpr size_t WS_R1   = WS_SSQV + 131072;
constexpr size_t WS_Q    = WS_R1;
constexpr size_t WS_QA   = WS_Q + 25165824;
constexpr size_t WS_UACT = WS_QA + 8388608;
constexpr size_t WS_GVT  = WS_UACT + 16777216;
constexpr size_t WS_X1   = WS_R1;
constexpr size_t WS_WST  = WS_R1 + 67108864;
constexpr size_t WS_BIASP = WS_WST + 4 * 4194304;
constexpr size_t WS_END  = WS_BIASP + 131072;

constexpr int LDS_BYTES = 155648;
constexpr int LDS_DATA  = 64;

struct Args {
  const float *x, *c; const int* pos;
  const float *w_ada, *b_ada, *g_norm1, *w_in, *g_q_a, *w_uq, *g_kv_a, *w_ukv, *g_sg, *w_sg, *b_sg, *g_attn_out, *g_sg_out,
              *w_o, *g_norm2, *w_peer_q, *peer_keys, *peer_u, *peer_v, *g_final;
  float* out; unsigned char* ws; int ph_lo, ph_hi;
};

#define XB_TMO      128
#define XB_XCNT(j)  (256  + 64 * (j))
#define XB_XSUB(j)  (1280 + 64 * (j))
#define XB_XGEN(j)  (2304 + 64 * (j))
#define XB_TOP      3328
#define XB_TOPGEN   3392
#define XCD_BAR_WORDS 3456
#define XB_SPIN_CAP (1u << 18)
#define LAS __attribute__((address_space(3)))

__device__ __forceinline__ unsigned xb_ld(unsigned* p)              { return __hip_atomic_load(p, __ATOMIC_RELAXED, __HIP_MEMORY_SCOPE_AGENT); }
__device__ __forceinline__ unsigned xb_add(unsigned* p, unsigned v) { return __hip_atomic_fetch_add(p, v, __ATOMIC_RELAXED, __HIP_MEMORY_SCOPE_AGENT); }
__device__ __forceinline__ unsigned xb_xcc_id() { return (unsigned)__builtin_amdgcn_s_getreg((3 << 11) | 20) & 0xFu; }
#define XB_SPIN(cond, bar) do { unsigned _sp = 0; while (cond) { __builtin_amdgcn_s_sleep(1); \
    if ((++_sp & 255u) == 0u) { if (xb_ld(&(bar)[XB_TMO])) break; if (_sp > XB_SPIN_CAP) { atomicAdd(&(bar)[XB_TMO], 1u); break; } } } } while (0)

struct XcdBarrier { unsigned* bar; unsigned x; volatile LAS unsigned* st; };

__device__ __forceinline__ XcdBarrier xcd_barrier_post(unsigned* bar, volatile LAS unsigned* st) {
    XcdBarrier b; b.bar = bar; b.x = xb_xcc_id(); b.st = st;
    if (threadIdx.x == 0) (void)xb_add(&bar[XB_XCNT(b.x)], 1u);
    return b;
}
__device__ __forceinline__ void xcd_barrier_complete(unsigned* bar, unsigned x, unsigned& nloc, unsigned& nx) {
    const unsigned G = gridDim.x * gridDim.y * gridDim.z;
    unsigned sum, cnt, mine, sp = 0u;
    for (;;) {
        sum = 0u; cnt = 0u; mine = 0u;
#pragma unroll
        for (unsigned j = 0; j < 16; ++j) { const unsigned c = xb_ld(&bar[XB_XCNT(j)]); sum += c; cnt += (c > 0u) ? 1u : 0u; mine = (j == x) ? c : mine; }
        if (sum == G) break;
        __builtin_amdgcn_s_sleep(1);
        if ((++sp & 255u) == 0u) { if (xb_ld(&bar[XB_TMO])) break; if (sp > XB_SPIN_CAP) { atomicAdd(&bar[XB_TMO], 1u); break; } }
    }
    nloc = mine > 0u ? mine : 1u; nx = cnt > 0u ? cnt : 1u;
}
__device__ __forceinline__ void xcd_barrier(const XcdBarrier& b) {
    asm volatile("s_waitcnt vmcnt(0)" ::: "memory");
    __syncthreads();
    if (threadIdx.x == 0) {
        unsigned* bar = b.bar;
        __builtin_amdgcn_s_waitcnt(0);
        unsigned nloc = b.st[0], nx = b.st[1];
        if (nloc == 0u) { xcd_barrier_complete(bar, b.x, nloc, nx); b.st[0] = nloc; b.st[1] = nx; }
        const unsigned old = xb_add(&bar[XB_XSUB(b.x)], 1u);
        const unsigned gen = old / nloc;
        if (old + 1u == (gen + 1u) * nloc) {
            __builtin_amdgcn_fence(__ATOMIC_RELEASE, "agent");
            asm volatile("s_waitcnt vmcnt(0)" ::: "memory");
            const unsigned og = xb_add(&bar[XB_TOP], 1u);
            const unsigned tg = og / nx;
            if (og + 1u == (tg + 1u) * nx) xb_add(&bar[XB_TOPGEN], 1u);
            else XB_SPIN(xb_ld(&bar[XB_TOPGEN]) == tg, bar);
            __builtin_amdgcn_fence(__ATOMIC_ACQUIRE, "agent");
            xb_add(&bar[XB_XGEN(b.x)], 1u);
            asm volatile("s_waitcnt vmcnt(0)" ::: "memory");
        } else {
            XB_SPIN(xb_ld(&bar[XB_XGEN(b.x)]) == gen, bar);
            __builtin_amdgcn_fence(__ATOMIC_ACQUIRE, "agent");
            asm volatile("s_waitcnt vmcnt(0)" ::: "memory");
        }
    }
    __syncthreads();
}

__device__ __forceinline__ unsigned pack2(float lo, float hi) {
  typedef __attribute__((ext_vector_type(2))) float f2; typedef __attribute__((ext_vector_type(2))) __bf16 b2;
  f2 v = {lo, hi}; b2 r = __builtin_convertvector(v, b2); return __builtin_bit_cast(unsigned, r);
}
__device__ __forceinline__ u16 f2bf(float f) { return (u16)(pack2(f, 0.f) & 0xFFFFu); }
__device__ __forceinline__ float bflo(unsigned w) { return __uint_as_float(w << 16); }
__device__ __forceinline__ float bfhi(unsigned w) { return __uint_as_float(w & 0xFFFF0000u); }
__device__ __forceinline__ float gelu_exact(float x) {
  const float z = fabsf(x) * 0.70710678118654752f;
  const float t = __builtin_amdgcn_rcpf(fmaf(0.3275911f, z, 1.f));
  float p = fmaf(1.061405429f, t, -1.453152027f); p = fmaf(p, t, 1.421413741f); p = fmaf(p, t, -0.284496736f); p = fmaf(p, t, 0.254829592f);
  const float e = p * t * __expf(-z * z);
  const float erfz = 1.f - e;
  return 0.5f * x * (1.f + copysignf(erfz, x));
}
__device__ __forceinline__ float wave_sum(float v) {
#pragma unroll
  for (int o = 32; o > 0; o >>= 1) v += __shfl_xor(v, o, 64);
  return v;
}
__device__ __forceinline__ int crow(int r, int hi) { return (r & 3) + 8 * (r >> 2) + 4 * hi; }
#define MFMA32(a, b, c) __builtin_amdgcn_mfma_f32_32x32x16_bf16((a), (b), (c), 0, 0, 0)

template <int MAP> __device__ __forceinline__ int colmap(int n) {
  if (MAP == 0) return n;
  if (MAP == 1) return n < 448 ? n : (n < 512 ? -1 : n - 64);
  if (MAP == 2) return (n >> 6) * 192 + 128 + (n & 63);
  return (n >> 7) * 256 + 128 + (n & 127);
}
template <int MAP> __device__ void cvt_transpose(const float* __restrict__ src, int src_ld, int K, int N, u16* __restrict__ dst, int gtid, int gthreads) {
  const int total = N * (K >> 3);
  for (int idx = gtid; idx < total; idx += gthreads) {
    const int n = idx % N, k8 = idx / N, sc = colmap<MAP>(n);
    float v[8];
#pragma unroll
    for (int j = 0; j < 8; ++j) v[j] = sc < 0 ? 0.f : src[(size_t)(k8 * 8 + j) * src_ld + sc];
    u32x4 w = {pack2(v[0], v[1]), pack2(v[2], v[3]), pack2(v[4], v[5]), pack2(v[6], v[7])};
    *(u32x4*)(dst + (size_t)n * K + k8 * 8) = w;
  }
}
template <int MAP> __device__ void cvt_transpose_tiled(const float* __restrict__ src, int src_ld, int K, int N, u16* __restrict__ dst, float* tile) {
  const int tid = threadIdx.x, tk = K >> 6, ntile = tk * (N >> 6);
  for (int t = blockIdx.x; t < ntile; t += gridDim.x) {
    const int k0 = (t % tk) * 64, n0 = (t / tk) * 64;
    __syncthreads();
    { const int nl = tid & 63, sc = colmap<MAP>(n0 + nl);
#pragma unroll
      for (int i = 0; i < 8; ++i) { const int k = (tid >> 6) + 8 * i; tile[k * 65 + nl] = sc < 0 ? 0.f : src[(size_t)(k0 + k) * src_ld + sc]; } }
    __syncthreads();
    { const int n = tid >> 3, kk = tid & 7; float v[8];
#pragma unroll
      for (int j = 0; j < 8; ++j) v[j] = tile[(8 * kk + j) * 65 + n];
      u32x4 w = {pack2(v[0], v[1]), pack2(v[2], v[3]), pack2(v[4], v[5]), pack2(v[6], v[7])};
      *(u32x4*)(dst + (size_t)(n0 + n) * K + k0 + 8 * kk) = w; }
  }
}
__device__ void cvt_direct(const float* __restrict__ src, u16* __restrict__ dst, size_t n8, int gtid, int gthreads) {
  for (size_t i = gtid; i < n8; i += gthreads) {
    const float4 a = *(const float4*)(src + i * 8), b = *(const float4*)(src + i * 8 + 4);
    u32x4 w = {pack2(a.x, a.y), pack2(a.z, a.w), pack2(b.x, b.y), pack2(b.z, b.w)};
    *(u32x4*)(dst + i * 8) = w;
  }
}
constexpr float PEER_SU = 32.f, PEER_SV = 4.f;
__device__ __forceinline__ void sincos_acc(float angf, float& sn, float& cs) {
  const double a = (double)angf;
  const double q = __builtin_rint(a * 0.63661977236758134308);
  double r = __builtin_fma(-q, 1.5707963267948966, a);
  r = __builtin_fma(-q, 6.123233995736766e-17, r);
  const double r2 = r * r;
  double s = r2 * (1.0 / 6227020800.0) - 1.0 / 39916800.0;
  s = s * r2 + 1.0 / 362880.0; s = s * r2 - 1.0 / 5040.0; s = s * r2 + 1.0 / 120.0; s = s * r2 - 1.0 / 6.0; s = r + r * r2 * s;
  double c = -r2 * (1.0 / 87178291200.0) + 1.0 / 479001600.0;
  c = c * r2 - 1.0 / 3628800.0; c = c * r2 + 1.0 / 40320.0; c = c * r2 - 1.0 / 720.0; c = c * r2 + 1.0 / 24.0; c = c * r2 - 0.5; c = 1.0 + r2 * c;
  const int n = ((int)q) & 3;
  const double ss = (n & 1) ? c : s, cc = (n & 1) ? s : c;
  sn = (float)((n & 2) ? -ss : ss);
  cs = (float)(((n + 1) & 2) ? -cc : cc);
}

__constant__ float INVF[32] = {1.000000000e+00f, 7.498942018e-01f, 5.623413324e-01f, 4.216965139e-01f, 3.162277639e-01f, 2.371373922e-01f, 1.778279394e-01f, 1.333521456e-01f,
  1.000000015e-01f, 7.498941571e-02f, 5.623412877e-02f, 4.216964915e-02f, 3.162277862e-02f, 2.371373586e-02f, 1.778279431e-02f, 1.333521493e-02f,
  9.999999776e-03f, 7.498942316e-03f, 5.623413250e-03f, 4.216964822e-03f, 3.162277862e-03f, 2.371373819e-03f, 1.778279431e-03f, 1.333521446e-03f,
  1.000000047e-03f, 7.498941850e-04f, 5.623413017e-04f, 4.216965463e-04f, 3.162277862e-04f, 2.371373848e-04f, 1.778279402e-04f, 1.333521504e-04f};
__device__ void phase0(const Args& a, char* lds) {
  unsigned char* ws = a.ws;
  const int tid = threadIdx.x, lane = tid & 63, wv = tid >> 6;
  const int NWV = gridDim.x * 8, gw = blockIdx.x * 8 + wv;
  const int gthreads = gridDim.x * 512, gtid = blockIdx.x * 512 + tid;
  float* modp = (float*)(ws + WS_MODP);
  for (int job = wv * gridDim.x + blockIdx.x; job < 96 * ADA_KS; job += NWV) {
    const int cg = job % 96, ks = job / 96, col = cg * 64 + lane;
    float a0 = 0.f, a1 = 0.f, a2 = 0.f, a3 = 0.f;
    const float* w = a.w_ada + (size_t)(ks * 64) * 6144 + col;
    float sv[4];
#pragma unroll
    for (int bb = 0; bb < 4; ++bb) { const float cv = a.c[bb * 1024 + ks * 64 + lane]; sv[bb] = cv / (1.f + __expf(-cv)); }
#pragma unroll 32
    for (int k = 0; k < 64; ++k) {
      const float wv_ = w[(size_t)k * 6144];
      a0 += __uint_as_float(__builtin_amdgcn_readlane(__float_as_uint(sv[0]), k)) * wv_;
      a1 += __uint_as_float(__builtin_amdgcn_readlane(__float_as_uint(sv[1]), k)) * wv_;
      a2 += __uint_as_float(__builtin_amdgcn_readlane(__float_as_uint(sv[2]), k)) * wv_;
      a3 += __uint_as_float(__builtin_amdgcn_readlane(__float_as_uint(sv[3]), k)) * wv_;
    }
    modp[(ks * 4 + 0) * 6144 + col] = a0; modp[(ks * 4 + 1) * 6144 + col] = a1;
    modp[(ks * 4 + 2) * 6144 + col] = a2; modp[(ks * 4 + 3) * 6144 + col] = a3;
  }
  { float* tile = (float*)(lds + LDS_DATA);
    cvt_transpose_tiled<1>(a.w_in, 1472, 1024, 1536, (u16*)(ws + WS_WIN), tile);
    cvt_transpose_tiled<0>(a.w_o, 1024, 1024, 1024, (u16*)(ws + WS_WO), tile);
    cvt_transpose_tiled<2>(a.w_uq, 768, 256, 256, (u16*)(ws + WS_WQ2) + 512 * 256, tile);
    cvt_transpose_tiled<3>(a.w_ukv, 1024, 128, 512, (u16*)(ws + WS_WUV), tile); }
  {
    u16* wq2 = (u16*)(ws + WS_WQ2);
    for (int idx = gtid; idx < 512 * 256; idx += gthreads) {
      const int n = idx >> 8, i = idx & 255, h = n >> 7, cc = n & 127;
      const float* pu = a.w_uq + (size_t)i * 768 + h * 192;
      const float* pk = a.w_ukv + (size_t)cc * 1024 + h * 256;
      float s = 0.f;
#pragma unroll 8
      for (int d = 0; d < 128; d += 4) {
        const float4 u = *(const float4*)(pu + d), k = *(const float4*)(pk + d);
        s += u.x * k.x + u.y * k.y + u.z * k.z + u.w * k.w;
      }
      wq2[(size_t)n * 256 + i] = f2bf(s);
    }
  }
  cvt_direct(a.peer_keys, (u16*)(ws + WS_KEYS), 262144 / 8, gtid, gthreads);
  cvt_direct(a.w_peer_q, (u16*)(ws + WS_WPQ), (size_t)1024 * 2048 / 8, gtid, gthreads);
  cvt_direct(a.w_sg, (u16*)(ws + WS_WSG), 65536 / 8, gtid, gthreads);
  {
    float* cs = (float*)(ws + WS_CS);
    for (int idx = gtid; idx < T * 32; idx += gthreads) {
      const int t = idx >> 5, i = idx & 31;
      const float inv = INVF[i];
      const float ang = (float)a.pos[t] * inv;
      float sn, c_; sincos_acc(ang, sn, c_);
      cs[(size_t)t * 64 + i] = c_; cs[(size_t)t * 64 + 32 + i] = sn;
    }
  }
}

__device__ void phase1(const Args& a, char* lds) {
  unsigned char* ws = a.ws;
  const int tid = threadIdx.x, lane = tid & 63, wv = tid >> 6;
  const float* modp = (const float*)(ws + WS_MODP);
  float* mod = (float*)(ws + WS_MOD);
  for (int idx = blockIdx.x * 512 + tid; idx < 4 * 6144; idx += gridDim.x * 512) {
    const int b = idx / 6144, m = idx % 6144;
    float s = a.b_ada[m];
#pragma unroll
    for (int ks = 0; ks < ADA_KS; ++ks) s += modp[(ks * 4 + b) * 6144 + m];
    mod[idx] = s;
  }
  float* sh = (float*)(lds + LDS_DATA);
  u16* H = (u16*)(ws + WS_H);
  for (int u = blockIdx.x; u < T / 64; u += gridDim.x) {
    const int b = u >> 6;
    __syncthreads();
    for (int j = tid; j < 2048; j += 512) {
      float s = a.b_ada[j];
#pragma unroll
      for (int ks = 0; ks < ADA_KS; ++ks) s += modp[(ks * 4 + b) * 6144 + j];
      sh[j] = s;
    }
    __syncthreads();
    for (int i0 = 0; i0 < 8; i0 += 4) {
      float4 xv[4][4];
#pragma unroll
      for (int i = 0; i < 4; ++i)
#pragma unroll
        for (int j = 0; j < 4; ++j) xv[i][j] = *(const float4*)(a.x + (size_t)(u * 64 + wv * 8 + i0 + i) * 1024 + j * 256 + lane * 4);
#pragma unroll
      for (int i = 0; i < 4; ++i) {
        const int r = u * 64 + wv * 8 + i0 + i;
        float ssq = 0.f;
#pragma unroll
        for (int j = 0; j < 4; ++j) ssq += xv[i][j].x * xv[i][j].x + xv[i][j].y * xv[i][j].y + xv[i][j].z * xv[i][j].z + xv[i][j].w * xv[i][j].w;
        ssq = wave_sum(ssq);
        const float rstd = rsqrtf(ssq * (1.f / 1024.f) + EPS);
#pragma unroll
        for (int j = 0; j < 4; ++j) {
          const int col = j * 256 + lane * 4;
          const float4 g = *(const float4*)(a.g_norm1 + col);
          const float h0 = xv[i][j].x * rstd * g.x * (1.f + sh[1024 + col]) + sh[col];
          const float h1 = xv[i][j].y * rstd * g.y * (1.f + sh[1024 + col + 1]) + sh[col + 1];
          const float h2 = xv[i][j].z * rstd * g.z * (1.f + sh[1024 + col + 2]) + sh[col + 2];
          const float h3 = xv[i][j].w * rstd * g.w * (1.f + sh[1024 + col + 3]) + sh[col + 3];
          uint2 o = {pack2(h0, h1), pack2(h2, h3)};
          *(uint2*)(H + (size_t)r * 1024 + col) = o;
        }
      }
    }
  }
}

constexpr int G_STAGE = 49152;
__device__ __forceinline__ void dma16(const void* gsrc, unsigned lds_dst) {
  unsigned keep;
  asm volatile("s_mov_b32 %0, m0\n\ts_mov_b32 m0, %2\n\ts_nop 0\n\tglobal_load_lds_dwordx4 %1, off\n\ts_mov_b32 m0, %0"
               : "=&s"(keep) : "v"(gsrc), "s"(lds_dst) : "memory");
}
__device__ __forceinline__ void gemm_128x256(const u16* __restrict__ A, int lda, const u16* __restrict__ Bt, int ldb, int KT,
                                             f32x16 (&acc)[2][2], char* lds) {
  const int tid = threadIdx.x, lane = tid & 63, wv = __builtin_amdgcn_readfirstlane(tid >> 6), r32 = lane & 31, hi = lane >> 5;
  const int wm = wv >> 2, wn = wv & 3;
  const int rin = lane >> 3, cc = lane & 7;
  const u16* pa[2]; const u16* pb[4];
#pragma unroll
  for (int j = 0; j < 2; ++j) pa[j] = A + (size_t)(16 * wv + 8 * j + rin) * lda + 8 * (cc ^ (4 * j + (rin >> 1)));
#pragma unroll
  for (int i = 0; i < 4; ++i) pb[i] = Bt + (size_t)(32 * wv + 8 * i + rin) * ldb + 8 * (cc ^ (4 * (i & 1) + (rin >> 1)));
  const unsigned lb = __builtin_amdgcn_readfirstlane((unsigned)(uintptr_t)lds);
  const unsigned dA = lb + 2048 * wv, dB = lb + 16384 + 4096 * wv;
#define G_ISSUE(stage, kt_) do { const unsigned _so = (unsigned)(stage) * G_STAGE; const int _ko = (kt_) * 64;                     \
    dma16(pa[0] + _ko, dA + _so); dma16(pa[1] + _ko, dA + _so + 1024);                                                           \
    dma16(pb[0] + _ko, dB + _so); dma16(pb[1] + _ko, dB + _so + 1024); dma16(pb[2] + _ko, dB + _so + 2048); dma16(pb[3] + _ko, dB + _so + 3072); } while (0)
#pragma unroll
  for (int m = 0; m < 2; ++m)
#pragma unroll
    for (int n = 0; n < 2; ++n)
#pragma unroll
      for (int r = 0; r < 16; ++r) acc[m][n][r] = 0.f;
  __syncthreads();
  G_ISSUE(0, 0);
  if (KT > 1) G_ISSUE(1, 1);
  const int xa = (r32 >> 1) & 7;
  const int aoff = (64 * wm + r32) * 128, boff = 16384 + (64 * wn + r32) * 128;
  int st = 0;
  for (int kt = 0; kt < KT; ++kt) {
    if (kt + 1 < KT) asm volatile("s_waitcnt vmcnt(6)\n\ts_barrier" ::: "memory");
    else             asm volatile("s_waitcnt vmcnt(0)\n\ts_barrier" ::: "memory");
    const int s2 = st == 0 ? 2 : st - 1;
    if (kt + 2 < KT && wv < 4) G_ISSUE(s2, kt + 2);
    const char* buf = lds + st * G_STAGE;
    __builtin_amdgcn_s_setprio(1);
    bf16x8 fa[2][2], fb[2][2];
#define G_LDF(S, SET) do { const int _cb = ((2 * (S) + hi) ^ xa) << 4;                                                      \
      fa[SET][0] = *(const bf16x8*)(buf + aoff + _cb); fa[SET][1] = *(const bf16x8*)(buf + aoff + 4096 + _cb);              \
      fb[SET][0] = *(const bf16x8*)(buf + boff + _cb); fb[SET][1] = *(const bf16x8*)(buf + boff + 4096 + _cb); } while (0)
#define G_MM(SET) do { acc[0][0] = MFMA32(fa[SET][0], fb[SET][0], acc[0][0]); acc[0][1] = MFMA32(fa[SET][0], fb[SET][1], acc[0][1]);   \
      acc[1][0] = MFMA32(fa[SET][1], fb[SET][0], acc[1][0]); acc[1][1] = MFMA32(fa[SET][1], fb[SET][1], acc[1][1]); } while (0)
    G_LDF(0, 0); __builtin_amdgcn_sched_barrier(0);
    G_LDF(1, 1); __builtin_amdgcn_sched_barrier(0); G_MM(0); __builtin_amdgcn_sched_barrier(0);
    G_LDF(2, 0); __builtin_amdgcn_sched_barrier(0); G_MM(1); __builtin_amdgcn_sched_barrier(0);
    G_LDF(3, 1); __builtin_amdgcn_sched_barrier(0); G_MM(0); __builtin_amdgcn_sched_barrier(0);
    G_MM(1);
#undef G_LDF
#undef G_MM
    __builtin_amdgcn_s_setprio(0);
    if (kt + 2 < KT && wv >= 4) G_ISSUE(s2, kt + 2);
    st = st == 2 ? 0 : st + 1;
  }
#undef G_ISSUE
  __syncthreads();
}
constexpr int CLD = 257;
__device__ __forceinline__ void acc_to_lds(const f32x16 (&acc)[2][2], float* Cl) {
  const int lane = threadIdx.x & 63, wv = threadIdx.x >> 6, r32 = lane & 31, hi = lane >> 5, wm = wv >> 2, wn = wv & 3;
#pragma unroll
  for (int m = 0; m < 2; ++m)
#pragma unroll
    for (int n = 0; n < 2; ++n)
#pragma unroll
      for (int r = 0; r < 16; ++r) Cl[(64 * wm + 32 * m + crow(r, hi)) * CLD + 64 * wn + 32 * n + r32] = acc[m][n][r];
}

constexpr int G2_STAGE = 65536;
__device__ __forceinline__ void gemm_256x256_wide(const u16* __restrict__ A, int lda, const u16* __restrict__ Bt, int ldb, int KT, f32x16 (&acc)[8], char* lds) {
  const int tid = threadIdx.x, lane = tid & 63, wv = __builtin_amdgcn_readfirstlane(tid >> 6), r32 = lane & 31, hi = lane >> 5;
  const int rin = lane >> 3, cc = lane & 7;
  const u16* pa[4]; const u16* pb[4];
#pragma unroll
  for (int i = 0; i < 4; ++i) {
    pa[i] = A + (size_t)(32 * wv + 8 * i + rin) * lda + 8 * (cc ^ (4 * (i & 1) + (rin >> 1)));
    pb[i] = Bt + (size_t)(32 * wv + 8 * i + rin) * ldb + 8 * (cc ^ (4 * (i & 1) + (rin >> 1)));
  }
  const unsigned lb = __builtin_amdgcn_readfirstlane((unsigned)(uintptr_t)lds);
  const unsigned dA = lb + 4096 * wv, dB = lb + 32768 + 4096 * wv;
#define G_ISSUE(stage, kt_) do { const unsigned _so = (unsigned)(stage) * G2_STAGE; const int _ko = (kt_) * 64;                    \
    dma16(pa[0] + _ko, dA + _so); dma16(pa[1] + _ko, dA + _so + 1024); dma16(pa[2] + _ko, dA + _so + 2048); dma16(pa[3] + _ko, dA + _so + 3072);   \
    dma16(pb[0] + _ko, dB + _so); dma16(pb[1] + _ko, dB + _so + 1024); dma16(pb[2] + _ko, dB + _so + 2048); dma16(pb[3] + _ko, dB + _so + 3072); } while (0)
#pragma unroll
  for (int m = 0; m < 8; ++m)
#pragma unroll
    for (int r = 0; r < 16; ++r) acc[m][r] = 0.f;
  __syncthreads();
  G_ISSUE(0, 0);
  const int xa = (r32 >> 1) & 7;
  const int aoff = r32 * 128, boff = 32768 + (32 * wv + r32) * 128;
  for (int kt = 0; kt < KT; ++kt) {
    asm volatile("s_waitcnt vmcnt(0)\n\ts_barrier" ::: "memory");
    if (kt + 1 < KT) G_ISSUE((kt + 1) & 1, kt + 1);
    const char* buf = lds + (kt & 1) * G2_STAGE;
    __builtin_amdgcn_s_setprio(1);
    bf16x8 fa[8], fb[4];
#pragma unroll
    for (int s = 0; s < 4; ++s) fb[s] = *(const bf16x8*)(buf + boff + (((2 * s + hi) ^ xa) << 4));
    { const int cb0 = (hi ^ xa) << 4;
#pragma unroll
      for (int m = 0; m < 8; ++m) fa[m] = *(const bf16x8*)(buf + aoff + 4096 * m + cb0); }
#pragma unroll
    for (int s = 0; s < 4; ++s) {
      const int cbn = ((2 * (s + 1) + hi) ^ xa) << 4;
#pragma unroll
      for (int m = 0; m < 8; ++m) { acc[m] = MFMA32(fa[m], fb[s], acc[m]); if (s < 3) fa[m] = *(const bf16x8*)(buf + aoff + 4096 * m + cbn); }
    }
    __builtin_amdgcn_s_setprio(0);
  }
#undef G_ISSUE
  __syncthreads();
}

__device__ __forceinline__ void xcd_unit(int u, int per, int& panel, int& sub) {
  if (gridDim.x == 256) { const int x = u & 7, k = ((u & 255) >> 3) + 32 * (u >> 8); panel = x + 8 * (k / per); sub = k % per; }
  else { panel = u / per; sub = u % per; }
}
__device__ void phase1b(const Args& a, char* lds) {
  unsigned char* ws = a.ws;
  const int tid = threadIdx.x, lane = tid & 63, wv = tid >> 6;
  const u16* KEYS = (const u16*)(ws + WS_KEYS); const u16* WPQB = (const u16*)(ws + WS_WPQ); u16* WST = (u16*)(ws + WS_WST);
  const float* modp = (const float*)(ws + WS_MODP); float* BIASP = (float*)(ws + WS_BIASP);
  char* gl = lds + LDS_DATA; float* Cl = (float*)gl;
  float* gsl = (float*)(gl + 131584);
  for (int u = blockIdx.x; u < 256; u += gridDim.x) {
    const int hh = u >> 4, nt = (u >> 2) & 3, b = u & 3;
    f32x16 acc[2][2];
    gemm_128x256(KEYS + (size_t)hh * 16384, 128, WPQB + (size_t)(nt * 256) * 2048 + hh * 128, 2048, 2, acc, gl);
    acc_to_lds(acc, Cl);
    for (int j = tid; j < 512; j += 512) {
      const int which = j >> 8, k = nt * 256 + (j & 255), m = (which ? 3072 : 4096) + k;
      float v = a.b_ada[m];
#pragma unroll
      for (int ks = 0; ks < ADA_KS; ++ks) v += modp[(ks * 4 + b) * 6144 + m];
      gsl[j] = which ? v : a.g_norm2[k] * (1.f + v);
    }
    __syncthreads();
    for (int i = 0; i < 16; ++i) {
      const int row = wv * 16 + i; const size_t n = (size_t)hh * 128 + row;
      float bp = 0.f, w[4];
#pragma unroll
      for (int j = 0; j < 4; ++j) { const float v = Cl[row * CLD + 4 * lane + j]; w[j] = v * gsl[4 * lane + j]; bp += v * gsl[256 + 4 * lane + j]; }
      *(uint2*)(WST + ((size_t)b * 2048 + n) * 1024 + nt * 256 + 4 * lane) = make_uint2(pack2(w[0], w[1]), pack2(w[2], w[3]));
      bp = wave_sum(bp);
      if (lane == 0) BIASP[((size_t)nt * 4 + b) * 2048 + n] = bp;
    }
    __syncthreads();
  }
}

__device__ void phase2(const Args& a, char* lds) {
  unsigned char* ws = a.ws;
  const int tid = threadIdx.x, lane = tid & 63, wv = tid >> 6;
  const u16* H = (const u16*)(ws + WS_H); const u16* WIN = (const u16*)(ws + WS_WIN);
  u16* QA = (u16*)(ws + WS_QA); u16* KV = (u16*)(ws + WS_KV); u16* UACT = (u16*)(ws + WS_UACT); u16* GVT = (u16*)(ws + WS_GVT);
  float* SSQV = (float*)(ws + WS_SSQV); const float* CS = (const float*)(ws + WS_CS);
  char* gl = lds + LDS_DATA; float* Cl = (float*)gl;
  for (int u = blockIdx.x; u < 128 * 6; u += gridDim.x) {
    int mt, nt; xcd_unit(u, 6, mt, nt); const int R0 = mt * 128;
    f32x16 acc[2][2];
    gemm_128x256(H + (size_t)R0 * 1024, 1024, WIN + (size_t)(nt * 256) * 1024, 1024, 16, acc, gl);
    acc_to_lds(acc, Cl);
    __syncthreads();
    if (nt == 0) {
      for (int i = 0; i < 16; ++i) {
        const int row = wv * 16 + i; float v[4], ssq = 0.f;
#pragma unroll
        for (int j = 0; j < 4; ++j) { v[j] = Cl[row * CLD + lane + 64 * j]; ssq += v[j] * v[j]; }
        ssq = wave_sum(ssq);
        const float rstd = rsqrtf(ssq * (1.f / 256.f) + EPS);
#pragma unroll
        for (int j = 0; j < 4; ++j) { const int col = lane + 64 * j; QA[(size_t)(R0 + row) * 256 + col] = f2bf(v[j] * rstd * a.g_q_a[col]); }
      }
    } else if (nt == 1) {
#pragma unroll 4
      for (int i = 0; i < 16; ++i) {
        const int row = wv * 16 + i, tok = R0 + row;
        const float v0 = Cl[row * CLD + lane], v1 = Cl[row * CLD + 64 + lane];
        const float ssq = wave_sum(v0 * v0 + v1 * v1);
        const float rstd = rsqrtf(ssq * (1.f / 128.f) + EPS);
        KV[(size_t)tok * 192 + lane] = f2bf(v0 * rstd * a.g_kv_a[lane]);
        KV[(size_t)tok * 192 + 64 + lane] = f2bf(v1 * rstd * a.g_kv_a[64 + lane]);
        if (lane < 32) {
          const float x1 = Cl[row * CLD + 128 + lane], x2 = Cl[row * CLD + 160 + lane];
          const float cs = CS[(size_t)tok * 64 + lane], sn = CS[(size_t)tok * 64 + 32 + lane];
          KV[(size_t)tok * 192 + 128 + lane] = f2bf(x1 * cs - x2 * sn);
          KV[(size_t)tok * 192 + 160 + lane] = f2bf(x2 * cs + x1 * sn);
        }
      }
    } else if (nt < 4) {
      for (int i = 0; i < 16; ++i) {
        const int row = wv * 16 + i;
#pragma unroll
        for (int j = 0; j < 4; ++j) { const int col = lane + 64 * j; UACT[(size_t)(R0 + row) * 512 + (nt - 2) * 256 + col] = f2bf(gelu_exact(Cl[row * CLD + col])); }
      }
    } else {
      for (int i = 0; i < 16; ++i) {
        const int row = wv * 16 + i; float ssq = 0.f;
#pragma unroll
        for (int j = 0; j < 4; ++j) { const int col = lane + 64 * j; const float g = gelu_exact(Cl[row * CLD + col]); const float gb = bflo((unsigned)f2bf(g)); ssq += gb * gb; Cl[row * CLD + col] = gb; }
        ssq = wave_sum(ssq);
        if (lane == 0) SSQV[(size_t)(R0 + row) * 2 + (nt - 4)] = ssq;
      }
      __syncthreads();
      for (int i = 0; i < 32; ++i) {
        const int c = wv * 32 + i;
        const float g0 = Cl[(2 * lane) * CLD + c], g1 = Cl[(2 * lane + 1) * CLD + c];
        *(unsigned*)(GVT + ((size_t)mt * 512 + (nt - 4) * 256 + c) * 128 + 2 * lane) = pack2(g0, g1);
      }
    }
    __syncthreads();
  }
}

__device__ void phase3(const Args& a, char* lds) {
  unsigned char* ws = a.ws;
  const int tid = threadIdx.x, lane = tid & 63, wv = tid >> 6, r32 = lane & 31, hi = lane >> 5;
  const u16* QA = (const u16*)(ws + WS_QA); const u16* WQ2 = (const u16*)(ws + WS_WQ2);
  u16* Q = (u16*)(ws + WS_Q); const float* CS = (const float*)(ws + WS_CS);
  const u16* UACT = (const u16*)(ws + WS_UACT); const u16* GVT = (const u16*)(ws + WS_GVT); const u16* WSG = (const u16*)(ws + WS_WSG);
  const float* SSQV = (const float*)(ws + WS_SSQV); u16* Y = (u16*)(ws + WS_Y);
  char* gl = lds + LDS_DATA; float* Cl = (float*)gl;
  for (int u = blockIdx.x; u < 384; u += gridDim.x) {
    {
      int mt, nt; xcd_unit(u, 3, mt, nt); const int R0 = mt * 128;
      f32x16 acc[2][2];
      gemm_128x256(QA + (size_t)R0 * 256, 256, WQ2 + (size_t)(nt * 256) * 256, 256, 4, acc, gl);
      acc_to_lds(acc, Cl);
      __syncthreads();
      if (nt < 2) {
        for (int i = 0; i < 16; ++i) {
          const int row = wv * 16 + i;
#pragma unroll
          for (int j = 0; j < 4; ++j) { const int n = nt * 256 + lane + 64 * j; Q[(size_t)(R0 + row) * 768 + (n >> 7) * 192 + (n & 127)] = f2bf(Cl[row * CLD + lane + 64 * j]); }
        }
      } else {
#pragma unroll 4
        for (int i = 0; i < 16; ++i) {
          const int row = wv * 16 + i, tok = R0 + row;
#pragma unroll
          for (int j = 0; j < 2; ++j) {
            const int idx = lane + 64 * j, h = idx >> 5, jj = idx & 31;
            const float x1 = Cl[row * CLD + h * 64 + jj], x2 = Cl[row * CLD + h * 64 + 32 + jj];
            const float cs = CS[(size_t)tok * 64 + jj], sn = CS[(size_t)tok * 64 + 32 + jj];
            Q[(size_t)tok * 768 + h * 192 + 128 + jj] = f2bf(x1 * cs - x2 * sn);
            Q[(size_t)tok * 768 + h * 192 + 160 + jj] = f2bf(x2 * cs + x1 * sn);
          }
        }
      }
      __syncthreads();
    }
  }
  for (int su = blockIdx.x; su < 256; su += gridDim.x) {
    {
      const int c = su >> 1, ph = su & 1;
      float* rs = (float*)gl;
      float* Yl = (float*)(gl + 512);
      __syncthreads();
      if (tid < 128) { const size_t t = (size_t)c * 128 + tid; rs[tid] = rsqrtf((SSQV[t * 2] + SSQV[t * 2 + 1]) * (1.f / 512.f) + EPS); }
      __syncthreads();
      const int h = wv >> 1, dh = wv & 1;
      f32x16 acc[2][2];
#pragma unroll
      for (int m = 0; m < 2; ++m)
#pragma unroll
        for (int n = 0; n < 2; ++n)
#pragma unroll
          for (int r = 0; r < 16; ++r) acc[m][n][r] = 0.f;
      for (int s = 0; s < 8; ++s) {
        const int q0 = 16 * s + 8 * hi;
        bf16x8 af[2], bfr[2];
#pragma unroll
        for (int m = 0; m < 2; ++m) af[m] = *(const bf16x8*)(WSG + ((size_t)h * 128 + ph * 64 + 32 * m + r32) * 128 + q0);
        float rq[8];
#pragma unroll
        for (int j = 0; j < 8; ++j) rq[j] = rs[q0 + j];
#pragma unroll
        for (int n = 0; n < 2; ++n) {
          const u32x4 w = *(const u32x4*)(GVT + ((size_t)c * 512 + h * 128 + dh * 64 + 32 * n + r32) * 128 + q0);
          u32x4 o;
#pragma unroll
          for (int k = 0; k < 4; ++k) o[k] = pack2(bflo(w[k]) * rq[2 * k], bfhi(w[k]) * rq[2 * k + 1]);
          bfr[n] = __builtin_bit_cast(bf16x8, o);
        }
#pragma unroll
        for (int m = 0; m < 2; ++m)
#pragma unroll
          for (int n = 0; n < 2; ++n) acc[m][n] = MFMA32(af[m], bfr[n], acc[m][n]);
      }
#pragma unroll
      for (int m = 0; m < 2; ++m)
#pragma unroll
        for (int n = 0; n < 2; ++n)
#pragma unroll
          for (int r = 0; r < 16; ++r) {
            const int pl = 32 * m + crow(r, hi), col = h * 128 + dh * 64 + 32 * n + r32;
            const size_t tok = (size_t)c * 128 + ph * 64 + pl;
            const float mix = acc[m][n][r] * a.g_sg[col] + a.b_sg[h * 128 + ph * 64 + pl];
            Yl[pl * 513 + col] = bflo((unsigned)UACT[tok * 512 + col]) * mix;
          }
      __syncthreads();
      for (int i = 0; i < 8; ++i) {
        const int pl = wv * 8 + i; const size_t tok = (size_t)c * 128 + ph * 64 + pl;
        float v[8], ssq = 0.f;
#pragma unroll
        for (int j = 0; j < 8; ++j) { v[j] = Yl[pl * 513 + lane + 64 * j]; ssq += v[j] * v[j]; }
        ssq = wave_sum(ssq);
        const float rstd = rsqrtf(ssq * (1.f / 512.f) + EPS);
#pragma unroll
        for (int j = 0; j < 8; ++j) { const int col = lane + 64 * j; Y[tok * 1024 + 512 + col] = f2bf(v[j] * rstd * a.g_sg_out[col]); }
      }
      __syncthreads();
    }
  }
}

constexpr float ATT_SCALE = 0.07216878364870322f;
constexpr float ATT_THR = 8.f;
constexpr int KVBUF = 24576;
#define SBAR() __builtin_amdgcn_sched_barrier(0)
__device__ __forceinline__ unsigned cvtpk(float lo, float hi) { unsigned r; asm volatile("v_cvt_pk_bf16_f32 %0, %1, %2" : "=v"(r) : "v"(lo), "v"(hi)); return r; }
__device__ __forceinline__ unsigned off_a(unsigned row, unsigned ch) { return 2048u * (row >> 3) + 512u * (ch >> 2) + 64u * (row & 7) + 16u * ((ch & 3) ^ ((row >> 2) & 3)); }

__device__ __forceinline__ void partialSM(f32x16& p0, f32x16& p1, float& m_reg, float& mn, float& alpha) {
  constexpr float C = ATT_SCALE * 1.4426950408889634f;
  float pmax = p0[0];
#pragma unroll
  for (int r = 1; r < 16; ++r) pmax = fmaxf(pmax, p0[r]);
#pragma unroll
  for (int r = 0; r < 16; ++r) pmax = fmaxf(pmax, p1[r]);
  { auto rr = __builtin_amdgcn_permlane32_swap(__float_as_uint(pmax), __float_as_uint(pmax), false, false);
    pmax = fmaxf(__uint_as_float(rr[0]), __uint_as_float(rr[1])); }
  if (__builtin_expect(__all(pmax - m_reg <= ATT_THR / ATT_SCALE), 1)) { mn = m_reg; alpha = 1.f; }
  else { mn = fmaxf(m_reg, pmax); alpha = __builtin_amdgcn_exp2f((m_reg - mn) * C); m_reg = mn; }
  const float mnC = -mn * C;
#pragma unroll
  for (int r = 0; r < 16; ++r) p0[r] = fmaf(p0[r], C, mnC);
#pragma unroll
  for (int r = 0; r < 16; ++r) p1[r] = fmaf(p1[r], C, mnC);
#pragma unroll
  for (int r = 0; r < 16; ++r) p0[r] = __builtin_amdgcn_exp2f(p0[r]);
}
__device__ __forceinline__ void finishSM(f32x16& p0, f32x16& p1, float alpha, float& l_reg, bf16x8& pa0, bf16x8& pa1, bf16x8& pa2, bf16x8& pa3) {
#pragma unroll
  for (int r = 0; r < 16; ++r) p1[r] = __builtin_amdgcn_exp2f(p1[r]);
  float ps = 0;
#pragma unroll
  for (int r = 0; r < 16; ++r) ps += p0[r];
#pragma unroll
  for (int r = 0; r < 16; ++r) ps += p1[r];
  { auto rr = __builtin_amdgcn_permlane32_swap(__float_as_uint(ps), __float_as_uint(ps), false, false);
    ps = __uint_as_float(rr[0]) + __uint_as_float(rr[1]); }
  l_reg = l_reg * alpha + ps;
#define PK4(P, BASE, OUT) do { unsigned a0 = cvtpk(P[BASE + 0], P[BASE + 1]), a1 = cvtpk(P[BASE + 2], P[BASE + 3]);   \
    unsigned b0 = cvtpk(P[BASE + 4], P[BASE + 5]), b1 = cvtpk(P[BASE + 6], P[BASE + 7]);                              \
    auto r0 = __builtin_amdgcn_permlane32_swap(a0, b0, false, false); auto r1 = __builtin_amdgcn_permlane32_swap(a1, b1, false, false); \
    u32x4 w = {r0[0], r1[0], r0[1], r1[1]}; OUT = __builtin_bit_cast(bf16x8, w); } while (0)
  PK4(p0, 0, pa0); PK4(p0, 8, pa1); PK4(p1, 0, pa2); PK4(p1, 8, pa3);
#undef PK4
}
__device__ __forceinline__ void qkt192(f32x16& p0, f32x16& p1, const char* kb, const char* qb, int ke, int ko, int kr) {
#pragma unroll
  for (int r = 0; r < 16; ++r) { p0[r] = 0.f; p1[r] = 0.f; }
#pragma unroll
  for (int d0 = 0; d0 < 8; ++d0) {
    const int o = ((d0 & 1) ? ko : ke) + 512 * (d0 >> 1);
    const bf16x8 b0 = *(const bf16x8*)(kb + o), b1 = *(const bf16x8*)(kb + o + 8192), q = *(const bf16x8*)(qb + 32 * d0);
    p0 = MFMA32(b0, q, p0); p1 = MFMA32(b1, q, p1);
  }
#pragma unroll
  for (int d1 = 0; d1 < 4; ++d1) {
    const int o = 16384 + (kr ^ (32 * d1));
    const bf16x8 b0 = *(const bf16x8*)(kb + o), b1 = *(const bf16x8*)(kb + o + 4096), q = *(const bf16x8*)(qb + 256 + 32 * d1);
    p0 = MFMA32(b0, q, p0); p1 = MFMA32(b1, q, p1);
  }
}
template <int OFF> __device__ __forceinline__ s16x4 tr_read(int vb) {
  s16x4 r; asm volatile("ds_read_b64_tr_b16 %0, %1 offset:%2" : "=&v"(r) : "v"(vb), "i"(OFF) : "memory"); return r;
}
template <int C> __device__ __forceinline__ void pv_one(f32x16& od, int vb0, int vb1, bf16x8 pa0, bf16x8 pa1, bf16x8 pa2, bf16x8 pa3) {
  const s16x4 l0 = tr_read<512 * C>(vb0), h0 = tr_read<512 * C>(vb1), l1 = tr_read<4096 + 512 * C>(vb0), h1 = tr_read<4096 + 512 * C>(vb1);
  const s16x4 l2 = tr_read<8192 + 512 * C>(vb0), h2 = tr_read<8192 + 512 * C>(vb1), l3 = tr_read<12288 + 512 * C>(vb0), h3 = tr_read<12288 + 512 * C>(vb1);
  asm volatile("s_waitcnt lgkmcnt(0)" ::: "memory"); SBAR();
#define PKV(L, H) (bf16x8){L[0], L[1], L[2], L[3], H[0], H[1], H[2], H[3]}
  od = MFMA32(pa0, PKV(l0, h0), od); od = MFMA32(pa1, PKV(l1, h1), od);
  od = MFMA32(pa2, PKV(l2, h2), od); od = MFMA32(pa3, PKV(l3, h3), od);
#undef PKV
}
__device__ __forceinline__ void pv_all(f32x16* o, int vb0, int vb1, bf16x8 pa0, bf16x8 pa1, bf16x8 pa2, bf16x8 pa3) {
  pv_one<0>(o[0], vb0, vb1, pa0, pa1, pa2, pa3); pv_one<1>(o[1], vb0, vb1, pa0, pa1, pa2, pa3);
  pv_one<2>(o[2], vb0, vb1, pa0, pa1, pa2, pa3); pv_one<3>(o[3], vb0, vb1, pa0, pa1, pa2, pa3);
}

__device__ void phase4(const Args& a, char* lds) {
  unsigned char* ws = a.ws;
  const int tid = threadIdx.x, wid = tid >> 6, lane = tid & 63, r32 = lane & 31, hi = lane >> 5;
  const u16* Qg = (const u16*)(ws + WS_Q); const u16* KVg = (const u16*)(ws + WS_KV); const u16* WUV = (const u16*)(ws + WS_WUV);
  u16* Y = (u16*)(ws + WS_Y);
  char* gl = lds + LDS_DATA;
  char* kvl = gl;
  float* wsl = (float*)(gl + 2 * KVBUF) + wid * 64; float* li_l = wsl; float* al_l = wsl + 32;
  float* Yl = (float*)gl;
  const int head = wid >> 1, qh = wid & 1;
  int sdst[3];
#pragma unroll
  for (int j = 0; j < 3; ++j) { const int id = tid + 512 * j, key = id / 24, ch = id % 24;
    sdst[j] = ch < 16 ? (int)off_a(key, ch) : 16384 + key * 128 + (((ch - 16) ^ ((key >> 1) & 7)) << 4); }
  const int xq = (r32 >> 2) & 3;
  const int ke = 2048 * (r32 >> 3) + 64 * (r32 & 7) + 16 * (hi ^ xq), ko = 2048 * (r32 >> 3) + 64 * (r32 & 7) + 16 * ((2 + hi) ^ xq);
  const int kr = r32 * 128 + ((hi ^ ((r32 >> 1) & 7)) << 4);
  const int tb = lane >> 4 & 1, tq = (lane & 15) >> 2, tp = lane & 3;
  const int vbl = 2048 * hi + 64 * tq + 32 * (tb ^ hi) + 8 * (tp & 1);
  const int lbase = (int)(uintptr_t)kvl;
  const int vb0 = lbase + vbl + 16 * (tp >> 1), vb1 = lbase + vbl + 256 + 16 * ((tp >> 1) ^ 1);
  for (int u = blockIdx.x; u < 256; u += gridDim.x) {
    const int b = u >> 6, qb_ = u & 63;
    const size_t tok0 = (size_t)b * SEQ + qb_ * 64 + qh * 32;
    const u16* KVb = KVg + (size_t)b * SEQ * 192;
    float m_reg = -1e30f, l_reg = 0.f; f32x16 o[4];
#pragma unroll
    for (int d = 0; d < 4; ++d)
#pragma unroll
      for (int r = 0; r < 16; ++r) o[d][r] = 0.f;
    char* Ql = gl + 2 * KVBUF + 2048;
    const char* qb = Ql + (qh * 32 + r32) * 1552 + (head * 192 + 8 * hi) * 2;
    u32x4 st0[3];
#define SLOAD(S, k0) do { const u16* _p = KVb + (size_t)(k0) * 192 + tid * 8; S[0] = *(const u32x4*)_p; S[1] = *(const u32x4*)(_p + 4096); S[2] = *(const u32x4*)(_p + 8192); } while (0)
#define SWRITE(bufi, S) do { char* _d = kvl + (bufi) * KVBUF; *(u32x4*)(_d + sdst[0]) = S[0]; *(u32x4*)(_d + sdst[1]) = S[1]; *(u32x4*)(_d + sdst[2]) = S[2]; } while (0)
#define RESC(al) do { if (__any((al) < 1.f)) { if (hi == 0) al_l[r32] = (al); asm volatile("s_waitcnt lgkmcnt(0)" ::: "memory"); \
    _Pragma("unroll") for (int d = 0; d < 4; ++d) _Pragma("unroll") for (int r = 0; r < 16; ++r) o[d][r] *= al_l[crow(r, hi)]; } } while (0)
#define CVT_LOAD(tile) const unsigned cit = ((unsigned)(u * 64 + (tile)) << 9) | (unsigned)tid; const bool cisv = cit >= 4194304u;                \
      const unsigned cio = cisv ? cit - 4194304u : cit; const float4 cf = *(const float4*)((cisv ? a.peer_v : a.peer_u) + (size_t)cio * 4)
#define CVT_STORE() do { const float csc = cisv ? PEER_SV : PEER_SU;                                                                               \
      int cp = __builtin_amdgcn_cvt_pk_fp8_f32(cf.x * csc, cf.y * csc, 0, false); cp = __builtin_amdgcn_cvt_pk_fp8_f32(cf.z * csc, cf.w * csc, cp, true); \
      *(int*)(ws + (cisv ? WS_VB : WS_UB) + (size_t)cio * 4) = cp; } while (0)
    constexpr int NT = SEQ / 64;
    f32x16 pA0, pA1, pB0, pB1; float mnA, mnB, alA, alB; bf16x8 pa0, pa1, pa2, pa3;
    __syncthreads();
    { const u16* Qu = Qg + ((size_t)b * SEQ + qb_ * 64) * 768; int tq_ = tid; asm volatile("" : "+v"(tq_));
#pragma unroll
      for (int i = 0; i < 12; ++i) { const int id = tq_ + 512 * i, row = id / 96, c = id % 96; *(u32x4*)(Ql + row * 1552 + c * 16) = *(const u32x4*)(Qu + (size_t)row * 768 + c * 8); } }
    SLOAD(st0, 0); SWRITE(0, st0); SLOAD(st0, 64); __syncthreads();
    { CVT_LOAD(0);
      qkt192(pA0, pA1, kvl, qb, ke, ko, kr); partialSM(pA0, pA1, m_reg, mnA, alA);
      SWRITE(1, st0); CVT_STORE(); }
    __syncthreads();
    for (int j = 1; j + 1 < NT; j += 2) {
      { CVT_LOAD(j);
        SBAR(); qkt192(pB0, pB1, kvl + KVBUF, qb, ke, ko, kr);
        finishSM(pA0, pA1, alA, l_reg, pa0, pa1, pa2, pa3); SBAR();
        SLOAD(st0, (j + 1) * 64); SBAR();
        pv_all(o, vb0, vb1, pa0, pa1, pa2, pa3); partialSM(pB0, pB1, m_reg, mnB, alB);
        __syncthreads(); SWRITE(0, st0); CVT_STORE();
        RESC(alB); __syncthreads(); }
      { CVT_LOAD(j + 1);
        SBAR(); qkt192(pA0, pA1, kvl, qb, ke, ko, kr);
        finishSM(pB0, pB1, alB, l_reg, pa0, pa1, pa2, pa3); SBAR();
        if (j + 2 < NT) SLOAD(st0, (j + 2) * 64); SBAR();
        pv_all(o, vb0 + KVBUF, vb1 + KVBUF, pa0, pa1, pa2, pa3); partialSM(pA0, pA1, m_reg, mnA, alA);
        __syncthreads(); if (j + 2 < NT) SWRITE(1, st0); CVT_STORE();
        RESC(alA); __syncthreads(); }
    }
    { CVT_LOAD(NT - 1);
      SBAR(); qkt192(pB0, pB1, kvl + KVBUF, qb, ke, ko, kr);
      finishSM(pA0, pA1, alA, l_reg, pa0, pa1, pa2, pa3); SBAR();
      pv_all(o, vb0, vb1, pa0, pa1, pa2, pa3); partialSM(pB0, pB1, m_reg, mnB, alB);
      CVT_STORE();
      __syncthreads(); RESC(alB);
      finishSM(pB0, pB1, alB, l_reg, pa0, pa1, pa2, pa3); SBAR();
      pv_all(o, vb0 + KVBUF, vb1 + KVBUF, pa0, pa1, pa2, pa3); }
    __syncthreads();
#undef SLOAD
#undef SWRITE
#undef RESC
#undef CVT_LOAD
#undef CVT_STORE
    int r32e = r32, hie = hi, lne = lane, wide = __builtin_amdgcn_readfirstlane(wid);
    asm volatile("" : "+v"(r32e), "+v"(hie), "+v"(lne), "+s"(wide));
    const int heade = wide >> 1, qhe = wide & 1;
    char* Ole = gl + 2 * KVBUF + 2048 + wide * 8704;
    if (hie == 0) li_l[r32e] = l_reg;
    asm volatile("s_waitcnt lgkmcnt(0)" ::: "memory");
#pragma unroll
    for (int r = 0; r < 16; ++r) {
      const int q = crow(r, hie); const float rl = __builtin_amdgcn_rcpf(li_l[q]);
#pragma unroll
      for (int d = 0; d < 4; ++d) *(u16*)(Ole + q * 272 + (32 * d + r32e) * 2) = f2bf(o[d][r] * rl);
    }
    asm volatile("s_waitcnt lgkmcnt(0)" ::: "memory");
    f32x16 y[4];
#pragma unroll
    for (int n = 0; n < 4; ++n)
#pragma unroll
      for (int r = 0; r < 16; ++r) y[n][r] = 0.f;
    const u16* wuv = WUV + ((size_t)heade * 128 + r32e) * 128 + 8 * hie;
#pragma unroll 2
    for (int s = 0; s < 8; ++s) {
      const bf16x8 af = *(const bf16x8*)(Ole + r32e * 272 + (16 * s + 8 * hie) * 2);
#pragma unroll
      for (int n = 0; n < 4; ++n) {
        const bf16x8 bw = *(const bf16x8*)(wuv + 32 * n * 128 + 16 * s);
        y[n] = MFMA32(af, bw, y[n]);
      }
    }
    __syncthreads();
#pragma unroll
    for (int n = 0; n < 4; ++n)
#pragma unroll
      for (int r = 0; r < 16; ++r) Yl[(qhe * 32 + crow(r, hie)) * 513 + heade * 128 + 32 * n + r32e] = y[n][r];
    __syncthreads();
    for (int i = 0; i < 8; ++i) {
      const int pl = wide * 8 + i; const size_t tok = (size_t)b * SEQ + qb_ * 64 + pl;
      float v[8], ssq = 0.f;
#pragma unroll
      for (int jj = 0; jj < 8; ++jj) { v[jj] = Yl[pl * 513 + lne + 64 * jj]; ssq += v[jj] * v[jj]; }
      ssq = wave_sum(ssq);
      const float rstd = rsqrtf(ssq * (1.f / 512.f) + EPS);
#pragma unroll
      for (int jj = 0; jj < 8; ++jj) { const int col = lne + 64 * jj; Y[tok * 1024 + col] = f2bf(v[jj] * rstd * a.g_attn_out[col]); }
    }
    __syncthreads();
  }
}

__device__ void phase5(const Args& a, char* lds) {
  unsigned char* ws = a.ws;
  const int tid = threadIdx.x, lane = tid & 63, wv = tid >> 6;
  const u16* Y = (const u16*)(ws + WS_Y); const u16* WO = (const u16*)(ws + WS_WO);
  float* X1 = (float*)(ws + WS_X1); float* SSQ = (float*)(ws + WS_SSQ); const float* mod = (const float*)(ws + WS_MOD);
  u16* X1B = (u16*)(ws + WS_H);
  char* gl = lds + LDS_DATA; float* Cl = (float*)gl;
  for (int u = blockIdx.x; u < 128 * 4; u += gridDim.x) {
    int mt, nt; xcd_unit(u, 4, mt, nt); const int R0 = mt * 128, b = R0 >> 12;
    f32x16 acc[2][2];
    gemm_128x256(Y + (size_t)R0 * 1024, 1024, WO + (size_t)(nt * 256) * 1024, 1024, 16, acc, gl);
    acc_to_lds(acc, Cl);
    __syncthreads();
    float2 g1[2];
#pragma unroll
    for (int j = 0; j < 2; ++j) g1[j] = *(const float2*)(mod + b * 6144 + 2048 + nt * 256 + 2 * lane + 128 * j);
    for (int i0 = 0; i0 < 16; i0 += 8) {
      float2 xv[8][2];
#pragma unroll
      for (int i = 0; i < 8; ++i)
#pragma unroll
        for (int j = 0; j < 2; ++j) xv[i][j] = *(const float2*)(a.x + (size_t)(R0 + wv * 16 + i0 + i) * 1024 + nt * 256 + 2 * lane + 128 * j);
#pragma unroll
      for (int i = 0; i < 8; ++i) {
        const int row = wv * 16 + i0 + i; const size_t tok = R0 + row; float ssq = 0.f;
#pragma unroll
        for (int j = 0; j < 2; ++j) {
          const int col = nt * 256 + 2 * lane + 128 * j;
          const float v0 = xv[i][j].x + g1[j].x * Cl[row * CLD + 2 * lane + 128 * j], v1 = xv[i][j].y + g1[j].y * Cl[row * CLD + 2 * lane + 128 * j + 1];
          *(unsigned*)(X1B + tok * 1024 + col) = pack2(v0, v1); ssq += v0 * v0 + v1 * v1;
        }
        ssq = wave_sum(ssq);
        if (lane == 0) SSQ[tok * 4 + nt] = ssq;
      }
    }
    __syncthreads();
  }
}
__device__ __forceinline__ float vmaxf(float a, float b) { float r; asm("v_max_f32 %0, %1, %2" : "=v"(r) : "v"(a), "v"(b)); return r; }
__device__ __forceinline__ float vminf(float a, float b) { float r; asm("v_min_f32 %0, %1, %2" : "=v"(r) : "v"(a), "v"(b)); return r; }
#define TK_CE(x, y) do { const float _h = vmaxf((x), (y)); (y) = vminf((x), (y)); (x) = _h; } while (0)
#define TK_SORT16(t) do { TK_CE(t[0], t[1]); TK_CE(t[2], t[3]); TK_CE(t[0], t[2]); TK_CE(t[1], t[3]); TK_CE(t[1], t[2]); TK_CE(t[4], t[5]); TK_CE(t[6], t[7]); TK_CE(t[4], t[6]); TK_CE(t[5], t[7]); TK_CE(t[5], t[6]); TK_CE(t[0], t[4]); TK_CE(t[2], t[6]); TK_CE(t[2], t[4]); TK_CE(t[1], t[5]); TK_CE(t[3], t[7]); TK_CE(t[3], t[5]); TK_CE(t[1], t[2]); TK_CE(t[3], t[4]); TK_CE(t[5], t[6]); TK_CE(t[8], t[9]); TK_CE(t[10], t[11]); TK_CE(t[8], t[10]); TK_CE(t[9], t[11]); TK_CE(t[9], t[10]); TK_CE(t[12], t[13]); TK_CE(t[14], t[15]); TK_CE(t[12], t[14]); TK_CE(t[13], t[15]); TK_CE(t[13], t[14]); TK_CE(t[8], t[12]); TK_CE(t[10], t[14]); TK_CE(t[10], t[12]); TK_CE(t[9], t[13]); TK_CE(t[11], t[15]); TK_CE(t[11], t[13]); TK_CE(t[9], t[10]); TK_CE(t[11], t[12]); TK_CE(t[13], t[14]); TK_CE(t[0], t[8]); TK_CE(t[4], t[12]); TK_CE(t[4], t[8]); TK_CE(t[2], t[10]); TK_CE(t[6], t[14]); TK_CE(t[6], t[10]); TK_CE(t[2], t[4]); TK_CE(t[6], t[8]); TK_CE(t[10], t[12]); TK_CE(t[1], t[9]); TK_CE(t[5], t[13]); TK_CE(t[5], t[9]); TK_CE(t[3], t[11]); TK_CE(t[7], t[15]); TK_CE(t[7], t[11]); TK_CE(t[3], t[5]); TK_CE(t[7], t[9]); TK_CE(t[11], t[13]); TK_CE(t[1], t[2]); TK_CE(t[3], t[4]); TK_CE(t[5], t[6]); TK_CE(t[7], t[8]); TK_CE(t[9], t[10]); TK_CE(t[11], t[12]); TK_CE(t[13], t[14]); } while (0)
#define TK_BMERGE16(t) do { TK_CE(t[0], t[8]); TK_CE(t[1], t[9]); TK_CE(t[2], t[10]); TK_CE(t[3], t[11]); TK_CE(t[4], t[12]); TK_CE(t[5], t[13]); TK_CE(t[6], t[14]); TK_CE(t[7], t[15]); TK_CE(t[0], t[4]); TK_CE(t[1], t[5]); TK_CE(t[2], t[6]); TK_CE(t[3], t[7]); TK_CE(t[8], t[12]); TK_CE(t[9], t[13]); TK_CE(t[10], t[14]); TK_CE(t[11], t[15]); TK_CE(t[0], t[2]); TK_CE(t[1], t[3]); TK_CE(t[4], t[6]); TK_CE(t[5], t[7]); TK_CE(t[8], t[10]); TK_CE(t[9], t[11]); TK_CE(t[12], t[14]); TK_CE(t[13], t[15]); TK_CE(t[0], t[1]); TK_CE(t[2], t[3]); TK_CE(t[4], t[5]); TK_CE(t[6], t[7]); TK_CE(t[8], t[9]); TK_CE(t[10], t[11]); TK_CE(t[12], t[13]); TK_CE(t[14], t[15]); } while (0)
#define TK_MERGE(A, B) do { _Pragma("unroll") for (int _i = 0; _i < 16; ++_i) A[_i] = vmaxf(A[_i], B[15 - _i]); TK_BMERGE16(A); } while (0)
__constant__ unsigned long long TK_I[4] = {0x0000000000000000ull, 0x0007744411111111ull, 0x0006655333322222ull, 0x00000000FEDCBA98ull};
__constant__ unsigned long long TK_J[4] = {0xFEDCBA9876543210ull, 0x0001021076543210ull, 0x0001010321043210ull, 0x0000000000000000ull};
__constant__ int TK_N[4] = {16, 13, 13, 8};

__device__ void phase6(const Args& a, char* lds) {
  unsigned char* ws = a.ws;
  const int tid = threadIdx.x, lane = tid & 63, wv = tid >> 6, r32 = lane & 31, hi = lane >> 5;
  const u16* H = (const u16*)(ws + WS_H); const u16* WST = (const u16*)(ws + WS_WST);
  float* TOPS = (float*)(ws + WS_TOPK);
  const float* BIASP = (const float*)(ws + WS_BIASP); const float* SSQ = (const float*)(ws + WS_SSQ);
  char* gl = lds + LDS_DATA;
  for (int u = blockIdx.x; u < 8 * 64; u += gridDim.x) {
    int tb, hd; xcd_unit(u, 8, tb, hd);
    const int b = tb >> 4;
    f32x16 sc[8];
    gemm_256x256_wide(WST + ((size_t)b * 2048 + hd * 256) * 1024, 1024, H + (size_t)tb * 256 * 1024, 1024, 16, sc, gl);
    float* bl = (float*)gl;
    if (tid < 256) bl[tid] = BIASP[((size_t)0 * 4 + b) * 2048 + hd * 256 + tid] + BIASP[((size_t)1 * 4 + b) * 2048 + hd * 256 + tid]
                           + BIASP[((size_t)2 * 4 + b) * 2048 + hd * 256 + tid] + BIASP[((size_t)3 * 4 + b) * 2048 + hd * 256 + tid];
    const float4 sq = *(const float4*)(SSQ + (size_t)(tb * 256 + 32 * wv + r32) * 4);
    const float rstd = rsqrtf((sq.x + sq.y + sq.z + sq.w) * (1.f / 1024.f) + EPS);
    __syncthreads();
#pragma unroll
    for (int half = 0; half < 2; ++half) {
      float g0[16], g1[16], g2[16], g3[16], p[16];
#pragma unroll
      for (int r = 0; r < 16; ++r) {
        const unsigned key = crow(r, hi);
        g0[r] = __uint_as_float((__float_as_uint(fmaf(sc[4 * half + 0][r], rstd, bl[128 * half + key])) & ~127u) | key);
        g1[r] = __uint_as_float((__float_as_uint(fmaf(sc[4 * half + 1][r], rstd, bl[128 * half + 32 + key])) & ~127u) | (32u + key));
        g2[r] = __uint_as_float((__float_as_uint(fmaf(sc[4 * half + 2][r], rstd, bl[128 * half + 64 + key])) & ~127u) | (64u + key));
        g3[r] = __uint_as_float((__float_as_uint(fmaf(sc[4 * half + 3][r], rstd, bl[128 * half + 96 + key])) & ~127u) | (96u + key));
      }
      TK_SORT16(g0); TK_SORT16(g1); TK_SORT16(g2); TK_SORT16(g3);
      TK_MERGE(g0, g1); TK_MERGE(g2, g3); TK_MERGE(g0, g2);
#pragma unroll
      for (int i = 0; i < 16; ++i) {
        auto rr = __builtin_amdgcn_permlane32_swap(__float_as_uint(g0[i]), __float_as_uint(g0[i]), false, false);
        p[i] = __uint_as_float(hi ? rr[0] : rr[1]);
      }
      TK_MERGE(g0, p);
      if (hi == 0) {
        float* dst = TOPS + ((size_t)(tb * 256 + 32 * wv + r32) * 16 + 2 * hd + half) * 16;
#pragma unroll
        for (int i = 0; i < 16; i += 4) *(float4*)(dst + i) = make_float4(g0[i], g0[i + 1], g0[i + 2], g0[i + 3]);
      }
    }
  }
}

typedef __attribute__((ext_vector_type(4))) float f32x4;
#define MFMA4(a, b, c) __builtin_amdgcn_mfma_f32_4x4x4bf16_1k((a), (b), (c), 0, 0, 0)
constexpr int P7_VROW = 2112, P7_VBUF = 4 * P7_VROW;
constexpr int P7_RING = 64;
constexpr int P7_ENT  = P7_RING + 8 * 2 * P7_VBUF;
constexpr int P7_CNT  = P7_ENT + 8 * 2048;
static_assert(P7_CNT + 8 * 256 <= LDS_BYTES, "phase 7 LDS map");
__device__ __forceinline__ float sel4(const f32x4& d, int k) { return k == 0 ? d[0] : (k == 1 ? d[1] : (k == 2 ? d[2] : d[3])); }
__device__ __forceinline__ unsigned fp8x2_bf16(unsigned x, float sc, bool hi) {
  return hi ? __builtin_bit_cast(unsigned, __builtin_amdgcn_cvt_scalef32_pk_bf16_fp8(x, sc, true)) : __builtin_bit_cast(unsigned, __builtin_amdgcn_cvt_scalef32_pk_bf16_fp8(x, sc, false));
}

__device__ void phase7(const Args& a, char* lds) {
  unsigned char* ws = a.ws;
  const int tid = threadIdx.x, lane = tid & 63, wv = __builtin_amdgcn_readfirstlane(tid >> 6), blk = lane >> 2, j4 = lane & 3;
  const u16* H = (const u16*)(ws + WS_H); const unsigned char* U8 = ws + WS_UB; const unsigned char* V8 = ws + WS_VB;
  const float* TOPS = (const float*)(ws + WS_TOPK); const float* X1 = (const float*)(ws + WS_X1); const float* mod = (const float*)(ws + WS_MOD);
  const float* SSQ = (const float*)(ws + WS_SSQ);
  const unsigned lbase = (unsigned)(uintptr_t)lds;
  char* ring = lds + P7_RING + wv * 2 * P7_VBUF;
  unsigned* ents = (unsigned*)(lds + P7_ENT + wv * 2048);
  int* cntw = (int*)(lds + P7_CNT + wv * 256);
  const int trb = (int)(lbase + P7_RING + wv * 2 * P7_VBUF) + ((lane & 15) >> 2) * P7_VROW + 32 * (lane >> 4) + 8 * (lane & 3);
  const int NWV = gridDim.x * 8;
  for (int qd = blockIdx.x * 8 + wv; qd < T / 4; qd += NWV) {
    const int tok0 = qd * 4, b = tok0 >> 12;
    float* TS = (float*)ring;
#pragma unroll
    for (int i = 0; i < 4; ++i) *(float4*)(TS + 256 * i + 4 * lane) = *(const float4*)(TOPS + (size_t)tok0 * 256 + 256 * i + 4 * lane);
    cntw[lane] = 0;
    asm volatile("s_waitcnt lgkmcnt(0)" ::: "memory");
    unsigned ec[8];
#pragma unroll
    for (int rd = 0; rd < 2; ++rd) {
      const int combo = (lane >> 2) + 16 * rd, tl = combo >> 3, hd = combo & 7, q = lane & 3;
      const float* t1 = TS + (tl * 16 + hd * 2) * 16; const float* t2 = t1 + 16;
      const unsigned long long ip = TK_I[q], jp = TK_J[q]; const int cn = TK_N[q];
      float L[16], P[16];
#pragma unroll
      for (int c = 0; c < 16; ++c) {
        const unsigned i = (unsigned)(ip >> (4 * c)) & 15u, j = (unsigned)(jp >> (4 * c)) & 15u;
        const float sm = t1[i] + t2[j];
        L[c] = c < cn ? __uint_as_float((__float_as_uint(sm) & ~255u) | (i << 4) | j) : -3.0e38f;
      }
      TK_SORT16(L);
#pragma unroll
      for (int c = 0; c < 16; ++c) P[c] = __uint_as_float(__builtin_amdgcn_update_dpp(0, __float_as_uint(L[c]), 0xB1, 0xf, 0xf, false));
      TK_MERGE(L, P);
#pragma unroll
      for (int c = 0; c < 16; ++c) P[c] = __uint_as_float(__builtin_amdgcn_update_dpp(0, __float_as_uint(L[c]), 0x4E, 0xf, 0xf, false));
      TK_MERGE(L, P);
      float sum = 0.f;
      const float m0 = __uint_as_float(__float_as_uint(L[0]) & ~255u);
#pragma unroll
      for (int c = 0; c < 16; ++c) sum += __expf(__uint_as_float(__float_as_uint(L[c]) & ~255u) - m0);
      const float inv = 1.f / sum;
#pragma unroll
      for (int r = 0; r < 4; ++r) {
        const float lv = q == 0 ? L[r] : (q == 1 ? L[4 + r] : (q == 2 ? L[8 + r] : L[12 + r]));
        const unsigned bits = __float_as_uint(lv), id = bits & 255u;
        const unsigned i1 = __float_as_uint(t1[id >> 4]) & 127u, i2 = __float_as_uint(t2[id & 15u]) & 127u;
        const float gate = __expf(__uint_as_float(bits & ~255u) - m0) * inv;
        ec[4 * rd + r] = (i1 * 128u + i2) | ((unsigned)tl << 14) | (pack2(0.f, gate) & 0xFFFF0000u);
      }
    }
    {
#pragma unroll
      for (int i = 0; i < 8; ++i) atomicAdd(&cntw[(ec[i] & 0x3FFFu) >> 8], 1);
      asm volatile("s_waitcnt lgkmcnt(0)" ::: "memory");
      const int c = cntw[lane]; int inc = c;
#pragma unroll
      for (int o = 1; o < 64; o <<= 1) { const int v = __shfl_up(inc, o, 64); if (lane >= o) inc += v; }
      asm volatile("s_waitcnt lgkmcnt(0)" ::: "memory");
      cntw[lane] = inc - c;
      asm volatile("s_waitcnt lgkmcnt(0)" ::: "memory");
#pragma unroll
      for (int i = 0; i < 8; ++i) { const int pos = atomicAdd(&cntw[(ec[i] & 0x3FFFu) >> 8], 1); ents[pos] = ec[i]; }
      asm volatile("s_waitcnt lgkmcnt(0)" ::: "memory");
    }
    u32x4 hA[4][2];
    { const float4 sq = *(const float4*)(SSQ + (size_t)(tok0 + j4) * 4);
      const float rstd = rsqrtf((sq.x + sq.y + sq.z + sq.w) * (1.f / 1024.f) + EPS);
#pragma unroll
      for (int i = 0; i < 4; ++i)
#pragma unroll
        for (int hf = 0; hf < 2; ++hf) {
          const int k0 = 256 * i + 16 * blk + 8 * hf;
          const u32x4 xb = *(const u32x4*)(H + (size_t)(tok0 + j4) * 1024 + k0);
          float hv[8];
#pragma unroll
          for (int e = 0; e < 8; e += 4) {
            const float4 g = *(const float4*)(a.g_norm2 + k0 + e), sc4 = *(const float4*)(mod + b * 6144 + 4096 + k0 + e), sh4 = *(const float4*)(mod + b * 6144 + 3072 + k0 + e);
            hv[e]     = bflo(xb[e >> 1]) * rstd * g.x * (1.f + sc4.x) + sh4.x;     hv[e + 1] = bfhi(xb[e >> 1]) * rstd * g.y * (1.f + sc4.y) + sh4.y;
            hv[e + 2] = bflo(xb[(e >> 1) + 1]) * rstd * g.z * (1.f + sc4.z) + sh4.z; hv[e + 3] = bfhi(xb[(e >> 1) + 1]) * rstd * g.w * (1.f + sc4.w) + sh4.w;
          }
          hA[i][hf] = (u32x4){pack2(hv[0], hv[1]), pack2(hv[2], hv[3]), pack2(hv[4], hv[5]), pack2(hv[6], hv[7])};
        } }
    f32x4 acc[16];
#pragma unroll
    for (int c = 0; c < 16; ++c) acc[c] = (f32x4){0.f, 0.f, 0.f, 0.f};
#define P7_VPHASE(bufi) do { const int _vb = trb + (bufi) * P7_VBUF;                                                            \
      { const s16x4 v0 = tr_read<0>(_vb), v1 = tr_read<128>(_vb), v2 = tr_read<256>(_vb), v3 = tr_read<384>(_vb),               \
                    v4 = tr_read<512>(_vb), v5 = tr_read<640>(_vb), v6 = tr_read<768>(_vb), v7 = tr_read<896>(_vb);               \
        asm volatile("s_waitcnt lgkmcnt(0)" ::: "memory"); SBAR();                                                                \
        acc[0] = MFMA4(awp, v0, acc[0]); acc[1] = MFMA4(awp, v1, acc[1]); acc[2] = MFMA4(awp, v2, acc[2]); acc[3] = MFMA4(awp, v3, acc[3]);   \
        acc[4] = MFMA4(awp, v4, acc[4]); acc[5] = MFMA4(awp, v5, acc[5]); acc[6] = MFMA4(awp, v6, acc[6]); acc[7] = MFMA4(awp, v7, acc[7]); } \
      { const s16x4 v0 = tr_read<1024>(_vb), v1 = tr_read<1152>(_vb), v2 = tr_read<1280>(_vb), v3 = tr_read<1408>(_vb),         \
                    v4 = tr_read<1536>(_vb), v5 = tr_read<1664>(_vb), v6 = tr_read<1792>(_vb), v7 = tr_read<1920>(_vb);           \
        asm volatile("s_waitcnt lgkmcnt(0)" ::: "memory"); SBAR();                                                                \
        acc[8] = MFMA4(awp, v0, acc[8]); acc[9] = MFMA4(awp, v1, acc[9]); acc[10] = MFMA4(awp, v2, acc[10]); acc[11] = MFMA4(awp, v3, acc[11]); \
        acc[12] = MFMA4(awp, v4, acc[12]); acc[13] = MFMA4(awp, v5, acc[13]); acc[14] = MFMA4(awp, v6, acc[14]); acc[15] = MFMA4(awp, v7, acc[15]); } } while (0)
    u32x4 u8[4], v8[4];
#define P7_LOADG(EN) do { const unsigned _ex = (EN) & 0x3FFFu; const unsigned char* _pu = U8 + (size_t)_ex * 1024 + 16 * blk;      \
      _Pragma("unroll") for (int _i = 0; _i < 4; ++_i) u8[_i] = *(const u32x4*)(_pu + 256 * _i);                                 \
      _Pragma("unroll") for (int _q = 0; _q < 4; ++_q) { const unsigned _eq = (unsigned)__builtin_amdgcn_readlane((int)_ex, _q);  \
        v8[_q] = *(const u32x4*)(V8 + (size_t)_eq * 1024 + 16 * lane); } } while (0)
    unsigned enc = ents[j4], enn = ents[4 + j4];
    P7_LOADG(enc);
    s16x4 awp = {0, 0, 0, 0};
    constexpr int NG = 128;
#pragma unroll 2
    for (int g = 0; g < NG; ++g) {
      if (g > 0) P7_VPHASE((g - 1) & 1);
      f32x4 d0 = {0.f, 0.f, 0.f, 0.f}, d1 = {0.f, 0.f, 0.f, 0.f};
#pragma unroll
      for (int i = 0; i < 4; ++i)
#pragma unroll
        for (int w = 0; w < 4; ++w) {
          const uint2 ub = {fp8x2_bf16(u8[i][w], 1.f / PEER_SU, false), fp8x2_bf16(u8[i][w], 1.f / PEER_SU, true)};
          const uint2 ha = {hA[i][w >> 1][2 * (w & 1)], hA[i][w >> 1][2 * (w & 1) + 1]};
          if (w & 1) d1 = MFMA4(__builtin_bit_cast(s16x4, ha), __builtin_bit_cast(s16x4, ub), d1);
          else       d0 = MFMA4(__builtin_bit_cast(s16x4, ha), __builtin_bit_cast(s16x4, ub), d0);
        }
      { char* vw = ring + (g & 1) * P7_VBUF + lane * 32;
#pragma unroll
        for (int q = 0; q < 4; ++q) {
          u32x4 o0, o1;
          o0[0] = fp8x2_bf16(v8[q][0], 1.f / PEER_SV, false); o0[1] = fp8x2_bf16(v8[q][0], 1.f / PEER_SV, true);
          o0[2] = fp8x2_bf16(v8[q][1], 1.f / PEER_SV, false); o0[3] = fp8x2_bf16(v8[q][1], 1.f / PEER_SV, true);
          o1[0] = fp8x2_bf16(v8[q][2], 1.f / PEER_SV, false); o1[1] = fp8x2_bf16(v8[q][2], 1.f / PEER_SV, true);
          o1[2] = fp8x2_bf16(v8[q][3], 1.f / PEER_SV, false); o1[3] = fp8x2_bf16(v8[q][3], 1.f / PEER_SV, true);
          *(u32x4*)(vw + q * P7_VROW) = o0; *(u32x4*)(vw + q * P7_VROW + 16) = o1;
        } }
      unsigned en2 = 0u;
      if (g + 1 < NG) { P7_LOADG(enn); if (g + 2 < NG) en2 = ents[4 * (g + 2) + j4]; }
      const int tk = (enc >> 14) & 3;
      float av = sel4(d0, tk) + sel4(d1, tk);
      av += __uint_as_float(__builtin_amdgcn_update_dpp(0, __float_as_uint(av), 0x124, 0xf, 0xf, false));
      av += __uint_as_float(__builtin_amdgcn_update_dpp(0, __float_as_uint(av), 0x128, 0xf, 0xf, false));
      av += __shfl_xor(av, 16, 64);
      { auto rr = __builtin_amdgcn_permlane32_swap(__float_as_uint(av), __float_as_uint(av), false, false); av = __uint_as_float(rr[0]) + __uint_as_float(rr[1]); }
      const float wgt = gelu_exact(av) * __uint_as_float(enc & 0xFFFF0000u);
      float z[4];
#define P7_QB(x, k) __builtin_amdgcn_update_dpp(0, (x), (k) * 0x55, 0xf, 0xf, false)
      { const unsigned wb = __float_as_uint(wgt), tb = (unsigned)tk;
        unsigned w0 = P7_QB(wb, 0), w1 = P7_QB(wb, 1), w2 = P7_QB(wb, 2), w3 = P7_QB(wb, 3);
        unsigned t0 = P7_QB(tb, 0), t1 = P7_QB(tb, 1), t2 = P7_QB(tb, 2), t3 = P7_QB(tb, 3);
        asm volatile("" : "+v"(w0), "+v"(w1), "+v"(w2), "+v"(w3), "+v"(t0), "+v"(t1), "+v"(t2), "+v"(t3));
        z[0] = ((int)t0 == j4) ? __uint_as_float(w0) : 0.f; z[1] = ((int)t1 == j4) ? __uint_as_float(w1) : 0.f;
        z[2] = ((int)t2 == j4) ? __uint_as_float(w2) : 0.f; z[3] = ((int)t3 == j4) ? __uint_as_float(w3) : 0.f; }
#undef P7_QB
      { const uint2 pk = {pack2(z[0], z[1]), pack2(z[2], z[3])}; awp = __builtin_bit_cast(s16x4, pk); }
      enc = enn; enn = en2;
    }
#undef P7_LOADG
    P7_VPHASE((NG - 1) & 1);
#undef P7_VPHASE
    int lne = lane; asm volatile("" : "+v"(lne));
    float ss[4] = {0.f, 0.f, 0.f, 0.f};
#pragma unroll
    for (int c = 0; c < 16; ++c) {
      const float g2 = mod[b * 6144 + 5120 + 64 * c + lne];
#pragma unroll
      for (int r = 0; r < 4; ++r) { const float v = bflo((unsigned)H[(size_t)(tok0 + r) * 1024 + 64 * c + lne]) + g2 * acc[c][r]; acc[c][r] = v; ss[r] += v * v; }
    }
    float rstd[4];
#pragma unroll
    for (int r = 0; r < 4; ++r) rstd[r] = rsqrtf(wave_sum(ss[r]) * (1.f / 1024.f) + EPS);
#pragma unroll
    for (int c = 0; c < 16; ++c) {
      const float gf = a.g_final[64 * c + lne];
#pragma unroll
      for (int r = 0; r < 4; ++r) a.out[(size_t)(tok0 + r) * 1024 + 64 * c + lne] = acc[c][r] * rstd[r] * gf;
    }
  }
}

constexpr int N_PHASES = 8;
__global__ void __launch_bounds__(512, 2) fwd(Args args) {
  extern __shared__ __attribute__((aligned(16))) char lds[];
  if (threadIdx.x == 0) *(uint4*)lds = make_uint4(0u, 0u, 0u, 0u);
  __syncthreads();
  const int lo = args.ph_lo, hi = args.ph_hi;
  XcdBarrier bar; bar.bar = (unsigned*)(args.ws + WS_BAR); bar.x = 0; bar.st = (volatile LAS unsigned*)lds;
  if (hi - lo > 1) bar = xcd_barrier_post((unsigned*)(args.ws + WS_BAR), (volatile LAS unsigned*)lds);
#ifndef ONLY_PHASE
#define ONLY_PHASE -1
#endif
#define IN(k) (lo <= (k) && (k) < hi && (ONLY_PHASE < 0 || ONLY_PHASE == (k)))
#define SEAM(k) do { if (IN(k) && IN((k) + 1)) xcd_barrier(bar); } while (0)
  if (IN(0)) phase0(args, lds);
  SEAM(0);
  if (IN(1)) { phase1(args, lds); phase1b(args, lds); }
  SEAM(1);
  if (IN(2)) phase2(args, lds);
  SEAM(2);
  if (IN(3)) phase3(args, lds);
  SEAM(3);
  if (IN(4)) phase4(args, lds);
  SEAM(4);
  if (IN(5)) phase5(args, lds);
  SEAM(5);
  if (IN(6)) phase6(args, lds);
  SEAM(6);
  if (IN(7)) phase7(args, lds);
#undef IN
#undef SEAM
}

extern "C" void kernel_launch(void* const* d_in, const int* in_sizes, int n_in, void* d_out, int out_size, void* d_ws, size_t ws_size, hipStream_t stream) {
  static int grid = 0;
  if (grid == 0) {
    if (n_in != 23 || out_size != T * DM || ws_size < WS_END) { fprintf(stderr, "kernel_launch: unexpected shapes (n_in %d out %d ws %zu need %zu)\n", n_in, out_size, ws_size, (size_t)WS_END); grid = -1; return; }
    int dev = 0, cus = 0, per_cu = 0;
    (void)hipGetDevice(&dev); (void)hipDeviceGetAttribute(&cus, hipDeviceAttributeMultiprocessorCount, dev);
    if (hipFuncSetAttribute((const void*)fwd, hipFuncAttributeMaxDynamicSharedMemorySize, LDS_BYTES) != hipSuccess) { fprintf(stderr, "kernel_launch: hipFuncSetAttribute failed\n"); grid = -1; return; }
    if (hipOccupancyMaxActiveBlocksPerMultiprocessor(&per_cu, (const void*)fwd, 512, LDS_BYTES) != hipSuccess || per_cu < 1) { fprintf(stderr, "kernel_launch: occupancy query says %d\n", per_cu); per_cu = 1; }
    (void)hipGetLastError();
    grid = cus;
  }
  if (grid < 0) return;
  (void)hipMemsetAsync((char*)d_ws + WS_BAR, 0, 16384, stream);
  Args a{};
  a.x = (const float*)d_in[0]; a.c = (const float*)d_in[1]; a.pos = (const int*)d_in[2];
  a.w_ada = (const float*)d_in[3]; a.b_ada = (const float*)d_in[4]; a.g_norm1 = (const float*)d_in[5]; a.w_in = (const float*)d_in[6];
  a.g_q_a = (const float*)d_in[7]; a.w_uq = (const float*)d_in[8]; a.g_kv_a = (const float*)d_in[9]; a.w_ukv = (const float*)d_in[10];
  a.g_sg = (const float*)d_in[11]; a.w_sg = (const float*)d_in[12]; a.b_sg = (const float*)d_in[13]; a.g_attn_out = (const float*)d_in[14];
  a.g_sg_out = (const float*)d_in[15]; a.w_o = (const float*)d_in[16]; a.g_norm2 = (const float*)d_in[17]; a.w_peer_q = (const float*)d_in[18];
  a.peer_keys = (const float*)d_in[19]; a.peer_u = (const float*)d_in[20]; a.peer_v = (const float*)d_in[21]; a.g_final = (const float*)d_in[22];
  a.out = (float*)d_out; a.ws = (unsigned char*)d_ws;
#if N_LAUNCH_MODE == 0
  a.ph_lo = 0; a.ph_hi = N_PHASES;
  hipLaunchKernelGGL(fwd, dim3(grid), dim3(512), LDS_BYTES, stream, a);
#else
  for (int p = 0; p < N_PHASES; ++p) for (int rep = 0; rep <= ((DUP_MASK >> p) & 1); ++rep) { a.ph_lo = p; a.ph_hi = p + 1; hipLaunchKernelGGL(fwd, dim3(grid), dim3(512), LDS_BYTES, stream, a); }
#endif
  const hipError_t le = hipPeekAtLastError();
  if (le != hipSuccess) fprintf(stderr, "kernel_launch: launch failed: %s\n", hipGetErrorName(le));
}
```

```cpp
#include <hip/hip_runtime.h>
#include <stdint.h>
#include <stdio.h>

#define N_LAUNCH_MODE 0
#define DUP_MASK 0x000

typedef unsigned short u16;
typedef __attribute__((ext_vector_type(8))) short bf16x8;
typedef __attribute__((ext_vector_type(4))) short s16x4;
typedef __attribute__((ext_vector_type(16))) float f32x16;
typedef __attribute__((ext_vector_type(4))) unsigned u32x4;

constexpr int T = 16384, DM = 1024, SEQ = 4096;
constexpr float EPS = 1e-6f;

constexpr size_t WS_BAR  = 0;
constexpr int ADA_KS = 16;
constexpr size_t WS_MODP = 16384;
constexpr size_t WS_MOD  = WS_MODP + (size_t)ADA_KS * 4 * 6144 * 4;
constexpr size_t WS_CS   = WS_MOD + 98304;
constexpr size_t WS_WIN  = WS_CS + 4194304;
constexpr size_t WS_WQ2  = WS_WIN + 3145728;
constexpr size_t WS_WUV  = WS_WQ2 + 393216;
constexpr size_t WS_WO   = WS_WUV + 131072;
constexpr size_t WS_WPQ  = WS_WO + 2097152;
constexpr size_t WS_KEYS = WS_WPQ + 4194304;
constexpr size_t WS_WSG  = WS_KEYS + 524288;
constexpr size_t WS_UB   = WS_WSG + 131072;
constexpr size_t WS_VB   = WS_UB + 33554432;
constexpr size_t WS_H    = WS_VB + 33554432;
constexpr size_t WS_Y    = WS_H + 33554432;
constexpr size_t WS_KV   = WS_Y + 33554432;
constexpr size_t WS_TOPK = WS_KV + 6291456;
constexpr size_t WS_SSQ  = WS_TOPK + 16777216;
constexpr size_t WS_SSQV = WS_SSQ + 262144;
constexpr size_t WS_R1   = WS_SSQV + 131072;
constexpr size_t WS_Q    = WS_R1;
constexpr size_t WS_QA   = WS_Q + 25165824;
constexpr size_t WS_UACT = WS_QA + 8388608;
constexpr size_t WS_GVT  = WS_UACT + 16777216;
constexpr size_t WS_X1   = WS_R1;
constexpr size_t WS_WST  = WS_R1 + 67108864;
constexpr size_t WS_BIASP = WS_WST + 4 * 4194304;
constexpr size_t WS_END  = WS_BIASP + 131072;

constexpr int LDS_BYTES = 155648;
constexpr int LDS_DATA  = 64;

struct Args {
  const float *x, *c; const int* pos;
  const float *w_ada, *b_ada, *g_norm1, *w_in, *g_q_a, *w_uq, *g_kv_a, *w_ukv, *g_sg, *w_sg, *b_sg, *g_attn_out, *g_sg_out,
              *w_o, *g_norm2, *w_peer_q, *peer_keys, *peer_u, *peer_v, *g_final;
  float* out; unsigned char* ws; int ph_lo, ph_hi;
};

#define XB_TMO      128
#define XB_XCNT(j)  (256  + 64 * (j))
#define XB_XSUB(j)  (1280 + 64 * (j))
#define XB_XGEN(j)  (2304 + 64 * (j))
#define XB_TOP      3328
#define XB_TOPGEN   3392
#define XCD_BAR_WORDS 3456
#define XB_SPIN_CAP (1u << 18)
#define LAS __attribute__((address_space(3)))

__device__ __forceinline__ unsigned xb_ld(unsigned* p)              { return __hip_atomic_load(p, __ATOMIC_RELAXED, __HIP_MEMORY_SCOPE_AGENT); }
__device__ __forceinline__ unsigned xb_add(unsigned* p, unsigned v) { return __hip_atomic_fetch_add(p, v, __ATOMIC_RELAXED, __HIP_MEMORY_SCOPE_AGENT); }
__device__ __forceinline__ unsigned xb_xcc_id() { return (unsigned)__builtin_amdgcn_s_getreg((3 << 11) | 20) & 0xFu; }
#define XB_SPIN(cond, bar) do { unsigned _sp = 0; while (cond) { __builtin_amdgcn_s_sleep(1); \
    if ((++_sp & 255u) == 0u) { if (xb_ld(&(bar)[XB_TMO])) break; if (_sp > XB_SPIN_CAP) { atomicAdd(&(bar)[XB_TMO], 1u); break; } } } } while (0)

struct XcdBarrier { unsigned* bar; unsigned x; volatile LAS unsigned* st; };

__device__ __forceinline__ XcdBarrier xcd_barrier_post(unsigned* bar, volatile LAS unsigned* st) {
    XcdBarrier b; b.bar = bar; b.x = xb_xcc_id(); b.st = st;
    if (threadIdx.x == 0) (void)xb_add(&bar[XB_XCNT(b.x)], 1u);
    return b;
}
__device__ __forceinline__ void xcd_barrier_complete(unsigned* bar, unsigned x, unsigned& nloc, unsigned& nx) {
    const unsigned G = gridDim.x * gridDim.y * gridDim.z;
    unsigned sum, cnt, mine, sp = 0u;
    for (;;) {
        sum = 0u; cnt = 0u; mine = 0u;
#pragma unroll
        for (unsigned j = 0; j < 16; ++j) { const unsigned c = xb_ld(&bar[XB_XCNT(j)]); sum += c; cnt += (c > 0u) ? 1u : 0u; mine = (j == x) ? c : mine; }
        if (sum == G) break;
        __builtin_amdgcn_s_sleep(1);
        if ((++sp & 255u) == 0u) { if (xb_ld(&bar[XB_TMO])) break; if (sp > XB_SPIN_CAP) { atomicAdd(&bar[XB_TMO], 1u); break; } }
    }
    nloc = mine > 0u ? mine : 1u; nx = cnt > 0u ? cnt : 1u;
}
__device__ __forceinline__ void xcd_barrier(const XcdBarrier& b) {
    asm volatile("s_waitcnt vmcnt(0)" ::: "memory");
    __syncthreads();
    if (threadIdx.x == 0) {
        unsigned* bar = b.bar;
        __builtin_amdgcn_s_waitcnt(0);
        unsigned nloc = b.st[0], nx = b.st[1];
        if (nloc == 0u) { xcd_barrier_complete(bar, b.x, nloc, nx); b.st[0] = nloc; b.st[1] = nx; }
        const unsigned old = xb_add(&bar[XB_XSUB(b.x)], 1u);
        const unsigned gen = old / nloc;
        if (old + 1u == (gen + 1u) * nloc) {
            __builtin_amdgcn_fence(__ATOMIC_RELEASE, "agent");
            asm volatile("s_waitcnt vmcnt(0)" ::: "memory");
            const unsigned og = xb_add(&bar[XB_TOP], 1u);
            const unsigned tg = og / nx;
            if (og + 1u == (tg + 1u) * nx) xb_add(&bar[XB_TOPGEN], 1u);
            else XB_SPIN(xb_ld(&bar[XB_TOPGEN]) == tg, bar);
            __builtin_amdgcn_fence(__ATOMIC_ACQUIRE, "agent");
            xb_add(&bar[XB_XGEN(b.x)], 1u);
            asm volatile("s_waitcnt vmcnt(0)" ::: "memory");
        } else {
            XB_SPIN(xb_ld(&bar[XB_XGEN(b.x)]) == gen, bar);
            __builtin_amdgcn_fence(__ATOMIC_ACQUIRE, "agent");
            asm volatile("s_waitcnt vmcnt(0)" ::: "memory");
        }
    }
    __syncthreads();
}

__device__ __forceinline__ unsigned pack2(float lo, float hi) {
  typedef __attribute__((ext_vector_type(2))) float f2; typedef __attribute__((ext_vector_type(2))) __bf16 b2;
  f2 v = {lo, hi}; b2 r = __builtin_convertvector(v, b2); return __builtin_bit_cast(unsigned, r);
}
__device__ __forceinline__ u16 f2bf(float f) { return (u16)(pack2(f, 0.f) & 0xFFFFu); }
__device__ __forceinline__ float bflo(unsigned w) { return __uint_as_float(w << 16); }
__device__ __forceinline__ float bfhi(unsigned w) { return __uint_as_float(w & 0xFFFF0000u); }
__device__ __forceinline__ float gelu_exact(float x) {
  const float z = fabsf(x) * 0.70710678118654752f;
  const float t = __builtin_amdgcn_rcpf(fmaf(0.3275911f, z, 1.f));
  float p = fmaf(1.061405429f, t, -1.453152027f); p = fmaf(p, t, 1.421413741f); p = fmaf(p, t, -0.284496736f); p = fmaf(p, t, 0.254829592f);
  const float e = p * t * __expf(-z * z);
  const float erfz = 1.f - e;
  return 0.5f * x * (1.f + copysignf(erfz, x));
}
__device__ __forceinline__ float wave_sum(float v) {
#pragma unroll
  for (int o = 32; o > 0; o >>= 1) v += __shfl_xor(v, o, 64);
  return v;
}
__device__ __forceinline__ int crow(int r, int hi) { return (r & 3) + 8 * (r >> 2) + 4 * hi; }
#define MFMA32(a, b, c) __builtin_amdgcn_mfma_f32_32x32x16_bf16((a), (b), (c), 0, 0, 0)

template <int MAP> __device__ __forceinline__ int colmap(int n) {
  if (MAP == 0) return n;
  if (MAP == 1) return n < 448 ? n : (n < 512 ? -1 : n - 64);
  if (MAP == 2) return (n >> 6) * 192 + 128 + (n & 63);
  return (n >> 7) * 256 + 128 + (n & 127);
}
template <int MAP> __device__ void cvt_transpose(const float* __restrict__ src, int src_ld, int K, int N, u16* __restrict__ dst, int gtid, int gthreads) {
  const int total = N * (K >> 3);
  for (int idx = gtid; idx < total; idx += gthreads) {
    const int n = idx % N, k8 = idx / N, sc = colmap<MAP>(n);
    float v[8];
#pragma unroll
    for (int j = 0; j < 8; ++j) v[j] = sc < 0 ? 0.f : src[(size_t)(k8 * 8 + j) * src_ld + sc];
    u32x4 w = {pack2(v[0], v[1]), pack2(v[2], v[3]), pack2(v[4], v[5]), pack2(v[6], v[7])};
    *(u32x4*)(dst + (size_t)n * K + k8 * 8) = w;
  }
}
template <int MAP> __device__ void cvt_transpose_tiled(const float* __restrict__ src, int src_ld, int K, int N, u16* __restrict__ dst, float* tile) {
  const int tid = threadIdx.x, tk = K >> 6, ntile = tk * (N >> 6);
  for (int t = blockIdx.x; t < ntile; t += gridDim.x) {
    const int k0 = (t % tk) * 64, n0 = (t / tk) * 64;
    __syncthreads();
    { const int nl = tid & 63, sc = colmap<MAP>(n0 + nl);
#pragma unroll
      for (int i = 0; i < 8; ++i) { const int k = (tid >> 6) + 8 * i; tile[k * 65 + nl] = sc < 0 ? 0.f : src[(size_t)(k0 + k) * src_ld + sc]; } }
    __syncthreads();
    { const int n = tid >> 3, kk = tid & 7; float v[8];
#pragma unroll
      for (int j = 0; j < 8; ++j) v[j] = tile[(8 * kk + j) * 65 + n];
      u32x4 w = {pack2(v[0], v[1]), pack2(v[2], v[3]), pack2(v[4], v[5]), pack2(v[6], v[7])};
      *(u32x4*)(dst + (size_t)(n0 + n) * K + k0 + 8 * kk) = w; }
  }
}
__device__ void cvt_direct(const float* __restrict__ src, u16* __restrict__ dst, size_t n8, int gtid, int gthreads) {
  for (size_t i = gtid; i < n8; i += gthreads) {
    const float4 a = *(const float4*)(src + i * 8), b = *(const float4*)(src + i * 8 + 4);
    u32x4 w = {pack2(a.x, a.y), pack2(a.z, a.w), pack2(b.x, b.y), pack2(b.z, b.w)};
    *(u32x4*)(dst + i * 8) = w;
  }
}
constexpr float PEER_SU = 32.f, PEER_SV = 4.f;
__device__ __forceinline__ void sincos_acc(float a, float& sn, float& cs) {
  const float q = __builtin_rintf(a * 0.636619772f);
  float r = __builtin_fmaf(-q, 1.57079601e+00f, a);
  r = __builtin_fmaf(-q, 3.13916473e-07f, r);
  r = __builtin_fmaf(-q, 5.39030253e-15f, r);
  const float r2 = r * r;
  float s = __builtin_fmaf(r2, 2.75573192e-06f, -1.98412698e-04f);
  s = __builtin_fmaf(s, r2, 8.33333333e-03f); s = __builtin_fmaf(s, r2, -1.66666667e-01f); s = __builtin_fmaf(r * r2, s, r);
  float c = __builtin_fmaf(r2, 2.48015873e-05f, -1.38888889e-03f);
  c = __builtin_fmaf(c, r2, 4.16666667e-02f); c = __builtin_fmaf(c, r2, -0.5f); c = __builtin_fmaf(c, r2, 1.f);
  const int n = ((int)q) & 3;
  const float ss = (n & 1) ? c : s, cc = (n & 1) ? s : c;
  sn = (n & 2) ? -ss : ss;
  cs = ((n + 1) & 2) ? -cc : cc;
}

__constant__ float INVF[32] = {1.000000000e+00f, 7.498942018e-01f, 5.623413324e-01f, 4.216965139e-01f, 3.162277639e-01f, 2.371373922e-01f, 1.778279394e-01f, 1.333521456e-01f,
  1.000000015e-01f, 7.498941571e-02f, 5.623412877e-02f, 4.216964915e-02f, 3.162277862e-02f, 2.371373586e-02f, 1.778279431e-02f, 1.333521493e-02f,
  9.999999776e-03f, 7.498942316e-03f, 5.623413250e-03f, 4.216964822e-03f, 3.162277862e-03f, 2.371373819e-03f, 1.778279431e-03f, 1.333521446e-03f,
  1.000000047e-03f, 7.498941850e-04f, 5.623413017e-04f, 4.216965463e-04f, 3.162277862e-04f, 2.371373848e-04f, 1.778279402e-04f, 1.333521504e-04f};
__device__ void phase0(const Args& a, char* lds) {
  unsigned char* ws = a.ws;
  const int tid = threadIdx.x, lane = tid & 63, wv = tid >> 6;
  const int NWV = gridDim.x * 8, gw = blockIdx.x * 8 + wv;
  const int gthreads = gridDim.x * 512, gtid = blockIdx.x * 512 + tid;
  float* modp = (float*)(ws + WS_MODP);
  for (int job = wv * gridDim.x + blockIdx.x; job < 96 * ADA_KS; job += NWV) {
    const int cg = job % 96, ks = job / 96, col = cg * 64 + lane;
    float a0 = 0.f, a1 = 0.f, a2 = 0.f, a3 = 0.f;
    const float* w = a.w_ada + (size_t)(ks * 64) * 6144 + col;
    float sv[4];
#pragma unroll
    for (int bb = 0; bb < 4; ++bb) { const float cv = a.c[bb * 1024 + ks * 64 + lane]; sv[bb] = cv / (1.f + __expf(-cv)); }
#pragma unroll 32
    for (int k = 0; k < 64; ++k) {
      const float wv_ = w[(size_t)k * 6144];
      a0 += __uint_as_float(__builtin_amdgcn_readlane(__float_as_uint(sv[0]), k)) * wv_;
      a1 += __uint_as_float(__builtin_amdgcn_readlane(__float_as_uint(sv[1]), k)) * wv_;
      a2 += __uint_as_float(__builtin_amdgcn_readlane(__float_as_uint(sv[2]), k)) * wv_;
      a3 += __uint_as_float(__builtin_amdgcn_readlane(__float_as_uint(sv[3]), k)) * wv_;
    }
    modp[(ks * 4 + 0) * 6144 + col] = a0; modp[(ks * 4 + 1) * 6144 + col] = a1;
    modp[(ks * 4 + 2) * 6144 + col] = a2; modp[(ks * 4 + 3) * 6144 + col] = a3;
  }
  { float* tile = (float*)(lds + LDS_DATA);
    cvt_transpose_tiled<1>(a.w_in, 1472, 1024, 1536, (u16*)(ws + WS_WIN), tile);
    cvt_transpose_tiled<0>(a.w_o, 1024, 1024, 1024, (u16*)(ws + WS_WO), tile);
    cvt_transpose_tiled<2>(a.w_uq, 768, 256, 256, (u16*)(ws + WS_WQ2) + 512 * 256, tile);
    cvt_transpose_tiled<3>(a.w_ukv, 1024, 128, 512, (u16*)(ws + WS_WUV), tile); }
  {
    u16* wq2 = (u16*)(ws + WS_WQ2);
    float* At = (float*)(lds + LDS_DATA); float* Bt = At + 16 * 129;
    for (int job = blockIdx.x; job < 256; job += gridDim.x) {
      const int h = job >> 6, cb = (job >> 3) & 7, ib = job & 7;
      __syncthreads();
      { const int row = tid >> 5, c4 = tid & 31;
        const float4 av = *(const float4*)(a.w_ukv + (size_t)(cb * 16 + row) * 1024 + h * 256 + 4 * c4);
        const float4 b0 = *(const float4*)(a.w_uq + (size_t)(ib * 32 + row) * 768 + h * 192 + 4 * c4);
        const float4 b1 = *(const float4*)(a.w_uq + (size_t)(ib * 32 + 16 + row) * 768 + h * 192 + 4 * c4);
        float* pa = At + row * 129 + 4 * c4; pa[0] = av.x; pa[1] = av.y; pa[2] = av.z; pa[3] = av.w;
        float* p0 = Bt + row * 129 + 4 * c4; p0[0] = b0.x; p0[1] = b0.y; p0[2] = b0.z; p0[3] = b0.w;
        float* p1 = Bt + (16 + row) * 129 + 4 * c4; p1[0] = b1.x; p1[1] = b1.y; p1[2] = b1.z; p1[3] = b1.w; }
      __syncthreads();
      { const int cl = tid >> 5, il = tid & 31;
        const float* pa = At + cl * 129; const float* pb = Bt + il * 129;
        float s0 = 0.f, s1 = 0.f, s2 = 0.f, s3 = 0.f;
#pragma unroll 8
        for (int d = 0; d < 128; d += 4) { s0 += pa[d] * pb[d]; s1 += pa[d + 1] * pb[d + 1]; s2 += pa[d + 2] * pb[d + 2]; s3 += pa[d + 3] * pb[d + 3]; }
        wq2[(size_t)(h * 128 + cb * 16 + cl) * 256 + ib * 32 + il] = f2bf((s0 + s1) + (s2 + s3)); }
    }
    __syncthreads();
  }
  cvt_direct(a.peer_keys, (u16*)(ws + WS_KEYS), 262144 / 8, gtid, gthreads);
  cvt_direct(a.w_peer_q, (u16*)(ws + WS_WPQ), (size_t)1024 * 2048 / 8, gtid, gthreads);
  cvt_direct(a.w_sg, (u16*)(ws + WS_WSG), 65536 / 8, gtid, gthreads);
  {
    float* cs = (float*)(ws + WS_CS);
    for (int idx = gtid; idx < T * 32; idx += gthreads) {
      const int t = idx >> 5, i = idx & 31;
      const float inv = INVF[i];
      const float ang = (float)a.pos[t] * inv;
      float sn, c_; sincos_acc(ang, sn, c_);
      cs[(size_t)t * 64 + i] = c_; cs[(size_t)t * 64 + 32 + i] = sn;
    }
  }
}

__device__ void phase1(const Args& a, char* lds) {
  unsigned char* ws = a.ws;
  const int tid = threadIdx.x, lane = tid & 63, wv = tid >> 6;
  const float* modp = (const float*)(ws + WS_MODP);
  float* mod = (float*)(ws + WS_MOD);
  for (int idx = blockIdx.x * 512 + tid; idx < 4 * 6144; idx += gridDim.x * 512) {
    const int b = idx / 6144, m = idx % 6144;
    float s = a.b_ada[m];
#pragma unroll
    for (int ks = 0; ks < ADA_KS; ++ks) s += modp[(ks * 4 + b) * 6144 + m];
    mod[idx] = s;
  }
  float* sh = (float*)(lds + LDS_DATA);
  u16* H = (u16*)(ws + WS_H);
  for (int u = blockIdx.x; u < T / 64; u += gridDim.x) {
    const int b = u >> 6;
    __syncthreads();
    for (int j = tid; j < 2048; j += 512) {
      float s = a.b_ada[j];
#pragma unroll
      for (int ks = 0; ks < ADA_KS; ++ks) s += modp[(ks * 4 + b) * 6144 + j];
      sh[j] = s;
    }
    __syncthreads();
    for (int i0 = 0; i0 < 8; i0 += 4) {
      float4 xv[4][4];
#pragma unroll
      for (int i = 0; i < 4; ++i)
#pragma unroll
        for (int j = 0; j < 4; ++j) xv[i][j] = *(const float4*)(a.x + (size_t)(u * 64 + wv * 8 + i0 + i) * 1024 + j * 256 + lane * 4);
#pragma unroll
      for (int i = 0; i < 4; ++i) {
        const int r = u * 64 + wv * 8 + i0 + i;
        float ssq = 0.f;
#pragma unroll
        for (int j = 0; j < 4; ++j) ssq += xv[i][j].x * xv[i][j].x + xv[i][j].y * xv[i][j].y + xv[i][j].z * xv[i][j].z + xv[i][j].w * xv[i][j].w;
        ssq = wave_sum(ssq);
        const float rstd = rsqrtf(ssq * (1.f / 1024.f) + EPS);
#pragma unroll
        for (int j = 0; j < 4; ++j) {
          const int col = j * 256 + lane * 4;
          const float4 g = *(const float4*)(a.g_norm1 + col);
          const float h0 = xv[i][j].x * rstd * g.x * (1.f + sh[1024 + col]) + sh[col];
          const float h1 = xv[i][j].y * rstd * g.y * (1.f + sh[1024 + col + 1]) + sh[col + 1];
          const float h2 = xv[i][j].z * rstd * g.z * (1.f + sh[1024 + col + 2]) + sh[col + 2];
          const float h3 = xv[i][j].w * rstd * g.w * (1.f + sh[1024 + col + 3]) + sh[col + 3];
          uint2 o = {pack2(h0, h1), pack2(h2, h3)};
          *(uint2*)(H + (size_t)r * 1024 + col) = o;
        }
      }
    }
  }
}

constexpr int G_STAGE = 49152;
__device__ __forceinline__ void dma16(const void* gsrc, unsigned lds_dst) {
  unsigned keep;
  asm volatile("s_mov_b32 %0, m0\n\ts_mov_b32 m0, %2\n\ts_nop 0\n\tglobal_load_lds_dwordx4 %1, off\n\ts_mov_b32 m0, %0"
               : "=&s"(keep) : "v"(gsrc), "s"(lds_dst) : "memory");
}
__device__ __forceinline__ void gemm_128x256(const u16* __restrict__ A, int lda, const u16* __restrict__ Bt, int ldb, int KT,
                                             f32x16 (&acc)[2][2], char* lds) {
  const int tid = threadIdx.x, lane = tid & 63, wv = __builtin_amdgcn_readfirstlane(tid >> 6), r32 = lane & 31, hi = lane >> 5;
  const int wm = wv >> 2, wn = wv & 3;
  const int rin = lane >> 3, cc = lane & 7;
  const u16* pa[2]; const u16* pb[4];
#pragma unroll
  for (int j = 0; j < 2; ++j) pa[j] = A + (size_t)(16 * wv + 8 * j + rin) * lda + 8 * (cc ^ (4 * j + (rin >> 1)));
#pragma unroll
  for (int i = 0; i < 4; ++i) pb[i] = Bt + (size_t)(32 * wv + 8 * i + rin) * ldb + 8 * (cc ^ (4 * (i & 1) + (rin >> 1)));
  const unsigned lb = __builtin_amdgcn_readfirstlane((unsigned)(uintptr_t)lds);
  const unsigned dA = lb + 2048 * wv, dB = lb + 16384 + 4096 * wv;
#define G_ISSUE(stage, kt_) do { const unsigned _so = (unsigned)(stage) * G_STAGE; const int _ko = (kt_) * 64;                     \
    dma16(pa[0] + _ko, dA + _so); dma16(pa[1] + _ko, dA + _so + 1024);                                                           \
    dma16(pb[0] + _ko, dB + _so); dma16(pb[1] + _ko, dB + _so + 1024); dma16(pb[2] + _ko, dB + _so + 2048); dma16(pb[3] + _ko, dB + _so + 3072); } while (0)
#pragma unroll
  for (int m = 0; m < 2; ++m)
#pragma unroll
    for (int n = 0; n < 2; ++n)
#pragma unroll
      for (int r = 0; r < 16; ++r) acc[m][n][r] = 0.f;
  __syncthreads();
  G_ISSUE(0, 0);
  if (KT > 1) G_ISSUE(1, 1);
  const int xa = (r32 >> 1) & 7;
  const int aoff = (64 * wm + r32) * 128, boff = 16384 + (64 * wn + r32) * 128;
  int st = 0;
  for (int kt = 0; kt < KT; ++kt) {
    if (kt + 1 < KT) asm volatile("s_waitcnt vmcnt(6)\n\ts_barrier" ::: "memory");
    else             asm volatile("s_waitcnt vmcnt(0)\n\ts_barrier" ::: "memory");
    const int s2 = st == 0 ? 2 : st - 1;
    if (kt + 2 < KT && wv < 4) G_ISSUE(s2, kt + 2);
    const char* buf = lds + st * G_STAGE;
    __builtin_amdgcn_s_setprio(1);
    bf16x8 fa[2][2], fb[2][2];
#define G_LDF(S, SET) do { const int _cb = ((2 * (S) + hi) ^ xa) << 4;                                                      \
      fa[SET][0] = *(const bf16x8*)(buf + aoff + _cb); fa[SET][1] = *(const bf16x8*)(buf + aoff + 4096 + _cb);              \
      fb[SET][0] = *(const bf16x8*)(buf + boff + _cb); fb[SET][1] = *(const bf16x8*)(buf + boff + 4096 + _cb); } while (0)
#define G_MM(SET) do { acc[0][0] = MFMA32(fa[SET][0], fb[SET][0], acc[0][0]); acc[0][1] = MFMA32(fa[SET][0], fb[SET][1], acc[0][1]);   \
      acc[1][0] = MFMA32(fa[SET][1], fb[SET][0], acc[1][0]); acc[1][1] = MFMA32(fa[SET][1], fb[SET][1], acc[1][1]); } while (0)
    G_LDF(0, 0); __builtin_amdgcn_sched_barrier(0);
    G_LDF(1, 1); __builtin_amdgcn_sched_barrier(0); G_MM(0); __builtin_amdgcn_sched_barrier(0);
    G_LDF(2, 0); __builtin_amdgcn_sched_barrier(0); G_MM(1); __builtin_amdgcn_sched_barrier(0);
    G_LDF(3, 1); __builtin_amdgcn_sched_barrier(0); G_MM(0); __builtin_amdgcn_sched_barrier(0);
    G_MM(1);
#undef G_LDF
#undef G_MM
    __builtin_amdgcn_s_setprio(0);
    if (kt + 2 < KT && wv >= 4) G_ISSUE(s2, kt + 2);
    st = st == 2 ? 0 : st + 1;
  }
#undef G_ISSUE
  __syncthreads();
}
constexpr int CLD = 257;
__device__ __forceinline__ void acc_to_lds(const f32x16 (&acc)[2][2], float* Cl) {
  const int lane = threadIdx.x & 63, wv = threadIdx.x >> 6, r32 = lane & 31, hi = lane >> 5, wm = wv >> 2, wn = wv & 3;
#pragma unroll
  for (int m = 0; m < 2; ++m)
#pragma unroll
    for (int n = 0; n < 2; ++n)
#pragma unroll
      for (int r = 0; r < 16; ++r) Cl[(64 * wm + 32 * m + crow(r, hi)) * CLD + 64 * wn + 32 * n + r32] = acc[m][n][r];
}

constexpr int G2_STAGE = 65536;
__device__ __forceinline__ void gemm_256x256_wide(const u16* __restrict__ A, int lda, const u16* __restrict__ Bt, int ldb, int KT, f32x16 (&acc)[8], char* lds) {
  const int tid = threadIdx.x, lane = tid & 63, wv = __builtin_amdgcn_readfirstlane(tid >> 6), r32 = lane & 31, hi = lane >> 5;
  const int rin = lane >> 3, cc = lane & 7;
  const u16* pa[4]; const u16* pb[4];
#pragma unroll
  for (int i = 0; i < 4; ++i) {
    pa[i] = A + (size_t)(32 * wv + 8 * i + rin) * lda + 8 * (cc ^ (4 * (i & 1) + (rin >> 1)));
    pb[i] = Bt + (size_t)(32 * wv + 8 * i + rin) * ldb + 8 * (cc ^ (4 * (i & 1) + (rin >> 1)));
  }
  const unsigned lb = __builtin_amdgcn_readfirstlane((unsigned)(uintptr_t)lds);
  const unsigned dA = lb + 4096 * wv, dB = lb + 32768 + 4096 * wv;
#define G_ISSUE(stage, kt_) do { const unsigned _so = (unsigned)(stage) * G2_STAGE; const int _ko = (kt_) * 64;                    \
    dma16(pa[0] + _ko, dA + _so); dma16(pa[1] + _ko, dA + _so + 1024); dma16(pa[2] + _ko, dA + _so + 2048); dma16(pa[3] + _ko, dA + _so + 3072);   \
    dma16(pb[0] + _ko, dB + _so); dma16(pb[1] + _ko, dB + _so + 1024); dma16(pb[2] + _ko, dB + _so + 2048); dma16(pb[3] + _ko, dB + _so + 3072); } while (0)
#pragma unroll
  for (int m = 0; m < 8; ++m)
#pragma unroll
    for (int r = 0; r < 16; ++r) acc[m][r] = 0.f;
  __syncthreads();
  G_ISSUE(0, 0);
  const int xa = (r32 >> 1) & 7;
  const int aoff = r32 * 128, boff = 32768 + (32 * wv + r32) * 128;
  for (int kt = 0; kt < KT; ++kt) {
    asm volatile("s_waitcnt vmcnt(0)\n\ts_barrier" ::: "memory");
    if (kt + 1 < KT) G_ISSUE((kt + 1) & 1, kt + 1);
    const char* buf = lds + (kt & 1) * G2_STAGE;
    __builtin_amdgcn_s_setprio(1);
    bf16x8 fa[8], fb[4];
#pragma unroll
    for (int s = 0; s < 4; ++s) fb[s] = *(const bf16x8*)(buf + boff + (((2 * s + hi) ^ xa) << 4));
    { const int cb0 = (hi ^ xa) << 4;
#pragma unroll
      for (int m = 0; m < 8; ++m) fa[m] = *(const bf16x8*)(buf + aoff + 4096 * m + cb0); }
#pragma unroll
    for (int s = 0; s < 4; ++s) {
      const int cbn = ((2 * (s + 1) + hi) ^ xa) << 4;
#pragma unroll
      for (int m = 0; m < 8; ++m) { acc[m] = MFMA32(fa[m], fb[s], acc[m]); if (s < 3) fa[m] = *(const bf16x8*)(buf + aoff + 4096 * m + cbn); }
    }
    __builtin_amdgcn_s_setprio(0);
  }
#undef G_ISSUE
  __syncthreads();
}

__device__ __forceinline__ void xcd_unit(int u, int per, int& panel, int& sub) {
  if (gridDim.x == 256) { const int x = u & 7, k = ((u & 255) >> 3) + 32 * (u >> 8); panel = x + 8 * (k / per); sub = k % per; }
  else { panel = u / per; sub = u % per; }
}
__device__ void phase1b(const Args& a, char* lds) {
  unsigned char* ws = a.ws;
  const int tid = threadIdx.x, lane = tid & 63, wv = tid >> 6;
  const u16* KEYS = (const u16*)(ws + WS_KEYS); const u16* WPQB = (const u16*)(ws + WS_WPQ); u16* WST = (u16*)(ws + WS_WST);
  const float* modp = (const float*)(ws + WS_MODP); float* BIASP = (float*)(ws + WS_BIASP);
  char* gl = lds + LDS_DATA; float* Cl = (float*)gl;
  float* gsl = (float*)(gl + 131584);
  for (int u = blockIdx.x; u < 256; u += gridDim.x) {
    const int hh = u >> 4, nt = (u >> 2) & 3, b = u & 3;
    f32x16 acc[2][2];
    gemm_128x256(KEYS + (size_t)hh * 16384, 128, WPQB + (size_t)(nt * 256) * 2048 + hh * 128, 2048, 2, acc, gl);
    acc_to_lds(acc, Cl);
    for (int j = tid; j < 512; j += 512) {
      const int which = j >> 8, k = nt * 256 + (j & 255), m = (which ? 3072 : 4096) + k;
      float v = a.b_ada[m];
#pragma unroll
      for (int ks = 0; ks < ADA_KS; ++ks) v += modp[(ks * 4 + b) * 6144 + m];
      gsl[j] = which ? v : a.g_norm2[k] * (1.f + v);
    }
    __syncthreads();
    for (int i = 0; i < 16; ++i) {
      const int row = wv * 16 + i; const size_t n = (size_t)hh * 128 + row;
      float bp = 0.f, w[4];
#pragma unroll
      for (int j = 0; j < 4; ++j) { const float v = Cl[row * CLD + 4 * lane + j]; w[j] = v * gsl[4 * lane + j]; bp += v * gsl[256 + 4 * lane + j]; }
      *(uint2*)(WST + ((size_t)b * 2048 + n) * 1024 + nt * 256 + 4 * lane) = make_uint2(pack2(w[0], w[1]), pack2(w[2], w[3]));
      bp = wave_sum(bp);
      if (lane == 0) BIASP[((size_t)nt * 4 + b) * 2048 + n] = bp;
    }
    __syncthreads();
  }
}

__device__ void phase2(const Args& a, char* lds) {
  unsigned char* ws = a.ws;
  const int tid = threadIdx.x, lane = tid & 63, wv = tid >> 6;
  const u16* H = (const u16*)(ws + WS_H); const u16* WIN = (const u16*)(ws + WS_WIN);
  u16* QA = (u16*)(ws + WS_QA); u16* KV = (u16*)(ws + WS_KV); u16* UACT = (u16*)(ws + WS_UACT); u16* GVT = (u16*)(ws + WS_GVT);
  float* SSQV = (float*)(ws + WS_SSQV); const float* CS = (const float*)(ws + WS_CS);
  char* gl = lds + LDS_DATA; float* Cl = (float*)gl;
  for (int u = blockIdx.x; u < 128 * 6; u += gridDim.x) {
    int mt, nt; xcd_unit(u, 6, mt, nt); const int R0 = mt * 128;
    f32x16 acc[2][2];
    gemm_128x256(H + (size_t)R0 * 1024, 1024, WIN + (size_t)(nt * 256) * 1024, 1024, 16, acc, gl);
    acc_to_lds(acc, Cl);
    __syncthreads();
    if (nt == 0) {
      for (int i = 0; i < 16; ++i) {
        const int row = wv * 16 + i; float v[4], ssq = 0.f;
#pragma unroll
        for (int j = 0; j < 4; ++j) { v[j] = Cl[row * CLD + lane + 64 * j]; ssq += v[j] * v[j]; }
        ssq = wave_sum(ssq);
        const float rstd = rsqrtf(ssq * (1.f / 256.f) + EPS);
#pragma unroll
        for (int j = 0; j < 4; ++j) { const int col = lane + 64 * j; QA[(size_t)(R0 + row) * 256 + col] = f2bf(v[j] * rstd * a.g_q_a[col]); }
      }
    } else if (nt == 1) {
#pragma unroll 4
      for (int i = 0; i < 16; ++i) {
        const int row = wv * 16 + i, tok = R0 + row;
        const float v0 = Cl[row * CLD + lane], v1 = Cl[row * CLD + 64 + lane];
        const float ssq = wave_sum(v0 * v0 + v1 * v1);
        const float rstd = rsqrtf(ssq * (1.f / 128.f) + EPS);
        KV[(size_t)tok * 192 + lane] = f2bf(v0 * rstd * a.g_kv_a[lane]);
        KV[(size_t)tok * 192 + 64 + lane] = f2bf(v1 * rstd * a.g_kv_a[64 + lane]);
        if (lane < 32) {
          const float x1 = Cl[row * CLD + 128 + lane], x2 = Cl[row * CLD + 160 + lane];
          const float cs = CS[(size_t)tok * 64 + lane], sn = CS[(size_t)tok * 64 + 32 + lane];
          KV[(size_t)tok * 192 + 128 + lane] = f2bf(x1 * cs - x2 * sn);
          KV[(size_t)tok * 192 + 160 + lane] = f2bf(x2 * cs + x1 * sn);
        }
      }
    } else if (nt < 4) {
      for (int i = 0; i < 16; ++i) {
        const int row = wv * 16 + i;
#pragma unroll
        for (int j = 0; j < 4; ++j) { const int col = lane + 64 * j; UACT[(size_t)(R0 + row) * 512 + (nt - 2) * 256 + col] = f2bf(gelu_exact(Cl[row * CLD + col])); }
      }
    } else {
      for (int i = 0; i < 16; ++i) {
        const int row = wv * 16 + i; float ssq = 0.f;
#pragma unroll
        for (int j = 0; j < 4; ++j) { const int col = lane + 64 * j; const float g = gelu_exact(Cl[row * CLD + col]); const float gb = bflo((unsigned)f2bf(g)); ssq += gb * gb; Cl[row * CLD + col] = gb; }
        ssq = wave_sum(ssq);
        if (lane == 0) SSQV[(size_t)(R0 + row) * 2 + (nt - 4)] = ssq;
      }
      __syncthreads();
      for (int i = 0; i < 32; ++i) {
        const int c = wv * 32 + i;
        const float g0 = Cl[(2 * lane) * CLD + c], g1 = Cl[(2 * lane + 1) * CLD + c];
        *(unsigned*)(GVT + ((size_t)mt * 512 + (nt - 4) * 256 + c) * 128 + 2 * lane) = pack2(g0, g1);
      }
    }
    __syncthreads();
  }
}

__device__ void phase3(const Args& a, char* lds) {
  unsigned char* ws = a.ws;
  const int tid = threadIdx.x, lane = tid & 63, wv = tid >> 6, r32 = lane & 31, hi = lane >> 5;
  const u16* QA = (const u16*)(ws + WS_QA); const u16* WQ2 = (const u16*)(ws + WS_WQ2);
  u16* Q = (u16*)(ws + WS_Q); const float* CS = (const float*)(ws + WS_CS);
  const u16* UACT = (const u16*)(ws + WS_UACT); const u16* GVT = (const u16*)(ws + WS_GVT); const u16* WSG = (const u16*)(ws + WS_WSG);
  const float* SSQV = (const float*)(ws + WS_SSQV); u16* Y = (u16*)(ws + WS_Y);
  char* gl = lds + LDS_DATA; float* Cl = (float*)gl;
  for (int u = blockIdx.x; u < 384; u += gridDim.x) {
    {
      int mt, nt; xcd_unit(u, 3, mt, nt); const int R0 = mt * 128;
      f32x16 acc[2][2];
      gemm_128x256(QA + (size_t)R0 * 256, 256, WQ2 + (size_t)(nt * 256) * 256, 256, 4, acc, gl);
      acc_to_lds(acc, Cl);
      __syncthreads();
      if (nt < 2) {
        for (int i = 0; i < 16; ++i) {
          const int row = wv * 16 + i;
#pragma unroll
          for (int j = 0; j < 4; ++j) { const int n = nt * 256 + lane + 64 * j; Q[(size_t)(R0 + row) * 768 + (n >> 7) * 192 + (n & 127)] = f2bf(Cl[row * CLD + lane + 64 * j]); }
        }
      } else {
#pragma unroll 4
        for (int i = 0; i < 16; ++i) {
          const int row = wv * 16 + i, tok = R0 + row;
#pragma unroll
          for (int j = 0; j < 2; ++j) {
            const int idx = lane + 64 * j, h = idx >> 5, jj = idx & 31;
            const float x1 = Cl[row * CLD + h * 64 + jj], x2 = Cl[row * CLD + h * 64 + 32 + jj];
            const float cs = CS[(size_t)tok * 64 + jj], sn = CS[(size_t)tok * 64 + 32 + jj];
            Q[(size_t)tok * 768 + h * 192 + 128 + jj] = f2bf(x1 * cs - x2 * sn);
            Q[(size_t)tok * 768 + h * 192 + 160 + jj] = f2bf(x2 * cs + x1 * sn);
          }
        }
      }
      __syncthreads();
    }
  }
  for (int su = blockIdx.x; su < 256; su += gridDim.x) {
    {
      const int c = su >> 1, ph = su & 1;
      float* rs = (float*)gl;
      float* Yl = (float*)(gl + 512);
      __syncthreads();
      if (tid < 128) { const size_t t = (size_t)c * 128 + tid; rs[tid] = rsqrtf((SSQV[t * 2] + SSQV[t * 2 + 1]) * (1.f / 512.f) + EPS); }
      __syncthreads();
      const int h = wv >> 1, dh = wv & 1;
      f32x16 acc[2][2];
#pragma unroll
      for (int m = 0; m < 2; ++m)
#pragma unroll
        for (int n = 0; n < 2; ++n)
#pragma unroll
          for (int r = 0; r < 16; ++r) acc[m][n][r] = 0.f;
      for (int s = 0; s < 8; ++s) {
        const int q0 = 16 * s + 8 * hi;
        bf16x8 af[2], bfr[2];
#pragma unroll
        for (int m = 0; m < 2; ++m) af[m] = *(const bf16x8*)(WSG + ((size_t)h * 128 + ph * 64 + 32 * m + r32) * 128 + q0);
        float rq[8];
#pragma unroll
        for (int j = 0; j < 8; ++j) rq[j] = rs[q0 + j];
#pragma unroll
        for (int n = 0; n < 2; ++n) {
          const u32x4 w = *(const u32x4*)(GVT + ((size_t)c * 512 + h * 128 + dh * 64 + 32 * n + r32) * 128 + q0);
          u32x4 o;
#pragma unroll
          for (int k = 0; k < 4; ++k) o[k] = pack2(bflo(w[k]) * rq[2 * k], bfhi(w[k]) * rq[2 * k + 1]);
          bfr[n] = __builtin_bit_cast(bf16x8, o);
        }
#pragma unroll
        for (int m = 0; m < 2; ++m)
#pragma unroll
          for (int n = 0; n < 2; ++n) acc[m][n] = MFMA32(af[m], bfr[n], acc[m][n]);
      }
#pragma unroll
      for (int m = 0; m < 2; ++m)
#pragma unroll
        for (int n = 0; n < 2; ++n)
#pragma unroll
          for (int r = 0; r < 16; ++r) {
            const int pl = 32 * m + crow(r, hi), col = h * 128 + dh * 64 + 32 * n + r32;
            const size_t tok = (size_t)c * 128 + ph * 64 + pl;
            const float mix = acc[m][n][r] * a.g_sg[col] + a.b_sg[h * 128 + ph * 64 + pl];
            Yl[pl * 513 + col] = bflo((unsigned)UACT[tok * 512 + col]) * mix;
          }
      __syncthreads();
      for (int i = 0; i < 8; ++i) {
        const int pl = wv * 8 + i; const size_t tok = (size_t)c * 128 + ph * 64 + pl;
        float v[8], ssq = 0.f;
#pragma unroll
        for (int j = 0; j < 8; ++j) { v[j] = Yl[pl * 513 + lane + 64 * j]; ssq += v[j] * v[j]; }
        ssq = wave_sum(ssq);
        const float rstd = rsqrtf(ssq * (1.f / 512.f) + EPS);
#pragma unroll
        for (int j = 0; j < 8; ++j) { const int col = lane + 64 * j; Y[tok * 1024 + 512 + col] = f2bf(v[j] * rstd * a.g_sg_out[col]); }
      }
      __syncthreads();
    }
  }
}

constexpr float ATT_SCALE = 0.07216878364870322f;
constexpr float ATT_THR = 8.f;
constexpr int KVBUF = 24576;
#define SBAR() __builtin_amdgcn_sched_barrier(0)
__device__ __forceinline__ unsigned cvtpk(float lo, float hi) { unsigned r; asm volatile("v_cvt_pk_bf16_f32 %0, %1, %2" : "=v"(r) : "v"(lo), "v"(hi)); return r; }
__device__ __forceinline__ unsigned off_a(unsigned row, unsigned ch) { return 2048u * (row >> 3) + 512u * (ch >> 2) + 64u * (row & 7) + 16u * ((ch & 3) ^ ((row >> 2) & 3)); }

__device__ __forceinline__ void partialSM(f32x16& p0, f32x16& p1, float& m_reg, float& mn, float& alpha) {
  constexpr float C = ATT_SCALE * 1.4426950408889634f;
  float pmax = p0[0];
#pragma unroll
  for (int r = 1; r < 16; ++r) pmax = fmaxf(pmax, p0[r]);
#pragma unroll
  for (int r = 0; r < 16; ++r) pmax = fmaxf(pmax, p1[r]);
  { auto rr = __builtin_amdgcn_permlane32_swap(__float_as_uint(pmax), __float_as_uint(pmax), false, false);
    pmax = fmaxf(__uint_as_float(rr[0]), __uint_as_float(rr[1])); }
  if (__builtin_expect(__all(pmax - m_reg <= ATT_THR / ATT_SCALE), 1)) { mn = m_reg; alpha = 1.f; }
  else { mn = fmaxf(m_reg, pmax); alpha = __builtin_amdgcn_exp2f((m_reg - mn) * C); m_reg = mn; }
  const float mnC = -mn * C;
#pragma unroll
  for (int r = 0; r < 16; ++r) p0[r] = fmaf(p0[r], C, mnC);
#pragma unroll
  for (int r = 0; r < 16; ++r) p1[r] = fmaf(p1[r], C, mnC);
#pragma unroll
  for (int r = 0; r < 16; ++r) p0[r] = __builtin_amdgcn_exp2f(p0[r]);
}
__device__ __forceinline__ void finishSM(f32x16& p0, f32x16& p1, float alpha, float& l_reg, bf16x8& pa0, bf16x8& pa1, bf16x8& pa2, bf16x8& pa3) {
#pragma unroll
  for (int r = 0; r < 16; ++r) p1[r] = __builtin_amdgcn_exp2f(p1[r]);
  float ps = 0;
#pragma unroll
  for (int r = 0; r < 16; ++r) ps += p0[r];
#pragma unroll
  for (int r = 0; r < 16; ++r) ps += p1[r];
  { auto rr = __builtin_amdgcn_permlane32_swap(__float_as_uint(ps), __float_as_uint(ps), false, false);
    ps = __uint_as_float(rr[0]) + __uint_as_float(rr[1]); }
  l_reg = l_reg * alpha + ps;
#define PK4(P, BASE, OUT) do { unsigned a0 = cvtpk(P[BASE + 0], P[BASE + 1]), a1 = cvtpk(P[BASE + 2], P[BASE + 3]);   \
    unsigned b0 = cvtpk(P[BASE + 4], P[BASE + 5]), b1 = cvtpk(P[BASE + 6], P[BASE + 7]);                              \
    auto r0 = __builtin_amdgcn_permlane32_swap(a0, b0, false, false); auto r1 = __builtin_amdgcn_permlane32_swap(a1, b1, false, false); \
    u32x4 w = {r0[0], r1[0], r0[1], r1[1]}; OUT = __builtin_bit_cast(bf16x8, w); } while (0)
  PK4(p0, 0, pa0); PK4(p0, 8, pa1); PK4(p1, 0, pa2); PK4(p1, 8, pa3);
#undef PK4
}
__device__ __forceinline__ void qkt192(f32x16& p0, f32x16& p1, const char* kb, const char* qb, int ke, int ko, int kr) {
#pragma unroll
  for (int r = 0; r < 16; ++r) { p0[r] = 0.f; p1[r] = 0.f; }
#pragma unroll
  for (int d0 = 0; d0 < 8; ++d0) {
    const int o = ((d0 & 1) ? ko : ke) + 512 * (d0 >> 1);
    const bf16x8 b0 = *(const bf16x8*)(kb + o), b1 = *(const bf16x8*)(kb + o + 8192), q = *(const bf16x8*)(qb + 32 * d0);
    p0 = MFMA32(b0, q, p0); p1 = MFMA32(b1, q, p1);
  }
#pragma unroll
  for (int d1 = 0; d1 < 4; ++d1) {
    const int o = 16384 + (kr ^ (32 * d1));
    const bf16x8 b0 = *(const bf16x8*)(kb + o), b1 = *(const bf16x8*)(kb + o + 4096), q = *(const bf16x8*)(qb + 256 + 32 * d1);
    p0 = MFMA32(b0, q, p0); p1 = MFMA32(b1, q, p1);
  }
}
template <int OFF> __device__ __forceinline__ s16x4 tr_read(int vb) {
  s16x4 r; asm volatile("ds_read_b64_tr_b16 %0, %1 offset:%2" : "=&v"(r) : "v"(vb), "i"(OFF) : "memory"); return r;
}
template <int C> __device__ __forceinline__ void pv_one(f32x16& od, int vb0, int vb1, bf16x8 pa0, bf16x8 pa1, bf16x8 pa2, bf16x8 pa3) {
  const s16x4 l0 = tr_read<512 * C>(vb0), h0 = tr_read<512 * C>(vb1), l1 = tr_read<4096 + 512 * C>(vb0), h1 = tr_read<4096 + 512 * C>(vb1);
  const s16x4 l2 = tr_read<8192 + 512 * C>(vb0), h2 = tr_read<8192 + 512 * C>(vb1), l3 = tr_read<12288 + 512 * C>(vb0), h3 = tr_read<12288 + 512 * C>(vb1);
  asm volatile("s_waitcnt lgkmcnt(0)" ::: "memory"); SBAR();
#define PKV(L, H) (bf16x8){L[0], L[1], L[2], L[3], H[0], H[1], H[2], H[3]}
  od = MFMA32(pa0, PKV(l0, h0), od); od = MFMA32(pa1, PKV(l1, h1), od);
  od = MFMA32(pa2, PKV(l2, h2), od); od = MFMA32(pa3, PKV(l3, h3), od);
#undef PKV
}
__device__ __forceinline__ void pv_all(f32x16* o, int vb0, int vb1, bf16x8 pa0, bf16x8 pa1, bf16x8 pa2, bf16x8 pa3) {
  pv_one<0>(o[0], vb0, vb1, pa0, pa1, pa2, pa3); pv_one<1>(o[1], vb0, vb1, pa0, pa1, pa2, pa3);
  pv_one<2>(o[2], vb0, vb1, pa0, pa1, pa2, pa3); pv_one<3>(o[3], vb0, vb1, pa0, pa1, pa2, pa3);
}

__device__ void phase4(const Args& a, char* lds) {
  unsigned char* ws = a.ws;
  const int tid = threadIdx.x, wid = tid >> 6, lane = tid & 63, r32 = lane & 31, hi = lane >> 5;
  const u16* Qg = (const u16*)(ws + WS_Q); const u16* KVg = (const u16*)(ws + WS_KV); const u16* WUV = (const u16*)(ws + WS_WUV);
  u16* Y = (u16*)(ws + WS_Y);
  char* gl = lds + LDS_DATA;
  char* kvl = gl;
  float* wsl = (float*)(gl + 2 * KVBUF) + wid * 64; float* li_l = wsl; float* al_l = wsl + 32;
  float* Yl = (float*)gl;
  const int head = wid >> 1, qh = wid & 1;
  int sdst[3];
#pragma unroll
  for (int j = 0; j < 3; ++j) { const int id = tid + 512 * j, key = id / 24, ch = id % 24;
    sdst[j] = ch < 16 ? (int)off_a(key, ch) : 16384 + key * 128 + (((ch - 16) ^ ((key >> 1) & 7)) << 4); }
  const int xq = (r32 >> 2) & 3;
  const int ke = 2048 * (r32 >> 3) + 64 * (r32 & 7) + 16 * (hi ^ xq), ko = 2048 * (r32 >> 3) + 64 * (r32 & 7) + 16 * ((2 + hi) ^ xq);
  const int kr = r32 * 128 + ((hi ^ ((r32 >> 1) & 7)) << 4);
  const int tb = lane >> 4 & 1, tq = (lane & 15) >> 2, tp = lane & 3;
  const int vbl = 2048 * hi + 64 * tq + 32 * (tb ^ hi) + 8 * (tp & 1);
  const int lbase = (int)(uintptr_t)kvl;
  const int vb0 = lbase + vbl + 16 * (tp >> 1), vb1 = lbase + vbl + 256 + 16 * ((tp >> 1) ^ 1);
  for (int u = blockIdx.x; u < 256; u += gridDim.x) {
    const int b = u >> 6, qb_ = u & 63;
    const size_t tok0 = (size_t)b * SEQ + qb_ * 64 + qh * 32;
    const u16* KVb = KVg + (size_t)b * SEQ * 192;
    float m_reg = -1e30f, l_reg = 0.f; f32x16 o[4];
#pragma unroll
    for (int d = 0; d < 4; ++d)
#pragma unroll
      for (int r = 0; r < 16; ++r) o[d][r] = 0.f;
    char* Ql = gl + 2 * KVBUF + 2048;
    const char* qb = Ql + (qh * 32 + r32) * 1552 + (head * 192 + 8 * hi) * 2;
    u32x4 st0[3];
#define SLOAD(S, k0) do { const u16* _p = KVb + (size_t)(k0) * 192 + tid * 8; S[0] = *(const u32x4*)_p; S[1] = *(const u32x4*)(_p + 4096); S[2] = *(const u32x4*)(_p + 8192); } while (0)
#define SWRITE(bufi, S) do { char* _d = kvl + (bufi) * KVBUF; *(u32x4*)(_d + sdst[0]) = S[0]; *(u32x4*)(_d + sdst[1]) = S[1]; *(u32x4*)(_d + sdst[2]) = S[2]; } while (0)
#define RESC(al) do { if (__any((al) < 1.f)) { if (hi == 0) al_l[r32] = (al); asm volatile("s_waitcnt lgkmcnt(0)" ::: "memory"); \
    _Pragma("unroll") for (int d = 0; d < 4; ++d) _Pragma("unroll") for (int r = 0; r < 16; ++r) o[d][r] *= al_l[crow(r, hi)]; } } while (0)
#define CVT_LOAD(tile) const unsigned cit = ((unsigned)(u * 64 + (tile)) << 9) | (unsigned)tid; const bool cisv = cit >= 4194304u;                \
      const unsigned cio = cisv ? cit - 4194304u : cit; const float4 cf = *(const float4*)((cisv ? a.peer_v : a.peer_u) + (size_t)cio * 4)
#define CVT_STORE() do { const float csc = cisv ? PEER_SV : PEER_SU;                                                                               \
      int cp = __builtin_amdgcn_cvt_pk_fp8_f32(cf.x * csc, cf.y * csc, 0, false); cp = __builtin_amdgcn_cvt_pk_fp8_f32(cf.z * csc, cf.w * csc, cp, true); \
      *(int*)(ws + (cisv ? WS_VB : WS_UB) + (size_t)cio * 4) = cp; } while (0)
    constexpr int NT = SEQ / 64;
    f32x16 pA0, pA1, pB0, pB1; float mnA, mnB, alA, alB; bf16x8 pa0, pa1, pa2, pa3;
    __syncthreads();
    { const u16* Qu = Qg + ((size_t)b * SEQ + qb_ * 64) * 768; int tq_ = tid; asm volatile("" : "+v"(tq_));
#pragma unroll
      for (int i = 0; i < 12; ++i) { const int id = tq_ + 512 * i, row = id / 96, c = id % 96; *(u32x4*)(Ql + row * 1552 + c * 16) = *(const u32x4*)(Qu + (size_t)row * 768 + c * 8); } }
    SLOAD(st0, 0); SWRITE(0, st0); SLOAD(st0, 64); __syncthreads();
    { CVT_LOAD(0);
      qkt192(pA0, pA1, kvl, qb, ke, ko, kr); partialSM(pA0, pA1, m_reg, mnA, alA);
      SWRITE(1, st0); CVT_STORE(); }
    __syncthreads();
    for (int j = 1; j + 1 < NT; j += 2) {
      { CVT_LOAD(j);
        SBAR(); qkt192(pB0, pB1, kvl + KVBUF, qb, ke, ko, kr);
        finishSM(pA0, pA1, alA, l_reg, pa0, pa1, pa2, pa3); SBAR();
        SLOAD(st0, (j + 1) * 64); SBAR();
        pv_all(o, vb0, vb1, pa0, pa1, pa2, pa3); partialSM(pB0, pB1, m_reg, mnB, alB);
        __syncthreads(); SWRITE(0, st0); CVT_STORE();
        RESC(alB); __syncthreads(); }
      { CVT_LOAD(j + 1);
        SBAR(); qkt192(pA0, pA1, kvl, qb, ke, ko, kr);
        finishSM(pB0, pB1, alB, l_reg, pa0, pa1, pa2, pa3); SBAR();
        if (j + 2 < NT) SLOAD(st0, (j + 2) * 64); SBAR();
        pv_all(o, vb0 + KVBUF, vb1 + KVBUF, pa0, pa1, pa2, pa3); partialSM(pA0, pA1, m_reg, mnA, alA);
        __syncthreads(); if (j + 2 < NT) SWRITE(1, st0); CVT_STORE();
        RESC(alA); __syncthreads(); }
    }
    { CVT_LOAD(NT - 1);
      SBAR(); qkt192(pB0, pB1, kvl + KVBUF, qb, ke, ko, kr);
      finishSM(pA0, pA1, alA, l_reg, pa0, pa1, pa2, pa3); SBAR();
      pv_all(o, vb0, vb1, pa0, pa1, pa2, pa3); partialSM(pB0, pB1, m_reg, mnB, alB);
      CVT_STORE();
      __syncthreads(); RESC(alB);
      finishSM(pB0, pB1, alB, l_reg, pa0, pa1, pa2, pa3); SBAR();
      pv_all(o, vb0 + KVBUF, vb1 + KVBUF, pa0, pa1, pa2, pa3); }
    __syncthreads();
#undef SLOAD
#undef SWRITE
#undef RESC
#undef CVT_LOAD
#undef CVT_STORE
    int r32e = r32, hie = hi, lne = lane, wide = __builtin_amdgcn_readfirstlane(wid);
    asm volatile("" : "+v"(r32e), "+v"(hie), "+v"(lne), "+s"(wide));
    const int heade = wide >> 1, qhe = wide & 1;
    char* Ole = gl + 2 * KVBUF + 2048 + wide * 8704;
    if (hie == 0) li_l[r32e] = l_reg;
    asm volatile("s_waitcnt lgkmcnt(0)" ::: "memory");
#pragma unroll
    for (int r = 0; r < 16; ++r) {
      const int q = crow(r, hie); const float rl = __builtin_amdgcn_rcpf(li_l[q]);
#pragma unroll
      for (int d = 0; d < 4; ++d) *(u16*)(Ole + q * 272 + (32 * d + r32e) * 2) = f2bf(o[d][r] * rl);
    }
    asm volatile("s_waitcnt lgkmcnt(0)" ::: "memory");
    f32x16 y[4];
#pragma unroll
    for (int n = 0; n < 4; ++n)
#pragma unroll
      for (int r = 0; r < 16; ++r) y[n][r] = 0.f;
    const u16* wuv = WUV + ((size_t)heade * 128 + r32e) * 128 + 8 * hie;
#pragma unroll 2
    for (int s = 0; s < 8; ++s) {
      const bf16x8 af = *(const bf16x8*)(Ole + r32e * 272 + (16 * s + 8 * hie) * 2);
#pragma unroll
      for (int n = 0; n < 4; ++n) {
        const bf16x8 bw = *(const bf16x8*)(wuv + 32 * n * 128 + 16 * s);
        y[n] = MFMA32(af, bw, y[n]);
      }
    }
    __syncthreads();
#pragma unroll
    for (int n = 0; n < 4; ++n)
#pragma unroll
      for (int r = 0; r < 16; ++r) Yl[(qhe * 32 + crow(r, hie)) * 513 + heade * 128 + 32 * n + r32e] = y[n][r];
    __syncthreads();
    for (int i = 0; i < 8; ++i) {
      const int pl = wide * 8 + i; const size_t tok = (size_t)b * SEQ + qb_ * 64 + pl;
      float v[8], ssq = 0.f;
#pragma unroll
      for (int jj = 0; jj < 8; ++jj) { v[jj] = Yl[pl * 513 + lne + 64 * jj]; ssq += v[jj] * v[jj]; }
      ssq = wave_sum(ssq);
      const float rstd = rsqrtf(ssq * (1.f / 512.f) + EPS);
#pragma unroll
      for (int jj = 0; jj < 8; ++jj) { const int col = lne + 64 * jj; Y[tok * 1024 + col] = f2bf(v[jj] * rstd * a.g_attn_out[col]); }
    }
    __syncthreads();
  }
}

__device__ void phase5(const Args& a, char* lds) {
  unsigned char* ws = a.ws;
  const int tid = threadIdx.x, lane = tid & 63, wv = tid >> 6;
  const u16* Y = (const u16*)(ws + WS_Y); const u16* WO = (const u16*)(ws + WS_WO);
  float* X1 = (float*)(ws + WS_X1); float* SSQ = (float*)(ws + WS_SSQ); const float* mod = (const float*)(ws + WS_MOD);
  u16* X1B = (u16*)(ws + WS_H);
  char* gl = lds + LDS_DATA; float* Cl = (float*)gl;
  for (int u = blockIdx.x; u < 128 * 4; u += gridDim.x) {
    int mt, nt; xcd_unit(u, 4, mt, nt); const int R0 = mt * 128, b = R0 >> 12;
    f32x16 acc[2][2];
    gemm_128x256(Y + (size_t)R0 * 1024, 1024, WO + (size_t)(nt * 256) * 1024, 1024, 16, acc, gl);
    acc_to_lds(acc, Cl);
    __syncthreads();
    float2 g1[2];
#pragma unroll
    for (int j = 0; j < 2; ++j) g1[j] = *(const float2*)(mod + b * 6144 + 2048 + nt * 256 + 2 * lane + 128 * j);
    for (int i0 = 0; i0 < 16; i0 += 8) {
      float2 xv[8][2];
#pragma unroll
      for (int i = 0; i < 8; ++i)
#pragma unroll
        for (int j = 0; j < 2; ++j) xv[i][j] = *(const float2*)(a.x + (size_t)(R0 + wv * 16 + i0 + i) * 1024 + nt * 256 + 2 * lane + 128 * j);
#pragma unroll
      for (int i = 0; i < 8; ++i) {
        const int row = wv * 16 + i0 + i; const size_t tok = R0 + row; float ssq = 0.f;
#pragma unroll
        for (int j = 0; j < 2; ++j) {
          const int col = nt * 256 + 2 * lane + 128 * j;
          const float v0 = xv[i][j].x + g1[j].x * Cl[row * CLD + 2 * lane + 128 * j], v1 = xv[i][j].y + g1[j].y * Cl[row * CLD + 2 * lane + 128 * j + 1];
          *(unsigned*)(X1B + tok * 1024 + col) = pack2(v0, v1); ssq += v0 * v0 + v1 * v1;
        }
        ssq = wave_sum(ssq);
        if (lane == 0) SSQ[tok * 4 + nt] = ssq;
      }
    }
    __syncthreads();
  }
}
__device__ __forceinline__ float vmaxf(float a, float b) { float r; asm("v_max_f32 %0, %1, %2" : "=v"(r) : "v"(a), "v"(b)); return r; }
__device__ __forceinline__ float vminf(float a, float b) { float r; asm("v_min_f32 %0, %1, %2" : "=v"(r) : "v"(a), "v"(b)); return r; }
#define TK_CE(x, y) do { const float _h = vmaxf((x), (y)); (y) = vminf((x), (y)); (x) = _h; } while (0)
#define TK_SORT16(t) do { TK_CE(t[0], t[1]); TK_CE(t[2], t[3]); TK_CE(t[0], t[2]); TK_CE(t[1], t[3]); TK_CE(t[1], t[2]); TK_CE(t[4], t[5]); TK_CE(t[6], t[7]); TK_CE(t[4], t[6]); TK_CE(t[5], t[7]); TK_CE(t[5], t[6]); TK_CE(t[0], t[4]); TK_CE(t[2], t[6]); TK_CE(t[2], t[4]); TK_CE(t[1], t[5]); TK_CE(t[3], t[7]); TK_CE(t[3], t[5]); TK_CE(t[1], t[2]); TK_CE(t[3], t[4]); TK_CE(t[5], t[6]); TK_CE(t[8], t[9]); TK_CE(t[10], t[11]); TK_CE(t[8], t[10]); TK_CE(t[9], t[11]); TK_CE(t[9], t[10]); TK_CE(t[12], t[13]); TK_CE(t[14], t[15]); TK_CE(t[12], t[14]); TK_CE(t[13], t[15]); TK_CE(t[13], t[14]); TK_CE(t[8], t[12]); TK_CE(t[10], t[14]); TK_CE(t[10], t[12]); TK_CE(t[9], t[13]); TK_CE(t[11], t[15]); TK_CE(t[11], t[13]); TK_CE(t[9], t[10]); TK_CE(t[11], t[12]); TK_CE(t[13], t[14]); TK_CE(t[0], t[8]); TK_CE(t[4], t[12]); TK_CE(t[4], t[8]); TK_CE(t[2], t[10]); TK_CE(t[6], t[14]); TK_CE(t[6], t[10]); TK_CE(t[2], t[4]); TK_CE(t[6], t[8]); TK_CE(t[10], t[12]); TK_CE(t[1], t[9]); TK_CE(t[5], t[13]); TK_CE(t[5], t[9]); TK_CE(t[3], t[11]); TK_CE(t[7], t[15]); TK_CE(t[7], t[11]); TK_CE(t[3], t[5]); TK_CE(t[7], t[9]); TK_CE(t[11], t[13]); TK_CE(t[1], t[2]); TK_CE(t[3], t[4]); TK_CE(t[5], t[6]); TK_CE(t[7], t[8]); TK_CE(t[9], t[10]); TK_CE(t[11], t[12]); TK_CE(t[13], t[14]); } while (0)
#define TK_BMERGE16(t) do { TK_CE(t[0], t[8]); TK_CE(t[1], t[9]); TK_CE(t[2], t[10]); TK_CE(t[3], t[11]); TK_CE(t[4], t[12]); TK_CE(t[5], t[13]); TK_CE(t[6], t[14]); TK_CE(t[7], t[15]); TK_CE(t[0], t[4]); TK_CE(t[1], t[5]); TK_CE(t[2], t[6]); TK_CE(t[3], t[7]); TK_CE(t[8], t[12]); TK_CE(t[9], t[13]); TK_CE(t[10], t[14]); TK_CE(t[11], t[15]); TK_CE(t[0], t[2]); TK_CE(t[1], t[3]); TK_CE(t[4], t[6]); TK_CE(t[5], t[7]); TK_CE(t[8], t[10]); TK_CE(t[9], t[11]); TK_CE(t[12], t[14]); TK_CE(t[13], t[15]); TK_CE(t[0], t[1]); TK_CE(t[2], t[3]); TK_CE(t[4], t[5]); TK_CE(t[6], t[7]); TK_CE(t[8], t[9]); TK_CE(t[10], t[11]); TK_CE(t[12], t[13]); TK_CE(t[14], t[15]); } while (0)
#define TK_MERGE(A, B) do { _Pragma("unroll") for (int _i = 0; _i < 16; ++_i) A[_i] = vmaxf(A[_i], B[15 - _i]); TK_BMERGE16(A); } while (0)
__constant__ unsigned long long TK_I[4] = {0x0000000000000000ull, 0x0007744411111111ull, 0x0006655333322222ull, 0x00000000FEDCBA98ull};
__constant__ unsigned long long TK_J[4] = {0xFEDCBA9876543210ull, 0x0001021076543210ull, 0x0001010321043210ull, 0x0000000000000000ull};
__constant__ int TK_N[4] = {16, 13, 13, 8};

__device__ void phase6(const Args& a, char* lds) {
  unsigned char* ws = a.ws;
  const int tid = threadIdx.x, lane = tid & 63, wv = tid >> 6, r32 = lane & 31, hi = lane >> 5;
  const u16* H = (const u16*)(ws + WS_H); const u16* WST = (const u16*)(ws + WS_WST);
  float* TOPS = (float*)(ws + WS_TOPK);
  const float* BIASP = (const float*)(ws + WS_BIASP); const float* SSQ = (const float*)(ws + WS_SSQ);
  char* gl = lds + LDS_DATA;
  for (int u = blockIdx.x; u < 8 * 64; u += gridDim.x) {
    int tb, hd; xcd_unit(u, 8, tb, hd);
    const int b = tb >> 4;
    f32x16 sc[8];
    gemm_256x256_wide(WST + ((size_t)b * 2048 + hd * 256) * 1024, 1024, H + (size_t)tb * 256 * 1024, 1024, 16, sc, gl);
    float* bl = (float*)gl;
    if (tid < 256) bl[tid] = BIASP[((size_t)0 * 4 + b) * 2048 + hd * 256 + tid] + BIASP[((size_t)1 * 4 + b) * 2048 + hd * 256 + tid]
                           + BIASP[((size_t)2 * 4 + b) * 2048 + hd * 256 + tid] + BIASP[((size_t)3 * 4 + b) * 2048 + hd * 256 + tid];
    const float4 sq = *(const float4*)(SSQ + (size_t)(tb * 256 + 32 * wv + r32) * 4);
    const float rstd = rsqrtf((sq.x + sq.y + sq.z + sq.w) * (1.f / 1024.f) + EPS);
    __syncthreads();
#pragma unroll
    for (int half = 0; half < 2; ++half) {
      float g0[16], g1[16], g2[16], g3[16], p[16];
#pragma unroll
      for (int r = 0; r < 16; ++r) {
        const unsigned key = crow(r, hi);
        g0[r] = __uint_as_float((__float_as_uint(fmaf(sc[4 * half + 0][r], rstd, bl[128 * half + key])) & ~127u) | key);
        g1[r] = __uint_as_float((__float_as_uint(fmaf(sc[4 * half + 1][r], rstd, bl[128 * half + 32 + key])) & ~127u) | (32u + key));
        g2[r] = __uint_as_float((__float_as_uint(fmaf(sc[4 * half + 2][r], rstd, bl[128 * half + 64 + key])) & ~127u) | (64u + key));
        g3[r] = __uint_as_float((__float_as_uint(fmaf(sc[4 * half + 3][r], rstd, bl[128 * half + 96 + key])) & ~127u) | (96u + key));
      }
      TK_SORT16(g0); TK_SORT16(g1); TK_SORT16(g2); TK_SORT16(g3);
      TK_MERGE(g0, g1); TK_MERGE(g2, g3); TK_MERGE(g0, g2);
#pragma unroll
      for (int i = 0; i < 16; ++i) {
        auto rr = __builtin_amdgcn_permlane32_swap(__float_as_uint(g0[i]), __float_as_uint(g0[i]), false, false);
        p[i] = __uint_as_float(hi ? rr[0] : rr[1]);
      }
      TK_MERGE(g0, p);
      if (hi == 0) {
        float* dst = TOPS + ((size_t)(tb * 256 + 32 * wv + r32) * 16 + 2 * hd + half) * 16;
#pragma unroll
        for (int i = 0; i < 16; i += 4) *(float4*)(dst + i) = make_float4(g0[i], g0[i + 1], g0[i + 2], g0[i + 3]);
      }
    }
  }
}

typedef __attribute__((ext_vector_type(4))) float f32x4;
#define MFMA4(a, b, c) __builtin_amdgcn_mfma_f32_4x4x4bf16_1k((a), (b), (c), 0, 0, 0)
constexpr int P7_VROW = 2112, P7_VBUF = 4 * P7_VROW;
constexpr int P7_RING = 64;
constexpr int P7_ENT  = P7_RING + 8 * 2 * P7_VBUF;
constexpr int P7_CNT  = P7_ENT + 8 * 2048;
static_assert(P7_CNT + 8 * 256 <= LDS_BYTES, "phase 7 LDS map");
__device__ __forceinline__ float sel4(const f32x4& d, int k) { return k == 0 ? d[0] : (k == 1 ? d[1] : (k == 2 ? d[2] : d[3])); }
__device__ __forceinline__ unsigned fp8x2_bf16(unsigned x, float sc, bool hi) {
  return hi ? __builtin_bit_cast(unsigned, __builtin_amdgcn_cvt_scalef32_pk_bf16_fp8(x, sc, true)) : __builtin_bit_cast(unsigned, __builtin_amdgcn_cvt_scalef32_pk_bf16_fp8(x, sc, false));
}

__device__ void phase7(const Args& a, char* lds) {
  unsigned char* ws = a.ws;
  const int tid = threadIdx.x, lane = tid & 63, wv = __builtin_amdgcn_readfirstlane(tid >> 6), blk = lane >> 2, j4 = lane & 3;
  const u16* H = (const u16*)(ws + WS_H); const unsigned char* U8 = ws + WS_UB; const unsigned char* V8 = ws + WS_VB;
  const float* TOPS = (const float*)(ws + WS_TOPK); const float* X1 = (const float*)(ws + WS_X1); const float* mod = (const float*)(ws + WS_MOD);
  const float* SSQ = (const float*)(ws + WS_SSQ);
  const unsigned lbase = (unsigned)(uintptr_t)lds;
  char* ring = lds + P7_RING + wv * 2 * P7_VBUF;
  unsigned* ents = (unsigned*)(lds + P7_ENT + wv * 2048);
  int* cntw = (int*)(lds + P7_CNT + wv * 256);
  const int trb = (int)(lbase + P7_RING + wv * 2 * P7_VBUF) + ((lane & 15) >> 2) * P7_VROW + 32 * (lane >> 4) + 8 * (lane & 3);
  const int NWV = gridDim.x * 8;
  for (int qd = blockIdx.x * 8 + wv; qd < T / 4; qd += NWV) {
    const int tok0 = qd * 4, b = tok0 >> 12;
    float* TS = (float*)ring;
#pragma unroll
    for (int i = 0; i < 4; ++i) *(float4*)(TS + 256 * i + 4 * lane) = *(const float4*)(TOPS + (size_t)tok0 * 256 + 256 * i + 4 * lane);
    cntw[lane] = 0;
    asm volatile("s_waitcnt lgkmcnt(0)" ::: "memory");
    unsigned ec[8];
#pragma unroll
    for (int rd = 0; rd < 2; ++rd) {
      const int combo = (lane >> 2) + 16 * rd, tl = combo >> 3, hd = combo & 7, q = lane & 3;
      const float* t1 = TS + (tl * 16 + hd * 2) * 16; const float* t2 = t1 + 16;
      const unsigned long long ip = TK_I[q], jp = TK_J[q]; const int cn = TK_N[q];
      float L[16], P[16];
#pragma unroll
      for (int c = 0; c < 16; ++c) {
        const unsigned i = (unsigned)(ip >> (4 * c)) & 15u, j = (unsigned)(jp >> (4 * c)) & 15u;
        const float sm = t1[i] + t2[j];
        L[c] = c < cn ? __uint_as_float((__float_as_uint(sm) & ~255u) | (i << 4) | j) : -3.0e38f;
      }
      TK_SORT16(L);
#pragma unroll
      for (int c = 0; c < 16; ++c) P[c] = __uint_as_float(__builtin_amdgcn_update_dpp(0, __float_as_uint(L[c]), 0xB1, 0xf, 0xf, false));
      TK_MERGE(L, P);
#pragma unroll
      for (int c = 0; c < 16; ++c) P[c] = __uint_as_float(__builtin_amdgcn_update_dpp(0, __float_as_uint(L[c]), 0x4E, 0xf, 0xf, false));
      TK_MERGE(L, P);
      float sum = 0.f;
      const float m0 = __uint_as_float(__float_as_uint(L[0]) & ~255u);
#pragma unroll
      for (int c = 0; c < 16; ++c) sum += __expf(__uint_as_float(__float_as_uint(L[c]) & ~255u) - m0);
      const float inv = 1.f / sum;
#pragma unroll
      for (int r = 0; r < 4; ++r) {
        const float lv = q == 0 ? L[r] : (q == 1 ? L[4 + r] : (q == 2 ? L[8 + r] : L[12 + r]));
        const unsigned bits = __float_as_uint(lv), id = bits & 255u;
        const unsigned i1 = __float_as_uint(t1[id >> 4]) & 127u, i2 = __float_as_uint(t2[id & 15u]) & 127u;
        const float gate = __expf(__uint_as_float(bits & ~255u) - m0) * inv;
        ec[4 * rd + r] = (i1 * 128u + i2) | ((unsigned)tl << 14) | (pack2(0.f, gate) & 0xFFFF0000u);
      }
    }
    {
#pragma unroll
      for (int i = 0; i < 8; ++i) atomicAdd(&cntw[(ec[i] & 0x3FFFu) >> 8], 1);
      asm volatile("s_waitcnt lgkmcnt(0)" ::: "memory");
      const int c = cntw[lane]; int inc = c;
#pragma unroll
      for (int o = 1; o < 64; o <<= 1) { const int v = __shfl_up(inc, o, 64); if (lane >= o) inc += v; }
      asm volatile("s_waitcnt lgkmcnt(0)" ::: "memory");
      cntw[lane] = inc - c;
      asm volatile("s_waitcnt lgkmcnt(0)" ::: "memory");
#pragma unroll
      for (int i = 0; i < 8; ++i) { const int pos = atomicAdd(&cntw[(ec[i] & 0x3FFFu) >> 8], 1); ents[pos] = ec[i]; }
      asm volatile("s_waitcnt lgkmcnt(0)" ::: "memory");
    }
    u32x4 hA[4][2];
    { const float4 sq = *(const float4*)(SSQ + (size_t)(tok0 + j4) * 4);
      const float rstd = rsqrtf((sq.x + sq.y + sq.z + sq.w) * (1.f / 1024.f) + EPS);
#pragma unroll
      for (int i = 0; i < 4; ++i)
#pragma unroll
        for (int hf = 0; hf < 2; ++hf) {
          const int k0 = 256 * i + 16 * blk + 8 * hf;
          const u32x4 xb = *(const u32x4*)(H + (size_t)(tok0 + j4) * 1024 + k0);
          float hv[8];
#pragma unroll
          for (int e = 0; e < 8; e += 4) {
            const float4 g = *(const float4*)(a.g_norm2 + k0 + e), sc4 = *(const float4*)(mod + b * 6144 + 4096 + k0 + e), sh4 = *(const float4*)(mod + b * 6144 + 3072 + k0 + e);
            hv[e]     = bflo(xb[e >> 1]) * rstd * g.x * (1.f + sc4.x) + sh4.x;     hv[e + 1] = bfhi(xb[e >> 1]) * rstd * g.y * (1.f + sc4.y) + sh4.y;
            hv[e + 2] = bflo(xb[(e >> 1) + 1]) * rstd * g.z * (1.f + sc4.z) + sh4.z; hv[e + 3] = bfhi(xb[(e >> 1) + 1]) * rstd * g.w * (1.f + sc4.w) + sh4.w;
          }
          hA[i][hf] = (u32x4){pack2(hv[0], hv[1]), pack2(hv[2], hv[3]), pack2(hv[4], hv[5]), pack2(hv[6], hv[7])};
        } }
    f32x4 acc[16];
#pragma unroll
    for (int c = 0; c < 16; ++c) acc[c] = (f32x4){0.f, 0.f, 0.f, 0.f};
#define P7_VPHASE(bufi) do { const int _vb = trb + (bufi) * P7_VBUF;                                                            \
      { const s16x4 v0 = tr_read<0>(_vb), v1 = tr_read<128>(_vb), v2 = tr_read<256>(_vb), v3 = tr_read<384>(_vb),               \
                    v4 = tr_read<512>(_vb), v5 = tr_read<640>(_vb), v6 = tr_read<768>(_vb), v7 = tr_read<896>(_vb);               \
        asm volatile("s_waitcnt lgkmcnt(0)" ::: "memory"); SBAR();                                                                \
        acc[0] = MFMA4(awp, v0, acc[0]); acc[1] = MFMA4(awp, v1, acc[1]); acc[2] = MFMA4(awp, v2, acc[2]); acc[3] = MFMA4(awp, v3, acc[3]);   \
        acc[4] = MFMA4(awp, v4, acc[4]); acc[5] = MFMA4(awp, v5, acc[5]); acc[6] = MFMA4(awp, v6, acc[6]); acc[7] = MFMA4(awp, v7, acc[7]); } \
      { const s16x4 v0 = tr_read<1024>(_vb), v1 = tr_read<1152>(_vb), v2 = tr_read<1280>(_vb), v3 = tr_read<1408>(_vb),         \
                    v4 = tr_read<1536>(_vb), v5 = tr_read<1664>(_vb), v6 = tr_read<1792>(_vb), v7 = tr_read<1920>(_vb);           \
        asm volatile("s_waitcnt lgkmcnt(0)" ::: "memory"); SBAR();                                                                \
        acc[8] = MFMA4(awp, v0, acc[8]); acc[9] = MFMA4(awp, v1, acc[9]); acc[10] = MFMA4(awp, v2, acc[10]); acc[11] = MFMA4(awp, v3, acc[11]); \
        acc[12] = MFMA4(awp, v4, acc[12]); acc[13] = MFMA4(awp, v5, acc[13]); acc[14] = MFMA4(awp, v6, acc[14]); acc[15] = MFMA4(awp, v7, acc[15]); } } while (0)
    u32x4 u8[4], v8[4];
#define P7_LOADG(EN) do { const unsigned _ex = (EN) & 0x3FFFu; const unsigned char* _pu = U8 + (size_t)_ex * 1024 + 16 * blk;      \
      _Pragma("unroll") for (int _i = 0; _i < 4; ++_i) u8[_i] = *(const u32x4*)(_pu + 256 * _i);                                 \
      _Pragma("unroll") for (int _q = 0; _q < 4; ++_q) { const unsigned _eq = (unsigned)__builtin_amdgcn_readlane((int)_ex, _q);  \
        v8[_q] = *(const u32x4*)(V8 + (size_t)_eq * 1024 + 16 * lane); } } while (0)
    unsigned enc = ents[j4], enn = ents[4 + j4];
    P7_LOADG(enc);
    s16x4 awp = {0, 0, 0, 0};
    constexpr int NG = 128;
#pragma unroll 2
    for (int g = 0; g < NG; ++g) {
      if (g > 0) P7_VPHASE((g - 1) & 1);
      f32x4 d0 = {0.f, 0.f, 0.f, 0.f}, d1 = {0.f, 0.f, 0.f, 0.f};
#pragma unroll
      for (int i = 0; i < 4; ++i)
#pragma unroll
        for (int w = 0; w < 4; ++w) {
          const uint2 ub = {fp8x2_bf16(u8[i][w], 1.f / PEER_SU, false), fp8x2_bf16(u8[i][w], 1.f / PEER_SU, true)};
          const uint2 ha = {hA[i][w >> 1][2 * (w & 1)], hA[i][w >> 1][2 * (w & 1) + 1]};
          if (w & 1) d1 = MFMA4(__builtin_bit_cast(s16x4, ha), __builtin_bit_cast(s16x4, ub), d1);
          else       d0 = MFMA4(__builtin_bit_cast(s16x4, ha), __builtin_bit_cast(s16x4, ub), d0);
        }
      { char* vw = ring + (g & 1) * P7_VBUF + lane * 32;
#pragma unroll
        for (int q = 0; q < 4; ++q) {
          u32x4 o0, o1;
          o0[0] = fp8x2_bf16(v8[q][0], 1.f / PEER_SV, false); o0[1] = fp8x2_bf16(v8[q][0], 1.f / PEER_SV, true);
          o0[2] = fp8x2_bf16(v8[q][1], 1.f / PEER_SV, false); o0[3] = fp8x2_bf16(v8[q][1], 1.f / PEER_SV, true);
          o1[0] = fp8x2_bf16(v8[q][2], 1.f / PEER_SV, false); o1[1] = fp8x2_bf16(v8[q][2], 1.f / PEER_SV, true);
          o1[2] = fp8x2_bf16(v8[q][3], 1.f / PEER_SV, false); o1[3] = fp8x2_bf16(v8[q][3], 1.f / PEER_SV, true);
          *(u32x4*)(vw + q * P7_VROW) = o0; *(u32x4*)(vw + q * P7_VROW + 16) = o1;
        } }
      unsigned en2 = 0u;
      if (g + 1 < NG) { P7_LOADG(enn); if (g + 2 < NG) en2 = ents[4 * (g + 2) + j4]; }
      const int tk = (enc >> 14) & 3;
      float av = sel4(d0, tk) + sel4(d1, tk);
      av += __uint_as_float(__builtin_amdgcn_update_dpp(0, __float_as_uint(av), 0x124, 0xf, 0xf, false));
      av += __uint_as_float(__builtin_amdgcn_update_dpp(0, __float_as_uint(av), 0x128, 0xf, 0xf, false));
      av += __shfl_xor(av, 16, 64);
      { auto rr = __builtin_amdgcn_permlane32_swap(__float_as_uint(av), __float_as_uint(av), false, false); av = __uint_as_float(rr[0]) + __uint_as_float(rr[1]); }
      const float wgt = gelu_exact(av) * __uint_as_float(enc & 0xFFFF0000u);
      float z[4];
#define P7_QB(x, k) __builtin_amdgcn_update_dpp(0, (x), (k) * 0x55, 0xf, 0xf, false)
      { const unsigned wb = __float_as_uint(wgt), tb = (unsigned)tk;
        unsigned w0 = P7_QB(wb, 0), w1 = P7_QB(wb, 1), w2 = P7_QB(wb, 2), w3 = P7_QB(wb, 3);
        unsigned t0 = P7_QB(tb, 0), t1 = P7_QB(tb, 1), t2 = P7_QB(tb, 2), t3 = P7_QB(tb, 3);
        asm volatile("" : "+v"(w0), "+v"(w1), "+v"(w2), "+v"(w3), "+v"(t0), "+v"(t1), "+v"(t2), "+v"(t3));
        z[0] = ((int)t0 == j4) ? __uint_as_float(w0) : 0.f; z[1] = ((int)t1 == j4) ? __uint_as_float(w1) : 0.f;
        z[2] = ((int)t2 == j4) ? __uint_as_float(w2) : 0.f; z[3] = ((int)t3 == j4) ? __uint_as_float(w3) : 0.f; }
#undef P7_QB
      { const uint2 pk = {pack2(z[0], z[1]), pack2(z[2], z[3])}; awp = __builtin_bit_cast(s16x4, pk); }
      enc = enn; enn = en2;
    }
#undef P7_LOADG
    P7_VPHASE((NG - 1) & 1);
#undef P7_VPHASE
    int lne = lane; asm volatile("" : "+v"(lne));
    float ss[4] = {0.f, 0.f, 0.f, 0.f};
#pragma unroll
    for (int c = 0; c < 16; ++c) {
      const float g2 = mod[b * 6144 + 5120 + 64 * c + lne];
#pragma unroll
      for (int r = 0; r < 4; ++r) { const float v = bflo((unsigned)H[(size_t)(tok0 + r) * 1024 + 64 * c + lne]) + g2 * acc[c][r]; acc[c][r] = v; ss[r] += v * v; }
    }
    float rstd[4];
#pragma unroll
    for (int r = 0; r < 4; ++r) rstd[r] = rsqrtf(wave_sum(ss[r]) * (1.f / 1024.f) + EPS);
#pragma unroll
    for (int c = 0; c < 16; ++c) {
      const float gf = a.g_final[64 * c + lne];
#pragma unroll
      for (int r = 0; r < 4; ++r) a.out[(size_t)(tok0 + r) * 1024 + 64 * c + lne] = acc[c][r] * rstd[r] * gf;
    }
  }
}

constexpr int N_PHASES = 8;
__global__ void __launch_bounds__(512, 2) fwd(Args args) {
  extern __shared__ __attribute__((aligned(16))) char lds[];
  if (threadIdx.x == 0) *(uint4*)lds = make_uint4(0u, 0u, 0u, 0u);
  __syncthreads();
  const int lo = args.ph_lo, hi = args.ph_hi;
  XcdBarrier bar; bar.bar = (unsigned*)(args.ws + WS_BAR); bar.x = 0; bar.st = (volatile LAS unsigned*)lds;
  if (hi - lo > 1) bar = xcd_barrier_post((unsigned*)(args.ws + WS_BAR), (volatile LAS unsigned*)lds);
#ifndef ONLY_PHASE
#define ONLY_PHASE -1
#endif
#define IN(k) (lo <= (k) && (k) < hi && (ONLY_PHASE < 0 || ONLY_PHASE == (k)))
#define SEAM(k) do { if (IN(k) && IN((k) + 1)) xcd_barrier(bar); } while (0)
  if (IN(0)) phase0(args, lds);
  SEAM(0);
  if (IN(1)) { phase1(args, lds); phase1b(args, lds); }
  SEAM(1);
  if (IN(2)) phase2(args, lds);
  SEAM(2);
  if (IN(3)) phase3(args, lds);
  SEAM(3);
  if (IN(4)) phase4(args, lds);
  SEAM(4);
  if (IN(5)) phase5(args, lds);
  SEAM(5);
  if (IN(6)) phase6(args, lds);
  SEAM(6);
  if (IN(7)) phase7(args, lds);
#undef IN
#undef SEAM
}

extern "C" void kernel_launch(void* const* d_in, const int* in_sizes, int n_in, void* d_out, int out_size, void* d_ws, size_t ws_size, hipStream_t stream) {
  static int grid = 0;
  if (grid == 0) {
    if (n_in != 23 || out_size != T * DM || ws_size < WS_END) { fprintf(stderr, "kernel_launch: unexpected shapes (n_in %d out %d ws %zu need %zu)\n", n_in, out_size, ws_size, (size_t)WS_END); grid = -1; return; }
    int dev = 0, cus = 0, per_cu = 0;
    (void)hipGetDevice(&dev); (void)hipDeviceGetAttribute(&cus, hipDeviceAttributeMultiprocessorCount, dev);
    if (hipFuncSetAttribute((const void*)fwd, hipFuncAttributeMaxDynamicSharedMemorySize, LDS_BYTES) != hipSuccess) { fprintf(stderr, "kernel_launch: hipFuncSetAttribute failed\n"); grid = -1; return; }
    if (hipOccupancyMaxActiveBlocksPerMultiprocessor(&per_cu, (const void*)fwd, 512, LDS_BYTES) != hipSuccess || per_cu < 1) { fprintf(stderr, "kernel_launch: occupancy query says %d\n", per_cu); per_cu = 1; }
    (void)hipGetLastError();
    grid = cus;
  }
  if (grid < 0) return;
  (void)hipMemsetAsync((char*)d_ws + WS_BAR, 0, 16384, stream);
  Args a{};
  a.x = (const float*)d_in[0]; a.c = (const float*)d_in[1]; a.pos = (const int*)d_in[2];
  a.w_ada = (const float*)d_in[3]; a.b_ada = (const float*)d_in[4]; a.g_norm1 = (const float*)d_in[5]; a.w_in = (const float*)d_in[6];
  a.g_q_a = (const float*)d_in[7]; a.w_uq = (const float*)d_in[8]; a.g_kv_a = (const float*)d_in[9]; a.w_ukv = (const float*)d_in[10];
  a.g_sg = (const float*)d_in[11]; a.w_sg = (const float*)d_in[12]; a.b_sg = (const float*)d_in[13]; a.g_attn_out = (const float*)d_in[14];
  a.g_sg_out = (const float*)d_in[15]; a.w_o = (const float*)d_in[16]; a.g_norm2 = (const float*)d_in[17]; a.w_peer_q = (const float*)d_in[18];
  a.peer_keys = (const float*)d_in[19]; a.peer_u = (const float*)d_in[20]; a.peer_v = (const float*)d_in[21]; a.g_final = (const float*)d_in[22];
  a.out = (float*)d_out; a.ws = (unsigned char*)d_ws;
#if N_LAUNCH_MODE == 0
  a.ph_lo = 0; a.ph_hi = N_PHASES;
  hipLaunchKernelGGL(fwd, dim3(grid), dim3(512), LDS_BYTES, stream, a);
#else
  for (int p = 0; p < N_PHASES; ++p) for (int rep = 0; rep <= ((DUP_MASK >> p) & 1); ++rep) { a.ph_lo = p; a.ph_hi = p + 1; hipLaunchKernelGGL(fwd, dim3(grid), dim3(512), LDS_BYTES, stream, a); }
#endif
  const hipError_t le = hipPeekAtLastError();
  if (le != hipSuccess) fprintf(stderr, "kernel_launch: launch failed: %s\n", hipGetErrorName(le));
}
```

```cpp
#include <hip/hip_runtime.h>
#include <stdint.h>
#include <stdio.h>

#define N_LAUNCH_MODE 0
#define DUP_MASK 0x000

typedef unsigned short u16;
typedef __attribute__((ext_vector_type(8))) short bf16x8;
typedef __attribute__((ext_vector_type(4))) short s16x4;
typedef __attribute__((ext_vector_type(16))) float f32x16;
typedef __attribute__((ext_vector_type(4))) unsigned u32x4;

constexpr int T = 16384, DM = 1024, SEQ = 4096;
constexpr float EPS = 1e-6f;

constexpr size_t WS_BAR  = 0;
constexpr int ADA_KS = 16;
constexpr size_t WS_MODP = 16384;
constexpr size_t WS_MOD  = WS_MODP + (size_t)ADA_KS * 4 * 6144 * 4;
constexpr size_t WS_CS   = WS_MOD + 98304;
constexpr size_t WS_WIN  = WS_CS + 4194304;
constexpr size_t WS_WQ2  = WS_WIN + 3145728;
constexpr size_t WS_WUV  = WS_WQ2 + 393216;
constexpr size_t WS_WO   = WS_WUV + 131072;
constexpr size_t WS_WPQ  = WS_WO + 2097152;
constexpr size_t WS_KEYS = WS_WPQ + 4194304;
constexpr size_t WS_WSG  = WS_KEYS + 524288;
constexpr size_t WS_UB   = WS_WSG + 131072;
constexpr size_t WS_VB   = WS_UB + 33554432;
constexpr size_t WS_H    = WS_VB + 33554432;
constexpr size_t WS_Y    = WS_H + 33554432;
constexpr size_t WS_KV   = WS_Y + 33554432;
constexpr size_t WS_TOPK = WS_KV + 6291456;
constexpr size_t WS_SSQ  = WS_TOPK + 16777216;
constexpr size_t WS_SSQV = WS_SSQ + 262144;
constexpr size_t WS_R1   = WS_SSQV + 131072;
constexpr size_t WS_Q    = WS_R1;
constexpr size_t WS_QA   = WS_Q + 25165824;
constexpr size_t WS_UACT = WS_QA + 8388608;
constexpr size_t WS_GVT  = WS_UACT + 16777216;
constexpr size_t WS_X1   = WS_R1;
constexpr size_t WS_WST  = WS_R1 + 67108864;
constexpr size_t WS_BIASP = WS_WST + 4 * 4194304;
constexpr size_t WS_END  = WS_BIASP + 131072;

constexpr int LDS_BYTES = 155648;
constexpr int LDS_DATA  = 64;

struct Args {
  const float *x, *c; const int* pos;
  const float *w_ada, *b_ada, *g_norm1, *w_in, *g_q_a, *w_uq, *g_kv_a, *w_ukv, *g_sg, *w_sg, *b_sg, *g_attn_out, *g_sg_out,
              *w_o, *g_norm2, *w_peer_q, *peer_keys, *peer_u, *peer_v, *g_final;
  float* out; unsigned char* ws; int ph_lo, ph_hi;
};

#define XB_TMO      128
#define XB_XCNT(j)  (256  + 64 * (j))
#define XB_XSUB(j)  (1280 + 64 * (j))
#define XB_XGEN(j)  (2304 + 64 * (j))
#define XB_TOP      3328
#define XB_TOPGEN   3392
#define XCD_BAR_WORDS 3456
#define XB_SPIN_CAP (1u << 18)
#define LAS __attribute__((address_space(3)))

__device__ __forceinline__ unsigned xb_ld(unsigned* p)              { return __hip_atomic_load(p, __ATOMIC_RELAXED, __HIP_MEMORY_SCOPE_AGENT); }
__device__ __forceinline__ unsigned xb_add(unsigned* p, unsigned v) { return __hip_atomic_fetch_add(p, v, __ATOMIC_RELAXED, __HIP_MEMORY_SCOPE_AGENT); }
__device__ __forceinline__ unsigned xb_xcc_id() { return (unsigned)__builtin_amdgcn_s_getreg((3 << 11) | 20) & 0xFu; }
#define XB_SPIN(cond, bar) do { unsigned _sp = 0; while (cond) { __builtin_amdgcn_s_sleep(1); \
    if ((++_sp & 255u) == 0u) { if (xb_ld(&(bar)[XB_TMO])) break; if (_sp > XB_SPIN_CAP) { atomicAdd(&(bar)[XB_TMO], 1u); break; } } } } while (0)

struct XcdBarrier { unsigned* bar; unsigned x; volatile LAS unsigned* st; };

__device__ __forceinline__ XcdBarrier xcd_barrier_post(unsigned* bar, volatile LAS unsigned* st) {
    XcdBarrier b; b.bar = bar; b.x = xb_xcc_id(); b.st = st;
    if (threadIdx.x == 0) (void)xb_add(&bar[XB_XCNT(b.x)], 1u);
    return b;
}
__device__ __forceinline__ void xcd_barrier_complete(unsigned* bar, unsigned x, unsigned& nloc, unsigned& nx) {
    const unsigned G = gridDim.x * gridDim.y * gridDim.z;
    unsigned sum, cnt, mine, sp = 0u;
    for (;;) {
        sum = 0u; cnt = 0u; mine = 0u;
#pragma unroll
        for (unsigned j = 0; j < 16; ++j) { const unsigned c = xb_ld(&bar[XB_XCNT(j)]); sum += c; cnt += (c > 0u) ? 1u : 0u; mine = (j == x) ? c : mine; }
        if (sum == G) break;
        __builtin_amdgcn_s_sleep(1);
        if ((++sp & 255u) == 0u) { if (xb_ld(&bar[XB_TMO])) break; if (sp > XB_SPIN_CAP) { atomicAdd(&bar[XB_TMO], 1u); break; } }
    }
    nloc = mine > 0u ? mine : 1u; nx = cnt > 0u ? cnt : 1u;
}
__device__ __forceinline__ void xcd_barrier(const XcdBarrier& b) {
    asm volatile("s_waitcnt vmcnt(0)" ::: "memory");
    __syncthreads();
    if (threadIdx.x == 0) {
        unsigned* bar = b.bar;
        __builtin_amdgcn_s_waitcnt(0);
        unsigned nloc = b.st[0], nx = b.st[1];
        if (nloc == 0u) { xcd_barrier_complete(bar, b.x, nloc, nx); b.st[0] = nloc; b.st[1] = nx; }
        const unsigned old = xb_add(&bar[XB_XSUB(b.x)], 1u);
        const unsigned gen = old / nloc;
        if (old + 1u == (gen + 1u) * nloc) {
            __builtin_amdgcn_fence(__ATOMIC_RELEASE, "agent");
            asm volatile("s_waitcnt vmcnt(0)" ::: "memory");
            const unsigned og = xb_add(&bar[XB_TOP], 1u);
            const unsigned tg = og / nx;
            if (og + 1u == (tg + 1u) * nx) xb_add(&bar[XB_TOPGEN], 1u);
            else XB_SPIN(xb_ld(&bar[XB_TOPGEN]) == tg, bar);
            __builtin_amdgcn_fence(__ATOMIC_ACQUIRE, "agent");
            xb_add(&bar[XB_XGEN(b.x)], 1u);
            asm volatile("s_waitcnt vmcnt(0)" ::: "memory");
        } else {
            XB_SPIN(xb_ld(&bar[XB_XGEN(b.x)]) == gen, bar);
            __builtin_amdgcn_fence(__ATOMIC_ACQUIRE, "agent");
            asm volatile("s_waitcnt vmcnt(0)" ::: "memory");
        }
    }
    __syncthreads();
}

__device__ __forceinline__ unsigned pack2(float lo, float hi) {
  typedef __attribute__((ext_vector_type(2))) float f2; typedef __attribute__((ext_vector_type(2))) __bf16 b2;
  f2 v = {lo, hi}; b2 r = __builtin_convertvector(v, b2); return __builtin_bit_cast(unsigned, r);
}
__device__ __forceinline__ u16 f2bf(float f) { return (u16)(pack2(f, 0.f) & 0xFFFFu); }
__device__ __forceinline__ float bflo(unsigned w) { return __uint_as_float(w << 16); }
__device__ __forceinline__ float bfhi(unsigned w) { return __uint_as_float(w & 0xFFFF0000u); }
__device__ __forceinline__ float gelu_exact(float x) {
  const float z = fabsf(x) * 0.70710678118654752f;
  const float t = __builtin_amdgcn_rcpf(fmaf(0.3275911f, z, 1.f));
  float p = fmaf(1.061405429f, t, -1.453152027f); p = fmaf(p, t, 1.421413741f); p = fmaf(p, t, -0.284496736f); p = fmaf(p, t, 0.254829592f);
  const float e = p * t * __expf(-z * z);
  const float erfz = 1.f - e;
  return 0.5f * x * (1.f + copysignf(erfz, x));
}
__device__ __forceinline__ float wave_sum(float v) {
#pragma unroll
  for (int o = 32; o > 0; o >>= 1) v += __shfl_xor(v, o, 64);
  return v;
}
__device__ __forceinline__ int crow(int r, int hi) { return (r & 3) + 8 * (r >> 2) + 4 * hi; }
#define MFMA32(a, b, c) __builtin_amdgcn_mfma_f32_32x32x16_bf16((a), (b), (c), 0, 0, 0)

template <int MAP> __device__ __forceinline__ int colmap(int n) {
  if (MAP == 0) return n;
  if (MAP == 1) return n < 448 ? n : (n < 512 ? -1 : n - 64);
  if (MAP == 2) return (n >> 6) * 192 + 128 + (n & 63);
  return (n >> 7) * 256 + 128 + (n & 127);
}
template <int MAP> __device__ void cvt_transpose(const float* __restrict__ src, int src_ld, int K, int N, u16* __restrict__ dst, int gtid, int gthreads) {
  const int total = N * (K >> 3);
  for (int idx = gtid; idx < total; idx += gthreads) {
    const int n = idx % N, k8 = idx / N, sc = colmap<MAP>(n);
    float v[8];
#pragma unroll
    for (int j = 0; j < 8; ++j) v[j] = sc < 0 ? 0.f : src[(size_t)(k8 * 8 + j) * src_ld + sc];
    u32x4 w = {pack2(v[0], v[1]), pack2(v[2], v[3]), pack2(v[4], v[5]), pack2(v[6], v[7])};
    *(u32x4*)(dst + (size_t)n * K + k8 * 8) = w;
  }
}
template <int MAP> __device__ void cvt_transpose_tiled(const float* __restrict__ src, int src_ld, int K, int N, u16* __restrict__ dst, float* tile) {
  const int tid = threadIdx.x, tk = K >> 6, ntile = tk * (N >> 6);
  for (int t = blockIdx.x; t < ntile; t += gridDim.x) {
    const int k0 = (t % tk) * 64, n0 = (t / tk) * 64;
    __syncthreads();
    { const int nl = tid & 63, sc = colmap<MAP>(n0 + nl);
#pragma unroll
      for (int i = 0; i < 8; ++i) { const int k = (tid >> 6) + 8 * i; tile[k * 65 + nl] = sc < 0 ? 0.f : src[(size_t)(k0 + k) * src_ld + sc]; } }
    __syncthreads();
    { const int n = tid >> 3, kk = tid & 7; float v[8];
#pragma unroll
      for (int j = 0; j < 8; ++j) v[j] = tile[(8 * kk + j) * 65 + n];
      u32x4 w = {pack2(v[0], v[1]), pack2(v[2], v[3]), pack2(v[4], v[5]), pack2(v[6], v[7])};
      *(u32x4*)(dst + (size_t)(n0 + n) * K + k0 + 8 * kk) = w; }
  }
}
__device__ void cvt_direct(const float* __restrict__ src, u16* __restrict__ dst, size_t n8, int gtid, int gthreads) {
  for (size_t i = gtid; i < n8; i += gthreads) {
    const float4 a = *(const float4*)(src + i * 8), b = *(const float4*)(src + i * 8 + 4);
    u32x4 w = {pack2(a.x, a.y), pack2(a.z, a.w), pack2(b.x, b.y), pack2(b.z, b.w)};
    *(u32x4*)(dst + i * 8) = w;
  }
}
constexpr float PEER_SU = 32.f, PEER_SV = 4.f;
__device__ __forceinline__ void sincos_acc(float a, float& sn, float& cs) {
  const float q = __builtin_rintf(a * 0.636619772f);
  float r = __builtin_fmaf(-q, 1.57079601e+00f, a);
  r = __builtin_fmaf(-q, 3.13916473e-07f, r);
  r = __builtin_fmaf(-q, 5.39030253e-15f, r);
  const float r2 = r * r;
  float s = __builtin_fmaf(r2, 2.75573192e-06f, -1.98412698e-04f);
  s = __builtin_fmaf(s, r2, 8.33333333e-03f); s = __builtin_fmaf(s, r2, -1.66666667e-01f); s = __builtin_fmaf(r * r2, s, r);
  float c = __builtin_fmaf(r2, 2.48015873e-05f, -1.38888889e-03f);
  c = __builtin_fmaf(c, r2, 4.16666667e-02f); c = __builtin_fmaf(c, r2, -0.5f); c = __builtin_fmaf(c, r2, 1.f);
  const int n = ((int)q) & 3;
  const float ss = (n & 1) ? c : s, cc = (n & 1) ? s : c;
  sn = (n & 2) ? -ss : ss;
  cs = ((n + 1) & 2) ? -cc : cc;
}

__constant__ float INVF[32] = {1.000000000e+00f, 7.498942018e-01f, 5.623413324e-01f, 4.216965139e-01f, 3.162277639e-01f, 2.371373922e-01f, 1.778279394e-01f, 1.333521456e-01f,
  1.000000015e-01f, 7.498941571e-02f, 5.623412877e-02f, 4.216964915e-02f, 3.162277862e-02f, 2.371373586e-02f, 1.778279431e-02f, 1.333521493e-02f,
  9.999999776e-03f, 7.498942316e-03f, 5.623413250e-03f, 4.216964822e-03f, 3.162277862e-03f, 2.371373819e-03f, 1.778279431e-03f, 1.333521446e-03f,
  1.000000047e-03f, 7.498941850e-04f, 5.623413017e-04f, 4.216965463e-04f, 3.162277862e-04f, 2.371373848e-04f, 1.778279402e-04f, 1.333521504e-04f};
__device__ void phase0(const Args& a, char* lds) {
  unsigned char* ws = a.ws;
  const int tid = threadIdx.x, lane = tid & 63, wv = tid >> 6;
  const int NWV = gridDim.x * 8, gw = blockIdx.x * 8 + wv;
  const int gthreads = gridDim.x * 512, gtid = blockIdx.x * 512 + tid;
  float* modp = (float*)(ws + WS_MODP);
  for (int job = wv * gridDim.x + blockIdx.x; job < 96 * ADA_KS; job += NWV) {
    const int cg = job % 96, ks = job / 96, col = cg * 64 + lane;
    float a0 = 0.f, a1 = 0.f, a2 = 0.f, a3 = 0.f;
    const float* w = a.w_ada + (size_t)(ks * 64) * 6144 + col;
    float sv[4];
#pragma unroll
    for (int bb = 0; bb < 4; ++bb) { const float cv = a.c[bb * 1024 + ks * 64 + lane]; sv[bb] = cv / (1.f + __expf(-cv)); }
#pragma unroll 32
    for (int k = 0; k < 64; ++k) {
      const float wv_ = w[(size_t)k * 6144];
      a0 += __uint_as_float(__builtin_amdgcn_readlane(__float_as_uint(sv[0]), k)) * wv_;
      a1 += __uint_as_float(__builtin_amdgcn_readlane(__float_as_uint(sv[1]), k)) * wv_;
      a2 += __uint_as_float(__builtin_amdgcn_readlane(__float_as_uint(sv[2]), k)) * wv_;
      a3 += __uint_as_float(__builtin_amdgcn_readlane(__float_as_uint(sv[3]), k)) * wv_;
    }
    modp[(ks * 4 + 0) * 6144 + col] = a0; modp[(ks * 4 + 1) * 6144 + col] = a1;
    modp[(ks * 4 + 2) * 6144 + col] = a2; modp[(ks * 4 + 3) * 6144 + col] = a3;
  }
  { float* tile = (float*)(lds + LDS_DATA);
    cvt_transpose_tiled<1>(a.w_in, 1472, 1024, 1536, (u16*)(ws + WS_WIN), tile);
    cvt_transpose_tiled<0>(a.w_o, 1024, 1024, 1024, (u16*)(ws + WS_WO), tile);
    cvt_transpose_tiled<2>(a.w_uq, 768, 256, 256, (u16*)(ws + WS_WQ2) + 512 * 256, tile);
    cvt_transpose_tiled<3>(a.w_ukv, 1024, 128, 512, (u16*)(ws + WS_WUV), tile); }
  {
    u16* wq2 = (u16*)(ws + WS_WQ2);
    float* At = (float*)(lds + LDS_DATA); float* Bt = At + 16 * 129;
    for (int job = blockIdx.x; job < 256; job += gridDim.x) {
      const int h = job >> 6, cb = (job >> 3) & 7, ib = job & 7;
      __syncthreads();
      { const int row = tid >> 5, c4 = tid & 31;
        const float4 av = *(const float4*)(a.w_ukv + (size_t)(cb * 16 + row) * 1024 + h * 256 + 4 * c4);
        const float4 b0 = *(const float4*)(a.w_uq + (size_t)(ib * 32 + row) * 768 + h * 192 + 4 * c4);
        const float4 b1 = *(const float4*)(a.w_uq + (size_t)(ib * 32 + 16 + row) * 768 + h * 192 + 4 * c4);
        float* pa = At + row * 129 + 4 * c4; pa[0] = av.x; pa[1] = av.y; pa[2] = av.z; pa[3] = av.w;
        float* p0 = Bt + row * 129 + 4 * c4; p0[0] = b0.x; p0[1] = b0.y; p0[2] = b0.z; p0[3] = b0.w;
        float* p1 = Bt + (16 + row) * 129 + 4 * c4; p1[0] = b1.x; p1[1] = b1.y; p1[2] = b1.z; p1[3] = b1.w; }
      __syncthreads();
      { const int cl = tid >> 5, il = tid & 31;
        const float* pa = At + cl * 129; const float* pb = Bt + il * 129;
        float s0 = 0.f, s1 = 0.f, s2 = 0.f, s3 = 0.f;
#pragma unroll 8
        for (int d = 0; d < 128; d += 4) { s0 += pa[d] * pb[d]; s1 += pa[d + 1] * pb[d + 1]; s2 += pa[d + 2] * pb[d + 2]; s3 += pa[d + 3] * pb[d + 3]; }
        wq2[(size_t)(h * 128 + cb * 16 + cl) * 256 + ib * 32 + il] = f2bf((s0 + s1) + (s2 + s3)); }
    }
    __syncthreads();
  }
  cvt_direct(a.peer_keys, (u16*)(ws + WS_KEYS), 262144 / 8, gtid, gthreads);
  cvt_direct(a.w_peer_q, (u16*)(ws + WS_WPQ), (size_t)1024 * 2048 / 8, gtid, gthreads);
  cvt_direct(a.w_sg, (u16*)(ws + WS_WSG), 65536 / 8, gtid, gthreads);
  {
    float* cs = (float*)(ws + WS_CS);
    for (int idx = gtid; idx < T * 32; idx += gthreads) {
      const int t = idx >> 5, i = idx & 31;
      const float inv = INVF[i];
      const float ang = (float)a.pos[t] * inv;
      float sn, c_; sincos_acc(ang, sn, c_);
      cs[(size_t)t * 64 + i] = c_; cs[(size_t)t * 64 + 32 + i] = sn;
    }
  }
}

__device__ void phase1(const Args& a, char* lds) {
  unsigned char* ws = a.ws;
  const int tid = threadIdx.x, lane = tid & 63, wv = tid >> 6;
  const float* modp = (const float*)(ws + WS_MODP);
  float* mod = (float*)(ws + WS_MOD);
  for (int idx = blockIdx.x * 512 + tid; idx < 4 * 6144; idx += gridDim.x * 512) {
    const int b = idx / 6144, m = idx % 6144;
    float s = a.b_ada[m];
#pragma unroll
    for (int ks = 0; ks < ADA_KS; ++ks) s += modp[(ks * 4 + b) * 6144 + m];
    mod[idx] = s;
  }
  float* sh = (float*)(lds + LDS_DATA);
  u16* H = (u16*)(ws + WS_H);
  for (int u = blockIdx.x; u < T / 64; u += gridDim.x) {
    const int b = u >> 6;
    __syncthreads();
    for (int j = tid; j < 2048; j += 512) {
      float s = a.b_ada[j];
#pragma unroll
      for (int ks = 0; ks < ADA_KS; ++ks) s += modp[(ks * 4 + b) * 6144 + j];
      sh[j] = s;
    }
    __syncthreads();
    for (int i0 = 0; i0 < 8; i0 += 4) {
      float4 xv[4][4];
#pragma unroll
      for (int i = 0; i < 4; ++i)
#pragma unroll
        for (int j = 0; j < 4; ++j) xv[i][j] = *(const float4*)(a.x + (size_t)(u * 64 + wv * 8 + i0 + i) * 1024 + j * 256 + lane * 4);
#pragma unroll
      for (int i = 0; i < 4; ++i) {
        const int r = u * 64 + wv * 8 + i0 + i;
        float ssq = 0.f;
#pragma unroll
        for (int j = 0; j < 4; ++j) ssq += xv[i][j].x * xv[i][j].x + xv[i][j].y * xv[i][j].y + xv[i][j].z * xv[i][j].z + xv[i][j].w * xv[i][j].w;
        ssq = wave_sum(ssq);
        const float rstd = rsqrtf(ssq * (1.f / 1024.f) + EPS);
#pragma unroll
        for (int j = 0; j < 4; ++j) {
          const int col = j * 256 + lane * 4;
          const float4 g = *(const float4*)(a.g_norm1 + col);
          const float h0 = xv[i][j].x * rstd * g.x * (1.f + sh[1024 + col]) + sh[col];
          const float h1 = xv[i][j].y * rstd * g.y * (1.f + sh[1024 + col + 1]) + sh[col + 1];
          const float h2 = xv[i][j].z * rstd * g.z * (1.f + sh[1024 + col + 2]) + sh[col + 2];
          const float h3 = xv[i][j].w * rstd * g.w * (1.f + sh[1024 + col + 3]) + sh[col + 3];
          uint2 o = {pack2(h0, h1), pack2(h2, h3)};
          *(uint2*)(H + (size_t)r * 1024 + col) = o;
        }
      }
    }
  }
}

constexpr int G_STAGE = 49152;
__device__ __forceinline__ void dma16(const void* gsrc, unsigned lds_dst) {
  unsigned keep;
  asm volatile("s_mov_b32 %0, m0\n\ts_mov_b32 m0, %2\n\ts_nop 0\n\tglobal_load_lds_dwordx4 %1, off\n\ts_mov_b32 m0, %0"
               : "=&s"(keep) : "v"(gsrc), "s"(lds_dst) : "memory");
}
__device__ __forceinline__ void gemm_128x256(const u16* __restrict__ A, int lda, const u16* __restrict__ Bt, int ldb, int KT,
                                             f32x16 (&acc)[2][2], char* lds) {
  const int tid = threadIdx.x, lane = tid & 63, wv = __builtin_amdgcn_readfirstlane(tid >> 6), r32 = lane & 31, hi = lane >> 5;
  const int wm = wv >> 2, wn = wv & 3;
  const int rin = lane >> 3, cc = lane & 7;
  const u16* pa[2]; const u16* pb[4];
#pragma unroll
  for (int j = 0; j < 2; ++j) pa[j] = A + (size_t)(16 * wv + 8 * j + rin) * lda + 8 * (cc ^ (4 * j + (rin >> 1)));
#pragma unroll
  for (int i = 0; i < 4; ++i) pb[i] = Bt + (size_t)(32 * wv + 8 * i + rin) * ldb + 8 * (cc ^ (4 * (i & 1) + (rin >> 1)));
  const unsigned lb = __builtin_amdgcn_readfirstlane((unsigned)(uintptr_t)lds);
  const unsigned dA = lb + 2048 * wv, dB = lb + 16384 + 4096 * wv;
#define G_ISSUE(stage, kt_) do { const unsigned _so = (unsigned)(stage) * G_STAGE; const int _ko = (kt_) * 64;                     \
    dma16(pa[0] + _ko, dA + _so); dma16(pa[1] + _ko, dA + _so + 1024);                                                           \
    dma16(pb[0] + _ko, dB + _so); dma16(pb[1] + _ko, dB + _so + 1024); dma16(pb[2] + _ko, dB + _so + 2048); dma16(pb[3] + _ko, dB + _so + 3072); } while (0)
#pragma unroll
  for (int m = 0; m < 2; ++m)
#pragma unroll
    for (int n = 0; n < 2; ++n)
#pragma unroll
      for (int r = 0; r < 16; ++r) acc[m][n][r] = 0.f;
  __syncthreads();
  G_ISSUE(0, 0);
  if (KT > 1) G_ISSUE(1, 1);
  const int xa = (r32 >> 1) & 7;
  const int aoff = (64 * wm + r32) * 128, boff = 16384 + (64 * wn + r32) * 128;
  int st = 0;
  for (int kt = 0; kt < KT; ++kt) {
    if (kt + 1 < KT) asm volatile("s_waitcnt vmcnt(6)\n\ts_barrier" ::: "memory");
    else             asm volatile("s_waitcnt vmcnt(0)\n\ts_barrier" ::: "memory");
    const int s2 = st == 0 ? 2 : st - 1;
    if (kt + 2 < KT && wv < 4) G_ISSUE(s2, kt + 2);
    const char* buf = lds + st * G_STAGE;
    __builtin_amdgcn_s_setprio(1);
    bf16x8 fa[2][2], fb[2][2];
#define G_LDF(S, SET) do { const int _cb = ((2 * (S) + hi) ^ xa) << 4;                                                      \
      fa[SET][0] = *(const bf16x8*)(buf + aoff + _cb); fa[SET][1] = *(const bf16x8*)(buf + aoff + 4096 + _cb);              \
      fb[SET][0] = *(const bf16x8*)(buf + boff + _cb); fb[SET][1] = *(const bf16x8*)(buf + boff + 4096 + _cb); } while (0)
#define G_MM(SET) do { acc[0][0] = MFMA32(fa[SET][0], fb[SET][0], acc[0][0]); acc[0][1] = MFMA32(fa[SET][0], fb[SET][1], acc[0][1]);   \
      acc[1][0] = MFMA32(fa[SET][1], fb[SET][0], acc[1][0]); acc[1][1] = MFMA32(fa[SET][1], fb[SET][1], acc[1][1]); } while (0)
    G_LDF(0, 0); __builtin_amdgcn_sched_barrier(0);
    G_LDF(1, 1); __builtin_amdgcn_sched_barrier(0); G_MM(0); __builtin_amdgcn_sched_barrier(0);
    G_LDF(2, 0); __builtin_amdgcn_sched_barrier(0); G_MM(1); __builtin_amdgcn_sched_barrier(0);
    G_LDF(3, 1); __builtin_amdgcn_sched_barrier(0); G_MM(0); __builtin_amdgcn_sched_barrier(0);
    G_MM(1);
#undef G_LDF
#undef G_MM
    __builtin_amdgcn_s_setprio(0);
    if (kt + 2 < KT && wv >= 4) G_ISSUE(s2, kt + 2);
    st = st == 2 ? 0 : st + 1;
  }
#undef G_ISSUE
  __syncthreads();
}
constexpr int CLD = 257;
__device__ __forceinline__ void acc_to_lds(const f32x16 (&acc)[2][2], float* Cl) {
  const int lane = threadIdx.x & 63, wv = threadIdx.x >> 6, r32 = lane & 31, hi = lane >> 5, wm = wv >> 2, wn = wv & 3;
#pragma unroll
  for (int m = 0; m < 2; ++m)
#pragma unroll
    for (int n = 0; n < 2; ++n)
#pragma unroll
      for (int r = 0; r < 16; ++r) Cl[(64 * wm + 32 * m + crow(r, hi)) * CLD + 64 * wn + 32 * n + r32] = acc[m][n][r];
}

constexpr int G2_STAGE = 65536;
__device__ __forceinline__ void gemm_256x256_wide(const u16* __restrict__ A, int lda, const u16* __restrict__ Bt, int ldb, int KT, f32x16 (&acc)[8], char* lds) {
  const int tid = threadIdx.x, lane = tid & 63, wv = __builtin_amdgcn_readfirstlane(tid >> 6), r32 = lane & 31, hi = lane >> 5;
  const int rin = lane >> 3, cc = lane & 7;
  const u16* pa[4]; const u16* pb[4];
#pragma unroll
  for (int i = 0; i < 4; ++i) {
    pa[i] = A + (size_t)(32 * wv + 8 * i + rin) * lda + 8 * (cc ^ (4 * (i & 1) + (rin >> 1)));
    pb[i] = Bt + (size_t)(32 * wv + 8 * i + rin) * ldb + 8 * (cc ^ (4 * (i & 1) + (rin >> 1)));
  }
  const unsigned lb = __builtin_amdgcn_readfirstlane((unsigned)(uintptr_t)lds);
  const unsigned dA = lb + 4096 * wv, dB = lb + 32768 + 4096 * wv;
#define G_ISSUE(stage, kt_) do { const unsigned _so = (unsigned)(stage) * G2_STAGE; const int _ko = (kt_) * 64;                    \
    dma16(pa[0] + _ko, dA + _so); dma16(pa[1] + _ko, dA + _so + 1024); dma16(pa[2] + _ko, dA + _so + 2048); dma16(pa[3] + _ko, dA + _so + 3072);   \
    dma16(pb[0] + _ko, dB + _so); dma16(pb[1] + _ko, dB + _so + 1024); dma16(pb[2] + _ko, dB + _so + 2048); dma16(pb[3] + _ko, dB + _so + 3072); } while (0)
#pragma unroll
  for (int m = 0; m < 8; ++m)
#pragma unroll
    for (int r = 0; r < 16; ++r) acc[m][r] = 0.f;
  __syncthreads();
  G_ISSUE(0, 0);
  const int xa = (r32 >> 1) & 7;
  const int aoff = r32 * 128, boff = 32768 + (32 * wv + r32) * 128;
  for (int kt = 0; kt < KT; ++kt) {
    asm volatile("s_waitcnt vmcnt(0)\n\ts_barrier" ::: "memory");
    if (kt + 1 < KT) G_ISSUE((kt + 1) & 1, kt + 1);
    const char* buf = lds + (kt & 1) * G2_STAGE;
    __builtin_amdgcn_s_setprio(1);
    bf16x8 fa[8], fb[4];
#pragma unroll
    for (int s = 0; s < 4; ++s) fb[s] = *(const bf16x8*)(buf + boff + (((2 * s + hi) ^ xa) << 4));
    { const int cb0 = (hi ^ xa) << 4;
#pragma unroll
      for (int m = 0; m < 8; ++m) fa[m] = *(const bf16x8*)(buf + aoff + 4096 * m + cb0); }
#pragma unroll
    for (int s = 0; s < 4; ++s) {
      const int cbn = ((2 * (s + 1) + hi) ^ xa) << 4;
#pragma unroll
      for (int m = 0; m < 8; ++m) { acc[m] = MFMA32(fa[m], fb[s], acc[m]); if (s < 3) fa[m] = *(const bf16x8*)(buf + aoff + 4096 * m + cbn); }
    }
    __builtin_amdgcn_s_setprio(0);
  }
#undef G_ISSUE
  __syncthreads();
}

__device__ __forceinline__ void xcd_unit(int u, int per, int& panel, int& sub) {
  if (gridDim.x == 256) { const int x = u & 7, k = ((u & 255) >> 3) + 32 * (u >> 8); panel = x + 8 * (k / per); sub = k % per; }
  else { panel = u / per; sub = u % per; }
}
__device__ void phase1b(const Args& a, char* lds) {
  unsigned char* ws = a.ws;
  const int tid = threadIdx.x, lane = tid & 63, wv = tid >> 6;
  const u16* KEYS = (const u16*)(ws + WS_KEYS); const u16* WPQB = (const u16*)(ws + WS_WPQ); u16* WST = (u16*)(ws + WS_WST);
  const float* modp = (const float*)(ws + WS_MODP); float* BIASP = (float*)(ws + WS_BIASP);
  char* gl = lds + LDS_DATA; float* Cl = (float*)gl;
  float* gsl = (float*)(gl + 131584);
  for (int u = blockIdx.x; u < 256; u += gridDim.x) {
    const int hh = u >> 4, nt = (u >> 2) & 3, b = u & 3;
    f32x16 acc[2][2];
    gemm_128x256(KEYS + (size_t)hh * 16384, 128, WPQB + (size_t)(nt * 256) * 2048 + hh * 128, 2048, 2, acc, gl);
    acc_to_lds(acc, Cl);
    for (int j = tid; j < 512; j += 512) {
      const int which = j >> 8, k = nt * 256 + (j & 255), m = (which ? 3072 : 4096) + k;
      float v = a.b_ada[m];
#pragma unroll
      for (int ks = 0; ks < ADA_KS; ++ks) v += modp[(ks * 4 + b) * 6144 + m];
      gsl[j] = which ? v : a.g_norm2[k] * (1.f + v);
    }
    __syncthreads();
    for (int i = 0; i < 16; ++i) {
      const int row = wv * 16 + i; const size_t n = (size_t)hh * 128 + row;
      float bp = 0.f, w[4];
#pragma unroll
      for (int j = 0; j < 4; ++j) { const float v = Cl[row * CLD + 4 * lane + j]; w[j] = v * gsl[4 * lane + j]; bp += v * gsl[256 + 4 * lane + j]; }
      *(uint2*)(WST + ((size_t)b * 2048 + n) * 1024 + nt * 256 + 4 * lane) = make_uint2(pack2(w[0], w[1]), pack2(w[2], w[3]));
      bp = wave_sum(bp);
      if (lane == 0) BIASP[((size_t)nt * 4 + b) * 2048 + n] = bp;
    }
    __syncthreads();
  }
}

__device__ void phase2(const Args& a, char* lds) {
  unsigned char* ws = a.ws;
  const int tid = threadIdx.x, lane = tid & 63, wv = tid >> 6;
  const u16* H = (const u16*)(ws + WS_H); const u16* WIN = (const u16*)(ws + WS_WIN);
  u16* QA = (u16*)(ws + WS_QA); u16* KV = (u16*)(ws + WS_KV); u16* UACT = (u16*)(ws + WS_UACT); u16* GVT = (u16*)(ws + WS_GVT);
  float* SSQV = (float*)(ws + WS_SSQV); const float* CS = (const float*)(ws + WS_CS);
  char* gl = lds + LDS_DATA; float* Cl = (float*)gl;
  for (int u = blockIdx.x; u < 128 * 6; u += gridDim.x) {
    int mt, nt; xcd_unit(u, 6, mt, nt); const int R0 = mt * 128;
    f32x16 acc[2][2];
    gemm_128x256(H + (size_t)R0 * 1024, 1024, WIN + (size_t)(nt * 256) * 1024, 1024, 16, acc, gl);
    acc_to_lds(acc, Cl);
    __syncthreads();
    if (nt == 0) {
      for (int i = 0; i < 16; ++i) {
        const int row = wv * 16 + i; float v[4], ssq = 0.f;
#pragma unroll
        for (int j = 0; j < 4; ++j) { v[j] = Cl[row * CLD + lane + 64 * j]; ssq += v[j] * v[j]; }
        ssq = wave_sum(ssq);
        const float rstd = rsqrtf(ssq * (1.f / 256.f) + EPS);
#pragma unroll
        for (int j = 0; j < 4; ++j) { const int col = lane + 64 * j; QA[(size_t)(R0 + row) * 256 + col] = f2bf(v[j] * rstd * a.g_q_a[col]); }
      }
    } else if (nt == 1) {
#pragma unroll 4
      for (int i = 0; i < 16; ++i) {
        const int row = wv * 16 + i, tok = R0 + row;
        const float v0 = Cl[row * CLD + lane], v1 = Cl[row * CLD + 64 + lane];
        const float ssq = wave_sum(v0 * v0 + v1 * v1);
        const float rstd = rsqrtf(ssq * (1.f / 128.f) + EPS);
        KV[(size_t)tok * 192 + lane] = f2bf(v0 * rstd * a.g_kv_a[lane]);
        KV[(size_t)tok * 192 + 64 + lane] = f2bf(v1 * rstd * a.g_kv_a[64 + lane]);
        if (lane < 32) {
          const float x1 = Cl[row * CLD + 128 + lane], x2 = Cl[row * CLD + 160 + lane];
          const float cs = CS[(size_t)tok * 64 + lane], sn = CS[(size_t)tok * 64 + 32 + lane];
          KV[(size_t)tok * 192 + 128 + lane] = f2bf(x1 * cs - x2 * sn);
          KV[(size_t)tok * 192 + 160 + lane] = f2bf(x2 * cs + x1 * sn);
        }
      }
    } else if (nt < 4) {
      for (int i = 0; i < 16; ++i) {
        const int row = wv * 16 + i;
#pragma unroll
        for (int j = 0; j < 4; ++j) { const int col = lane + 64 * j; UACT[(size_t)(R0 + row) * 512 + (nt - 2) * 256 + col] = f2bf(gelu_exact(Cl[row * CLD + col])); }
      }
    } else {
      for (int i = 0; i < 16; ++i) {
        const int row = wv * 16 + i; float ssq = 0.f;
#pragma unroll
        for (int j = 0; j < 4; ++j) { const int col = lane + 64 * j; const float g = gelu_exact(Cl[row * CLD + col]); const float gb = bflo((unsigned)f2bf(g)); ssq += gb * gb; Cl[row * CLD + col] = gb; }
        ssq = wave_sum(ssq);
        if (lane == 0) SSQV[(size_t)(R0 + row) * 2 + (nt - 4)] = ssq;
      }
      __syncthreads();
      for (int i = 0; i < 32; ++i) {
        const int c = wv * 32 + i;
        const float g0 = Cl[(2 * lane) * CLD + c], g1 = Cl[(2 * lane + 1) * CLD + c];
        *(unsigned*)(GVT + ((size_t)mt * 512 + (nt - 4) * 256 + c) * 128 + 2 * lane) = pack2(g0, g1);
      }
    }
    __syncthreads();
  }
}

__device__ void phase3(const Args& a, char* lds) {
  unsigned char* ws = a.ws;
  const int tid = threadIdx.x, lane = tid & 63, wv = tid >> 6, r32 = lane & 31, hi = lane >> 5;
  const u16* QA = (const u16*)(ws + WS_QA); const u16* WQ2 = (const u16*)(ws + WS_WQ2);
  u16* Q = (u16*)(ws + WS_Q); const float* CS = (const float*)(ws + WS_CS);
  const u16* UACT = (const u16*)(ws + WS_UACT); const u16* GVT = (const u16*)(ws + WS_GVT); const u16* WSG = (const u16*)(ws + WS_WSG);
  const float* SSQV = (const float*)(ws + WS_SSQV); u16* Y = (u16*)(ws + WS_Y);
  char* gl = lds + LDS_DATA; float* Cl = (float*)gl;
  for (int u = blockIdx.x; u < 384; u += gridDim.x) {
    {
      int mt, nt; xcd_unit(u, 3, mt, nt); const int R0 = mt * 128;
      f32x16 acc[2][2];
      gemm_128x256(QA + (size_t)R0 * 256, 256, WQ2 + (size_t)(nt * 256) * 256, 256, 4, acc, gl);
      acc_to_lds(acc, Cl);
      __syncthreads();
      if (nt < 2) {
        for (int i = 0; i < 16; ++i) {
          const int row = wv * 16 + i;
#pragma unroll
          for (int j = 0; j < 4; ++j) { const int n = nt * 256 + lane + 64 * j; Q[(size_t)(R0 + row) * 768 + (n >> 7) * 192 + (n & 127)] = f2bf(Cl[row * CLD + lane + 64 * j]); }
        }
      } else {
#pragma unroll 4
        for (int i = 0; i < 16; ++i) {
          const int row = wv * 16 + i, tok = R0 + row;
#pragma unroll
          for (int j = 0; j < 2; ++j) {
            const int idx = lane + 64 * j, h = idx >> 5, jj = idx & 31;
            const float x1 = Cl[row * CLD + h * 64 + jj], x2 = Cl[row * CLD + h * 64 + 32 + jj];
            const float cs = CS[(size_t)tok * 64 + jj], sn = CS[(size_t)tok * 64 + 32 + jj];
            Q[(size_t)tok * 768 + h * 192 + 128 + jj] = f2bf(x1 * cs - x2 * sn);
            Q[(size_t)tok * 768 + h * 192 + 160 + jj] = f2bf(x2 * cs + x1 * sn);
          }
        }
      }
      __syncthreads();
    }
  }
  for (int su = blockIdx.x; su < 256; su += gridDim.x) {
    {
      const int c = su >> 1, ph = su & 1;
      float* rs = (float*)gl;
      float* Yl = (float*)(gl + 512);
      __syncthreads();
      if (tid < 128) { const size_t t = (size_t)c * 128 + tid; rs[tid] = rsqrtf((SSQV[t * 2] + SSQV[t * 2 + 1]) * (1.f / 512.f) + EPS); }
      __syncthreads();
      const int h = wv >> 1, dh = wv & 1;
      f32x16 acc[2][2];
#pragma unroll
      for (int m = 0; m < 2; ++m)
#pragma unroll
        for (int n = 0; n < 2; ++n)
#pragma unroll
          for (int r = 0; r < 16; ++r) acc[m][n][r] = 0.f;
      for (int s = 0; s < 8; ++s) {
        const int q0 = 16 * s + 8 * hi;
        bf16x8 af[2], bfr[2];
#pragma unroll
        for (int m = 0; m < 2; ++m) af[m] = *(const bf16x8*)(WSG + ((size_t)h * 128 + ph * 64 + 32 * m + r32) * 128 + q0);
        float rq[8];
#pragma unroll
        for (int j = 0; j < 8; ++j) rq[j] = rs[q0 + j];
#pragma unroll
        for (int n = 0; n < 2; ++n) {
          const u32x4 w = *(const u32x4*)(GVT + ((size_t)c * 512 + h * 128 + dh * 64 + 32 * n + r32) * 128 + q0);
          u32x4 o;
#pragma unroll
          for (int k = 0; k < 4; ++k) o[k] = pack2(bflo(w[k]) * rq[2 * k], bfhi(w[k]) * rq[2 * k + 1]);
          bfr[n] = __builtin_bit_cast(bf16x8, o);
        }
#pragma unroll
        for (int m = 0; m < 2; ++m)
#pragma unroll
          for (int n = 0; n < 2; ++n) acc[m][n] = MFMA32(af[m], bfr[n], acc[m][n]);
      }
#pragma unroll
      for (int m = 0; m < 2; ++m)
#pragma unroll
        for (int n = 0; n < 2; ++n)
#pragma unroll
          for (int r = 0; r < 16; ++r) {
            const int pl = 32 * m + crow(r, hi), col = h * 128 + dh * 64 + 32 * n + r32;
            const size_t tok = (size_t)c * 128 + ph * 64 + pl;
            const float mix = acc[m][n][r] * a.g_sg[col] + a.b_sg[h * 128 + ph * 64 + pl];
            Yl[pl * 513 + col] = bflo((unsigned)UACT[tok * 512 + col]) * mix;
          }
      __syncthreads();
      for (int i = 0; i < 8; ++i) {
        const int pl = wv * 8 + i; const size_t tok = (size_t)c * 128 + ph * 64 + pl;
        float v[8], ssq = 0.f;
#pragma unroll
        for (int j = 0; j < 8; ++j) { v[j] = Yl[pl * 513 + lane + 64 * j]; ssq += v[j] * v[j]; }
        ssq = wave_sum(ssq);
        const float rstd = rsqrtf(ssq * (1.f / 512.f) + EPS);
#pragma unroll
        for (int j = 0; j < 8; ++j) { const int col = lane + 64 * j; Y[tok * 1024 + 512 + col] = f2bf(v[j] * rstd * a.g_sg_out[col]); }
      }
      __syncthreads();
    }
  }
}

constexpr float ATT_SCALE = 0.07216878364870322f;
constexpr float ATT_THR = 8.f;
constexpr int KVBUF = 24576;
#define SBAR() __builtin_amdgcn_sched_barrier(0)
__device__ __forceinline__ unsigned cvtpk(float lo, float hi) { unsigned r; asm volatile("v_cvt_pk_bf16_f32 %0, %1, %2" : "=v"(r) : "v"(lo), "v"(hi)); return r; }
__device__ __forceinline__ unsigned off_a(unsigned row, unsigned ch) { return 2048u * (row >> 3) + 512u * (ch >> 2) + 64u * (row & 7) + 16u * ((ch & 3) ^ ((row >> 2) & 3)); }

__device__ __forceinline__ void partialSM(f32x16& p0, f32x16& p1, float& m_reg, float& mn, float& alpha) {
  constexpr float C = ATT_SCALE * 1.4426950408889634f;
  float pmax = p0[0];
#pragma unroll
  for (int r = 1; r < 16; ++r) pmax = fmaxf(pmax, p0[r]);
#pragma unroll
  for (int r = 0; r < 16; ++r) pmax = fmaxf(pmax, p1[r]);
  { auto rr = __builtin_amdgcn_permlane32_swap(__float_as_uint(pmax), __float_as_uint(pmax), false, false);
    pmax = fmaxf(__uint_as_float(rr[0]), __uint_as_float(rr[1])); }
  if (__builtin_expect(__all(pmax - m_reg <= ATT_THR / ATT_SCALE), 1)) { mn = m_reg; alpha = 1.f; }
  else { mn = fmaxf(m_reg, pmax); alpha = __builtin_amdgcn_exp2f((m_reg - mn) * C); m_reg = mn; }
  const float mnC = -mn * C;
#pragma unroll
  for (int r = 0; r < 16; ++r) p0[r] = fmaf(p0[r], C, mnC);
#pragma unroll
  for (int r = 0; r < 16; ++r) p1[r] = fmaf(p1[r], C, mnC);
#pragma unroll
  for (int r = 0; r < 16; ++r) p0[r] = __builtin_amdgcn_exp2f(p0[r]);
}
__device__ __forceinline__ void finishSM(f32x16& p0, f32x16& p1, float alpha, float& l_reg, bf16x8& pa0, bf16x8& pa1, bf16x8& pa2, bf16x8& pa3) {
#pragma unroll
  for (int r = 0; r < 16; ++r) p1[r] = __builtin_amdgcn_exp2f(p1[r]);
  float ps = 0;
#pragma unroll
  for (int r = 0; r < 16; ++r) ps += p0[r];
#pragma unroll
  for (int r = 0; r < 16; ++r) ps += p1[r];
  { auto rr = __builtin_amdgcn_permlane32_swap(__float_as_uint(ps), __float_as_uint(ps), false, false);
    ps = __uint_as_float(rr[0]) + __uint_as_float(rr[1]); }
  l_reg = l_reg * alpha + ps;
#define PK4(P, BASE, OUT) do { unsigned a0 = cvtpk(P[BASE + 0], P[BASE + 1]), a1 = cvtpk(P[BASE + 2], P[BASE + 3]);   \
    unsigned b0 = cvtpk(P[BASE + 4], P[BASE + 5]), b1 = cvtpk(P[BASE + 6], P[BASE + 7]);                              \
    auto r0 = __builtin_amdgcn_permlane32_swap(a0, b0, false, false); auto r1 = __builtin_amdgcn_permlane32_swap(a1, b1, false, false); \
    u32x4 w = {r0[0], r1[0], r0[1], r1[1]}; OUT = __builtin_bit_cast(bf16x8, w); } while (0)
  PK4(p0, 0, pa0); PK4(p0, 8, pa1); PK4(p1, 0, pa2); PK4(p1, 8, pa3);
#undef PK4
}
__device__ __forceinline__ void qkt192(f32x16& p0, f32x16& p1, const char* kb, const char* qb, int ke, int ko, int kr) {
#pragma unroll
  for (int r = 0; r < 16; ++r) { p0[r] = 0.f; p1[r] = 0.f; }
#pragma unroll
  for (int d0 = 0; d0 < 8; ++d0) {
    const int o = ((d0 & 1) ? ko : ke) + 512 * (d0 >> 1);
    const bf16x8 b0 = *(const bf16x8*)(kb + o), b1 = *(const bf16x8*)(kb + o + 8192), q = *(const bf16x8*)(qb + 32 * d0);
    p0 = MFMA32(b0, q, p0); p1 = MFMA32(b1, q, p1);
  }
#pragma unroll
  for (int d1 = 0; d1 < 4; ++d1) {
    const int o = 16384 + (kr ^ (32 * d1));
    const bf16x8 b0 = *(const bf16x8*)(kb + o), b1 = *(const bf16x8*)(kb + o + 4096), q = *(const bf16x8*)(qb + 256 + 32 * d1);
    p0 = MFMA32(b0, q, p0); p1 = MFMA32(b1, q, p1);
  }
}
template <int OFF> __device__ __forceinline__ s16x4 tr_read(int vb) {
  s16x4 r; asm volatile("ds_read_b64_tr_b16 %0, %1 offset:%2" : "=&v"(r) : "v"(vb), "i"(OFF) : "memory"); return r;
}
template <int C> __device__ __forceinline__ void pv_one(f32x16& od, int vb0, int vb1, bf16x8 pa0, bf16x8 pa1, bf16x8 pa2, bf16x8 pa3) {
  const s16x4 l0 = tr_read<512 * C>(vb0), h0 = tr_read<512 * C>(vb1), l1 = tr_read<4096 + 512 * C>(vb0), h1 = tr_read<4096 + 512 * C>(vb1);
  const s16x4 l2 = tr_read<8192 + 512 * C>(vb0), h2 = tr_read<8192 + 512 * C>(vb1), l3 = tr_read<12288 + 512 * C>(vb0), h3 = tr_read<12288 + 512 * C>(vb1);
  asm volatile("s_waitcnt lgkmcnt(0)" ::: "memory"); SBAR();
#define PKV(L, H) (bf16x8){L[0], L[1], L[2], L[3], H[0], H[1], H[2], H[3]}
  od = MFMA32(pa0, PKV(l0, h0), od); od = MFMA32(pa1, PKV(l1, h1), od);
  od = MFMA32(pa2, PKV(l2, h2), od); od = MFMA32(pa3, PKV(l3, h3), od);
#undef PKV
}
__device__ __forceinline__ void pv_all(f32x16* o, int vb0, int vb1, bf16x8 pa0, bf16x8 pa1, bf16x8 pa2, bf16x8 pa3) {
  pv_one<0>(o[0], vb0, vb1, pa0, pa1, pa2, pa3); pv_one<1>(o[1], vb0, vb1, pa0, pa1, pa2, pa3);
  pv_one<2>(o[2], vb0, vb1, pa0, pa1, pa2, pa3); pv_one<3>(o[3], vb0, vb1, pa0, pa1, pa2, pa3);
}

__device__ void phase4(const Args& a, char* lds) {
  unsigned char* ws = a.ws;
  const int tid = threadIdx.x, wid = tid >> 6, lane = tid & 63, r32 = lane & 31, hi = lane >> 5;
  const u16* Qg = (const u16*)(ws + WS_Q); const u16* KVg = (const u16*)(ws + WS_KV); const u16* WUV = (const u16*)(ws + WS_WUV);
  u16* Y = (u16*)(ws + WS_Y);
  char* gl = lds + LDS_DATA;
  char* kvl = gl;
  float* wsl = (float*)(gl + 2 * KVBUF) + wid * 64; float* li_l = wsl; float* al_l = wsl + 32;
  float* Yl = (float*)gl;
  const int head = wid >> 1, qh = wid & 1;
  int sdst[3];
#pragma unroll
  for (int j = 0; j < 3; ++j) { const int id = tid + 512 * j, key = id / 24, ch = id % 24;
    sdst[j] = ch < 16 ? (int)off_a(key, ch) : 16384 + key * 128 + (((ch - 16) ^ ((key >> 1) & 7)) << 4); }
  const int xq = (r32 >> 2) & 3;
  const int ke = 2048 * (r32 >> 3) + 64 * (r32 & 7) + 16 * (hi ^ xq), ko = 2048 * (r32 >> 3) + 64 * (r32 & 7) + 16 * ((2 + hi) ^ xq);
  const int kr = r32 * 128 + ((hi ^ ((r32 >> 1) & 7)) << 4);
  const int tb = lane >> 4 & 1, tq = (lane & 15) >> 2, tp = lane & 3;
  const int vbl = 2048 * hi + 64 * tq + 32 * (tb ^ hi) + 8 * (tp & 1);
  const int lbase = (int)(uintptr_t)kvl;
  const int vb0 = lbase + vbl + 16 * (tp >> 1), vb1 = lbase + vbl + 256 + 16 * ((tp >> 1) ^ 1);
  for (int u = blockIdx.x; u < 256; u += gridDim.x) {
    const int b = u >> 6, qb_ = u & 63;
    const size_t tok0 = (size_t)b * SEQ + qb_ * 64 + qh * 32;
    const u16* KVb = KVg + (size_t)b * SEQ * 192;
    float m_reg = -1e30f, l_reg = 0.f; f32x16 o[4];
#pragma unroll
    for (int d = 0; d < 4; ++d)
#pragma unroll
      for (int r = 0; r < 16; ++r) o[d][r] = 0.f;
    char* Ql = gl + 2 * KVBUF + 2048;
    const char* qb = Ql + (qh * 32 + r32) * 1552 + (head * 192 + 8 * hi) * 2;
    u32x4 st0[3];
#define SLOAD(S, k0) do { const u16* _p = KVb + (size_t)(k0) * 192 + tid * 8; S[0] = *(const u32x4*)_p; S[1] = *(const u32x4*)(_p + 4096); S[2] = *(const u32x4*)(_p + 8192); } while (0)
#define SWRITE(bufi, S) do { char* _d = kvl + (bufi) * KVBUF; *(u32x4*)(_d + sdst[0]) = S[0]; *(u32x4*)(_d + sdst[1]) = S[1]; *(u32x4*)(_d + sdst[2]) = S[2]; } while (0)
#define RESC(al) do { if (__any((al) < 1.f)) { if (hi == 0) al_l[r32] = (al); asm volatile("s_waitcnt lgkmcnt(0)" ::: "memory"); \
    _Pragma("unroll") for (int d = 0; d < 4; ++d) _Pragma("unroll") for (int r = 0; r < 16; ++r) o[d][r] *= al_l[crow(r, hi)]; } } while (0)
#define CVT_LOAD(tile) const unsigned cit = ((unsigned)(u * 64 + (tile)) << 9) | (unsigned)tid; const bool cisv = cit >= 4194304u;                \
      const unsigned cio = cisv ? cit - 4194304u : cit; const float4 cf = *(const float4*)((cisv ? a.peer_v : a.peer_u) + (size_t)cio * 4)
#define CVT_STORE() do { const float csc = cisv ? PEER_SV : PEER_SU;                                                                               \
      int cp = __builtin_amdgcn_cvt_pk_fp8_f32(cf.x * csc, cf.y * csc, 0, false); cp = __builtin_amdgcn_cvt_pk_fp8_f32(cf.z * csc, cf.w * csc, cp, true); \
      *(int*)(ws + (cisv ? WS_VB : WS_UB) + (size_t)cio * 4) = cp; } while (0)
    constexpr int NT = SEQ / 64;
    f32x16 pA0, pA1, pB0, pB1; float mnA, mnB, alA, alB; bf16x8 pa0, pa1, pa2, pa3;
    __syncthreads();
    { const u16* Qu = Qg + ((size_t)b * SEQ + qb_ * 64) * 768; int tq_ = tid; asm volatile("" : "+v"(tq_));
#pragma unroll
      for (int i = 0; i < 12; ++i) { const int id = tq_ + 512 * i, row = id / 96, c = id % 96; *(u32x4*)(Ql + row * 1552 + c * 16) = *(const u32x4*)(Qu + (size_t)row * 768 + c * 8); } }
    SLOAD(st0, 0); SWRITE(0, st0); SLOAD(st0, 64); __syncthreads();
    { CVT_LOAD(0);
      qkt192(pA0, pA1, kvl, qb, ke, ko, kr); partialSM(pA0, pA1, m_reg, mnA, alA);
      SWRITE(1, st0); CVT_STORE(); }
    __syncthreads();
    for (int j = 1; j + 1 < NT; j += 2) {
      { CVT_LOAD(j);
        SBAR(); qkt192(pB0, pB1, kvl + KVBUF, qb, ke, ko, kr);
        finishSM(pA0, pA1, alA, l_reg, pa0, pa1, pa2, pa3); SBAR();
        SLOAD(st0, (j + 1) * 64); SBAR();
        pv_all(o, vb0, vb1, pa0, pa1, pa2, pa3); partialSM(pB0, pB1, m_reg, mnB, alB);
        __syncthreads(); SWRITE(0, st0); CVT_STORE();
        RESC(alB); __syncthreads(); }
      { CVT_LOAD(j + 1);
        SBAR(); qkt192(pA0, pA1, kvl, qb, ke, ko, kr);
        finishSM(pB0, pB1, alB, l_reg, pa0, pa1, pa2, pa3); SBAR();
        if (j + 2 < NT) SLOAD(st0, (j + 2) * 64); SBAR();
        pv_all(o, vb0 + KVBUF, vb1 + KVBUF, pa0, pa1, pa2, pa3); partialSM(pA0, pA1, m_reg, mnA, alA);
        __syncthreads(); if (j + 2 < NT) SWRITE(1, st0); CVT_STORE();
        RESC(alA); __syncthreads(); }
    }
    { CVT_LOAD(NT - 1);
      SBAR(); qkt192(pB0, pB1, kvl + KVBUF, qb, ke, ko, kr);
      finishSM(pA0, pA1, alA, l_reg, pa0, pa1, pa2, pa3); SBAR();
      pv_all(o, vb0, vb1, pa0, pa1, pa2, pa3); partialSM(pB0, pB1, m_reg, mnB, alB);
      CVT_STORE();
      __syncthreads(); RESC(alB);
      finishSM(pB0, pB1, alB, l_reg, pa0, pa1, pa2, pa3); SBAR();
      pv_all(o, vb0 + KVBUF, vb1 + KVBUF, pa0, pa1, pa2, pa3); }
    __syncthreads();
#undef SLOAD
#undef SWRITE
#undef RESC
#undef CVT_LOAD
#undef CVT_STORE
    int r32e = r32, hie = hi, lne = lane, wide = __builtin_amdgcn_readfirstlane(wid);
    asm volatile("" : "+v"(r32e), "+v"(hie), "+v"(lne), "+s"(wide));
    const int heade = wide >> 1, qhe = wide & 1;
    char* Ole = gl + 2 * KVBUF + 2048 + wide * 8704;
    if (hie == 0) li_l[r32e] = l_reg;
    asm volatile("s_waitcnt lgkmcnt(0)" ::: "memory");
#pragma unroll
    for (int r = 0; r < 16; ++r) {
      const int q = crow(r, hie); const float rl = __builtin_amdgcn_rcpf(li_l[q]);
#pragma unroll
      for (int d = 0; d < 4; ++d) *(u16*)(Ole + q * 272 + (32 * d + r32e) * 2) = f2bf(o[d][r] * rl);
    }
    asm volatile("s_waitcnt lgkmcnt(0)" ::: "memory");
    f32x16 y[4];
#pragma unroll
    for (int n = 0; n < 4; ++n)
#pragma unroll
      for (int r = 0; r < 16; ++r) y[n][r] = 0.f;
    const u16* wuv = WUV + ((size_t)heade * 128 + r32e) * 128 + 8 * hie;
#pragma unroll 2
    for (int s = 0; s < 8; ++s) {
      const bf16x8 af = *(const bf16x8*)(Ole + r32e * 272 + (16 * s + 8 * hie) * 2);
#pragma unroll
      for (int n = 0; n < 4; ++n) {
        const bf16x8 bw = *(const bf16x8*)(wuv + 32 * n * 128 + 16 * s);
        y[n] = MFMA32(af, bw, y[n]);
      }
    }
    __syncthreads();
#pragma unroll
    for (int n = 0; n < 4; ++n)
#pragma unroll
      for (int r = 0; r < 16; ++r) Yl[(qhe * 32 + crow(r, hie)) * 513 + heade * 128 + 32 * n + r32e] = y[n][r];
    __syncthreads();
    for (int i = 0; i < 8; ++i) {
      const int pl = wide * 8 + i; const size_t tok = (size_t)b * SEQ + qb_ * 64 + pl;
      float v[8], ssq = 0.f;
#pragma unroll
      for (int jj = 0; jj < 8; ++jj) { v[jj] = Yl[pl * 513 + lne + 64 * jj]; ssq += v[jj] * v[jj]; }
      ssq = wave_sum(ssq);
      const float rstd = rsqrtf(ssq * (1.f / 512.f) + EPS);
#pragma unroll
      for (int jj = 0; jj < 8; ++jj) { const int col = lne + 64 * jj; Y[tok * 1024 + col] = f2bf(v[jj] * rstd * a.g_attn_out[col]); }
    }
    __syncthreads();
  }
}

__device__ void phase5(const Args& a, char* lds) {
  unsigned char* ws = a.ws;
  const int tid = threadIdx.x, lane = tid & 63, wv = tid >> 6;
  const u16* Y = (const u16*)(ws + WS_Y); const u16* WO = (const u16*)(ws + WS_WO);
  float* X1 = (float*)(ws + WS_X1); float* SSQ = (float*)(ws + WS_SSQ); const float* mod = (const float*)(ws + WS_MOD);
  u16* X1B = (u16*)(ws + WS_H);
  char* gl = lds + LDS_DATA; float* Cl = (float*)gl;
  for (int u = blockIdx.x; u < 128 * 4; u += gridDim.x) {
    int mt, nt; xcd_unit(u, 4, mt, nt); const int R0 = mt * 128, b = R0 >> 12;
    f32x16 acc[2][2];
    gemm_128x256(Y + (size_t)R0 * 1024, 1024, WO + (size_t)(nt * 256) * 1024, 1024, 16, acc, gl);
    acc_to_lds(acc, Cl);
    __syncthreads();
    float2 g1[2];
#pragma unroll
    for (int j = 0; j < 2; ++j) g1[j] = *(const float2*)(mod + b * 6144 + 2048 + nt * 256 + 2 * lane + 128 * j);
    for (int i0 = 0; i0 < 16; i0 += 8) {
      float2 xv[8][2];
#pragma unroll
      for (int i = 0; i < 8; ++i)
#pragma unroll
        for (int j = 0; j < 2; ++j) xv[i][j] = *(const float2*)(a.x + (size_t)(R0 + wv * 16 + i0 + i) * 1024 + nt * 256 + 2 * lane + 128 * j);
#pragma unroll
      for (int i = 0; i < 8; ++i) {
        const int row = wv * 16 + i0 + i; const size_t tok = R0 + row; float ssq = 0.f;
#pragma unroll
        for (int j = 0; j < 2; ++j) {
          const int col = nt * 256 + 2 * lane + 128 * j;
          const float v0 = xv[i][j].x + g1[j].x * Cl[row * CLD + 2 * lane + 128 * j], v1 = xv[i][j].y + g1[j].y * Cl[row * CLD + 2 * lane + 128 * j + 1];
          *(unsigned*)(X1B + tok * 1024 + col) = pack2(v0, v1); ssq += v0 * v0 + v1 * v1;
        }
        ssq = wave_sum(ssq);
        if (lane == 0) SSQ[tok * 4 + nt] = ssq;
      }
    }
    __syncthreads();
  }
}
__device__ __forceinline__ float vmaxf(float a, float b) { float r; asm("v_max_f32 %0, %1, %2" : "=v"(r) : "v"(a), "v"(b)); return r; }
__device__ __forceinline__ float vminf(float a, float b) { float r; asm("v_min_f32 %0, %1, %2" : "=v"(r) : "v"(a), "v"(b)); return r; }
#define TK_CE(x, y) do { const float _h = vmaxf((x), (y)); (y) = vminf((x), (y)); (x) = _h; } while (0)
#define TK_SORT16(t) do { TK_CE(t[0], t[1]); TK_CE(t[2], t[3]); TK_CE(t[0], t[2]); TK_CE(t[1], t[3]); TK_CE(t[1], t[2]); TK_CE(t[4], t[5]); TK_CE(t[6], t[7]); TK_CE(t[4], t[6]); TK_CE(t[5], t[7]); TK_CE(t[5], t[6]); TK_CE(t[0], t[4]); TK_CE(t[2], t[6]); TK_CE(t[2], t[4]); TK_CE(t[1], t[5]); TK_CE(t[3], t[7]); TK_CE(t[3], t[5]); TK_CE(t[1], t[2]); TK_CE(t[3], t[4]); TK_CE(t[5], t[6]); TK_CE(t[8], t[9]); TK_CE(t[10], t[11]); TK_CE(t[8], t[10]); TK_CE(t[9], t[11]); TK_CE(t[9], t[10]); TK_CE(t[12], t[13]); TK_CE(t[14], t[15]); TK_CE(t[12], t[14]); TK_CE(t[13], t[15]); TK_CE(t[13], t[14]); TK_CE(t[8], t[12]); TK_CE(t[10], t[14]); TK_CE(t[10], t[12]); TK_CE(t[9], t[13]); TK_CE(t[11], t[15]); TK_CE(t[11], t[13]); TK_CE(t[9], t[10]); TK_CE(t[11], t[12]); TK_CE(t[13], t[14]); TK_CE(t[0], t[8]); TK_CE(t[4], t[12]); TK_CE(t[4], t[8]); TK_CE(t[2], t[10]); TK_CE(t[6], t[14]); TK_CE(t[6], t[10]); TK_CE(t[2], t[4]); TK_CE(t[6], t[8]); TK_CE(t[10], t[12]); TK_CE(t[1], t[9]); TK_CE(t[5], t[13]); TK_CE(t[5], t[9]); TK_CE(t[3], t[11]); TK_CE(t[7], t[15]); TK_CE(t[7], t[11]); TK_CE(t[3], t[5]); TK_CE(t[7], t[9]); TK_CE(t[11], t[13]); TK_CE(t[1], t[2]); TK_CE(t[3], t[4]); TK_CE(t[5], t[6]); TK_CE(t[7], t[8]); TK_CE(t[9], t[10]); TK_CE(t[11], t[12]); TK_CE(t[13], t[14]); } while (0)
#define TK_BMERGE16(t) do { TK_CE(t[0], t[8]); TK_CE(t[1], t[9]); TK_CE(t[2], t[10]); TK_CE(t[3], t[11]); TK_CE(t[4], t[12]); TK_CE(t[5], t[13]); TK_CE(t[6], t[14]); TK_CE(t[7], t[15]); TK_CE(t[0], t[4]); TK_CE(t[1], t[5]); TK_CE(t[2], t[6]); TK_CE(t[3], t[7]); TK_CE(t[8], t[12]); TK_CE(t[9], t[13]); TK_CE(t[10], t[14]); TK_CE(t[11], t[15]); TK_CE(t[0], t[2]); TK_CE(t[1], t[3]); TK_CE(t[4], t[6]); TK_CE(t[5], t[7]); TK_CE(t[8], t[10]); TK_CE(t[9], t[11]); TK_CE(t[12], t[14]); TK_CE(t[13], t[15]); TK_CE(t[0], t[1]); TK_CE(t[2], t[3]); TK_CE(t[4], t[5]); TK_CE(t[6], t[7]); TK_CE(t[8], t[9]); TK_CE(t[10], t[11]); TK_CE(t[12], t[13]); TK_CE(t[14], t[15]); } while (0)
#define TK_MERGE(A, B) do { _Pragma("unroll") for (int _i = 0; _i < 16; ++_i) A[_i] = vmaxf(A[_i], B[15 - _i]); TK_BMERGE16(A); } while (0)
__constant__ unsigned long long TK_I[4] = {0x0000000000000000ull, 0x0007744411111111ull, 0x0006655333322222ull, 0x00000000FEDCBA98ull};
__constant__ unsigned long long TK_J[4] = {0xFEDCBA9876543210ull, 0x0001021076543210ull, 0x0001010321043210ull, 0x0000000000000000ull};
__constant__ int TK_N[4] = {16, 13, 13, 8};

__device__ void phase6(const Args& a, char* lds) {
  unsigned char* ws = a.ws;
  const int tid = threadIdx.x, lane = tid & 63, wv = tid >> 6, r32 = lane & 31, hi = lane >> 5;
  const u16* H = (const u16*)(ws + WS_H); const u16* WST = (const u16*)(ws + WS_WST);
  float* TOPS = (float*)(ws + WS_TOPK);
  const float* BIASP = (const float*)(ws + WS_BIASP); const float* SSQ = (const float*)(ws + WS_SSQ);
  char* gl = lds + LDS_DATA;
  for (int u = blockIdx.x; u < 8 * 64; u += gridDim.x) {
    int tb, hd; xcd_unit(u, 8, tb, hd);
    const int b = tb >> 4;
    f32x16 sc[8];
    gemm_256x256_wide(WST + ((size_t)b * 2048 + hd * 256) * 1024, 1024, H + (size_t)tb * 256 * 1024, 1024, 16, sc, gl);
    float* bl = (float*)gl;
    if (tid < 256) bl[tid] = BIASP[((size_t)0 * 4 + b) * 2048 + hd * 256 + tid] + BIASP[((size_t)1 * 4 + b) * 2048 + hd * 256 + tid]
                           + BIASP[((size_t)2 * 4 + b) * 2048 + hd * 256 + tid] + BIASP[((size_t)3 * 4 + b) * 2048 + hd * 256 + tid];
    const float4 sq = *(const float4*)(SSQ + (size_t)(tb * 256 + 32 * wv + r32) * 4);
    const float rstd = rsqrtf((sq.x + sq.y + sq.z + sq.w) * (1.f / 1024.f) + EPS);
    __syncthreads();
#pragma unroll
    for (int half = 0; half < 2; ++half) {
      float g0[16], g1[16], g2[16], g3[16], p[16];
#pragma unroll
      for (int r = 0; r < 16; ++r) {
        const unsigned key = crow(r, hi);
        g0[r] = __uint_as_float((__float_as_uint(fmaf(sc[4 * half + 0][r], rstd, bl[128 * half + key])) & ~127u) | key);
        g1[r] = __uint_as_float((__float_as_uint(fmaf(sc[4 * half + 1][r], rstd, bl[128 * half + 32 + key])) & ~127u) | (32u + key));
        g2[r] = __uint_as_float((__float_as_uint(fmaf(sc[4 * half + 2][r], rstd, bl[128 * half + 64 + key])) & ~127u) | (64u + key));
        g3[r] = __uint_as_float((__float_as_uint(fmaf(sc[4 * half + 3][r], rstd, bl[128 * half + 96 + key])) & ~127u) | (96u + key));
      }
      TK_SORT16(g0); TK_SORT16(g1); TK_SORT16(g2); TK_SORT16(g3);
      TK_MERGE(g0, g1); TK_MERGE(g2, g3); TK_MERGE(g0, g2);
#pragma unroll
      for (int i = 0; i < 16; ++i) {
        auto rr = __builtin_amdgcn_permlane32_swap(__float_as_uint(g0[i]), __float_as_uint(g0[i]), false, false);
        p[i] = __uint_as_float(hi ? rr[0] : rr[1]);
      }
      TK_MERGE(g0, p);
      if (hi == 0) {
        float* dst = TOPS + ((size_t)(tb * 256 + 32 * wv + r32) * 16 + 2 * hd + half) * 16;
#pragma unroll
        for (int i = 0; i < 16; i += 4) *(float4*)(dst + i) = make_float4(g0[i], g0[i + 1], g0[i + 2], g0[i + 3]);
      }
    }
  }
}

typedef __attribute__((ext_vector_type(4))) float f32x4;
#define MFMA4(a, b, c) __builtin_amdgcn_mfma_f32_4x4x4bf16_1k((a), (b), (c), 0, 0, 0)
#define MFMA8(a, b, c) __builtin_amdgcn_mfma_f32_16x16x32_fp8_fp8((a), (b), (c), 0, 0, 0)
constexpr float P7_HS = 16.f;
constexpr int P7_VROW = 2112, P7_VBUF = 4 * P7_VROW;
constexpr int P7_RING = 64;
constexpr int P7_ENT  = P7_RING + 8 * 2 * P7_VBUF;
constexpr int P7_CNT  = P7_ENT + 8 * 2048;
static_assert(P7_CNT + 8 * 256 <= LDS_BYTES, "phase 7 LDS map");
__device__ __forceinline__ float sel4(const f32x4& d, int k) { return k == 0 ? d[0] : (k == 1 ? d[1] : (k == 2 ? d[2] : d[3])); }
__device__ __forceinline__ unsigned fp8x2_bf16(unsigned x, float sc, bool hi) {
  return hi ? __builtin_bit_cast(unsigned, __builtin_amdgcn_cvt_scalef32_pk_bf16_fp8(x, sc, true)) : __builtin_bit_cast(unsigned, __builtin_amdgcn_cvt_scalef32_pk_bf16_fp8(x, sc, false));
}

__device__ void phase7(const Args& a, char* lds) {
  unsigned char* ws = a.ws;
  const int tid = threadIdx.x, lane = tid & 63, wv = __builtin_amdgcn_readfirstlane(tid >> 6), blk = lane >> 2, j4 = lane & 3;
  const u16* H = (const u16*)(ws + WS_H); const unsigned char* U8 = ws + WS_UB; const unsigned char* V8 = ws + WS_VB;
  const float* TOPS = (const float*)(ws + WS_TOPK); const float* X1 = (const float*)(ws + WS_X1); const float* mod = (const float*)(ws + WS_MOD);
  const float* SSQ = (const float*)(ws + WS_SSQ);
  const unsigned lbase = (unsigned)(uintptr_t)lds;
  char* ring = lds + P7_RING + wv * 2 * P7_VBUF;
  unsigned* ents = (unsigned*)(lds + P7_ENT + wv * 2048);
  int* cntw = (int*)(lds + P7_CNT + wv * 256);
  const int trb = (int)(lbase + P7_RING + wv * 2 * P7_VBUF) + ((lane & 15) >> 2) * P7_VROW + 32 * (lane >> 4) + 8 * (lane & 3);
  const int NWV = gridDim.x * 8;
  const bool dg = (lane >> 4) == ((lane >> 2) & 3);
  for (int qd = blockIdx.x * 8 + wv; qd < T / 4; qd += NWV) {
    const int tok0 = qd * 4, b = tok0 >> 12;
    float* TS = (float*)ring;
#pragma unroll
    for (int i = 0; i < 4; ++i) *(float4*)(TS + 256 * i + 4 * lane) = *(const float4*)(TOPS + (size_t)tok0 * 256 + 256 * i + 4 * lane);
    cntw[lane] = 0;
    asm volatile("s_waitcnt lgkmcnt(0)" ::: "memory");
    unsigned ec[8];
#pragma unroll
    for (int rd = 0; rd < 2; ++rd) {
      const int combo = (lane >> 2) + 16 * rd, tl = combo >> 3, hd = combo & 7, q = lane & 3;
      const float* t1 = TS + (tl * 16 + hd * 2) * 16; const float* t2 = t1 + 16;
      const unsigned long long ip = TK_I[q], jp = TK_J[q]; const int cn = TK_N[q];
      float L[16], P[16];
#pragma unroll
      for (int c = 0; c < 16; ++c) {
        const unsigned i = (unsigned)(ip >> (4 * c)) & 15u, j = (unsigned)(jp >> (4 * c)) & 15u;
        const float sm = t1[i] + t2[j];
        L[c] = c < cn ? __uint_as_float((__float_as_uint(sm) & ~255u) | (i << 4) | j) : -3.0e38f;
      }
      TK_SORT16(L);
#pragma unroll
      for (int c = 0; c < 16; ++c) P[c] = __uint_as_float(__builtin_amdgcn_update_dpp(0, __float_as_uint(L[c]), 0xB1, 0xf, 0xf, false));
      TK_MERGE(L, P);
#pragma unroll
      for (int c = 0; c < 16; ++c) P[c] = __uint_as_float(__builtin_amdgcn_update_dpp(0, __float_as_uint(L[c]), 0x4E, 0xf, 0xf, false));
      TK_MERGE(L, P);
      float sum = 0.f;
      const float m0 = __uint_as_float(__float_as_uint(L[0]) & ~255u);
#pragma unroll
      for (int c = 0; c < 16; ++c) sum += __expf(__uint_as_float(__float_as_uint(L[c]) & ~255u) - m0);
      const float inv = 1.f / sum;
#pragma unroll
      for (int r = 0; r < 4; ++r) {
        const float lv = q == 0 ? L[r] : (q == 1 ? L[4 + r] : (q == 2 ? L[8 + r] : L[12 + r]));
        const unsigned bits = __float_as_uint(lv), id = bits & 255u;
        const unsigned i1 = __float_as_uint(t1[id >> 4]) & 127u, i2 = __float_as_uint(t2[id & 15u]) & 127u;
        const float gate = __expf(__uint_as_float(bits & ~255u) - m0) * inv;
        ec[4 * rd + r] = (i1 * 128u + i2) | ((unsigned)tl << 14) | (pack2(0.f, gate) & 0xFFFF0000u);
      }
    }
    {
#pragma unroll
      for (int i = 0; i < 8; ++i) atomicAdd(&cntw[(ec[i] & 0x3FFFu) >> 8], 1);
      asm volatile("s_waitcnt lgkmcnt(0)" ::: "memory");
      const int c = cntw[lane]; int inc = c;
#pragma unroll
      for (int o = 1; o < 64; o <<= 1) { const int v = __shfl_up(inc, o, 64); if (lane >= o) inc += v; }
      asm volatile("s_waitcnt lgkmcnt(0)" ::: "memory");
      cntw[lane] = inc - c;
      asm volatile("s_waitcnt lgkmcnt(0)" ::: "memory");
#pragma unroll
      for (int i = 0; i < 8; ++i) { const int pos = atomicAdd(&cntw[(ec[i] & 0x3FFFu) >> 8], 1); ents[pos] = ec[i]; }
      asm volatile("s_waitcnt lgkmcnt(0)" ::: "memory");
    }
    uint2 hA[4][2];
    { const float4 sq = *(const float4*)(SSQ + (size_t)(tok0 + j4) * 4);
      const float rstd = rsqrtf((sq.x + sq.y + sq.z + sq.w) * (1.f / 1024.f) + EPS);
#pragma unroll
      for (int i = 0; i < 4; ++i)
#pragma unroll
        for (int hf = 0; hf < 2; ++hf) {
          const int k0 = 256 * i + 16 * blk + 8 * hf;
          const u32x4 xb = *(const u32x4*)(H + (size_t)(tok0 + j4) * 1024 + k0);
          float hv[8];
#pragma unroll
          for (int e = 0; e < 8; e += 4) {
            const float4 g = *(const float4*)(a.g_norm2 + k0 + e), sc4 = *(const float4*)(mod + b * 6144 + 4096 + k0 + e), sh4 = *(const float4*)(mod + b * 6144 + 3072 + k0 + e);
            hv[e]     = bflo(xb[e >> 1]) * rstd * g.x * (1.f + sc4.x) + sh4.x;     hv[e + 1] = bfhi(xb[e >> 1]) * rstd * g.y * (1.f + sc4.y) + sh4.y;
            hv[e + 2] = bflo(xb[(e >> 1) + 1]) * rstd * g.z * (1.f + sc4.z) + sh4.z; hv[e + 3] = bfhi(xb[(e >> 1) + 1]) * rstd * g.w * (1.f + sc4.w) + sh4.w;
          }
          int p0 = __builtin_amdgcn_cvt_pk_fp8_f32(hv[0] * P7_HS, hv[1] * P7_HS, 0, false); p0 = __builtin_amdgcn_cvt_pk_fp8_f32(hv[2] * P7_HS, hv[3] * P7_HS, p0, true);
          int p1 = __builtin_amdgcn_cvt_pk_fp8_f32(hv[4] * P7_HS, hv[5] * P7_HS, 0, false); p1 = __builtin_amdgcn_cvt_pk_fp8_f32(hv[6] * P7_HS, hv[7] * P7_HS, p1, true);
          hA[i][hf] = make_uint2((unsigned)p0, (unsigned)p1);
        } }
    f32x4 acc[16];
#pragma unroll
    for (int c = 0; c < 16; ++c) acc[c] = (f32x4){0.f, 0.f, 0.f, 0.f};
#define P7_VPHASE(bufi) do { const int _vb = trb + (bufi) * P7_VBUF;                                                            \
      { const s16x4 v0 = tr_read<0>(_vb), v1 = tr_read<128>(_vb), v2 = tr_read<256>(_vb), v3 = tr_read<384>(_vb),               \
                    v4 = tr_read<512>(_vb), v5 = tr_read<640>(_vb), v6 = tr_read<768>(_vb), v7 = tr_read<896>(_vb);               \
        asm volatile("s_waitcnt lgkmcnt(0)" ::: "memory"); SBAR();                                                                \
        acc[0] = MFMA4(awp, v0, acc[0]); acc[1] = MFMA4(awp, v1, acc[1]); acc[2] = MFMA4(awp, v2, acc[2]); acc[3] = MFMA4(awp, v3, acc[3]);   \
        acc[4] = MFMA4(awp, v4, acc[4]); acc[5] = MFMA4(awp, v5, acc[5]); acc[6] = MFMA4(awp, v6, acc[6]); acc[7] = MFMA4(awp, v7, acc[7]); } \
      { const s16x4 v0 = tr_read<1024>(_vb), v1 = tr_read<1152>(_vb), v2 = tr_read<1280>(_vb), v3 = tr_read<1408>(_vb),         \
                    v4 = tr_read<1536>(_vb), v5 = tr_read<1664>(_vb), v6 = tr_read<1792>(_vb), v7 = tr_read<1920>(_vb);           \
        asm volatile("s_waitcnt lgkmcnt(0)" ::: "memory"); SBAR();                                                                \
        acc[8] = MFMA4(awp, v0, acc[8]); acc[9] = MFMA4(awp, v1, acc[9]); acc[10] = MFMA4(awp, v2, acc[10]); acc[11] = MFMA4(awp, v3, acc[11]); \
        acc[12] = MFMA4(awp, v4, acc[12]); acc[13] = MFMA4(awp, v5, acc[13]); acc[14] = MFMA4(awp, v6, acc[14]); acc[15] = MFMA4(awp, v7, acc[15]); } } while (0)
    u32x4 u8[4], v8[4];
#define P7_LOADG(EN) do { const unsigned _ex = (EN) & 0x3FFFu; const unsigned char* _pu = U8 + (size_t)_ex * 1024 + 16 * blk;      \
      _Pragma("unroll") for (int _i = 0; _i < 4; ++_i) u8[_i] = *(const u32x4*)(_pu + 256 * _i);                                 \
      _Pragma("unroll") for (int _q = 0; _q < 4; ++_q) { const unsigned _eq = (unsigned)__builtin_amdgcn_readlane((int)_ex, _q);  \
        v8[_q] = *(const u32x4*)(V8 + (size_t)_eq * 1024 + 16 * lane); } } while (0)
    unsigned enc = ents[j4], enn = ents[4 + j4];
    P7_LOADG(enc);
    s16x4 awp = {0, 0, 0, 0};
    constexpr int NG = 128;
#pragma unroll 2
    for (int g = 0; g < NG; ++g) {
      if (g > 0) P7_VPHASE((g - 1) & 1);
      f32x4 d0 = {0.f, 0.f, 0.f, 0.f}, d1 = {0.f, 0.f, 0.f, 0.f};
#pragma unroll
      for (int i = 0; i < 4; ++i) {
        d0 = MFMA8(__builtin_bit_cast(long, hA[i][0]), __builtin_bit_cast(long, make_uint2(u8[i][0], u8[i][1])), d0);
        d1 = MFMA8(__builtin_bit_cast(long, hA[i][1]), __builtin_bit_cast(long, make_uint2(u8[i][2], u8[i][3])), d1);
      }
      { char* vw = ring + (g & 1) * P7_VBUF + lane * 32;
#pragma unroll
        for (int q = 0; q < 4; ++q) {
          u32x4 o0, o1;
          o0[0] = fp8x2_bf16(v8[q][0], 1.f / PEER_SV, false); o0[1] = fp8x2_bf16(v8[q][0], 1.f / PEER_SV, true);
          o0[2] = fp8x2_bf16(v8[q][1], 1.f / PEER_SV, false); o0[3] = fp8x2_bf16(v8[q][1], 1.f / PEER_SV, true);
          o1[0] = fp8x2_bf16(v8[q][2], 1.f / PEER_SV, false); o1[1] = fp8x2_bf16(v8[q][2], 1.f / PEER_SV, true);
          o1[2] = fp8x2_bf16(v8[q][3], 1.f / PEER_SV, false); o1[3] = fp8x2_bf16(v8[q][3], 1.f / PEER_SV, true);
          *(u32x4*)(vw + q * P7_VROW) = o0; *(u32x4*)(vw + q * P7_VROW + 16) = o1;
        } }
      unsigned en2 = 0u;
      if (g + 1 < NG) { P7_LOADG(enn); if (g + 2 < NG) en2 = ents[4 * (g + 2) + j4]; }
      const int tk = (enc >> 14) & 3;
      float av = dg ? (sel4(d0, tk) + sel4(d1, tk)) * (1.f / (PEER_SU * P7_HS)) : 0.f;
      av += __uint_as_float(__builtin_amdgcn_update_dpp(0, __float_as_uint(av), 0x124, 0xf, 0xf, false));
      av += __uint_as_float(__builtin_amdgcn_update_dpp(0, __float_as_uint(av), 0x128, 0xf, 0xf, false));
      av += __shfl_xor(av, 16, 64);
      { auto rr = __builtin_amdgcn_permlane32_swap(__float_as_uint(av), __float_as_uint(av), false, false); av = __uint_as_float(rr[0]) + __uint_as_float(rr[1]); }
      const float wgt = gelu_exact(av) * __uint_as_float(enc & 0xFFFF0000u);
      float z[4];
#define P7_QB(x, k) __builtin_amdgcn_update_dpp(0, (x), (k) * 0x55, 0xf, 0xf, false)
      { const unsigned wb = __float_as_uint(wgt), tb = (unsigned)tk;
        unsigned w0 = P7_QB(wb, 0), w1 = P7_QB(wb, 1), w2 = P7_QB(wb, 2), w3 = P7_QB(wb, 3);
        unsigned t0 = P7_QB(tb, 0), t1 = P7_QB(tb, 1), t2 = P7_QB(tb, 2), t3 = P7_QB(tb, 3);
        asm volatile("" : "+v"(w0), "+v"(w1), "+v"(w2), "+v"(w3), "+v"(t0), "+v"(t1), "+v"(t2), "+v"(t3));
        z[0] = ((int)t0 == j4) ? __uint_as_float(w0) : 0.f; z[1] = ((int)t1 == j4) ? __uint_as_float(w1) : 0.f;
        z[2] = ((int)t2 == j4) ? __uint_as_float(w2) : 0.f; z[3] = ((int)t3 == j4) ? __uint_as_float(w3) : 0.f; }
#undef P7_QB
      { const uint2 pk = {pack2(z[0], z[1]), pack2(z[2], z[3])}; awp = __builtin_bit_cast(s16x4, pk); }
      enc = enn; enn = en2;
    }
#undef P7_LOADG
    P7_VPHASE((NG - 1) & 1);
#undef P7_VPHASE
    int lne = lane; asm volatile("" : "+v"(lne));
    float ss[4] = {0.f, 0.f, 0.f, 0.f};
#pragma unroll
    for (int c = 0; c < 16; ++c) {
      const float g2 = mod[b * 6144 + 5120 + 64 * c + lne];
#pragma unroll
      for (int r = 0; r < 4; ++r) { const float v = bflo((unsigned)H[(size_t)(tok0 + r) * 1024 + 64 * c + lne]) + g2 * acc[c][r]; acc[c][r] = v; ss[r] += v * v; }
    }
    float rstd[4];
#pragma unroll
    for (int r = 0; r < 4; ++r) rstd[r] = rsqrtf(wave_sum(ss[r]) * (1.f / 1024.f) + EPS);
#pragma unroll
    for (int c = 0; c < 16; ++c) {
      const float gf = a.g_final[64 * c + lne];
#pragma unroll
      for (int r = 0; r < 4; ++r) a.out[(size_t)(tok0 + r) * 1024 + 64 * c + lne] = acc[c][r] * rstd[r] * gf;
    }
  }
}

constexpr int N_PHASES = 8;
__global__ void __launch_bounds__(512, 2) fwd(Args args) {
  extern __shared__ __attribute__((aligned(16))) char lds[];
  if (threadIdx.x == 0) *(uint4*)lds = make_uint4(0u, 0u, 0u, 0u);
  __syncthreads();
  const int lo = args.ph_lo, hi = args.ph_hi;
  XcdBarrier bar; bar.bar = (unsigned*)(args.ws + WS_BAR); bar.x = 0; bar.st = (volatile LAS unsigned*)lds;
  if (hi - lo > 1) bar = xcd_barrier_post((unsigned*)(args.ws + WS_BAR), (volatile LAS unsigned*)lds);
#ifndef ONLY_PHASE
#define ONLY_PHASE -1
#endif
#define IN(k) (lo <= (k) && (k) < hi && (ONLY_PHASE < 0 || ONLY_PHASE == (k)))
#define SEAM(k) do { if (IN(k) && IN((k) + 1)) xcd_barrier(bar); } while (0)
  if (IN(0)) phase0(args, lds);
  SEAM(0);
  if (IN(1)) { phase1(args, lds); phase1b(args, lds); }
  SEAM(1);
  if (IN(2)) phase2(args, lds);
  SEAM(2);
  if (IN(3)) phase3(args, lds);
  SEAM(3);
  if (IN(4)) phase4(args, lds);
  SEAM(4);
  if (IN(5)) phase5(args, lds);
  SEAM(5);
  if (IN(6)) phase6(args, lds);
  SEAM(6);
  if (IN(7)) phase7(args, lds);
#undef IN
#undef SEAM
}

extern "C" void kernel_launch(void* const* d_in, const int* in_sizes, int n_in, void* d_out, int out_size, void* d_ws, size_t ws_size, hipStream_t stream) {
  static int grid = 0;
  if (grid == 0) {
    if (n_in != 23 || out_size != T * DM || ws_size < WS_END) { fprintf(stderr, "kernel_launch: unexpected shapes (n_in %d out %d ws %zu need %zu)\n", n_in, out_size, ws_size, (size_t)WS_END); grid = -1; return; }
    int dev = 0, cus = 0, per_cu = 0;
    (void)hipGetDevice(&dev); (void)hipDeviceGetAttribute(&cus, hipDeviceAttributeMultiprocessorCount, dev);
    if (hipFuncSetAttribute((const void*)fwd, hipFuncAttributeMaxDynamicSharedMemorySize, LDS_BYTES) != hipSuccess) { fprintf(stderr, "kernel_launch: hipFuncSetAttribute failed\n"); grid = -1; return; }
    if (hipOccupancyMaxActiveBlocksPerMultiprocessor(&per_cu, (const void*)fwd, 512, LDS_BYTES) != hipSuccess || per_cu < 1) { fprintf(stderr, "kernel_launch: occupancy query says %d\n", per_cu); per_cu = 1; }
    (void)hipGetLastError();
    grid = cus;
  }
  if (grid < 0) return;
  (void)hipMemsetAsync((char*)d_ws + WS_BAR, 0, 16384, stream);
  Args a{};
  a.x = (const float*)d_in[0]; a.c = (const float*)d_in[1]; a.pos = (const int*)d_in[2];
  a.w_ada = (const float*)d_in[3]; a.b_ada = (const float*)d_in[4]; a.g_norm1 = (const float*)d_in[5]; a.w_in = (const float*)d_in[6];
  a.g_q_a = (const float*)d_in[7]; a.w_uq = (const float*)d_in[8]; a.g_kv_a = (const float*)d_in[9]; a.w_ukv = (const float*)d_in[10];
  a.g_sg = (const float*)d_in[11]; a.w_sg = (const float*)d_in[12]; a.b_sg = (const float*)d_in[13]; a.g_attn_out = (const float*)d_in[14];
  a.g_sg_out = (const float*)d_in[15]; a.w_o = (const float*)d_in[16]; a.g_norm2 = (const float*)d_in[17]; a.w_peer_q = (const float*)d_in[18];
  a.peer_keys = (const float*)d_in[19]; a.peer_u = (const float*)d_in[20]; a.peer_v = (const float*)d_in[21]; a.g_final = (const float*)d_in[22];
  a.out = (float*)d_out; a.ws = (unsigned char*)d_ws;
#if N_LAUNCH_MODE == 0
  a.ph_lo = 0; a.ph_hi = N_PHASES;
  hipLaunchKernelGGL(fwd, dim3(grid), dim3(512), LDS_BYTES, stream, a);
#else
  for (int p = 0; p < N_PHASES; ++p) for (int rep = 0; rep <= ((DUP_MASK >> p) & 1); ++rep) { a.ph_lo = p; a.ph_hi = p + 1; hipLaunchKernelGGL(fwd, dim3(grid), dim3(512), LDS_BYTES, stream, a); }
#endif
  const hipError_t le = hipPeekAtLastError();
  if (le != hipSuccess) fprintf(stderr, "kernel_launch: launch failed: %s\n", hipGetErrorName(le));
}
```

```cpp
#include <hip/hip_runtime.h>
#include <stdint.h>
#include <stdio.h>

#define N_LAUNCH_MODE 0
#define DUP_MASK 0x000

typedef unsigned short u16;
typedef __attribute__((ext_vector_type(8))) short bf16x8;
typedef __attribute__((ext_vector_type(4))) short s16x4;
typedef __attribute__((ext_vector_type(16))) float f32x16;
typedef __attribute__((ext_vector_type(4))) unsigned u32x4;
typedef __attribute__((ext_vector_type(4))) float f32x4;

constexpr int T = 16384, DM = 1024, SEQ = 4096;
constexpr float EPS = 1e-6f;

constexpr size_t WS_BAR  = 0;
constexpr int ADA_KS = 16;
constexpr size_t WS_MODP = 16384;
constexpr size_t WS_MOD  = WS_MODP + (size_t)ADA_KS * 4 * 6144 * 4;
constexpr size_t WS_CS   = WS_MOD + 98304;
constexpr size_t WS_WIN  = WS_CS + 4194304;
constexpr size_t WS_WQ2  = WS_WIN + 3145728;
constexpr size_t WS_WUV  = WS_WQ2 + 393216;
constexpr size_t WS_WO   = WS_WUV + 131072;
constexpr size_t WS_WPQ  = WS_WO + 2097152;
constexpr size_t WS_KEYS = WS_WPQ + 4194304;
constexpr size_t WS_WSG  = WS_KEYS + 524288;
constexpr size_t WS_UB   = WS_WSG + 131072;
constexpr size_t WS_VB   = WS_UB + 33554432;
constexpr size_t WS_H    = WS_VB + 33554432;
constexpr size_t WS_Y    = WS_H + 33554432;
constexpr size_t WS_KV   = WS_Y + 33554432;
constexpr size_t WS_TOPK = WS_KV + 6291456;
constexpr size_t WS_SSQ  = WS_TOPK + 16777216;
constexpr size_t WS_SSQV = WS_SSQ + 262144;
constexpr size_t WS_R1   = WS_SSQV + 131072;
constexpr size_t WS_Q    = WS_R1;
constexpr size_t WS_QA   = WS_Q + 25165824;
constexpr size_t WS_UACT = WS_QA + 8388608;
constexpr size_t WS_GVT  = WS_UACT + 16777216;
constexpr size_t WS_X1   = WS_R1;
constexpr size_t WS_WST  = WS_R1 + 67108864;
constexpr size_t WS_BIASP = WS_WST + 4 * 4194304;
constexpr size_t WS_END  = WS_BIASP + 131072;

constexpr int LDS_BYTES = 155648;
constexpr int LDS_DATA  = 64;

struct Args {
  const float *x, *c; const int* pos;
  const float *w_ada, *b_ada, *g_norm1, *w_in, *g_q_a, *w_uq, *g_kv_a, *w_ukv, *g_sg, *w_sg, *b_sg, *g_attn_out, *g_sg_out,
              *w_o, *g_norm2, *w_peer_q, *peer_keys, *peer_u, *peer_v, *g_final;
  float* out; unsigned char* ws; int ph_lo, ph_hi;
};

#define XB_TMO      128
#define XB_XCNT(j)  (256  + 64 * (j))
#define XB_XSUB(j)  (1280 + 64 * (j))
#define XB_XGEN(j)  (2304 + 64 * (j))
#define XB_TOP      3328
#define XB_TOPGEN   3392
#define XCD_BAR_WORDS 3456
#define XB_SPIN_CAP (1u << 18)
#define LAS __attribute__((address_space(3)))

__device__ __forceinline__ unsigned xb_ld(unsigned* p)              { return __hip_atomic_load(p, __ATOMIC_RELAXED, __HIP_MEMORY_SCOPE_AGENT); }
__device__ __forceinline__ unsigned xb_add(unsigned* p, unsigned v) { return __hip_atomic_fetch_add(p, v, __ATOMIC_RELAXED, __HIP_MEMORY_SCOPE_AGENT); }
__device__ __forceinline__ unsigned xb_xcc_id() { return (unsigned)__builtin_amdgcn_s_getreg((3 << 11) | 20) & 0xFu; }
#define XB_SPIN(cond, bar) do { unsigned _sp = 0; while (cond) { __builtin_amdgcn_s_sleep(1); \
    if ((++_sp & 255u) == 0u) { if (xb_ld(&(bar)[XB_TMO])) break; if (_sp > XB_SPIN_CAP) { atomicAdd(&(bar)[XB_TMO], 1u); break; } } } } while (0)

struct XcdBarrier { unsigned* bar; unsigned x; volatile LAS unsigned* st; };

__device__ __forceinline__ XcdBarrier xcd_barrier_post(unsigned* bar, volatile LAS unsigned* st) {
    XcdBarrier b; b.bar = bar; b.x = xb_xcc_id(); b.st = st;
    if (threadIdx.x == 0) (void)xb_add(&bar[XB_XCNT(b.x)], 1u);
    return b;
}
__device__ __forceinline__ void xcd_barrier_complete(unsigned* bar, unsigned x, unsigned& nloc, unsigned& nx) {
    const unsigned G = gridDim.x * gridDim.y * gridDim.z;
    unsigned sum, cnt, mine, sp = 0u;
    for (;;) {
        sum = 0u; cnt = 0u; mine = 0u;
#pragma unroll
        for (unsigned j = 0; j < 16; ++j) { const unsigned c = xb_ld(&bar[XB_XCNT(j)]); sum += c; cnt += (c > 0u) ? 1u : 0u; mine = (j == x) ? c : mine; }
        if (sum == G) break;
        __builtin_amdgcn_s_sleep(1);
        if ((++sp & 255u) == 0u) { if (xb_ld(&bar[XB_TMO])) break; if (sp > XB_SPIN_CAP) { atomicAdd(&bar[XB_TMO], 1u); break; } }
    }
    nloc = mine > 0u ? mine : 1u; nx = cnt > 0u ? cnt : 1u;
}
__device__ __forceinline__ void xcd_barrier_arrive(const XcdBarrier& b) {
    asm volatile("s_waitcnt vmcnt(0)" ::: "memory");
    __syncthreads();
    if (threadIdx.x == 0) {
        unsigned* bar = b.bar;
        __builtin_amdgcn_s_waitcnt(0);
        unsigned nloc = b.st[0], nx = b.st[1];
        if (nloc == 0u) { xcd_barrier_complete(bar, b.x, nloc, nx); b.st[0] = nloc; b.st[1] = nx; }
        const unsigned old = xb_add(&bar[XB_XSUB(b.x)], 1u);
        const unsigned gen = old / nloc;
        if (old - gen * nloc == (nloc * 3u) >> 2) asm volatile("buffer_wbl2 sc1" ::: "memory");
        if (old + 1u == (gen + 1u) * nloc) {
            __builtin_amdgcn_fence(__ATOMIC_RELEASE, "agent");
            asm volatile("s_waitcnt vmcnt(0)" ::: "memory");
#pragma unroll
            for (unsigned j = 0; j < 16; ++j) (void)xb_add(&bar[XB_XGEN(j)], 1u);
        }
        b.st[3] = (gen + 1u) * nx;
    }
}
__device__ __forceinline__ void xcd_barrier_wait(const XcdBarrier& b) {
    if (threadIdx.x == 0) {
        unsigned* bar = b.bar;
        const unsigned target = b.st[3];
        XB_SPIN((int)(xb_ld(&bar[XB_XGEN(b.x)]) - target) < 0, bar);
        __builtin_amdgcn_fence(__ATOMIC_ACQUIRE, "agent");
        asm volatile("s_waitcnt vmcnt(0)" ::: "memory");
    }
    __syncthreads();
}

__device__ __forceinline__ void xcd_barrier(const XcdBarrier& b) { xcd_barrier_arrive(b); xcd_barrier_wait(b); }

typedef __attribute__((ext_vector_type(2))) float f32x2;
typedef __attribute__((ext_vector_type(2))) unsigned u32x2;
__device__ __forceinline__ float4 ldnt4(const float* p) { const f32x4 v = __builtin_nontemporal_load((const f32x4*)p); return make_float4(v[0], v[1], v[2], v[3]); }
__device__ __forceinline__ float ldnt1(const float* p) { return __builtin_nontemporal_load(p); }
__device__ __forceinline__ float2 ldnt2(const float* p) { const f32x2 v = __builtin_nontemporal_load((const f32x2*)p); return make_float2(v[0], v[1]); }
__device__ __forceinline__ void stnt2(void* p, unsigned a, unsigned b) { const u32x2 v = {a, b}; __builtin_nontemporal_store(v, (u32x2*)p); }
__device__ __forceinline__ void stnt1(void* p, unsigned a) { __builtin_nontemporal_store(a, (unsigned*)p); }
__device__ __forceinline__ void stnt4f(float* p, float a, float b, float c, float d) { const f32x4 v = {a, b, c, d}; __builtin_nontemporal_store(v, (f32x4*)p); }
__device__ __forceinline__ unsigned pack2(float lo, float hi) {
  typedef __attribute__((ext_vector_type(2))) float f2; typedef __attribute__((ext_vector_type(2))) __bf16 b2;
  f2 v = {lo, hi}; b2 r = __builtin_convertvector(v, b2); return __builtin_bit_cast(unsigned, r);
}
__device__ __forceinline__ u16 f2bf(float f) { return (u16)(pack2(f, 0.f) & 0xFFFFu); }
__device__ __forceinline__ float bflo(unsigned w) { return __uint_as_float(w << 16); }
__device__ __forceinline__ float bfhi(unsigned w) { return __uint_as_float(w & 0xFFFF0000u); }
__device__ __forceinline__ float gelu_exact(float x) {
  const float z = fabsf(x) * 0.70710678118654752f;
  const float t = __builtin_amdgcn_rcpf(fmaf(0.3275911f, z, 1.f));
  float p = fmaf(1.061405429f, t, -1.453152027f); p = fmaf(p, t, 1.421413741f); p = fmaf(p, t, -0.284496736f); p = fmaf(p, t, 0.254829592f);
  const float e = p * t * __expf(-z * z);
  const float erfz = 1.f - e;
  return 0.5f * x * (1.f + copysignf(erfz, x));
}
__device__ __forceinline__ float wave_sum(float v) {
  { auto r = __builtin_amdgcn_permlane32_swap(__float_as_uint(v), __float_as_uint(v), false, false); v = __uint_as_float(r[0]) + __uint_as_float(r[1]); }
  { auto r = __builtin_amdgcn_permlane16_swap(__float_as_uint(v), __float_as_uint(v), false, false); v = __uint_as_float(r[0]) + __uint_as_float(r[1]); }
  v += __uint_as_float(__builtin_amdgcn_update_dpp(__float_as_uint(v), __float_as_uint(v), 0x128, 0xf, 0xf, false));
  v += __uint_as_float(__builtin_amdgcn_update_dpp(__float_as_uint(v), __float_as_uint(v), 0x124, 0xf, 0xf, false));
  v += __uint_as_float(__builtin_amdgcn_update_dpp(__float_as_uint(v), __float_as_uint(v), 0x4E, 0xf, 0xf, false));
  v += __uint_as_float(__builtin_amdgcn_update_dpp(__float_as_uint(v), __float_as_uint(v), 0xB1, 0xf, 0xf, false));
  return v;
}
__device__ __forceinline__ int crow(int r, int hi) { return (r & 3) + 8 * (r >> 2) + 4 * hi; }
#define MFMA32(a, b, c) __builtin_amdgcn_mfma_f32_32x32x16_bf16((a), (b), (c), 0, 0, 0)

template <int MAP> __device__ __forceinline__ int colmap(int n) {
  if (MAP == 0) return n;
  if (MAP == 1) return n < 448 ? n : (n < 512 ? -1 : n - 64);
  if (MAP == 2) return (n >> 6) * 192 + 128 + (n & 63);
  return (n >> 7) * 256 + 128 + (n & 127);
}
template <int MAP> __device__ void cvt_transpose(const float* __restrict__ src, int src_ld, int K, int N, u16* __restrict__ dst, int gtid, int gthreads) {
  const int total = N * (K >> 3);
  for (int idx = gtid; idx < total; idx += gthreads) {
    const int n = idx % N, k8 = idx / N, sc = colmap<MAP>(n);
    float v[8];
#pragma unroll
    for (int j = 0; j < 8; ++j) v[j] = sc < 0 ? 0.f : src[(size_t)(k8 * 8 + j) * src_ld + sc];
    u32x4 w = {pack2(v[0], v[1]), pack2(v[2], v[3]), pack2(v[4], v[5]), pack2(v[6], v[7])};
    *(u32x4*)(dst + (size_t)n * K + k8 * 8) = w;
  }
}
template <int MAP> __device__ void cvt_transpose_tiled(const float* __restrict__ src, int src_ld, int K, int N, u16* __restrict__ dst, float* tile) {
  const int tid = threadIdx.x, tk = K >> 6, ntile = tk * (N >> 6);
  for (int t = blockIdx.x; t < ntile; t += gridDim.x) {
    const int k0 = (t % tk) * 64, n0 = (t / tk) * 64;
    __syncthreads();
    { const int nl = tid & 63, sc = colmap<MAP>(n0 + nl);
#pragma unroll
      for (int i = 0; i < 8; ++i) { const int k = (tid >> 6) + 8 * i; tile[k * 65 + nl] = sc < 0 ? 0.f : ldnt1(src + (size_t)(k0 + k) * src_ld + sc); } }
    __syncthreads();
    { const int n = tid >> 3, kk = tid & 7; float v[8];
#pragma unroll
      for (int j = 0; j < 8; ++j) v[j] = tile[(8 * kk + j) * 65 + n];
      u32x4 w = {pack2(v[0], v[1]), pack2(v[2], v[3]), pack2(v[4], v[5]), pack2(v[6], v[7])};
      *(u32x4*)(dst + (size_t)(n0 + n) * K + k0 + 8 * kk) = w; }
  }
}
__device__ void cvt_direct(const float* __restrict__ src, u16* __restrict__ dst, size_t n8, int gtid, int gthreads) {
  for (size_t i = gtid; i < n8; i += gthreads) {
    const float4 a = ldnt4(src + i * 8), b = ldnt4(src + i * 8 + 4);
    u32x4 w = {pack2(a.x, a.y), pack2(a.z, a.w), pack2(b.x, b.y), pack2(b.z, b.w)};
    *(u32x4*)(dst + i * 8) = w;
  }
}
constexpr float PEER_SU = 32.f, PEER_SV = 4.f;
typedef __attribute__((ext_vector_type(3))) unsigned u32x3;
typedef __attribute__((ext_vector_type(6))) unsigned u32x6;
typedef __attribute__((ext_vector_type(16))) unsigned u32x16;
typedef __attribute__((ext_vector_type(32))) __bf16 bf16x32;
template <int SC> __device__ __forceinline__ unsigned fp6_code(float v) {
  const float t = fabsf(v);
  float m = fminf(fminf((8.f * SC) * t, fmaf(4.f * SC, t, 8.f)), fmaf(2.f * SC, t, 16.f));
  m = fminf(m, 31.f);
  return (__float_as_uint(m + 8388608.f) & 31u) | ((__float_as_uint(v) >> 26) & 32u);
}
__device__ __forceinline__ unsigned fp6_codef(float v, float sc) {
  const float t = fabsf(v);
  float m = fminf(fminf((8.f * sc) * t, fmaf(4.f * sc, t, 8.f)), fmaf(2.f * sc, t, 16.f));
  m = fminf(m, 31.f);
  return (__float_as_uint(m + 8388608.f) & 31u) | ((__float_as_uint(v) >> 26) & 32u);
}
constexpr float P7_HS6 = 0.875f;
constexpr int PEER_SU6 = 48;
__device__ __forceinline__ void sincos_acc(float a, float& sn, float& cs) {
  const float q = __builtin_rintf(a * 0.636619772f);
  float r = __builtin_fmaf(-q, 1.57079601e+00f, a);
  r = __builtin_fmaf(-q, 3.13916473e-07f, r);
  r = __builtin_fmaf(-q, 5.39030253e-15f, r);
  const float r2 = r * r;
  float s = __builtin_fmaf(r2, 2.75573192e-06f, -1.98412698e-04f);
  s = __builtin_fmaf(s, r2, 8.33333333e-03f); s = __builtin_fmaf(s, r2, -1.66666667e-01f); s = __builtin_fmaf(r * r2, s, r);
  float c = __builtin_fmaf(r2, 2.48015873e-05f, -1.38888889e-03f);
  c = __builtin_fmaf(c, r2, 4.16666667e-02f); c = __builtin_fmaf(c, r2, -0.5f); c = __builtin_fmaf(c, r2, 1.f);
  const int n = ((int)q) & 3;
  const float ss = (n & 1) ? c : s, cc = (n & 1) ? s : c;
  sn = (n & 2) ? -ss : ss;
  cs = ((n + 1) & 2) ? -cc : cc;
}

__constant__ float INVF[32] = {1.000000000e+00f, 7.498942018e-01f, 5.623413324e-01f, 4.216965139e-01f, 3.162277639e-01f, 2.371373922e-01f, 1.778279394e-01f, 1.333521456e-01f,
  1.000000015e-01f, 7.498941571e-02f, 5.623412877e-02f, 4.216964915e-02f, 3.162277862e-02f, 2.371373586e-02f, 1.778279431e-02f, 1.333521493e-02f,
  9.999999776e-03f, 7.498942316e-03f, 5.623413250e-03f, 4.216964822e-03f, 3.162277862e-03f, 2.371373819e-03f, 1.778279431e-03f, 1.333521446e-03f,
  1.000000047e-03f, 7.498941850e-04f, 5.623413017e-04f, 4.216965463e-04f, 3.162277862e-04f, 2.371373848e-04f, 1.778279402e-04f, 1.333521504e-04f};
template <int PART> __device__ void phase0(const Args& a, char* lds) {
  unsigned char* ws = a.ws;
  const int tid = threadIdx.x, lane = tid & 63, wv = tid >> 6;
  const int NWV = gridDim.x * 8, gw = blockIdx.x * 8 + wv;
  const int gthreads = gridDim.x * 512, gtid = blockIdx.x * 512 + tid;
  if (PART == 0) {
  float* modp = (float*)(ws + WS_MODP);
  for (int job = wv * gridDim.x + blockIdx.x; job < 96 * ADA_KS; job += NWV) {
    const int cg = job % 96, ks = job / 96, col = cg * 64 + lane;
    float a0 = 0.f, a1 = 0.f, a2 = 0.f, a3 = 0.f;
    const float* w = a.w_ada + (size_t)(ks * 64) * 6144 + col;
    float sv[4];
#pragma unroll
    for (int bb = 0; bb < 4; ++bb) { const float cv = a.c[bb * 1024 + ks * 64 + lane]; sv[bb] = cv / (1.f + __expf(-cv)); }
#pragma unroll 32
    for (int k = 0; k < 64; ++k) {
      const float wv_ = ldnt1(w + (size_t)k * 6144);
      a0 += __uint_as_float(__builtin_amdgcn_readlane(__float_as_uint(sv[0]), k)) * wv_;
      a1 += __uint_as_float(__builtin_amdgcn_readlane(__float_as_uint(sv[1]), k)) * wv_;
      a2 += __uint_as_float(__builtin_amdgcn_readlane(__float_as_uint(sv[2]), k)) * wv_;
      a3 += __uint_as_float(__builtin_amdgcn_readlane(__float_as_uint(sv[3]), k)) * wv_;
    }
    modp[(ks * 4 + 0) * 6144 + col] = a0; modp[(ks * 4 + 1) * 6144 + col] = a1;
    modp[(ks * 4 + 2) * 6144 + col] = a2; modp[(ks * 4 + 3) * 6144 + col] = a3;
  }
  }
  if (PART == 0) return;
  { float* tile = (float*)(lds + LDS_DATA);
    if (PART == 1) cvt_transpose_tiled<1>(a.w_in, 1472, 1024, 1536, (u16*)(ws + WS_WIN), tile);
    if (PART == 3) cvt_transpose_tiled<0>(a.w_o, 1024, 1024, 1024, (u16*)(ws + WS_WO), tile);
    if (PART == 2) cvt_transpose_tiled<2>(a.w_uq, 768, 256, 256, (u16*)(ws + WS_WQ2) + 512 * 256, tile);
    if (PART == 2) cvt_transpose_tiled<3>(a.w_ukv, 1024, 128, 512, (u16*)(ws + WS_WUV), tile);
    __syncthreads(); }
  if (PART == 2) {
    u16* wq2 = (u16*)(ws + WS_WQ2);
    float* At = (float*)(lds + LDS_DATA); float* Bt = At + 16 * 129;
    for (int job = blockIdx.x; job < 256; job += gridDim.x) {
      const int h = job >> 6, cb = (job >> 3) & 7, ib = job & 7;
      __syncthreads();
      { const int row = tid >> 5, c4 = tid & 31;
        const float4 av = *(const float4*)(a.w_ukv + (size_t)(cb * 16 + row) * 1024 + h * 256 + 4 * c4);
        const float4 b0 = *(const float4*)(a.w_uq + (size_t)(ib * 32 + row) * 768 + h * 192 + 4 * c4);
        const float4 b1 = *(const float4*)(a.w_uq + (size_t)(ib * 32 + 16 + row) * 768 + h * 192 + 4 * c4);
        float* pa = At + row * 129 + 4 * c4; pa[0] = av.x; pa[1] = av.y; pa[2] = av.z; pa[3] = av.w;
        float* p0 = Bt + row * 129 + 4 * c4; p0[0] = b0.x; p0[1] = b0.y; p0[2] = b0.z; p0[3] = b0.w;
        float* p1 = Bt + (16 + row) * 129 + 4 * c4; p1[0] = b1.x; p1[1] = b1.y; p1[2] = b1.z; p1[3] = b1.w; }
      __syncthreads();
      { const int cl = tid >> 5, il = tid & 31;
        const float* pa = At + cl * 129; const float* pb = Bt + il * 129;
        float s0 = 0.f, s1 = 0.f, s2 = 0.f, s3 = 0.f;
#pragma unroll 8
        for (int d = 0; d < 128; d += 4) { s0 += pa[d] * pb[d]; s1 += pa[d + 1] * pb[d + 1]; s2 += pa[d + 2] * pb[d + 2]; s3 += pa[d + 3] * pb[d + 3]; }
        wq2[(size_t)(h * 128 + cb * 16 + cl) * 256 + ib * 32 + il] = f2bf((s0 + s1) + (s2 + s3)); }
    }
    __syncthreads();
  }
  if (PART == 3) cvt_direct(a.peer_keys, (u16*)(ws + WS_KEYS), 262144 / 8, gtid, gthreads);
  if (PART == 3) cvt_direct(a.w_peer_q, (u16*)(ws + WS_WPQ), (size_t)1024 * 2048 / 8, gtid, gthreads);
  if (PART == 2) cvt_direct(a.w_sg, (u16*)(ws + WS_WSG), 65536 / 8, gtid, gthreads);
  if (PART == 1) {
    float* cs = (float*)(ws + WS_CS);
    for (int idx = gtid; idx < T * 32; idx += gthreads) {
      const int t = idx >> 5, i = idx & 31;
      const float inv = INVF[i];
      const float ang = (float)a.pos[t] * inv;
      float sn, c_; sincos_acc(ang, sn, c_);
      cs[(size_t)t * 64 + i] = c_; cs[(size_t)t * 64 + 32 + i] = sn;
    }
  }
}

__device__ void phase1(const Args& a, char* lds) {
  unsigned char* ws = a.ws;
  const int tid = threadIdx.x, lane = tid & 63, wv = tid >> 6;
  const float* modp = (const float*)(ws + WS_MODP);
  float* mod = (float*)(ws + WS_MOD);
  for (int idx = blockIdx.x * 512 + tid; idx < 4 * 6144; idx += gridDim.x * 512) {
    const int b = idx / 6144, m = idx % 6144;
    float s = a.b_ada[m];
#pragma unroll
    for (int ks = 0; ks < ADA_KS; ++ks) s += modp[(ks * 4 + b) * 6144 + m];
    mod[idx] = s;
  }
  float* sh = (float*)(lds + LDS_DATA);
  u16* H = (u16*)(ws + WS_H);
  for (int u = blockIdx.x; u < T / 64; u += gridDim.x) {
    const int b = u >> 6;
    __syncthreads();
    for (int j = tid; j < 2048; j += 512) {
      float s = a.b_ada[j];
#pragma unroll
      for (int ks = 0; ks < ADA_KS; ++ks) s += modp[(ks * 4 + b) * 6144 + j];
      sh[j] = s;
    }
    __syncthreads();
    for (int i0 = 0; i0 < 8; i0 += 4) {
      float4 xv[4][4];
#pragma unroll
      for (int i = 0; i < 4; ++i)
#pragma unroll
        for (int j = 0; j < 4; ++j) xv[i][j] = ldnt4(a.x + (size_t)(u * 64 + wv * 8 + i0 + i) * 1024 + j * 256 + lane * 4);
#pragma unroll
      for (int i = 0; i < 4; ++i) {
        const int r = u * 64 + wv * 8 + i0 + i;
        float ssq = 0.f;
#pragma unroll
        for (int j = 0; j < 4; ++j) ssq += xv[i][j].x * xv[i][j].x + xv[i][j].y * xv[i][j].y + xv[i][j].z * xv[i][j].z + xv[i][j].w * xv[i][j].w;
        ssq = wave_sum(ssq);
        const float rstd = rsqrtf(ssq * (1.f / 1024.f) + EPS);
#pragma unroll
        for (int j = 0; j < 4; ++j) {
          const int col = j * 256 + lane * 4;
          const float4 g = *(const float4*)(a.g_norm1 + col);
          const float h0 = xv[i][j].x * rstd * g.x * (1.f + sh[1024 + col]) + sh[col];
          const float h1 = xv[i][j].y * rstd * g.y * (1.f + sh[1024 + col + 1]) + sh[col + 1];
          const float h2 = xv[i][j].z * rstd * g.z * (1.f + sh[1024 + col + 2]) + sh[col + 2];
          const float h3 = xv[i][j].w * rstd * g.w * (1.f + sh[1024 + col + 3]) + sh[col + 3];
          uint2 o = {pack2(h0, h1), pack2(h2, h3)};
          stnt2(H + (size_t)r * 1024 + col, o.x, o.y);
        }
      }
    }
  }
}

constexpr int G_STAGE = 49152;
__device__ __forceinline__ void dma16(const void* gsrc, unsigned lds_dst) {
  unsigned keep;
  asm volatile("s_mov_b32 %0, m0\n\ts_mov_b32 m0, %2\n\ts_nop 0\n\tglobal_load_lds_dwordx4 %1, off\n\ts_mov_b32 m0, %0"
               : "=&s"(keep) : "v"(gsrc), "s"(lds_dst) : "memory");
}
__device__ __forceinline__ void gemm_128x256(const u16* __restrict__ A, int lda, const u16* __restrict__ Bt, int ldb, int KT,
                                             f32x16 (&acc)[2][2], char* lds) {
  const int tid = threadIdx.x, lane = tid & 63, wv = __builtin_amdgcn_readfirstlane(tid >> 6), r32 = lane & 31, hi = lane >> 5;
  const int wm = wv >> 2, wn = wv & 3;
  const int rin = lane >> 3, cc = lane & 7;
  const u16* pa[2]; const u16* pb[4];
#pragma unroll
  for (int j = 0; j < 2; ++j) pa[j] = A + (size_t)(16 * wv + 8 * j + rin) * lda + 8 * (cc ^ (4 * j + (rin >> 1)));
#pragma unroll
  for (int i = 0; i < 4; ++i) pb[i] = Bt + (size_t)(32 * wv + 8 * i + rin) * ldb + 8 * (cc ^ (4 * (i & 1) + (rin >> 1)));
  const unsigned lb = __builtin_amdgcn_readfirstlane((unsigned)(uintptr_t)lds);
  const unsigned dA = lb + 2048 * wv, dB = lb + 16384 + 4096 * wv;
#define G_ISSUE(stage, kt_) do { const unsigned _so = (unsigned)(stage) * G_STAGE; const int _ko = (kt_) * 64;                     \
    dma16(pa[0] + _ko, dA + _so); dma16(pa[1] + _ko, dA + _so + 1024);                                                           \
    dma16(pb[0] + _ko, dB + _so); dma16(pb[1] + _ko, dB + _so + 1024); dma16(pb[2] + _ko, dB + _so + 2048); dma16(pb[3] + _ko, dB + _so + 3072); } while (0)
#pragma unroll
  for (int m = 0; m < 2; ++m)
#pragma unroll
    for (int n = 0; n < 2; ++n)
#pragma unroll
      for (int r = 0; r < 16; ++r) acc[m][n][r] = 0.f;
  __syncthreads();
  G_ISSUE(0, 0);
  if (KT > 1) G_ISSUE(1, 1);
  const int xa = (r32 >> 1) & 7;
  const int aoff = (64 * wm + r32) * 128, boff = 16384 + (64 * wn + r32) * 128;
  int st = 0;
  for (int kt = 0; kt < KT; ++kt) {
    if (kt + 1 < KT) asm volatile("s_waitcnt vmcnt(6)\n\ts_barrier" ::: "memory");
    else             asm volatile("s_waitcnt vmcnt(0)\n\ts_barrier" ::: "memory");
    const int s2 = st == 0 ? 2 : st - 1;
    if (kt + 2 < KT && wv < 4) G_ISSUE(s2, kt + 2);
    const char* buf = lds + st * G_STAGE;
    __builtin_amdgcn_s_setprio(1);
    bf16x8 fa[2][2], fb[2][2];
#define G_LDF(S, SET) do { const int _cb = ((2 * (S) + hi) ^ xa) << 4;                                                      \
      fa[SET][0] = *(const bf16x8*)(buf + aoff + _cb); fa[SET][1] = *(const bf16x8*)(buf + aoff + 4096 + _cb);              \
      fb[SET][0] = *(const bf16x8*)(buf + boff + _cb); fb[SET][1] = *(const bf16x8*)(buf + boff + 4096 + _cb); } while (0)
#define G_MM(SET) do { acc[0][0] = MFMA32(fa[SET][0], fb[SET][0], acc[0][0]); acc[0][1] = MFMA32(fa[SET][0], fb[SET][1], acc[0][1]);   \
      acc[1][0] = MFMA32(fa[SET][1], fb[SET][0], acc[1][0]); acc[1][1] = MFMA32(fa[SET][1], fb[SET][1], acc[1][1]); } while (0)
    G_LDF(0, 0); __builtin_amdgcn_sched_barrier(0);
    G_LDF(1, 1); __builtin_amdgcn_sched_barrier(0); G_MM(0); __builtin_amdgcn_sched_barrier(0);
    G_LDF(2, 0); __builtin_amdgcn_sched_barrier(0); G_MM(1); __builtin_amdgcn_sched_barrier(0);
    G_LDF(3, 1); __builtin_amdgcn_sched_barrier(0); G_MM(0); __builtin_amdgcn_sched_barrier(0);
    G_MM(1);
#undef G_LDF
#undef G_MM
    __builtin_amdgcn_s_setprio(0);
    if (kt + 2 < KT && wv >= 4) G_ISSUE(s2, kt + 2);
    st = st == 2 ? 0 : st + 1;
  }
#undef G_ISSUE
  __syncthreads();
}
constexpr int CLD = 257;
__device__ __forceinline__ void acc_to_lds(const f32x16 (&acc)[2][2], float* Cl) {
  const int lane = threadIdx.x & 63, wv = threadIdx.x >> 6, r32 = lane & 31, hi = lane >> 5, wm = wv >> 2, wn = wv & 3;
#pragma unroll
  for (int m = 0; m < 2; ++m)
#pragma unroll
    for (int n = 0; n < 2; ++n)
#pragma unroll
      for (int r = 0; r < 16; ++r) Cl[(64 * wm + 32 * m + crow(r, hi)) * CLD + 64 * wn + 32 * n + r32] = acc[m][n][r];
}

constexpr int G2_STAGE = 65536;
__device__ __forceinline__ void gemm_256x256_wide(const u16* __restrict__ A, int lda, const u16* __restrict__ Bt, int ldb, int KT, f32x16 (&acc)[8], char* lds) {
  const int tid = threadIdx.x, lane = tid & 63, wv = __builtin_amdgcn_readfirstlane(tid >> 6), r32 = lane & 31, hi = lane >> 5;
  const int rin = lane >> 3, cc = lane & 7;
  const u16* pa[4]; const u16* pb[4];
#pragma unroll
  for (int i = 0; i < 4; ++i) {
    pa[i] = A + (size_t)(32 * wv + 8 * i + rin) * lda + 8 * (cc ^ (4 * (i & 1) + (rin >> 1)));
    pb[i] = Bt + (size_t)(32 * wv + 8 * i + rin) * ldb + 8 * (cc ^ (4 * (i & 1) + (rin >> 1)));
  }
  const unsigned lb = __builtin_amdgcn_readfirstlane((unsigned)(uintptr_t)lds);
  const unsigned dA = lb + 4096 * wv, dB = lb + 32768 + 4096 * wv;
#define G_ISSUE(stage, kt_) do { const unsigned _so = (unsigned)(stage) * G2_STAGE; const int _ko = (kt_) * 64;                    \
    dma16(pa[0] + _ko, dA + _so); dma16(pa[1] + _ko, dA + _so + 1024); dma16(pa[2] + _ko, dA + _so + 2048); dma16(pa[3] + _ko, dA + _so + 3072);   \
    dma16(pb[0] + _ko, dB + _so); dma16(pb[1] + _ko, dB + _so + 1024); dma16(pb[2] + _ko, dB + _so + 2048); dma16(pb[3] + _ko, dB + _so + 3072); } while (0)
#pragma unroll
  for (int m = 0; m < 8; ++m)
#pragma unroll
    for (int r = 0; r < 16; ++r) acc[m][r] = 0.f;
  __syncthreads();
  G_ISSUE(0, 0);
  const int xa = (r32 >> 1) & 7;
  const int aoff = r32 * 128, boff = 32768 + (32 * wv + r32) * 128;
  for (int kt = 0; kt < KT; ++kt) {
    asm volatile("s_waitcnt vmcnt(0)\n\ts_barrier" ::: "memory");
    if (kt + 1 < KT) G_ISSUE((kt + 1) & 1, kt + 1);
    const char* buf = lds + (kt & 1) * G2_STAGE;
    __builtin_amdgcn_s_setprio(1);
    bf16x8 fa[8], fb[4];
#pragma unroll
    for (int s = 0; s < 4; ++s) fb[s] = *(const bf16x8*)(buf + boff + (((2 * s + hi) ^ xa) << 4));
    { const int cb0 = (hi ^ xa) << 4;
#pragma unroll
      for (int m = 0; m < 8; ++m) fa[m] = *(const bf16x8*)(buf + aoff + 4096 * m + cb0); }
#pragma unroll
    for (int s = 0; s < 4; ++s) {
      const int cbn = ((2 * (s + 1) + hi) ^ xa) << 4;
#pragma unroll
      for (int m = 0; m < 8; ++m) { acc[m] = MFMA32(fa[m], fb[s], acc[m]); if (s < 3) fa[m] = *(const bf16x8*)(buf + aoff + 4096 * m + cbn); }
    }
    __builtin_amdgcn_s_setprio(0);
  }
#undef G_ISSUE
  __syncthreads();
}


constexpr int G3_STAGE = 32768;
template <bool ILV> __device__ __forceinline__ void gemm_256x256(const u16* __restrict__ A, int lda, const u16* __restrict__ Bt, int ldb, int KT, f32x16 (&acc)[4][2], char* lds) {
  int tid_ = threadIdx.x; asm volatile("" : "+v"(tid_));
  const int tid = tid_, lane = tid & 63, wv = __builtin_amdgcn_readfirstlane(tid >> 6), r32 = lane & 31, hi = lane >> 5;
  const int wm = wv >> 2, wn = wv & 3;
  const int prow = lane >> 2, pc = lane & 3;
  const u16* pa[2]; const u16* pb[2];
#pragma unroll
  for (int j = 0; j < 2; ++j) {
    pa[j] = A + (size_t)(32 * wv + 16 * j + prow) * lda + 8 * (pc ^ ((prow >> 2) & 3));
    pb[j] = Bt + (size_t)(32 * wv + 16 * j + prow) * ldb + 8 * (pc ^ ((prow >> 2) & 3));
  }
  const unsigned lb = __builtin_amdgcn_readfirstlane((unsigned)(uintptr_t)lds);
  const unsigned dA = lb + 2048 * wv, dB = lb + 16384 + 2048 * wv;
#define G_ISSUE(stage, kt_) do { const unsigned _so = (unsigned)(stage) * G3_STAGE; const int _ko = (kt_) * 32;                    \
    dma16(pa[0] + _ko, dA + _so); dma16(pa[1] + _ko, dA + _so + 1024); dma16(pb[0] + _ko, dB + _so); dma16(pb[1] + _ko, dB + _so + 1024); } while (0)
#pragma unroll
  for (int m = 0; m < 4; ++m)
#pragma unroll
    for (int n = 0; n < 2; ++n)
#pragma unroll
      for (int r = 0; r < 16; ++r) acc[m][n][r] = 0.f;
  __syncthreads();
  G_ISSUE(0, 0);
  if (KT > 1) G_ISSUE(1, 1);
  if (KT > 2) G_ISSUE(2, 2);
  const int xa = (r32 >> 2) & 3;
  const int aoff = ((ILV ? 32 : 128) * wm + r32) * 64, boff = 16384 + (64 * wn + r32) * 64;
  constexpr int AMS = ILV ? 4096 : 2048;
  const int c0 = (hi ^ xa) << 4, c1 = ((2 + hi) ^ xa) << 4;
  for (int kt = 0; kt < KT; ++kt) {
    if (kt + 2 < KT)      asm volatile("s_waitcnt vmcnt(8)\n\ts_barrier" ::: "memory");
    else if (kt + 1 < KT) asm volatile("s_waitcnt vmcnt(4)\n\ts_barrier" ::: "memory");
    else                  asm volatile("s_waitcnt vmcnt(0)\n\ts_barrier" ::: "memory");
    if (kt + 3 < KT && wv < 4) G_ISSUE((kt + 3) & 3, kt + 3);
    const char* buf = lds + (kt & 3) * G3_STAGE;
    __builtin_amdgcn_s_setprio(1);
    bf16x8 fa0[4], fb0[2], fa1[4], fb1[2];
#pragma unroll
    for (int m = 0; m < 4; ++m) fa0[m] = *(const bf16x8*)(buf + aoff + AMS * m + c0);
#pragma unroll
    for (int n = 0; n < 2; ++n) fb0[n] = *(const bf16x8*)(buf + boff + 2048 * n + c0);
    __builtin_amdgcn_sched_barrier(0);
#pragma unroll
    for (int m = 0; m < 4; ++m) fa1[m] = *(const bf16x8*)(buf + aoff + AMS * m + c1);
#pragma unroll
    for (int n = 0; n < 2; ++n) fb1[n] = *(const bf16x8*)(buf + boff + 2048 * n + c1);
    __builtin_amdgcn_sched_barrier(0);
#pragma unroll
    for (int m = 0; m < 4; ++m)
#pragma unroll
      for (int n = 0; n < 2; ++n) acc[m][n] = MFMA32(fa0[m], fb0[n], acc[m][n]);
    __builtin_amdgcn_sched_barrier(0);
#pragma unroll
    for (int m = 0; m < 4; ++m)
#pragma unroll
      for (int n = 0; n < 2; ++n) acc[m][n] = MFMA32(fa1[m], fb1[n], acc[m][n]);
    __builtin_amdgcn_s_setprio(0);
    if (kt + 3 < KT && wv >= 4) G_ISSUE((kt + 3) & 3, kt + 3);
  }
#undef G_ISSUE
  __syncthreads();
}
template <int HALF> __device__ __forceinline__ void acc_to_lds_half(const f32x16 (&acc)[4][2], float* Cl) {
  const int lane = threadIdx.x & 63, wv = threadIdx.x >> 6, r32 = lane & 31, hi = lane >> 5, wm = wv >> 2, wn = wv & 3;
#pragma unroll
  for (int mm = 0; mm < 2; ++mm)
#pragma unroll
    for (int n = 0; n < 2; ++n)
#pragma unroll
      for (int r = 0; r < 16; ++r) Cl[(64 * mm + 32 * wm + crow(r, hi)) * CLD + 64 * wn + 32 * n + r32] = acc[2 * HALF + mm][n][r];
}

__device__ __forceinline__ void xcd_unit(int u, int per, int& panel, int& sub) {
  if (gridDim.x == 256) { const int x = u & 7, k = ((u & 255) >> 3) + 32 * (u >> 8); panel = x + 8 * (k / per); sub = k % per; }
  else { panel = u / per; sub = u % per; }
}
__device__ void phase1b(const Args& a, char* lds) {
  unsigned char* ws = a.ws;
  const int tid = threadIdx.x, lane = tid & 63, wv = tid >> 6;
  const u16* KEYS = (const u16*)(ws + WS_KEYS); const u16* WPQB = (const u16*)(ws + WS_WPQ); u16* WST = (u16*)(ws + WS_WST);
  const float* modp = (const float*)(ws + WS_MODP); float* BIASP = (float*)(ws + WS_BIASP);
  char* gl = lds + LDS_DATA; float* Cl = (float*)gl;
  float* gsl = (float*)(gl + 131584);
  for (int u = blockIdx.x; u < 256; u += gridDim.x) {
    const int hh = u >> 4, nt = (u >> 2) & 3, b = u & 3;
    f32x16 acc[2][2];
    gemm_128x256(KEYS + (size_t)hh * 16384, 128, WPQB + (size_t)(nt * 256) * 2048 + hh * 128, 2048, 2, acc, gl);
    acc_to_lds(acc, Cl);
    for (int j = tid; j < 512; j += 512) {
      const int which = j >> 8, k = nt * 256 + (j & 255), m = (which ? 3072 : 4096) + k;
      float v = a.b_ada[m];
#pragma unroll
      for (int ks = 0; ks < ADA_KS; ++ks) v += modp[(ks * 4 + b) * 6144 + m];
      gsl[j] = which ? v : a.g_norm2[k] * (1.f + v);
    }
    __syncthreads();
    for (int i = 0; i < 16; ++i) {
      const int row = wv * 16 + i; const size_t n = (size_t)hh * 128 + row;
      float bp = 0.f, w[4];
#pragma unroll
      for (int j = 0; j < 4; ++j) { const float v = Cl[row * CLD + 4 * lane + j]; w[j] = v * gsl[4 * lane + j]; bp += v * gsl[256 + 4 * lane + j]; }
      *(uint2*)(WST + ((size_t)b * 2048 + n) * 1024 + nt * 256 + 4 * lane) = make_uint2(pack2(w[0], w[1]), pack2(w[2], w[3]));
      bp = wave_sum(bp);
      if (lane == 0) BIASP[((size_t)nt * 4 + b) * 2048 + n] = bp;
    }
    __syncthreads();
  }
}

__device__ void phase2(const Args& a, char* lds) {
  unsigned char* ws = a.ws;
  const int tid = threadIdx.x, lane = tid & 63, wv = tid >> 6;
  const u16* H = (const u16*)(ws + WS_H); const u16* WIN = (const u16*)(ws + WS_WIN);
  u16* QA = (u16*)(ws + WS_QA); u16* KV = (u16*)(ws + WS_KV); u16* UACT = (u16*)(ws + WS_UACT); u16* GVT = (u16*)(ws + WS_GVT);
  float* SSQV = (float*)(ws + WS_SSQV); const float* CS = (const float*)(ws + WS_CS);
  char* gl = lds + LDS_DATA; float* Cl = (float*)gl;
  for (int u = blockIdx.x; u < 128 * 6; u += gridDim.x) {
    int mt, nt; xcd_unit(u, 6, mt, nt); const int R0 = mt * 128;
    f32x16 acc[2][2];
    gemm_128x256(H + (size_t)R0 * 1024, 1024, WIN + (size_t)(nt * 256) * 1024, 1024, 16, acc, gl);
    acc_to_lds(acc, Cl);
    __syncthreads();
    if (nt == 0) {
      for (int i = 0; i < 16; ++i) {
        const int row = wv * 16 + i; float v[4], ssq = 0.f;
#pragma unroll
        for (int j = 0; j < 4; ++j) { v[j] = Cl[row * CLD + lane + 64 * j]; ssq += v[j] * v[j]; }
        ssq = wave_sum(ssq);
        const float rstd = rsqrtf(ssq * (1.f / 256.f) + EPS);
#pragma unroll
        for (int j = 0; j < 4; ++j) { const int col = lane + 64 * j; QA[(size_t)(R0 + row) * 256 + col] = f2bf(v[j] * rstd * a.g_q_a[col]); }
      }
    } else if (nt == 1) {
#pragma unroll 4
      for (int i = 0; i < 16; ++i) {
        const int row = wv * 16 + i, tok = R0 + row;
        const float v0 = Cl[row * CLD + lane], v1 = Cl[row * CLD + 64 + lane];
        const float ssq = wave_sum(v0 * v0 + v1 * v1);
        const float rstd = rsqrtf(ssq * (1.f / 128.f) + EPS);
        KV[(size_t)tok * 192 + lane] = f2bf(v0 * rstd * a.g_kv_a[lane]);
        KV[(size_t)tok * 192 + 64 + lane] = f2bf(v1 * rstd * a.g_kv_a[64 + lane]);
        if (lane < 32) {
          const float x1 = Cl[row * CLD + 128 + lane], x2 = Cl[row * CLD + 160 + lane];
          const float cs = CS[(size_t)tok * 64 + lane], sn = CS[(size_t)tok * 64 + 32 + lane];
          KV[(size_t)tok * 192 + 128 + lane] = f2bf(x1 * cs - x2 * sn);
          KV[(size_t)tok * 192 + 160 + lane] = f2bf(x2 * cs + x1 * sn);
        }
      }
    } else if (nt < 4) {
      for (int i = 0; i < 16; ++i) {
        const int row = wv * 16 + i;
#pragma unroll
        for (int j = 0; j < 4; ++j) { const int col = lane + 64 * j; UACT[(size_t)(R0 + row) * 512 + (nt - 2) * 256 + col] = f2bf(gelu_exact(Cl[row * CLD + col])); }
      }
    } else {
      for (int i = 0; i < 16; ++i) {
        const int row = wv * 16 + i; float ssq = 0.f;
#pragma unroll
        for (int j = 0; j < 4; ++j) { const int col = lane + 64 * j; const float g = gelu_exact(Cl[row * CLD + col]); const float gb = bflo((unsigned)f2bf(g)); ssq += gb * gb; Cl[row * CLD + col] = gb; }
        ssq = wave_sum(ssq);
        if (lane == 0) SSQV[(size_t)(R0 + row) * 2 + (nt - 4)] = ssq;
      }
      __syncthreads();
      for (int i = 0; i < 32; ++i) {
        const int c = wv * 32 + i;
        const float g0 = Cl[(2 * lane) * CLD + c], g1 = Cl[(2 * lane + 1) * CLD + c];
        *(unsigned*)(GVT + ((size_t)mt * 512 + (nt - 4) * 256 + c) * 128 + 2 * lane) = pack2(g0, g1);
      }
    }
    __syncthreads();
  }
}

template <int PART> __device__ void phase3(const Args& a, char* lds) {
  unsigned char* ws = a.ws;
  const int tid = threadIdx.x, lane = tid & 63, wv = tid >> 6, r32 = lane & 31, hi = lane >> 5;
  const u16* QA = (const u16*)(ws + WS_QA); const u16* WQ2 = (const u16*)(ws + WS_WQ2);
  u16* Q = (u16*)(ws + WS_Q); const float* CS = (const float*)(ws + WS_CS);
  const u16* UACT = (const u16*)(ws + WS_UACT); const u16* GVT = (const u16*)(ws + WS_GVT); const u16* WSG = (const u16*)(ws + WS_WSG);
  const float* SSQV = (const float*)(ws + WS_SSQV); u16* Y = (u16*)(ws + WS_Y);
  char* gl = lds + LDS_DATA; float* Cl = (float*)gl;
  if (PART == 0)
  for (int u = blockIdx.x; u < 384; u += gridDim.x) {
    {
      int mt, nt; xcd_unit(u, 3, mt, nt); const int R0 = mt * 128;
      f32x16 acc[2][2];
      gemm_128x256(QA + (size_t)R0 * 256, 256, WQ2 + (size_t)(nt * 256) * 256, 256, 4, acc, gl);
      acc_to_lds(acc, Cl);
      __syncthreads();
      if (nt < 2) {
        for (int i = 0; i < 16; ++i) {
          const int row = wv * 16 + i;
#pragma unroll
          for (int j = 0; j < 4; ++j) { const int n = nt * 256 + lane + 64 * j; Q[(size_t)(R0 + row) * 768 + (n >> 7) * 192 + (n & 127)] = f2bf(Cl[row * CLD + lane + 64 * j]); }
        }
      } else {
#pragma unroll 4
        for (int i = 0; i < 16; ++i) {
          const int row = wv * 16 + i, tok = R0 + row;
#pragma unroll
          for (int j = 0; j < 2; ++j) {
            const int idx = lane + 64 * j, h = idx >> 5, jj = idx & 31;
            const float x1 = Cl[row * CLD + h * 64 + jj], x2 = Cl[row * CLD + h * 64 + 32 + jj];
            const float cs = CS[(size_t)tok * 64 + jj], sn = CS[(size_t)tok * 64 + 32 + jj];
            Q[(size_t)tok * 768 + h * 192 + 128 + jj] = f2bf(x1 * cs - x2 * sn);
            Q[(size_t)tok * 768 + h * 192 + 160 + jj] = f2bf(x2 * cs + x1 * sn);
          }
        }
      }
      __syncthreads();
    }
  }
  if (PART == 1)
  for (int su = blockIdx.x; su < 256; su += gridDim.x) {
    {
      const int c = su >> 1, ph = su & 1;
      float* rs = (float*)gl;
      float* Yl = (float*)(gl + 512);
      __syncthreads();
      if (tid < 128) { const size_t t = (size_t)c * 128 + tid; rs[tid] = rsqrtf((SSQV[t * 2] + SSQV[t * 2 + 1]) * (1.f / 512.f) + EPS); }
      __syncthreads();
      const int h = wv >> 1, dh = wv & 1;
      f32x16 acc[2][2];
#pragma unroll
      for (int m = 0; m < 2; ++m)
#pragma unroll
        for (int n = 0; n < 2; ++n)
#pragma unroll
          for (int r = 0; r < 16; ++r) acc[m][n][r] = 0.f;
#pragma unroll
      for (int sb = 0; sb < 8; sb += 4) {
        u32x4 afw[4][2], bw[4][2];
#pragma unroll
        for (int s = 0; s < 4; ++s) {
          const int q0 = 16 * (sb + s) + 8 * hi;
#pragma unroll
          for (int m = 0; m < 2; ++m) afw[s][m] = *(const u32x4*)(WSG + ((size_t)h * 128 + ph * 64 + 32 * m + r32) * 128 + q0);
#pragma unroll
          for (int n = 0; n < 2; ++n) bw[s][n] = *(const u32x4*)(GVT + ((size_t)c * 512 + h * 128 + dh * 64 + 32 * n + r32) * 128 + q0);
        }
        __builtin_amdgcn_sched_barrier(0);
#pragma unroll
        for (int s = 0; s < 4; ++s) {
          const int q0 = 16 * (sb + s) + 8 * hi;
          bf16x8 bfr[2];
          float rq[8];
#pragma unroll
          for (int j = 0; j < 8; ++j) rq[j] = rs[q0 + j];
#pragma unroll
          for (int n = 0; n < 2; ++n) {
            const u32x4 w = bw[s][n];
            u32x4 o;
#pragma unroll
            for (int k = 0; k < 4; ++k) o[k] = pack2(bflo(w[k]) * rq[2 * k], bfhi(w[k]) * rq[2 * k + 1]);
            bfr[n] = __builtin_bit_cast(bf16x8, o);
          }
#pragma unroll
          for (int m = 0; m < 2; ++m)
#pragma unroll
            for (int n = 0; n < 2; ++n) acc[m][n] = MFMA32(__builtin_bit_cast(bf16x8, afw[s][m]), bfr[n], acc[m][n]);
        }
        __builtin_amdgcn_sched_barrier(0);
      }
      { float gs[2];
#pragma unroll
        for (int n = 0; n < 2; ++n) gs[n] = a.g_sg[h * 128 + dh * 64 + 32 * n + r32];
#pragma unroll
        for (int m = 0; m < 2; ++m)
#pragma unroll
          for (int n = 0; n < 2; ++n)
#pragma unroll
            for (int r = 0; r < 16; ++r) {
              const int pl = 32 * m + crow(r, hi), col = h * 128 + dh * 64 + 32 * n + r32;
              Yl[pl * 513 + col] = acc[m][n][r] * gs[n] + a.b_sg[h * 128 + ph * 64 + pl];
            } }
      __syncthreads();
      for (int i = 0; i < 8; ++i) {
        const int pl = wv * 8 + i; const size_t tok = (size_t)c * 128 + ph * 64 + pl;
        float v[8], ssq = 0.f;
#pragma unroll
        for (int j = 0; j < 8; ++j) { v[j] = Yl[pl * 513 + lane + 64 * j] * bflo((unsigned)UACT[tok * 512 + lane + 64 * j]); ssq += v[j] * v[j]; }
        ssq = wave_sum(ssq);
        const float rstd = rsqrtf(ssq * (1.f / 512.f) + EPS);
#pragma unroll
        for (int j = 0; j < 8; ++j) { const int col = lane + 64 * j; Y[tok * 1024 + 512 + col] = f2bf(v[j] * rstd * a.g_sg_out[col]); }
      }
      __syncthreads();
    }
  }
}

constexpr float ATT_SCALE = 0.07216878364870322f;
constexpr float ATT_THR = 8.f;
constexpr int KVBUF = 24576;
#define SBAR() __builtin_amdgcn_sched_barrier(0)
__device__ __forceinline__ unsigned cvtpk(float lo, float hi) { unsigned r; asm volatile("v_cvt_pk_bf16_f32 %0, %1, %2" : "=v"(r) : "v"(lo), "v"(hi)); return r; }
__device__ __forceinline__ unsigned off_a(unsigned row, unsigned ch) { return 2048u * (row >> 3) + 512u * (ch >> 2) + 64u * (row & 7) + 16u * ((ch & 3) ^ ((row >> 2) & 3)); }

__device__ __forceinline__ void partialSM(f32x16& p0, f32x16& p1, float& m_reg, float& mn, float& alpha) {
  constexpr float C = ATT_SCALE * 1.4426950408889634f;
  float pmax = p0[0];
#pragma unroll
  for (int r = 1; r < 16; ++r) pmax = fmaxf(pmax, p0[r]);
#pragma unroll
  for (int r = 0; r < 16; ++r) pmax = fmaxf(pmax, p1[r]);
  { auto rr = __builtin_amdgcn_permlane32_swap(__float_as_uint(pmax), __float_as_uint(pmax), false, false);
    pmax = fmaxf(__uint_as_float(rr[0]), __uint_as_float(rr[1])); }
  if (__builtin_expect(__all(pmax - m_reg <= ATT_THR / ATT_SCALE), 1)) { mn = m_reg; alpha = 1.f; }
  else { mn = fmaxf(m_reg, pmax); alpha = __builtin_amdgcn_exp2f((m_reg - mn) * C); m_reg = mn; }
  const float mnC = -mn * C;
#pragma unroll
  for (int r = 0; r < 16; ++r) p0[r] = fmaf(p0[r], C, mnC);
#pragma unroll
  for (int r = 0; r < 16; ++r) p1[r] = fmaf(p1[r], C, mnC);
#pragma unroll
  for (int r = 0; r < 16; ++r) p0[r] = __builtin_amdgcn_exp2f(p0[r]);
}
__device__ __forceinline__ void finishSM(f32x16& p0, f32x16& p1, float alpha, float& l_reg, bf16x8& pa0, bf16x8& pa1, bf16x8& pa2, bf16x8& pa3) {
#pragma unroll
  for (int r = 0; r < 16; ++r) p1[r] = __builtin_amdgcn_exp2f(p1[r]);
  float ps = 0;
#pragma unroll
  for (int r = 0; r < 16; ++r) ps += p0[r];
#pragma unroll
  for (int r = 0; r < 16; ++r) ps += p1[r];
  { auto rr = __builtin_amdgcn_permlane32_swap(__float_as_uint(ps), __float_as_uint(ps), false, false);
    ps = __uint_as_float(rr[0]) + __uint_as_float(rr[1]); }
  l_reg = l_reg * alpha + ps;
#define PK4(P, BASE, OUT) do { unsigned a0 = cvtpk(P[BASE + 0], P[BASE + 1]), a1 = cvtpk(P[BASE + 2], P[BASE + 3]);   \
    unsigned b0 = cvtpk(P[BASE + 4], P[BASE + 5]), b1 = cvtpk(P[BASE + 6], P[BASE + 7]);                              \
    auto r0 = __builtin_amdgcn_permlane32_swap(a0, b0, false, false); auto r1 = __builtin_amdgcn_permlane32_swap(a1, b1, false, false); \
    u32x4 w = {r0[0], r1[0], r0[1], r1[1]}; OUT = __builtin_bit_cast(bf16x8, w); } while (0)
  PK4(p0, 0, pa0); PK4(p0, 8, pa1); PK4(p1, 0, pa2); PK4(p1, 8, pa3);
#undef PK4
}
constexpr int NQR = 12;
__device__ __forceinline__ void qkt192(f32x16& p0, f32x16& p1, const char* kb, const char* qb, int ke, int ko, int kr, const bf16x8 (&qr)[NQR]) {
#pragma unroll
  for (int r = 0; r < 16; ++r) { p0[r] = 0.f; p1[r] = 0.f; }
#pragma unroll
  for (int d0 = 0; d0 < 8; ++d0) {
    const int o = ((d0 & 1) ? ko : ke) + 512 * (d0 >> 1);
    const bf16x8 b0 = *(const bf16x8*)(kb + o), b1 = *(const bf16x8*)(kb + o + 8192), q = d0 < NQR ? qr[d0 < NQR ? d0 : 0] : *(const bf16x8*)(qb + 32 * d0);
    p0 = MFMA32(b0, q, p0); p1 = MFMA32(b1, q, p1);
  }
#pragma unroll
  for (int d1 = 0; d1 < 4; ++d1) {
    const int o = 16384 + (kr ^ (32 * d1));
    const bf16x8 b0 = *(const bf16x8*)(kb + o), b1 = *(const bf16x8*)(kb + o + 4096), q = qr[8 + d1];
    p0 = MFMA32(b0, q, p0); p1 = MFMA32(b1, q, p1);
  }
}
template <int OFF> __device__ __forceinline__ s16x4 tr_read(int vb) {
  s16x4 r; asm volatile("ds_read_b64_tr_b16 %0, %1 offset:%2" : "=&v"(r) : "v"(vb), "i"(OFF) : "memory"); return r;
}
template <int C> __device__ __forceinline__ void pv_one(f32x16& od, int vb0, int vb1, bf16x8 pa0, bf16x8 pa1, bf16x8 pa2, bf16x8 pa3) {
  const s16x4 l0 = tr_read<512 * C>(vb0), h0 = tr_read<512 * C>(vb1), l1 = tr_read<4096 + 512 * C>(vb0), h1 = tr_read<4096 + 512 * C>(vb1);
  const s16x4 l2 = tr_read<8192 + 512 * C>(vb0), h2 = tr_read<8192 + 512 * C>(vb1), l3 = tr_read<12288 + 512 * C>(vb0), h3 = tr_read<12288 + 512 * C>(vb1);
  asm volatile("s_waitcnt lgkmcnt(0)" ::: "memory"); SBAR();
#define PKV(L, H) (bf16x8){L[0], L[1], L[2], L[3], H[0], H[1], H[2], H[3]}
  od = MFMA32(pa0, PKV(l0, h0), od); od = MFMA32(pa1, PKV(l1, h1), od);
  od = MFMA32(pa2, PKV(l2, h2), od); od = MFMA32(pa3, PKV(l3, h3), od);
#undef PKV
}
__device__ __forceinline__ void pv_all(f32x16* o, int vb0, int vb1, bf16x8 pa0, bf16x8 pa1, bf16x8 pa2, bf16x8 pa3) {
  pv_one<0>(o[0], vb0, vb1, pa0, pa1, pa2, pa3); pv_one<1>(o[1], vb0, vb1, pa0, pa1, pa2, pa3);
  pv_one<2>(o[2], vb0, vb1, pa0, pa1, pa2, pa3); pv_one<3>(o[3], vb0, vb1, pa0, pa1, pa2, pa3);
}

__device__ void phase4(const Args& a, char* lds, const XcdBarrier pbar, bool pend) {
  unsigned char* ws = a.ws;
  const int tid = threadIdx.x, wid = tid >> 6, lane = tid & 63, r32 = lane & 31, hi = lane >> 5;
  const u16* Qg = (const u16*)(ws + WS_Q); const u16* KVg = (const u16*)(ws + WS_KV); const u16* WUV = (const u16*)(ws + WS_WUV);
  u16* Y = (u16*)(ws + WS_Y);
  char* gl = lds + LDS_DATA;
  char* kvl = gl;
  float* wsl = (float*)(gl + 2 * KVBUF) + wid * 64; float* li_l = wsl; float* al_l = wsl + 32;
  float* Yl = (float*)gl;
  const int head = wid >> 1, qh = wid & 1;
  int sdst[3];
#pragma unroll
  for (int j = 0; j < 3; ++j) { const int id = tid + 512 * j, key = id / 24, ch = id % 24;
    sdst[j] = ch < 16 ? (int)off_a(key, ch) : 16384 + key * 128 + (((ch - 16) ^ ((key >> 1) & 7)) << 4); }
  const int xq = (r32 >> 2) & 3;
  const int ke = 2048 * (r32 >> 3) + 64 * (r32 & 7) + 16 * (hi ^ xq), ko = 2048 * (r32 >> 3) + 64 * (r32 & 7) + 16 * ((2 + hi) ^ xq);
  const int kr = r32 * 128 + ((hi ^ ((r32 >> 1) & 7)) << 4);
  const int tb = lane >> 4 & 1, tq = (lane & 15) >> 2, tp = lane & 3;
  const int vbl = 2048 * hi + 64 * tq + 32 * (tb ^ hi) + 8 * (tp & 1);
  const int lbase = (int)(uintptr_t)kvl;
  const int vb0 = lbase + vbl + 16 * (tp >> 1), vb1 = lbase + vbl + 256 + 16 * ((tp >> 1) ^ 1);
  for (int u = blockIdx.x; u < 256; u += gridDim.x) {
    const int b = u >> 6, qb_ = u & 63;
    const size_t tok0 = (size_t)b * SEQ + qb_ * 64 + qh * 32;
    const u16* KVb = KVg + (size_t)b * SEQ * 192;
    float m_reg = -1e30f, l_reg = 0.f; f32x16 o[4];
#pragma unroll
    for (int d = 0; d < 4; ++d)
#pragma unroll
      for (int r = 0; r < 16; ++r) o[d][r] = 0.f;
    char* Ql = gl + 2 * KVBUF + 2048;
    const char* qb = Ql + (qh * 32 + r32) * 1552 + (head * 192 + 8 * hi) * 2;
    u32x4 st0[3];
#define SLOAD(S, k0) do { const u16* _p = KVb + (size_t)(k0) * 192 + tid * 8; S[0] = *(const u32x4*)_p; S[1] = *(const u32x4*)(_p + 4096); S[2] = *(const u32x4*)(_p + 8192); } while (0)
#define SWRITE(bufi, S) do { char* _d = kvl + (bufi) * KVBUF; *(u32x4*)(_d + sdst[0]) = S[0]; *(u32x4*)(_d + sdst[1]) = S[1]; *(u32x4*)(_d + sdst[2]) = S[2]; } while (0)
#define RESC(al) do { if (__any((al) < 1.f)) { if (hi == 0) al_l[r32] = (al); asm volatile("s_waitcnt lgkmcnt(0)" ::: "memory"); \
    _Pragma("unroll") for (int d = 0; d < 4; ++d) _Pragma("unroll") for (int r = 0; r < 16; ++r) o[d][r] *= al_l[crow(r, hi)]; } } while (0)
#define CVT_LOAD(tile, ISV) const unsigned cio = ((unsigned)(u * 32 + ((tile) >> 1)) << 9) | (unsigned)tid;                                    \
      const f32x4 cf_ = __builtin_nontemporal_load((const f32x4*)(((ISV) ? a.peer_v : a.peer_u) + (size_t)cio * 4));     \
      const float4 cf = make_float4(cf_[0], cf_[1], cf_[2], cf_[3])
#define CVT_STORE(ISV) do { if (ISV) {                                                                                                          \
        const unsigned cw = fp6_code<4>(cf.x) | (fp6_code<4>(cf.y) << 6) | (fp6_code<4>(cf.z) << 12) | (fp6_code<4>(cf.w) << 18);       \
        const unsigned cn = __builtin_amdgcn_update_dpp(cw, cw, 0xF9, 0xf, 0xf, false);                   \
        const unsigned cq = (unsigned)tid & 3u, cd = (cw >> (8u * cq)) | (cn << (24u - 8u * cq));                \
        if (cq < 3u) *(unsigned*)(ws + WS_UB + ((cio >> 8) * 1536u + 768u + (cio & 252u) * 3u + 4u * cq)) = cd;                                           \
      } else {                                                                                                                                    \
        const unsigned cw = fp6_code<PEER_SU6>(cf.x) | (fp6_code<PEER_SU6>(cf.y) << 6) | (fp6_code<PEER_SU6>(cf.z) << 12) | (fp6_code<PEER_SU6>(cf.w) << 18); \
        const unsigned cn = __builtin_amdgcn_update_dpp(cw, cw, 0xF9, 0xf, 0xf, false);                                                           \
        const unsigned cq = (unsigned)tid & 3u, cd = (cw >> (8u * cq)) | (cn << (24u - 8u * cq));                                                 \
        const unsigned cc = cio & 255u, cdw = 3u * ((cc & 15u) >> 2) + cq;                               \
        if (cq < 3u) *(unsigned*)(ws + WS_UB + ((cio >> 8) * 1536u + 256u * (cdw >> 2) + 16u * (cc >> 4) + 4u * (cdw & 3u))) = cd;                 \
      } } while (0)
    constexpr int NT = SEQ / 64;
    f32x16 pA0, pA1, pB0, pB1; float mnA, mnB, alA, alB; bf16x8 pa0, pa1, pa2, pa3;
    SLOAD(st0, 0);
    if (pend) { xcd_barrier_wait(pbar); pend = false; } else __syncthreads();
    { const u16* Qu = Qg + ((size_t)b * SEQ + qb_ * 64) * 768; int tq_ = tid; asm volatile("" : "+v"(tq_));
#pragma unroll
      for (int i = 0; i < 12; ++i) { const int id = tq_ + 512 * i, row = id / 96, c = id % 96; *(u32x4*)(Ql + row * 1552 + c * 16) = *(const u32x4*)(Qu + (size_t)row * 768 + c * 8); } }
    SWRITE(0, st0); SLOAD(st0, 64); __syncthreads();
    bf16x8 qr[NQR];
#pragma unroll
    for (int d0 = 0; d0 < NQR; ++d0) qr[d0] = *(const bf16x8*)(qb + 32 * d0);
    { CVT_LOAD(0, false);
      qkt192(pA0, pA1, kvl, qb, ke, ko, kr, qr); partialSM(pA0, pA1, m_reg, mnA, alA);
      SWRITE(1, st0); CVT_STORE(false); }
    __syncthreads();
    for (int j = 1; j + 1 < NT; j += 2) {
      { CVT_LOAD(j, true);
        SBAR(); qkt192(pB0, pB1, kvl + KVBUF, qb, ke, ko, kr, qr);
        finishSM(pA0, pA1, alA, l_reg, pa0, pa1, pa2, pa3); SBAR();
        SLOAD(st0, (j + 1) * 64); SBAR();
        pv_all(o, vb0, vb1, pa0, pa1, pa2, pa3); partialSM(pB0, pB1, m_reg, mnB, alB);
        __syncthreads(); SWRITE(0, st0); CVT_STORE(true);
        RESC(alB); __syncthreads(); }
      { CVT_LOAD(j + 1, false);
        SBAR(); qkt192(pA0, pA1, kvl, qb, ke, ko, kr, qr);
        finishSM(pB0, pB1, alB, l_reg, pa0, pa1, pa2, pa3); SBAR();
        if (j + 2 < NT) SLOAD(st0, (j + 2) * 64); SBAR();
        pv_all(o, vb0 + KVBUF, vb1 + KVBUF, pa0, pa1, pa2, pa3); partialSM(pA0, pA1, m_reg, mnA, alA);
        __syncthreads(); if (j + 2 < NT) SWRITE(1, st0); CVT_STORE(false);
        RESC(alA); __syncthreads(); }
    }
    { CVT_LOAD(NT - 1, true);
      SBAR(); qkt192(pB0, pB1, kvl + KVBUF, qb, ke, ko, kr, qr);
      finishSM(pA0, pA1, alA, l_reg, pa0, pa1, pa2, pa3); SBAR();
      pv_all(o, vb0, vb1, pa0, pa1, pa2, pa3); partialSM(pB0, pB1, m_reg, mnB, alB);
      CVT_STORE(true);
      __syncthreads(); RESC(alB);
      finishSM(pB0, pB1, alB, l_reg, pa0, pa1, pa2, pa3); SBAR();
      pv_all(o, vb0 + KVBUF, vb1 + KVBUF, pa0, pa1, pa2, pa3); }
    __syncthreads();
#undef SLOAD
#undef SWRITE
#undef RESC
#undef CVT_LOAD
#undef CVT_STORE
    int r32e = r32, hie = hi, lne = lane, wide = __builtin_amdgcn_readfirstlane(wid);
    asm volatile("" : "+v"(r32e), "+v"(hie), "+v"(lne), "+s"(wide));
    const int heade = wide >> 1, qhe = wide & 1;
    char* Ole = gl + 2 * KVBUF + 2048 + wide * 8704;
    if (hie == 0) li_l[r32e] = l_reg;
    asm volatile("s_waitcnt lgkmcnt(0)" ::: "memory");
#pragma unroll
    for (int r = 0; r < 16; ++r) {
      const int q = crow(r, hie); const float rl = __builtin_amdgcn_rcpf(li_l[q]);
#pragma unroll
      for (int d = 0; d < 4; ++d) *(u16*)(Ole + q * 272 + (32 * d + r32e) * 2) = f2bf(o[d][r] * rl);
    }
    asm volatile("s_waitcnt lgkmcnt(0)" ::: "memory");
    f32x16 y[4];
#pragma unroll
    for (int n = 0; n < 4; ++n)
#pragma unroll
      for (int r = 0; r < 16; ++r) y[n][r] = 0.f;
    const u16* wuv = WUV + ((size_t)heade * 128 + r32e) * 128 + 8 * hie;
#pragma unroll 2
    for (int s = 0; s < 8; ++s) {
      const bf16x8 af = *(const bf16x8*)(Ole + r32e * 272 + (16 * s + 8 * hie) * 2);
#pragma unroll
      for (int n = 0; n < 4; ++n) {
        const bf16x8 bw = *(const bf16x8*)(wuv + 32 * n * 128 + 16 * s);
        y[n] = MFMA32(af, bw, y[n]);
      }
    }
    __syncthreads();
#pragma unroll
    for (int n = 0; n < 4; ++n)
#pragma unroll
      for (int r = 0; r < 16; ++r) Yl[(qhe * 32 + crow(r, hie)) * 513 + heade * 128 + 32 * n + r32e] = y[n][r];
    __syncthreads();
    for (int i = 0; i < 8; ++i) {
      const int pl = wide * 8 + i; const size_t tok = (size_t)b * SEQ + qb_ * 64 + pl;
      float v[8], ssq = 0.f;
#pragma unroll
      for (int jj = 0; jj < 8; ++jj) { v[jj] = Yl[pl * 513 + lne + 64 * jj]; ssq += v[jj] * v[jj]; }
      ssq = wave_sum(ssq);
      const float rstd = rsqrtf(ssq * (1.f / 512.f) + EPS);
#pragma unroll
      for (int jj = 0; jj < 8; ++jj) { const int col = lne + 64 * jj; Y[tok * 1024 + col] = f2bf(v[jj] * rstd * a.g_attn_out[col]); }
    }
    __syncthreads();
  }
  if (pend) xcd_barrier_wait(pbar);
}

__device__ void phase5(const Args& a, char* lds) {
  unsigned char* ws = a.ws;
  const int tid = threadIdx.x, lane = tid & 63, wv = tid >> 6;
  const u16* Y = (const u16*)(ws + WS_Y); const u16* WO = (const u16*)(ws + WS_WO);
  float* X1 = (float*)(ws + WS_X1); float* SSQ = (float*)(ws + WS_SSQ); const float* mod = (const float*)(ws + WS_MOD);
  u16* X1B = (u16*)(ws + WS_H);
  char* gl = lds + LDS_DATA; float* Cl = (float*)gl;
  for (int u = blockIdx.x; u < 64 * 4; u += gridDim.x) {
    int mt, nt; xcd_unit(u, 4, mt, nt); const int b = (mt * 256) >> 12;
    f32x16 acc[4][2];
    gemm_256x256<true>(Y + (size_t)(mt * 256) * 1024, 1024, WO + (size_t)(nt * 256) * 1024, 1024, 32, acc, gl);
    float2 g1[2];
#pragma unroll
    for (int j = 0; j < 2; ++j) g1[j] = *(const float2*)(mod + b * 6144 + 2048 + nt * 256 + 2 * lane + 128 * j);
#pragma unroll
    for (int half = 0; half < 2; ++half) {
      const int R0 = mt * 256 + 128 * half;
      if (half == 0) acc_to_lds_half<0>(acc, Cl); else acc_to_lds_half<1>(acc, Cl);
      __syncthreads();
      for (int i0 = 0; i0 < 16; i0 += 8) {
        float2 xv[8][2];
#pragma unroll
        for (int i = 0; i < 8; ++i)
#pragma unroll
          for (int j = 0; j < 2; ++j) xv[i][j] = ldnt2(a.x + (size_t)(R0 + wv * 16 + i0 + i) * 1024 + nt * 256 + 2 * lane + 128 * j);
#pragma unroll
        for (int i = 0; i < 8; ++i) {
          const int row = wv * 16 + i0 + i; const size_t tok = R0 + row; float ssq = 0.f;
#pragma unroll
          for (int j = 0; j < 2; ++j) {
            const int col = nt * 256 + 2 * lane + 128 * j;
            const float v0 = xv[i][j].x + g1[j].x * Cl[row * CLD + 2 * lane + 128 * j], v1 = xv[i][j].y + g1[j].y * Cl[row * CLD + 2 * lane + 128 * j + 1];
            stnt1(X1B + tok * 1024 + col, pack2(v0, v1)); ssq += v0 * v0 + v1 * v1;
          }
          ssq = wave_sum(ssq);
          if (lane == 0) SSQ[tok * 4 + nt] = ssq;
        }
      }
      __syncthreads();
    }
  }
}
__device__ __forceinline__ float vmaxf(float a, float b) { float r; asm("v_max_f32 %0, %1, %2" : "=v"(r) : "v"(a), "v"(b)); return r; }
__device__ __forceinline__ float vminf(float a, float b) { float r; asm("v_min_f32 %0, %1, %2" : "=v"(r) : "v"(a), "v"(b)); return r; }
#define TK_CE(x, y) do { const float _h = vmaxf((x), (y)); (y) = vminf((x), (y)); (x) = _h; } while (0)
#define TK_SORT16(t) do { TK_CE(t[0], t[1]); TK_CE(t[2], t[3]); TK_CE(t[0], t[2]); TK_CE(t[1], t[3]); TK_CE(t[1], t[2]); TK_CE(t[4], t[5]); TK_CE(t[6], t[7]); TK_CE(t[4], t[6]); TK_CE(t[5], t[7]); TK_CE(t[5], t[6]); TK_CE(t[0], t[4]); TK_CE(t[2], t[6]); TK_CE(t[2], t[4]); TK_CE(t[1], t[5]); TK_CE(t[3], t[7]); TK_CE(t[3], t[5]); TK_CE(t[1], t[2]); TK_CE(t[3], t[4]); TK_CE(t[5], t[6]); TK_CE(t[8], t[9]); TK_CE(t[10], t[11]); TK_CE(t[8], t[10]); TK_CE(t[9], t[11]); TK_CE(t[9], t[10]); TK_CE(t[12], t[13]); TK_CE(t[14], t[15]); TK_CE(t[12], t[14]); TK_CE(t[13], t[15]); TK_CE(t[13], t[14]); TK_CE(t[8], t[12]); TK_CE(t[10], t[14]); TK_CE(t[10], t[12]); TK_CE(t[9], t[13]); TK_CE(t[11], t[15]); TK_CE(t[11], t[13]); TK_CE(t[9], t[10]); TK_CE(t[11], t[12]); TK_CE(t[13], t[14]); TK_CE(t[0], t[8]); TK_CE(t[4], t[12]); TK_CE(t[4], t[8]); TK_CE(t[2], t[10]); TK_CE(t[6], t[14]); TK_CE(t[6], t[10]); TK_CE(t[2], t[4]); TK_CE(t[6], t[8]); TK_CE(t[10], t[12]); TK_CE(t[1], t[9]); TK_CE(t[5], t[13]); TK_CE(t[5], t[9]); TK_CE(t[3], t[11]); TK_CE(t[7], t[15]); TK_CE(t[7], t[11]); TK_CE(t[3], t[5]); TK_CE(t[7], t[9]); TK_CE(t[11], t[13]); TK_CE(t[1], t[2]); TK_CE(t[3], t[4]); TK_CE(t[5], t[6]); TK_CE(t[7], t[8]); TK_CE(t[9], t[10]); TK_CE(t[11], t[12]); TK_CE(t[13], t[14]); } while (0)
#define TK_BMERGE16(t) do { TK_CE(t[0], t[8]); TK_CE(t[1], t[9]); TK_CE(t[2], t[10]); TK_CE(t[3], t[11]); TK_CE(t[4], t[12]); TK_CE(t[5], t[13]); TK_CE(t[6], t[14]); TK_CE(t[7], t[15]); TK_CE(t[0], t[4]); TK_CE(t[1], t[5]); TK_CE(t[2], t[6]); TK_CE(t[3], t[7]); TK_CE(t[8], t[12]); TK_CE(t[9], t[13]); TK_CE(t[10], t[14]); TK_CE(t[11], t[15]); TK_CE(t[0], t[2]); TK_CE(t[1], t[3]); TK_CE(t[4], t[6]); TK_CE(t[5], t[7]); TK_CE(t[8], t[10]); TK_CE(t[9], t[11]); TK_CE(t[12], t[14]); TK_CE(t[13], t[15]); TK_CE(t[0], t[1]); TK_CE(t[2], t[3]); TK_CE(t[4], t[5]); TK_CE(t[6], t[7]); TK_CE(t[8], t[9]); TK_CE(t[10], t[11]); TK_CE(t[12], t[13]); TK_CE(t[14], t[15]); } while (0)
#define TK_MERGE(A, B) do { _Pragma("unroll") for (int _i = 0; _i < 16; ++_i) A[_i] = vmaxf(A[_i], B[15 - _i]); TK_BMERGE16(A); } while (0)
__constant__ unsigned long long TK_I[4] = {0x0000000000000000ull, 0x0007744411111111ull, 0x0006655333322222ull, 0x00000000FEDCBA98ull};
__constant__ unsigned long long TK_J[4] = {0xFEDCBA9876543210ull, 0x0001021076543210ull, 0x0001010321043210ull, 0x0000000000000000ull};
__constant__ int TK_N[4] = {16, 13, 13, 8};

__device__ void phase6(const Args& a, char* lds) {
  unsigned char* ws = a.ws;
  const int tid = threadIdx.x, lane = tid & 63, wv = tid >> 6, r32 = lane & 31, hi = lane >> 5;
  const u16* H = (const u16*)(ws + WS_H); const u16* WST = (const u16*)(ws + WS_WST);
  float* TOPS = (float*)(ws + WS_TOPK);
  const float* BIASP = (const float*)(ws + WS_BIASP); const float* SSQ = (const float*)(ws + WS_SSQ);
  char* gl = lds + LDS_DATA;
  for (int u = blockIdx.x; u < 8 * 64; u += gridDim.x) {
    int tb, hd; xcd_unit(u, 8, tb, hd);
    const int b = tb >> 4;
    f32x16 sc[8];
    gemm_256x256_wide(WST + ((size_t)b * 2048 + hd * 256) * 1024, 1024, H + (size_t)tb * 256 * 1024, 1024, 16, sc, gl);
    float* bl = (float*)gl;
    if (tid < 256) bl[tid] = BIASP[((size_t)0 * 4 + b) * 2048 + hd * 256 + tid] + BIASP[((size_t)1 * 4 + b) * 2048 + hd * 256 + tid]
                           + BIASP[((size_t)2 * 4 + b) * 2048 + hd * 256 + tid] + BIASP[((size_t)3 * 4 + b) * 2048 + hd * 256 + tid];
    const float4 sq = *(const float4*)(SSQ + (size_t)(tb * 256 + 32 * wv + r32) * 4);
    const float rstd = rsqrtf((sq.x + sq.y + sq.z + sq.w) * (1.f / 1024.f) + EPS);
    __syncthreads();
#pragma unroll
    for (int half = 0; half < 2; ++half) {
      float g0[16], g1[16], g2[16], g3[16], p[16];
#pragma unroll
      for (int r = 0; r < 16; ++r) {
        const unsigned key = crow(r, hi);
        g0[r] = __uint_as_float((__float_as_uint(fmaf(sc[4 * half + 0][r], rstd, bl[128 * half + key])) & ~127u) | key);
        g1[r] = __uint_as_float((__float_as_uint(fmaf(sc[4 * half + 1][r], rstd, bl[128 * half + 32 + key])) & ~127u) | (32u + key));
        g2[r] = __uint_as_float((__float_as_uint(fmaf(sc[4 * half + 2][r], rstd, bl[128 * half + 64 + key])) & ~127u) | (64u + key));
        g3[r] = __uint_as_float((__float_as_uint(fmaf(sc[4 * half + 3][r], rstd, bl[128 * half + 96 + key])) & ~127u) | (96u + key));
      }
      TK_SORT16(g0); TK_SORT16(g1); TK_SORT16(g2); TK_SORT16(g3);
      TK_MERGE(g0, g1); TK_MERGE(g2, g3); TK_MERGE(g0, g2);
#pragma unroll
      for (int i = 0; i < 16; ++i) {
        auto rr = __builtin_amdgcn_permlane32_swap(__float_as_uint(g0[i]), __float_as_uint(g0[i]), false, false);
        p[i] = __uint_as_float(hi ? rr[0] : rr[1]);
      }
      TK_MERGE(g0, p);
      if (hi == 0) {
        float* dst = TOPS + ((size_t)(tb * 256 + 32 * wv + r32) * 16 + 2 * hd + half) * 16;
#pragma unroll
        for (int i = 0; i < 16; i += 4) stnt4f(dst + i, g0[i], g0[i + 1], g0[i + 2], g0[i + 3]);
      }
    }
  }
}

#define MFMA4(a, b, c) __builtin_amdgcn_mfma_f32_4x4x4bf16_1k((a), (b), (c), 0, 0, 0)
constexpr int P7_VROW = 2112, P7_VBUF = 4 * P7_VROW;
constexpr int P7_RING = 64;
constexpr int P7_ENT  = P7_RING + 8 * 2 * P7_VBUF;
constexpr int P7_CNT  = P7_ENT + 8 * 2048;
static_assert(P7_CNT + 8 * 256 <= LDS_BYTES, "phase 7 LDS map");
__device__ __forceinline__ float sel4(const f32x4& d, int k) { return k == 0 ? d[0] : (k == 1 ? d[1] : (k == 2 ? d[2] : d[3])); }
__device__ __forceinline__ unsigned fp8x2_bf16(unsigned x, float sc, bool hi) {
  return hi ? __builtin_bit_cast(unsigned, __builtin_amdgcn_cvt_scalef32_pk_bf16_fp8(x, sc, true)) : __builtin_bit_cast(unsigned, __builtin_amdgcn_cvt_scalef32_pk_bf16_fp8(x, sc, false));
}

__device__ void phase7(const Args& a, char* lds, const XcdBarrier pbar, bool pend) {
  unsigned char* ws = a.ws;
  const int tid = threadIdx.x, lane = tid & 63, wv = __builtin_amdgcn_readfirstlane(tid >> 6), blk = lane >> 2, j4 = lane & 3;
  const u16* H = (const u16*)(ws + WS_H); const unsigned char* U8 = ws + WS_UB; const unsigned char* V8 = ws + WS_UB + 768;
  const float* TOPS = (const float*)(ws + WS_TOPK); const float* X1 = (const float*)(ws + WS_X1); const float* mod = (const float*)(ws + WS_MOD);
  const float* SSQ = (const float*)(ws + WS_SSQ);
  const unsigned lbase = (unsigned)(uintptr_t)lds;
  char* ring = lds + P7_RING + wv * 2 * P7_VBUF;
  unsigned* ents = (unsigned*)(lds + P7_ENT + wv * 2048);
  int* cntw = (int*)(lds + P7_CNT + wv * 256);
  const int trb = (int)(lbase + P7_RING + wv * 2 * P7_VBUF) + ((lane & 15) >> 2) * P7_VROW + 32 * (lane >> 4) + 8 * (lane & 3);
  const int NWV = gridDim.x * 8;
  const bool dg = (lane >> 4) == ((lane >> 2) & 3);
  for (int qd = blockIdx.x * 8 + wv; qd < T / 4; qd += NWV) {
    const int tok0 = qd * 4, b = tok0 >> 12;
    unsigned hA6[12];
    { const float4 sq = *(const float4*)(SSQ + (size_t)(tok0 + j4) * 4);
      const float rstd = rsqrtf((sq.x + sq.y + sq.z + sq.w) * (1.f / 1024.f) + EPS);
#pragma unroll
      for (int i = 0; i < 4; ++i) {
        unsigned w4[4];
#pragma unroll
        for (int hf = 0; hf < 2; ++hf) {
          const int k0 = 64 * blk + 8 * (2 * i + hf);
          const u32x4 xb = *(const u32x4*)(H + (size_t)(tok0 + j4) * 1024 + k0);
          float hv[8];
#pragma unroll
          for (int e = 0; e < 8; e += 4) {
            const float4 g = *(const float4*)(a.g_norm2 + k0 + e), sc4 = *(const float4*)(mod + b * 6144 + 4096 + k0 + e), sh4 = *(const float4*)(mod + b * 6144 + 3072 + k0 + e);
            hv[e]     = bflo(xb[e >> 1]) * rstd * g.x * (1.f + sc4.x) + sh4.x;     hv[e + 1] = bfhi(xb[e >> 1]) * rstd * g.y * (1.f + sc4.y) + sh4.y;
            hv[e + 2] = bflo(xb[(e >> 1) + 1]) * rstd * g.z * (1.f + sc4.z) + sh4.z; hv[e + 3] = bfhi(xb[(e >> 1) + 1]) * rstd * g.w * (1.f + sc4.w) + sh4.w;
          }
          w4[2 * hf]     = fp6_codef(hv[0], P7_HS6) | (fp6_codef(hv[1], P7_HS6) << 6) | (fp6_codef(hv[2], P7_HS6) << 12) | (fp6_codef(hv[3], P7_HS6) << 18);
          w4[2 * hf + 1] = fp6_codef(hv[4], P7_HS6) | (fp6_codef(hv[5], P7_HS6) << 6) | (fp6_codef(hv[6], P7_HS6) << 12) | (fp6_codef(hv[7], P7_HS6) << 18);
        }
        hA6[3 * i] = w4[0] | (w4[1] << 24); hA6[3 * i + 1] = (w4[1] >> 8) | (w4[2] << 16); hA6[3 * i + 2] = (w4[2] >> 16) | (w4[3] << 8);
      } }
    { u32x4* hp = (u32x4*)(ring + 8192 + lane * 48);
      hp[0] = (u32x4){hA6[0], hA6[1], hA6[2], hA6[3]}; hp[1] = (u32x4){hA6[4], hA6[5], hA6[6], hA6[7]}; hp[2] = (u32x4){hA6[8], hA6[9], hA6[10], hA6[11]}; }
    if (pend) { xcd_barrier_wait(pbar); pend = false; }
    float* TS = (float*)ring;
#pragma unroll
    for (int i = 0; i < 4; ++i) *(float4*)(TS + 256 * i + 4 * lane) = ldnt4(TOPS + (size_t)tok0 * 256 + 256 * i + 4 * lane);
    cntw[lane] = 0;
    asm volatile("s_waitcnt lgkmcnt(0)" ::: "memory");
    unsigned ec[8];
#pragma unroll
    for (int rd = 0; rd < 2; ++rd) {
      const int combo = (lane >> 2) + 16 * rd, tl = combo >> 3, hd = combo & 7, q = lane & 3;
      const float* t1 = TS + (tl * 16 + hd * 2) * 16; const float* t2 = t1 + 16;
      const unsigned long long ip = TK_I[q], jp = TK_J[q]; const int cn = TK_N[q];
      float L[16], P[16];
#pragma unroll
      for (int c = 0; c < 16; ++c) {
        const unsigned i = (unsigned)(ip >> (4 * c)) & 15u, j = (unsigned)(jp >> (4 * c)) & 15u;
        const float sm = t1[i] + t2[j];
        L[c] = c < cn ? __uint_as_float((__float_as_uint(sm) & ~255u) | (i << 4) | j) : -3.0e38f;
      }
      TK_SORT16(L);
#pragma unroll
      for (int c = 0; c < 16; ++c) P[c] = __uint_as_float(__builtin_amdgcn_update_dpp(0, __float_as_uint(L[c]), 0xB1, 0xf, 0xf, false));
      TK_MERGE(L, P);
#pragma unroll
      for (int c = 0; c < 16; ++c) P[c] = __uint_as_float(__builtin_amdgcn_update_dpp(0, __float_as_uint(L[c]), 0x4E, 0xf, 0xf, false));
      TK_MERGE(L, P);
      float sum = 0.f;
      const float m0 = __uint_as_float(__float_as_uint(L[0]) & ~255u);
#pragma unroll
      for (int c = 0; c < 16; ++c) sum += __expf(__uint_as_float(__float_as_uint(L[c]) & ~255u) - m0);
      const float inv = 1.f / sum;
#pragma unroll
      for (int r = 0; r < 4; ++r) {
        const float lv = q == 0 ? L[r] : (q == 1 ? L[4 + r] : (q == 2 ? L[8 + r] : L[12 + r]));
        const unsigned bits = __float_as_uint(lv), id = bits & 255u;
        const unsigned i1 = __float_as_uint(t1[id >> 4]) & 127u, i2 = __float_as_uint(t2[id & 15u]) & 127u;
        const float gate = __expf(__uint_as_float(bits & ~255u) - m0) * inv;
        ec[4 * rd + r] = (i1 * 128u + i2) | ((unsigned)tl << 14) | (pack2(0.f, gate) & 0xFFFF0000u);
      }
    }
    {
#pragma unroll
      for (int i = 0; i < 8; ++i) atomicAdd(&cntw[(ec[i] & 0x3FFFu) >> 8], 1);
      asm volatile("s_waitcnt lgkmcnt(0)" ::: "memory");
      const int c = cntw[lane]; int inc = c;
#pragma unroll
      for (int o = 1; o < 64; o <<= 1) { const int v = __shfl_up(inc, o, 64); if (lane >= o) inc += v; }
      asm volatile("s_waitcnt lgkmcnt(0)" ::: "memory");
      cntw[lane] = inc - c;
      asm volatile("s_waitcnt lgkmcnt(0)" ::: "memory");
#pragma unroll
      for (int i = 0; i < 8; ++i) { const int pos = atomicAdd(&cntw[(ec[i] & 0x3FFFu) >> 8], 1); ents[pos] = ec[i]; }
      asm volatile("s_waitcnt lgkmcnt(0)" ::: "memory");
    }
    { const u32x4* hp = (const u32x4*)(ring + 8192 + lane * 48); const u32x4 h0 = hp[0], h1 = hp[1], h2 = hp[2];
      hA6[0] = h0[0]; hA6[1] = h0[1]; hA6[2] = h0[2]; hA6[3] = h0[3]; hA6[4] = h1[0]; hA6[5] = h1[1]; hA6[6] = h1[2]; hA6[7] = h1[3];
      hA6[8] = h2[0]; hA6[9] = h2[1]; hA6[10] = h2[2]; hA6[11] = h2[3]; }
    f32x4 acc[16];
#pragma unroll
    for (int c = 0; c < 16; ++c) acc[c] = (f32x4){0.f, 0.f, 0.f, 0.f};
#define P7_VPHASE(bufi) do { const int _vb = trb + (bufi) * P7_VBUF;                                                            \
      const s16x4 v0 = tr_read<0>(_vb), v1 = tr_read<128>(_vb), v2 = tr_read<256>(_vb), v3 = tr_read<384>(_vb),                 \
                  v4 = tr_read<512>(_vb), v5 = tr_read<640>(_vb), v6 = tr_read<768>(_vb), v7 = tr_read<896>(_vb);                 \
      const s16x4 w0 = tr_read<1024>(_vb), w1 = tr_read<1152>(_vb), w2 = tr_read<1280>(_vb), w3 = tr_read<1408>(_vb),           \
                  w4 = tr_read<1536>(_vb), w5 = tr_read<1664>(_vb), w6 = tr_read<1792>(_vb), w7 = tr_read<1920>(_vb);             \
      asm volatile("s_waitcnt lgkmcnt(8)" ::: "memory"); SBAR();        \
      acc[0] = MFMA4(awp, v0, acc[0]); acc[1] = MFMA4(awp, v1, acc[1]); acc[2] = MFMA4(awp, v2, acc[2]); acc[3] = MFMA4(awp, v3, acc[3]);   \
      acc[4] = MFMA4(awp, v4, acc[4]); acc[5] = MFMA4(awp, v5, acc[5]); acc[6] = MFMA4(awp, v6, acc[6]); acc[7] = MFMA4(awp, v7, acc[7]);   \
      asm volatile("s_waitcnt lgkmcnt(0)" ::: "memory"); SBAR();                                                                  \
      acc[8] = MFMA4(awp, w0, acc[8]); acc[9] = MFMA4(awp, w1, acc[9]); acc[10] = MFMA4(awp, w2, acc[10]); acc[11] = MFMA4(awp, w3, acc[11]); \
      acc[12] = MFMA4(awp, w4, acc[12]); acc[13] = MFMA4(awp, w5, acc[13]); acc[14] = MFMA4(awp, w6, acc[14]); acc[15] = MFMA4(awp, w7, acc[15]); } while (0)
    u32x4 u8[3]; u32x3 v8[4];
#define P7_LOADG(EN) do { const unsigned _ex = (EN) & 0x3FFFu; const unsigned char* _pu = U8 + (size_t)_ex * 1536 + 16 * blk;       \
      _Pragma("unroll") for (int _q = 0; _q < 4; ++_q) { const unsigned _eq = (unsigned)__builtin_amdgcn_readlane((int)_ex, _q);  \
        v8[_q] = *(const u32x3*)(V8 + (size_t)_eq * 1536 + 12 * lane); }                                                          \
      _Pragma("unroll") for (int _i = 0; _i < 3; ++_i) u8[_i] = *(const u32x4*)(_pu + 256 * _i); } while (0)
    unsigned enc = ents[j4], enn = ents[4 + j4];
    P7_LOADG(enc);
    s16x4 awp = {0, 0, 0, 0};
    constexpr int NG = 128;
#pragma unroll 2
    for (int g = 0; g < NG; ++g) {
      if (g > 0) P7_VPHASE((g - 1) & 1);
      { char* vw = ring + (g & 1) * P7_VBUF + lane * 32;
#pragma unroll
        for (int q = 0; q < 4; q += 2) {
          const u32x6 src = {v8[q][0], v8[q][1], v8[q][2], v8[q + 1][0], v8[q + 1][1], v8[q + 1][2]};
          const u32x16 w = __builtin_bit_cast(u32x16, __builtin_amdgcn_cvt_scalef32_pk32_bf16_fp6(src, 1.f / PEER_SV));
          *(u32x4*)(vw + q * P7_VROW) = (u32x4){w[0], w[1], w[2], w[3]};             *(u32x4*)(vw + q * P7_VROW + 16) = (u32x4){w[4], w[5], w[6], w[7]};
          *(u32x4*)(vw + (q + 1) * P7_VROW) = (u32x4){w[8], w[9], w[10], w[11]};     *(u32x4*)(vw + (q + 1) * P7_VROW + 16) = (u32x4){w[12], w[13], w[14], w[15]};
        } }
      f32x4 d0 = {0.f, 0.f, 0.f, 0.f}, d1 = {0.f, 0.f, 0.f, 0.f};
      { typedef __attribute__((ext_vector_type(8))) int i32x8;
        const i32x8 a0 = {(int)hA6[0], (int)hA6[1], (int)hA6[2], (int)hA6[3], (int)hA6[4], (int)hA6[5], 0, 0};
        const i32x8 a1 = {(int)hA6[6], (int)hA6[7], (int)hA6[8], (int)hA6[9], (int)hA6[10], (int)hA6[11], 0, 0};
        const i32x8 b0 = {(int)u8[0][0], (int)u8[0][1], (int)u8[0][2], (int)u8[0][3], (int)u8[1][0], (int)u8[1][1], 0, 0};
        const i32x8 b1 = {(int)u8[1][2], (int)u8[1][3], (int)u8[2][0], (int)u8[2][1], (int)u8[2][2], (int)u8[2][3], 0, 0};
        d0 = __builtin_amdgcn_mfma_scale_f32_16x16x128_f8f6f4(a0, b0, d0, 2, 2, 0, 0, 0, 0);
        d1 = __builtin_amdgcn_mfma_scale_f32_16x16x128_f8f6f4(a1, b1, d1, 2, 2, 0, 0, 0, 0);
        asm volatile("" :: "v"(b0), "v"(b1), "v"(a0), "v"(a1)); }
      unsigned en2 = 0u;
      if (g + 1 < NG) { P7_LOADG(enn); if (g + 2 < NG) en2 = ents[4 * (g + 2) + j4]; }
      const int tk = (enc >> 14) & 3;
      float av = dg ? (sel4(d0, tk) + sel4(d1, tk)) * (1.f / (PEER_SU6 * P7_HS6)) : 0.f;
      av += __uint_as_float(__builtin_amdgcn_update_dpp(0, __float_as_uint(av), 0x124, 0xf, 0xf, false));
      av += __uint_as_float(__builtin_amdgcn_update_dpp(0, __float_as_uint(av), 0x128, 0xf, 0xf, false));
      { auto rq = __builtin_amdgcn_permlane16_swap(__float_as_uint(av), __float_as_uint(av), false, false); av = __uint_as_float(rq[0]) + __uint_as_float(rq[1]); }
      { auto rr = __builtin_amdgcn_permlane32_swap(__float_as_uint(av), __float_as_uint(av), false, false); av = __uint_as_float(rr[0]) + __uint_as_float(rr[1]); }
      const float wgt = gelu_exact(av) * __uint_as_float(enc & 0xFFFF0000u);
      float z[4];
#define P7_QB(x, k) __builtin_amdgcn_update_dpp(0, (x), (k) * 0x55, 0xf, 0xf, false)
      { const unsigned wb = __float_as_uint(wgt), tb = (unsigned)tk;
        unsigned w0 = P7_QB(wb, 0), w1 = P7_QB(wb, 1), w2 = P7_QB(wb, 2), w3 = P7_QB(wb, 3);
        unsigned t0 = P7_QB(tb, 0), t1 = P7_QB(tb, 1), t2 = P7_QB(tb, 2), t3 = P7_QB(tb, 3);
        asm volatile("" : "+v"(w0), "+v"(w1), "+v"(w2), "+v"(w3), "+v"(t0), "+v"(t1), "+v"(t2), "+v"(t3));
        z[0] = ((int)t0 == j4) ? __uint_as_float(w0) : 0.f; z[1] = ((int)t1 == j4) ? __uint_as_float(w1) : 0.f;
        z[2] = ((int)t2 == j4) ? __uint_as_float(w2) : 0.f; z[3] = ((int)t3 == j4) ? __uint_as_float(w3) : 0.f; }
#undef P7_QB
      { const uint2 pk = {pack2(z[0], z[1]), pack2(z[2], z[3])}; awp = __builtin_bit_cast(s16x4, pk); }
      enc = enn; enn = en2;
    }
#undef P7_LOADG
    P7_VPHASE((NG - 1) & 1);
#undef P7_VPHASE
    int lne = lane; asm volatile("" : "+v"(lne));
    float ss[4] = {0.f, 0.f, 0.f, 0.f};
#pragma unroll
    for (int c = 0; c < 16; ++c) {
      const float g2 = mod[b * 6144 + 5120 + 64 * c + lne];
#pragma unroll
      for (int r = 0; r < 4; ++r) { const float v = bflo((unsigned)H[(size_t)(tok0 + r) * 1024 + 64 * c + lne]) + g2 * acc[c][r]; acc[c][r] = v; ss[r] += v * v; }
    }
    float rstd[4];
#pragma unroll
    for (int r = 0; r < 4; ++r) rstd[r] = rsqrtf(wave_sum(ss[r]) * (1.f / 1024.f) + EPS);
#pragma unroll
    for (int c = 0; c < 16; ++c) {
      const float gf = a.g_final[64 * c + lne];
#pragma unroll
      for (int r = 0; r < 4; ++r) __builtin_nontemporal_store(acc[c][r] * rstd[r] * gf, a.out + (size_t)(tok0 + r) * 1024 + 64 * c + lne);
    }
  }
}

constexpr int N_PHASES = 8;
__global__ void __launch_bounds__(512, 2) fwd(Args args) {
  extern __shared__ __attribute__((aligned(16))) char lds[];
  if (threadIdx.x == 0) *(uint4*)lds = make_uint4(0u, 0u, 0u, 0u);
  __syncthreads();
  const int lo = args.ph_lo, hi = args.ph_hi;
  XcdBarrier bar; bar.bar = (unsigned*)(args.ws + WS_BAR); bar.x = 0; bar.st = (volatile LAS unsigned*)lds;
  if (hi - lo > 1) bar = xcd_barrier_post((unsigned*)(args.ws + WS_BAR), (volatile LAS unsigned*)lds);
#ifndef ONLY_PHASE
#define ONLY_PHASE -1
#endif
#define IN(k) (lo <= (k) && (k) < hi && (ONLY_PHASE < 0 || ONLY_PHASE == (k)))
#define SEAM(k) do { if (IN(k) && IN((k) + 1)) xcd_barrier(bar); } while (0)
  if (IN(0)) phase0<0>(args, lds);
#define SEAMW(k, work) do { const bool _b = IN(k) && IN((k) + 1); if (_b) xcd_barrier_arrive(bar); if (IN(k)) { work; } if (_b) xcd_barrier_wait(bar); } while (0)
  SEAMW(0, phase0<1>(args, lds));
  if (IN(1)) phase1(args, lds);
  SEAMW(1, phase0<2>(args, lds));
  if (IN(2)) phase2(args, lds);
  SEAMW(2, phase0<3>(args, lds));
  if (IN(3)) phase3<0>(args, lds);
  const bool split34 = IN(3) && IN(4);
  if (split34) xcd_barrier_arrive(bar);
  if (IN(3)) phase3<1>(args, lds);
  if (IN(4)) phase4(args, lds, bar, split34);
  SEAMW(4, phase1b(args, lds));
  if (IN(5)) phase5(args, lds);
  SEAM(5);
  if (IN(6)) phase6(args, lds);
  const bool split67 = IN(6) && IN(7);
  if (split67) xcd_barrier_arrive(bar);
  if (IN(7)) phase7(args, lds, bar, split67);
#undef IN
#undef SEAM
}

extern "C" void kernel_launch(void* const* d_in, const int* in_sizes, int n_in, void* d_out, int out_size, void* d_ws, size_t ws_size, hipStream_t stream) {
  static int grid = 0;
  if (grid == 0) {
    if (n_in != 23 || out_size != T * DM || ws_size < WS_END) { fprintf(stderr, "kernel_launch: unexpected shapes (n_in %d out %d ws %zu need %zu)\n", n_in, out_size, ws_size, (size_t)WS_END); grid = -1; return; }
    int dev = 0, cus = 0, per_cu = 0;
    (void)hipGetDevice(&dev); (void)hipDeviceGetAttribute(&cus, hipDeviceAttributeMultiprocessorCount, dev);
    if (hipFuncSetAttribute((const void*)fwd, hipFuncAttributeMaxDynamicSharedMemorySize, LDS_BYTES) != hipSuccess) { fprintf(stderr, "kernel_launch: hipFuncSetAttribute failed\n"); grid = -1; return; }
    if (hipOccupancyMaxActiveBlocksPerMultiprocessor(&per_cu, (const void*)fwd, 512, LDS_BYTES) != hipSuccess || per_cu < 1) { fprintf(stderr, "kernel_launch: occupancy query says %d\n", per_cu); per_cu = 1; }
    (void)hipGetLastError();
    grid = cus;
  }
  if (grid < 0) return;
  (void)hipMemsetAsync((char*)d_ws + WS_BAR, 0, 16384, stream);
  Args a{};
  a.x = (const float*)d_in[0]; a.c = (const float*)d_in[1]; a.pos = (const int*)d_in[2];
  a.w_ada = (const float*)d_in[3]; a.b_ada = (const float*)d_in[4]; a.g_norm1 = (const float*)d_in[5]; a.w_in = (const float*)d_in[6];
  a.g_q_a = (const float*)d_in[7]; a.w_uq = (const float*)d_in[8]; a.g_kv_a = (const float*)d_in[9]; a.w_ukv = (const float*)d_in[10];
  a.g_sg = (const float*)d_in[11]; a.w_sg = (const float*)d_in[12]; a.b_sg = (const float*)d_in[13]; a.g_attn_out = (const float*)d_in[14];
  a.g_sg_out = (const float*)d_in[15]; a.w_o = (const float*)d_in[16]; a.g_norm2 = (const float*)d_in[17]; a.w_peer_q = (const float*)d_in[18];
  a.peer_keys = (const float*)d_in[19]; a.peer_u = (const float*)d_in[20]; a.peer_v = (const float*)d_in[21]; a.g_final = (const float*)d_in[22];
  a.out = (float*)d_out; a.ws = (unsigned char*)d_ws;
#if N_LAUNCH_MODE == 0
  a.ph_lo = 0; a.ph_hi = N_PHASES;
  hipLaunchKernelGGL(fwd, dim3(grid), dim3(512), LDS_BYTES, stream, a);
#else
  for (int p = 0; p < N_PHASES; ++p) for (int rep = 0; rep <= ((DUP_MASK >> p) & 1); ++rep) { a.ph_lo = p; a.ph_hi = p + 1; hipLaunchKernelGGL(fwd, dim3(grid), dim3(512), LDS_BYTES, stream, a); }
#endif
  const hipError_t le = hipPeekAtLastError();
  if (le != hipSuccess) fprintf(stderr, "kernel_launch: launch failed: %s\n", hipGetErrorName(le));
}
```
